# Optimizing an MI355X kernel written in HIP

```python
import math
import jax, jax.numpy as jnp
from jax import lax
import numpy as np

D_MODEL = 2048
BATCH = 2
SEQ = 4096
DEPTH = 1

N_HEADS = 8
HEAD_DIM = 128
N_KV_HEADS = 2
Q_PER_KV = N_HEADS // N_KV_HEADS
ATTN_WIDTH = N_HEADS * HEAD_DIM
KV_WIDTH = N_KV_HEADS * HEAD_DIM
IDX_HEADS = 16
IDX_DIM = 64
IDX_TOPK_MAX = 256
Q_BLOCK = 128
POOL_WINDOWS = (2, 4, 8, 16)
POOL_GROUPS = 4
POOL_WIDTH = 1024
POOL_GROUP_DIM = POOL_WIDTH // POOL_GROUPS
N_BRANCHES = 2
IN_SPLITS = (ATTN_WIDTH, KV_WIDTH, KV_WIDTH, IDX_HEADS * IDX_DIM, IDX_DIM, IDX_HEADS,
             POOL_WIDTH, N_BRANCHES * D_MODEL)
IN_WIDTH = 7760
N_EXPERTS = 64
N_EXPERT_GROUPS = 8
EXPERTS_PER_GROUP = N_EXPERTS // N_EXPERT_GROUPS
TOPK_GROUPS = 4
EXPERT_TOPK = 8
EXPERT_HIDDEN = 512
SHARED_HIDDEN = 512
ROUTED_SCALE = 2.5
MOE_BLOCK = 128
NORM_EPS = 1e-6
N_MOD = 6

kernel_name = "hybrid_dsa_pool_moe_adaln_block"


def rms_norm(x, g):
    xf = x.astype(jnp.float32)
    y = xf * lax.rsqrt(jnp.mean(xf * xf, axis=-1, keepdims=True) + NORM_EPS)
    return (y * g.astype(jnp.float32)).astype(x.dtype)


def alibi_slopes():
    s = np.array([2.0 ** (-8.0 * (i + 1) / N_HEADS) for i in range(N_HEADS)], dtype=np.float32)
    return jnp.asarray(s)


def sparse_indexed_attention(q, k, v, qi, ki, wi, q_norm, k_norm):
    B, S = q.shape[0], q.shape[1]
    topk = min(IDX_TOPK_MAX, S // 4)
    q = rms_norm(q.reshape(B, S, N_HEADS, HEAD_DIM), q_norm).reshape(B, S, N_KV_HEADS, Q_PER_KV, HEAD_DIM)
    k = rms_norm(k.reshape(B, S, N_KV_HEADS, HEAD_DIM), k_norm)
    v = v.reshape(B, S, N_KV_HEADS, HEAD_DIM)
    qi = qi.reshape(B, S, IDX_HEADS, IDX_DIM)
    wi = wi.astype(jnp.float32) * (IDX_HEADS ** -0.5 * IDX_DIM ** -0.5)
    slopes = alibi_slopes().reshape(N_KV_HEADS, Q_PER_KV)
    key_pos = jnp.arange(S)
    attn_scale = HEAD_DIM ** -0.5

    def block(i):
        start = i * Q_BLOCK
        qb = lax.dynamic_slice_in_dim(q, start, Q_BLOCK, axis=1)
        qib = lax.dynamic_slice_in_dim(qi, start, Q_BLOCK, axis=1)
        wib = lax.dynamic_slice_in_dim(wi, start, Q_BLOCK, axis=1)
        qpos = start + jnp.arange(Q_BLOCK)
        dots = jnp.einsum('bthd,bsd->bths', qib, ki).astype(jnp.float32)
        isc = jnp.einsum('bths,bth->bts', jax.nn.relu(dots), wib)
        causal = key_pos[None, :] <= qpos[:, None]
        isc = jnp.where(causal[None], isc, -jnp.inf)
        _, idx = lax.top_k(isc, topk)
        valid = idx <= qpos[None, :, None]
        k_sel = jax.vmap(lambda kb, ib: kb[ib])(k, idx)
        v_sel = jax.vmap(lambda vb, ib: vb[ib])(v, idx)
        logits = jnp.einsum('btngd,btjnd->btngj', qb, k_sel).astype(jnp.float32) * attn_scale
        dist = (qpos[None, :, None] - idx).astype(jnp.float32)
        logits = logits - slopes[None, None, :, :, None] * dist[:, :, None, None, :]
        logits = jnp.where(valid[:, :, None, None, :], logits, -jnp.inf)
        p = jax.nn.softmax(logits, axis=-1).astype(v.dtype)
        o = jnp.einsum('btngj,btjnd->btngd', p, v_sel)
        return o.reshape(B, Q_BLOCK, ATTN_WIDTH)

    out = lax.map(block, jnp.arange(S // Q_BLOCK))
    return out.transpose(1, 0, 2, 3).reshape(B, S, ATTN_WIDTH)


def causal_pool_minus_identity(u, window):
    S = u.shape[1]
    uf = u.astype(jnp.float32)
    cs = jnp.pad(jnp.cumsum(uf, axis=1), ((0, 0), (1, 0), (0, 0)))
    t = jnp.arange(S)
    lo = jnp.maximum(t + 1 - window, 0)
    win_sum = cs[:, t + 1] - cs[:, lo]
    count = (t + 1 - lo).astype(jnp.float32)
    return (win_sum / count[None, :, None] - uf).astype(u.dtype)


def multiscale_pool(u, pool_lin, pool_scale):
    B, S = u.shape[0], u.shape[1]
    ug = u.reshape(B, S, POOL_GROUPS, POOL_GROUP_DIM)
    pooled = jnp.stack([causal_pool_minus_identity(ug[:, :, g], POOL_WINDOWS[g])
                        for g in range(POOL_GROUPS)], axis=2)
    mixed = jnp.einsum('bsgc,gcd->bsgd', pooled, pool_lin).reshape(B, S, POOL_WIDTH)
    return mixed * pool_scale


def moe_ffn(h, w_router, router_bias, w1, w3, w2, ws1, ws3, ws2):
    B, S, D = h.shape
    N = B * S
    t = h.reshape(N, D)
    scores = jax.nn.sigmoid(jnp.dot(t, w_router).astype(jnp.float32))
    sel = scores + router_bias.astype(jnp.float32)
    grp_score = lax.top_k(sel.reshape(N, N_EXPERT_GROUPS, EXPERTS_PER_GROUP), 2)[0].sum(-1)
    _, top_g = lax.top_k(grp_score, TOPK_GROUPS)
    gmask = jnp.any(top_g[:, :, None] == jnp.arange(N_EXPERT_GROUPS)[None, None, :], axis=1)
    sel = jnp.where(jnp.repeat(gmask, EXPERTS_PER_GROUP, axis=1), sel, -jnp.inf)
    _, top_e = lax.top_k(sel, EXPERT_TOPK)
    gate = jnp.take_along_axis(scores, top_e, axis=1)
    gate = gate / jnp.sum(gate, axis=-1, keepdims=True) * ROUTED_SCALE
    NK = N * EXPERT_TOPK
    flat_e = top_e.reshape(-1)
    flat_tok = jnp.repeat(jnp.arange(N, dtype=jnp.int32), EXPERT_TOPK)
    flat_g = gate.reshape(-1)
    order = jnp.argsort(flat_e)
    sorted_e = flat_e[order]
    counts = jnp.bincount(flat_e, length=N_EXPERTS)
    padded = (counts + MOE_BLOCK - 1) // MOE_BLOCK * MOE_BLOCK
    pend = jnp.cumsum(padded)
    pstart = pend - padded
    ustart = jnp.cumsum(counts) - counts
    dest = pstart[sorted_e] + (jnp.arange(NK) - ustart[sorted_e])
    n_blocks = -(-(NK + N_EXPERTS * (MOE_BLOCK - 1)) // MOE_BLOCK)
    P = n_blocks * MOE_BLOCK
    buf_tok = jnp.zeros((P,), jnp.int32).at[dest].set(flat_tok[order])
    buf_gate = jnp.zeros((P,), jnp.float32).at[dest].set(flat_g[order])
    block_e = jnp.minimum(jnp.searchsorted(pend, jnp.arange(n_blocks) * MOE_BLOCK, side='right'),
                          N_EXPERTS - 1)

    def expert_block(args):
        e, tok, g = args
        xb = t[tok]
        y = jnp.dot(jax.nn.silu(jnp.dot(xb, w1[e])) * jnp.dot(xb, w3[e]), w2[e])
        return y * g[:, None].astype(y.dtype)

    ys = lax.map(expert_block, (block_e, buf_tok.reshape(n_blocks, MOE_BLOCK),
                                buf_gate.reshape(n_blocks, MOE_BLOCK)))
    routed = jax.ops.segment_sum(ys.reshape(P, D), buf_tok, num_segments=N)
    shared = jnp.dot(jax.nn.silu(jnp.dot(t, ws1)) * jnp.dot(t, ws3), ws2)
    return (routed + shared).reshape(B, S, D)


def hybrid_layer(x, c, w_ada, b_ada, g_mix, w_in, q_norm, k_norm, w_attn_up, pool_lin,
                 pool_scale, w_pool_up, w_out, g_ffn, w_router, router_bias, w1, w3, w2,
                 ws1, ws3, ws2):
    mod = jnp.dot(jax.nn.silu(c), w_ada) + b_ada
    shift_m, scale_m, gate_m, shift_f, scale_f, gate_f = jnp.split(mod[:, None, :], N_MOD, axis=-1)
    h = rms_norm(x, g_mix) * (1 + scale_m) + shift_m
    proj = jnp.dot(h, w_in)
    offs = np.cumsum(IN_SPLITS)[:-1].tolist()
    q, k, v, qi, ki, wi, u, gates = jnp.split(proj, offs, axis=-1)
    attn = sparse_indexed_attention(q, k, v, qi, ki, wi, q_norm, k_norm)
    pool = multiscale_pool(u, pool_lin, pool_scale)
    g_attn, g_pool = jnp.split(jax.nn.sigmoid(gates), N_BRANCHES, axis=-1)
    merged = g_attn * jnp.dot(attn, w_attn_up) + g_pool * jnp.dot(pool, w_pool_up)
    x = x + gate_m * jnp.dot(merged, w_out)
    h2 = rms_norm(x, g_ffn) * (1 + scale_f) + shift_f
    x = x + gate_f * moe_ffn(h2, w_router, router_bias, w1, w3, w2, ws1, ws3, ws2)
    return x


def setup_inputs(seed: int = 0) -> dict:
    key = jax.random.key(seed)
    ks = jax.random.split(key, 24)

    def nrm(k, shape, scale):
        return jax.random.normal(k, shape, jnp.float32) * scale

    L = DEPTH
    D = D_MODEL
    return {
        "x": nrm(ks[0], (BATCH, SEQ, D), 1.0),
        "c": nrm(ks[1], (BATCH, D), 1.0),
        "w_ada": nrm(ks[2], (L, D, N_MOD * D), 0.5 * D ** -0.5),
        "b_ada": nrm(ks[3], (L, N_MOD * D), 0.02),
        "g_mix": 1.0 + nrm(ks[4], (L, D), 0.02),
        "w_in": nrm(ks[5], (L, D, IN_WIDTH), D ** -0.5),
        "q_norm": 1.0 + nrm(ks[6], (L, HEAD_DIM), 0.02),
        "k_norm": 1.0 + nrm(ks[7], (L, HEAD_DIM), 0.02),
        "w_attn_up": nrm(ks[8], (L, ATTN_WIDTH, D), ATTN_WIDTH ** -0.5),
        "pool_lin": nrm(ks[9], (L, POOL_GROUPS, POOL_GROUP_DIM, POOL_GROUP_DIM), POOL_GROUP_DIM ** -0.5),
        "pool_scale": 1.0 + nrm(ks[10], (L, POOL_WIDTH), 0.02),
        "w_pool_up": nrm(ks[11], (L, POOL_WIDTH, D), POOL_WIDTH ** -0.5),
        "w_out": nrm(ks[12], (L, D, D), D ** -0.5),
        "g_ffn": 1.0 + nrm(ks[13], (L, D), 0.02),
        "w_router": nrm(ks[14], (L, D, N_EXPERTS), D ** -0.5),
        "router_bias": nrm(ks[15], (L, N_EXPERTS), 0.01),
        "w1": nrm(ks[16], (L, N_EXPERTS, D, EXPERT_HIDDEN), D ** -0.5),
        "w3": nrm(ks[17], (L, N_EXPERTS, D, EXPERT_HIDDEN), D ** -0.5),
        "w2": nrm(ks[18], (L, N_EXPERTS, EXPERT_HIDDEN, D), EXPERT_HIDDEN ** -0.5),
        "ws1": nrm(ks[19], (L, D, SHARED_HIDDEN), D ** -0.5),
        "ws3": nrm(ks[20], (L, D, SHARED_HIDDEN), D ** -0.5),
        "ws2": nrm(ks[21], (L, SHARED_HIDDEN, D), SHARED_HIDDEN ** -0.5),
    }


def reference(x, c, w_ada, b_ada, g_mix, w_in, q_norm, k_norm, w_attn_up, pool_lin, pool_scale,
              w_pool_up, w_out, g_ffn, w_router, router_bias, w1, w3, w2, ws1, ws3, ws2):
    for l in range(DEPTH):
        x = hybrid_layer(x, c, w_ada[l], b_ada[l], g_mix[l], w_in[l], q_norm[l], k_norm[l],
                         w_attn_up[l], pool_lin[l], pool_scale[l], w_pool_up[l], w_out[l],
                         g_ffn[l], w_router[l], router_bias[l], w1[l], w3[l], w2[l],
                         ws1[l], ws3[l], ws2[l])
    return x
```

```cpp
#include <hip/hip_runtime.h>
#include <cstdio>
#include <cstdint>

#define LAS __attribute__((address_space(3)))
#define GAS __attribute__((address_space(1)))
typedef unsigned short bf16_t;
typedef short bf16x8 __attribute__((ext_vector_type(8)));
typedef short s16x4 __attribute__((ext_vector_type(4)));
typedef float f32x4 __attribute__((ext_vector_type(4)));
typedef float f32x2 __attribute__((ext_vector_type(2)));
typedef float f32x16 __attribute__((ext_vector_type(16)));
typedef unsigned u32x4 __attribute__((ext_vector_type(4)));
typedef unsigned u32x2 __attribute__((ext_vector_type(2)));

constexpr int DM = 2048, NB = 2, SEQ = 4096, NTOK = NB * SEQ;
constexpr int NH = 8, HD = 128, NKV = 2, AW = 1024, KVW = 256, IH = 16, ID = 64, TOPK = 256;
constexpr int PW = 1024, INW = 7760, INP = 7936;
constexpr int NE = 64, EH = 512, NGRP = 8, EPG = 8, TOPG = 4, ETOP = 8;
constexpr float NORM_EPS = 1e-6f, ROUTED_SCALE = 2.5f;
constexpr int NTHR = 512, NWAVES = 8;

constexpr size_t MiB = 1u << 20;
constexpr size_t WS_CTL = 0, CTL_BYTES = 1 * MiB;
constexpr size_t WS_W13 = 1 * MiB;
constexpr size_t WS_W2 = WS_W13 + 256 * MiB;
constexpr size_t WS_WS13 = WS_W2 + 128 * MiB;
constexpr size_t WS_WS2 = WS_WS13 + 4 * MiB;
constexpr size_t WS_H = WS_WS2 + 2 * MiB;
constexpr int HROWS_R = 65536 + 64 * 256, HROWS = HROWS_R + NTOK;
constexpr size_t WS_ROUTE = WS_H + (size_t)HROWS * EH * 2;
constexpr size_t RT_EID = 0, RT_GATE = RT_EID + (size_t)NTOK * 8 * 4, RT_POS = RT_GATE + (size_t)NTOK * 8 * 4, RT_LIST = RT_POS + (size_t)NTOK * 8 * 4,
                 RT_IDENT = RT_LIST + (size_t)NE * NTOK * 4, RT_END = RT_IDENT + (size_t)NTOK * 4;
constexpr size_t WS_R = (WS_ROUTE + RT_END + MiB - 1) / MiB * MiB;
constexpr size_t WS_Y = WS_R;
constexpr size_t WS_WIN = WS_R;
constexpr size_t WS_WAU = WS_WIN + 31 * MiB, WS_WPU = WS_WAU + 4 * MiB, WS_WOUT = WS_WPU + 4 * MiB, WS_PLIN = WS_WOUT + 8 * MiB, WS_WR = WS_PLIN + MiB / 2;
constexpr size_t WS_HB = WS_WR + MiB / 2;
constexpr size_t WS_Q = WS_HB + 32 * MiB, WS_K = WS_Q + 16 * MiB, WS_V = WS_K + 4 * MiB, WS_QI = WS_V + 4 * MiB, WS_KW = WS_QI + 16 * MiB, WS_U = WS_KW + 4 * MiB,
                 WS_G = WS_U + 16 * MiB;
constexpr size_t WS_POOLED = WS_G + 64 * MiB, WS_POOL = WS_POOLED + 16 * MiB, WS_ATTN = WS_POOL + 16 * MiB, WS_MERGED = WS_ATTN + 16 * MiB, WS_MASK = WS_MERGED + 32 * MiB,
                 WS_REND = WS_MASK + 4 * MiB;
constexpr size_t WS_END = WS_Y + (size_t)HROWS_R * DM * 2;
static_assert(WS_REND <= WS_END, "overlay region");
constexpr int CW_BAR = 4096;
constexpr int CW_ECNT = 8192;
constexpr int CW_MOD = 16384;
static_assert((CW_MOD + 2 * 6 * DM) * 4 <= (int)CTL_BYTES, "ctl");

__device__ __forceinline__ int lane_id() { int l; asm volatile("v_mbcnt_lo_u32_b32 %0, -1, 0\n\tv_mbcnt_hi_u32_b32 %0, -1, %0" : "=v"(l)); return l; }
__device__ __forceinline__ unsigned cvt_pk_bf16(float lo, float hi) { unsigned r; asm volatile("v_cvt_pk_bf16_f32 %0, %1, %2" : "=v"(r) : "v"(lo), "v"(hi)); return r; }
__device__ __forceinline__ float bf2f(unsigned short b) { return __uint_as_float(((unsigned)b) << 16); }
__device__ __forceinline__ float bflo(unsigned w) { return __uint_as_float(w << 16); }
__device__ __forceinline__ float bfhi(unsigned w) { return __uint_as_float(w & 0xffff0000u); }
__device__ __forceinline__ float wave_sum(float v) {
#pragma unroll
    for (int o = 1; o < 64; o <<= 1) v += __shfl_xor(v, o);
    return v;
}
__device__ __forceinline__ float sigmoidf_(float x) { return 1.0f / (1.0f + __expf(-x)); }

#define XB_TMO      128
#define XB_XCNT(j)  (256  + 64 * (j))
#define XB_XSUB(j)  (1280 + 64 * (j))
#define XB_XGEN(j)  (2304 + 64 * (j))
#define XB_TOP      3328
#define XB_TOPGEN   3392
#define XCD_BAR_WORDS 3456
#define XB_SPIN_CAP (1u << 18)
__device__ __forceinline__ unsigned xb_ld(unsigned* p)              { return __hip_atomic_load(p, __ATOMIC_RELAXED, __HIP_MEMORY_SCOPE_AGENT); }
__device__ __forceinline__ unsigned xb_add(unsigned* p, unsigned v) { return __hip_atomic_fetch_add(p, v, __ATOMIC_RELAXED, __HIP_MEMORY_SCOPE_AGENT); }
__device__ __forceinline__ unsigned xb_xcc_id() { return (unsigned)__builtin_amdgcn_s_getreg((3 << 11) | 20) & 0xFu; }
#define XB_SPIN(cond, bar) do { unsigned _sp = 0; while (cond) { __builtin_amdgcn_s_sleep(1); \
    if ((++_sp & 255u) == 0u) { if (xb_ld(&(bar)[XB_TMO])) break; if (_sp > XB_SPIN_CAP) { atomicAdd(&(bar)[XB_TMO], 1u); break; } } } } while (0)
struct XcdBarrier { unsigned* bar; unsigned x; volatile LAS unsigned* st; };
__device__ __forceinline__ XcdBarrier xcd_barrier_post(unsigned* bar, volatile LAS unsigned* st, int wave) {
    XcdBarrier b; b.bar = bar; b.x = xb_xcc_id(); b.st = st;
    if (wave == 0 && lane_id() == 0) (void)xb_add(&bar[XB_XCNT(b.x)], 1u);
    return b;
}
__device__ __forceinline__ void xcd_barrier_complete(unsigned* bar, unsigned x, unsigned& nloc, unsigned& nx) {
    const unsigned G = gridDim.x * gridDim.y * gridDim.z;
    unsigned sum, cnt, mine, sp = 0u;
    for (;;) {
        sum = 0u; cnt = 0u; mine = 0u;
#pragma unroll
        for (unsigned j = 0; j < 16; ++j) { const unsigned c = xb_ld(&bar[XB_XCNT(j)]); sum += c; cnt += (c > 0u) ? 1u : 0u; mine = (j == x) ? c : mine; }
        if (sum == G) break;
        __builtin_amdgcn_s_sleep(1);
        if ((++sp & 255u) == 0u) { if (xb_ld(&bar[XB_TMO])) break; if (sp > XB_SPIN_CAP) { atomicAdd(&bar[XB_TMO], 1u); break; } }
    }
    nloc = mine > 0u ? mine : 1u; nx = cnt > 0u ? cnt : 1u;
}
__device__ __forceinline__ void xcd_barrier(const XcdBarrier& b, int wave) {
    asm volatile("s_waitcnt vmcnt(0)" ::: "memory");
    __syncthreads();
    if (wave == 0 && lane_id() == 0) {
        unsigned* bar = b.bar;
        __builtin_amdgcn_s_waitcnt(0);
        unsigned nloc = b.st[0], nx = b.st[1];
        if (nloc == 0u) { xcd_barrier_complete(bar, b.x, nloc, nx); b.st[0] = nloc; b.st[1] = nx; }
        const unsigned old = xb_add(&bar[XB_XSUB(b.x)], 1u);
        const unsigned gen = old / nloc;
        if (old + 1u == (gen + 1u) * nloc) {
            __builtin_amdgcn_fence(__ATOMIC_RELEASE, "agent");
            asm volatile("s_waitcnt vmcnt(0)" ::: "memory");
            const unsigned og = xb_add(&bar[XB_TOP], 1u);
            const unsigned tg = og / nx;
            if (og + 1u == (tg + 1u) * nx) xb_add(&bar[XB_TOPGEN], 1u);
            else XB_SPIN(xb_ld(&bar[XB_TOPGEN]) == tg, bar);
            __builtin_amdgcn_fence(__ATOMIC_ACQUIRE, "agent");
            xb_add(&bar[XB_XGEN(b.x)], 1u);
            asm volatile("s_waitcnt vmcnt(0)" ::: "memory");
        } else {
            XB_SPIN(xb_ld(&bar[XB_XGEN(b.x)]) == gen, bar);
            __builtin_amdgcn_fence(__ATOMIC_ACQUIRE, "agent");
            asm volatile("s_waitcnt vmcnt(0)" ::: "memory");
        }
    }
    __syncthreads();
}
namespace pg8 {
constexpr int BM = 256, BK = 64, HALF = 128, HTB = HALF * BK * 2, STAGE_BYTES = 8 * HTB, NXCD = 8, WGM = 8;
__host__ __device__ __forceinline__ int lds_byte(int r, int c) { const int st = (r >> 4) * 2 + (c >> 5), rr = r & 15, cc = c & 31, ob = rr * 64 + cc * 2; return st * 1024 + (ob ^ (((ob >> 9) & 1) << 5)); }
__host__ __device__ __forceinline__ void stage_rc(int b, int& R, int& C) { const int st = b / 1024, sb = b % 1024, swz = sb ^ (((sb >> 9) & 1) << 5); R = (st >> 1) * 16 + swz / 64; C = (st & 1) * 32 + (swz % 64) / 2; }
__host__ __device__ __forceinline__ int perm32(int rho) { const int n = rho >> 4, i = rho & 15; return 8 * (i >> 2) + 4 * n + (i & 3); }

struct Unit { const char* A; const char* B; const int* tok; int pm, pn, aux; };

struct TileOrder {
    int nM, nN, nwg, G, c;
    __device__ void init(int M, int N, int G_, int c_) { nM = M / BM; nN = N / BM; nwg = nM * nN; G = G_; c = c_; }
    __device__ bool tile(int i, int& pm, int& pn) const {
        const long L = (long)i * G + c; if (L >= nwg) return false;
        int wgid = (int)L; { const int q = nwg / NXCD, r = nwg % NXCD, xcd = wgid % NXCD, off = wgid / NXCD; wgid = (xcd < r ? xcd * (q + 1) : r * (q + 1) + (xcd - r) * q) + off; }
        const int nig = WGM * nN, gid = wgid / nig, fm = gid * WGM, gsz = (nM - fm) < WGM ? (nM - fm) : WGM;
        pm = fm + ((wgid % nig) % gsz); pn = (wgid % nig) / gsz; return true;
    }
};

template <class Epi, class Sched, bool GATHER>
__device__ __forceinline__ void gemm_phase(LAS unsigned char* lds, const int wid, const int K, const int lda, const Sched& S, const Epi& E) {
    const int lane = lane_id(), tid = wid * 64 + lane, wr = wid >> 2, wc = wid & 3, fr = lane & 15, fq = lane >> 4;
    const int nt = K / BK;
    unsigned voffA[2], voffB[2]; int RA[2], CA[2];
#pragma unroll
    for (int i = 0; i < 2; ++i) { int R, C; stage_rc(tid * 16 + i * 8192, R, C); const int Rb = (R & ~31) + perm32(R & 31);
        voffA[i] = (unsigned)(R * lda + C) * 2u; voffB[i] = (unsigned)(Rb * K + C) * 2u; RA[i] = R; CA[i] = C; }
    const size_t kstep = (size_t)(BK * 2);
    const size_t hstepA = (size_t)HALF * lda * 2, hstepB = (size_t)HALF * K * 2;
    const unsigned ldsw = (unsigned)wid * 1024u;
    const int aoff = lds_byte(wr * 64 + fr, fq * 8), boff = lds_byte(wc * 32 + fr, fq * 8);
#define PG8_SA(b, h) (((b) * 2 + (h)) * HTB)
#define PG8_SB(b, h) ((4 + (b) * 2 + (h)) * HTB)
#define PG8_DMA(bufoff, gptr, i_) __builtin_amdgcn_global_load_lds((const GAS unsigned*)(gptr), (LAS unsigned*)(lds + (bufoff) + ldsw + (i_) * 8192), 16, 0, 0)
#define PG8_STAGEB(bufoff, gbase) do { _Pragma("unroll") for (int _i = 0; _i < 2; ++_i) PG8_DMA(bufoff, (const char*)(gbase) + voffB[_i], _i); } while (0)
#define PG8_STAGEA(bufoff, kt, h, GO) do { _Pragma("unroll") for (int _i = 0; _i < 2; ++_i) { \
        if constexpr (GATHER) PG8_DMA(bufoff, (const char*)(kt) + GO[h][_i], _i); else PG8_DMA(bufoff, (const char*)(kt) + (h) * hstepA + voffA[_i], _i); } } while (0)
#define PG8_LDA(dst, b, h) do { _Pragma("unroll") for (int m = 0; m < 4; ++m) _Pragma("unroll") for (int k = 0; k < 2; ++k) dst[m][k] = *(const LAS bf16x8*)(lds + PG8_SA(b, h) + aoff + m * 2048 + k * 1024); } while (0)
#define PG8_LDB(dst, b, h) do { _Pragma("unroll") for (int n = 0; n < 2; ++n) _Pragma("unroll") for (int k = 0; k < 2; ++k) dst[n][k] = *(const LAS bf16x8*)(lds + PG8_SB(b, h) + boff + n * 2048 + k * 1024); } while (0)
#define PG8_MMA(ai, bj, At, Bt) do { __builtin_amdgcn_s_setprio(1); _Pragma("unroll") for (int m = 0; m < 4; ++m) _Pragma("unroll") for (int n = 0; n < 2; ++n) _Pragma("unroll") for (int k = 0; k < 2; ++k) \
        acc[ai][bj][m][n] = __builtin_amdgcn_mfma_f32_16x16x32_bf16(Bt[n][k], At[m][k], acc[ai][bj][m][n], 0, 0, 0); __builtin_amdgcn_s_setprio(0); } while (0)
#define PG8_WAIT_V(n) asm volatile("s_waitcnt vmcnt(" #n ")" ::: "memory")
#define PG8_WAIT_L(n) asm volatile("s_waitcnt lgkmcnt(" #n ")" ::: "memory")
#define PG8_BAR __builtin_amdgcn_s_barrier()
#define PG8_SCHED __builtin_amdgcn_sched_barrier(0)
#define PG8_GLOAD(GO, u) do { if constexpr (GATHER) { _Pragma("unroll") for (int _h = 0; _h < 2; ++_h) _Pragma("unroll") for (int _i = 0; _i < 2; ++_i) \
        { unsigned _t = (unsigned)(u).tok[_h * HALF + RA[_i]]; _t = _t < (unsigned)NTOK ? _t : (unsigned)(NTOK - 1); GO[_h][_i] = (_t * (unsigned)lda + (unsigned)CA[_i]) * 2u; } } } while (0)
    Unit cur, nxt; int ui = 0;
    if (!S.next(0, cur)) return;
    f32x4 acc[2][2][4][2];
#pragma unroll
    for (int a = 0; a < 2; ++a)
#pragma unroll
        for (int b = 0; b < 2; ++b)
#pragma unroll
            for (int m = 0; m < 4; ++m)
#pragma unroll
                for (int n = 0; n < 2; ++n) acc[a][b][m][n] = (f32x4){0.f, 0.f, 0.f, 0.f};
    bf16x8 At[4][2], B0[2][2], B1[2][2];
    unsigned gC[2][2] = {{0u, 0u}, {0u, 0u}}, gN[2][2] = {{0u, 0u}, {0u, 0u}};
    PG8_GLOAD(gC, cur);
    const char* cA = cur.A; const char* cB = cur.B;
    PG8_STAGEB(PG8_SB(0, 0), cB); PG8_STAGEB(PG8_SB(0, 1), cB + hstepB); PG8_STAGEA(PG8_SA(0, 0), cA, 0, gC); PG8_STAGEA(PG8_SA(0, 1), cA, 1, gC);
    if (wr == 1) PG8_BAR;
    PG8_WAIT_V(2); PG8_BAR;
    PG8_STAGEB(PG8_SB(1, 0), cB + kstep); PG8_STAGEA(PG8_SA(1, 0), cA + kstep, 0, gC); PG8_STAGEB(PG8_SB(1, 1), cB + hstepB + kstep);
    PG8_WAIT_V(6); PG8_BAR;
    for (;;) {
        const bool has_next = S.next(ui + 1, nxt);
        if (has_next) PG8_GLOAD(gN, nxt);
        const char* nA = has_next ? nxt.A : cA; const char* nB = has_next ? nxt.B : cB;
        for (int t = 0; t < nt; t += 2) {
            const bool last = (t == nt - 2);
            const char* a1 = cA + (size_t)(t + 1) * kstep;
            const char* a2 = last ? nA : cA + (size_t)(t + 2) * kstep; const char* b2 = last ? nB : cB + (size_t)(t + 2) * kstep;
            const char* a3 = a2 + kstep; const char* b3 = b2 + kstep;
            unsigned g2[2][2];
#pragma unroll
            for (int _h = 0; _h < 2; ++_h)
#pragma unroll
                for (int _i = 0; _i < 2; ++_i) g2[_h][_i] = gC[_h][_i];
            if (GATHER && last && has_next) {
#pragma unroll
                for (int _h = 0; _h < 2; ++_h)
#pragma unroll
                    for (int _i = 0; _i < 2; ++_i) g2[_h][_i] = gN[_h][_i];
            }
            PG8_LDB(B0, 0, 0); PG8_LDB(B1, 0, 1); PG8_SCHED; PG8_LDA(At, 0, 0); PG8_STAGEA(PG8_SA(1, 1), a1, 1, gC);
            PG8_WAIT_V(8); PG8_WAIT_L(0); PG8_BAR; PG8_MMA(0, 0, At, B0); PG8_MMA(0, 1, At, B1); PG8_BAR; PG8_SCHED;
            PG8_LDA(At, 0, 1); PG8_STAGEB(PG8_SB(0, 0), b2); PG8_STAGEB(PG8_SB(0, 1), b2 + hstepB); PG8_STAGEA(PG8_SA(0, 0), a2, 0, g2);
            PG8_WAIT_V(8); PG8_WAIT_L(0); PG8_BAR; PG8_MMA(1, 0, At, B0); PG8_MMA(1, 1, At, B1); PG8_BAR; PG8_SCHED;
            PG8_LDB(B0, 1, 0); PG8_LDB(B1, 1, 1); PG8_SCHED; PG8_LDA(At, 1, 0); PG8_STAGEA(PG8_SA(0, 1), a2, 1, g2);
            PG8_WAIT_V(8); PG8_WAIT_L(0); PG8_BAR; PG8_MMA(0, 0, At, B0); PG8_MMA(0, 1, At, B1); PG8_BAR; PG8_SCHED;
            PG8_LDA(At, 1, 1); PG8_STAGEB(PG8_SB(1, 0), b3); PG8_STAGEB(PG8_SB(1, 1), b3 + hstepB); PG8_STAGEA(PG8_SA(1, 0), a3, 0, g2);
            PG8_WAIT_V(8); PG8_WAIT_L(0); PG8_BAR; PG8_MMA(1, 0, At, B0); PG8_MMA(1, 1, At, B1); PG8_BAR; PG8_SCHED;
        }
        if (wr == 0) PG8_BAR;
        asm volatile("s_nop 15\n\ts_nop 7" ::: "memory");
        const bool keep = E(acc, cur, wr, wc, fr, fq);
        if (!has_next) break;
        if (!keep) {
#pragma unroll
        for (int a = 0; a < 2; ++a)
#pragma unroll
            for (int b = 0; b < 2; ++b)
#pragma unroll
                for (int m = 0; m < 4; ++m)
#pragma unroll
                    for (int n = 0; n < 2; ++n) acc[a][b][m][n] = (f32x4){0.f, 0.f, 0.f, 0.f};
        }
        cur = nxt; cA = nA; cB = nB; ++ui;
#pragma unroll
        for (int _h = 0; _h < 2; ++_h)
#pragma unroll
            for (int _i = 0; _i < 2; ++_i) gC[_h][_i] = gN[_h][_i];
        if (wr == 1) PG8_BAR;
    }
    PG8_WAIT_V(0);
    PG8_BAR;
#undef PG8_SA
#undef PG8_SB
#undef PG8_DMA
#undef PG8_STAGEA
#undef PG8_STAGEB
#undef PG8_LDA
#undef PG8_LDB
#undef PG8_MMA
#undef PG8_WAIT_V
#undef PG8_WAIT_L
#undef PG8_BAR
#undef PG8_SCHED
#undef PG8_GLOAD
}
}
struct Args { const float* in[22]; float* out; unsigned char* ws; int ph_lo, ph_hi; };
enum { I_X = 0, I_C, I_WADA, I_BADA, I_GMIX, I_WIN, I_QNORM, I_KNORM, I_WAU, I_PLIN, I_PSCALE, I_WPU, I_WOUT, I_GFFN, I_WROUTER, I_RBIAS, I_W1, I_W3, I_W2, I_WS1, I_WS3, I_WS2 };
struct Frame {
    LAS unsigned char* lds;
    int wave, G, gw, NGW;
    unsigned char* ws; unsigned* ctl; float* out;
};
#define LDS_WAIT() asm volatile("s_waitcnt lgkmcnt(0)" ::: "memory")
#define VM_WAIT() asm volatile("s_waitcnt vmcnt(0)" ::: "memory")

__device__ __forceinline__ void tr_tile(const float* __restrict__ src, int ld_src, int nvalid, bf16_t* __restrict__ dst, int ld_dst, int lane) {
    const int q = lane >> 4, c4 = (lane & 15) * 4;
    const bool ok = c4 < nvalid;
#pragma unroll
    for (int g = 0; g < 2; ++g) {
        f32x4 v[8];
#pragma unroll
        for (int j = 0; j < 8; ++j) { const int k = 32 * g + 8 * q + j; v[j] = ok ? *(const f32x4*)(src + (size_t)k * ld_src + c4) : (f32x4){0.f, 0.f, 0.f, 0.f}; }
#pragma unroll
        for (int nn = 0; nn < 4; ++nn) {
            u32x4 w; w.x = cvt_pk_bf16(v[0][nn], v[1][nn]); w.y = cvt_pk_bf16(v[2][nn], v[3][nn]); w.z = cvt_pk_bf16(v[4][nn], v[5][nn]); w.w = cvt_pk_bf16(v[6][nn], v[7][nn]);
            *(u32x4*)(dst + (size_t)(c4 + nn) * ld_dst + 32 * g + 8 * q) = w;
        }
    }
}
constexpr int ADA_WGS = 6 * DM / 128;
__device__ __forceinline__ void p0_prologue(Frame& F, const Args& a) {
    LAS float* sc = (LAS float*)F.lds;
    const int lane = lane_id(), tid = F.wave * 64 + lane;
    for (int i = tid; i < NB * DM; i += NTHR) { const float c = a.in[I_C][i]; sc[i] = c / (1.0f + __expf(-c)); }
    __syncthreads();
    float* mod = (float*)(F.ctl + CW_MOD);
    unsigned char* ws = F.ws;
    for (int strip = blockIdx.x; strip < ADA_WGS; strip += F.G) {
        const int w = F.wave, col = strip * 128 + 2 * lane;
        const float* wp = a.in[I_WADA] + (size_t)(256 * w) * (6 * DM) + col;
        f32x2 a0 = {0.f, 0.f}, a1 = {0.f, 0.f};
#pragma unroll 16
        for (int k = 0; k < 256; ++k) { const f32x2 wv = *(const f32x2*)(wp + (size_t)k * (6 * DM)); const float s0 = sc[256 * w + k], s1 = sc[DM + 256 * w + k]; a0 += wv * s0; a1 += wv * s1; }
        LAS float* part = (LAS float*)(F.lds + 16384);
        *(LAS f32x2*)(part + (w * 2 + 0) * 128 + 2 * lane) = a0; *(LAS f32x2*)(part + (w * 2 + 1) * 128 + 2 * lane) = a1;
        __syncthreads();
        if (tid < 256) { const int b = tid >> 7, c = tid & 127; float sum = a.in[I_BADA][strip * 128 + c];
#pragma unroll
            for (int ww = 0; ww < 8; ++ww) sum += part[(ww * 2 + b) * 128 + c];
            mod[b * 6 * DM + strip * 128 + c] = sum; }
        __syncthreads();
    }
    bf16_t* Win_t = (bf16_t*)(ws + WS_WIN);
    constexpr int J_IN_A = 32 * 40, J_IN_B = 32 * 4, J_IN_C = 32 * 80, J_AU = 16 * 32, J_PU = 16 * 32, J_OUT = 32 * 32, J_PL = 4 * 16, J_S13 = 2 * 32 * 8, J_S2 = 8 * 32, J_WR = 32,
                  J_W13 = NE * 2 * 32 * 8, J_W2 = NE * 8 * 32;
    constexpr int NITEMS = J_IN_A + J_IN_B + J_IN_C + J_AU + J_PU + J_OUT + J_PL + J_S13 + J_S2 + J_WR + J_W13 + J_W2;
    for (int it = F.gw; it < NITEMS; it += F.NGW) {
        int r = it;
        if (r < J_IN_A) { const int kb = r / 40, nb = r % 40; tr_tile(a.in[I_WIN] + (size_t)(64 * kb) * INW + 64 * nb, INW, 64, Win_t + (size_t)(64 * nb) * DM + 64 * kb, DM, lane); continue; } r -= J_IN_A;
        if (r < J_IN_B) { const int kb = r / 4, nb = r % 4; const int nv = nb == 0 ? 64 : (nb == 1 ? 16 : 0);
            tr_tile(a.in[I_WIN] + (size_t)(64 * kb) * INW + 2560 + (nb < 2 ? 64 * nb : 0), INW, nv, Win_t + (size_t)(2560 + 64 * nb) * DM + 64 * kb, DM, lane); continue; } r -= J_IN_B;
        if (r < J_IN_C) { const int kb = r / 80, nb = r % 80; tr_tile(a.in[I_WIN] + (size_t)(64 * kb) * INW + 2640 + 64 * nb, INW, 64, Win_t + (size_t)(2816 + 64 * nb) * DM + 64 * kb, DM, lane); continue; } r -= J_IN_C;
        if (r < J_AU) { const int kb = r / 32, nb = r % 32; tr_tile(a.in[I_WAU] + (size_t)(64 * kb) * DM + 64 * nb, DM, 64, (bf16_t*)(ws + WS_WAU) + (size_t)(64 * nb) * AW + 64 * kb, AW, lane); continue; } r -= J_AU;
        if (r < J_PU) { const int kb = r / 32, nb = r % 32; tr_tile(a.in[I_WPU] + (size_t)(64 * kb) * DM + 64 * nb, DM, 64, (bf16_t*)(ws + WS_WPU) + (size_t)(64 * nb) * PW + 64 * kb, PW, lane); continue; } r -= J_PU;
        if (r < J_OUT) { const int kb = r / 32, nb = r % 32; tr_tile(a.in[I_WOUT] + (size_t)(64 * kb) * DM + 64 * nb, DM, 64, (bf16_t*)(ws + WS_WOUT) + (size_t)(64 * nb) * DM + 64 * kb, DM, lane); continue; } r -= J_OUT;
        if (r < J_PL) { const int g = r / 16, kb = (r % 16) / 4, nb = r % 4; tr_tile(a.in[I_PLIN] + (size_t)g * 65536 + (size_t)(64 * kb) * 256 + 64 * nb, 256, 64, (bf16_t*)(ws + WS_PLIN) + (size_t)g * 65536 + (size_t)(64 * nb) * 256 + 64 * kb, 256, lane); continue; } r -= J_PL;
        if (r < J_S13) { const int which = r / 256, kb = (r % 256) / 8, nb = r % 8; const float* src = (which ? a.in[I_WS3] : a.in[I_WS1]) + (size_t)(64 * kb) * EH + 64 * nb;
            tr_tile(src, EH, 64, (bf16_t*)(ws + WS_WS13) + (size_t)(256 * (nb >> 1) + 64 * (nb & 1) + 128 * which) * DM + 64 * kb, DM, lane); continue; } r -= J_S13;
        if (r < J_S2) { const int kb = r / 32, nb = r % 32; tr_tile(a.in[I_WS2] + (size_t)(64 * kb) * DM + 64 * nb, DM, 64, (bf16_t*)(ws + WS_WS2) + (size_t)(64 * nb) * EH + 64 * kb, EH, lane); continue; } r -= J_S2;
        if (r < J_WR) { const int kb = r; tr_tile(a.in[I_WROUTER] + (size_t)(64 * kb) * NE, NE, 64, (bf16_t*)(ws + WS_WR) + 64 * kb, DM, lane); continue; } r -= J_WR;
        if (r < J_W13) { const int e = r / 512, rr = r % 512, which = rr / 256, kb = (rr % 256) / 8, nb = rr % 8;
            const float* src = (which ? a.in[I_W3] : a.in[I_W1]) + ((size_t)e * DM + 64 * kb) * EH + 64 * nb;
            tr_tile(src, EH, 64, (bf16_t*)(ws + WS_W13) + ((size_t)e * 1024 + 256 * (nb >> 1) + 64 * (nb & 1) + 128 * which) * DM + 64 * kb, DM, lane); continue; } r -= J_W13;
        { const int e = r / 256, kb = (r % 256) / 32, nb = r % 32;
            tr_tile(a.in[I_W2] + ((size_t)e * EH + 64 * kb) * DM + 64 * nb, DM, 64, (bf16_t*)(ws + WS_W2) + ((size_t)e * DM + 64 * nb) * EH + 64 * kb, EH, lane); }
    }
}

__device__ __forceinline__ void modnorm_row(const float* __restrict__ xrow, const float* __restrict__ g, const float* __restrict__ shift, const float* __restrict__ scale, bf16_t* __restrict__ orow, int lane) {
    f32x4 v[8]; float ss = 0.f;
#pragma unroll
    for (int j = 0; j < 8; ++j) { v[j] = *(const f32x4*)(xrow + 4 * lane + 256 * j); ss += (v[j].x * v[j].x + v[j].y * v[j].y) + (v[j].z * v[j].z + v[j].w * v[j].w); }
    const float rstd = rsqrtf(wave_sum(ss) * (1.0f / DM) + NORM_EPS);
#pragma unroll
    for (int j = 0; j < 8; ++j) { const int c = 4 * lane + 256 * j;
        const f32x4 gg = *(const f32x4*)(g + c), sh = *(const f32x4*)(shift + c), sl = *(const f32x4*)(scale + c);
        const f32x4 o = v[j] * rstd * gg * (sl + 1.0f) + sh;
        u32x2 w; w.x = cvt_pk_bf16(o.x, o.y); w.y = cvt_pk_bf16(o.z, o.w);
        *(u32x2*)(orow + c) = w; }
}
__device__ __forceinline__ void p1_h(Frame& F, const Args& a) {
    const float* mod = (const float*)(F.ctl + CW_MOD);
    bf16_t* hb = (bf16_t*)(F.ws + WS_HB); const int lane = lane_id();
    for (int m = F.gw; m < NTOK; m += F.NGW) { const int b = m / SEQ;
        modnorm_row(a.in[I_X] + (size_t)m * DM, a.in[I_GMIX], mod + b * 6 * DM + 0 * DM, mod + b * 6 * DM + 1 * DM, hb + (size_t)m * DM, lane); }
}
struct SchedDense {
    pg8::TileOrder T; const char* A; const char* B; size_t a_tile, b_tile;
    __device__ __forceinline__ bool next(int i, pg8::Unit& u) const { int pm, pn; if (!T.tile(i, pm, pn)) return false; u.pm = pm; u.pn = pn; u.aux = 0; u.tok = nullptr;
        u.A = A + (size_t)pm * a_tile; u.B = B + (size_t)pn * b_tile; return true; }
};
__device__ __forceinline__ void st_bf16x8(bf16_t* p, f32x4 v0, f32x4 v1) { u32x4 w; w.x = cvt_pk_bf16(v0[0], v0[1]); w.y = cvt_pk_bf16(v0[2], v0[3]); w.z = cvt_pk_bf16(v1[0], v1[1]); w.w = cvt_pk_bf16(v1[2], v1[3]); *(u32x4*)p = w; }
struct EpiInproj {
    unsigned char* ws;
    __device__ __forceinline__ bool operator()(f32x4 (&acc)[2][2][4][2], const pg8::Unit& u, int wr, int wc, int fr, int fq) const {
        const int pn = u.pn; bf16_t* base; int ld, ct; bool sig = false;
        if (pn < 4) { base = (bf16_t*)(ws + WS_Q); ld = AW; ct = pn; }
        else if (pn == 4) { base = (bf16_t*)(ws + WS_K); ld = KVW; ct = 0; }
        else if (pn == 5) { base = (bf16_t*)(ws + WS_V); ld = KVW; ct = 0; }
        else if (pn < 10) { base = (bf16_t*)(ws + WS_QI); ld = IH * ID; ct = pn - 6; }
        else if (pn == 10) { base = (bf16_t*)(ws + WS_KW); ld = 256; ct = 0; }
        else if (pn < 15) { base = (bf16_t*)(ws + WS_U); ld = PW; ct = pn - 11; }
        else { base = (bf16_t*)(ws + WS_G); ld = 2 * DM; ct = pn - 15; sig = true; }
        const int row0 = u.pm * 256 + wr * 64 + fr, col0 = ct * 256 + wc * 32 + 8 * fq;
#pragma unroll
        for (int ai = 0; ai < 2; ++ai)
#pragma unroll
            for (int m = 0; m < 4; ++m) { bf16_t* rowp = base + (size_t)(row0 + ai * 128 + m * 16) * ld + col0;
#pragma unroll
                for (int bj = 0; bj < 2; ++bj) { f32x4 v0 = acc[ai][bj][m][0], v1 = acc[ai][bj][m][1];
                    if (sig) {
#pragma unroll
                        for (int j = 0; j < 4; ++j) { v0[j] = fminf(__builtin_amdgcn_rcpf(1.0f + __expf(-v0[j])), 1.0f); v1[j] = fminf(__builtin_amdgcn_rcpf(1.0f + __expf(-v1[j])), 1.0f); } }
                    st_bf16x8(rowp + bj * 128, v0, v1); } }
        return false;
    }
};
__device__ __forceinline__ void p2_inproj(Frame& F) {
    SchedDense S; S.T.init(NTOK, INP, F.G, (int)blockIdx.x); S.A = (const char*)(F.ws + WS_HB); S.B = (const char*)(F.ws + WS_WIN);
    S.a_tile = (size_t)256 * DM * 2; S.b_tile = (size_t)256 * DM * 2;
    EpiInproj E{F.ws};
    pg8::gemm_phase<EpiInproj, SchedDense, false>(F.lds, F.wave, DM, DM, S, E);
}
__device__ __forceinline__ void p3_qknorm(Frame& F, const Args& a) {
    bf16_t* Q = (bf16_t*)(F.ws + WS_Q); bf16_t* K = (bf16_t*)(F.ws + WS_K);
    const int lane = lane_id(); const float SCALE = 0.08838834764831845f;
    for (int m = F.gw; m < NTOK; m += F.NGW) {
        u32x4 q0 = *(const u32x4*)(Q + (size_t)m * AW + 16 * lane), q1 = *(const u32x4*)(Q + (size_t)m * AW + 16 * lane + 8);
        u32x2 k0 = *(const u32x2*)(K + (size_t)m * KVW + 4 * lane);
        float qv[16], kv[4]; float ss = 0.f, sk = 0.f;
#pragma unroll
        for (int j = 0; j < 4; ++j) { qv[2 * j] = bflo(q0[j]); qv[2 * j + 1] = bfhi(q0[j]); qv[8 + 2 * j] = bflo(q1[j]); qv[8 + 2 * j + 1] = bfhi(q1[j]); }
#pragma unroll
        for (int j = 0; j < 16; ++j) ss += qv[j] * qv[j];
        kv[0] = bflo(k0[0]); kv[1] = bfhi(k0[0]); kv[2] = bflo(k0[1]); kv[3] = bfhi(k0[1]);
#pragma unroll
        for (int j = 0; j < 4; ++j) sk += kv[j] * kv[j];
        ss += __shfl_xor(ss, 1); ss += __shfl_xor(ss, 2); ss += __shfl_xor(ss, 4);
        sk += __shfl_xor(sk, 1); sk += __shfl_xor(sk, 2); sk += __shfl_xor(sk, 4); sk += __shfl_xor(sk, 8); sk += __shfl_xor(sk, 16);
        const float rq = rsqrtf(ss * (1.0f / HD) + NORM_EPS) * SCALE, rk = rsqrtf(sk * (1.0f / HD) + NORM_EPS);
        const int dq = (16 * lane) & 127, dk = (4 * lane) & 127;
        float qn[16];
#pragma unroll
        for (int j = 0; j < 16; ++j) qn[j] = qv[j] * rq * a.in[I_QNORM][dq + j];
        u32x4 o0, o1;
#pragma unroll
        for (int j = 0; j < 4; ++j) { o0[j] = cvt_pk_bf16(qn[2 * j], qn[2 * j + 1]); o1[j] = cvt_pk_bf16(qn[8 + 2 * j], qn[8 + 2 * j + 1]); }
        *(u32x4*)(Q + (size_t)m * AW + 16 * lane) = o0; *(u32x4*)(Q + (size_t)m * AW + 16 * lane + 8) = o1;
        u32x2 ok; ok[0] = cvt_pk_bf16(kv[0] * rk * a.in[I_KNORM][dk], kv[1] * rk * a.in[I_KNORM][dk + 1]); ok[1] = cvt_pk_bf16(kv[2] * rk * a.in[I_KNORM][dk + 2], kv[3] * rk * a.in[I_KNORM][dk + 3]);
        *(u32x2*)(K + (size_t)m * KVW + 4 * lane) = ok;
    }
}
__device__ __forceinline__ void p3_pooled(Frame& F) {
    const bf16_t* U = (const bf16_t*)(F.ws + WS_U); bf16_t* P = (bf16_t*)(F.ws + WS_POOLED);
    const int lane = lane_id();
    for (int it = F.gw; it < (NTOK / 32) * 4; it += F.NGW) {
        const int g = it & 3, t0 = (it >> 2) * 32, pos0 = t0 % SEQ, w = 2 << g, c = 256 * g + 4 * lane;
        f32x4 W = {0.f, 0.f, 0.f, 0.f};
        for (int j = 1; j <= 16; ++j) { if (j <= w && pos0 - j >= 0) { const u32x2 v = *(const u32x2*)(U + (size_t)(t0 - j) * PW + c); W += (f32x4){bflo(v[0]), bfhi(v[0]), bflo(v[1]), bfhi(v[1])}; } }
#pragma unroll 8
        for (int i = 0; i < 32; ++i) { const int t = t0 + i, pos = pos0 + i;
            const u32x2 v = *(const u32x2*)(U + (size_t)t * PW + c); const f32x4 cur = {bflo(v[0]), bfhi(v[0]), bflo(v[1]), bfhi(v[1])};
            W += cur;
            if (pos - w >= 0) { const u32x2 o = *(const u32x2*)(U + (size_t)(t - w) * PW + c); W -= (f32x4){bflo(o[0]), bfhi(o[0]), bflo(o[1]), bfhi(o[1])}; }
            const float inv = 1.0f / (float)(pos + 1 < w ? pos + 1 : w);
            const f32x4 r = W * inv - cur;
            u32x2 ow; ow[0] = cvt_pk_bf16(r[0], r[1]); ow[1] = cvt_pk_bf16(r[2], r[3]);
            *(u32x2*)(P + (size_t)t * PW + c) = ow; }
    }
}
__device__ __forceinline__ unsigned mono_key(float s) { const unsigned u = __float_as_uint(s); return (u & 0x80000000u) ? ~u : (u | 0x80000000u); }
__device__ __forceinline__ void idx_block(Frame& F, int b, int i16) {
    const bf16_t* QI = (const bf16_t*)(F.ws + WS_QI); const bf16_t* KW = (const bf16_t*)(F.ws + WS_KW);
    unsigned short* MT = (unsigned short*)(F.ws + WS_MASK);
    LAS unsigned* T = (LAS unsigned*)F.lds;
    const int lane = lane_id(), w = F.wave, tid = w * 64 + lane, r32 = lane & 31, hi = lane >> 5;
    const int tpos0 = 16 * i16, t0 = b * SEQ + tpos0, nh = (tpos0 + 16 + 31) >> 5, kzero = 64 * ((tpos0 >> 6) + 1);
    for (int k = tid; k < kzero; k += NTHR) T[k] = 0u;
    bf16x8 Af[4];
    { const int qsel = (r32 >> 2) & 1, head = (r32 & 3) + 4 * (r32 >> 3); const size_t tq = (size_t)(t0 + 2 * w + qsel);
      const float wv = bf2f(KW[tq * 256 + 64 + head]);
#pragma unroll
      for (int s = 0; s < 4; ++s) { const u32x4 q = *(const u32x4*)(QI + tq * (IH * ID) + head * ID + 16 * s + 8 * hi); u32x4 o;
#pragma unroll
          for (int j = 0; j < 4; ++j) o[j] = cvt_pk_bf16(bflo(q[j]) * wv, bfhi(q[j]) * wv);
          Af[s] = __builtin_bit_cast(bf16x8, o); } }
    float X[16];
    { const size_t tq = (size_t)(t0 + 2 * w + hi); const u32x4 w0 = *(const u32x4*)(KW + tq * 256 + 64), w1 = *(const u32x4*)(KW + tq * 256 + 72);
      const float PINF = __builtin_inff();
#pragma unroll
      for (int j = 0; j < 4; ++j) { X[2 * j] = bflo(w0[j]) >= 0.f ? PINF : -PINF; X[2 * j + 1] = bfhi(w0[j]) >= 0.f ? PINF : -PINF;
                                    X[8 + 2 * j] = bflo(w1[j]) >= 0.f ? PINF : -PINF; X[8 + 2 * j + 1] = bfhi(w1[j]) >= 0.f ? PINF : -PINF; } }
    const int mypos = tpos0 + 2 * w + hi;
    unsigned keys[128];
    const __amdgpu_buffer_rsrc_t krs = __builtin_amdgcn_make_buffer_rsrc((void*)(KW + (size_t)b * SEQ * 256), 0, SEQ * 256 * 2, 0x00020000);
    const int kvoff = r32 * 512 + hi * 16;
    u32x4 Bn[4];
#pragma unroll
    for (int s = 0; s < 4; ++s) Bn[s] = __builtin_amdgcn_raw_buffer_load_b128(krs, kvoff + 32 * s, 0, 0);
#pragma unroll
    for (int n = 0; n < 128; ++n) {
        keys[n] = 0u;
        if (n < nh) {
            u32x4 Bc[4];
#pragma unroll
            for (int s = 0; s < 4; ++s) Bc[s] = Bn[s];
            if (n + 1 < nh) {
#pragma unroll
                for (int s = 0; s < 4; ++s) Bn[s] = __builtin_amdgcn_raw_buffer_load_b128(krs, kvoff + 32 * s, (n + 1) * 16384, 0);
            }
            f32x16 acc = {0.f, 0.f, 0.f, 0.f, 0.f, 0.f, 0.f, 0.f, 0.f, 0.f, 0.f, 0.f, 0.f, 0.f, 0.f, 0.f};
#pragma unroll
            for (int s = 0; s < 4; ++s) acc = __builtin_amdgcn_mfma_f32_32x32x16_bf16(Af[s], __builtin_bit_cast(bf16x8, Bc[s]), acc, 0, 0, 0);
            float sc = 0.f;
#pragma unroll
            for (int j = 0; j < 16; ++j) sc += __builtin_amdgcn_fmed3f(acc[j], 0.f, X[j]);
            keys[n] = (32 * n + r32 <= mypos) ? mono_key(sc) : 0u;
        }
    }
    unsigned T0 = 0u, T1 = 0u; bool done0 = false, done1 = false;
    for (int bit = 31; bit >= 0; --bit) {
        const unsigned c0 = T0 | (1u << bit), c1 = T1 | (1u << bit), cand = hi ? c1 : c0;
        unsigned cnt = 0;
#pragma unroll
        for (int n8 = 0; n8 < 16; ++n8) { if (n8 * 8 < nh) {
#pragma unroll
            for (int j = 0; j < 8; ++j) cnt += (keys[n8 * 8 + j] >= cand) ? 1u : 0u; } }
        cnt += __shfl_xor(cnt, 1); cnt += __shfl_xor(cnt, 2); cnt += __shfl_xor(cnt, 4); cnt += __shfl_xor(cnt, 8); cnt += __shfl_xor(cnt, 16);
        const unsigned n0 = __builtin_amdgcn_readlane(cnt, 0), n1 = __builtin_amdgcn_readlane(cnt, 32);
        if (!done0 && n0 >= (unsigned)TOPK) { T0 = c0; if (n0 == (unsigned)TOPK) done0 = true; }
        if (!done1 && n1 >= (unsigned)TOPK) { T1 = c1; if (n1 == (unsigned)TOPK) done1 = true; }
        if (done0 && done1) break;
    }
    { const unsigned Tsel = hi ? T1 : T0, Tf = Tsel > 1u ? Tsel : 1u;
      __syncthreads();
#pragma unroll
      for (int n = 0; n < 128; ++n) { if (n < nh) {
          unsigned bitv = keys[n] >= Tf ? 1u : 0u; const unsigned other = __shfl_xor(bitv, 32);
          bitv |= other << 1;
          if (hi == 0 && bitv) __hip_atomic_fetch_or(T + 32 * n + r32, bitv << (2 * w), __ATOMIC_RELAXED, __HIP_MEMORY_SCOPE_WORKGROUP); } }
    }
    __syncthreads();
    { const int rg = (b * SEQ + tpos0) >> 5, f = i16 & 1;
      for (int k = tid; k < kzero; k += NTHR) { const int kk = k & 63, p = (kk & ~7) | ((kk & 3) << 1) | ((kk >> 2) & 1);
          MT[((size_t)(rg * 64 + (k >> 6)) * 64 + p) * 2 + f] = (unsigned short)(T[k] & 0xffffu); } }
    __syncthreads();
}
__device__ __forceinline__ void p3_indexer(Frame& F) {
    for (int v2 = 2 * blockIdx.x; v2 < 512; v2 += 2 * F.G) { for (int ps = 0; ps < 2; ++ps) { const int v = v2 >> 1, b = v >> 7, i = v & 127; idx_block(F, b, ps ? 255 - i : i); } }
}
namespace att {
constexpr int KVBLK = 64, SHM_V = KVBLK * HD * 2, SHM_K = KVBLK * HD * 2;
constexpr int LDS_V = 0, LDS_K = 2 * SHM_V, LDS_WS = 2 * SHM_V + 2 * SHM_K, LDS_BYTES = LDS_WS + NWAVES * 64 * 4;
constexpr float THR = 8.f, LOG2E = 1.4426950408889634f;
#define KSWZ(row, colB) ((row) * 256 + ((colB) ^ (((row) & 7) << 4)))
#define SBAR() __builtin_amdgcn_sched_barrier(0)
__device__ __forceinline__ int v_st(int k, int c) { const int kk = (k & ~0xC) | ((k & 4) << 1) | ((k & 8) >> 1); return ((kk >> 3) * 4 + (c >> 5)) * 512 + ((kk & 7) * 32 + (c & 31)) * 2; }
__device__ __forceinline__ int v_rd_base(int lane) { return ((lane & 3) << 3) | (((lane >> 2) & 3) << 6) | (((lane >> 4) & 1) << 5) | (((lane >> 5) & 1) << 8); }
constexpr int v_rd_off(int d0, int ks, int half) { return d0 * 512 + ks * 4096 + half * 2048; }
__device__ __forceinline__ int crow(int r, int hi) { return (r & 3) + 8 * (r >> 2) + 4 * hi; }
__device__ __forceinline__ void partialSM(f32x16& p0, f32x16& p1, float& m_reg, float& mn, float& alpha) {
    float pmax = p0[0];
#pragma unroll
    for (int r = 1; r < 16; ++r) pmax = fmaxf(pmax, p0[r]);
#pragma unroll
    for (int r = 0; r < 16; ++r) pmax = fmaxf(pmax, p1[r]);
    { auto rr = __builtin_amdgcn_permlane32_swap(__float_as_uint(pmax), __float_as_uint(pmax), false, false);
      pmax = fmaxf(__uint_as_float(rr[0]), __uint_as_float(rr[1])); }
    if (__builtin_expect(__all((pmax - m_reg) <= THR), 1)) { mn = m_reg; alpha = 1.f; }
    else { mn = fmaxf(m_reg, pmax); alpha = __builtin_amdgcn_exp2f((m_reg - mn) * LOG2E); m_reg = mn; }
    const float mnL = -mn * LOG2E;
#pragma unroll
    for (int r = 0; r < 16; ++r) p0[r] = fmaf(p0[r], LOG2E, mnL);
#pragma unroll
    for (int r = 0; r < 16; ++r) p1[r] = fmaf(p1[r], LOG2E, mnL);
#pragma unroll
    for (int r = 0; r < 16; ++r) p0[r] = __builtin_amdgcn_exp2f(p0[r]);
}
__device__ __forceinline__ void finishSM(f32x16& p0, f32x16& p1, float alpha, float& l_reg, bf16x8& pa0, bf16x8& pa1, bf16x8& pa2, bf16x8& pa3) {
#pragma unroll
    for (int r = 0; r < 16; ++r) p1[r] = __builtin_amdgcn_exp2f(p1[r]);
    float ps = 0;
#pragma unroll
    for (int r = 0; r < 16; ++r) ps += p0[r];
#pragma unroll
    for (int r = 0; r < 16; ++r) ps += p1[r];
    { auto rr = __builtin_amdgcn_permlane32_swap(__float_as_uint(ps), __float_as_uint(ps), false, false);
      ps = __uint_as_float(rr[0]) + __uint_as_float(rr[1]); }
    l_reg = l_reg * alpha + ps;
#define PK4(P, B_, OUT) do { unsigned a0 = cvt_pk_bf16(P[B_+0], P[B_+1]), a1 = cvt_pk_bf16(P[B_+2], P[B_+3]);                          \
        unsigned b0 = cvt_pk_bf16(P[B_+4], P[B_+5]), b1 = cvt_pk_bf16(P[B_+6], P[B_+7]);                                             \
        auto r0 = __builtin_amdgcn_permlane32_swap(a0, b0, false, false); auto r1 = __builtin_amdgcn_permlane32_swap(a1, b1, false, false); \
        u32x4 w = {r0[0], r1[0], r0[1], r1[1]}; OUT = __builtin_bit_cast(bf16x8, w); } while (0)
    PK4(p0, 0, pa0); PK4(p0, 8, pa1); PK4(p1, 0, pa2); PK4(p1, 8, pa3);
#undef PK4
}
template <int KB>
__device__ __forceinline__ void qkt(f32x16& p0, f32x16& p1, const LAS char* K_lds, int r32, int hi, const bf16x8* qr, bf16x8 kf0, bf16x8 kf1, bf16x8 qf) {
    p0 = __builtin_amdgcn_mfma_f32_32x32x16_bf16(kf0, qf, (f32x16){0.f, 0.f, 0.f, 0.f, 0.f, 0.f, 0.f, 0.f, 0.f, 0.f, 0.f, 0.f, 0.f, 0.f, 0.f, 0.f}, 0, 0, 0);
    p1 = __builtin_amdgcn_mfma_f32_32x32x16_bf16(kf1, qf, (f32x16){0.f, 0.f, 0.f, 0.f, 0.f, 0.f, 0.f, 0.f, 0.f, 0.f, 0.f, 0.f, 0.f, 0.f, 0.f, 0.f}, 0, 0, 0);
    const LAS char* kb[4];
#pragma unroll
    for (int dd = 0; dd < 4; ++dd) kb[dd] = K_lds + KB * SHM_K + KSWZ(r32, (dd * 16 + hi * 8) * 2);
#pragma unroll
    for (int d0 = 0; d0 < 8; ++d0) { const LAS char* ap = kb[d0 & 3] + (d0 >> 2) * 128;
        bf16x8 b0 = *(const LAS bf16x8*)(ap);
        bf16x8 b1 = *(const LAS bf16x8*)(ap + 32 * 256);
        p0 = __builtin_amdgcn_mfma_f32_32x32x16_bf16(b0, qr[d0], p0, 0, 0, 0);
        p1 = __builtin_amdgcn_mfma_f32_32x32x16_bf16(b1, qr[d0], p1, 0, 0, 0); }
}
template <int VB>
__device__ __forceinline__ void pv_tile(f32x16* o, int vb0, bf16x8 pa0, bf16x8 pa1, bf16x8 pa2, bf16x8 pa3) {
#define TRRD(dst, off) asm volatile("ds_read_b64_tr_b16 %0, %1 offset:%2" : "=&v"(dst) : "v"(vb0), "i"(off) : "memory")
#define PV_D0(d0) do { s16x4 l0, l1, l2, l3, h0, h1, h2, h3; constexpr int b_ = VB * SHM_V + v_rd_off(d0, 0, 0); \
        TRRD(l0, b_); TRRD(h0, b_ + 2048); TRRD(l1, b_ + 4096); TRRD(h1, b_ + 6144); TRRD(l2, b_ + 8192); TRRD(h2, b_ + 10240); TRRD(l3, b_ + 12288); TRRD(h3, b_ + 14336); \
        asm volatile("s_waitcnt lgkmcnt(0)" ::: "memory"); SBAR();   \
        o[d0] = __builtin_amdgcn_mfma_f32_32x32x16_bf16(pa0, (bf16x8){l0[0], l0[1], l0[2], l0[3], h0[0], h0[1], h0[2], h0[3]}, o[d0], 0, 0, 0);   \
        o[d0] = __builtin_amdgcn_mfma_f32_32x32x16_bf16(pa1, (bf16x8){l1[0], l1[1], l1[2], l1[3], h1[0], h1[1], h1[2], h1[3]}, o[d0], 0, 0, 0);   \
        o[d0] = __builtin_amdgcn_mfma_f32_32x32x16_bf16(pa2, (bf16x8){l2[0], l2[1], l2[2], l2[3], h2[0], h2[1], h2[2], h2[3]}, o[d0], 0, 0, 0);   \
        o[d0] = __builtin_amdgcn_mfma_f32_32x32x16_bf16(pa3, (bf16x8){l3[0], l3[1], l3[2], l3[3], h3[0], h3[1], h3[2], h3[3]}, o[d0], 0, 0, 0); } while (0)
    PV_D0(0); PV_D0(1); PV_D0(2); PV_D0(3);
#undef PV_D0
#undef TRRD
}
typedef const __attribute__((address_space(4))) unsigned long long* cmask_t;
__device__ __forceinline__ void mask_tile(f32x16& p0, f32x16& p1, const unsigned long long* mpg) {
    const float NEG = -__builtin_inff();
    cmask_t mp = (cmask_t)mpg;
    asm volatile("s_nop 15\n\ts_nop 7" : "+v"(p0), "+v"(p1));
#pragma unroll
    for (int r = 0; r < 16; ++r) { const unsigned long long m0 = mp[r], m1 = mp[16 + r];
        asm volatile("v_cndmask_b32 %0, %1, %0, %2" : "+v"(p0[r]) : "v"(NEG), "s"(m0));
        asm volatile("v_cndmask_b32 %0, %1, %0, %2" : "+v"(p1[r]) : "v"(NEG), "s"(m1)); }
}
template <int BUF>
__device__ __forceinline__ void tile_step(f32x16* o, float& m_reg, float& l_reg, const LAS char* K_lds, int vb0, LAS float* al_l, int r32, int hi, const bf16x8* qr,
                                          int kb_key, bf16x8 qf, const unsigned long long* mp) {
    f32x16 p0, p1; float mn, alpha; bf16x8 pa0, pa1, pa2, pa3;
    const unsigned kbb = __float_as_uint((float)kb_key) >> 16, k0b = __float_as_uint((float)r32) >> 16, k1b = __float_as_uint((float)(r32 + 32)) >> 16;
    u32x4 f0 = {hi ? 0u : (kbb | (k0b << 16)), 0u, 0u, 0u}, f1 = {hi ? 0u : (kbb | (k1b << 16)), 0u, 0u, 0u};
    qkt<BUF>(p0, p1, K_lds, r32, hi, qr, __builtin_bit_cast(bf16x8, f0), __builtin_bit_cast(bf16x8, f1), qf);
    mask_tile(p0, p1, mp);
    partialSM(p0, p1, m_reg, mn, alpha);
    finishSM(p0, p1, alpha, l_reg, pa0, pa1, pa2, pa3);
    if (__any(alpha < 1.f)) { if (hi == 0) al_l[r32] = alpha; asm volatile("s_waitcnt lgkmcnt(0)" ::: "memory");
#pragma unroll
        for (int r = 0; r < 16; ++r) { const float av = al_l[crow(r, hi)];
#pragma unroll
            for (int d_ = 0; d_ < 4; ++d_) o[d_][r] *= av; } }
    pv_tile<BUF>(o, vb0, pa0, pa1, pa2, pa3);
}
__device__ __forceinline__ void attn_unit(Frame& F, int b, int g, int qb) {
    const bf16_t* Q = (const bf16_t*)(F.ws + WS_Q); const bf16_t* K = (const bf16_t*)(F.ws + WS_K); const bf16_t* V = (const bf16_t*)(F.ws + WS_V);
    bf16_t* O = (bf16_t*)(F.ws + WS_ATTN); const unsigned long long* MT = (const unsigned long long*)(F.ws + WS_MASK);
    LAS char* lds = (LAS char*)F.lds;
    const int wid = F.wave, lane = lane_id(), tid = wid * 64 + lane, r32 = lane & 31, hi = lane >> 5;
    const int hq = wid >> 1, th = wid & 1, h = 4 * g + hq, tok0 = b * SEQ + 64 * qb + 32 * th, NT = qb + 1;
    LAS char* V_lds = lds + LDS_V; LAS char* K_lds = lds + LDS_K; LAS float* wsf = (LAS float*)(lds + LDS_WS) + wid * 64; LAS float* li_l = wsf; LAS float* al_l = wsf + 32;
    const int sr = tid >> 4, sc = (tid & 15) * 8, vst0 = v_st(sr, sc), vst1 = v_st(32 + sr, sc), kws = KSWZ(sr, sc * 2);
    const int vb0 = (int)(uintptr_t)V_lds + v_rd_base(lane);
    bf16x8 qr[8];
#pragma unroll
    for (int d0 = 0; d0 < 8; ++d0) qr[d0] = *(const bf16x8*)(Q + (size_t)(tok0 + r32) * AW + h * HD + d0 * 16 + hi * 8);
    const unsigned sb = __float_as_uint(__builtin_ldexpf(1.0f, -(h + 1))) >> 16;
    const u32x4 qfw = {hi ? 0u : (sb | (sb << 16)), 0u, 0u, 0u}; const bf16x8 qf = __builtin_bit_cast(bf16x8, qfw);
    const bf16_t* Kg = K + (size_t)(b * SEQ) * KVW + g * HD + sc; const bf16_t* Vg = V + (size_t)(b * SEQ) * KVW + g * HD + sc;
    const unsigned long long* mrow = MT + (size_t)__builtin_amdgcn_readfirstlane(tok0 >> 5) * 64 * 32;
    float m_reg = -1e30f, l_reg = 0.f; f32x16 o[4] = {};
    bf16x8 st_k0, st_k1, st_v0, st_v1;
#define SLOAD(k0) do { st_k0 = *(const bf16x8*)(Kg + (size_t)((k0) + sr) * KVW); st_k1 = *(const bf16x8*)(Kg + (size_t)((k0) + 32 + sr) * KVW); \
                       st_v0 = *(const bf16x8*)(Vg + (size_t)((k0) + sr) * KVW); st_v1 = *(const bf16x8*)(Vg + (size_t)((k0) + 32 + sr) * KVW); } while (0)
#define SWRITE(bf) do { *(LAS bf16x8*)(K_lds + (bf) * SHM_K + kws) = st_k0; *(LAS bf16x8*)(K_lds + (bf) * SHM_K + kws + 32 * 256) = st_k1; \
                        *(LAS bf16x8*)(V_lds + (bf) * SHM_V + vst0) = st_v0; *(LAS bf16x8*)(V_lds + (bf) * SHM_V + vst1) = st_v1; } while (0)
    SLOAD(0); SWRITE(0);
    __syncthreads();
    for (int t = 0; t < NT; t += 2) {
        if (t + 1 < NT) SLOAD((t + 1) * KVBLK);
        tile_step<0>(o, m_reg, l_reg, K_lds, vb0, al_l, r32, hi, qr, t * KVBLK, qf, mrow + (size_t)t * 32);
        if (t + 1 < NT) SWRITE(1);
        __syncthreads();
        if (t + 1 < NT) {
            if (t + 2 < NT) SLOAD((t + 2) * KVBLK);
            tile_step<1>(o, m_reg, l_reg, K_lds, vb0, al_l, r32, hi, qr, (t + 1) * KVBLK, qf, mrow + (size_t)(t + 1) * 32);
            if (t + 2 < NT) SWRITE(0);
            __syncthreads();
        }
    }
#undef SLOAD
#undef SWRITE
    if (hi == 0) li_l[r32] = l_reg; asm volatile("s_waitcnt lgkmcnt(0)" ::: "memory");
    bf16_t* Ow = O + (size_t)tok0 * AW + h * HD;
#pragma unroll
    for (int r = 0; r < 16; ++r) { const int orow = crow(r, hi); const float rl = __builtin_amdgcn_rcpf(li_l[orow]);
#pragma unroll
        for (int d0 = 0; d0 < 4; ++d0) { const float v = o[d0][r] * rl; const float vn = __shfl_xor(v, 1);
            if ((r32 & 1) == 0) *(unsigned*)(Ow + (size_t)orow * AW + d0 * 32 + r32) = cvt_pk_bf16(v, vn); } }
    __syncthreads();
}
#undef KSWZ
#undef SBAR
}
struct SchedPool {
    const char* A; const char* B; int c;
    __device__ __forceinline__ bool next(int i, pg8::Unit& u) const { if (i > 0 || c >= 128) return false; const int rt = c >> 2, g = c & 3; u.pm = rt; u.pn = g; u.aux = 0; u.tok = nullptr;
        u.A = A + ((size_t)rt * 256 * PW + g * 256) * 2; u.B = B + (size_t)g * 65536 * 2; return true; }
};
struct EpiPool {
    bf16_t* out; const float* pscale;
    __device__ __forceinline__ bool operator()(f32x4 (&acc)[2][2][4][2], const pg8::Unit& u, int wr, int wc, int fr, int fq) const {
        const int row0 = u.pm * 256 + wr * 64 + fr, col0 = u.pn * 256 + wc * 32 + 8 * fq;
#pragma unroll
        for (int bj = 0; bj < 2; ++bj) { const f32x4 s0 = *(const f32x4*)(pscale + col0 + bj * 128), s1 = *(const f32x4*)(pscale + col0 + bj * 128 + 4);
#pragma unroll
            for (int ai = 0; ai < 2; ++ai)
#pragma unroll
                for (int m = 0; m < 4; ++m) st_bf16x8(out + (size_t)(row0 + ai * 128 + m * 16) * PW + col0 + bj * 128, acc[ai][bj][m][0] * s0, acc[ai][bj][m][1] * s1); }
        return false;
    }
};
__device__ __forceinline__ void p4_pool_attn(Frame& F, const Args& a) {
    for (int c = blockIdx.x; c < 256; c += F.G) {
        const int bg = c >> 6, qb = c & 63;
        if (qb < 32) { SchedPool S{(const char*)(F.ws + WS_POOLED), (const char*)(F.ws + WS_PLIN), bg * 32 + qb}; EpiPool E{(bf16_t*)(F.ws + WS_POOL), a.in[I_PSCALE]};
            pg8::gemm_phase<EpiPool, SchedPool, false>(F.lds, F.wave, 256, PW, S, E); __syncthreads(); }
        att::attn_unit(F, bg >> 1, bg & 1, qb);
    }
}
struct SchedMerge {
    pg8::TileOrder T; const char* A0; const char* B0; const char* A1; const char* B1;
    __device__ __forceinline__ bool next(int i, pg8::Unit& u) const { int pm, pn; if (!T.tile(i >> 1, pm, pn)) return false; u.pm = pm; u.pn = pn; u.aux = i & 1; u.tok = nullptr;
        u.A = ((i & 1) ? A1 : A0) + (size_t)pm * 256 * 1024 * 2; u.B = ((i & 1) ? B1 : B0) + (size_t)pn * 256 * 1024 * 2; return true; }
};
struct EpiMerge {
    const bf16_t* G; bf16_t* out;
    __device__ __forceinline__ bool operator()(f32x4 (&acc)[2][2][4][2], const pg8::Unit& u, int wr, int wc, int fr, int fq) const {
        const int row0 = u.pm * 256 + wr * 64 + fr, col0 = u.pn * 256 + wc * 32 + 8 * fq;
#pragma unroll
        for (int ai = 0; ai < 2; ++ai)
#pragma unroll
            for (int m = 0; m < 4; ++m) { const size_t r = (size_t)(row0 + ai * 128 + m * 16);
#pragma unroll
                for (int bj = 0; bj < 2; ++bj) { const int c = col0 + bj * 128;
                    const u32x4 gp = *(const u32x4*)(G + r * (2 * DM) + DM + c);
                    const f32x4 p0 = {bflo(gp[0]), bfhi(gp[0]), bflo(gp[1]), bfhi(gp[1])}, p1 = {bflo(gp[2]), bfhi(gp[2]), bflo(gp[3]), bfhi(gp[3])};
                    if (u.aux == 0) { const u32x4 ga = *(const u32x4*)(G + r * (2 * DM) + c);
                        const f32x4 a0 = {bflo(ga[0]), bfhi(ga[0]), bflo(ga[1]), bfhi(ga[1])}, a1 = {bflo(ga[2]), bfhi(ga[2]), bflo(ga[3]), bfhi(ga[3])};
#pragma unroll
                        for (int j = 0; j < 4; ++j) { acc[ai][bj][m][0][j] *= a0[j] * __builtin_amdgcn_rcpf(fmaxf(p0[j], 1e-30f)); acc[ai][bj][m][1][j] *= a1[j] * __builtin_amdgcn_rcpf(fmaxf(p1[j], 1e-30f)); } }
                    else st_bf16x8(out + r * DM + c, acc[ai][bj][m][0] * p0, acc[ai][bj][m][1] * p1); } }
        return u.aux == 0;
    }
};
__device__ __forceinline__ void p5_merge(Frame& F) {
    SchedMerge S; S.T.init(NTOK, DM, F.G, (int)blockIdx.x); S.A0 = (const char*)(F.ws + WS_ATTN); S.B0 = (const char*)(F.ws + WS_WAU); S.A1 = (const char*)(F.ws + WS_POOL); S.B1 = (const char*)(F.ws + WS_WPU);
    EpiMerge E{(const bf16_t*)(F.ws + WS_G), (bf16_t*)(F.ws + WS_MERGED)};
    pg8::gemm_phase<EpiMerge, SchedMerge, false>(F.lds, F.wave, 1024, 1024, S, E);
}
struct EpiOut {
    const float* x; const float* mod; float* out;
    __device__ __forceinline__ bool operator()(f32x4 (&acc)[2][2][4][2], const pg8::Unit& u, int wr, int wc, int fr, int fq) const {
        const int row0 = u.pm * 256 + wr * 64 + fr, col0 = u.pn * 256 + wc * 32 + 8 * fq; const int b = (u.pm * 256) / SEQ;
        const float* gm = mod + b * 6 * DM + 2 * DM;
#pragma unroll
        for (int bj = 0; bj < 2; ++bj) { const int c = col0 + bj * 128; const f32x4 g0 = *(const f32x4*)(gm + c), g1 = *(const f32x4*)(gm + c + 4);
#pragma unroll
            for (int ai = 0; ai < 2; ++ai)
#pragma unroll
                for (int m = 0; m < 4; ++m) { const size_t o = (size_t)(row0 + ai * 128 + m * 16) * DM + c;
                    const f32x4 x0 = *(const f32x4*)(x + o), x1 = *(const f32x4*)(x + o + 4);
                    *(f32x4*)(out + o) = x0 + g0 * acc[ai][bj][m][0]; *(f32x4*)(out + o + 4) = x1 + g1 * acc[ai][bj][m][1]; } }
        return false;
    }
};
__device__ __forceinline__ void p6_out(Frame& F, const Args& a) {
    SchedDense S; S.T.init(NTOK, DM, F.G, (int)blockIdx.x); S.A = (const char*)(F.ws + WS_MERGED); S.B = (const char*)(F.ws + WS_WOUT);
    S.a_tile = (size_t)256 * DM * 2; S.b_tile = (size_t)256 * DM * 2;
    EpiOut E{a.in[I_X], (const float*)(F.ctl + CW_MOD), F.out};
    pg8::gemm_phase<EpiOut, SchedDense, false>(F.lds, F.wave, DM, DM, S, E);
}
constexpr int P7_ROWB = 4096 + 16;
constexpr int P7_LDS_P = 16 * P7_ROWB;
constexpr int P7_LDS_H = P7_LDS_P + 2 * 16 * 64 * 4;
__device__ __forceinline__ void p7_router(Frame& F, const Args& a) {
    const float* mod = (const float*)(F.ctl + CW_MOD);
    bf16_t* hb = (bf16_t*)(F.ws + WS_HB); const bf16_t* Wr = (const bf16_t*)(F.ws + WS_WR);
    unsigned char* rt = F.ws + WS_ROUTE;
    int* eid = (int*)(rt + RT_EID); float* gate = (float*)(rt + RT_GATE); int* posn = (int*)(rt + RT_POS); int* list = (int*)(rt + RT_LIST); int* ident = (int*)(rt + RT_IDENT);
    unsigned* ecnt = F.ctl + CW_ECNT;
    LAS unsigned char* lds = F.lds; LAS float* P = (LAS float*)(lds + P7_LDS_P); LAS unsigned* hist = (LAS unsigned*)(lds + P7_LDS_H); LAS unsigned* baseL = hist + 64;
    const int lane = lane_id(), w = F.wave, tid = w * 64 + lane;
    if (tid < 64) hist[tid] = 0u;
    __syncthreads();
    for (int p = blockIdx.x; p < NTOK / 16; p += F.G) {
        const int row0 = 16 * p;
#pragma unroll
        for (int rr = 0; rr < 2; ++rr) { const int lr = 2 * w + rr, m = row0 + lr, b = m / SEQ;
            const float* xrow = F.out + (size_t)m * DM; const float* sh = mod + b * 6 * DM + 3 * DM; const float* sl = mod + b * 6 * DM + 4 * DM;
            f32x4 v[8]; float ss = 0.f;
#pragma unroll
            for (int j = 0; j < 8; ++j) { v[j] = *(const f32x4*)(xrow + 4 * lane + 256 * j); ss += (v[j].x * v[j].x + v[j].y * v[j].y) + (v[j].z * v[j].z + v[j].w * v[j].w); }
            const float rstd = rsqrtf(wave_sum(ss) * (1.0f / DM) + NORM_EPS);
#pragma unroll
            for (int j = 0; j < 8; ++j) { const int c = 4 * lane + 256 * j;
                const f32x4 gg = *(const f32x4*)(a.in[I_GFFN] + c), shv = *(const f32x4*)(sh + c), slv = *(const f32x4*)(sl + c);
                const f32x4 o = v[j] * rstd * gg * (slv + 1.0f) + shv;
                u32x2 wv; wv.x = cvt_pk_bf16(o.x, o.y); wv.y = cvt_pk_bf16(o.z, o.w);
                *(u32x2*)(hb + (size_t)m * DM + c) = wv; *(LAS u32x2*)(lds + lr * P7_ROWB + c * 2) = wv; }
            if (lane == 0) ident[m] = m;
        }
        __syncthreads();
        { const int nb = w & 3, kh = w >> 2, fr = lane & 15, kq = lane >> 4;
          f32x4 acc = {0.f, 0.f, 0.f, 0.f};
          const bf16_t* wp = Wr + (size_t)(16 * nb + fr) * DM + 1024 * kh + 8 * kq;
          const LAS unsigned char* ap = lds + fr * P7_ROWB + (1024 * kh + 8 * kq) * 2;
#pragma unroll 8
          for (int s = 0; s < 32; ++s) { const bf16x8 bv = *(const bf16x8*)(wp + 32 * s); const bf16x8 av = *(const LAS bf16x8*)(ap + 64 * s);
              acc = __builtin_amdgcn_mfma_f32_16x16x32_bf16(av, bv, acc, 0, 0, 0); }
#pragma unroll
          for (int j = 0; j < 4; ++j) P[(kh * 16 + 4 * kq + j) * 64 + 16 * nb + fr] = acc[j];
        }
        __syncthreads();
        int myrank[2]; unsigned mylocal[2]; bool chosen[2]; float mygate[2];
#pragma unroll
        for (int rr = 0; rr < 2; ++rr) { const int lr = 2 * w + rr;
            const float logit = P[lr * 64 + lane] + P[(16 + lr) * 64 + lane];
            const float score = 1.0f / (1.0f + __expf(-logit)); const float sel = score + a.in[I_RBIAS][lane];
            float m1 = sel; m1 = fmaxf(m1, __shfl_xor(m1, 1)); m1 = fmaxf(m1, __shfl_xor(m1, 2)); m1 = fmaxf(m1, __shfl_xor(m1, 4));
            const unsigned long long bm = __ballot(sel == m1); const unsigned grp = (unsigned)((bm >> (lane & ~7)) & 0xffull); const int first = __builtin_ctz(grp | 0x100u);
            float m2 = ((lane & 7) == first) ? -__builtin_inff() : sel; m2 = fmaxf(m2, __shfl_xor(m2, 1)); m2 = fmaxf(m2, __shfl_xor(m2, 2)); m2 = fmaxf(m2, __shfl_xor(m2, 4));
            const float gs = m1 + m2; const int g = lane >> 3; int grank = 0;
#pragma unroll
            for (int g2 = 0; g2 < 8; ++g2) { const float o = __uint_as_float(__builtin_amdgcn_readlane(__float_as_uint(gs), 8 * g2)); grank += (o > gs || (o == gs && g2 < g)) ? 1 : 0; }
            const float selm = grank < TOPG ? sel : -__builtin_inff(); int rank = 0;
#pragma unroll
            for (int e2 = 0; e2 < 64; ++e2) { const float o = __uint_as_float(__builtin_amdgcn_readlane(__float_as_uint(selm), e2)); rank += (o > selm || (o == selm && e2 < lane)) ? 1 : 0; }
            const bool ch = rank < ETOP && grank < TOPG; const float gsum = wave_sum(ch ? score : 0.f);
            chosen[rr] = ch; myrank[rr] = rank; mygate[rr] = score / gsum * ROUTED_SCALE;
            mylocal[rr] = ch ? __hip_atomic_fetch_add(hist + lane, 1u, __ATOMIC_RELAXED, __HIP_MEMORY_SCOPE_WORKGROUP) : 0u;
        }
        __syncthreads();
        if (w == 0) { const unsigned c = hist[lane]; baseL[lane] = c ? __hip_atomic_fetch_add(ecnt + lane, c, __ATOMIC_RELAXED, __HIP_MEMORY_SCOPE_AGENT) : 0u; hist[lane] = 0u; }
        __syncthreads();
#pragma unroll
        for (int rr = 0; rr < 2; ++rr) if (chosen[rr]) { const int m = row0 + 2 * w + rr; const unsigned pos = baseL[lane] + mylocal[rr];
            eid[m * 8 + myrank[rr]] = lane; gate[m * 8 + myrank[rr]] = mygate[rr]; posn[m * 8 + myrank[rr]] = (int)pos; list[(size_t)lane * NTOK + pos] = m; }
        __syncthreads();
    }
}
constexpr int MOE_LDS = 131072;
__device__ __forceinline__ int moe_prefix(Frame& F) {
    LAS int* rtoff = (LAS int*)(F.lds + MOE_LDS);
    if (F.wave == 0 && lane_id() == 0) { int s = 0; for (int e = 0; e < NE; ++e) { rtoff[e] = s; unsigned n = F.ctl[CW_ECNT + e]; if (n > (unsigned)NTOK) n = NTOK; s += (int)((n + 255u) >> 8); } rtoff[NE] = s; }
    __syncthreads();
    return __builtin_amdgcn_readfirstlane(rtoff[NE]);
}
__device__ __forceinline__ int moe_find(const LAS int* rtoff, int rtg) {
    int lo = 0, hi = NE;
#pragma unroll
    for (int it = 0; it < 6; ++it) { const int mid = (lo + hi) >> 1; if (rtoff[mid] <= rtg) lo = mid; else hi = mid; }
    return __builtin_amdgcn_readfirstlane(lo);
}
struct SchedMoe1 {
    const LAS int* rtoff; int RT, G, c; const char* hb; const char* w13; const char* ws13; const int* list; const int* ident;
    __device__ __forceinline__ bool next(int i, pg8::Unit& u) const {
        const int idx = i * G + c; if (idx >= (RT + NTOK / 256) * 4) return false;
        const int rtg = idx >> 2, ct = idx & 3; u.pn = ct; u.aux = 0; u.A = hb;
        if (rtg < RT) { const int e = moe_find(rtoff, rtg), rt = rtg - __builtin_amdgcn_readfirstlane(rtoff[e]); u.pm = rtg; u.tok = list + (size_t)e * NTOK + rt * 256;
            u.B = w13 + ((size_t)e * 1024 + ct * 256) * DM * 2; }
        else { const int rt = rtg - RT; u.pm = HROWS_R / 256 + rt; u.tok = ident + rt * 256; u.B = ws13 + (size_t)(ct * 256) * DM * 2; }
        return true; }
};
struct EpiMoe1 {
    bf16_t* H;
    __device__ __forceinline__ bool operator()(f32x4 (&acc)[2][2][4][2], const pg8::Unit& u, int wr, int wc, int fr, int fq) const {
        const int row0 = u.pm * 256 + wr * 64 + fr, col0 = u.pn * 128 + wc * 32 + 8 * fq;
#pragma unroll
        for (int ai = 0; ai < 2; ++ai)
#pragma unroll
            for (int m = 0; m < 4; ++m) { f32x4 h0, h1;
#pragma unroll
                for (int j = 0; j < 4; ++j) { const float g0 = acc[ai][0][m][0][j], g1 = acc[ai][0][m][1][j];
                    h0[j] = g0 * __builtin_amdgcn_rcpf(1.0f + __expf(-g0)) * acc[ai][1][m][0][j]; h1[j] = g1 * __builtin_amdgcn_rcpf(1.0f + __expf(-g1)) * acc[ai][1][m][1][j]; }
                st_bf16x8(H + (size_t)(row0 + ai * 128 + m * 16) * EH + col0, h0, h1); }
        return false;
    }
};
__device__ __forceinline__ void p8_gemm1(Frame& F) {
    const int RT = moe_prefix(F);
    SchedMoe1 S{(const LAS int*)(F.lds + MOE_LDS), RT, F.G, (int)blockIdx.x, (const char*)(F.ws + WS_HB), (const char*)(F.ws + WS_W13), (const char*)(F.ws + WS_WS13),
                (const int*)(F.ws + WS_ROUTE + RT_LIST), (const int*)(F.ws + WS_ROUTE + RT_IDENT)};
    EpiMoe1 E{(bf16_t*)(F.ws + WS_H)};
    pg8::gemm_phase<EpiMoe1, SchedMoe1, true>(F.lds, F.wave, DM, DM, S, E);
}
struct SchedMoe2 {
    const LAS int* rtoff; int RT, G, c; const char* H; const char* w2;
    __device__ __forceinline__ bool next(int i, pg8::Unit& u) const {
        const int idx = i * G + c; if (idx >= RT * 8) return false;
        const int rtg = idx >> 3, ct = idx & 7, e = moe_find(rtoff, rtg); u.pm = rtg; u.pn = ct; u.aux = 0; u.tok = nullptr;
        u.A = H + (size_t)rtg * 256 * EH * 2; u.B = w2 + ((size_t)e * DM + ct * 256) * EH * 2; return true; }
};
struct EpiY {
    bf16_t* Y;
    __device__ __forceinline__ bool operator()(f32x4 (&acc)[2][2][4][2], const pg8::Unit& u, int wr, int wc, int fr, int fq) const {
        const int row0 = u.pm * 256 + wr * 64 + fr, col0 = u.pn * 256 + wc * 32 + 8 * fq;
#pragma unroll
        for (int ai = 0; ai < 2; ++ai)
#pragma unroll
            for (int m = 0; m < 4; ++m)
#pragma unroll
                for (int bj = 0; bj < 2; ++bj) st_bf16x8(Y + (size_t)(row0 + ai * 128 + m * 16) * DM + col0 + bj * 128, acc[ai][bj][m][0], acc[ai][bj][m][1]);
        return false;
    }
};
__device__ __forceinline__ void p9_gemm2(Frame& F) {
    const int RT = moe_prefix(F);
    SchedMoe2 S{(const LAS int*)(F.lds + MOE_LDS), RT, F.G, (int)blockIdx.x, (const char*)(F.ws + WS_H), (const char*)(F.ws + WS_W2)};
    EpiY E{(bf16_t*)(F.ws + WS_Y)};
    pg8::gemm_phase<EpiY, SchedMoe2, false>(F.lds, F.wave, EH, EH, S, E);
}
struct EpiFinal {
    const LAS int* rtoff; const bf16_t* Y; const int* eid; const float* gate; const int* posn; const float* mod; float* out;
    __device__ __forceinline__ bool operator()(f32x4 (&acc)[2][2][4][2], const pg8::Unit& u, int wr, int wc, int fr, int fq) const {
        const int row0 = u.pm * 256 + wr * 64 + fr, col0 = u.pn * 256 + wc * 32 + 8 * fq; const int b = (u.pm * 256) / SEQ;
        const float* gf = mod + b * 6 * DM + 5 * DM;
#pragma unroll
        for (int ai = 0; ai < 2; ++ai)
#pragma unroll
            for (int m = 0; m < 4; ++m) { const int t = row0 + ai * 128 + m * 16;
                const u32x4 e0 = *(const u32x4*)(eid + t * 8), e1 = *(const u32x4*)(eid + t * 8 + 4), p0 = *(const u32x4*)(posn + t * 8), p1 = *(const u32x4*)(posn + t * 8 + 4);
                const f32x4 g0 = *(const f32x4*)(gate + t * 8), g1 = *(const f32x4*)(gate + t * 8 + 4);
                f32x4 s[2][2] = {{acc[ai][0][m][0], acc[ai][0][m][1]}, {acc[ai][1][m][0], acc[ai][1][m][1]}};
#pragma unroll
                for (int k = 0; k < 8; ++k) { const unsigned e = k < 4 ? e0[k & 3] : e1[k & 3], p = k < 4 ? p0[k & 3] : p1[k & 3]; const float gk = k < 4 ? g0[k & 3] : g1[k & 3];
                    const size_t yr = (size_t)(256 * rtoff[e & 63] + (int)p);
#pragma unroll
                    for (int bj = 0; bj < 2; ++bj) { const u32x4 y = *(const u32x4*)(Y + yr * DM + col0 + bj * 128);
                        s[bj][0] += (f32x4){bflo(y[0]), bfhi(y[0]), bflo(y[1]), bfhi(y[1])} * gk; s[bj][1] += (f32x4){bflo(y[2]), bfhi(y[2]), bflo(y[3]), bfhi(y[3])} * gk; } }
#pragma unroll
                for (int bj = 0; bj < 2; ++bj) { const int c = col0 + bj * 128; const size_t o = (size_t)t * DM + c;
                    const f32x4 x0 = *(const f32x4*)(out + o), x1 = *(const f32x4*)(out + o + 4), f0 = *(const f32x4*)(gf + c), f1 = *(const f32x4*)(gf + c + 4);
                    *(f32x4*)(out + o) = x0 + f0 * s[bj][0]; *(f32x4*)(out + o + 4) = x1 + f1 * s[bj][1]; } }
        return false;
    }
};
__device__ __forceinline__ void p10_final(Frame& F) {
    (void)moe_prefix(F);
    SchedDense S; S.T.init(NTOK, DM, F.G, (int)blockIdx.x); S.A = (const char*)(F.ws + WS_H) + (size_t)HROWS_R * EH * 2; S.B = (const char*)(F.ws + WS_WS2);
    S.a_tile = (size_t)256 * EH * 2; S.b_tile = (size_t)256 * EH * 2;
    unsigned char* rt = F.ws + WS_ROUTE;
    EpiFinal E{(const LAS int*)(F.lds + MOE_LDS), (const bf16_t*)(F.ws + WS_Y), (const int*)(rt + RT_EID), (const float*)(rt + RT_GATE), (const int*)(rt + RT_POS), (const float*)(F.ctl + CW_MOD), F.out};
    pg8::gemm_phase<EpiFinal, SchedDense, false>(F.lds, F.wave, EH, EH, S, E);
}
constexpr int LDS_BYTES = 147456;
constexpr int N_PHASES = 11;
__global__ void __launch_bounds__(NTHR, 2) fwd(Args args) {
    extern __shared__ __attribute__((aligned(16))) unsigned char lds_raw[];
    Frame F; F.lds = (LAS unsigned char*)lds_raw; F.wave = __builtin_amdgcn_readfirstlane((int)threadIdx.x >> 6);
    F.G = gridDim.x; F.gw = blockIdx.x * NWAVES + F.wave; F.NGW = F.G * NWAVES; F.ws = args.ws; F.ctl = (unsigned*)(args.ws + WS_CTL); F.out = args.out;
    volatile LAS unsigned* xbw = (volatile LAS unsigned*)(F.lds + LDS_BYTES - 16);
    if (threadIdx.x < 4) xbw[threadIdx.x] = 0u;
    __syncthreads();
    const bool one = (args.ph_hi - args.ph_lo) > 1;
    XcdBarrier bar; bar.bar = F.ctl + CW_BAR; bar.x = 0; bar.st = xbw;
    if (one) bar = xcd_barrier_post(F.ctl + CW_BAR, xbw, F.wave);
    const int lo = args.ph_lo, hi = args.ph_hi;
#define IN(k) (lo <= (k) && (k) < hi)
#define SEAM(k) do { if (IN(k) && IN((k) + 1)) xcd_barrier(bar, F.wave); } while (0)
    if (IN(0)) { p0_prologue(F, args); } SEAM(0);
    if (IN(1)) { p1_h(F, args); } SEAM(1);
    if (IN(2)) { p2_inproj(F); } SEAM(2);
    if (IN(3)) { p3_qknorm(F, args); p3_pooled(F); __syncthreads(); p3_indexer(F); } SEAM(3);
    if (IN(4)) { p4_pool_attn(F, args); } SEAM(4);
    if (IN(5)) { p5_merge(F); } SEAM(5);
    if (IN(6)) { p6_out(F, args); } SEAM(6);
    if (IN(7)) { p7_router(F, args); } SEAM(7);
    if (IN(8)) { p8_gemm1(F); } SEAM(8);
    if (IN(9)) { p9_gemm2(F); } SEAM(9);
    if (IN(10)) { p10_final(F); }
#undef IN
#undef SEAM
}
#ifndef N_LAUNCHES
#define N_LAUNCHES 11
#endif
extern "C" void kernel_launch(void* const* d_in, const int* in_sizes, int n_in, void* d_out, int out_size, void* d_ws, size_t ws_size, hipStream_t stream) {
    static int grid = 0;
    if (grid == 0) {
        if (n_in != 22 || out_size != NTOK * DM || ws_size < WS_END) { fprintf(stderr, "kernel_launch: unexpected shapes (n_in %d out %d ws %zu need %zu)\n", n_in, out_size, ws_size, (size_t)WS_END); grid = -1; return; }
        int dev = 0, cus = 0, per_cu = 0;
        if (hipGetDevice(&dev) != hipSuccess || hipDeviceGetAttribute(&cus, hipDeviceAttributeMultiprocessorCount, dev) != hipSuccess) { grid = -1; return; }
        if (hipFuncSetAttribute((const void*)fwd, hipFuncAttributeMaxDynamicSharedMemorySize, LDS_BYTES) != hipSuccess) { fprintf(stderr, "kernel_launch: hipFuncSetAttribute failed\n"); grid = -1; return; }
        if (hipOccupancyMaxActiveBlocksPerMultiprocessor(&per_cu, (const void*)fwd, NTHR, LDS_BYTES) != hipSuccess || per_cu < 1) fprintf(stderr, "kernel_launch: occupancy query says %d\n", per_cu);
        (void)hipGetLastError();
        grid = cus;
    }
    if (grid < 0) return;
    (void)hipMemsetAsync((char*)d_ws + WS_CTL, 0, CTL_BYTES, stream);
    Args a{};
    for (int i = 0; i < 22; ++i) a.in[i] = (const float*)d_in[i];
    a.out = (float*)d_out; a.ws = (unsigned char*)d_ws;
    if (N_LAUNCHES == 1) { a.ph_lo = 0; a.ph_hi = N_PHASES; hipLaunchKernelGGL(fwd, dim3(grid), dim3(NTHR), LDS_BYTES, stream, a); }
    else for (int p = 0; p < N_PHASES; ++p) { a.ph_lo = p; a.ph_hi = p + 1; hipLaunchKernelGGL(fwd, dim3(grid), dim3(NTHR), LDS_BYTES, stream, a); }
}
```

```cpp
#include <hip/hip_runtime.h>
#include <cstdio>
#include <cstdint>

#define LAS __attribute__((address_space(3)))
#define GAS __attribute__((address_space(1)))
typedef unsigned short bf16_t;
typedef short bf16x8 __attribute__((ext_vector_type(8)));
typedef short s16x4 __attribute__((ext_vector_type(4)));
typedef float f32x4 __attribute__((ext_vector_type(4)));
typedef float f32x2 __attribute__((ext_vector_type(2)));
typedef float f32x16 __attribute__((ext_vector_type(16)));
typedef unsigned u32x4 __attribute__((ext_vector_type(4)));
typedef unsigned u32x2 __attribute__((ext_vector_type(2)));

constexpr int DM = 2048, NB = 2, SEQ = 4096, NTOK = NB * SEQ;
constexpr int NH = 8, HD = 128, NKV = 2, AW = 1024, KVW = 256, IH = 16, ID = 64, TOPK = 256;
constexpr int PW = 1024, INW = 7760, INP = 7936;
constexpr int NE = 64, EH = 512, NGRP = 8, EPG = 8, TOPG = 4, ETOP = 8;
constexpr float NORM_EPS = 1e-6f, ROUTED_SCALE = 2.5f;
constexpr int NTHR = 512, NWAVES = 8;

constexpr size_t MiB = 1u << 20;
constexpr size_t WS_CTL = 0, CTL_BYTES = 1 * MiB;
constexpr size_t WS_W13 = 1 * MiB;
constexpr size_t WS_W2 = WS_W13 + 256 * MiB;
constexpr size_t WS_WS13 = WS_W2 + 128 * MiB;
constexpr size_t WS_WS2 = WS_WS13 + 4 * MiB;
constexpr size_t WS_H = WS_WS2 + 2 * MiB;
constexpr int HROWS_R = 65536 + 64 * 256, HROWS = HROWS_R + NTOK;
constexpr size_t WS_ROUTE = WS_H + (size_t)HROWS * EH * 2;
constexpr size_t RT_EID = 0, RT_GATE = RT_EID + (size_t)NTOK * 8 * 4, RT_POS = RT_GATE + (size_t)NTOK * 8 * 4, RT_LIST = RT_POS + (size_t)NTOK * 8 * 4,
                 RT_IDENT = RT_LIST + (size_t)NE * NTOK * 4, RT_END = RT_IDENT + (size_t)NTOK * 4;
constexpr size_t WS_R = (WS_ROUTE + RT_END + MiB - 1) / MiB * MiB;
constexpr size_t WS_Y = WS_R;
constexpr size_t WS_WIN = WS_R;
constexpr size_t WS_WAU = WS_WIN + 31 * MiB, WS_WPU = WS_WAU + 4 * MiB, WS_WOUT = WS_WPU + 4 * MiB, WS_PLIN = WS_WOUT + 8 * MiB, WS_WR = WS_PLIN + MiB / 2;
constexpr size_t WS_HB = WS_WR + MiB / 2;
constexpr size_t WS_Q = WS_HB + 32 * MiB, WS_K = WS_Q + 16 * MiB, WS_V = WS_K + 4 * MiB, WS_QI = WS_V + 4 * MiB, WS_KW = WS_QI + 16 * MiB, WS_U = WS_KW + 4 * MiB,
                 WS_G = WS_U + 16 * MiB;
constexpr size_t WS_POOLED = WS_G + 64 * MiB, WS_POOL = WS_POOLED + 16 * MiB, WS_ATTN = WS_POOL + 16 * MiB, WS_MERGED = WS_ATTN + 16 * MiB, WS_MASK = WS_MERGED + 32 * MiB,
                 WS_REND = WS_MASK + 4 * MiB;
constexpr size_t WS_END = WS_Y + (size_t)HROWS_R * DM * 2;
static_assert(WS_REND <= WS_END, "overlay region");
constexpr int CW_BAR = 4096;
constexpr int CW_ECNT = 8192;
constexpr int CW_MOD = 16384;
static_assert((CW_MOD + 2 * 6 * DM) * 4 <= (int)CTL_BYTES, "ctl");

__device__ __forceinline__ int lane_id() { int l; asm volatile("v_mbcnt_lo_u32_b32 %0, -1, 0\n\tv_mbcnt_hi_u32_b32 %0, -1, %0" : "=v"(l)); return l; }
__device__ __forceinline__ unsigned cvt_pk_bf16(float lo, float hi) { unsigned r; asm volatile("v_cvt_pk_bf16_f32 %0, %1, %2" : "=v"(r) : "v"(lo), "v"(hi)); return r; }
__device__ __forceinline__ float bf2f(unsigned short b) { return __uint_as_float(((unsigned)b) << 16); }
__device__ __forceinline__ float bflo(unsigned w) { return __uint_as_float(w << 16); }
__device__ __forceinline__ float bfhi(unsigned w) { return __uint_as_float(w & 0xffff0000u); }
__device__ __forceinline__ float wave_sum(float v) {
#pragma unroll
    for (int o = 1; o < 64; o <<= 1) v += __shfl_xor(v, o);
    return v;
}
__device__ __forceinline__ float sigmoidf_(float x) { return 1.0f / (1.0f + __expf(-x)); }

#define XB_TMO      128
#define XB_XCNT(j)  (256  + 64 * (j))
#define XB_XSUB(j)  (1280 + 64 * (j))
#define XB_XGEN(j)  (2304 + 64 * (j))
#define XB_TOP      3328
#define XB_TOPGEN   3392
#define XCD_BAR_WORDS 3456
#define XB_SPIN_CAP (1u << 18)
__device__ __forceinline__ unsigned xb_ld(unsigned* p)              { return __hip_atomic_load(p, __ATOMIC_RELAXED, __HIP_MEMORY_SCOPE_AGENT); }
__device__ __forceinline__ unsigned xb_add(unsigned* p, unsigned v) { return __hip_atomic_fetch_add(p, v, __ATOMIC_RELAXED, __HIP_MEMORY_SCOPE_AGENT); }
__device__ __forceinline__ unsigned xb_xcc_id() { return (unsigned)__builtin_amdgcn_s_getreg((3 << 11) | 20) & 0xFu; }
#define XB_SPIN(cond, bar) do { unsigned _sp = 0; while (cond) { __builtin_amdgcn_s_sleep(1); \
    if ((++_sp & 255u) == 0u) { if (xb_ld(&(bar)[XB_TMO])) break; if (_sp > XB_SPIN_CAP) { atomicAdd(&(bar)[XB_TMO], 1u); break; } } } } while (0)
struct XcdBarrier { unsigned* bar; unsigned x; volatile LAS unsigned* st; };
__device__ __forceinline__ XcdBarrier xcd_barrier_post(unsigned* bar, volatile LAS unsigned* st, int wave) {
    XcdBarrier b; b.bar = bar; b.x = xb_xcc_id(); b.st = st;
    if (wave == 0 && lane_id() == 0) (void)xb_add(&bar[XB_XCNT(b.x)], 1u);
    return b;
}
__device__ __forceinline__ void xcd_barrier_complete(unsigned* bar, unsigned x, unsigned& nloc, unsigned& nx) {
    const unsigned G = gridDim.x * gridDim.y * gridDim.z;
    unsigned sum, cnt, mine, sp = 0u;
    for (;;) {
        sum = 0u; cnt = 0u; mine = 0u;
#pragma unroll
        for (unsigned j = 0; j < 16; ++j) { const unsigned c = xb_ld(&bar[XB_XCNT(j)]); sum += c; cnt += (c > 0u) ? 1u : 0u; mine = (j == x) ? c : mine; }
        if (sum == G) break;
        __builtin_amdgcn_s_sleep(1);
        if ((++sp & 255u) == 0u) { if (xb_ld(&bar[XB_TMO])) break; if (sp > XB_SPIN_CAP) { atomicAdd(&bar[XB_TMO], 1u); break; } }
    }
    nloc = mine > 0u ? mine : 1u; nx = cnt > 0u ? cnt : 1u;
}
__device__ __forceinline__ void xcd_barrier(const XcdBarrier& b, int wave) {
    asm volatile("s_waitcnt vmcnt(0)" ::: "memory");
    __syncthreads();
    if (wave == 0 && lane_id() == 0) {
        unsigned* bar = b.bar;
        __builtin_amdgcn_s_waitcnt(0);
        unsigned nloc = b.st[0], nx = b.st[1];
        if (nloc == 0u) { xcd_barrier_complete(bar, b.x, nloc, nx); b.st[0] = nloc; b.st[1] = nx; }
        const unsigned old = xb_add(&bar[XB_XSUB(b.x)], 1u);
        const unsigned gen = old / nloc;
        if (old + 1u == (gen + 1u) * nloc) {
            __builtin_amdgcn_fence(__ATOMIC_RELEASE, "agent");
            asm volatile("s_waitcnt vmcnt(0)" ::: "memory");
            const unsigned og = xb_add(&bar[XB_TOP], 1u);
            const unsigned tg = og / nx;
            if (og + 1u == (tg + 1u) * nx) xb_add(&bar[XB_TOPGEN], 1u);
            else XB_SPIN(xb_ld(&bar[XB_TOPGEN]) == tg, bar);
            __builtin_amdgcn_fence(__ATOMIC_ACQUIRE, "agent");
            xb_add(&bar[XB_XGEN(b.x)], 1u);
            asm volatile("s_waitcnt vmcnt(0)" ::: "memory");
        } else {
            XB_SPIN(xb_ld(&bar[XB_XGEN(b.x)]) == gen, bar);
            __builtin_amdgcn_fence(__ATOMIC_ACQUIRE, "agent");
            asm volatile("s_waitcnt vmcnt(0)" ::: "memory");
        }
    }
    __syncthreads();
}
namespace pg8 {
constexpr int BM = 256, BK = 64, HALF = 128, HTB = HALF * BK * 2, STAGE_BYTES = 8 * HTB, NXCD = 8, WGM = 8;
__host__ __device__ __forceinline__ int lds_byte(int r, int c) { const int st = (r >> 4) * 2 + (c >> 5), rr = r & 15, cc = c & 31, ob = rr * 64 + cc * 2; return st * 1024 + (ob ^ (((ob >> 9) & 1) << 5)); }
__host__ __device__ __forceinline__ void stage_rc(int b, int& R, int& C) { const int st = b / 1024, sb = b % 1024, swz = sb ^ (((sb >> 9) & 1) << 5); R = (st >> 1) * 16 + swz / 64; C = (st & 1) * 32 + (swz % 64) / 2; }
__host__ __device__ __forceinline__ int perm32(int rho) { const int n = rho >> 4, i = rho & 15; return 8 * (i >> 2) + 4 * n + (i & 3); }

struct Unit { const char* A; const char* B; const int* tok; int pm, pn, aux; };

struct TileOrder {
    int nM, nN, nwg, G, c;
    __device__ void init(int M, int N, int G_, int c_) { nM = M / BM; nN = N / BM; nwg = nM * nN; G = G_; c = c_; }
    __device__ bool tile(int i, int& pm, int& pn) const {
        const long L = (long)i * G + c; if (L >= nwg) return false;
        int wgid = (int)L; { const int q = nwg / NXCD, r = nwg % NXCD, xcd = wgid % NXCD, off = wgid / NXCD; wgid = (xcd < r ? xcd * (q + 1) : r * (q + 1) + (xcd - r) * q) + off; }
        const int nig = WGM * nN, gid = wgid / nig, fm = gid * WGM, gsz = (nM - fm) < WGM ? (nM - fm) : WGM;
        pm = fm + ((wgid % nig) % gsz); pn = (wgid % nig) / gsz; return true;
    }
};

template <class Epi, class Sched, bool GATHER>
__device__ __forceinline__ void gemm_phase(LAS unsigned char* lds, const int wid, const int K, const int lda, const Sched& S, const Epi& E) {
    const int lane = lane_id(), tid = wid * 64 + lane, wr = wid >> 2, wc = wid & 3, fr = lane & 15, fq = lane >> 4;
    const int nt = K / BK;
    unsigned voffA[2], voffB[2]; int RA[2], CA[2];
#pragma unroll
    for (int i = 0; i < 2; ++i) { int R, C; stage_rc(tid * 16 + i * 8192, R, C); const int Rb = (R & ~31) + perm32(R & 31);
        voffA[i] = (unsigned)(R * lda + C) * 2u; voffB[i] = (unsigned)(Rb * K + C) * 2u; RA[i] = R; CA[i] = C; }
    const size_t kstep = (size_t)(BK * 2);
    const size_t hstepA = (size_t)HALF * lda * 2, hstepB = (size_t)HALF * K * 2;
    const unsigned ldsw = (unsigned)wid * 1024u;
    const int aoff = lds_byte(wr * 64 + fr, fq * 8), boff = lds_byte(wc * 32 + fr, fq * 8);
#define PG8_SA(b, h) (((b) * 2 + (h)) * HTB)
#define PG8_SB(b, h) ((4 + (b) * 2 + (h)) * HTB)
#define PG8_DMA(bufoff, gptr, i_) __builtin_amdgcn_global_load_lds((const GAS unsigned*)(gptr), (LAS unsigned*)(lds + (bufoff) + ldsw + (i_) * 8192), 16, 0, 0)
#define PG8_STAGEB(bufoff, gbase) do { _Pragma("unroll") for (int _i = 0; _i < 2; ++_i) PG8_DMA(bufoff, (const char*)(gbase) + voffB[_i], _i); } while (0)
#define PG8_STAGEA(bufoff, kt, h, GO) do { _Pragma("unroll") for (int _i = 0; _i < 2; ++_i) { \
        if constexpr (GATHER) PG8_DMA(bufoff, (const char*)(kt) + GO[h][_i], _i); else PG8_DMA(bufoff, (const char*)(kt) + (h) * hstepA + voffA[_i], _i); } } while (0)
#define PG8_LDA(dst, b, h) do { _Pragma("unroll") for (int m = 0; m < 4; ++m) _Pragma("unroll") for (int k = 0; k < 2; ++k) dst[m][k] = *(const LAS bf16x8*)(lds + PG8_SA(b, h) + aoff + m * 2048 + k * 1024); } while (0)
#define PG8_LDB(dst, b, h) do { _Pragma("unroll") for (int n = 0; n < 2; ++n) _Pragma("unroll") for (int k = 0; k < 2; ++k) dst[n][k] = *(const LAS bf16x8*)(lds + PG8_SB(b, h) + boff + n * 2048 + k * 1024); } while (0)
#define PG8_MMA(ai, bj, At, Bt) do { __builtin_amdgcn_s_setprio(1); _Pragma("unroll") for (int m = 0; m < 4; ++m) _Pragma("unroll") for (int n = 0; n < 2; ++n) _Pragma("unroll") for (int k = 0; k < 2; ++k) \
        acc[ai][bj][m][n] = __builtin_amdgcn_mfma_f32_16x16x32_bf16(Bt[n][k], At[m][k], acc[ai][bj][m][n], 0, 0, 0); __builtin_amdgcn_s_setprio(0); } while (0)
#define PG8_WAIT_V(n) asm volatile("s_waitcnt vmcnt(" #n ")" ::: "memory")
#define PG8_WAIT_L(n) asm volatile("s_waitcnt lgkmcnt(" #n ")" ::: "memory")
#define PG8_BAR __builtin_amdgcn_s_barrier()
#define PG8_SCHED __builtin_amdgcn_sched_barrier(0)
#define PG8_GLOAD(GO, u) do { if constexpr (GATHER) { _Pragma("unroll") for (int _h = 0; _h < 2; ++_h) _Pragma("unroll") for (int _i = 0; _i < 2; ++_i) \
        { unsigned _t = (unsigned)(u).tok[_h * HALF + RA[_i]]; _t = _t < (unsigned)NTOK ? _t : (unsigned)(NTOK - 1); GO[_h][_i] = (_t * (unsigned)lda + (unsigned)CA[_i]) * 2u; } } } while (0)
    Unit cur, nxt; int ui = 0;
    if (!S.next(0, cur)) return;
    f32x4 acc[2][2][4][2];
#pragma unroll
    for (int a = 0; a < 2; ++a)
#pragma unroll
        for (int b = 0; b < 2; ++b)
#pragma unroll
            for (int m = 0; m < 4; ++m)
#pragma unroll
                for (int n = 0; n < 2; ++n) acc[a][b][m][n] = (f32x4){0.f, 0.f, 0.f, 0.f};
    bf16x8 At[4][2], B0[2][2], B1[2][2];
    unsigned gC[2][2] = {{0u, 0u}, {0u, 0u}}, gN[2][2] = {{0u, 0u}, {0u, 0u}};
    PG8_GLOAD(gC, cur);
    const char* cA = cur.A; const char* cB = cur.B;
    PG8_STAGEB(PG8_SB(0, 0), cB); PG8_STAGEB(PG8_SB(0, 1), cB + hstepB); PG8_STAGEA(PG8_SA(0, 0), cA, 0, gC); PG8_STAGEA(PG8_SA(0, 1), cA, 1, gC);
    if (wr == 1) PG8_BAR;
    PG8_WAIT_V(2); PG8_BAR;
    PG8_STAGEB(PG8_SB(1, 0), cB + kstep); PG8_STAGEA(PG8_SA(1, 0), cA + kstep, 0, gC); PG8_STAGEB(PG8_SB(1, 1), cB + hstepB + kstep);
    PG8_WAIT_V(6); PG8_BAR;
    for (;;) {
        const bool has_next = S.next(ui + 1, nxt);
        if (has_next) PG8_GLOAD(gN, nxt);
        const char* nA = has_next ? nxt.A : cA; const char* nB = has_next ? nxt.B : cB;
        for (int t = 0; t < nt; t += 2) {
            const bool last = (t == nt - 2);
            const char* a1 = cA + (size_t)(t + 1) * kstep;
            const char* a2 = last ? nA : cA + (size_t)(t + 2) * kstep; const char* b2 = last ? nB : cB + (size_t)(t + 2) * kstep;
            const char* a3 = a2 + kstep; const char* b3 = b2 + kstep;
            unsigned g2[2][2];
#pragma unroll
            for (int _h = 0; _h < 2; ++_h)
#pragma unroll
                for (int _i = 0; _i < 2; ++_i) g2[_h][_i] = gC[_h][_i];
            if (GATHER && last && has_next) {
#pragma unroll
                for (int _h = 0; _h < 2; ++_h)
#pragma unroll
                    for (int _i = 0; _i < 2; ++_i) g2[_h][_i] = gN[_h][_i];
            }
            PG8_LDB(B0, 0, 0); PG8_LDB(B1, 0, 1); PG8_SCHED; PG8_LDA(At, 0, 0); PG8_STAGEA(PG8_SA(1, 1), a1, 1, gC);
            PG8_WAIT_V(8); PG8_WAIT_L(0); PG8_BAR; PG8_MMA(0, 0, At, B0); PG8_MMA(0, 1, At, B1); PG8_BAR; PG8_SCHED;
            PG8_LDA(At, 0, 1); PG8_STAGEB(PG8_SB(0, 0), b2); PG8_STAGEB(PG8_SB(0, 1), b2 + hstepB); PG8_STAGEA(PG8_SA(0, 0), a2, 0, g2);
            PG8_WAIT_V(8); PG8_WAIT_L(0); PG8_BAR; PG8_MMA(1, 0, At, B0); PG8_MMA(1, 1, At, B1); PG8_BAR; PG8_SCHED;
            PG8_LDB(B0, 1, 0); PG8_LDB(B1, 1, 1); PG8_SCHED; PG8_LDA(At, 1, 0); PG8_STAGEA(PG8_SA(0, 1), a2, 1, g2);
            PG8_WAIT_V(8); PG8_WAIT_L(0); PG8_BAR; PG8_MMA(0, 0, At, B0); PG8_MMA(0, 1, At, B1); PG8_BAR; PG8_SCHED;
            PG8_LDA(At, 1, 1); PG8_STAGEB(PG8_SB(1, 0), b3); PG8_STAGEB(PG8_SB(1, 1), b3 + hstepB); PG8_STAGEA(PG8_SA(1, 0), a3, 0, g2);
            PG8_WAIT_V(8); PG8_WAIT_L(0); PG8_BAR; PG8_MMA(1, 0, At, B0); PG8_MMA(1, 1, At, B1); PG8_BAR; PG8_SCHED;
        }
        if (wr == 0) PG8_BAR;
        asm volatile("s_nop 15\n\ts_nop 7" ::: "memory");
        const bool keep = E(acc, cur, wr, wc, fr, fq);
        if (!has_next) break;
        if (!keep) {
#pragma unroll
        for (int a = 0; a < 2; ++a)
#pragma unroll
            for (int b = 0; b < 2; ++b)
#pragma unroll
                for (int m = 0; m < 4; ++m)
#pragma unroll
                    for (int n = 0; n < 2; ++n) acc[a][b][m][n] = (f32x4){0.f, 0.f, 0.f, 0.f};
        }
        cur = nxt; cA = nA; cB = nB; ++ui;
#pragma unroll
        for (int _h = 0; _h < 2; ++_h)
#pragma unroll
            for (int _i = 0; _i < 2; ++_i) gC[_h][_i] = gN[_h][_i];
        if (wr == 1) PG8_BAR;
    }
    PG8_WAIT_V(0);
    PG8_BAR;
#undef PG8_SA
#undef PG8_SB
#undef PG8_DMA
#undef PG8_STAGEA
#undef PG8_STAGEB
#undef PG8_LDA
#undef PG8_LDB
#undef PG8_MMA
#undef PG8_WAIT_V
#undef PG8_WAIT_L
#undef PG8_BAR
#undef PG8_SCHED
#undef PG8_GLOAD
}
}
struct Args { const float* in[22]; float* out; unsigned char* ws; int ph_lo, ph_hi; };
enum { I_X = 0, I_C, I_WADA, I_BADA, I_GMIX, I_WIN, I_QNORM, I_KNORM, I_WAU, I_PLIN, I_PSCALE, I_WPU, I_WOUT, I_GFFN, I_WROUTER, I_RBIAS, I_W1, I_W3, I_W2, I_WS1, I_WS3, I_WS2 };
struct Frame {
    LAS unsigned char* lds;
    int wave, G, gw, NGW;
    unsigned char* ws; unsigned* ctl; float* out;
};
#define LDS_WAIT() asm volatile("s_waitcnt lgkmcnt(0)" ::: "memory")
#define VM_WAIT() asm volatile("s_waitcnt vmcnt(0)" ::: "memory")

__device__ __forceinline__ void tr_tile(const float* __restrict__ src, int ld_src, int nvalid, bf16_t* __restrict__ dst, int ld_dst, int lane) {
    const int q = lane >> 4, c4 = (lane & 15) * 4;
    const bool ok = c4 < nvalid;
#pragma unroll
    for (int g = 0; g < 2; ++g) {
        f32x4 v[8];
#pragma unroll
        for (int j = 0; j < 8; ++j) { const int k = 32 * g + 8 * q + j; v[j] = ok ? *(const f32x4*)(src + (size_t)k * ld_src + c4) : (f32x4){0.f, 0.f, 0.f, 0.f}; }
#pragma unroll
        for (int nn = 0; nn < 4; ++nn) {
            u32x4 w; w.x = cvt_pk_bf16(v[0][nn], v[1][nn]); w.y = cvt_pk_bf16(v[2][nn], v[3][nn]); w.z = cvt_pk_bf16(v[4][nn], v[5][nn]); w.w = cvt_pk_bf16(v[6][nn], v[7][nn]);
            *(u32x4*)(dst + (size_t)(c4 + nn) * ld_dst + 32 * g + 8 * q) = w;
        }
    }
}
constexpr int ADA_WGS = 6 * DM / 128;
__device__ __forceinline__ void p0_prologue(Frame& F, const Args& a) {
    LAS float* sc = (LAS float*)F.lds;
    const int lane = lane_id(), tid = F.wave * 64 + lane;
    for (int i = tid; i < NB * DM; i += NTHR) { const float c = a.in[I_C][i]; sc[i] = c / (1.0f + __expf(-c)); }
    __syncthreads();
    float* mod = (float*)(F.ctl + CW_MOD);
    unsigned char* ws = F.ws;
    for (int strip = blockIdx.x; strip < ADA_WGS; strip += F.G) {
        const int w = F.wave, col = strip * 128 + 2 * lane;
        const float* wp = a.in[I_WADA] + (size_t)(256 * w) * (6 * DM) + col;
        f32x2 a0 = {0.f, 0.f}, a1 = {0.f, 0.f};
#pragma unroll 16
        for (int k = 0; k < 256; ++k) { const f32x2 wv = *(const f32x2*)(wp + (size_t)k * (6 * DM)); const float s0 = sc[256 * w + k], s1 = sc[DM + 256 * w + k]; a0 += wv * s0; a1 += wv * s1; }
        LAS float* part = (LAS float*)(F.lds + 16384);
        *(LAS f32x2*)(part + (w * 2 + 0) * 128 + 2 * lane) = a0; *(LAS f32x2*)(part + (w * 2 + 1) * 128 + 2 * lane) = a1;
        __syncthreads();
        if (tid < 256) { const int b = tid >> 7, c = tid & 127; float sum = a.in[I_BADA][strip * 128 + c];
#pragma unroll
            for (int ww = 0; ww < 8; ++ww) sum += part[(ww * 2 + b) * 128 + c];
            mod[b * 6 * DM + strip * 128 + c] = sum; }
        __syncthreads();
    }
    bf16_t* Win_t = (bf16_t*)(ws + WS_WIN);
    constexpr int J_IN_A = 32 * 40, J_IN_B = 32 * 4, J_IN_C = 32 * 80, J_AU = 16 * 32, J_PU = 16 * 32, J_OUT = 32 * 32, J_PL = 4 * 16, J_S13 = 2 * 32 * 8, J_S2 = 8 * 32, J_WR = 32,
                  J_W13 = NE * 2 * 32 * 8, J_W2 = NE * 8 * 32;
    constexpr int NITEMS = J_IN_A + J_IN_B + J_IN_C + J_AU + J_PU + J_OUT + J_PL + J_S13 + J_S2 + J_WR + J_W13 + J_W2;
    for (int it = F.gw; it < NITEMS; it += F.NGW) {
        int r = it;
        if (r < J_IN_A) { const int kb = r / 40, nb = r % 40; tr_tile(a.in[I_WIN] + (size_t)(64 * kb) * INW + 64 * nb, INW, 64, Win_t + (size_t)(64 * nb) * DM + 64 * kb, DM, lane); continue; } r -= J_IN_A;
        if (r < J_IN_B) { const int kb = r / 4, nb = r % 4; const int nv = nb == 0 ? 64 : (nb == 1 ? 16 : 0);
            tr_tile(a.in[I_WIN] + (size_t)(64 * kb) * INW + 2560 + (nb < 2 ? 64 * nb : 0), INW, nv, Win_t + (size_t)(2560 + 64 * nb) * DM + 64 * kb, DM, lane); continue; } r -= J_IN_B;
        if (r < J_IN_C) { const int kb = r / 80, nb = r % 80; tr_tile(a.in[I_WIN] + (size_t)(64 * kb) * INW + 2640 + 64 * nb, INW, 64, Win_t + (size_t)(2816 + 64 * nb) * DM + 64 * kb, DM, lane); continue; } r -= J_IN_C;
        if (r < J_AU) { const int kb = r / 32, nb = r % 32; tr_tile(a.in[I_WAU] + (size_t)(64 * kb) * DM + 64 * nb, DM, 64, (bf16_t*)(ws + WS_WAU) + (size_t)(64 * nb) * AW + 64 * kb, AW, lane); continue; } r -= J_AU;
        if (r < J_PU) { const int kb = r / 32, nb = r % 32; tr_tile(a.in[I_WPU] + (size_t)(64 * kb) * DM + 64 * nb, DM, 64, (bf16_t*)(ws + WS_WPU) + (size_t)(64 * nb) * PW + 64 * kb, PW, lane); continue; } r -= J_PU;
        if (r < J_OUT) { const int kb = r / 32, nb = r % 32; tr_tile(a.in[I_WOUT] + (size_t)(64 * kb) * DM + 64 * nb, DM, 64, (bf16_t*)(ws + WS_WOUT) + (size_t)(64 * nb) * DM + 64 * kb, DM, lane); continue; } r -= J_OUT;
        if (r < J_PL) { const int g = r / 16, kb = (r % 16) / 4, nb = r % 4; tr_tile(a.in[I_PLIN] + (size_t)g * 65536 + (size_t)(64 * kb) * 256 + 64 * nb, 256, 64, (bf16_t*)(ws + WS_PLIN) + (size_t)g * 65536 + (size_t)(64 * nb) * 256 + 64 * kb, 256, lane); continue; } r -= J_PL;
        if (r < J_S13) { const int which = r / 256, kb = (r % 256) / 8, nb = r % 8; const float* src = (which ? a.in[I_WS3] : a.in[I_WS1]) + (size_t)(64 * kb) * EH + 64 * nb;
            tr_tile(src, EH, 64, (bf16_t*)(ws + WS_WS13) + (size_t)(256 * (nb >> 1) + 64 * (nb & 1) + 128 * which) * DM + 64 * kb, DM, lane); continue; } r -= J_S13;
        if (r < J_S2) { const int kb = r / 32, nb = r % 32; tr_tile(a.in[I_WS2] + (size_t)(64 * kb) * DM + 64 * nb, DM, 64, (bf16_t*)(ws + WS_WS2) + (size_t)(64 * nb) * EH + 64 * kb, EH, lane); continue; } r -= J_S2;
        if (r < J_WR) { const int kb = r; tr_tile(a.in[I_WROUTER] + (size_t)(64 * kb) * NE, NE, 64, (bf16_t*)(ws + WS_WR) + 64 * kb, DM, lane); continue; } r -= J_WR;
        if (r < J_W13) { const int e = r / 512, rr = r % 512, which = rr / 256, kb = (rr % 256) / 8, nb = rr % 8;
            const float* src = (which ? a.in[I_W3] : a.in[I_W1]) + ((size_t)e * DM + 64 * kb) * EH + 64 * nb;
            tr_tile(src, EH, 64, (bf16_t*)(ws + WS_W13) + ((size_t)e * 1024 + 256 * (nb >> 1) + 64 * (nb & 1) + 128 * which) * DM + 64 * kb, DM, lane); continue; } r -= J_W13;
        { const int e = r / 256, kb = (r % 256) / 32, nb = r % 32;
            tr_tile(a.in[I_W2] + ((size_t)e * EH + 64 * kb) * DM + 64 * nb, DM, 64, (bf16_t*)(ws + WS_W2) + ((size_t)e * DM + 64 * nb) * EH + 64 * kb, EH, lane); }
    }
}

__device__ __forceinline__ void modnorm_row(const float* __restrict__ xrow, const float* __restrict__ g, const float* __restrict__ shift, const float* __restrict__ scale, bf16_t* __restrict__ orow, int lane) {
    f32x4 v[8]; float ss = 0.f;
#pragma unroll
    for (int j = 0; j < 8; ++j) { v[j] = *(const f32x4*)(xrow + 4 * lane + 256 * j); ss += (v[j].x * v[j].x + v[j].y * v[j].y) + (v[j].z * v[j].z + v[j].w * v[j].w); }
    const float rstd = rsqrtf(wave_sum(ss) * (1.0f / DM) + NORM_EPS);
#pragma unroll
    for (int j = 0; j < 8; ++j) { const int c = 4 * lane + 256 * j;
        const f32x4 gg = *(const f32x4*)(g + c), sh = *(const f32x4*)(shift + c), sl = *(const f32x4*)(scale + c);
        const f32x4 o = v[j] * rstd * gg * (sl + 1.0f) + sh;
        u32x2 w; w.x = cvt_pk_bf16(o.x, o.y); w.y = cvt_pk_bf16(o.z, o.w);
        *(u32x2*)(orow + c) = w; }
}
__device__ __forceinline__ void p1_h(Frame& F, const Args& a) {
    const float* mod = (const float*)(F.ctl + CW_MOD);
    bf16_t* hb = (bf16_t*)(F.ws + WS_HB); const int lane = lane_id();
    for (int m = F.gw; m < NTOK; m += F.NGW) { const int b = m / SEQ;
        modnorm_row(a.in[I_X] + (size_t)m * DM, a.in[I_GMIX], mod + b * 6 * DM + 0 * DM, mod + b * 6 * DM + 1 * DM, hb + (size_t)m * DM, lane); }
}
struct SchedDense {
    pg8::TileOrder T; const char* A; const char* B; size_t a_tile, b_tile;
    __device__ __forceinline__ bool next(int i, pg8::Unit& u) const { int pm, pn; if (!T.tile(i, pm, pn)) return false; u.pm = pm; u.pn = pn; u.aux = 0; u.tok = nullptr;
        u.A = A + (size_t)pm * a_tile; u.B = B + (size_t)pn * b_tile; return true; }
};
__device__ __forceinline__ void st_bf16x8(bf16_t* p, f32x4 v0, f32x4 v1) { u32x4 w; w.x = cvt_pk_bf16(v0[0], v0[1]); w.y = cvt_pk_bf16(v0[2], v0[3]); w.z = cvt_pk_bf16(v1[0], v1[1]); w.w = cvt_pk_bf16(v1[2], v1[3]); *(u32x4*)p = w; }
struct EpiInproj {
    unsigned char* ws;
    __device__ __forceinline__ bool operator()(f32x4 (&acc)[2][2][4][2], const pg8::Unit& u, int wr, int wc, int fr, int fq) const {
        const int pn = u.pn; bf16_t* base; int ld, ct; bool sig = false;
        if (pn < 4) { base = (bf16_t*)(ws + WS_Q); ld = AW; ct = pn; }
        else if (pn == 4) { base = (bf16_t*)(ws + WS_K); ld = KVW; ct = 0; }
        else if (pn == 5) { base = (bf16_t*)(ws + WS_V); ld = KVW; ct = 0; }
        else if (pn < 10) { base = (bf16_t*)(ws + WS_QI); ld = IH * ID; ct = pn - 6; }
        else if (pn == 10) { base = (bf16_t*)(ws + WS_KW); ld = 256; ct = 0; }
        else if (pn < 15) { base = (bf16_t*)(ws + WS_U); ld = PW; ct = pn - 11; }
        else { base = (bf16_t*)(ws + WS_G); ld = 2 * DM; ct = pn - 15; sig = true; }
        const int row0 = u.pm * 256 + wr * 64 + fr, col0 = ct * 256 + wc * 32 + 8 * fq;
#pragma unroll
        for (int ai = 0; ai < 2; ++ai)
#pragma unroll
            for (int m = 0; m < 4; ++m) { bf16_t* rowp = base + (size_t)(row0 + ai * 128 + m * 16) * ld + col0;
#pragma unroll
                for (int bj = 0; bj < 2; ++bj) { f32x4 v0 = acc[ai][bj][m][0], v1 = acc[ai][bj][m][1];
                    if (sig) {
#pragma unroll
                        for (int j = 0; j < 4; ++j) { v0[j] = fminf(__builtin_amdgcn_rcpf(1.0f + __expf(-v0[j])), 1.0f); v1[j] = fminf(__builtin_amdgcn_rcpf(1.0f + __expf(-v1[j])), 1.0f); } }
                    st_bf16x8(rowp + bj * 128, v0, v1); } }
        return false;
    }
};
__device__ __forceinline__ void p2_inproj(Frame& F) {
    SchedDense S; S.T.init(NTOK, INP, F.G, (int)blockIdx.x); S.A = (const char*)(F.ws + WS_HB); S.B = (const char*)(F.ws + WS_WIN);
    S.a_tile = (size_t)256 * DM * 2; S.b_tile = (size_t)256 * DM * 2;
    EpiInproj E{F.ws};
    pg8::gemm_phase<EpiInproj, SchedDense, false>(F.lds, F.wave, DM, DM, S, E);
}
__device__ __forceinline__ void p3_qknorm(Frame& F, const Args& a) {
    bf16_t* Q = (bf16_t*)(F.ws + WS_Q); bf16_t* K = (bf16_t*)(F.ws + WS_K);
    const int lane = lane_id(); const float SCALE = 0.08838834764831845f;
    for (int m = F.gw; m < NTOK; m += F.NGW) {
        u32x4 q0 = *(const u32x4*)(Q + (size_t)m * AW + 16 * lane), q1 = *(const u32x4*)(Q + (size_t)m * AW + 16 * lane + 8);
        u32x2 k0 = *(const u32x2*)(K + (size_t)m * KVW + 4 * lane);
        float qv[16], kv[4]; float ss = 0.f, sk = 0.f;
#pragma unroll
        for (int j = 0; j < 4; ++j) { qv[2 * j] = bflo(q0[j]); qv[2 * j + 1] = bfhi(q0[j]); qv[8 + 2 * j] = bflo(q1[j]); qv[8 + 2 * j + 1] = bfhi(q1[j]); }
#pragma unroll
        for (int j = 0; j < 16; ++j) ss += qv[j] * qv[j];
        kv[0] = bflo(k0[0]); kv[1] = bfhi(k0[0]); kv[2] = bflo(k0[1]); kv[3] = bfhi(k0[1]);
#pragma unroll
        for (int j = 0; j < 4; ++j) sk += kv[j] * kv[j];
        ss += __shfl_xor(ss, 1); ss += __shfl_xor(ss, 2); ss += __shfl_xor(ss, 4);
        sk += __shfl_xor(sk, 1); sk += __shfl_xor(sk, 2); sk += __shfl_xor(sk, 4); sk += __shfl_xor(sk, 8); sk += __shfl_xor(sk, 16);
        const float rq = rsqrtf(ss * (1.0f / HD) + NORM_EPS) * SCALE, rk = rsqrtf(sk * (1.0f / HD) + NORM_EPS);
        const int dq = (16 * lane) & 127, dk = (4 * lane) & 127;
        float qn[16];
#pragma unroll
        for (int j = 0; j < 16; ++j) qn[j] = qv[j] * rq * a.in[I_QNORM][dq + j];
        u32x4 o0, o1;
#pragma unroll
        for (int j = 0; j < 4; ++j) { o0[j] = cvt_pk_bf16(qn[2 * j], qn[2 * j + 1]); o1[j] = cvt_pk_bf16(qn[8 + 2 * j], qn[8 + 2 * j + 1]); }
        *(u32x4*)(Q + (size_t)m * AW + 16 * lane) = o0; *(u32x4*)(Q + (size_t)m * AW + 16 * lane + 8) = o1;
        u32x2 ok; ok[0] = cvt_pk_bf16(kv[0] * rk * a.in[I_KNORM][dk], kv[1] * rk * a.in[I_KNORM][dk + 1]); ok[1] = cvt_pk_bf16(kv[2] * rk * a.in[I_KNORM][dk + 2], kv[3] * rk * a.in[I_KNORM][dk + 3]);
        *(u32x2*)(K + (size_t)m * KVW + 4 * lane) = ok;
    }
}
__device__ __forceinline__ void p3_pooled(Frame& F) {
    const bf16_t* U = (const bf16_t*)(F.ws + WS_U); bf16_t* P = (bf16_t*)(F.ws + WS_POOLED);
    const int lane = lane_id();
    for (int it = F.gw; it < (NTOK / 32) * 4; it += F.NGW) {
        const int g = it & 3, t0 = (it >> 2) * 32, pos0 = t0 % SEQ, w = 2 << g, c = 256 * g + 4 * lane;
        f32x4 W = {0.f, 0.f, 0.f, 0.f};
        for (int j = 1; j <= 16; ++j) { if (j <= w && pos0 - j >= 0) { const u32x2 v = *(const u32x2*)(U + (size_t)(t0 - j) * PW + c); W += (f32x4){bflo(v[0]), bfhi(v[0]), bflo(v[1]), bfhi(v[1])}; } }
#pragma unroll 8
        for (int i = 0; i < 32; ++i) { const int t = t0 + i, pos = pos0 + i;
            const u32x2 v = *(const u32x2*)(U + (size_t)t * PW + c); const f32x4 cur = {bflo(v[0]), bfhi(v[0]), bflo(v[1]), bfhi(v[1])};
            W += cur;
            if (pos - w >= 0) { const u32x2 o = *(const u32x2*)(U + (size_t)(t - w) * PW + c); W -= (f32x4){bflo(o[0]), bfhi(o[0]), bflo(o[1]), bfhi(o[1])}; }
            const float inv = 1.0f / (float)(pos + 1 < w ? pos + 1 : w);
            const f32x4 r = W * inv - cur;
            u32x2 ow; ow[0] = cvt_pk_bf16(r[0], r[1]); ow[1] = cvt_pk_bf16(r[2], r[3]);
            *(u32x2*)(P + (size_t)t * PW + c) = ow; }
    }
}
__device__ __forceinline__ unsigned mono_key(float s) { const unsigned u = __float_as_uint(s); return (u & 0x80000000u) ? ~u : (u | 0x80000000u); }
__device__ __forceinline__ void idx_block(Frame& F, int b, int i16) {
    const bf16_t* QI = (const bf16_t*)(F.ws + WS_QI); const bf16_t* KW = (const bf16_t*)(F.ws + WS_KW);
    unsigned short* MT = (unsigned short*)(F.ws + WS_MASK);
    LAS unsigned* T = (LAS unsigned*)F.lds;
    const int lane = lane_id(), w = F.wave, tid = w * 64 + lane, r32 = lane & 31, hi = lane >> 5;
    const int tpos0 = 16 * i16, t0 = b * SEQ + tpos0, nh = (tpos0 + 16 + 31) >> 5, kzero = 64 * ((tpos0 >> 6) + 1);
    for (int k = tid; k < kzero; k += NTHR) T[k] = 0u;
    bf16x8 Af[4];
    { const int qsel = (r32 >> 2) & 1, head = (r32 & 3) + 4 * (r32 >> 3); const size_t tq = (size_t)(t0 + 2 * w + qsel);
      const float wv = bf2f(KW[tq * 256 + 64 + head]);
#pragma unroll
      for (int s = 0; s < 4; ++s) { const u32x4 q = *(const u32x4*)(QI + tq * (IH * ID) + head * ID + 16 * s + 8 * hi); u32x4 o;
#pragma unroll
          for (int j = 0; j < 4; ++j) o[j] = cvt_pk_bf16(bflo(q[j]) * wv, bfhi(q[j]) * wv);
          Af[s] = __builtin_bit_cast(bf16x8, o); } }
    float X[16];
    { const size_t tq = (size_t)(t0 + 2 * w + hi); const u32x4 w0 = *(const u32x4*)(KW + tq * 256 + 64), w1 = *(const u32x4*)(KW + tq * 256 + 72);
      const float PINF = __builtin_inff();
#pragma unroll
      for (int j = 0; j < 4; ++j) { X[2 * j] = bflo(w0[j]) >= 0.f ? PINF : -PINF; X[2 * j + 1] = bfhi(w0[j]) >= 0.f ? PINF : -PINF;
                                    X[8 + 2 * j] = bflo(w1[j]) >= 0.f ? PINF : -PINF; X[8 + 2 * j + 1] = bfhi(w1[j]) >= 0.f ? PINF : -PINF; } }
    const int mypos = tpos0 + 2 * w + hi;
    unsigned keys[128];
    const __amdgpu_buffer_rsrc_t krs = __builtin_amdgcn_make_buffer_rsrc((void*)(KW + (size_t)b * SEQ * 256), 0, SEQ * 256 * 2, 0x00020000);
    const int kvoff = r32 * 512 + hi * 16;
    u32x4 Bn[4];
#pragma unroll
    for (int s = 0; s < 4; ++s) Bn[s] = __builtin_amdgcn_raw_buffer_load_b128(krs, kvoff + 32 * s, 0, 0);
#pragma unroll
    for (int n = 0; n < 128; ++n) {
        keys[n] = 0u;
        if (n < nh) {
            u32x4 Bc[4];
#pragma unroll
            for (int s = 0; s < 4; ++s) Bc[s] = Bn[s];
            if (n + 1 < nh) {
#pragma unroll
                for (int s = 0; s < 4; ++s) Bn[s] = __builtin_amdgcn_raw_buffer_load_b128(krs, kvoff + 32 * s, (n + 1) * 16384, 0);
            }
            f32x16 acc = {0.f, 0.f, 0.f, 0.f, 0.f, 0.f, 0.f, 0.f, 0.f, 0.f, 0.f, 0.f, 0.f, 0.f, 0.f, 0.f};
#pragma unroll
            for (int s = 0; s < 4; ++s) acc = __builtin_amdgcn_mfma_f32_32x32x16_bf16(Af[s], __builtin_bit_cast(bf16x8, Bc[s]), acc, 0, 0, 0);
            float sc = 0.f;
#pragma unroll
            for (int j = 0; j < 16; ++j) sc += __builtin_amdgcn_fmed3f(acc[j], 0.f, X[j]);
            keys[n] = (32 * n + r32 <= mypos) ? mono_key(sc) : 0u;
        }
    }
    unsigned T0 = 0u, T1 = 0u; bool done0 = false, done1 = false;
    for (int bit = 31; bit >= 0; --bit) {
        const unsigned c0 = T0 | (1u << bit), c1 = T1 | (1u << bit), cand = hi ? c1 : c0;
        unsigned cnt = 0;
#pragma unroll
        for (int n8 = 0; n8 < 16; ++n8) { if (n8 * 8 < nh) {
#pragma unroll
            for (int j = 0; j < 8; ++j) cnt += (keys[n8 * 8 + j] >= cand) ? 1u : 0u; } }
        cnt += __shfl_xor(cnt, 1); cnt += __shfl_xor(cnt, 2); cnt += __shfl_xor(cnt, 4); cnt += __shfl_xor(cnt, 8); cnt += __shfl_xor(cnt, 16);
        const unsigned n0 = __builtin_amdgcn_readlane(cnt, 0), n1 = __builtin_amdgcn_readlane(cnt, 32);
        if (!done0 && n0 >= (unsigned)TOPK) { T0 = c0; if (n0 == (unsigned)TOPK) done0 = true; }
        if (!done1 && n1 >= (unsigned)TOPK) { T1 = c1; if (n1 == (unsigned)TOPK) done1 = true; }
        if (done0 && done1) break;
    }
    { const unsigned Tsel = hi ? T1 : T0, Tf = Tsel > 1u ? Tsel : 1u;
      __syncthreads();
#pragma unroll
      for (int n = 0; n < 128; ++n) { if (n < nh) {
          unsigned bitv = keys[n] >= Tf ? 1u : 0u; const unsigned other = __shfl_xor(bitv, 32);
          bitv |= other << 1;
          if (hi == 0 && bitv) __hip_atomic_fetch_or(T + 32 * n + r32, bitv << (2 * w), __ATOMIC_RELAXED, __HIP_MEMORY_SCOPE_WORKGROUP); } }
    }
    __syncthreads();
    { const int rg = (b * SEQ + tpos0) >> 5, f = i16 & 1;
      for (int k = tid; k < kzero; k += NTHR) { const int kk = k & 63, p = (kk & ~7) | ((kk & 3) << 1) | ((kk >> 2) & 1);
          MT[((size_t)(rg * 64 + (k >> 6)) * 64 + p) * 2 + f] = (unsigned short)(T[k] & 0xffffu); } }
    __syncthreads();
}
__device__ __forceinline__ void p3_indexer(Frame& F) {
    for (int v2 = 2 * blockIdx.x; v2 < 512; v2 += 2 * F.G) { for (int ps = 0; ps < 2; ++ps) { const int v = v2 >> 1, b = v >> 7, i = v & 127; idx_block(F, b, ps ? 255 - i : i); } }
}
namespace att {
constexpr int KVBLK = 64, SHM_V = KVBLK * HD * 2, SHM_K = KVBLK * HD * 2;
constexpr int LDS_V = 0, LDS_K = 2 * SHM_V, LDS_WS = 2 * SHM_V + 2 * SHM_K, LDS_BYTES = LDS_WS + NWAVES * 64 * 4;
constexpr float THR = 8.f, LOG2E = 1.4426950408889634f;
#define KSWZ(row, colB) ((row) * 256 + ((colB) ^ (((row) & 7) << 4)))
#define SBAR() __builtin_amdgcn_sched_barrier(0)
__device__ __forceinline__ int v_st(int k, int c) { const int kk = (k & ~0xC) | ((k & 4) << 1) | ((k & 8) >> 1); return ((kk >> 3) * 4 + (c >> 5)) * 512 + ((kk & 7) * 32 + (c & 31)) * 2; }
__device__ __forceinline__ int v_rd_base(int lane) { return ((lane & 3) << 3) | (((lane >> 2) & 3) << 6) | (((lane >> 4) & 1) << 5) | (((lane >> 5) & 1) << 8); }
constexpr int v_rd_off(int d0, int ks, int half) { return d0 * 512 + ks * 4096 + half * 2048; }
__device__ __forceinline__ int crow(int r, int hi) { return (r & 3) + 8 * (r >> 2) + 4 * hi; }
__device__ __forceinline__ void partialSM(f32x16& p0, f32x16& p1, float& m_reg, float& mn, float& alpha) {
    float pmax = p0[0];
#pragma unroll
    for (int r = 1; r < 16; ++r) pmax = fmaxf(pmax, p0[r]);
#pragma unroll
    for (int r = 0; r < 16; ++r) pmax = fmaxf(pmax, p1[r]);
    { auto rr = __builtin_amdgcn_permlane32_swap(__float_as_uint(pmax), __float_as_uint(pmax), false, false);
      pmax = fmaxf(__uint_as_float(rr[0]), __uint_as_float(rr[1])); }
    if (__builtin_expect(__all((pmax - m_reg) <= THR), 1)) { mn = m_reg; alpha = 1.f; }
    else { mn = fmaxf(m_reg, pmax); alpha = __builtin_amdgcn_exp2f((m_reg - mn) * LOG2E); m_reg = mn; }
    const float mnL = -mn * LOG2E;
#pragma unroll
    for (int r = 0; r < 16; ++r) p0[r] = fmaf(p0[r], LOG2E, mnL);
#pragma unroll
    for (int r = 0; r < 16; ++r) p1[r] = fmaf(p1[r], LOG2E, mnL);
#pragma unroll
    for (int r = 0; r < 16; ++r) p0[r] = __builtin_amdgcn_exp2f(p0[r]);
}
__device__ __forceinline__ void finishSM(f32x16& p0, f32x16& p1, float alpha, float& l_reg, bf16x8& pa0, bf16x8& pa1, bf16x8& pa2, bf16x8& pa3) {
#pragma unroll
    for (int r = 0; r < 16; ++r) p1[r] = __builtin_amdgcn_exp2f(p1[r]);
    float ps = 0;
#pragma unroll
    for (int r = 0; r < 16; ++r) ps += p0[r];
#pragma unroll
    for (int r = 0; r < 16; ++r) ps += p1[r];
    { auto rr = __builtin_amdgcn_permlane32_swap(__float_as_uint(ps), __float_as_uint(ps), false, false);
      ps = __uint_as_float(rr[0]) + __uint_as_float(rr[1]); }
    l_reg = l_reg * alpha + ps;
#define PK4(P, B_, OUT) do { unsigned a0 = cvt_pk_bf16(P[B_+0], P[B_+1]), a1 = cvt_pk_bf16(P[B_+2], P[B_+3]);                          \
        unsigned b0 = cvt_pk_bf16(P[B_+4], P[B_+5]), b1 = cvt_pk_bf16(P[B_+6], P[B_+7]);                                             \
        auto r0 = __builtin_amdgcn_permlane32_swap(a0, b0, false, false); auto r1 = __builtin_amdgcn_permlane32_swap(a1, b1, false, false); \
        u32x4 w = {r0[0], r1[0], r0[1], r1[1]}; OUT = __builtin_bit_cast(bf16x8, w); } while (0)
    PK4(p0, 0, pa0); PK4(p0, 8, pa1); PK4(p1, 0, pa2); PK4(p1, 8, pa3);
#undef PK4
}
template <int KB>
__device__ __forceinline__ void qkt(f32x16& p0, f32x16& p1, const LAS char* K_lds, int r32, int hi, const bf16x8* qr, bf16x8 kf0, bf16x8 kf1, bf16x8 qf) {
    p0 = __builtin_amdgcn_mfma_f32_32x32x16_bf16(kf0, qf, (f32x16){0.f, 0.f, 0.f, 0.f, 0.f, 0.f, 0.f, 0.f, 0.f, 0.f, 0.f, 0.f, 0.f, 0.f, 0.f, 0.f}, 0, 0, 0);
    p1 = __builtin_amdgcn_mfma_f32_32x32x16_bf16(kf1, qf, (f32x16){0.f, 0.f, 0.f, 0.f, 0.f, 0.f, 0.f, 0.f, 0.f, 0.f, 0.f, 0.f, 0.f, 0.f, 0.f, 0.f}, 0, 0, 0);
    const LAS char* kb[4];
#pragma unroll
    for (int dd = 0; dd < 4; ++dd) kb[dd] = K_lds + KB * SHM_K + KSWZ(r32, (dd * 16 + hi * 8) * 2);
#pragma unroll
    for (int d0 = 0; d0 < 8; ++d0) { const LAS char* ap = kb[d0 & 3] + (d0 >> 2) * 128;
        bf16x8 b0 = *(const LAS bf16x8*)(ap);
        bf16x8 b1 = *(const LAS bf16x8*)(ap + 32 * 256);
        p0 = __builtin_amdgcn_mfma_f32_32x32x16_bf16(b0, qr[d0], p0, 0, 0, 0);
        p1 = __builtin_amdgcn_mfma_f32_32x32x16_bf16(b1, qr[d0], p1, 0, 0, 0); }
}
template <int VB>
__device__ __forceinline__ void pv_tile(f32x16* o, int vb0, bf16x8 pa0, bf16x8 pa1, bf16x8 pa2, bf16x8 pa3) {
#define TRRD(dst, off) asm volatile("ds_read_b64_tr_b16 %0, %1 offset:%2" : "=&v"(dst) : "v"(vb0), "i"(off) : "memory")
#define PV_D0(d0) do { s16x4 l0, l1, l2, l3, h0, h1, h2, h3; constexpr int b_ = VB * SHM_V + v_rd_off(d0, 0, 0); \
        TRRD(l0, b_); TRRD(h0, b_ + 2048); TRRD(l1, b_ + 4096); TRRD(h1, b_ + 6144); TRRD(l2, b_ + 8192); TRRD(h2, b_ + 10240); TRRD(l3, b_ + 12288); TRRD(h3, b_ + 14336); \
        asm volatile("s_waitcnt lgkmcnt(0)" ::: "memory"); SBAR();   \
        o[d0] = __builtin_amdgcn_mfma_f32_32x32x16_bf16(pa0, (bf16x8){l0[0], l0[1], l0[2], l0[3], h0[0], h0[1], h0[2], h0[3]}, o[d0], 0, 0, 0);   \
        o[d0] = __builtin_amdgcn_mfma_f32_32x32x16_bf16(pa1, (bf16x8){l1[0], l1[1], l1[2], l1[3], h1[0], h1[1], h1[2], h1[3]}, o[d0], 0, 0, 0);   \
        o[d0] = __builtin_amdgcn_mfma_f32_32x32x16_bf16(pa2, (bf16x8){l2[0], l2[1], l2[2], l2[3], h2[0], h2[1], h2[2], h2[3]}, o[d0], 0, 0, 0);   \
        o[d0] = __builtin_amdgcn_mfma_f32_32x32x16_bf16(pa3, (bf16x8){l3[0], l3[1], l3[2], l3[3], h3[0], h3[1], h3[2], h3[3]}, o[d0], 0, 0, 0); } while (0)
    PV_D0(0); PV_D0(1); PV_D0(2); PV_D0(3);
#undef PV_D0
#undef TRRD
}
typedef const __attribute__((address_space(4))) unsigned long long* cmask_t;
__device__ __forceinline__ void mask_tile(f32x16& p0, f32x16& p1, const unsigned long long* mpg) {
    const float NEG = -__builtin_inff();
    cmask_t mp = (cmask_t)mpg;
    asm volatile("s_nop 15\n\ts_nop 7" : "+v"(p0), "+v"(p1));
#pragma unroll
    for (int r = 0; r < 16; ++r) { const unsigned long long m0 = mp[r], m1 = mp[16 + r];
        asm volatile("v_cndmask_b32 %0, %1, %0, %2" : "+v"(p0[r]) : "v"(NEG), "s"(m0));
        asm volatile("v_cndmask_b32 %0, %1, %0, %2" : "+v"(p1[r]) : "v"(NEG), "s"(m1)); }
}
template <int BUF>
__device__ __forceinline__ void tile_step(f32x16* o, float& m_reg, float& l_reg, const LAS char* K_lds, int vb0, LAS float* al_l, int r32, int hi, const bf16x8* qr,
                                          int kb_key, bf16x8 qf, const unsigned long long* mp) {
    f32x16 p0, p1; float mn, alpha; bf16x8 pa0, pa1, pa2, pa3;
    const unsigned kbb = __float_as_uint((float)kb_key) >> 16, k0b = __float_as_uint((float)r32) >> 16, k1b = __float_as_uint((float)(r32 + 32)) >> 16;
    u32x4 f0 = {hi ? 0u : (kbb | (k0b << 16)), 0u, 0u, 0u}, f1 = {hi ? 0u : (kbb | (k1b << 16)), 0u, 0u, 0u};
    qkt<BUF>(p0, p1, K_lds, r32, hi, qr, __builtin_bit_cast(bf16x8, f0), __builtin_bit_cast(bf16x8, f1), qf);
    mask_tile(p0, p1, mp);
    partialSM(p0, p1, m_reg, mn, alpha);
    finishSM(p0, p1, alpha, l_reg, pa0, pa1, pa2, pa3);
    if (__any(alpha < 1.f)) { if (hi == 0) al_l[r32] = alpha; asm volatile("s_waitcnt lgkmcnt(0)" ::: "memory");
#pragma unroll
        for (int r = 0; r < 16; ++r) { const float av = al_l[crow(r, hi)];
#pragma unroll
            for (int d_ = 0; d_ < 4; ++d_) o[d_][r] *= av; } }
    pv_tile<BUF>(o, vb0, pa0, pa1, pa2, pa3);
}
__device__ __forceinline__ void attn_unit(Frame& F, int b, int g, int qb) {
    const bf16_t* Q = (const bf16_t*)(F.ws + WS_Q); const bf16_t* K = (const bf16_t*)(F.ws + WS_K); const bf16_t* V = (const bf16_t*)(F.ws + WS_V);
    bf16_t* O = (bf16_t*)(F.ws + WS_ATTN); const unsigned long long* MT = (const unsigned long long*)(F.ws + WS_MASK);
    LAS char* lds = (LAS char*)F.lds;
    const int wid = F.wave, lane = lane_id(), tid = wid * 64 + lane, r32 = lane & 31, hi = lane >> 5;
    const int hq = wid >> 1, th = wid & 1, h = 4 * g + hq, tok0 = b * SEQ + 64 * qb + 32 * th, NT = qb + 1;
    LAS char* V_lds = lds + LDS_V; LAS char* K_lds = lds + LDS_K; LAS float* wsf = (LAS float*)(lds + LDS_WS) + wid * 64; LAS float* li_l = wsf; LAS float* al_l = wsf + 32;
    const int sr = tid >> 4, sc = (tid & 15) * 8, vst0 = v_st(sr, sc), vst1 = v_st(32 + sr, sc), kws = KSWZ(sr, sc * 2);
    const int vb0 = (int)(uintptr_t)V_lds + v_rd_base(lane);
    bf16x8 qr[8];
#pragma unroll
    for (int d0 = 0; d0 < 8; ++d0) qr[d0] = *(const bf16x8*)(Q + (size_t)(tok0 + r32) * AW + h * HD + d0 * 16 + hi * 8);
    const unsigned sb = __float_as_uint(__builtin_ldexpf(1.0f, -(h + 1))) >> 16;
    const u32x4 qfw = {hi ? 0u : (sb | (sb << 16)), 0u, 0u, 0u}; const bf16x8 qf = __builtin_bit_cast(bf16x8, qfw);
    const bf16_t* Kg = K + (size_t)(b * SEQ) * KVW + g * HD + sc; const bf16_t* Vg = V + (size_t)(b * SEQ) * KVW + g * HD + sc;
    const unsigned long long* mrow = MT + (size_t)__builtin_amdgcn_readfirstlane(tok0 >> 5) * 64 * 32;
    float m_reg = -1e30f, l_reg = 0.f; f32x16 o[4] = {};
    bf16x8 st_k0, st_k1, st_v0, st_v1;
#define SLOAD(k0) do { st_k0 = *(const bf16x8*)(Kg + (size_t)((k0) + sr) * KVW); st_k1 = *(const bf16x8*)(Kg + (size_t)((k0) + 32 + sr) * KVW); \
                       st_v0 = *(const bf16x8*)(Vg + (size_t)((k0) + sr) * KVW); st_v1 = *(const bf16x8*)(Vg + (size_t)((k0) + 32 + sr) * KVW); } while (0)
#define SWRITE(bf) do { *(LAS bf16x8*)(K_lds + (bf) * SHM_K + kws) = st_k0; *(LAS bf16x8*)(K_lds + (bf) * SHM_K + kws + 32 * 256) = st_k1; \
                        *(LAS bf16x8*)(V_lds + (bf) * SHM_V + vst0) = st_v0; *(LAS bf16x8*)(V_lds + (bf) * SHM_V + vst1) = st_v1; } while (0)
    SLOAD(0); SWRITE(0);
    __syncthreads();
    for (int t = 0; t < NT; t += 2) {
        if (t + 1 < NT) SLOAD((t + 1) * KVBLK);
        tile_step<0>(o, m_reg, l_reg, K_lds, vb0, al_l, r32, hi, qr, t * KVBLK, qf, mrow + (size_t)t * 32);
        if (t + 1 < NT) SWRITE(1);
        __syncthreads();
        if (t + 1 < NT) {
            if (t + 2 < NT) SLOAD((t + 2) * KVBLK);
            tile_step<1>(o, m_reg, l_reg, K_lds, vb0, al_l, r32, hi, qr, (t + 1) * KVBLK, qf, mrow + (size_t)(t + 1) * 32);
            if (t + 2 < NT) SWRITE(0);
            __syncthreads();
        }
    }
#undef SLOAD
#undef SWRITE
    if (hi == 0) li_l[r32] = l_reg; asm volatile("s_waitcnt lgkmcnt(0)" ::: "memory");
    bf16_t* Ow = O + (size_t)tok0 * AW + h * HD;
#pragma unroll
    for (int r = 0; r < 16; ++r) { const int orow = crow(r, hi); const float rl = __builtin_amdgcn_rcpf(li_l[orow]);
#pragma unroll
        for (int d0 = 0; d0 < 4; ++d0) { const float v = o[d0][r] * rl; const float vn = __shfl_xor(v, 1);
            if ((r32 & 1) == 0) *(unsigned*)(Ow + (size_t)orow * AW + d0 * 32 + r32) = cvt_pk_bf16(v, vn); } }
    __syncthreads();
}
#undef KSWZ
#undef SBAR
}
struct SchedPool {
    const char* A; const char* B; int c;
    __device__ __forceinline__ bool next(int i, pg8::Unit& u) const { if (i > 0 || c >= 128) return false; const int rt = c >> 2, g = c & 3; u.pm = rt; u.pn = g; u.aux = 0; u.tok = nullptr;
        u.A = A + ((size_t)rt * 256 * PW + g * 256) * 2; u.B = B + (size_t)g * 65536 * 2; return true; }
};
struct EpiPool {
    bf16_t* out; const float* pscale;
    __device__ __forceinline__ bool operator()(f32x4 (&acc)[2][2][4][2], const pg8::Unit& u, int wr, int wc, int fr, int fq) const {
        const int row0 = u.pm * 256 + wr * 64 + fr, col0 = u.pn * 256 + wc * 32 + 8 * fq;
#pragma unroll
        for (int bj = 0; bj < 2; ++bj) { const f32x4 s0 = *(const f32x4*)(pscale + col0 + bj * 128), s1 = *(const f32x4*)(pscale + col0 + bj * 128 + 4);
#pragma unroll
            for (int ai = 0; ai < 2; ++ai)
#pragma unroll
                for (int m = 0; m < 4; ++m) st_bf16x8(out + (size_t)(row0 + ai * 128 + m * 16) * PW + col0 + bj * 128, acc[ai][bj][m][0] * s0, acc[ai][bj][m][1] * s1); }
        return false;
    }
};
__device__ __forceinline__ void p4_pool_attn(Frame& F, const Args& a) {
    for (int c = blockIdx.x; c < 256; c += F.G) {
        const int bg = c >> 6, qb = c & 63;
        if (qb < 32) { SchedPool S{(const char*)(F.ws + WS_POOLED), (const char*)(F.ws + WS_PLIN), bg * 32 + qb}; EpiPool E{(bf16_t*)(F.ws + WS_POOL), a.in[I_PSCALE]};
            pg8::gemm_phase<EpiPool, SchedPool, false>(F.lds, F.wave, 256, PW, S, E); __syncthreads(); }
        att::attn_unit(F, bg >> 1, bg & 1, qb);
    }
}
struct SchedMerge {
    pg8::TileOrder T; const char* A0; const char* B0; const char* A1; const char* B1;
    __device__ __forceinline__ bool next(int i, pg8::Unit& u) const { int pm, pn; if (!T.tile(i >> 1, pm, pn)) return false; u.pm = pm; u.pn = pn; u.aux = i & 1; u.tok = nullptr;
        u.A = ((i & 1) ? A1 : A0) + (size_t)pm * 256 * 1024 * 2; u.B = ((i & 1) ? B1 : B0) + (size_t)pn * 256 * 1024 * 2; return true; }
};
struct EpiMerge {
    const bf16_t* G; bf16_t* out;
    __device__ __forceinline__ bool operator()(f32x4 (&acc)[2][2][4][2], const pg8::Unit& u, int wr, int wc, int fr, int fq) const {
        const int row0 = u.pm * 256 + wr * 64 + fr, col0 = u.pn * 256 + wc * 32 + 8 * fq;
#pragma unroll
        for (int ai = 0; ai < 2; ++ai)
#pragma unroll
            for (int m = 0; m < 4; ++m) { const size_t r = (size_t)(row0 + ai * 128 + m * 16);
#pragma unroll
                for (int bj = 0; bj < 2; ++bj) { const int c = col0 + bj * 128;
                    const u32x4 gp = *(const u32x4*)(G + r * (2 * DM) + DM + c);
                    const f32x4 p0 = {bflo(gp[0]), bfhi(gp[0]), bflo(gp[1]), bfhi(gp[1])}, p1 = {bflo(gp[2]), bfhi(gp[2]), bflo(gp[3]), bfhi(gp[3])};
                    if (u.aux == 0) { const u32x4 ga = *(const u32x4*)(G + r * (2 * DM) + c);
                        const f32x4 a0 = {bflo(ga[0]), bfhi(ga[0]), bflo(ga[1]), bfhi(ga[1])}, a1 = {bflo(ga[2]), bfhi(ga[2]), bflo(ga[3]), bfhi(ga[3])};
#pragma unroll
                        for (int j = 0; j < 4; ++j) { acc[ai][bj][m][0][j] *= a0[j] * __builtin_amdgcn_rcpf(fmaxf(p0[j], 1e-30f)); acc[ai][bj][m][1][j] *= a1[j] * __builtin_amdgcn_rcpf(fmaxf(p1[j], 1e-30f)); } }
                    else st_bf16x8(out + r * DM + c, acc[ai][bj][m][0] * p0, acc[ai][bj][m][1] * p1); } }
        return u.aux == 0;
    }
};
__device__ __forceinline__ void p5_merge(Frame& F) {
    SchedMerge S; S.T.init(NTOK, DM, F.G, (int)blockIdx.x); S.A0 = (const char*)(F.ws + WS_ATTN); S.B0 = (const char*)(F.ws + WS_WAU); S.A1 = (const char*)(F.ws + WS_POOL); S.B1 = (const char*)(F.ws + WS_WPU);
    EpiMerge E{(const bf16_t*)(F.ws + WS_G), (bf16_t*)(F.ws + WS_MERGED)};
    pg8::gemm_phase<EpiMerge, SchedMerge, false>(F.lds, F.wave, 1024, 1024, S, E);
}
struct EpiOut {
    const float* x; const float* mod; float* out;
    __device__ __forceinline__ bool operator()(f32x4 (&acc)[2][2][4][2], const pg8::Unit& u, int wr, int wc, int fr, int fq) const {
        const int row0 = u.pm * 256 + wr * 64 + fr, col0 = u.pn * 256 + wc * 32 + 8 * fq; const int b = (u.pm * 256) / SEQ;
        const float* gm = mod + b * 6 * DM + 2 * DM;
#pragma unroll
        for (int bj = 0; bj < 2; ++bj) { const int c = col0 + bj * 128; const f32x4 g0 = *(const f32x4*)(gm + c), g1 = *(const f32x4*)(gm + c + 4);
#pragma unroll
            for (int ai = 0; ai < 2; ++ai)
#pragma unroll
                for (int m = 0; m < 4; ++m) { const size_t o = (size_t)(row0 + ai * 128 + m * 16) * DM + c;
                    const f32x4 x0 = *(const f32x4*)(x + o), x1 = *(const f32x4*)(x + o + 4);
                    *(f32x4*)(out + o) = x0 + g0 * acc[ai][bj][m][0]; *(f32x4*)(out + o + 4) = x1 + g1 * acc[ai][bj][m][1]; } }
        return false;
    }
};
__device__ __forceinline__ void p6_out(Frame& F, const Args& a) {
    SchedDense S; S.T.init(NTOK, DM, F.G, (int)blockIdx.x); S.A = (const char*)(F.ws + WS_MERGED); S.B = (const char*)(F.ws + WS_WOUT);
    S.a_tile = (size_t)256 * DM * 2; S.b_tile = (size_t)256 * DM * 2;
    EpiOut E{a.in[I_X], (const float*)(F.ctl + CW_MOD), F.out};
    pg8::gemm_phase<EpiOut, SchedDense, false>(F.lds, F.wave, DM, DM, S, E);
}
constexpr int P7_ROWB = 4096 + 16;
constexpr int P7_LDS_P = 16 * P7_ROWB;
constexpr int P7_LDS_H = P7_LDS_P + 2 * 16 * 64 * 4;
__device__ __forceinline__ void p7_router(Frame& F, const Args& a) {
    const float* mod = (const float*)(F.ctl + CW_MOD);
    bf16_t* hb = (bf16_t*)(F.ws + WS_HB); const bf16_t* Wr = (const bf16_t*)(F.ws + WS_WR);
    unsigned char* rt = F.ws + WS_ROUTE;
    int* eid = (int*)(rt + RT_EID); float* gate = (float*)(rt + RT_GATE); int* posn = (int*)(rt + RT_POS); int* list = (int*)(rt + RT_LIST); int* ident = (int*)(rt + RT_IDENT);
    unsigned* ecnt = F.ctl + CW_ECNT;
    LAS unsigned char* lds = F.lds; LAS float* P = (LAS float*)(lds + P7_LDS_P); LAS unsigned* hist = (LAS unsigned*)(lds + P7_LDS_H); LAS unsigned* baseL = hist + 64;
    const int lane = lane_id(), w = F.wave, tid = w * 64 + lane;
    if (tid < 64) hist[tid] = 0u;
    __syncthreads();
    for (int p = blockIdx.x; p < NTOK / 16; p += F.G) {
        const int row0 = 16 * p;
#pragma unroll
        for (int rr = 0; rr < 2; ++rr) { const int lr = 2 * w + rr, m = row0 + lr, b = m / SEQ;
            const float* xrow = F.out + (size_t)m * DM; const float* sh = mod + b * 6 * DM + 3 * DM; const float* sl = mod + b * 6 * DM + 4 * DM;
            f32x4 v[8]; float ss = 0.f;
#pragma unroll
            for (int j = 0; j < 8; ++j) { v[j] = *(const f32x4*)(xrow + 4 * lane + 256 * j); ss += (v[j].x * v[j].x + v[j].y * v[j].y) + (v[j].z * v[j].z + v[j].w * v[j].w); }
            const float rstd = rsqrtf(wave_sum(ss) * (1.0f / DM) + NORM_EPS);
#pragma unroll
            for (int j = 0; j < 8; ++j) { const int c = 4 * lane + 256 * j;
                const f32x4 gg = *(const f32x4*)(a.in[I_GFFN] + c), shv = *(const f32x4*)(sh + c), slv = *(const f32x4*)(sl + c);
                const f32x4 o = v[j] * rstd * gg * (slv + 1.0f) + shv;
                u32x2 wv; wv.x = cvt_pk_bf16(o.x, o.y); wv.y = cvt_pk_bf16(o.z, o.w);
                *(u32x2*)(hb + (size_t)m * DM + c) = wv; *(LAS u32x2*)(lds + lr * P7_ROWB + c * 2) = wv; }
            if (lane == 0) ident[m] = m;
        }
        __syncthreads();
        { const int nb = w & 3, kh = w >> 2, fr = lane & 15, kq = lane >> 4;
          f32x4 acc = {0.f, 0.f, 0.f, 0.f};
          const bf16_t* wp = Wr + (size_t)(16 * nb + fr) * DM + 1024 * kh + 8 * kq;
          const LAS unsigned char* ap = lds + fr * P7_ROWB + (1024 * kh + 8 * kq) * 2;
#pragma unroll 8
          for (int s = 0; s < 32; ++s) { const bf16x8 bv = *(const bf16x8*)(wp + 32 * s); const bf16x8 av = *(const LAS bf16x8*)(ap + 64 * s);
              acc = __builtin_amdgcn_mfma_f32_16x16x32_bf16(av, bv, acc, 0, 0, 0); }
#pragma unroll
          for (int j = 0; j < 4; ++j) P[(kh * 16 + 4 * kq + j) * 64 + 16 * nb + fr] = acc[j];
        }
        __syncthreads();
        int myrank[2]; unsigned mylocal[2]; bool chosen[2]; float mygate[2];
#pragma unroll
        for (int rr = 0; rr < 2; ++rr) { const int lr = 2 * w + rr;
            const float logit = P[lr * 64 + lane] + P[(16 + lr) * 64 + lane];
            const float score = 1.0f / (1.0f + __expf(-logit)); const float sel = score + a.in[I_RBIAS][lane];
            float m1 = sel; m1 = fmaxf(m1, __shfl_xor(m1, 1)); m1 = fmaxf(m1, __shfl_xor(m1, 2)); m1 = fmaxf(m1, __shfl_xor(m1, 4));
            const unsigned long long bm = __ballot(sel == m1); const unsigned grp = (unsigned)((bm >> (lane & ~7)) & 0xffull); const int first = __builtin_ctz(grp | 0x100u);
            float m2 = ((lane & 7) == first) ? -__builtin_inff() : sel; m2 = fmaxf(m2, __shfl_xor(m2, 1)); m2 = fmaxf(m2, __shfl_xor(m2, 2)); m2 = fmaxf(m2, __shfl_xor(m2, 4));
            const float gs = m1 + m2; const int g = lane >> 3; int grank = 0;
#pragma unroll
            for (int g2 = 0; g2 < 8; ++g2) { const float o = __uint_as_float(__builtin_amdgcn_readlane(__float_as_uint(gs), 8 * g2)); grank += (o > gs || (o == gs && g2 < g)) ? 1 : 0; }
            const float selm = grank < TOPG ? sel : -__builtin_inff(); int rank = 0;
#pragma unroll
            for (int e2 = 0; e2 < 64; ++e2) { const float o = __uint_as_float(__builtin_amdgcn_readlane(__float_as_uint(selm), e2)); rank += (o > selm || (o == selm && e2 < lane)) ? 1 : 0; }
            const bool ch = rank < ETOP && grank < TOPG; const float gsum = wave_sum(ch ? score : 0.f);
            chosen[rr] = ch; myrank[rr] = rank; mygate[rr] = score / gsum * ROUTED_SCALE;
            mylocal[rr] = ch ? __hip_atomic_fetch_add(hist + lane, 1u, __ATOMIC_RELAXED, __HIP_MEMORY_SCOPE_WORKGROUP) : 0u;
        }
        __syncthreads();
        if (w == 0) { const unsigned c = hist[lane]; baseL[lane] = c ? __hip_atomic_fetch_add(ecnt + lane, c, __ATOMIC_RELAXED, __HIP_MEMORY_SCOPE_AGENT) : 0u; hist[lane] = 0u; }
        __syncthreads();
#pragma unroll
        for (int rr = 0; rr < 2; ++rr) if (chosen[rr]) { const int m = row0 + 2 * w + rr; const unsigned pos = baseL[lane] + mylocal[rr];
            eid[m * 8 + myrank[rr]] = lane; gate[m * 8 + myrank[rr]] = mygate[rr]; posn[m * 8 + myrank[rr]] = (int)pos; list[(size_t)lane * NTOK + pos] = m; }
        __syncthreads();
    }
}
constexpr int MOE_LDS = 131072;
__device__ __forceinline__ int moe_prefix(Frame& F) {
    LAS int* rtoff = (LAS int*)(F.lds + MOE_LDS);
    if (F.wave == 0 && lane_id() == 0) { int s = 0; for (int e = 0; e < NE; ++e) { rtoff[e] = s; unsigned n = F.ctl[CW_ECNT + e]; if (n > (unsigned)NTOK) n = NTOK; s += (int)((n + 255u) >> 8); } rtoff[NE] = s; }
    __syncthreads();
    return __builtin_amdgcn_readfirstlane(rtoff[NE]);
}
__device__ __forceinline__ int moe_find(const LAS int* rtoff, int rtg) {
    int lo = 0, hi = NE;
#pragma unroll
    for (int it = 0; it < 6; ++it) { const int mid = (lo + hi) >> 1; if (rtoff[mid] <= rtg) lo = mid; else hi = mid; }
    return __builtin_amdgcn_readfirstlane(lo);
}
struct SchedMoe1 {
    const LAS int* rtoff; int RT, G, c; const char* hb; const char* w13; const char* ws13; const int* list; const int* ident;
    __device__ __forceinline__ bool next(int i, pg8::Unit& u) const {
        const int idx = i * G + c; if (idx >= (RT + NTOK / 256) * 4) return false;
        const int rtg = idx >> 2, ct = idx & 3; u.pn = ct; u.aux = 0; u.A = hb;
        if (rtg < RT) { const int e = moe_find(rtoff, rtg), rt = rtg - __builtin_amdgcn_readfirstlane(rtoff[e]); u.pm = rtg; u.tok = list + (size_t)e * NTOK + rt * 256;
            u.B = w13 + ((size_t)e * 1024 + ct * 256) * DM * 2; }
        else { const int rt = rtg - RT; u.pm = HROWS_R / 256 + rt; u.tok = ident + rt * 256; u.B = ws13 + (size_t)(ct * 256) * DM * 2; }
        return true; }
};
struct EpiMoe1 {
    bf16_t* H;
    __device__ __forceinline__ bool operator()(f32x4 (&acc)[2][2][4][2], const pg8::Unit& u, int wr, int wc, int fr, int fq) const {
        const int row0 = u.pm * 256 + wr * 64 + fr, col0 = u.pn * 128 + wc * 32 + 8 * fq;
#pragma unroll
        for (int ai = 0; ai < 2; ++ai)
#pragma unroll
            for (int m = 0; m < 4; ++m) { f32x4 h0, h1;
#pragma unroll
                for (int j = 0; j < 4; ++j) { const float g0 = acc[ai][0][m][0][j], g1 = acc[ai][0][m][1][j];
                    h0[j] = g0 * __builtin_amdgcn_rcpf(1.0f + __expf(-g0)) * acc[ai][1][m][0][j]; h1[j] = g1 * __builtin_amdgcn_rcpf(1.0f + __expf(-g1)) * acc[ai][1][m][1][j]; }
                st_bf16x8(H + (size_t)(row0 + ai * 128 + m * 16) * EH + col0, h0, h1); }
        return false;
    }
};
__device__ __forceinline__ void p8_gemm1(Frame& F) {
    const int RT = moe_prefix(F);
    SchedMoe1 S{(const LAS int*)(F.lds + MOE_LDS), RT, F.G, (int)blockIdx.x, (const char*)(F.ws + WS_HB), (const char*)(F.ws + WS_W13), (const char*)(F.ws + WS_WS13),
                (const int*)(F.ws + WS_ROUTE + RT_LIST), (const int*)(F.ws + WS_ROUTE + RT_IDENT)};
    EpiMoe1 E{(bf16_t*)(F.ws + WS_H)};
    pg8::gemm_phase<EpiMoe1, SchedMoe1, true>(F.lds, F.wave, DM, DM, S, E);
}
struct SchedMoe2 {
    const LAS int* rtoff; int RT, G, c; const char* H; const char* w2;
    __device__ __forceinline__ bool next(int i, pg8::Unit& u) const {
        const int idx = i * G + c; if (idx >= RT * 8) return false;
        const int rtg = idx >> 3, ct = idx & 7, e = moe_find(rtoff, rtg); u.pm = rtg; u.pn = ct; u.aux = 0; u.tok = nullptr;
        u.A = H + (size_t)rtg * 256 * EH * 2; u.B = w2 + ((size_t)e * DM + ct * 256) * EH * 2; return true; }
};
struct EpiY {
    bf16_t* Y;
    __device__ __forceinline__ bool operator()(f32x4 (&acc)[2][2][4][2], const pg8::Unit& u, int wr, int wc, int fr, int fq) const {
        const int row0 = u.pm * 256 + wr * 64 + fr, col0 = u.pn * 256 + wc * 32 + 8 * fq;
#pragma unroll
        for (int ai = 0; ai < 2; ++ai)
#pragma unroll
            for (int m = 0; m < 4; ++m)
#pragma unroll
                for (int bj = 0; bj < 2; ++bj) st_bf16x8(Y + (size_t)(row0 + ai * 128 + m * 16) * DM + col0 + bj * 128, acc[ai][bj][m][0], acc[ai][bj][m][1]);
        return false;
    }
};
__device__ __forceinline__ void p9_gemm2(Frame& F) {
    const int RT = moe_prefix(F);
    SchedMoe2 S{(const LAS int*)(F.lds + MOE_LDS), RT, F.G, (int)blockIdx.x, (const char*)(F.ws + WS_H), (const char*)(F.ws + WS_W2)};
    EpiY E{(bf16_t*)(F.ws + WS_Y)};
    pg8::gemm_phase<EpiY, SchedMoe2, false>(F.lds, F.wave, EH, EH, S, E);
}
struct EpiFinal {
    const LAS int* rtoff; const bf16_t* Y; const int* eid; const float* gate; const int* posn; const float* mod; float* out;
    __device__ __forceinline__ bool operator()(f32x4 (&acc)[2][2][4][2], const pg8::Unit& u, int wr, int wc, int fr, int fq) const {
        const int row0 = u.pm * 256 + wr * 64 + fr, col0 = u.pn * 256 + wc * 32 + 8 * fq; const int b = (u.pm * 256) / SEQ;
        const float* gf = mod + b * 6 * DM + 5 * DM;
#pragma unroll
        for (int ai = 0; ai < 2; ++ai)
#pragma unroll
            for (int m = 0; m < 4; ++m) { const int t = row0 + ai * 128 + m * 16;
                const u32x4 e0 = *(const u32x4*)(eid + t * 8), e1 = *(const u32x4*)(eid + t * 8 + 4), p0 = *(const u32x4*)(posn + t * 8), p1 = *(const u32x4*)(posn + t * 8 + 4);
                const f32x4 g0 = *(const f32x4*)(gate + t * 8), g1 = *(const f32x4*)(gate + t * 8 + 4);
                f32x4 s[2][2] = {{acc[ai][0][m][0], acc[ai][0][m][1]}, {acc[ai][1][m][0], acc[ai][1][m][1]}};
#pragma unroll
                for (int k = 0; k < 8; ++k) { const unsigned e = k < 4 ? e0[k & 3] : e1[k & 3], p = k < 4 ? p0[k & 3] : p1[k & 3]; const float gk = k < 4 ? g0[k & 3] : g1[k & 3];
                    const size_t yr = (size_t)(256 * rtoff[e & 63] + (int)p);
#pragma unroll
                    for (int bj = 0; bj < 2; ++bj) { const u32x4 y = *(const u32x4*)(Y + yr * DM + col0 + bj * 128);
                        s[bj][0] += (f32x4){bflo(y[0]), bfhi(y[0]), bflo(y[1]), bfhi(y[1])} * gk; s[bj][1] += (f32x4){bflo(y[2]), bfhi(y[2]), bflo(y[3]), bfhi(y[3])} * gk; } }
#pragma unroll
                for (int bj = 0; bj < 2; ++bj) { const int c = col0 + bj * 128; const size_t o = (size_t)t * DM + c;
                    const f32x4 x0 = *(const f32x4*)(out + o), x1 = *(const f32x4*)(out + o + 4), f0 = *(const f32x4*)(gf + c), f1 = *(const f32x4*)(gf + c + 4);
                    *(f32x4*)(out + o) = x0 + f0 * s[bj][0]; *(f32x4*)(out + o + 4) = x1 + f1 * s[bj][1]; } }
        return false;
    }
};
__device__ __forceinline__ void p10_final(Frame& F) {
    (void)moe_prefix(F);
    SchedDense S; S.T.init(NTOK, DM, F.G, (int)blockIdx.x); S.A = (const char*)(F.ws + WS_H) + (size_t)HROWS_R * EH * 2; S.B = (const char*)(F.ws + WS_WS2);
    S.a_tile = (size_t)256 * EH * 2; S.b_tile = (size_t)256 * EH * 2;
    unsigned char* rt = F.ws + WS_ROUTE;
    EpiFinal E{(const LAS int*)(F.lds + MOE_LDS), (const bf16_t*)(F.ws + WS_Y), (const int*)(rt + RT_EID), (const float*)(rt + RT_GATE), (const int*)(rt + RT_POS), (const float*)(F.ctl + CW_MOD), F.out};
    pg8::gemm_phase<EpiFinal, SchedDense, false>(F.lds, F.wave, EH, EH, S, E);
}
constexpr int LDS_BYTES = 147456;
constexpr int N_PHASES = 11;
__global__ void __launch_bounds__(NTHR, 2) fwd(Args args) {
    extern __shared__ __attribute__((aligned(16))) unsigned char lds_raw[];
    Frame F; F.lds = (LAS unsigned char*)lds_raw; F.wave = __builtin_amdgcn_readfirstlane((int)threadIdx.x >> 6);
    F.G = gridDim.x; F.gw = blockIdx.x * NWAVES + F.wave; F.NGW = F.G * NWAVES; F.ws = args.ws; F.ctl = (unsigned*)(args.ws + WS_CTL); F.out = args.out;
    volatile LAS unsigned* xbw = (volatile LAS unsigned*)(F.lds + LDS_BYTES - 16);
    if (threadIdx.x < 4) xbw[threadIdx.x] = 0u;
    __syncthreads();
    const bool one = (args.ph_hi - args.ph_lo) > 1;
    XcdBarrier bar; bar.bar = F.ctl + CW_BAR; bar.x = 0; bar.st = xbw;
    if (one) bar = xcd_barrier_post(F.ctl + CW_BAR, xbw, F.wave);
    const int lo = args.ph_lo, hi = args.ph_hi;
#define IN(k) (lo <= (k) && (k) < hi)
#define SEAM(k) do { if (IN(k) && IN((k) + 1)) xcd_barrier(bar, F.wave); } while (0)
    if (IN(0)) { p0_prologue(F, args); } SEAM(0);
    if (IN(1)) { p1_h(F, args); } SEAM(1);
    if (IN(2)) { p2_inproj(F); } SEAM(2);
    if (IN(3)) { p3_qknorm(F, args); p3_pooled(F); __syncthreads(); p3_indexer(F); } SEAM(3);
    if (IN(4)) { p4_pool_attn(F, args); } SEAM(4);
    if (IN(5)) { p5_merge(F); } SEAM(5);
    if (IN(6)) { p6_out(F, args); } SEAM(6);
    if (IN(7)) { p7_router(F, args); } SEAM(7);
    if (IN(8)) { p8_gemm1(F); } SEAM(8);
    if (IN(9)) { p9_gemm2(F); } SEAM(9);
    if (IN(10)) { p10_final(F); }
#undef IN
#undef SEAM
}
#ifndef N_LAUNCHES
#define N_LAUNCHES 1
#endif
extern "C" void kernel_launch(void* const* d_in, const int* in_sizes, int n_in, void* d_out, int out_size, void* d_ws, size_t ws_size, hipStream_t stream) {
    static int grid = 0;
    if (grid == 0) {
        if (n_in != 22 || out_size != NTOK * DM || ws_size < WS_END) { fprintf(stderr, "kernel_launch: unexpected shapes (n_in %d out %d ws %zu need %zu)\n", n_in, out_size, ws_size, (size_t)WS_END); grid = -1; return; }
        int dev = 0, cus = 0, per_cu = 0;
        if (hipGetDevice(&dev) != hipSuccess || hipDeviceGetAttribute(&cus, hipDeviceAttributeMultiprocessorCount, dev) != hipSuccess) { grid = -1; return; }
        if (hipFuncSetAttribute((const void*)fwd, hipFuncAttributeMaxDynamicSharedMemorySize, LDS_BYTES) != hipSuccess) { fprintf(stderr, "kernel_launch: hipFuncSetAttribute failed\n"); grid = -1; return; }
        if (hipOccupancyMaxActiveBlocksPerMultiprocessor(&per_cu, (const void*)fwd, NTHR, LDS_BYTES) != hipSuccess || per_cu < 1) fprintf(stderr, "kernel_launch: occupancy query says %d\n", per_cu);
        (void)hipGetLastError();
        grid = cus;
    }
    if (grid < 0) return;
    (void)hipMemsetAsync((char*)d_ws + WS_CTL, 0, CTL_BYTES, stream);
    Args a{};
    for (int i = 0; i < 22; ++i) a.in[i] = (const float*)d_in[i];
    a.out = (float*)d_out; a.ws = (unsigned char*)d_ws;
    if (N_LAUNCHES == 1) { a.ph_lo = 0; a.ph_hi = N_PHASES; hipLaunchKernelGGL(fwd, dim3(grid), dim3(NTHR), LDS_BYTES, stream, a); }
    else for (int p = 0; p < N_PHASES; ++p) { a.ph_lo = p; a.ph_hi = p + 1; hipLaunchKernelGGL(fwd, dim3(grid), dim3(NTHR), LDS_BYTES, stream, a); }
}
```

```cpp
#include <hip/hip_runtime.h>
#include <cstdio>
#include <cstdint>

#define LAS __attribute__((address_space(3)))
#define GAS __attribute__((address_space(1)))
typedef unsigned short bf16_t;
typedef short bf16x8 __attribute__((ext_vector_type(8)));
typedef short s16x4 __attribute__((ext_vector_type(4)));
typedef float f32x4 __attribute__((ext_vector_type(4)));
typedef float f32x2 __attribute__((ext_vector_type(2)));
typedef float f32x16 __attribute__((ext_vector_type(16)));
typedef unsigned u32x4 __attribute__((ext_vector_type(4)));
typedef unsigned u32x2 __attribute__((ext_vector_type(2)));

constexpr int DM = 2048, NB = 2, SEQ = 4096, NTOK = NB * SEQ;
constexpr int NH = 8, HD = 128, NKV = 2, AW = 1024, KVW = 256, IH = 16, ID = 64, TOPK = 256;
constexpr int PW = 1024, INW = 7760, INP = 7936;
constexpr int NE = 64, EH = 512, NGRP = 8, EPG = 8, TOPG = 4, ETOP = 8;
constexpr float NORM_EPS = 1e-6f, ROUTED_SCALE = 2.5f;
constexpr int NTHR = 512, NWAVES = 8;

constexpr size_t MiB = 1u << 20;
constexpr size_t WS_CTL = 0, CTL_BYTES = 1 * MiB;
constexpr size_t WS_W13 = 1 * MiB;
constexpr size_t WS_W2 = WS_W13 + 256 * MiB;
constexpr size_t WS_WS13 = WS_W2 + 128 * MiB;
constexpr size_t WS_WS2 = WS_WS13 + 4 * MiB;
constexpr size_t WS_H = WS_WS2 + 2 * MiB;
constexpr int HROWS_R = 65536 + 64 * 256, HROWS = HROWS_R + NTOK;
constexpr size_t WS_ROUTE = WS_H + (size_t)HROWS * EH * 2;
constexpr size_t RT_EID = 0, RT_GATE = RT_EID + (size_t)NTOK * 8 * 4, RT_POS = RT_GATE + (size_t)NTOK * 8 * 4, RT_LIST = RT_POS + (size_t)NTOK * 8 * 4,
                 RT_IDENT = RT_LIST + (size_t)NE * NTOK * 4, RT_END = RT_IDENT + (size_t)NTOK * 4;
constexpr size_t WS_R = (WS_ROUTE + RT_END + MiB - 1) / MiB * MiB;
constexpr size_t WS_Y = WS_R;
constexpr size_t WS_WIN = WS_R;
constexpr size_t WS_WAU = WS_WIN + 31 * MiB, WS_WPU = WS_WAU + 4 * MiB, WS_WOUT = WS_WPU + 4 * MiB, WS_PLIN = WS_WOUT + 8 * MiB, WS_WR = WS_PLIN + MiB / 2;
constexpr size_t WS_HB = WS_WR + MiB / 2;
constexpr size_t WS_Q = WS_HB + 32 * MiB, WS_K = WS_Q + 16 * MiB, WS_V = WS_K + 4 * MiB, WS_QI = WS_V + 4 * MiB, WS_KW = WS_QI + 16 * MiB, WS_U = WS_KW + 4 * MiB,
                 WS_G = WS_U + 16 * MiB;
constexpr size_t WS_POOLED = WS_G + 64 * MiB, WS_POOL = WS_POOLED + 16 * MiB, WS_ATTN = WS_POOL + 16 * MiB, WS_MERGED = WS_ATTN + 16 * MiB, WS_MASK = WS_MERGED + 32 * MiB,
                 WS_REND = WS_MASK + 4 * MiB;
constexpr size_t WS_END = WS_Y + (size_t)HROWS_R * DM * 2;
static_assert(WS_REND <= WS_END, "overlay region");
constexpr int CW_BAR = 4096;
constexpr int CW_ECNT = 8192;
constexpr int CW_CONVQ = 12288;
constexpr int CW_DONE = 12352;
constexpr int CW_MOD = 16384;
static_assert((CW_MOD + 2 * 6 * DM) * 4 <= (int)CTL_BYTES, "ctl");

__device__ __forceinline__ int lane_id() { int l; asm volatile("v_mbcnt_lo_u32_b32 %0, -1, 0\n\tv_mbcnt_hi_u32_b32 %0, -1, %0" : "=v"(l)); return l; }
__device__ __forceinline__ unsigned cvt_pk_bf16(float lo, float hi) { unsigned r; asm volatile("v_cvt_pk_bf16_f32 %0, %1, %2" : "=v"(r) : "v"(lo), "v"(hi)); return r; }
__device__ __forceinline__ unsigned pk4_fp8(float a, float b, float c, float d) {
    a = __builtin_amdgcn_fmed3f(a, -448.f, 448.f); b = __builtin_amdgcn_fmed3f(b, -448.f, 448.f); c = __builtin_amdgcn_fmed3f(c, -448.f, 448.f); d = __builtin_amdgcn_fmed3f(d, -448.f, 448.f);
    int w = __builtin_amdgcn_cvt_pk_fp8_f32(a, b, 0, false); w = __builtin_amdgcn_cvt_pk_fp8_f32(c, d, w, true); return (unsigned)w; }
constexpr float W8_SCALE = 64.f;  constexpr int W8_E8 = 127 - 6;
constexpr float H8_SCALE = 8.f;   constexpr int H8_E8 = 127 - 3;
__device__ __forceinline__ float bf2f(unsigned short b) { return __uint_as_float(((unsigned)b) << 16); }
__device__ __forceinline__ float bflo(unsigned w) { return __uint_as_float(w << 16); }
__device__ __forceinline__ float bfhi(unsigned w) { return __uint_as_float(w & 0xffff0000u); }
__device__ __forceinline__ float wave_sum(float v) {
#pragma unroll
    for (int o = 1; o < 64; o <<= 1) v += __shfl_xor(v, o);
    return v;
}
__device__ __forceinline__ float sigmoidf_(float x) { return 1.0f / (1.0f + __expf(-x)); }

#define XB_TMO      128
#define XB_XCNT(j)  (256  + 64 * (j))
#define XB_XSUB(j)  (1280 + 64 * (j))
#define XB_XGEN(j)  (2304 + 64 * (j))
#define XB_TOP      3328
#define XB_TOPGEN   3392
#define XCD_BAR_WORDS 3456
#define XB_SPIN_CAP (1u << 18)
__device__ __forceinline__ unsigned xb_ld(unsigned* p)              { return __hip_atomic_load(p, __ATOMIC_RELAXED, __HIP_MEMORY_SCOPE_AGENT); }
__device__ __forceinline__ unsigned xb_add(unsigned* p, unsigned v) { return __hip_atomic_fetch_add(p, v, __ATOMIC_RELAXED, __HIP_MEMORY_SCOPE_AGENT); }
__device__ __forceinline__ unsigned xb_xcc_id() { return (unsigned)__builtin_amdgcn_s_getreg((3 << 11) | 20) & 0xFu; }
#define XB_SPIN(cond, bar) do { unsigned _sp = 0; while (cond) { __builtin_amdgcn_s_sleep(1); \
    if ((++_sp & 255u) == 0u) { if (xb_ld(&(bar)[XB_TMO])) break; if (_sp > XB_SPIN_CAP) { atomicAdd(&(bar)[XB_TMO], 1u); break; } } } } while (0)
struct XcdBarrier { unsigned* bar; unsigned x; volatile LAS unsigned* st; };
__device__ __forceinline__ XcdBarrier xcd_barrier_post(unsigned* bar, volatile LAS unsigned* st, int wave) {
    XcdBarrier b; b.bar = bar; b.x = xb_xcc_id(); b.st = st;
    if (wave == 0 && lane_id() == 0) (void)xb_add(&bar[XB_XCNT(b.x)], 1u);
    return b;
}
__device__ __forceinline__ void xcd_barrier_complete(unsigned* bar, unsigned x, unsigned& nloc, unsigned& nx) {
    const unsigned G = gridDim.x * gridDim.y * gridDim.z;
    unsigned sum, cnt, mine, sp = 0u;
    for (;;) {
        sum = 0u; cnt = 0u; mine = 0u;
#pragma unroll
        for (unsigned j = 0; j < 16; ++j) { const unsigned c = xb_ld(&bar[XB_XCNT(j)]); sum += c; cnt += (c > 0u) ? 1u : 0u; mine = (j == x) ? c : mine; }
        if (sum == G) break;
        __builtin_amdgcn_s_sleep(1);
        if ((++sp & 255u) == 0u) { if (xb_ld(&bar[XB_TMO])) break; if (sp > XB_SPIN_CAP) { atomicAdd(&bar[XB_TMO], 1u); break; } }
    }
    nloc = mine > 0u ? mine : 1u; nx = cnt > 0u ? cnt : 1u;
}
__device__ __forceinline__ void xcd_barrier(const XcdBarrier& b, int wave) {
    asm volatile("s_waitcnt vmcnt(0)" ::: "memory");
    __syncthreads();
    if (wave == 0 && lane_id() == 0) {
        unsigned* bar = b.bar;
        __builtin_amdgcn_s_waitcnt(0);
        unsigned nloc = b.st[0], nx = b.st[1];
        if (nloc == 0u) { xcd_barrier_complete(bar, b.x, nloc, nx); b.st[0] = nloc; b.st[1] = nx; }
        const unsigned old = xb_add(&bar[XB_XSUB(b.x)], 1u);
        const unsigned gen = old / nloc;
        if (old + 1u == (gen + 1u) * nloc) {
            __builtin_amdgcn_fence(__ATOMIC_RELEASE, "agent");
            asm volatile("s_waitcnt vmcnt(0)" ::: "memory");
            const unsigned og = xb_add(&bar[XB_TOP], 1u);
            const unsigned tg = og / nx;
            if (og + 1u == (tg + 1u) * nx) xb_add(&bar[XB_TOPGEN], 1u);
            else XB_SPIN(xb_ld(&bar[XB_TOPGEN]) == tg, bar);
            __builtin_amdgcn_fence(__ATOMIC_ACQUIRE, "agent");
            xb_add(&bar[XB_XGEN(b.x)], 1u);
            asm volatile("s_waitcnt vmcnt(0)" ::: "memory");
        } else {
            XB_SPIN(xb_ld(&bar[XB_XGEN(b.x)]) == gen, bar);
            __builtin_amdgcn_fence(__ATOMIC_ACQUIRE, "agent");
            asm volatile("s_waitcnt vmcnt(0)" ::: "memory");
        }
    }
    __syncthreads();
}
namespace pg8 {
constexpr int BM = 256, BK = 64, HALF = 128, HTB = HALF * BK * 2, STAGE_BYTES = 8 * HTB, NXCD = 8, WGM = 8;
__host__ __device__ __forceinline__ int lds_byte(int r, int c) { const int st = (r >> 4) * 2 + (c >> 5), rr = r & 15, cc = c & 31, ob = rr * 64 + cc * 2; return st * 1024 + (ob ^ (((ob >> 9) & 1) << 5)); }
__host__ __device__ __forceinline__ void stage_rc(int b, int& R, int& C) { const int st = b / 1024, sb = b % 1024, swz = sb ^ (((sb >> 9) & 1) << 5); R = (st >> 1) * 16 + swz / 64; C = (st & 1) * 32 + (swz % 64) / 2; }
__host__ __device__ __forceinline__ int perm32(int rho) { const int n = rho >> 4, i = rho & 15; return 8 * (i >> 2) + 4 * n + (i & 3); }

struct Unit { const char* A; const char* B; const int* tok; int pm, pn, aux; };

struct TileOrder {
    int nM, nN, nwg, G, c;
    __device__ void init(int M, int N, int G_, int c_) { nM = M / BM; nN = N / BM; nwg = nM * nN; G = G_; c = c_; }
    __device__ bool tile(int i, int& pm, int& pn) const {
        const long L = (long)i * G + c; if (L >= nwg) return false;
        int wgid = (int)L; { const int q = nwg / NXCD, r = nwg % NXCD, xcd = wgid % NXCD, off = wgid / NXCD; wgid = (xcd < r ? xcd * (q + 1) : r * (q + 1) + (xcd - r) * q) + off; }
        const int nig = WGM * nN, gid = wgid / nig, fm = gid * WGM, gsz = (nM - fm) < WGM ? (nM - fm) : WGM;
        pm = fm + ((wgid % nig) % gsz); pn = (wgid % nig) / gsz; return true;
    }
};

typedef int i32x8 __attribute__((ext_vector_type(8)));
template <class Epi, class Sched, bool GATHER, int ES = 2, int SCA = 127, int SCB = 127>
__device__ __forceinline__ void gemm_phase(LAS unsigned char* lds, const int wid, const int Kb, const int ldab, const Sched& S, const Epi& E) {
    const int lane = lane_id(), tid = wid * 64 + lane, wr = wid >> 2, wc = wid & 3, fr = lane & 15, fq = lane >> 4;
    const int nt = Kb / (BK * 2);
    unsigned voffA[2], voffB[2];
#pragma unroll
    for (int i = 0; i < 2; ++i) { int R, C; stage_rc(tid * 16 + i * 8192, R, C); const int Rb = (R & ~31) + perm32(R & 31);
        voffA[i] = (unsigned)(R * ldab + C * 2); voffB[i] = (unsigned)(Rb * Kb + C * 2); }
    const size_t kstep = (size_t)(BK * 2);
    const size_t hstepA = (size_t)HALF * ldab, hstepB = (size_t)HALF * Kb;
    const unsigned ldsw = (unsigned)wid * 1024u;
    const int aoff = ES == 2 ? lds_byte(wr * 64 + fr, fq * 8) : lds_byte(wr * 64 + fr, fq * 16), boff = ES == 2 ? lds_byte(wc * 32 + fr, fq * 8) : lds_byte(wc * 32 + fr, fq * 16);
    constexpr int OFF1 = ES == 2 ? 1024 : 16;
#define PG8_SA(b, h) (((b) * 2 + (h)) * HTB)
#define PG8_SB(b, h) ((4 + (b) * 2 + (h)) * HTB)
    const unsigned ldsbase = (unsigned)(uintptr_t)lds + ldsw;
#define PG8_DMA2(bufoff, sbase, voff_, i_) do { unsigned keep_; asm volatile("s_mov_b32 %0, m0\n\ts_mov_b32 m0, %3\n\ts_nop 0\n\tglobal_load_lds_dwordx4 %1, %2\n\ts_mov_b32 m0, %0" \
        : "=&s"(keep_) : "v"(voff_), "s"(sbase), "s"(ldsbase + (unsigned)((bufoff) + (i_) * 8192)) : "memory"); } while (0)
#define PG8_STAGEB(bufoff, gbase) do { _Pragma("unroll") for (int _i = 0; _i < 2; ++_i) PG8_DMA2(bufoff, (const char*)(gbase), voffB[_i], _i); } while (0)
#define PG8_STAGEA(bufoff, kt, h, GO) do { _Pragma("unroll") for (int _i = 0; _i < 2; ++_i) { \
        if constexpr (GATHER) PG8_DMA2(bufoff, (const char*)(kt), GO[h][_i], _i); else PG8_DMA2(bufoff, (const char*)(kt) + (h) * hstepA, voffA[_i], _i); } } while (0)
#define PG8_LD8(p0, p1) __builtin_bit_cast(i32x8, __builtin_shufflevector(*(const LAS u32x4*)(p0), *(const LAS u32x4*)(p1), 0, 1, 2, 3, 4, 5, 6, 7))
#define PG8_LDA(dst, b, h) do { _Pragma("unroll") for (int m = 0; m < 4; ++m) dst[m] = PG8_LD8(lds + PG8_SA(b, h) + aoff + m * 2048, lds + PG8_SA(b, h) + aoff + OFF1 + m * 2048); } while (0)
#define PG8_LDB(dst, b, h) do { _Pragma("unroll") for (int n = 0; n < 2; ++n) dst[n] = PG8_LD8(lds + PG8_SB(b, h) + boff + n * 2048, lds + PG8_SB(b, h) + boff + OFF1 + n * 2048); } while (0)
#define PG8_LO(x) __builtin_bit_cast(bf16x8, __builtin_shufflevector(x, x, 0, 1, 2, 3))
#define PG8_HI(x) __builtin_bit_cast(bf16x8, __builtin_shufflevector(x, x, 4, 5, 6, 7))
#define PG8_MMA(ai, bj, At, Bt) do { __builtin_amdgcn_s_setprio(1); _Pragma("unroll") for (int m = 0; m < 4; ++m) _Pragma("unroll") for (int n = 0; n < 2; ++n) { \
        if constexpr (ES == 2) { acc[ai][bj][m][n] = __builtin_amdgcn_mfma_f32_16x16x32_bf16(PG8_LO(Bt[n]), PG8_LO(At[m]), acc[ai][bj][m][n], 0, 0, 0); \
                                 acc[ai][bj][m][n] = __builtin_amdgcn_mfma_f32_16x16x32_bf16(PG8_HI(Bt[n]), PG8_HI(At[m]), acc[ai][bj][m][n], 0, 0, 0); } \
        else acc[ai][bj][m][n] = __builtin_amdgcn_mfma_scale_f32_16x16x128_f8f6f4(Bt[n], At[m], acc[ai][bj][m][n], 0, 0, 0, SCB * 0x01010101, 0, SCA * 0x01010101); } \
        __builtin_amdgcn_s_setprio(0); } while (0)
#define PG8_WAIT_V(n) asm volatile("s_waitcnt vmcnt(" #n ")" ::: "memory")
#define PG8_WAIT_L(n) asm volatile("s_waitcnt lgkmcnt(" #n ")" ::: "memory")
#define PG8_BAR __builtin_amdgcn_s_barrier()
#define PG8_SCHED __builtin_amdgcn_sched_barrier(0)
#define PG8_GLOAD(GO, u) do { if constexpr (GATHER) { const int _tid = wid * 64 + lane_id(); _Pragma("unroll") for (int _i = 0; _i < 2; ++_i) { int _R, _C; stage_rc(_tid * 16 + _i * 8192, _R, _C); \
        _Pragma("unroll") for (int _h = 0; _h < 2; ++_h) { unsigned _t = (unsigned)(u).tok[_h * HALF + _R]; _t = _t < (unsigned)NTOK ? _t : (unsigned)(NTOK - 1); GO[_h][_i] = _t * (unsigned)ldab + (unsigned)_C * 2u; } } } } while (0)
    Unit cur, nxt; int ui = 0;
    if (!S.next(0, cur)) return;
    f32x4 acc[2][2][4][2];
#pragma unroll
    for (int a = 0; a < 2; ++a)
#pragma unroll
        for (int b = 0; b < 2; ++b)
#pragma unroll
            for (int m = 0; m < 4; ++m)
#pragma unroll
                for (int n = 0; n < 2; ++n) acc[a][b][m][n] = (f32x4){0.f, 0.f, 0.f, 0.f};
    i32x8 At[4], B0[2], B1[2];
    unsigned gC[2][2] = {{0u, 0u}, {0u, 0u}}, gN[2][2] = {{0u, 0u}, {0u, 0u}};
    PG8_GLOAD(gC, cur);
    const char* cA = cur.A; const char* cB = cur.B;
    PG8_STAGEB(PG8_SB(0, 0), cB); PG8_STAGEB(PG8_SB(0, 1), cB + hstepB); PG8_STAGEA(PG8_SA(0, 0), cA, 0, gC); PG8_STAGEA(PG8_SA(0, 1), cA, 1, gC);
    if (wr == 1) PG8_BAR;
    PG8_WAIT_V(2); PG8_BAR;
    PG8_STAGEB(PG8_SB(1, 0), cB + kstep); PG8_STAGEA(PG8_SA(1, 0), cA + kstep, 0, gC); PG8_STAGEB(PG8_SB(1, 1), cB + hstepB + kstep);
    PG8_WAIT_V(6); PG8_BAR;
    for (;;) {
        const bool has_next = S.next(ui + 1, nxt);
        if (has_next) PG8_GLOAD(gN, nxt);
        const char* nA = has_next ? nxt.A : cA; const char* nB = has_next ? nxt.B : cB;
#pragma clang loop unroll(disable)
        for (int t = 0; t < nt; t += 2) {
            const bool last = (t == nt - 2);
            const char* a1 = cA + (size_t)(t + 1) * kstep;
            const char* a2 = last ? nA : cA + (size_t)(t + 2) * kstep; const char* b2 = last ? nB : cB + (size_t)(t + 2) * kstep;
            const char* a3 = a2 + kstep; const char* b3 = b2 + kstep;
            PG8_LDB(B0, 0, 0); PG8_LDB(B1, 0, 1); PG8_SCHED; PG8_LDA(At, 0, 0); PG8_STAGEA(PG8_SA(1, 1), a1, 1, gC);
            if (GATHER && last && has_next) {
#pragma unroll
                for (int _h = 0; _h < 2; ++_h)
#pragma unroll
                    for (int _i = 0; _i < 2; ++_i) gC[_h][_i] = gN[_h][_i];
            }
            PG8_WAIT_V(8); PG8_WAIT_L(0); PG8_BAR; PG8_MMA(0, 0, At, B0); PG8_MMA(0, 1, At, B1); PG8_BAR; PG8_SCHED;
            PG8_LDA(At, 0, 1); PG8_STAGEB(PG8_SB(0, 0), b2); PG8_STAGEB(PG8_SB(0, 1), b2 + hstepB); PG8_STAGEA(PG8_SA(0, 0), a2, 0, gC);
            PG8_WAIT_V(8); PG8_WAIT_L(0); PG8_BAR; PG8_MMA(1, 0, At, B0); PG8_MMA(1, 1, At, B1); PG8_BAR; PG8_SCHED;
            PG8_LDB(B0, 1, 0); PG8_LDB(B1, 1, 1); PG8_SCHED; PG8_LDA(At, 1, 0); PG8_STAGEA(PG8_SA(0, 1), a2, 1, gC);
            PG8_WAIT_V(8); PG8_WAIT_L(0); PG8_BAR; PG8_MMA(0, 0, At, B0); PG8_MMA(0, 1, At, B1); PG8_BAR; PG8_SCHED;
            PG8_LDA(At, 1, 1); PG8_STAGEB(PG8_SB(1, 0), b3); PG8_STAGEB(PG8_SB(1, 1), b3 + hstepB); PG8_STAGEA(PG8_SA(1, 0), a3, 0, gC);
            PG8_WAIT_V(8); PG8_WAIT_L(0); PG8_BAR; PG8_MMA(1, 0, At, B0); PG8_MMA(1, 1, At, B1); PG8_BAR; PG8_SCHED;
        }
        if (wr == 0) PG8_BAR;
        asm volatile("s_nop 15\n\ts_nop 7" ::: "memory");
        const int le_ = lane_id();
        const bool keep = E(acc, cur, wr, wc, le_ & 15, le_ >> 4);
        if (!has_next) break;
        if (!keep) {
#pragma unroll
        for (int a = 0; a < 2; ++a)
#pragma unroll
            for (int b = 0; b < 2; ++b)
#pragma unroll
                for (int m = 0; m < 4; ++m)
#pragma unroll
                    for (int n = 0; n < 2; ++n) acc[a][b][m][n] = (f32x4){0.f, 0.f, 0.f, 0.f};
        }
        cur = nxt; cA = nA; cB = nB; ++ui;
        if (wr == 1) PG8_BAR;
    }
    PG8_WAIT_V(0);
    PG8_BAR;
#undef PG8_SA
#undef PG8_SB
#undef PG8_DMA2
#undef PG8_STAGEA
#undef PG8_STAGEB
#undef PG8_LDA
#undef PG8_LDB
#undef PG8_MMA
#undef PG8_LD8
#undef PG8_LO
#undef PG8_HI
#undef PG8_WAIT_V
#undef PG8_WAIT_L
#undef PG8_BAR
#undef PG8_SCHED
#undef PG8_GLOAD
}
}
struct Args { const float* in[22]; float* out; unsigned char* ws; int ph_lo, ph_hi; };
enum { I_X = 0, I_C, I_WADA, I_BADA, I_GMIX, I_WIN, I_QNORM, I_KNORM, I_WAU, I_PLIN, I_PSCALE, I_WPU, I_WOUT, I_GFFN, I_WROUTER, I_RBIAS, I_W1, I_W3, I_W2, I_WS1, I_WS3, I_WS2 };
struct Frame {
    LAS unsigned char* lds;
    int wave, G, gw, NGW;
    unsigned char* ws; unsigned* ctl; float* out;
};
#define LDS_WAIT() asm volatile("s_waitcnt lgkmcnt(0)" ::: "memory")
#define VM_WAIT() asm volatile("s_waitcnt vmcnt(0)" ::: "memory")

__device__ __forceinline__ void tr_tile(const float* __restrict__ src, int ld_src, int nvalid, bf16_t* __restrict__ dst, int ld_dst, int lane) {
    const int q = lane >> 4, c4 = (lane & 15) * 4;
    const bool ok = c4 < nvalid;
#pragma unroll
    for (int g = 0; g < 2; ++g) {
        f32x4 v[8];
#pragma unroll
        for (int j = 0; j < 8; ++j) { const int k = 32 * g + 8 * q + j; v[j] = ok ? *(const f32x4*)(src + (size_t)k * ld_src + c4) : (f32x4){0.f, 0.f, 0.f, 0.f}; }
#pragma unroll
        for (int nn = 0; nn < 4; ++nn) {
            u32x4 w; w.x = cvt_pk_bf16(v[0][nn], v[1][nn]); w.y = cvt_pk_bf16(v[2][nn], v[3][nn]); w.z = cvt_pk_bf16(v[4][nn], v[5][nn]); w.w = cvt_pk_bf16(v[6][nn], v[7][nn]);
            *(u32x4*)(dst + (size_t)(c4 + nn) * ld_dst + 32 * g + 8 * q) = w;
        }
    }
}
__device__ __forceinline__ void tr8_issue(const float* __restrict__ src, int ld_src, int lane, f32x4 (&v)[16]) {
    const int q = lane >> 4, c4 = (lane & 15) * 4;
    const unsigned voff = (unsigned)((16 * q) * ld_src + c4) * 4u;
#pragma unroll
    for (int j = 0; j < 16; ++j) v[j] = *(const f32x4*)((const char*)src + (size_t)j * ld_src * 4 + voff);
}
__device__ __forceinline__ void tr8_finish(unsigned char* __restrict__ dst, int ld_dst, int lane, const f32x4 (&v)[16]) {
    const int q = lane >> 4, c4 = (lane & 15) * 4;
#pragma unroll
    for (int nn = 0; nn < 4; ++nn) { u32x4 w;
#pragma unroll
        for (int t = 0; t < 4; ++t) w[t] = pk4_fp8(v[4 * t][nn] * W8_SCALE, v[4 * t + 1][nn] * W8_SCALE, v[4 * t + 2][nn] * W8_SCALE, v[4 * t + 3][nn] * W8_SCALE);
        *(u32x4*)(dst + (size_t)(c4 + nn) * ld_dst + 16 * q) = w; }
}
constexpr int ADA_WGS = 6 * DM / 128;
__device__ __forceinline__ void p0_prologue(Frame& F, const Args& a) {
    LAS float* sc = (LAS float*)F.lds;
    const int lane = lane_id(), tid = F.wave * 64 + lane;
    for (int i = tid; i < NB * DM; i += NTHR) { const float c = a.in[I_C][i]; sc[i] = c / (1.0f + __expf(-c)); }
    __syncthreads();
    float* mod = (float*)(F.ctl + CW_MOD);
    unsigned char* ws = F.ws;
    for (int strip = blockIdx.x; strip < ADA_WGS; strip += F.G) {
        const int w = F.wave, col = strip * 128 + 2 * lane;
        const float* wp = a.in[I_WADA] + (size_t)(256 * w) * (6 * DM) + col;
        f32x2 a0 = {0.f, 0.f}, a1 = {0.f, 0.f};
#pragma unroll 16
        for (int k = 0; k < 256; ++k) { const f32x2 wv = *(const f32x2*)(wp + (size_t)k * (6 * DM)); const float s0 = sc[256 * w + k], s1 = sc[DM + 256 * w + k]; a0 += wv * s0; a1 += wv * s1; }
        LAS float* part = (LAS float*)(F.lds + 16384);
        *(LAS f32x2*)(part + (w * 2 + 0) * 128 + 2 * lane) = a0; *(LAS f32x2*)(part + (w * 2 + 1) * 128 + 2 * lane) = a1;
        __syncthreads();
        if (tid < 256) { const int b = tid >> 7, c = tid & 127; float sum = a.in[I_BADA][strip * 128 + c];
#pragma unroll
            for (int ww = 0; ww < 8; ++ww) sum += part[(ww * 2 + b) * 128 + c];
            mod[b * 6 * DM + strip * 128 + c] = sum; }
        __syncthreads();
    }
    bf16_t* Win_t = (bf16_t*)(ws + WS_WIN);
    constexpr int J_IN_A = 32 * 40, J_IN_B = 32 * 4, J_IN_C = 32 * 80, J_AU = 16 * 32, J_PU = 16 * 32, J_OUT = 32 * 32, J_PL = 4 * 16, J_S13 = 2 * 32 * 8, J_S2 = 8 * 32, J_WR = 32,
                  J_W13 = 0, J_W2 = 0;
    constexpr int NITEMS = J_IN_A + J_IN_B + J_IN_C + J_AU + J_PU + J_OUT + J_PL + J_S13 + J_S2 + J_WR;
    for (int it = F.gw; it < NITEMS; it += F.NGW) {
        int r = it;
        if (r < J_IN_A) { const int kb = r / 40, nb = r % 40; tr_tile(a.in[I_WIN] + (size_t)(64 * kb) * INW + 64 * nb, INW, 64, Win_t + (size_t)(64 * nb) * DM + 64 * kb, DM, lane); continue; } r -= J_IN_A;
        if (r < J_IN_B) { const int kb = r / 4, nb = r % 4; const int nv = nb == 0 ? 64 : (nb == 1 ? 16 : 0);
            tr_tile(a.in[I_WIN] + (size_t)(64 * kb) * INW + 2560 + (nb < 2 ? 64 * nb : 0), INW, nv, Win_t + (size_t)(2560 + 64 * nb) * DM + 64 * kb, DM, lane); continue; } r -= J_IN_B;
        if (r < J_IN_C) { const int kb = r / 80, nb = r % 80; tr_tile(a.in[I_WIN] + (size_t)(64 * kb) * INW + 2640 + 64 * nb, INW, 64, Win_t + (size_t)(2816 + 64 * nb) * DM + 64 * kb, DM, lane); continue; } r -= J_IN_C;
        if (r < J_AU) { const int kb = r / 32, nb = r % 32; tr_tile(a.in[I_WAU] + (size_t)(64 * kb) * DM + 64 * nb, DM, 64, (bf16_t*)(ws + WS_WAU) + (size_t)(64 * nb) * AW + 64 * kb, AW, lane); continue; } r -= J_AU;
        if (r < J_PU) { const int kb = r / 32, nb = r % 32; tr_tile(a.in[I_WPU] + (size_t)(64 * kb) * DM + 64 * nb, DM, 64, (bf16_t*)(ws + WS_WPU) + (size_t)(64 * nb) * PW + 64 * kb, PW, lane); continue; } r -= J_PU;
        if (r < J_OUT) { const int kb = r / 32, nb = r % 32; tr_tile(a.in[I_WOUT] + (size_t)(64 * kb) * DM + 64 * nb, DM, 64, (bf16_t*)(ws + WS_WOUT) + (size_t)(64 * nb) * DM + 64 * kb, DM, lane); continue; } r -= J_OUT;
        if (r < J_PL) { const int g = r / 16, kb = (r % 16) / 4, nb = r % 4; tr_tile(a.in[I_PLIN] + (size_t)g * 65536 + (size_t)(64 * kb) * 256 + 64 * nb, 256, 64, (bf16_t*)(ws + WS_PLIN) + (size_t)g * 65536 + (size_t)(64 * nb) * 256 + 64 * kb, 256, lane); continue; } r -= J_PL;
        if (r < J_S13) { const int which = r / 256, kb = (r % 256) / 8, nb = r % 8; const float* src = (which ? a.in[I_WS3] : a.in[I_WS1]) + (size_t)(64 * kb) * EH + 64 * nb;
            f32x4 v[16]; tr8_issue(src, EH, lane, v); tr8_finish(ws + WS_WS13 + (size_t)(256 * (nb >> 1) + 64 * (nb & 1) + 128 * which) * DM + 64 * kb, DM, lane, v); continue; } r -= J_S13;
        if (r < J_S2) { const int kb = r / 32, nb = r % 32; f32x4 v[16]; tr8_issue(a.in[I_WS2] + (size_t)(64 * kb) * DM + 64 * nb, DM, lane, v); tr8_finish(ws + WS_WS2 + (size_t)(64 * nb) * EH + 64 * kb, EH, lane, v); continue; } r -= J_S2;
        { const int kb = r; tr_tile(a.in[I_WROUTER] + (size_t)(64 * kb) * NE, NE, 64, (bf16_t*)(ws + WS_WR) + 64 * kb, DM, lane); }
    }
}

constexpr int NCONV_W13 = NE * 2 * 32 * 8, NCONV = NCONV_W13 + NE * 8 * 32;
__device__ __forceinline__ void conv_ptrs(const Args& a, unsigned char* ws, int it, const float*& src, int& ld_src, unsigned char*& dst, int& ld_dst) {
    if (it < NCONV_W13) { const int e = it / 512, rr = it % 512, which = rr / 256, kb = (rr % 256) / 8, nb = rr % 8;
        src = (which ? a.in[I_W3] : a.in[I_W1]) + ((size_t)e * DM + 64 * kb) * EH + 64 * nb; ld_src = EH;
        dst = ws + WS_W13 + ((size_t)e * 1024 + 256 * (nb >> 1) + 64 * (nb & 1) + 128 * which) * DM + 64 * kb; ld_dst = DM; }
    else { const int r = it - NCONV_W13, e = r / 256, kb = (r % 256) / 32, nb = r % 32;
        src = a.in[I_W2] + ((size_t)e * EH + 64 * kb) * DM + 64 * nb; ld_src = DM; dst = ws + WS_W2 + ((size_t)e * DM + 64 * nb) * EH + 64 * kb; ld_dst = EH; }
}
__device__ __forceinline__ void conv_issue16(const Args& a, unsigned char* ws, int it, int lane, f32x4 (&v)[16]) {
    const float* src; int ld_src; unsigned char* dst; int ld_dst; conv_ptrs(a, ws, it, src, ld_src, dst, ld_dst); tr8_issue(src, ld_src, lane, v); }
__device__ __forceinline__ void conv_finish16(const Args& a, unsigned char* ws, int it, int lane, const f32x4 (&v)[16]) {
    const float* src; int ld_src; unsigned char* dst; int ld_dst; conv_ptrs(a, ws, it, src, ld_src, dst, ld_dst); tr8_finish(dst, ld_dst, lane, v); }
__device__ __forceinline__ void phase_done(Frame& F, int phase) { __syncthreads(); if (F.wave == 0 && lane_id() == 0) __hip_atomic_fetch_add(F.ctl + CW_DONE + 64 * phase, 1u, __ATOMIC_RELAXED, __HIP_MEMORY_SCOPE_AGENT); }
template <bool BOUNDED>
struct ConvQ {
    Frame& F; int phase, lane; unsigned cur, end;
    __device__ __forceinline__ int next() {
        constexpr unsigned B = BOUNDED ? 2u : 8u;
        if (cur >= end) {
            if (BOUNDED) { const unsigned d = __hip_atomic_load(F.ctl + CW_DONE + 64 * phase, __ATOMIC_RELAXED, __HIP_MEMORY_SCOPE_AGENT); if ((unsigned)__builtin_amdgcn_readfirstlane(d) >= (unsigned)F.G) return -1; }
            unsigned s = 0; if (lane == 0) s = __hip_atomic_fetch_add(F.ctl + CW_CONVQ, B, __ATOMIC_RELAXED, __HIP_MEMORY_SCOPE_AGENT);
            s = __builtin_amdgcn_readfirstlane(s);
            if (s >= (unsigned)NCONV) return -1;
            cur = s; end = s + B < (unsigned)NCONV ? s + B : (unsigned)NCONV;
        }
        return (int)cur++;
    }
};
template <bool BOUNDED>
__device__ __forceinline__ void conv_drain(Frame& F, const Args& a, int phase) {
    const int lane = lane_id();
    ConvQ<BOUNDED> Q{F, phase, lane, 0u, 0u};
    f32x4 va[16], vb[16];
    int ia = Q.next(); if (ia < 0) return;
    conv_issue16(a, F.ws, ia, lane, va);
    for (;;) {
        const int ib = Q.next(); if (ib >= 0) conv_issue16(a, F.ws, ib, lane, vb);
        conv_finish16(a, F.ws, ia, lane, va);
        if (ib < 0) break;
        ia = Q.next(); if (ia >= 0) conv_issue16(a, F.ws, ia, lane, va);
        conv_finish16(a, F.ws, ib, lane, vb);
        if (ia < 0) break;
    }
}

__device__ __forceinline__ void modnorm_row(const float* __restrict__ xrow, const float* __restrict__ g, const float* __restrict__ shift, const float* __restrict__ scale, bf16_t* __restrict__ orow, int lane) {
    f32x4 v[8]; float ss = 0.f;
#pragma unroll
    for (int j = 0; j < 8; ++j) { v[j] = *(const f32x4*)(xrow + 4 * lane + 256 * j); ss += (v[j].x * v[j].x + v[j].y * v[j].y) + (v[j].z * v[j].z + v[j].w * v[j].w); }
    const float rstd = rsqrtf(wave_sum(ss) * (1.0f / DM) + NORM_EPS);
#pragma unroll
    for (int j = 0; j < 8; ++j) { const int c = 4 * lane + 256 * j;
        const f32x4 gg = *(const f32x4*)(g + c), sh = *(const f32x4*)(shift + c), sl = *(const f32x4*)(scale + c);
        const f32x4 o = v[j] * rstd * gg * (sl + 1.0f) + sh;
        u32x2 w; w.x = cvt_pk_bf16(o.x, o.y); w.y = cvt_pk_bf16(o.z, o.w);
        *(u32x2*)(orow + c) = w; }
}
__device__ __forceinline__ void p1_h(Frame& F, const Args& a) {
    const float* mod = (const float*)(F.ctl + CW_MOD);
    bf16_t* hb = (bf16_t*)(F.ws + WS_HB); const int lane = lane_id();
    for (int m = F.gw; m < NTOK; m += F.NGW) { const int b = m / SEQ;
        modnorm_row(a.in[I_X] + (size_t)m * DM, a.in[I_GMIX], mod + b * 6 * DM + 0 * DM, mod + b * 6 * DM + 1 * DM, hb + (size_t)m * DM, lane); }
}
struct SchedDense {
    pg8::TileOrder T; const char* A; const char* B; size_t a_tile, b_tile;
    __device__ __forceinline__ bool next(int i, pg8::Unit& u) const { int pm, pn; if (!T.tile(i, pm, pn)) return false; u.pm = pm; u.pn = pn; u.aux = 0; u.tok = nullptr;
        u.A = A + (size_t)pm * a_tile; u.B = B + (size_t)pn * b_tile; return true; }
};
__device__ __forceinline__ void st_bf16x8(bf16_t* p, f32x4 v0, f32x4 v1) { u32x4 w; w.x = cvt_pk_bf16(v0[0], v0[1]); w.y = cvt_pk_bf16(v0[2], v0[3]); w.z = cvt_pk_bf16(v1[0], v1[1]); w.w = cvt_pk_bf16(v1[2], v1[3]); *(u32x4*)p = w; }
struct EpiInproj {
    unsigned char* ws;
    __device__ __forceinline__ bool operator()(f32x4 (&acc)[2][2][4][2], const pg8::Unit& u, int wr, int wc, int fr, int fq) const {
        const int pn = u.pn; bf16_t* base; int ld, ct; bool sig = false;
        if (pn < 4) { base = (bf16_t*)(ws + WS_Q); ld = AW; ct = pn; }
        else if (pn == 4) { base = (bf16_t*)(ws + WS_K); ld = KVW; ct = 0; }
        else if (pn == 5) { base = (bf16_t*)(ws + WS_V); ld = KVW; ct = 0; }
        else if (pn < 10) { base = (bf16_t*)(ws + WS_QI); ld = IH * ID; ct = pn - 6; }
        else if (pn == 10) { base = (bf16_t*)(ws + WS_KW); ld = 256; ct = 0; }
        else if (pn < 15) { base = (bf16_t*)(ws + WS_U); ld = PW; ct = pn - 11; }
        else { base = (bf16_t*)(ws + WS_G); ld = 2 * DM; ct = pn - 15; sig = true; }
        const int row0 = u.pm * 256 + wr * 64 + fr, col0 = ct * 256 + wc * 32 + 8 * fq;
#pragma unroll
        for (int ai = 0; ai < 2; ++ai)
#pragma unroll
            for (int m = 0; m < 4; ++m) { bf16_t* rowp = base + (size_t)(row0 + ai * 128 + m * 16) * ld + col0;
#pragma unroll
                for (int bj = 0; bj < 2; ++bj) { f32x4 v0 = acc[ai][bj][m][0], v1 = acc[ai][bj][m][1];
                    if (sig) {
#pragma unroll
                        for (int j = 0; j < 4; ++j) { v0[j] = fminf(__builtin_amdgcn_rcpf(1.0f + __expf(-v0[j])), 1.0f); v1[j] = fminf(__builtin_amdgcn_rcpf(1.0f + __expf(-v1[j])), 1.0f); } }
                    st_bf16x8(rowp + bj * 128, v0, v1); } }
        return false;
    }
};
__device__ __forceinline__ void p2_inproj(Frame& F) {
    SchedDense S; S.T.init(NTOK, INP, F.G, (int)blockIdx.x); S.A = (const char*)(F.ws + WS_HB); S.B = (const char*)(F.ws + WS_WIN);
    S.a_tile = (size_t)256 * DM * 2; S.b_tile = (size_t)256 * DM * 2;
    EpiInproj E{F.ws};
    pg8::gemm_phase<EpiInproj, SchedDense, false>(F.lds, F.wave, DM * 2, DM * 2, S, E);
}
__device__ __forceinline__ void p3_qknorm(Frame& F, const Args& a) {
    bf16_t* Q = (bf16_t*)(F.ws + WS_Q); bf16_t* K = (bf16_t*)(F.ws + WS_K);
    const int lane = lane_id(); const float SCALE = 0.08838834764831845f;
    for (int m = F.gw; m < NTOK; m += F.NGW) {
        u32x4 q0 = *(const u32x4*)(Q + (size_t)m * AW + 16 * lane), q1 = *(const u32x4*)(Q + (size_t)m * AW + 16 * lane + 8);
        u32x2 k0 = *(const u32x2*)(K + (size_t)m * KVW + 4 * lane);
        float qv[16], kv[4]; float ss = 0.f, sk = 0.f;
#pragma unroll
        for (int j = 0; j < 4; ++j) { qv[2 * j] = bflo(q0[j]); qv[2 * j + 1] = bfhi(q0[j]); qv[8 + 2 * j] = bflo(q1[j]); qv[8 + 2 * j + 1] = bfhi(q1[j]); }
#pragma unroll
        for (int j = 0; j < 16; ++j) ss += qv[j] * qv[j];
        kv[0] = bflo(k0[0]); kv[1] = bfhi(k0[0]); kv[2] = bflo(k0[1]); kv[3] = bfhi(k0[1]);
#pragma unroll
        for (int j = 0; j < 4; ++j) sk += kv[j] * kv[j];
        ss += __shfl_xor(ss, 1); ss += __shfl_xor(ss, 2); ss += __shfl_xor(ss, 4);
        sk += __shfl_xor(sk, 1); sk += __shfl_xor(sk, 2); sk += __shfl_xor(sk, 4); sk += __shfl_xor(sk, 8); sk += __shfl_xor(sk, 16);
        const float rq = rsqrtf(ss * (1.0f / HD) + NORM_EPS) * SCALE, rk = rsqrtf(sk * (1.0f / HD) + NORM_EPS);
        const int dq = (16 * lane) & 127, dk = (4 * lane) & 127;
        float qn[16];
#pragma unroll
        for (int j = 0; j < 16; ++j) qn[j] = qv[j] * rq * a.in[I_QNORM][dq + j];
        u32x4 o0, o1;
#pragma unroll
        for (int j = 0; j < 4; ++j) { o0[j] = cvt_pk_bf16(qn[2 * j], qn[2 * j + 1]); o1[j] = cvt_pk_bf16(qn[8 + 2 * j], qn[8 + 2 * j + 1]); }
        *(u32x4*)(Q + (size_t)m * AW + 16 * lane) = o0; *(u32x4*)(Q + (size_t)m * AW + 16 * lane + 8) = o1;
        u32x2 ok; ok[0] = cvt_pk_bf16(kv[0] * rk * a.in[I_KNORM][dk], kv[1] * rk * a.in[I_KNORM][dk + 1]); ok[1] = cvt_pk_bf16(kv[2] * rk * a.in[I_KNORM][dk + 2], kv[3] * rk * a.in[I_KNORM][dk + 3]);
        *(u32x2*)(K + (size_t)m * KVW + 4 * lane) = ok;
    }
}
__device__ __forceinline__ void p3_pooled(Frame& F) {
    const bf16_t* U = (const bf16_t*)(F.ws + WS_U); bf16_t* P = (bf16_t*)(F.ws + WS_POOLED);
    const int lane = lane_id();
    for (int it = F.gw; it < (NTOK / 32) * 4; it += F.NGW) {
        const int g = it & 3, t0 = (it >> 2) * 32, pos0 = t0 % SEQ, w = 2 << g, c = 256 * g + 4 * lane;
        f32x4 W = {0.f, 0.f, 0.f, 0.f};
        for (int j = 1; j <= 16; ++j) { if (j <= w && pos0 - j >= 0) { const u32x2 v = *(const u32x2*)(U + (size_t)(t0 - j) * PW + c); W += (f32x4){bflo(v[0]), bfhi(v[0]), bflo(v[1]), bfhi(v[1])}; } }
#pragma unroll 8
        for (int i = 0; i < 32; ++i) { const int t = t0 + i, pos = pos0 + i;
            const u32x2 v = *(const u32x2*)(U + (size_t)t * PW + c); const f32x4 cur = {bflo(v[0]), bfhi(v[0]), bflo(v[1]), bfhi(v[1])};
            W += cur;
            if (pos - w >= 0) { const u32x2 o = *(const u32x2*)(U + (size_t)(t - w) * PW + c); W -= (f32x4){bflo(o[0]), bfhi(o[0]), bflo(o[1]), bfhi(o[1])}; }
            const float inv = 1.0f / (float)(pos + 1 < w ? pos + 1 : w);
            const f32x4 r = W * inv - cur;
            u32x2 ow; ow[0] = cvt_pk_bf16(r[0], r[1]); ow[1] = cvt_pk_bf16(r[2], r[3]);
            *(u32x2*)(P + (size_t)t * PW + c) = ow; }
    }
}
__device__ __forceinline__ unsigned mono_key(float s) { const unsigned u = __float_as_uint(s); return (u & 0x80000000u) ? ~u : (u | 0x80000000u); }
__device__ __forceinline__ void idx_block(Frame& F, const Args& a, int b, int i16) {
    const bf16_t* QI = (const bf16_t*)(F.ws + WS_QI); const bf16_t* KW = (const bf16_t*)(F.ws + WS_KW);
    unsigned short* MT = (unsigned short*)(F.ws + WS_MASK);
    LAS unsigned* T = (LAS unsigned*)F.lds;
    const int lane = lane_id(), w = F.wave, tid = w * 64 + lane, r32 = lane & 31, hi = lane >> 5;
    const int tpos0 = 16 * i16, t0 = b * SEQ + tpos0, nh = (tpos0 + 16 + 31) >> 5, kzero = 64 * ((tpos0 >> 6) + 1);
    for (int k = tid; k < kzero; k += NTHR) T[k] = 0u;
    bf16x8 Af[4];
    { const int qsel = (r32 >> 2) & 1, head = (r32 & 3) + 4 * (r32 >> 3); const size_t tq = (size_t)(t0 + 2 * w + qsel);
      const float wv = bf2f(KW[tq * 256 + 64 + head]);
#pragma unroll
      for (int s = 0; s < 4; ++s) { const u32x4 q = *(const u32x4*)(QI + tq * (IH * ID) + head * ID + 16 * s + 8 * hi); u32x4 o;
#pragma unroll
          for (int j = 0; j < 4; ++j) o[j] = cvt_pk_bf16(bflo(q[j]) * wv, bfhi(q[j]) * wv);
          Af[s] = __builtin_bit_cast(bf16x8, o); } }
    float X[16];
    { const size_t tq = (size_t)(t0 + 2 * w + hi); const u32x4 w0 = *(const u32x4*)(KW + tq * 256 + 64), w1 = *(const u32x4*)(KW + tq * 256 + 72);
      const float PINF = __builtin_inff();
#pragma unroll
      for (int j = 0; j < 4; ++j) { X[2 * j] = bflo(w0[j]) >= 0.f ? PINF : -PINF; X[2 * j + 1] = bfhi(w0[j]) >= 0.f ? PINF : -PINF;
                                    X[8 + 2 * j] = bflo(w1[j]) >= 0.f ? PINF : -PINF; X[8 + 2 * j + 1] = bfhi(w1[j]) >= 0.f ? PINF : -PINF; } }
    const int mypos = tpos0 + 2 * w + hi;
    unsigned keys[128];
    const __amdgpu_buffer_rsrc_t krs = __builtin_amdgcn_make_buffer_rsrc((void*)(KW + (size_t)b * SEQ * 256), 0, SEQ * 256 * 2, 0x00020000);
    const int kvoff = r32 * 512 + hi * 16;
    u32x4 Bn[4];
#pragma unroll
    for (int s = 0; s < 4; ++s) Bn[s] = __builtin_amdgcn_raw_buffer_load_b128(krs, kvoff + 32 * s, 0, 0);
#pragma unroll
    for (int n = 0; n < 128; ++n) {
        keys[n] = 0u;
        if (n < nh) {
            u32x4 Bc[4];
#pragma unroll
            for (int s = 0; s < 4; ++s) Bc[s] = Bn[s];
            if (n + 1 < nh) {
#pragma unroll
                for (int s = 0; s < 4; ++s) Bn[s] = __builtin_amdgcn_raw_buffer_load_b128(krs, kvoff + 32 * s, (n + 1) * 16384, 0);
            }
            f32x16 acc = {0.f, 0.f, 0.f, 0.f, 0.f, 0.f, 0.f, 0.f, 0.f, 0.f, 0.f, 0.f, 0.f, 0.f, 0.f, 0.f};
#pragma unroll
            for (int s = 0; s < 4; ++s) acc = __builtin_amdgcn_mfma_f32_32x32x16_bf16(Af[s], __builtin_bit_cast(bf16x8, Bc[s]), acc, 0, 0, 0);
            float sc = 0.f;
#pragma unroll
            for (int j = 0; j < 16; ++j) sc += __builtin_amdgcn_fmed3f(acc[j], 0.f, X[j]);
            keys[n] = (32 * n + r32 <= mypos) ? mono_key(sc) : 0u;
        }
    }
    unsigned T0 = 0u, T1 = 0u; bool done0 = false, done1 = false;
    for (int bit = 31; bit >= 0; --bit) {
        const unsigned c0 = T0 | (1u << bit), c1 = T1 | (1u << bit), cand = hi ? c1 : c0;
        unsigned cnt = 0;
#pragma unroll
        for (int n8 = 0; n8 < 16; ++n8) { if (n8 * 8 < nh) {
#pragma unroll
            for (int j = 0; j < 8; ++j) cnt += (keys[n8 * 8 + j] >= cand) ? 1u : 0u; } }
        cnt += __shfl_xor(cnt, 1); cnt += __shfl_xor(cnt, 2); cnt += __shfl_xor(cnt, 4); cnt += __shfl_xor(cnt, 8); cnt += __shfl_xor(cnt, 16);
        const unsigned n0 = __builtin_amdgcn_readlane(cnt, 0), n1 = __builtin_amdgcn_readlane(cnt, 32);
        if (!done0 && n0 >= (unsigned)TOPK) { T0 = c0; if (n0 == (unsigned)TOPK) done0 = true; }
        if (!done1 && n1 >= (unsigned)TOPK) { T1 = c1; if (n1 == (unsigned)TOPK) done1 = true; }
        if (done0 && done1) break;
    }
    { const unsigned Tsel = hi ? T1 : T0, Tf = Tsel > 1u ? Tsel : 1u;
      __syncthreads();
#pragma unroll
      for (int n = 0; n < 128; ++n) { if (n < nh) {
          unsigned bitv = keys[n] >= Tf ? 1u : 0u; const unsigned other = __shfl_xor(bitv, 32);
          bitv |= other << 1;
          if (hi == 0 && bitv) __hip_atomic_fetch_or(T + 32 * n + r32, bitv << (2 * w), __ATOMIC_RELAXED, __HIP_MEMORY_SCOPE_WORKGROUP); } }
    }
    __syncthreads();
    { const int rg = (b * SEQ + tpos0) >> 5, f = i16 & 1;
      for (int k = tid; k < kzero; k += NTHR) { const int kk = k & 63, p = (kk & ~7) | ((kk & 3) << 1) | ((kk >> 2) & 1);
          MT[((size_t)(rg * 64 + (k >> 6)) * 64 + p) * 2 + f] = (unsigned short)(T[k] & 0xffffu); } }
    __syncthreads();
}
__device__ __forceinline__ void p3_indexer(Frame& F, const Args& a) {
    for (int v2 = 2 * blockIdx.x; v2 < 512; v2 += 2 * F.G) { for (int ps = 0; ps < 2; ++ps) { const int v = v2 >> 1, b = v >> 7, i = v & 127; idx_block(F, a, b, ps ? 255 - i : i); } }
}
namespace att {
constexpr int KVBLK = 64, SHM_V = KVBLK * HD * 2, SHM_K = KVBLK * HD * 2;
constexpr int LDS_V = 0, LDS_K = 2 * SHM_V, LDS_WS = 2 * SHM_V + 2 * SHM_K, LDS_BYTES = LDS_WS + NWAVES * 64 * 4;
constexpr float THR = 8.f, LOG2E = 1.4426950408889634f;
#define KSWZ(row, colB) ((row) * 256 + ((colB) ^ (((row) & 7) << 4)))
#define SBAR() __builtin_amdgcn_sched_barrier(0)
__device__ __forceinline__ int v_st(int k, int c) { const int kk = (k & ~0xC) | ((k & 4) << 1) | ((k & 8) >> 1); return ((kk >> 3) * 4 + (c >> 5)) * 512 + ((kk & 7) * 32 + (c & 31)) * 2; }
__device__ __forceinline__ int v_rd_base(int lane) { return ((lane & 3) << 3) | (((lane >> 2) & 3) << 6) | (((lane >> 4) & 1) << 5) | (((lane >> 5) & 1) << 8); }
constexpr int v_rd_off(int d0, int ks, int half) { return d0 * 512 + ks * 4096 + half * 2048; }
__device__ __forceinline__ int crow(int r, int hi) { return (r & 3) + 8 * (r >> 2) + 4 * hi; }
__device__ __forceinline__ void partialSM(f32x16& p0, f32x16& p1, float& m_reg, float& mn, float& alpha) {
    float pmax = p0[0];
#pragma unroll
    for (int r = 1; r < 16; ++r) pmax = fmaxf(pmax, p0[r]);
#pragma unroll
    for (int r = 0; r < 16; ++r) pmax = fmaxf(pmax, p1[r]);
    { auto rr = __builtin_amdgcn_permlane32_swap(__float_as_uint(pmax), __float_as_uint(pmax), false, false);
      pmax = fmaxf(__uint_as_float(rr[0]), __uint_as_float(rr[1])); }
    if (__builtin_expect(__all((pmax - m_reg) <= THR), 1)) { mn = m_reg; alpha = 1.f; }
    else { mn = fmaxf(m_reg, pmax); alpha = __builtin_amdgcn_exp2f((m_reg - mn) * LOG2E); m_reg = mn; }
    const float mnL = -mn * LOG2E;
#pragma unroll
    for (int r = 0; r < 16; ++r) p0[r] = fmaf(p0[r], LOG2E, mnL);
#pragma unroll
    for (int r = 0; r < 16; ++r) p1[r] = fmaf(p1[r], LOG2E, mnL);
#pragma unroll
    for (int r = 0; r < 16; ++r) p0[r] = __builtin_amdgcn_exp2f(p0[r]);
}
__device__ __forceinline__ void finishSM(f32x16& p0, f32x16& p1, float alpha, float& l_reg, bf16x8& pa0, bf16x8& pa1, bf16x8& pa2, bf16x8& pa3) {
#pragma unroll
    for (int r = 0; r < 16; ++r) p1[r] = __builtin_amdgcn_exp2f(p1[r]);
    float ps = 0;
#pragma unroll
    for (int r = 0; r < 16; ++r) ps += p0[r];
#pragma unroll
    for (int r = 0; r < 16; ++r) ps += p1[r];
    { auto rr = __builtin_amdgcn_permlane32_swap(__float_as_uint(ps), __float_as_uint(ps), false, false);
      ps = __uint_as_float(rr[0]) + __uint_as_float(rr[1]); }
    l_reg = l_reg * alpha + ps;
#define PK4(P, B_, OUT) do { unsigned a0 = cvt_pk_bf16(P[B_+0], P[B_+1]), a1 = cvt_pk_bf16(P[B_+2], P[B_+3]);                          \
        unsigned b0 = cvt_pk_bf16(P[B_+4], P[B_+5]), b1 = cvt_pk_bf16(P[B_+6], P[B_+7]);                                             \
        auto r0 = __builtin_amdgcn_permlane32_swap(a0, b0, false, false); auto r1 = __builtin_amdgcn_permlane32_swap(a1, b1, false, false); \
        u32x4 w = {r0[0], r1[0], r0[1], r1[1]}; OUT = __builtin_bit_cast(bf16x8, w); } while (0)
    PK4(p0, 0, pa0); PK4(p0, 8, pa1); PK4(p1, 0, pa2); PK4(p1, 8, pa3);
#undef PK4
}
template <int KB>
__device__ __forceinline__ void qkt(f32x16& p0, f32x16& p1, const LAS char* K_lds, int r32, int hi, const bf16x8* qr, bf16x8 kf0, bf16x8 kf1, bf16x8 qf) {
    p0 = __builtin_amdgcn_mfma_f32_32x32x16_bf16(kf0, qf, (f32x16){0.f, 0.f, 0.f, 0.f, 0.f, 0.f, 0.f, 0.f, 0.f, 0.f, 0.f, 0.f, 0.f, 0.f, 0.f, 0.f}, 0, 0, 0);
    p1 = __builtin_amdgcn_mfma_f32_32x32x16_bf16(kf1, qf, (f32x16){0.f, 0.f, 0.f, 0.f, 0.f, 0.f, 0.f, 0.f, 0.f, 0.f, 0.f, 0.f, 0.f, 0.f, 0.f, 0.f}, 0, 0, 0);
    const LAS char* kb[4];
#pragma unroll
    for (int dd = 0; dd < 4; ++dd) kb[dd] = K_lds + KB * SHM_K + KSWZ(r32, (dd * 16 + hi * 8) * 2);
#pragma unroll
    for (int d0 = 0; d0 < 8; ++d0) { const LAS char* ap = kb[d0 & 3] + (d0 >> 2) * 128;
        bf16x8 b0 = *(const LAS bf16x8*)(ap);
        bf16x8 b1 = *(const LAS bf16x8*)(ap + 32 * 256);
        p0 = __builtin_amdgcn_mfma_f32_32x32x16_bf16(b0, qr[d0], p0, 0, 0, 0);
        p1 = __builtin_amdgcn_mfma_f32_32x32x16_bf16(b1, qr[d0], p1, 0, 0, 0); }
}
template <int VB>
__device__ __forceinline__ void pv_tile(f32x16* o, int vb0, bf16x8 pa0, bf16x8 pa1, bf16x8 pa2, bf16x8 pa3) {
#define TRRD(dst, off) asm volatile("ds_read_b64_tr_b16 %0, %1 offset:%2" : "=&v"(dst) : "v"(vb0), "i"(off) : "memory")
#define PV_D0(d0) do { s16x4 l0, l1, l2, l3, h0, h1, h2, h3; constexpr int b_ = VB * SHM_V + v_rd_off(d0, 0, 0); \
        TRRD(l0, b_); TRRD(h0, b_ + 2048); TRRD(l1, b_ + 4096); TRRD(h1, b_ + 6144); TRRD(l2, b_ + 8192); TRRD(h2, b_ + 10240); TRRD(l3, b_ + 12288); TRRD(h3, b_ + 14336); \
        asm volatile("s_waitcnt lgkmcnt(0)" ::: "memory"); SBAR();   \
        o[d0] = __builtin_amdgcn_mfma_f32_32x32x16_bf16(pa0, (bf16x8){l0[0], l0[1], l0[2], l0[3], h0[0], h0[1], h0[2], h0[3]}, o[d0], 0, 0, 0);   \
        o[d0] = __builtin_amdgcn_mfma_f32_32x32x16_bf16(pa1, (bf16x8){l1[0], l1[1], l1[2], l1[3], h1[0], h1[1], h1[2], h1[3]}, o[d0], 0, 0, 0);   \
        o[d0] = __builtin_amdgcn_mfma_f32_32x32x16_bf16(pa2, (bf16x8){l2[0], l2[1], l2[2], l2[3], h2[0], h2[1], h2[2], h2[3]}, o[d0], 0, 0, 0);   \
        o[d0] = __builtin_amdgcn_mfma_f32_32x32x16_bf16(pa3, (bf16x8){l3[0], l3[1], l3[2], l3[3], h3[0], h3[1], h3[2], h3[3]}, o[d0], 0, 0, 0); } while (0)
    PV_D0(0); PV_D0(1); PV_D0(2); PV_D0(3);
#undef PV_D0
#undef TRRD
}
typedef const __attribute__((address_space(4))) unsigned long long* cmask_t;
__device__ __forceinline__ void mask_tile(f32x16& p0, f32x16& p1, const unsigned long long* mpg) {
    const float NEG = -__builtin_inff();
    cmask_t mp = (cmask_t)mpg;
    asm volatile("s_nop 15\n\ts_nop 7" : "+v"(p0), "+v"(p1));
#pragma unroll
    for (int r = 0; r < 16; ++r) { const unsigned long long m0 = mp[r], m1 = mp[16 + r];
        asm volatile("v_cndmask_b32 %0, %1, %0, %2" : "+v"(p0[r]) : "v"(NEG), "s"(m0));
        asm volatile("v_cndmask_b32 %0, %1, %0, %2" : "+v"(p1[r]) : "v"(NEG), "s"(m1)); }
}
template <int BUF>
__device__ __forceinline__ void tile_step(f32x16* o, float& m_reg, float& l_reg, const LAS char* K_lds, int vb0, LAS float* al_l, int r32, int hi, const bf16x8* qr,
                                          int kb_key, bf16x8 qf, const unsigned long long* mp) {
    f32x16 p0, p1; float mn, alpha; bf16x8 pa0, pa1, pa2, pa3;
    const unsigned kbb = __float_as_uint((float)kb_key) >> 16, k0b = __float_as_uint((float)r32) >> 16, k1b = __float_as_uint((float)(r32 + 32)) >> 16;
    u32x4 f0 = {hi ? 0u : (kbb | (k0b << 16)), 0u, 0u, 0u}, f1 = {hi ? 0u : (kbb | (k1b << 16)), 0u, 0u, 0u};
    qkt<BUF>(p0, p1, K_lds, r32, hi, qr, __builtin_bit_cast(bf16x8, f0), __builtin_bit_cast(bf16x8, f1), qf);
    mask_tile(p0, p1, mp);
    partialSM(p0, p1, m_reg, mn, alpha);
    finishSM(p0, p1, alpha, l_reg, pa0, pa1, pa2, pa3);
    if (__any(alpha < 1.f)) { if (hi == 0) al_l[r32] = alpha; asm volatile("s_waitcnt lgkmcnt(0)" ::: "memory");
#pragma unroll
        for (int r = 0; r < 16; ++r) { const float av = al_l[crow(r, hi)];
#pragma unroll
            for (int d_ = 0; d_ < 4; ++d_) o[d_][r] *= av; } }
    pv_tile<BUF>(o, vb0, pa0, pa1, pa2, pa3);
}
__device__ __forceinline__ void attn_unit(Frame& F, int b, int g, int qb) {
    const bf16_t* Q = (const bf16_t*)(F.ws + WS_Q); const bf16_t* K = (const bf16_t*)(F.ws + WS_K); const bf16_t* V = (const bf16_t*)(F.ws + WS_V);
    bf16_t* O = (bf16_t*)(F.ws + WS_ATTN); const unsigned long long* MT = (const unsigned long long*)(F.ws + WS_MASK);
    LAS char* lds = (LAS char*)F.lds;
    const int wid = F.wave, lane = lane_id(), tid = wid * 64 + lane, r32 = lane & 31, hi = lane >> 5;
    const int hq = wid >> 1, th = wid & 1, h = 4 * g + hq, tok0 = b * SEQ + 64 * qb + 32 * th, NT = qb + 1;
    LAS char* V_lds = lds + LDS_V; LAS char* K_lds = lds + LDS_K; LAS float* wsf = (LAS float*)(lds + LDS_WS) + wid * 64; LAS float* li_l = wsf; LAS float* al_l = wsf + 32;
    const int sr = tid >> 4, sc = (tid & 15) * 8, vst0 = v_st(sr, sc), vst1 = v_st(32 + sr, sc), kws = KSWZ(sr, sc * 2);
    const int vb0 = (int)(uintptr_t)V_lds + v_rd_base(lane);
    bf16x8 qr[8];
#pragma unroll
    for (int d0 = 0; d0 < 8; ++d0) qr[d0] = *(const bf16x8*)(Q + (size_t)(tok0 + r32) * AW + h * HD + d0 * 16 + hi * 8);
    const unsigned sb = __float_as_uint(__builtin_ldexpf(1.0f, -(h + 1))) >> 16;
    const u32x4 qfw = {hi ? 0u : (sb | (sb << 16)), 0u, 0u, 0u}; const bf16x8 qf = __builtin_bit_cast(bf16x8, qfw);
    const bf16_t* Kg = K + (size_t)(b * SEQ) * KVW + g * HD + sc; const bf16_t* Vg = V + (size_t)(b * SEQ) * KVW + g * HD + sc;
    const unsigned long long* mrow = MT + (size_t)__builtin_amdgcn_readfirstlane(tok0 >> 5) * 64 * 32;
    float m_reg = -1e30f, l_reg = 0.f; f32x16 o[4] = {};
    bf16x8 st_k0, st_k1, st_v0, st_v1;
#define SLOAD(k0) do { st_k0 = *(const bf16x8*)(Kg + (size_t)((k0) + sr) * KVW); st_k1 = *(const bf16x8*)(Kg + (size_t)((k0) + 32 + sr) * KVW); \
                       st_v0 = *(const bf16x8*)(Vg + (size_t)((k0) + sr) * KVW); st_v1 = *(const bf16x8*)(Vg + (size_t)((k0) + 32 + sr) * KVW); } while (0)
#define SWRITE(bf) do { *(LAS bf16x8*)(K_lds + (bf) * SHM_K + kws) = st_k0; *(LAS bf16x8*)(K_lds + (bf) * SHM_K + kws + 32 * 256) = st_k1; \
                        *(LAS bf16x8*)(V_lds + (bf) * SHM_V + vst0) = st_v0; *(LAS bf16x8*)(V_lds + (bf) * SHM_V + vst1) = st_v1; } while (0)
    SLOAD(0); SWRITE(0);
    __syncthreads();
    for (int t = 0; t < NT; t += 2) {
        if (t + 1 < NT) SLOAD((t + 1) * KVBLK);
        tile_step<0>(o, m_reg, l_reg, K_lds, vb0, al_l, r32, hi, qr, t * KVBLK, qf, mrow + (size_t)t * 32);
        if (t + 1 < NT) SWRITE(1);
        __syncthreads();
        if (t + 1 < NT) {
            if (t + 2 < NT) SLOAD((t + 2) * KVBLK);
            tile_step<1>(o, m_reg, l_reg, K_lds, vb0, al_l, r32, hi, qr, (t + 1) * KVBLK, qf, mrow + (size_t)(t + 1) * 32);
            if (t + 2 < NT) SWRITE(0);
            __syncthreads();
        }
    }
#undef SLOAD
#undef SWRITE
    if (hi == 0) li_l[r32] = l_reg; asm volatile("s_waitcnt lgkmcnt(0)" ::: "memory");
    bf16_t* Ow = O + (size_t)tok0 * AW + h * HD;
#pragma unroll
    for (int r = 0; r < 16; ++r) { const int orow = crow(r, hi); const float rl = __builtin_amdgcn_rcpf(li_l[orow]);
#pragma unroll
        for (int d0 = 0; d0 < 4; ++d0) { const float v = o[d0][r] * rl; const float vn = __shfl_xor(v, 1);
            if ((r32 & 1) == 0) *(unsigned*)(Ow + (size_t)orow * AW + d0 * 32 + r32) = cvt_pk_bf16(v, vn); } }
    __syncthreads();
}
#undef KSWZ
#undef SBAR
}
struct SchedPool {
    const char* A; const char* B; int c;
    __device__ __forceinline__ bool next(int i, pg8::Unit& u) const { if (i > 0 || c >= 128) return false; const int rt = c >> 2, g = c & 3; u.pm = rt; u.pn = g; u.aux = 0; u.tok = nullptr;
        u.A = A + ((size_t)rt * 256 * PW + g * 256) * 2; u.B = B + (size_t)g * 65536 * 2; return true; }
};
struct EpiPool {
    bf16_t* out; const float* pscale;
    __device__ __forceinline__ bool operator()(f32x4 (&acc)[2][2][4][2], const pg8::Unit& u, int wr, int wc, int fr, int fq) const {
        const int row0 = u.pm * 256 + wr * 64 + fr, col0 = u.pn * 256 + wc * 32 + 8 * fq;
#pragma unroll
        for (int bj = 0; bj < 2; ++bj) { const f32x4 s0 = *(const f32x4*)(pscale + col0 + bj * 128), s1 = *(const f32x4*)(pscale + col0 + bj * 128 + 4);
#pragma unroll
            for (int ai = 0; ai < 2; ++ai)
#pragma unroll
                for (int m = 0; m < 4; ++m) st_bf16x8(out + (size_t)(row0 + ai * 128 + m * 16) * PW + col0 + bj * 128, acc[ai][bj][m][0] * s0, acc[ai][bj][m][1] * s1); }
        return false;
    }
};
__device__ __forceinline__ void p4_pool_attn(Frame& F, const Args& a) {
    for (int c = blockIdx.x; c < 256; c += F.G) {
        const int bg = c >> 6, qb = c & 63;
        if (qb < 32) { SchedPool S{(const char*)(F.ws + WS_POOLED), (const char*)(F.ws + WS_PLIN), bg * 32 + qb}; EpiPool E{(bf16_t*)(F.ws + WS_POOL), a.in[I_PSCALE]};
            pg8::gemm_phase<EpiPool, SchedPool, false>(F.lds, F.wave, 256 * 2, PW * 2, S, E); __syncthreads(); }
        att::attn_unit(F, bg >> 1, bg & 1, qb);
    }
}
struct SchedMerge {
    pg8::TileOrder T; const char* A0; const char* B0; const char* A1; const char* B1;
    __device__ __forceinline__ bool next(int i, pg8::Unit& u) const { int pm, pn; if (!T.tile(i >> 1, pm, pn)) return false; u.pm = pm; u.pn = pn; u.aux = i & 1; u.tok = nullptr;
        u.A = ((i & 1) ? A1 : A0) + (size_t)pm * 256 * 1024 * 2; u.B = ((i & 1) ? B1 : B0) + (size_t)pn * 256 * 1024 * 2; return true; }
};
struct EpiMerge {
    const bf16_t* G; bf16_t* out;
    __device__ __forceinline__ bool operator()(f32x4 (&acc)[2][2][4][2], const pg8::Unit& u, int wr, int wc, int fr, int fq) const {
        const int row0 = u.pm * 256 + wr * 64 + fr, col0 = u.pn * 256 + wc * 32 + 8 * fq;
#pragma unroll
        for (int ai = 0; ai < 2; ++ai)
#pragma unroll
            for (int m = 0; m < 4; ++m) { const size_t r = (size_t)(row0 + ai * 128 + m * 16);
#pragma unroll
                for (int bj = 0; bj < 2; ++bj) { const int c = col0 + bj * 128;
                    const u32x4 gp = *(const u32x4*)(G + r * (2 * DM) + DM + c);
                    const f32x4 p0 = {bflo(gp[0]), bfhi(gp[0]), bflo(gp[1]), bfhi(gp[1])}, p1 = {bflo(gp[2]), bfhi(gp[2]), bflo(gp[3]), bfhi(gp[3])};
                    if (u.aux == 0) { const u32x4 ga = *(const u32x4*)(G + r * (2 * DM) + c);
                        const f32x4 a0 = {bflo(ga[0]), bfhi(ga[0]), bflo(ga[1]), bfhi(ga[1])}, a1 = {bflo(ga[2]), bfhi(ga[2]), bflo(ga[3]), bfhi(ga[3])};
#pragma unroll
                        for (int j = 0; j < 4; ++j) { acc[ai][bj][m][0][j] *= a0[j] * __builtin_amdgcn_rcpf(fmaxf(p0[j], 1e-30f)); acc[ai][bj][m][1][j] *= a1[j] * __builtin_amdgcn_rcpf(fmaxf(p1[j], 1e-30f)); } }
                    else st_bf16x8(out + r * DM + c, acc[ai][bj][m][0] * p0, acc[ai][bj][m][1] * p1); } }
        return u.aux == 0;
    }
};
__device__ __forceinline__ void p5_merge(Frame& F) {
    SchedMerge S; S.T.init(NTOK, DM, F.G, (int)blockIdx.x); S.A0 = (const char*)(F.ws + WS_ATTN); S.B0 = (const char*)(F.ws + WS_WAU); S.A1 = (const char*)(F.ws + WS_POOL); S.B1 = (const char*)(F.ws + WS_WPU);
    EpiMerge E{(const bf16_t*)(F.ws + WS_G), (bf16_t*)(F.ws + WS_MERGED)};
    pg8::gemm_phase<EpiMerge, SchedMerge, false>(F.lds, F.wave, 1024 * 2, 1024 * 2, S, E);
}
struct EpiOut {
    const float* x; const float* mod; float* out;
    __device__ __forceinline__ bool operator()(f32x4 (&acc)[2][2][4][2], const pg8::Unit& u, int wr, int wc, int fr, int fq) const {
        const int row0 = u.pm * 256 + wr * 64 + fr, col0 = u.pn * 256 + wc * 32 + 8 * fq; const int b = (u.pm * 256) / SEQ;
        const float* gm = mod + b * 6 * DM + 2 * DM;
#pragma unroll
        for (int bj = 0; bj < 2; ++bj) { const int c = col0 + bj * 128; const f32x4 g0 = *(const f32x4*)(gm + c), g1 = *(const f32x4*)(gm + c + 4);
#pragma unroll
            for (int ai = 0; ai < 2; ++ai)
#pragma unroll
                for (int m = 0; m < 4; ++m) { const size_t o = (size_t)(row0 + ai * 128 + m * 16) * DM + c;
                    const f32x4 x0 = *(const f32x4*)(x + o), x1 = *(const f32x4*)(x + o + 4);
                    *(f32x4*)(out + o) = x0 + g0 * acc[ai][bj][m][0]; *(f32x4*)(out + o + 4) = x1 + g1 * acc[ai][bj][m][1]; } }
        return false;
    }
};
__device__ __forceinline__ void p6_out(Frame& F, const Args& a) {
    SchedDense S; S.T.init(NTOK, DM, F.G, (int)blockIdx.x); S.A = (const char*)(F.ws + WS_MERGED); S.B = (const char*)(F.ws + WS_WOUT);
    S.a_tile = (size_t)256 * DM * 2; S.b_tile = (size_t)256 * DM * 2;
    EpiOut E{a.in[I_X], (const float*)(F.ctl + CW_MOD), F.out};
    pg8::gemm_phase<EpiOut, SchedDense, false>(F.lds, F.wave, DM * 2, DM * 2, S, E);
}
constexpr int P7_ROWB = 4096 + 16;
constexpr int P7_LDS_P = 16 * P7_ROWB;
constexpr int P7_LDS_H = P7_LDS_P + 2 * 16 * 64 * 4;
__device__ __forceinline__ void p7_router(Frame& F, const Args& a) {
    const float* mod = (const float*)(F.ctl + CW_MOD);
    unsigned char* hb8 = F.ws + WS_HB; const bf16_t* Wr = (const bf16_t*)(F.ws + WS_WR);
    unsigned char* rt = F.ws + WS_ROUTE;
    int* eid = (int*)(rt + RT_EID); float* gate = (float*)(rt + RT_GATE); int* posn = (int*)(rt + RT_POS); int* list = (int*)(rt + RT_LIST); int* ident = (int*)(rt + RT_IDENT);
    unsigned* ecnt = F.ctl + CW_ECNT;
    LAS unsigned char* lds = F.lds; LAS float* P = (LAS float*)(lds + P7_LDS_P); LAS unsigned* hist = (LAS unsigned*)(lds + P7_LDS_H); LAS unsigned* baseL = hist + 64;
    const int lane = lane_id(), w = F.wave, tid = w * 64 + lane;
    if (tid < 64) hist[tid] = 0u;
    __syncthreads();
    for (int p = blockIdx.x; p < NTOK / 16; p += F.G) {
        const int row0 = 16 * p;
#pragma unroll
        for (int rr = 0; rr < 2; ++rr) { const int lr = 2 * w + rr, m = row0 + lr, b = m / SEQ;
            const float* xrow = F.out + (size_t)m * DM; const float* sh = mod + b * 6 * DM + 3 * DM; const float* sl = mod + b * 6 * DM + 4 * DM;
            f32x4 v[8]; float ss = 0.f;
#pragma unroll
            for (int j = 0; j < 8; ++j) { v[j] = *(const f32x4*)(xrow + 4 * lane + 256 * j); ss += (v[j].x * v[j].x + v[j].y * v[j].y) + (v[j].z * v[j].z + v[j].w * v[j].w); }
            const float rstd = rsqrtf(wave_sum(ss) * (1.0f / DM) + NORM_EPS);
#pragma unroll
            for (int j = 0; j < 8; ++j) { const int c = 4 * lane + 256 * j;
                const f32x4 gg = *(const f32x4*)(a.in[I_GFFN] + c), shv = *(const f32x4*)(sh + c), slv = *(const f32x4*)(sl + c);
                const f32x4 o = v[j] * rstd * gg * (slv + 1.0f) + shv;
                u32x2 wv; wv.x = cvt_pk_bf16(o.x, o.y); wv.y = cvt_pk_bf16(o.z, o.w);
                *(unsigned*)(hb8 + (size_t)m * DM + c) = pk4_fp8(o.x, o.y, o.z, o.w); *(LAS u32x2*)(lds + lr * P7_ROWB + c * 2) = wv; }
            if (lane == 0) ident[m] = m;
        }
        __syncthreads();
        { const int nb = w & 3, kh = w >> 2, fr = lane & 15, kq = lane >> 4;
          f32x4 acc = {0.f, 0.f, 0.f, 0.f};
          const bf16_t* wp = Wr + (size_t)(16 * nb + fr) * DM + 1024 * kh + 8 * kq;
          const LAS unsigned char* ap = lds + fr * P7_ROWB + (1024 * kh + 8 * kq) * 2;
#pragma unroll 8
          for (int s = 0; s < 32; ++s) { const bf16x8 bv = *(const bf16x8*)(wp + 32 * s); const bf16x8 av = *(const LAS bf16x8*)(ap + 64 * s);
              acc = __builtin_amdgcn_mfma_f32_16x16x32_bf16(av, bv, acc, 0, 0, 0); }
#pragma unroll
          for (int j = 0; j < 4; ++j) P[(kh * 16 + 4 * kq + j) * 64 + 16 * nb + fr] = acc[j];
        }
        __syncthreads();
        int myrank[2]; unsigned mylocal[2]; bool chosen[2]; float mygate[2];
#pragma unroll
        for (int rr = 0; rr < 2; ++rr) { const int lr = 2 * w + rr;
            const float logit = P[lr * 64 + lane] + P[(16 + lr) * 64 + lane];
            const float score = 1.0f / (1.0f + __expf(-logit)); const float sel = score + a.in[I_RBIAS][lane];
            float m1 = sel; m1 = fmaxf(m1, __shfl_xor(m1, 1)); m1 = fmaxf(m1, __shfl_xor(m1, 2)); m1 = fmaxf(m1, __shfl_xor(m1, 4));
            const unsigned long long bm = __ballot(sel == m1); const unsigned grp = (unsigned)((bm >> (lane & ~7)) & 0xffull); const int first = __builtin_ctz(grp | 0x100u);
            float m2 = ((lane & 7) == first) ? -__builtin_inff() : sel; m2 = fmaxf(m2, __shfl_xor(m2, 1)); m2 = fmaxf(m2, __shfl_xor(m2, 2)); m2 = fmaxf(m2, __shfl_xor(m2, 4));
            const float gs = m1 + m2; const int g = lane >> 3; int grank = 0;
#pragma unroll
            for (int g2 = 0; g2 < 8; ++g2) { const float o = __uint_as_float(__builtin_amdgcn_readlane(__float_as_uint(gs), 8 * g2)); grank += (o > gs || (o == gs && g2 < g)) ? 1 : 0; }
            const float selm = grank < TOPG ? sel : -__builtin_inff(); int rank = 0;
#pragma unroll
            for (int e2 = 0; e2 < 64; ++e2) { const float o = __uint_as_float(__builtin_amdgcn_readlane(__float_as_uint(selm), e2)); rank += (o > selm || (o == selm && e2 < lane)) ? 1 : 0; }
            const bool ch = rank < ETOP && grank < TOPG; const float gsum = wave_sum(ch ? score : 0.f);
            chosen[rr] = ch; myrank[rr] = rank; mygate[rr] = score / gsum * ROUTED_SCALE;
            mylocal[rr] = ch ? __hip_atomic_fetch_add(hist + lane, 1u, __ATOMIC_RELAXED, __HIP_MEMORY_SCOPE_WORKGROUP) : 0u;
        }
        __syncthreads();
        if (w == 0) { const unsigned c = hist[lane]; baseL[lane] = c ? __hip_atomic_fetch_add(ecnt + lane, c, __ATOMIC_RELAXED, __HIP_MEMORY_SCOPE_AGENT) : 0u; hist[lane] = 0u; }
        __syncthreads();
#pragma unroll
        for (int rr = 0; rr < 2; ++rr) if (chosen[rr]) { const int m = row0 + 2 * w + rr; const unsigned pos = baseL[lane] + mylocal[rr];
            eid[m * 8 + myrank[rr]] = lane; gate[m * 8 + myrank[rr]] = mygate[rr]; posn[m * 8 + myrank[rr]] = (int)pos; list[(size_t)lane * NTOK + pos] = m; }
        __syncthreads();
    }
}
constexpr int MOE_LDS = 131072;
__device__ __forceinline__ int moe_prefix(Frame& F) {
    LAS int* rtoff = (LAS int*)(F.lds + MOE_LDS);
    if (F.wave == 0 && lane_id() == 0) { int s = 0; for (int e = 0; e < NE; ++e) { rtoff[e] = s; unsigned n = F.ctl[CW_ECNT + e]; if (n > (unsigned)NTOK) n = NTOK; s += (int)((n + 255u) >> 8); } rtoff[NE] = s; }
    __syncthreads();
    return __builtin_amdgcn_readfirstlane(rtoff[NE]);
}
__device__ __forceinline__ int moe_find(const LAS int* rtoff, int rtg) {
    int lo = 0, hi = NE;
#pragma unroll
    for (int it = 0; it < 6; ++it) { const int mid = (lo + hi) >> 1; const int v = __builtin_amdgcn_readfirstlane(rtoff[mid]); if (v <= rtg) lo = mid; else hi = mid; }
    return lo;
}
struct SchedMoe1 {
    const LAS int* rtoff; int RT, G, c; const char* hb; const char* w13; const char* ws13; const int* list; const int* ident;
    __device__ __forceinline__ bool next(int i, pg8::Unit& u) const {
        const int idx = i * G + c; if (idx >= (RT + NTOK / 256) * 4) return false;
        const int rtg = idx >> 2, ct = idx & 3; u.pn = ct; u.aux = 0; u.A = hb;
        if (rtg < RT) { const int e = moe_find(rtoff, rtg), rt = rtg - __builtin_amdgcn_readfirstlane(rtoff[e]); u.pm = rtg; u.tok = list + (size_t)e * NTOK + rt * 256;
            u.B = w13 + ((size_t)e * 1024 + ct * 256) * DM; }
        else { const int rt = rtg - RT; u.pm = HROWS_R / 256 + rt; u.tok = ident + rt * 256; u.B = ws13 + (size_t)(ct * 256) * DM; }
        return true; }
};
struct EpiMoe1 {
    unsigned char* H;
    __device__ __forceinline__ bool operator()(f32x4 (&acc)[2][2][4][2], const pg8::Unit& u, int wr, int wc, int fr, int fq) const {
        const int row0 = u.pm * 256 + wr * 64 + fr, col0 = u.pn * 128 + wc * 32 + 8 * fq;
#pragma unroll
        for (int ai = 0; ai < 2; ++ai)
#pragma unroll
            for (int m = 0; m < 4; ++m) { f32x4 h0, h1;
#pragma unroll
                for (int j = 0; j < 4; ++j) { const float g0 = acc[ai][0][m][0][j], g1 = acc[ai][0][m][1][j];
                    h0[j] = g0 * __builtin_amdgcn_rcpf(1.0f + __expf(-g0)) * acc[ai][1][m][0][j]; h1[j] = g1 * __builtin_amdgcn_rcpf(1.0f + __expf(-g1)) * acc[ai][1][m][1][j]; }
                u32x2 w; w.x = pk4_fp8(h0[0] * H8_SCALE, h0[1] * H8_SCALE, h0[2] * H8_SCALE, h0[3] * H8_SCALE); w.y = pk4_fp8(h1[0] * H8_SCALE, h1[1] * H8_SCALE, h1[2] * H8_SCALE, h1[3] * H8_SCALE);
                *(u32x2*)(H + (size_t)(row0 + ai * 128 + m * 16) * EH + col0) = w; }
        return false;
    }
};
__device__ __forceinline__ void p8_gemm1(Frame& F) {
    const int RT = moe_prefix(F);
    SchedMoe1 S{(const LAS int*)(F.lds + MOE_LDS), RT, F.G, (int)blockIdx.x, (const char*)(F.ws + WS_HB), (const char*)(F.ws + WS_W13), (const char*)(F.ws + WS_WS13),
                (const int*)(F.ws + WS_ROUTE + RT_LIST), (const int*)(F.ws + WS_ROUTE + RT_IDENT)};
    EpiMoe1 E{F.ws + WS_H};
    pg8::gemm_phase<EpiMoe1, SchedMoe1, true, 1, 127, W8_E8>(F.lds, F.wave, DM, DM, S, E);
}
struct SchedMoe2 {
    const LAS int* rtoff; int RT, G, c; const char* H; const char* w2;
    __device__ __forceinline__ bool next(int i, pg8::Unit& u) const {
        const int idx = i * G + c; if (idx >= RT * 8) return false;
        const int rtg = idx >> 3, ct = idx & 7, e = moe_find(rtoff, rtg); u.pm = rtg; u.pn = ct; u.aux = 0; u.tok = nullptr;
        u.A = H + (size_t)rtg * 256 * EH; u.B = w2 + ((size_t)e * DM + ct * 256) * EH; return true; }
};
struct EpiY {
    bf16_t* Y;
    __device__ __forceinline__ bool operator()(f32x4 (&acc)[2][2][4][2], const pg8::Unit& u, int wr, int wc, int fr, int fq) const {
        const int row0 = u.pm * 256 + wr * 64 + fr, col0 = u.pn * 256 + wc * 32 + 8 * fq;
#pragma unroll
        for (int ai = 0; ai < 2; ++ai)
#pragma unroll
            for (int m = 0; m < 4; ++m)
#pragma unroll
                for (int bj = 0; bj < 2; ++bj) st_bf16x8(Y + (size_t)(row0 + ai * 128 + m * 16) * DM + col0 + bj * 128, acc[ai][bj][m][0], acc[ai][bj][m][1]);
        return false;
    }
};
__device__ __forceinline__ void p9_gemm2(Frame& F) {
    const int RT = moe_prefix(F);
    SchedMoe2 S{(const LAS int*)(F.lds + MOE_LDS), RT, F.G, (int)blockIdx.x, (const char*)(F.ws + WS_H), (const char*)(F.ws + WS_W2)};
    EpiY E{(bf16_t*)(F.ws + WS_Y)};
    pg8::gemm_phase<EpiY, SchedMoe2, false, 1, H8_E8, W8_E8>(F.lds, F.wave, EH, EH, S, E);
}
struct EpiFinal {
    const LAS int* rtoff; const bf16_t* Y; const int* eid; const float* gate; const int* posn; const float* mod; float* out;
    __device__ __forceinline__ bool operator()(f32x4 (&acc)[2][2][4][2], const pg8::Unit& u, int wr, int wc, int fr, int fq) const {
        const int row0 = u.pm * 256 + wr * 64 + fr, col0 = u.pn * 256 + wc * 32 + 8 * fq; const int b = (u.pm * 256) / SEQ;
        const float* gf = mod + b * 6 * DM + 5 * DM;
#pragma unroll
        for (int ai = 0; ai < 2; ++ai)
#pragma unroll
            for (int m = 0; m < 4; ++m) { const int t = row0 + ai * 128 + m * 16;
                const u32x4 e0 = *(const u32x4*)(eid + t * 8), e1 = *(const u32x4*)(eid + t * 8 + 4), p0 = *(const u32x4*)(posn + t * 8), p1 = *(const u32x4*)(posn + t * 8 + 4);
                const f32x4 g0 = *(const f32x4*)(gate + t * 8), g1 = *(const f32x4*)(gate + t * 8 + 4);
                f32x4 s[2][2] = {{acc[ai][0][m][0], acc[ai][0][m][1]}, {acc[ai][1][m][0], acc[ai][1][m][1]}};
#pragma unroll
                for (int k = 0; k < 8; ++k) { const unsigned e = k < 4 ? e0[k & 3] : e1[k & 3], p = k < 4 ? p0[k & 3] : p1[k & 3]; const float gk = k < 4 ? g0[k & 3] : g1[k & 3];
                    const size_t yr = (size_t)(256 * rtoff[e & 63] + (int)p);
#pragma unroll
                    for (int bj = 0; bj < 2; ++bj) { const u32x4 y = *(const u32x4*)(Y + yr * DM + col0 + bj * 128);
                        s[bj][0] += (f32x4){bflo(y[0]), bfhi(y[0]), bflo(y[1]), bfhi(y[1])} * gk; s[bj][1] += (f32x4){bflo(y[2]), bfhi(y[2]), bflo(y[3]), bfhi(y[3])} * gk; } }
#pragma unroll
                for (int bj = 0; bj < 2; ++bj) { const int c = col0 + bj * 128; const size_t o = (size_t)t * DM + c;
                    const f32x4 x0 = *(const f32x4*)(out + o), x1 = *(const f32x4*)(out + o + 4), f0 = *(const f32x4*)(gf + c), f1 = *(const f32x4*)(gf + c + 4);
                    *(f32x4*)(out + o) = x0 + f0 * s[bj][0]; *(f32x4*)(out + o + 4) = x1 + f1 * s[bj][1]; } }
        return false;
    }
};
__device__ __forceinline__ void p10_final(Frame& F) {
    (void)moe_prefix(F);
    SchedDense S; S.T.init(NTOK, DM, F.G, (int)blockIdx.x); S.A = (const char*)(F.ws + WS_H) + (size_t)HROWS_R * EH; S.B = (const char*)(F.ws + WS_WS2);
    S.a_tile = (size_t)256 * EH; S.b_tile = (size_t)256 * EH;
    unsigned char* rt = F.ws + WS_ROUTE;
    EpiFinal E{(const LAS int*)(F.lds + MOE_LDS), (const bf16_t*)(F.ws + WS_Y), (const int*)(rt + RT_EID), (const float*)(rt + RT_GATE), (const int*)(rt + RT_POS), (const float*)(F.ctl + CW_MOD), F.out};
    pg8::gemm_phase<EpiFinal, SchedDense, false, 1, H8_E8, W8_E8>(F.lds, F.wave, EH, EH, S, E);
}
constexpr int LDS_BYTES = 147456;
constexpr int N_PHASES = 11;
#ifndef PROBE_REP
#define PROBE_REP -1
#endif
#define REP(k, stmt) do { stmt; if (PROBE_REP == (k)) { __syncthreads(); stmt; } } while (0)
__global__ void __launch_bounds__(NTHR, 2) fwd(Args args) {
    extern __shared__ __attribute__((aligned(16))) unsigned char lds_raw[];
    Frame F; F.lds = (LAS unsigned char*)lds_raw; F.wave = __builtin_amdgcn_readfirstlane((int)threadIdx.x >> 6);
    F.G = gridDim.x; F.gw = blockIdx.x * NWAVES + F.wave; F.NGW = F.G * NWAVES; F.ws = args.ws; F.ctl = (unsigned*)(args.ws + WS_CTL); F.out = args.out;
    volatile LAS unsigned* xbw = (volatile LAS unsigned*)(F.lds + LDS_BYTES - 16);
    if (threadIdx.x < 4) xbw[threadIdx.x] = 0u;
    __syncthreads();
    const bool one = (args.ph_hi - args.ph_lo) > 1;
    XcdBarrier bar; bar.bar = F.ctl + CW_BAR; bar.x = 0; bar.st = xbw;
    if (one) bar = xcd_barrier_post(F.ctl + CW_BAR, xbw, F.wave);
    const int lo = args.ph_lo, hi = args.ph_hi;
#define IN(k) (lo <= (k) && (k) < hi)
#define SEAM(k) do { if (IN(k) && IN((k) + 1)) xcd_barrier(bar, F.wave); } while (0)
    if (IN(0)) { REP(0, p0_prologue(F, args)); } SEAM(0);
    if (IN(1)) { REP(1, p1_h(F, args)); } SEAM(1);
    if (IN(2)) { REP(2, p2_inproj(F)); if (one) { phase_done(F, 2); conv_drain<true>(F, args, 2); } } SEAM(2);
    if (IN(3)) { p3_qknorm(F, args); p3_pooled(F); __syncthreads(); REP(3, p3_indexer(F, args)); } SEAM(3);
    if (IN(4)) { REP(4, p4_pool_attn(F, args)); if (one) { phase_done(F, 4); conv_drain<true>(F, args, 4); } } SEAM(4);
    if (IN(5)) { REP(5, p5_merge(F)); } SEAM(5);
    if (IN(6)) { REP(6, p6_out(F, args)); } SEAM(6);
    if (IN(7)) { p7_router(F, args); conv_drain<false>(F, args, 7); } SEAM(7);
    if (IN(8)) { REP(8, p8_gemm1(F)); } SEAM(8);
    if (IN(9)) { REP(9, p9_gemm2(F)); } SEAM(9);
    if (IN(10)) { p10_final(F); }
#undef IN
#undef SEAM
}
#ifndef N_LAUNCHES
#define N_LAUNCHES 1
#endif
extern "C" void kernel_launch(void* const* d_in, const int* in_sizes, int n_in, void* d_out, int out_size, void* d_ws, size_t ws_size, hipStream_t stream) {
    static int grid = 0;
    if (grid == 0) {
        if (n_in != 22 || out_size != NTOK * DM || ws_size < WS_END) { fprintf(stderr, "kernel_launch: unexpected shapes (n_in %d out %d ws %zu need %zu)\n", n_in, out_size, ws_size, (size_t)WS_END); grid = -1; return; }
        int dev = 0, cus = 0, per_cu = 0;
        if (hipGetDevice(&dev) != hipSuccess || hipDeviceGetAttribute(&cus, hipDeviceAttributeMultiprocessorCount, dev) != hipSuccess) { grid = -1; return; }
        if (hipFuncSetAttribute((const void*)fwd, hipFuncAttributeMaxDynamicSharedMemorySize, LDS_BYTES) != hipSuccess) { fprintf(stderr, "kernel_launch: hipFuncSetAttribute failed\n"); grid = -1; return; }
        if (hipOccupancyMaxActiveBlocksPerMultiprocessor(&per_cu, (const void*)fwd, NTHR, LDS_BYTES) != hipSuccess || per_cu < 1) fprintf(stderr, "kernel_launch: occupancy query says %d\n", per_cu);
        (void)hipGetLastError();
        grid = cus;
    }
    if (grid < 0) return;
    (void)hipMemsetAsync((char*)d_ws + WS_CTL, 0, CTL_BYTES, stream);
    Args a{};
    for (int i = 0; i < 22; ++i) a.in[i] = (const float*)d_in[i];
    a.out = (float*)d_out; a.ws = (unsigned char*)d_ws;
    if (N_LAUNCHES == 1) { a.ph_lo = 0; a.ph_hi = N_PHASES; hipLaunchKernelGGL(fwd, dim3(grid), dim3(NTHR), LDS_BYTES, stream, a); }
    else for (int p = 0; p < N_PHASES; ++p) { a.ph_lo = p; a.ph_hi = p + 1; hipLaunchKernelGGL(fwd, dim3(grid), dim3(NTHR), LDS_BYTES, stream, a); }
}
```

```cpp
#include <hip/hip_runtime.h>
#include <cstdio>
#include <cstdint>

#define LAS __attribute__((address_space(3)))
#define GAS __attribute__((address_space(1)))
typedef unsigned short bf16_t;
typedef short bf16x8 __attribute__((ext_vector_type(8)));
typedef short s16x4 __attribute__((ext_vector_type(4)));
typedef float f32x4 __attribute__((ext_vector_type(4)));
typedef float f32x2 __attribute__((ext_vector_type(2)));
typedef float f32x16 __attribute__((ext_vector_type(16)));
typedef unsigned u32x4 __attribute__((ext_vector_type(4)));
typedef unsigned u32x2 __attribute__((ext_vector_type(2)));

constexpr int DM = 2048, NB = 2, SEQ = 4096, NTOK = NB * SEQ;
constexpr int NH = 8, HD = 128, NKV = 2, AW = 1024, KVW = 256, IH = 16, ID = 64, TOPK = 256;
constexpr int PW = 1024, INW = 7760, INP = 7936;
constexpr int NE = 64, EH = 512, NGRP = 8, EPG = 8, TOPG = 4, ETOP = 8;
constexpr float NORM_EPS = 1e-6f, ROUTED_SCALE = 2.5f;
constexpr int NTHR = 512, NWAVES = 8;

constexpr size_t MiB = 1u << 20;
constexpr size_t WS_CTL = 0, CTL_BYTES = 1 * MiB;
constexpr size_t WS_W13 = 1 * MiB;
constexpr size_t WS_W2 = WS_W13 + 256 * MiB;
constexpr size_t WS_WS13 = WS_W2 + 128 * MiB;
constexpr size_t WS_WS2 = WS_WS13 + 4 * MiB;
constexpr size_t WS_H = WS_WS2 + 2 * MiB;
constexpr int HROWS_R = 65536 + 64 * 256, HROWS = HROWS_R + NTOK;
constexpr size_t WS_ROUTE = WS_H + (size_t)HROWS * EH * 2;
constexpr size_t RT_EID = 0, RT_GATE = RT_EID + (size_t)NTOK * 8 * 4, RT_POS = RT_GATE + (size_t)NTOK * 8 * 4, RT_LIST = RT_POS + (size_t)NTOK * 8 * 4,
                 RT_IDENT = RT_LIST + (size_t)NE * NTOK * 4, RT_END = RT_IDENT + (size_t)NTOK * 4;
constexpr size_t WS_R = (WS_ROUTE + RT_END + MiB - 1) / MiB * MiB;
constexpr size_t WS_Y = WS_R;
constexpr size_t WS_WIN = WS_R;
constexpr size_t WS_WAU = WS_WIN + 31 * MiB, WS_WPU = WS_WAU + 4 * MiB, WS_WOUT = WS_WPU + 4 * MiB, WS_PLIN = WS_WOUT + 8 * MiB, WS_WR = WS_PLIN + MiB / 2;
constexpr size_t WS_HB = WS_WR + MiB / 2;
constexpr size_t WS_Q = WS_HB + 32 * MiB, WS_K = WS_Q + 16 * MiB, WS_V = WS_K + 4 * MiB, WS_QI = WS_V + 4 * MiB, WS_KW = WS_QI + 16 * MiB, WS_U = WS_KW + 4 * MiB,
                 WS_G = WS_U + 16 * MiB;
constexpr size_t WS_POOLED = WS_G + 64 * MiB, WS_POOL = WS_POOLED + 16 * MiB, WS_ATTN = WS_POOL + 16 * MiB, WS_MERGED = WS_ATTN + 16 * MiB, WS_MASK = WS_MERGED + 32 * MiB,
                 WS_H8 = WS_MASK + 4 * MiB,
                 WS_REND = WS_H8 + 32 * MiB;
constexpr size_t WS_END = WS_Y + (size_t)HROWS_R * DM * 2;
static_assert(WS_REND <= WS_END, "overlay region");
constexpr int CW_BAR = 4096;
constexpr int CW_ECNT = 8192;
constexpr int CW_CONVQ = 12288;
constexpr int CW_DONE = 12544;
constexpr int CW_MOD = 16384;
static_assert((CW_MOD + 2 * 6 * DM) * 4 <= (int)CTL_BYTES, "ctl");

__device__ __forceinline__ int lane_id() { int l; asm volatile("v_mbcnt_lo_u32_b32 %0, -1, 0\n\tv_mbcnt_hi_u32_b32 %0, -1, %0" : "=v"(l)); return l; }
__device__ __forceinline__ unsigned cvt_pk_bf16(float lo, float hi) { unsigned r; asm volatile("v_cvt_pk_bf16_f32 %0, %1, %2" : "=v"(r) : "v"(lo), "v"(hi)); return r; }
__device__ __forceinline__ unsigned pk4_fp8(float a, float b, float c, float d) {
    a = __builtin_amdgcn_fmed3f(a, -448.f, 448.f); b = __builtin_amdgcn_fmed3f(b, -448.f, 448.f); c = __builtin_amdgcn_fmed3f(c, -448.f, 448.f); d = __builtin_amdgcn_fmed3f(d, -448.f, 448.f);
    int w = __builtin_amdgcn_cvt_pk_fp8_f32(a, b, 0, false); w = __builtin_amdgcn_cvt_pk_fp8_f32(c, d, w, true); return (unsigned)w; }
#ifndef FP8_INPROJ
#define FP8_INPROJ 0
#endif
#ifndef FP8_MERGE
#define FP8_MERGE 1
#endif
#ifndef FP8_OUT
#define FP8_OUT 1
#endif
constexpr float W8_SCALE = 8.f;   constexpr int W8_E8 = 127 - 3;
constexpr float H8_SCALE = 8.f;   constexpr int H8_E8 = 127 - 3;
constexpr float A8_SCALE = 8.f;   constexpr int A8_E8 = 127 - 3;
__device__ __forceinline__ float bf2f(unsigned short b) { return __uint_as_float(((unsigned)b) << 16); }
__device__ __forceinline__ float bflo(unsigned w) { return __uint_as_float(w << 16); }
__device__ __forceinline__ float bfhi(unsigned w) { return __uint_as_float(w & 0xffff0000u); }
__device__ __forceinline__ float wave_sum(float v) {
#pragma unroll
    for (int o = 1; o < 64; o <<= 1) v += __shfl_xor(v, o);
    return v;
}
__device__ __forceinline__ float sigmoidf_(float x) { return 1.0f / (1.0f + __expf(-x)); }

#define XB_TMO      128
#define XB_XCNT(j)  (256  + 64 * (j))
#define XB_XSUB(j)  (1280 + 64 * (j))
#define XB_XGEN(j)  (2304 + 64 * (j))
#define XB_TOP      3328
#define XB_TOPGEN   3392
#define XCD_BAR_WORDS 3456
#define XB_SPIN_CAP (1u << 18)
__device__ __forceinline__ unsigned xb_ld(unsigned* p)              { return __hip_atomic_load(p, __ATOMIC_RELAXED, __HIP_MEMORY_SCOPE_AGENT); }
__device__ __forceinline__ unsigned xb_add(unsigned* p, unsigned v) { return __hip_atomic_fetch_add(p, v, __ATOMIC_RELAXED, __HIP_MEMORY_SCOPE_AGENT); }
__device__ __forceinline__ unsigned xb_xcc_id() { return (unsigned)__builtin_amdgcn_s_getreg((3 << 11) | 20) & 0xFu; }
#define XB_SPIN(cond, bar) do { unsigned _sp = 0; while (cond) { __builtin_amdgcn_s_sleep(1); \
    if ((++_sp & 255u) == 0u) { if (xb_ld(&(bar)[XB_TMO])) break; if (_sp > XB_SPIN_CAP) { atomicAdd(&(bar)[XB_TMO], 1u); break; } } } } while (0)
struct XcdBarrier { unsigned* bar; unsigned x; volatile LAS unsigned* st; };
__device__ __forceinline__ XcdBarrier xcd_barrier_post(unsigned* bar, volatile LAS unsigned* st, int wave) {
    XcdBarrier b; b.bar = bar; b.x = xb_xcc_id(); b.st = st;
    if (wave == 0 && lane_id() == 0) (void)xb_add(&bar[XB_XCNT(b.x)], 1u);
    return b;
}
__device__ __forceinline__ void xcd_barrier_complete(unsigned* bar, unsigned x, unsigned& nloc, unsigned& nx) {
    const unsigned G = gridDim.x * gridDim.y * gridDim.z;
    unsigned sum, cnt, mine, sp = 0u;
    for (;;) {
        sum = 0u; cnt = 0u; mine = 0u;
#pragma unroll
        for (unsigned j = 0; j < 16; ++j) { const unsigned c = xb_ld(&bar[XB_XCNT(j)]); sum += c; cnt += (c > 0u) ? 1u : 0u; mine = (j == x) ? c : mine; }
        if (sum == G) break;
        __builtin_amdgcn_s_sleep(1);
        if ((++sp & 255u) == 0u) { if (xb_ld(&bar[XB_TMO])) break; if (sp > XB_SPIN_CAP) { atomicAdd(&bar[XB_TMO], 1u); break; } }
    }
    nloc = mine > 0u ? mine : 1u; nx = cnt > 0u ? cnt : 1u;
}
__device__ __forceinline__ void xcd_barrier(const XcdBarrier& b, int wave) {
    asm volatile("s_waitcnt vmcnt(0)" ::: "memory");
    __syncthreads();
    if (wave == 0 && lane_id() == 0) {
        unsigned* bar = b.bar;
        __builtin_amdgcn_s_waitcnt(0);
        unsigned nloc = b.st[0], nx = b.st[1];
        if (nloc == 0u) { xcd_barrier_complete(bar, b.x, nloc, nx); b.st[0] = nloc; b.st[1] = nx; }
        const unsigned old = xb_add(&bar[XB_XSUB(b.x)], 1u);
        const unsigned gen = old / nloc;
        if (old + 1u == (gen + 1u) * nloc) {
            __builtin_amdgcn_fence(__ATOMIC_RELEASE, "agent");
            asm volatile("s_waitcnt vmcnt(0)" ::: "memory");
            const unsigned og = xb_add(&bar[XB_TOP], 1u);
            const unsigned tg = og / nx;
            if (og + 1u == (tg + 1u) * nx) xb_add(&bar[XB_TOPGEN], 1u);
            else XB_SPIN(xb_ld(&bar[XB_TOPGEN]) == tg, bar);
            __builtin_amdgcn_fence(__ATOMIC_ACQUIRE, "agent");
            xb_add(&bar[XB_XGEN(b.x)], 1u);
            asm volatile("s_waitcnt vmcnt(0)" ::: "memory");
        } else {
            XB_SPIN(xb_ld(&bar[XB_XGEN(b.x)]) == gen, bar);
            __builtin_amdgcn_fence(__ATOMIC_ACQUIRE, "agent");
            asm volatile("s_waitcnt vmcnt(0)" ::: "memory");
        }
    }
    __syncthreads();
}
namespace pg8 {
constexpr int BM = 256, BK = 64, HALF = 128, HTB = HALF * BK * 2, STAGE_BYTES = 8 * HTB, NXCD = 8, WGM = 8;
__host__ __device__ __forceinline__ int lds_byte(int r, int c) { const int st = (r >> 4) * 2 + (c >> 5), rr = r & 15, cc = c & 31, ob = rr * 64 + cc * 2; return st * 1024 + (ob ^ (((ob >> 9) & 1) << 5)); }
__host__ __device__ __forceinline__ void stage_rc(int b, int& R, int& C) { const int st = b / 1024, sb = b % 1024, swz = sb ^ (((sb >> 9) & 1) << 5); R = (st >> 1) * 16 + swz / 64; C = (st & 1) * 32 + (swz % 64) / 2; }
__host__ __device__ __forceinline__ int perm32(int rho) { const int n = rho >> 4, i = rho & 15; return 8 * (i >> 2) + 4 * n + (i & 3); }

struct Unit { const char* A; const char* B; const int* tok; int pm, pn, aux; int nt8; };

struct TileOrder {
    int nM, nN, nwg, G, c;
    __device__ void init(int M, int N, int G_, int c_) { nM = M / BM; nN = N / BM; nwg = nM * nN; G = G_; c = c_; }
    __device__ bool tile(int i, int& pm, int& pn) const {
        const long L = (long)i * G + c; if (L >= nwg) return false;
        int wgid = (int)L; { const int q = nwg / NXCD, r = nwg % NXCD, xcd = wgid % NXCD, off = wgid / NXCD; wgid = (xcd < r ? xcd * (q + 1) : r * (q + 1) + (xcd - r) * q) + off; }
        const int nig = WGM * nN, gid = wgid / nig, fm = gid * WGM, gsz = (nM - fm) < WGM ? (nM - fm) : WGM;
        pm = fm + ((wgid % nig) % gsz); pn = (wgid % nig) / gsz; return true;
    }
};

typedef int i32x8 __attribute__((ext_vector_type(8)));
template <class Epi, class Sched, bool GATHER, int ES = 2, int SCA = 127, int SCB = 127, bool MIXED = false>
__device__ __forceinline__ void gemm_phase(LAS unsigned char* lds, const int wid, const int Kb, const int ldab, const Sched& S, const Epi& E, const int nt_ovr = 0) {
    const int lane = lane_id(), tid = wid * 64 + lane, wr = wid >> 2, wc = wid & 3, fr = lane & 15, fq = lane >> 4;
    const int nt = nt_ovr ? nt_ovr : Kb / (BK * 2);
    unsigned voffA[2], voffB[2];
#pragma unroll
    for (int i = 0; i < 2; ++i) { int R, C; stage_rc(tid * 16 + i * 8192, R, C); const int Rb = (R & ~31) + perm32(R & 31);
        voffA[i] = (unsigned)(R * ldab + C * 2); voffB[i] = (unsigned)(Rb * Kb + C * 2); }
    const size_t kstep = (size_t)(BK * 2);
    const size_t hstepA = (size_t)HALF * ldab, hstepB = (size_t)HALF * Kb;
    const unsigned ldsw = (unsigned)wid * 1024u;
    const int aoff = (ES == 2 || MIXED) ? lds_byte(wr * 64 + fr, fq * 8) : lds_byte(wr * 64 + fr, fq * 16), boff = (ES == 2 || MIXED) ? lds_byte(wc * 32 + fr, fq * 8) : lds_byte(wc * 32 + fr, fq * 16);
    constexpr int OFF1 = (ES == 2 || MIXED) ? 1024 : 16;
#define PG8_SA(b, h) (((b) * 2 + (h)) * HTB)
#define PG8_SB(b, h) ((4 + (b) * 2 + (h)) * HTB)
    const unsigned ldsbase = (unsigned)(uintptr_t)lds + ldsw;
#define PG8_DMA2(bufoff, sbase, voff_, i_) do { unsigned keep_; asm volatile("s_mov_b32 %0, m0\n\ts_mov_b32 m0, %3\n\ts_nop 0\n\tglobal_load_lds_dwordx4 %1, %2\n\ts_mov_b32 m0, %0" \
        : "=&s"(keep_) : "v"(voff_), "s"(sbase), "s"(ldsbase + (unsigned)((bufoff) + (i_) * 8192)) : "memory"); } while (0)
#define PG8_STAGEB(bufoff, gbase) do { _Pragma("unroll") for (int _i = 0; _i < 2; ++_i) PG8_DMA2(bufoff, (const char*)(gbase), voffB[_i], _i); } while (0)
#define PG8_STAGEA(bufoff, kt, h, GO) do { _Pragma("unroll") for (int _i = 0; _i < 2; ++_i) { \
        if constexpr (GATHER) PG8_DMA2(bufoff, (const char*)(kt), GO[h][_i], _i); else PG8_DMA2(bufoff, (const char*)(kt) + (h) * hstepA, voffA[_i], _i); } } while (0)
#define PG8_LD8(p0, p1) __builtin_bit_cast(i32x8, __builtin_shufflevector(*(const LAS u32x4*)(p0), *(const LAS u32x4*)(p1), 0, 1, 2, 3, 4, 5, 6, 7))
#define PG8_LDA(dst, b, h) do { _Pragma("unroll") for (int m = 0; m < 4; ++m) dst[m] = PG8_LD8(lds + PG8_SA(b, h) + aoff + m * 2048, lds + PG8_SA(b, h) + aoff + OFF1 + m * 2048); } while (0)
#define PG8_LDB(dst, b, h) do { _Pragma("unroll") for (int n = 0; n < 2; ++n) dst[n] = PG8_LD8(lds + PG8_SB(b, h) + boff + n * 2048, lds + PG8_SB(b, h) + boff + OFF1 + n * 2048); } while (0)
#define PG8_LO(x) __builtin_bit_cast(bf16x8, __builtin_shufflevector(x, x, 0, 1, 2, 3))
#define PG8_HI(x) __builtin_bit_cast(bf16x8, __builtin_shufflevector(x, x, 4, 5, 6, 7))
#define PG8_MMA16(ai, bj, At, Bt) do { _Pragma("unroll") for (int m = 0; m < 4; ++m) _Pragma("unroll") for (int n = 0; n < 2; ++n) { \
        acc[ai][bj][m][n] = __builtin_amdgcn_mfma_f32_16x16x32_bf16(PG8_LO(Bt[n]), PG8_LO(At[m]), acc[ai][bj][m][n], 0, 0, 0); \
        acc[ai][bj][m][n] = __builtin_amdgcn_mfma_f32_16x16x32_bf16(PG8_HI(Bt[n]), PG8_HI(At[m]), acc[ai][bj][m][n], 0, 0, 0); } } while (0)
#define PG8_MMA8(ai, bj, At, Bt) do { _Pragma("unroll") for (int m = 0; m < 4; ++m) _Pragma("unroll") for (int n = 0; n < 2; ++n) \
        acc[ai][bj][m][n] = __builtin_amdgcn_mfma_scale_f32_16x16x128_f8f6f4(Bt[n], At[m], acc[ai][bj][m][n], 0, 0, 0, SCB * 0x01010101, 0, SCA * 0x01010101); } while (0)
#define PG8_MMA(ai, bj, At, Bt) do { __builtin_amdgcn_s_setprio(1); \
        if constexpr (MIXED) { if (cur8) PG8_MMA8(ai, bj, At, Bt); else PG8_MMA16(ai, bj, At, Bt); } \
        else if constexpr (ES == 2) PG8_MMA16(ai, bj, At, Bt); else PG8_MMA8(ai, bj, At, Bt); \
        __builtin_amdgcn_s_setprio(0); } while (0)
#define PG8_WAIT_V(n) asm volatile("s_waitcnt vmcnt(" #n ")" ::: "memory")
#define PG8_WAIT_L(n) asm volatile("s_waitcnt lgkmcnt(" #n ")" ::: "memory")
#define PG8_BAR __builtin_amdgcn_s_barrier()
#define PG8_SCHED __builtin_amdgcn_sched_barrier(0)
#define PG8_GLOAD(GO, u) do { if constexpr (GATHER) { const int _tid = wid * 64 + lane_id(); _Pragma("unroll") for (int _i = 0; _i < 2; ++_i) { int _R, _C; stage_rc(_tid * 16 + _i * 8192, _R, _C); \
        _Pragma("unroll") for (int _h = 0; _h < 2; ++_h) { unsigned _t = (unsigned)(u).tok[_h * HALF + _R]; _t = _t < (unsigned)NTOK ? _t : (unsigned)(NTOK - 1); GO[_h][_i] = _t * (unsigned)ldab + (unsigned)_C * 2u; } } } } while (0)
    Unit cur, nxt; int ui = 0;
    if (!S.next(0, cur)) return;
    f32x4 acc[2][2][4][2];
#pragma unroll
    for (int a = 0; a < 2; ++a)
#pragma unroll
        for (int b = 0; b < 2; ++b)
#pragma unroll
            for (int m = 0; m < 4; ++m)
#pragma unroll
                for (int n = 0; n < 2; ++n) acc[a][b][m][n] = (f32x4){0.f, 0.f, 0.f, 0.f};
    i32x8 At[4], B0[2], B1[2];
    unsigned gC[2][2] = {{0u, 0u}, {0u, 0u}}, gN[2][2] = {{0u, 0u}, {0u, 0u}};
    PG8_GLOAD(gC, cur);
    const char* cA = cur.A; const char* cB = cur.B;
    bool cur8 = MIXED && cur.nt8 > 0; int ntc = cur8 ? cur.nt8 : nt;
    PG8_STAGEB(PG8_SB(0, 0), cB); PG8_STAGEB(PG8_SB(0, 1), cB + hstepB); PG8_STAGEA(PG8_SA(0, 0), cA, 0, gC); PG8_STAGEA(PG8_SA(0, 1), cA, 1, gC);
    if (wr == 1) PG8_BAR;
    PG8_WAIT_V(2); PG8_BAR;
    PG8_STAGEB(PG8_SB(1, 0), cB + kstep); PG8_STAGEA(PG8_SA(1, 0), cA + kstep, 0, gC); PG8_STAGEB(PG8_SB(1, 1), cB + hstepB + kstep);
    PG8_WAIT_V(6); PG8_BAR;
    for (;;) {
        const bool has_next = S.next(ui + 1, nxt);
        if (has_next) PG8_GLOAD(gN, nxt);
        const char* nA = has_next ? nxt.A : cA; const char* nB = has_next ? nxt.B : cB;
#pragma clang loop unroll(disable)
        for (int t = 0; t < ntc; t += 2) {
            const bool last = (t == ntc - 2);
            const char* a1 = cA + (size_t)(t + 1) * kstep;
            const char* a2 = last ? nA : cA + (size_t)(t + 2) * kstep; const char* b2 = last ? nB : cB + (size_t)(t + 2) * kstep;
            const char* a3 = a2 + kstep; const char* b3 = b2 + kstep;
            PG8_LDB(B0, 0, 0); PG8_LDB(B1, 0, 1); PG8_SCHED; PG8_LDA(At, 0, 0); PG8_STAGEA(PG8_SA(1, 1), a1, 1, gC);
            if (GATHER && last && has_next) {
#pragma unroll
                for (int _h = 0; _h < 2; ++_h)
#pragma unroll
                    for (int _i = 0; _i < 2; ++_i) gC[_h][_i] = gN[_h][_i];
            }
            PG8_WAIT_V(8); PG8_WAIT_L(0); PG8_BAR; PG8_MMA(0, 0, At, B0); PG8_MMA(0, 1, At, B1); PG8_BAR; PG8_SCHED;
            PG8_LDA(At, 0, 1); PG8_STAGEB(PG8_SB(0, 0), b2); PG8_STAGEB(PG8_SB(0, 1), b2 + hstepB); PG8_STAGEA(PG8_SA(0, 0), a2, 0, gC);
            PG8_WAIT_V(8); PG8_WAIT_L(0); PG8_BAR; PG8_MMA(1, 0, At, B0); PG8_MMA(1, 1, At, B1); PG8_BAR; PG8_SCHED;
            PG8_LDB(B0, 1, 0); PG8_LDB(B1, 1, 1); PG8_SCHED; PG8_LDA(At, 1, 0); PG8_STAGEA(PG8_SA(0, 1), a2, 1, gC);
            PG8_WAIT_V(8); PG8_WAIT_L(0); PG8_BAR; PG8_MMA(0, 0, At, B0); PG8_MMA(0, 1, At, B1); PG8_BAR; PG8_SCHED;
            PG8_LDA(At, 1, 1); PG8_STAGEB(PG8_SB(1, 0), b3); PG8_STAGEB(PG8_SB(1, 1), b3 + hstepB); PG8_STAGEA(PG8_SA(1, 0), a3, 0, gC);
            PG8_WAIT_V(8); PG8_WAIT_L(0); PG8_BAR; PG8_MMA(1, 0, At, B0); PG8_MMA(1, 1, At, B1); PG8_BAR; PG8_SCHED;
        }
        if (wr == 0) PG8_BAR;
        asm volatile("s_nop 15\n\ts_nop 7" ::: "memory");
        const int le_ = lane_id();
        const bool keep = E(acc, cur, wr, wc, le_ & 15, le_ >> 4);
        if (!has_next) break;
        if (!keep) {
#pragma unroll
        for (int a = 0; a < 2; ++a)
#pragma unroll
            for (int b = 0; b < 2; ++b)
#pragma unroll
                for (int m = 0; m < 4; ++m)
#pragma unroll
                    for (int n = 0; n < 2; ++n) acc[a][b][m][n] = (f32x4){0.f, 0.f, 0.f, 0.f};
        }
        cur = nxt; cA = nA; cB = nB; ++ui; cur8 = MIXED && cur.nt8 > 0; ntc = cur8 ? cur.nt8 : nt;
        if (wr == 1) PG8_BAR;
    }
    PG8_WAIT_V(0);
    PG8_BAR;
#undef PG8_SA
#undef PG8_SB
#undef PG8_DMA2
#undef PG8_STAGEA
#undef PG8_STAGEB
#undef PG8_LDA
#undef PG8_LDB
#undef PG8_MMA
#undef PG8_MMA8
#undef PG8_MMA16
#undef PG8_LD8
#undef PG8_LO
#undef PG8_HI
#undef PG8_WAIT_V
#undef PG8_WAIT_L
#undef PG8_BAR
#undef PG8_SCHED
#undef PG8_GLOAD
}
}
struct Args { const float* in[22]; float* out; unsigned char* ws; int ph_lo, ph_hi; };
enum { I_X = 0, I_C, I_WADA, I_BADA, I_GMIX, I_WIN, I_QNORM, I_KNORM, I_WAU, I_PLIN, I_PSCALE, I_WPU, I_WOUT, I_GFFN, I_WROUTER, I_RBIAS, I_W1, I_W3, I_W2, I_WS1, I_WS3, I_WS2 };
struct Frame {
    LAS unsigned char* lds;
    int wave, G, gw, NGW;
    unsigned char* ws; unsigned* ctl; float* out;
};
#define LDS_WAIT() asm volatile("s_waitcnt lgkmcnt(0)" ::: "memory")
#define VM_WAIT() asm volatile("s_waitcnt vmcnt(0)" ::: "memory")

__device__ __forceinline__ void tr_tile(const float* __restrict__ src, int ld_src, int nvalid, bf16_t* __restrict__ dst, int ld_dst, int lane) {
    const int q = lane >> 4, c4 = (lane & 15) * 4;
    const bool ok = c4 < nvalid;
#pragma unroll
    for (int g = 0; g < 2; ++g) {
        f32x4 v[8];
#pragma unroll
        for (int j = 0; j < 8; ++j) { const int k = 32 * g + 8 * q + j; v[j] = ok ? *(const f32x4*)(src + (size_t)k * ld_src + c4) : (f32x4){0.f, 0.f, 0.f, 0.f}; }
#pragma unroll
        for (int nn = 0; nn < 4; ++nn) {
            u32x4 w; w.x = cvt_pk_bf16(v[0][nn], v[1][nn]); w.y = cvt_pk_bf16(v[2][nn], v[3][nn]); w.z = cvt_pk_bf16(v[4][nn], v[5][nn]); w.w = cvt_pk_bf16(v[6][nn], v[7][nn]);
            *(u32x4*)(dst + (size_t)(c4 + nn) * ld_dst + 32 * g + 8 * q) = w;
        }
    }
}
__device__ __forceinline__ void tr8_issue(const float* __restrict__ src, int ld_src, int lane, f32x4 (&v)[16], int nvalid = 64) {
    const int q = lane >> 4, c4 = (lane & 15) * 4; const bool ok = c4 < nvalid;
    const unsigned voff = (unsigned)((16 * q) * ld_src + c4) * 4u;
#pragma unroll
    for (int j = 0; j < 16; ++j) v[j] = ok ? __builtin_nontemporal_load((const f32x4*)((const char*)src + (size_t)j * ld_src * 4 + voff)) : (f32x4){0.f, 0.f, 0.f, 0.f};
}
__device__ __forceinline__ void tr8_finish(unsigned char* __restrict__ dst, int ld_dst, int lane, const f32x4 (&v)[16]) {
    const int q = lane >> 4, c4 = (lane & 15) * 4;
#pragma unroll
    for (int nn = 0; nn < 4; ++nn) { u32x4 w;
#pragma unroll
        for (int t = 0; t < 4; ++t) w[t] = pk4_fp8(v[4 * t][nn] * W8_SCALE, v[4 * t + 1][nn] * W8_SCALE, v[4 * t + 2][nn] * W8_SCALE, v[4 * t + 3][nn] * W8_SCALE);
        *(u32x4*)(dst + (size_t)(c4 + nn) * ld_dst + 16 * q) = w; }
}
template <bool F8>
__device__ __forceinline__ void wcopy_tile(const float* src, int ld_src, int nvalid, unsigned char* dstbase, size_t drow, int ldk, int k0, int lane) {
    if constexpr (F8) { f32x4 v[16]; tr8_issue(src, ld_src, lane, v, nvalid); tr8_finish(dstbase + drow * ldk + k0, ldk, lane, v); }
    else tr_tile(src, ld_src, nvalid, (bf16_t*)dstbase + drow * ldk + k0, ldk, lane);
}
constexpr int ADA_WGS = 6 * DM / 128;
__device__ __forceinline__ void p0_prologue(Frame& F, const Args& a) {
    LAS float* sc = (LAS float*)F.lds;
    const int lane = lane_id(), tid = F.wave * 64 + lane;
    for (int i = tid; i < NB * DM; i += NTHR) { const float c = a.in[I_C][i]; sc[i] = c / (1.0f + __expf(-c)); }
    __syncthreads();
    float* mod = (float*)(F.ctl + CW_MOD);
    unsigned char* ws = F.ws;
    for (int job = blockIdx.x; job < 2 * ADA_WGS; job += F.G) {
        const int strip = job % ADA_WGS, kh = job / ADA_WGS, w = F.wave, col = strip * 128 + 2 * lane, krow0 = kh * 1024 + 128 * w;
        const float* wp = a.in[I_WADA] + (size_t)krow0 * (6 * DM) + col;
        f32x2 a0 = {0.f, 0.f}, a1 = {0.f, 0.f};
#pragma unroll 16
        for (int k = 0; k < 128; ++k) { const f32x2 wv = *(const f32x2*)(wp + (size_t)k * (6 * DM)); const float s0 = sc[krow0 + k], s1 = sc[DM + krow0 + k]; a0 += wv * s0; a1 += wv * s1; }
        LAS float* part = (LAS float*)(F.lds + 16384);
        *(LAS f32x2*)(part + (w * 2 + 0) * 128 + 2 * lane) = a0; *(LAS f32x2*)(part + (w * 2 + 1) * 128 + 2 * lane) = a1;
        __syncthreads();
        if (tid < 256) { const int b = tid >> 7, c = tid & 127; float sum = kh == 0 ? a.in[I_BADA][strip * 128 + c] : 0.f;
#pragma unroll
            for (int ww = 0; ww < 8; ++ww) sum += part[(ww * 2 + b) * 128 + c];
            unsafeAtomicAdd(mod + b * 6 * DM + strip * 128 + c, sum); }
        __syncthreads();
    }
    unsigned char* Win8 = ws + WS_WIN;
    constexpr int J_IN_A = 32 * 40, J_IN_B = 32 * 4, J_IN_C = 32 * 80, J_AU = 16 * 32, J_PU = 16 * 32, J_OUT = 32 * 32, J_PL = 4 * 16, J_S13 = 2 * 32 * 8, J_S2 = 8 * 32, J_WR = 32,
                  J_W13 = 0, J_W2 = 0;
    constexpr int NITEMS = J_IN_A + J_IN_B + J_IN_C + J_AU + J_PU + J_OUT + J_PL + J_S13 + J_S2 + J_WR;
    for (int it = F.gw; it < NITEMS; it += F.NGW) {
        int r = it;
        if (r < J_IN_A) { const int kb = r / 40, nb = r % 40; if ((nb >> 2) == 5) wcopy_tile<true>(a.in[I_WIN] + (size_t)(64 * kb) * INW + 64 * nb, INW, 64, Win8, (size_t)(64 * nb), 2 * DM, 64 * kb, lane);
            else wcopy_tile<false>(a.in[I_WIN] + (size_t)(64 * kb) * INW + 64 * nb, INW, 64, Win8, (size_t)(64 * nb), DM, 64 * kb, lane); continue; } r -= J_IN_A;
        if (r < J_IN_B) { const int kb = r / 4, nb = r % 4; const int nv = nb == 0 ? 64 : (nb == 1 ? 16 : 0);
            wcopy_tile<false>(a.in[I_WIN] + (size_t)(64 * kb) * INW + 2560 + (nb < 2 ? 64 * nb : 0), INW, nv, Win8, (size_t)(2560 + 64 * nb), DM, 64 * kb, lane); continue; } r -= J_IN_B;
        if (r < J_IN_C) { const int kb = r / 80, nb = r % 80; wcopy_tile<true>(a.in[I_WIN] + (size_t)(64 * kb) * INW + 2640 + 64 * nb, INW, 64, Win8, (size_t)(2816 + 64 * nb), 2 * DM, 64 * kb, lane); continue; } r -= J_IN_C;
        if (r < J_AU) { const int kb = r / 32, nb = r % 32; wcopy_tile<FP8_MERGE>(a.in[I_WAU] + (size_t)(64 * kb) * DM + 64 * nb, DM, 64, ws + WS_WAU, (size_t)(64 * nb), AW, 64 * kb, lane); continue; } r -= J_AU;
        if (r < J_PU) { const int kb = r / 32, nb = r % 32; wcopy_tile<FP8_MERGE>(a.in[I_WPU] + (size_t)(64 * kb) * DM + 64 * nb, DM, 64, ws + WS_WPU, (size_t)(64 * nb), PW, 64 * kb, lane); continue; } r -= J_PU;
        if (r < J_OUT) { const int kb = r / 32, nb = r % 32; wcopy_tile<FP8_OUT>(a.in[I_WOUT] + (size_t)(64 * kb) * DM + 64 * nb, DM, 64, ws + WS_WOUT, (size_t)(64 * nb), DM, 64 * kb, lane); continue; } r -= J_OUT;
        if (r < J_PL) { const int g = r / 16, kb = (r % 16) / 4, nb = r % 4; tr_tile(a.in[I_PLIN] + (size_t)g * 65536 + (size_t)(64 * kb) * 256 + 64 * nb, 256, 64, (bf16_t*)(ws + WS_PLIN) + (size_t)g * 65536 + (size_t)(64 * nb) * 256 + 64 * kb, 256, lane); continue; } r -= J_PL;
        if (r < J_S13) { const int which = r / 256, kb = (r % 256) / 8, nb = r % 8; const float* src = (which ? a.in[I_WS3] : a.in[I_WS1]) + (size_t)(64 * kb) * EH + 64 * nb;
            f32x4 v[16]; tr8_issue(src, EH, lane, v); tr8_finish(ws + WS_WS13 + (size_t)(256 * (nb >> 1) + 64 * (nb & 1) + 128 * which) * DM + 64 * kb, DM, lane, v); continue; } r -= J_S13;
        if (r < J_S2) { const int kb = r / 32, nb = r % 32; f32x4 v[16]; tr8_issue(a.in[I_WS2] + (size_t)(64 * kb) * DM + 64 * nb, DM, lane, v); tr8_finish(ws + WS_WS2 + (size_t)(64 * nb) * EH + 64 * kb, EH, lane, v); continue; } r -= J_S2;
        { const int kb = r; tr_tile(a.in[I_WROUTER] + (size_t)(64 * kb) * NE, NE, 64, (bf16_t*)(ws + WS_WR) + 64 * kb, DM, lane); }
    }
}

constexpr int NCONV_W13 = NE * 2 * 32 * 8, NCONV = NCONV_W13 + NE * 8 * 32;
__device__ __forceinline__ void conv_ptrs(const Args& a, unsigned char* ws, int it, const float*& src, int& ld_src, unsigned char*& dst, int& ld_dst) {
    if (it < NCONV_W13) { const int e = it / 512, rr = it % 512, which = rr / 256, kb = (rr % 256) / 8, nb = rr % 8;
        src = (which ? a.in[I_W3] : a.in[I_W1]) + ((size_t)e * DM + 64 * kb) * EH + 64 * nb; ld_src = EH;
        dst = ws + WS_W13 + ((size_t)e * 1024 + 256 * (nb >> 1) + 64 * (nb & 1) + 128 * which) * DM + 64 * kb; ld_dst = DM; }
    else { const int r = it - NCONV_W13, e = r / 256, kb = (r % 256) / 32, nb = r % 32;
        src = a.in[I_W2] + ((size_t)e * EH + 64 * kb) * DM + 64 * nb; ld_src = DM; dst = ws + WS_W2 + ((size_t)e * DM + 64 * nb) * EH + 64 * kb; ld_dst = EH; }
}
__device__ __forceinline__ void conv_issue16(const Args& a, unsigned char* ws, int it, int lane, f32x4 (&v)[16]) {
    const float* src; int ld_src; unsigned char* dst; int ld_dst; conv_ptrs(a, ws, it, src, ld_src, dst, ld_dst); tr8_issue(src, ld_src, lane, v); }
__device__ __forceinline__ void conv_finish16(const Args& a, unsigned char* ws, int it, int lane, const f32x4 (&v)[16]) {
    const float* src; int ld_src; unsigned char* dst; int ld_dst; conv_ptrs(a, ws, it, src, ld_src, dst, ld_dst); tr8_finish(dst, ld_dst, lane, v); }
__device__ __forceinline__ void phase_done(Frame& F, int phase) { __syncthreads(); if (F.wave == 0 && lane_id() == 0) __hip_atomic_fetch_add(F.ctl + CW_DONE + 64 * phase, 1u, __ATOMIC_RELAXED, __HIP_MEMORY_SCOPE_AGENT); }
constexpr int CONV_SEG1_END = NCONV_W13 + (NCONV - NCONV_W13) * 3 / 10 / 8 * 8;
__device__ __forceinline__ unsigned conv_seg_lo(int sg) { return sg == 0 ? 0u : (sg == 1 ? (unsigned)NCONV_W13 : (unsigned)CONV_SEG1_END); }
__device__ __forceinline__ unsigned conv_seg_hi(int sg) { return sg == 0 ? (unsigned)NCONV_W13 : (sg == 1 ? (unsigned)CONV_SEG1_END : (unsigned)NCONV); }
template <bool BOUNDED, int SEG_LO, int SEG_HI>
struct ConvQ {
    Frame& F; int phase, lane; unsigned cur, end; int sg;
    __device__ __forceinline__ int next() {
        constexpr unsigned B = BOUNDED ? 6u : 8u;
        while (cur >= end) {
            if (BOUNDED) { const unsigned d = __hip_atomic_load(F.ctl + CW_DONE + 64 * phase, __ATOMIC_RELAXED, __HIP_MEMORY_SCOPE_AGENT); if ((unsigned)__builtin_amdgcn_readfirstlane(d) >= (unsigned)F.G) return -1; }
            const unsigned lo = conv_seg_lo(sg), hi = conv_seg_hi(sg);
            unsigned s = 0; if (lane == 0) s = __hip_atomic_fetch_add(F.ctl + CW_CONVQ + 64 * sg, B, __ATOMIC_RELAXED, __HIP_MEMORY_SCOPE_AGENT);
            s = (unsigned)__builtin_amdgcn_readfirstlane(s) + lo;
            if (s >= hi) { if (sg < SEG_HI) { ++sg; continue; } return -1; }
            cur = s; end = s + B < hi ? s + B : hi;
        }
        return (int)cur++;
    }
};
template <bool BOUNDED, int SEG_LO, int SEG_HI>
__device__ __forceinline__ void conv_drain(Frame& F, const Args& a, int phase, int quota = 0) {
    const int lane = lane_id();
    ConvQ<BOUNDED, SEG_LO, SEG_HI> Q{F, phase, lane, 0u, 0u, SEG_LO};
    f32x4 va[16], vb[16]; int n = 0;
    int ia = Q.next(); if (ia < 0) return;
    conv_issue16(a, F.ws, ia, lane, va);
    for (;;) {
        ++n; const int ib = (quota > 0 && n >= quota && Q.cur >= Q.end) ? -1 : Q.next(); if (ib >= 0) conv_issue16(a, F.ws, ib, lane, vb);
        conv_finish16(a, F.ws, ia, lane, va);
        if (ib < 0) break;
        ++n; ia = (quota > 0 && n >= quota && Q.cur >= Q.end) ? -1 : Q.next(); if (ia >= 0) conv_issue16(a, F.ws, ia, lane, va);
        conv_finish16(a, F.ws, ib, lane, vb);
        if (ia < 0) break;
    }
}

__device__ __forceinline__ void modnorm_row(const float* __restrict__ xrow, const float* __restrict__ g, const float* __restrict__ shift, const float* __restrict__ scale, unsigned char* __restrict__ orow, unsigned char* __restrict__ orow8, int lane) {
    f32x4 v[8]; float ss = 0.f;
#pragma unroll
    for (int j = 0; j < 8; ++j) { v[j] = *(const f32x4*)(xrow + 4 * lane + 256 * j); ss += (v[j].x * v[j].x + v[j].y * v[j].y) + (v[j].z * v[j].z + v[j].w * v[j].w); }
    const float rstd = rsqrtf(wave_sum(ss) * (1.0f / DM) + NORM_EPS);
#pragma unroll
    for (int j = 0; j < 8; ++j) { const int c = 4 * lane + 256 * j;
        const f32x4 gg = *(const f32x4*)(g + c), sh = *(const f32x4*)(shift + c), sl = *(const f32x4*)(scale + c);
        const f32x4 o = v[j] * rstd * gg * (sl + 1.0f) + sh;
        { u32x2 w; w.x = cvt_pk_bf16(o.x, o.y); w.y = cvt_pk_bf16(o.z, o.w); *(u32x2*)((bf16_t*)orow + c) = w; }
        if (orow8) *(unsigned*)(orow8 + c) = pk4_fp8(o.x * A8_SCALE, o.y * A8_SCALE, o.z * A8_SCALE, o.w * A8_SCALE); }
}
__device__ __forceinline__ void p1_h(Frame& F, const Args& a) {
    const float* mod = (const float*)(F.ctl + CW_MOD);
    unsigned char* hb = F.ws + WS_HB; const int lane = lane_id();
    for (int m = F.gw; m < NTOK; m += F.NGW) { const int b = m / SEQ;
        modnorm_row(a.in[I_X] + (size_t)m * DM, a.in[I_GMIX], mod + b * 6 * DM + 0 * DM, mod + b * 6 * DM + 1 * DM, hb + (size_t)m * DM * 2, F.ws + WS_H8 + (size_t)m * DM * 2, lane); }
}
struct SchedDense {
    pg8::TileOrder T; const char* A; const char* B; size_t a_tile, b_tile;
    __device__ __forceinline__ bool next(int i, pg8::Unit& u) const { int pm, pn; if (!T.tile(i, pm, pn)) return false; u.pm = pm; u.pn = pn; u.aux = 0; u.tok = nullptr; u.nt8 = 0;
        u.A = A + (size_t)pm * a_tile; u.B = B + (size_t)pn * b_tile; return true; }
};
__device__ __forceinline__ void st_bf16x8(bf16_t* p, f32x4 v0, f32x4 v1) { u32x4 w; w.x = cvt_pk_bf16(v0[0], v0[1]); w.y = cvt_pk_bf16(v0[2], v0[3]); w.z = cvt_pk_bf16(v1[0], v1[1]); w.w = cvt_pk_bf16(v1[2], v1[3]); *(u32x4*)p = w; }
struct EpiInproj {
    unsigned char* ws;
    __device__ __forceinline__ bool operator()(f32x4 (&acc)[2][2][4][2], const pg8::Unit& u, int wr, int wc, int fr, int fq) const {
        const int pn = u.pn; bf16_t* base; int ld, ct; bool sig = false;
        if (pn < 4) { base = (bf16_t*)(ws + WS_Q); ld = AW; ct = pn; }
        else if (pn == 4) { base = (bf16_t*)(ws + WS_K); ld = KVW; ct = 0; }
        else if (pn == 5) { base = (bf16_t*)(ws + WS_V); ld = KVW; ct = 0; }
        else if (pn < 10) { base = (bf16_t*)(ws + WS_QI); ld = IH * ID; ct = pn - 6; }
        else if (pn == 10) { base = (bf16_t*)(ws + WS_KW); ld = 256; ct = 0; }
        else if (pn < 15) { base = (bf16_t*)(ws + WS_U); ld = PW; ct = pn - 11; }
        else { base = (bf16_t*)(ws + WS_G); ld = 2 * DM; ct = pn - 15; sig = true; }
        const int row0 = u.pm * 256 + wr * 64 + fr, col0 = ct * 256 + wc * 32 + 8 * fq;
#pragma unroll
        for (int ai = 0; ai < 2; ++ai)
#pragma unroll
            for (int m = 0; m < 4; ++m) { bf16_t* rowp = base + (size_t)(row0 + ai * 128 + m * 16) * ld + col0;
#pragma unroll
                for (int bj = 0; bj < 2; ++bj) { f32x4 v0 = acc[ai][bj][m][0], v1 = acc[ai][bj][m][1];
                    if (sig) {
#pragma unroll
                        for (int j = 0; j < 4; ++j) { v0[j] = fminf(__builtin_amdgcn_rcpf(1.0f + __expf(-v0[j])), 1.0f); v1[j] = fminf(__builtin_amdgcn_rcpf(1.0f + __expf(-v1[j])), 1.0f); } }
                    st_bf16x8(rowp + bj * 128, v0, v1); } }
        return false;
    }
};
struct SchedInproj {
    int G, c, kind; const char* hA; const char* win;
    __device__ __forceinline__ bool next(int i, pg8::Unit& u) const {
        const int first = kind == 0 ? c : c + ((320 - c + G - 1) / G) * G;
        const int j = first + i * G; if (j >= (kind == 0 ? 320 : 992)) return false;
        int pn, pm;
        if (kind == 0) { const int t = j >> 5; pm = j & 31; pn = t < 5 ? t : t + 1; }
        else { const int jj = j - 320, t = jj >> 5; pm = jj & 31; pn = t == 0 ? 5 : t + 10; }
        u.pm = pm; u.pn = pn; u.aux = 0; u.tok = nullptr; u.nt8 = 0;
        u.A = hA + (size_t)pm * 256 * DM * 2; u.B = win + (size_t)pn * 256 * DM * 2; return true; }
};
__device__ __forceinline__ void p2_inproj(Frame& F, const Args& a) {
    const int NG = F.G >= 256 ? 248 : F.G;
    if ((int)blockIdx.x >= NG) { conv_drain<false, 0, 2>(F, a, 2, 24); return; }
    EpiInproj E{F.ws};
    { SchedInproj S{NG, (int)blockIdx.x, 0, (const char*)(F.ws + WS_HB), (const char*)(F.ws + WS_WIN)};
      pg8::gemm_phase<EpiInproj, SchedInproj, false, 2>(F.lds, F.wave, DM * 2, DM * 2, S, E); }
    { SchedInproj S{NG, (int)blockIdx.x, 1, (const char*)(F.ws + WS_H8), (const char*)(F.ws + WS_WIN)};
      pg8::gemm_phase<EpiInproj, SchedInproj, false, 1, A8_E8, W8_E8>(F.lds, F.wave, DM * 2, DM * 2, S, E, DM / 128); }
}
__device__ __forceinline__ void p3_qknorm(Frame& F, const Args& a) {
    bf16_t* Q = (bf16_t*)(F.ws + WS_Q); bf16_t* K = (bf16_t*)(F.ws + WS_K);
    const int lane = lane_id(); const float SCALE = 0.08838834764831845f;
    for (int m = F.gw; m < NTOK; m += F.NGW) {
        u32x4 q0 = *(const u32x4*)(Q + (size_t)m * AW + 16 * lane), q1 = *(const u32x4*)(Q + (size_t)m * AW + 16 * lane + 8);
        u32x2 k0 = *(const u32x2*)(K + (size_t)m * KVW + 4 * lane);
        float qv[16], kv[4]; float ss = 0.f, sk = 0.f;
#pragma unroll
        for (int j = 0; j < 4; ++j) { qv[2 * j] = bflo(q0[j]); qv[2 * j + 1] = bfhi(q0[j]); qv[8 + 2 * j] = bflo(q1[j]); qv[8 + 2 * j + 1] = bfhi(q1[j]); }
#pragma unroll
        for (int j = 0; j < 16; ++j) ss += qv[j] * qv[j];
        kv[0] = bflo(k0[0]); kv[1] = bfhi(k0[0]); kv[2] = bflo(k0[1]); kv[3] = bfhi(k0[1]);
#pragma unroll
        for (int j = 0; j < 4; ++j) sk += kv[j] * kv[j];
        ss += __shfl_xor(ss, 1); ss += __shfl_xor(ss, 2); ss += __shfl_xor(ss, 4);
        sk += __shfl_xor(sk, 1); sk += __shfl_xor(sk, 2); sk += __shfl_xor(sk, 4); sk += __shfl_xor(sk, 8); sk += __shfl_xor(sk, 16);
        const float rq = rsqrtf(ss * (1.0f / HD) + NORM_EPS) * SCALE, rk = rsqrtf(sk * (1.0f / HD) + NORM_EPS);
        const int dq = (16 * lane) & 127, dk = (4 * lane) & 127;
        float qn[16];
#pragma unroll
        for (int j = 0; j < 16; ++j) qn[j] = qv[j] * rq * a.in[I_QNORM][dq + j];
        u32x4 o0, o1;
#pragma unroll
        for (int j = 0; j < 4; ++j) { o0[j] = cvt_pk_bf16(qn[2 * j], qn[2 * j + 1]); o1[j] = cvt_pk_bf16(qn[8 + 2 * j], qn[8 + 2 * j + 1]); }
        *(u32x4*)(Q + (size_t)m * AW + 16 * lane) = o0; *(u32x4*)(Q + (size_t)m * AW + 16 * lane + 8) = o1;
        u32x2 ok; ok[0] = cvt_pk_bf16(kv[0] * rk * a.in[I_KNORM][dk], kv[1] * rk * a.in[I_KNORM][dk + 1]); ok[1] = cvt_pk_bf16(kv[2] * rk * a.in[I_KNORM][dk + 2], kv[3] * rk * a.in[I_KNORM][dk + 3]);
        *(u32x2*)(K + (size_t)m * KVW + 4 * lane) = ok;
    }
}
__device__ __forceinline__ void pooled_item(Frame& F, int t0, int g, int lane) {
    const bf16_t* U = (const bf16_t*)(F.ws + WS_U); bf16_t* P = (bf16_t*)(F.ws + WS_POOLED);
    const int pos0 = t0 % SEQ, w = 2 << g, c = 256 * g + 4 * lane;
    f32x4 W = {0.f, 0.f, 0.f, 0.f};
    for (int j = 1; j <= 16; ++j) { if (j <= w && pos0 - j >= 0) { const u32x2 v = *(const u32x2*)(U + (size_t)(t0 - j) * PW + c); W += (f32x4){bflo(v[0]), bfhi(v[0]), bflo(v[1]), bfhi(v[1])}; } }
#pragma unroll 8
    for (int i = 0; i < 32; ++i) { const int t = t0 + i, pos = pos0 + i;
        const u32x2 v = *(const u32x2*)(U + (size_t)t * PW + c); const f32x4 cur = {bflo(v[0]), bfhi(v[0]), bflo(v[1]), bfhi(v[1])};
        W += cur;
        if (pos - w >= 0) { const u32x2 o = *(const u32x2*)(U + (size_t)(t - w) * PW + c); W -= (f32x4){bflo(o[0]), bfhi(o[0]), bflo(o[1]), bfhi(o[1])}; }
        const float inv = 1.0f / (float)(pos + 1 < w ? pos + 1 : w);
        const f32x4 r = W * inv - cur;
        u32x2 ow; ow[0] = cvt_pk_bf16(r[0], r[1]); ow[1] = cvt_pk_bf16(r[2], r[3]);
        *(u32x2*)(P + (size_t)t * PW + c) = ow; }
}
__device__ __forceinline__ unsigned mono_key(float s) { const unsigned u = __float_as_uint(s); return (u & 0x80000000u) ? ~u : (u | 0x80000000u); }
__device__ __forceinline__ void idx_block(Frame& F, const Args& a, int b, int i16) {
    const bf16_t* QI = (const bf16_t*)(F.ws + WS_QI); const bf16_t* KW = (const bf16_t*)(F.ws + WS_KW);
    unsigned short* MT = (unsigned short*)(F.ws + WS_MASK);
    LAS unsigned* T = (LAS unsigned*)F.lds;
    const int lane = lane_id(), w = F.wave, tid = w * 64 + lane, r32 = lane & 31, hi = lane >> 5;
    const int tpos0 = 16 * i16, t0 = b * SEQ + tpos0, nh = (tpos0 + 16 + 31) >> 5, kzero = 64 * ((tpos0 >> 6) + 1);
    for (int k = tid; k < kzero; k += NTHR) T[k] = 0u;
    bf16x8 Af[4];
    { const int qsel = (r32 >> 2) & 1, head = (r32 & 3) + 4 * (r32 >> 3); const size_t tq = (size_t)(t0 + 2 * w + qsel);
      const float wv = bf2f(KW[tq * 256 + 64 + head]);
#pragma unroll
      for (int s = 0; s < 4; ++s) { const u32x4 q = *(const u32x4*)(QI + tq * (IH * ID) + head * ID + 16 * s + 8 * hi); u32x4 o;
#pragma unroll
          for (int j = 0; j < 4; ++j) o[j] = cvt_pk_bf16(bflo(q[j]) * wv, bfhi(q[j]) * wv);
          Af[s] = __builtin_bit_cast(bf16x8, o); } }
    float X[16];
    { const size_t tq = (size_t)(t0 + 2 * w + hi); const u32x4 w0 = *(const u32x4*)(KW + tq * 256 + 64), w1 = *(const u32x4*)(KW + tq * 256 + 72);
      const float PINF = __builtin_inff();
#pragma unroll
      for (int j = 0; j < 4; ++j) { X[2 * j] = bflo(w0[j]) >= 0.f ? PINF : -PINF; X[2 * j + 1] = bfhi(w0[j]) >= 0.f ? PINF : -PINF;
                                    X[8 + 2 * j] = bflo(w1[j]) >= 0.f ? PINF : -PINF; X[8 + 2 * j + 1] = bfhi(w1[j]) >= 0.f ? PINF : -PINF; } }
    const int mypos = tpos0 + 2 * w + hi;
    unsigned keys[128];
    constexpr int RING = 16384, SLOT = 8192;
    const int nt64 = (nh + 1) >> 1;
    const unsigned dvoff = (unsigned)((lane >> 3) * 512 + (((lane & 7) ^ (lane >> 3)) << 4));
    const char* kwb = (const char*)(KW + (size_t)b * SEQ * 256) + w * 4096;
    const unsigned ldsw = (unsigned)(uintptr_t)F.lds + RING + w * 1024;
#define IDX_DMA(t_) do { unsigned keep_; asm volatile("s_mov_b32 %0, m0\n\ts_mov_b32 m0, %3\n\ts_nop 0\n\tglobal_load_lds_dwordx4 %1, %2\n\ts_mov_b32 m0, %0" \
        : "=&s"(keep_) : "v"(dvoff), "s"(kwb + (size_t)(t_) * 32768), "s"(ldsw + (unsigned)(((t_) & 3) * SLOT)) : "memory"); } while (0)
    int boffs[4];
#pragma unroll
    for (int s = 0; s < 4; ++s) boffs[s] = r32 * 128 + ((((2 * s + hi) ^ (r32 & 7))) << 4);
    __syncthreads();
    if (0 < nt64) IDX_DMA(0);
    if (1 < nt64) IDX_DMA(1);
    if (2 < nt64) IDX_DMA(2);
#pragma unroll
    for (int t = 0; t < 64; ++t) {
        keys[2 * t] = 0u; keys[2 * t + 1] = 0u;
        if (t < nt64) {
            const int rem = nt64 - 1 - t;
            if (rem >= 2) asm volatile("s_waitcnt vmcnt(2)" ::: "memory"); else if (rem == 1) asm volatile("s_waitcnt vmcnt(1)" ::: "memory"); else asm volatile("s_waitcnt vmcnt(0)" ::: "memory");
            __builtin_amdgcn_s_barrier(); asm volatile("" ::: "memory");
            if (t + 3 < nt64) IDX_DMA(t + 3);
#pragma unroll
            for (int half = 0; half < 2; ++half) { const int n = 2 * t + half;
                if (n < nh) {
                    f32x16 acc = {0.f, 0.f, 0.f, 0.f, 0.f, 0.f, 0.f, 0.f, 0.f, 0.f, 0.f, 0.f, 0.f, 0.f, 0.f, 0.f};
#pragma unroll
                    for (int s = 0; s < 4; ++s) { const bf16x8 bfr = *(const LAS bf16x8*)(F.lds + RING + (t & 3) * SLOT + half * 4096 + boffs[s]);
                        acc = __builtin_amdgcn_mfma_f32_32x32x16_bf16(Af[s], bfr, acc, 0, 0, 0); }
                    float sc = 0.f;
#pragma unroll
                    for (int j = 0; j < 16; ++j) sc += __builtin_amdgcn_fmed3f(acc[j], 0.f, X[j]);
                    keys[n] = (32 * n + r32 <= mypos) ? mono_key(sc) : 0u;
                } }
        }
    }
#undef IDX_DMA
    unsigned T0 = 0u, T1 = 0u; bool done0 = false, done1 = false;
    for (int bit = 31; bit >= 0; --bit) {
        const unsigned c0 = T0 | (1u << bit), c1 = T1 | (1u << bit), cand = hi ? c1 : c0;
        unsigned cnt = 0;
#pragma unroll
        for (int n8 = 0; n8 < 16; ++n8) { if (n8 * 8 < nh) {
#pragma unroll
            for (int j = 0; j < 8; ++j) cnt += (keys[n8 * 8 + j] >= cand) ? 1u : 0u; } }
        cnt += __shfl_xor(cnt, 1); cnt += __shfl_xor(cnt, 2); cnt += __shfl_xor(cnt, 4); cnt += __shfl_xor(cnt, 8); cnt += __shfl_xor(cnt, 16);
        const unsigned n0 = __builtin_amdgcn_readlane(cnt, 0), n1 = __builtin_amdgcn_readlane(cnt, 32);
        if (!done0 && n0 >= (unsigned)TOPK) { T0 = c0; if (n0 == (unsigned)TOPK) done0 = true; }
        if (!done1 && n1 >= (unsigned)TOPK) { T1 = c1; if (n1 == (unsigned)TOPK) done1 = true; }
        if (done0 && done1) break;
    }
    { const unsigned Tsel = hi ? T1 : T0, Tf = Tsel > 1u ? Tsel : 1u;
      __syncthreads();
#pragma unroll
      for (int n = 0; n < 128; ++n) { if (n < nh) {
          unsigned bitv = keys[n] >= Tf ? 1u : 0u; const unsigned other = __shfl_xor(bitv, 32);
          bitv |= other << 1;
          if (hi == 0 && bitv) __hip_atomic_fetch_or(T + 32 * n + r32, bitv << (2 * w), __ATOMIC_RELAXED, __HIP_MEMORY_SCOPE_WORKGROUP); } }
    }
    __syncthreads();
    { const int rg = (b * SEQ + tpos0) >> 5, f = i16 & 1;
      for (int k = tid; k < kzero; k += NTHR) { const int kk = k & 63, p = (kk & ~7) | ((kk & 3) << 1) | ((kk >> 2) & 1);
          MT[((size_t)(rg * 64 + (k >> 6)) * 64 + p) * 2 + f] = (unsigned short)(T[k] & 0xffffu); } }
    __syncthreads();
}
__device__ __forceinline__ void p3_indexer(Frame& F, const Args& a) {
    for (int v2 = 2 * blockIdx.x; v2 < 512; v2 += 2 * F.G) { for (int ps = 0; ps < 2; ++ps) { const int v = v2 >> 1, b = v >> 7, i = v & 127; idx_block(F, a, b, ps ? 255 - i : i); } }
}
namespace att {
constexpr int KVBLK = 64, SHM_V = KVBLK * HD * 2, SHM_K = KVBLK * HD * 2;
constexpr int LDS_V = 0, LDS_K = 2 * SHM_V, LDS_WS = 2 * SHM_V + 2 * SHM_K, LDS_BYTES = LDS_WS + NWAVES * 64 * 4;
constexpr float THR = 8.f, LOG2E = 1.4426950408889634f;
#define KSWZ(row, colB) ((row) * 256 + ((colB) ^ (((row) & 7) << 4)))
#define SBAR() __builtin_amdgcn_sched_barrier(0)
__device__ __forceinline__ int v_st(int k, int c) { const int kk = (k & ~0xC) | ((k & 4) << 1) | ((k & 8) >> 1); return ((kk >> 3) * 4 + (c >> 5)) * 512 + ((kk & 7) * 32 + (c & 31)) * 2; }
__device__ __forceinline__ int v_rd_base(int lane) { return ((lane & 3) << 3) | (((lane >> 2) & 3) << 6) | (((lane >> 4) & 1) << 5) | (((lane >> 5) & 1) << 8); }
constexpr int v_rd_off(int d0, int ks, int half) { return d0 * 512 + ks * 4096 + half * 2048; }
__device__ __forceinline__ int crow(int r, int hi) { return (r & 3) + 8 * (r >> 2) + 4 * hi; }
__device__ __forceinline__ void partialSM(f32x16& p0, f32x16& p1, float& m_reg, float& mn, float& alpha) {
    float pmax = p0[0];
#pragma unroll
    for (int r = 1; r < 16; ++r) pmax = fmaxf(pmax, p0[r]);
#pragma unroll
    for (int r = 0; r < 16; ++r) pmax = fmaxf(pmax, p1[r]);
    { auto rr = __builtin_amdgcn_permlane32_swap(__float_as_uint(pmax), __float_as_uint(pmax), false, false);
      pmax = fmaxf(__uint_as_float(rr[0]), __uint_as_float(rr[1])); }
    if (__builtin_expect(__all((pmax - m_reg) <= THR), 1)) { mn = m_reg; alpha = 1.f; }
    else { mn = fmaxf(m_reg, pmax); alpha = __builtin_amdgcn_exp2f((m_reg - mn) * LOG2E); m_reg = mn; }
    const float mnL = -mn * LOG2E;
#pragma unroll
    for (int r = 0; r < 16; ++r) p0[r] = fmaf(p0[r], LOG2E, mnL);
#pragma unroll
    for (int r = 0; r < 16; ++r) p1[r] = fmaf(p1[r], LOG2E, mnL);
#pragma unroll
    for (int r = 0; r < 16; ++r) p0[r] = __builtin_amdgcn_exp2f(p0[r]);
}
__device__ __forceinline__ void finishSM(f32x16& p0, f32x16& p1, float alpha, float& l_reg, bf16x8& pa0, bf16x8& pa1, bf16x8& pa2, bf16x8& pa3) {
#pragma unroll
    for (int r = 0; r < 16; ++r) p1[r] = __builtin_amdgcn_exp2f(p1[r]);
    float ps = 0;
#pragma unroll
    for (int r = 0; r < 16; ++r) ps += p0[r];
#pragma unroll
    for (int r = 0; r < 16; ++r) ps += p1[r];
    { auto rr = __builtin_amdgcn_permlane32_swap(__float_as_uint(ps), __float_as_uint(ps), false, false);
      ps = __uint_as_float(rr[0]) + __uint_as_float(rr[1]); }
    l_reg = l_reg * alpha + ps;
#define PK4(P, B_, OUT) do { unsigned a0 = cvt_pk_bf16(P[B_+0], P[B_+1]), a1 = cvt_pk_bf16(P[B_+2], P[B_+3]);                          \
        unsigned b0 = cvt_pk_bf16(P[B_+4], P[B_+5]), b1 = cvt_pk_bf16(P[B_+6], P[B_+7]);                                             \
        auto r0 = __builtin_amdgcn_permlane32_swap(a0, b0, false, false); auto r1 = __builtin_amdgcn_permlane32_swap(a1, b1, false, false); \
        u32x4 w = {r0[0], r1[0], r0[1], r1[1]}; OUT = __builtin_bit_cast(bf16x8, w); } while (0)
    PK4(p0, 0, pa0); PK4(p0, 8, pa1); PK4(p1, 0, pa2); PK4(p1, 8, pa3);
#undef PK4
}
template <int KB>
__device__ __forceinline__ void qkt(f32x16& p0, f32x16& p1, const LAS char* K_lds, int r32, int hi, const bf16x8* qr, bf16x8 kf0, bf16x8 kf1, bf16x8 qf) {
    const LAS char* kb[4];
#pragma unroll
    for (int dd = 0; dd < 4; ++dd) kb[dd] = K_lds + KB * SHM_K + KSWZ(r32, (dd * 16 + hi * 8) * 2);
    bf16x8 ka[2], kc[2];
    ka[0] = *(const LAS bf16x8*)(kb[0]); kc[0] = *(const LAS bf16x8*)(kb[0] + 32 * 256);
    p0 = __builtin_amdgcn_mfma_f32_32x32x16_bf16(kf0, qf, (f32x16){0.f, 0.f, 0.f, 0.f, 0.f, 0.f, 0.f, 0.f, 0.f, 0.f, 0.f, 0.f, 0.f, 0.f, 0.f, 0.f}, 0, 0, 0);
    p1 = __builtin_amdgcn_mfma_f32_32x32x16_bf16(kf1, qf, (f32x16){0.f, 0.f, 0.f, 0.f, 0.f, 0.f, 0.f, 0.f, 0.f, 0.f, 0.f, 0.f, 0.f, 0.f, 0.f, 0.f}, 0, 0, 0);
    SBAR();
#pragma unroll
    for (int d0 = 0; d0 < 8; ++d0) { const int c = d0 & 1;
        if (d0 < 7) { const LAS char* ap = kb[(d0 + 1) & 3] + ((d0 + 1) >> 2) * 128; ka[c ^ 1] = *(const LAS bf16x8*)(ap); kc[c ^ 1] = *(const LAS bf16x8*)(ap + 32 * 256); }
        p0 = __builtin_amdgcn_mfma_f32_32x32x16_bf16(ka[c], qr[d0], p0, 0, 0, 0);
        p1 = __builtin_amdgcn_mfma_f32_32x32x16_bf16(kc[c], qr[d0], p1, 0, 0, 0);
        SBAR(); }
}
template <int VB>
__device__ __forceinline__ void pv_tile(f32x16* o, int vb0, bf16x8 pa0, bf16x8 pa1, bf16x8 pa2, bf16x8 pa3) {
#define TRRD(dst, off) asm volatile("ds_read_b64_tr_b16 %0, %1 offset:%2" : "=&v"(dst) : "v"(vb0), "i"(off) : "memory")
#define PV_D0(d0) do { s16x4 l0, l1, l2, l3, h0, h1, h2, h3; constexpr int b_ = VB * SHM_V + v_rd_off(d0, 0, 0); \
        TRRD(l0, b_); TRRD(h0, b_ + 2048); TRRD(l1, b_ + 4096); TRRD(h1, b_ + 6144); TRRD(l2, b_ + 8192); TRRD(h2, b_ + 10240); TRRD(l3, b_ + 12288); TRRD(h3, b_ + 14336); \
        asm volatile("s_waitcnt lgkmcnt(0)" ::: "memory"); SBAR();   \
        o[d0] = __builtin_amdgcn_mfma_f32_32x32x16_bf16(pa0, (bf16x8){l0[0], l0[1], l0[2], l0[3], h0[0], h0[1], h0[2], h0[3]}, o[d0], 0, 0, 0);   \
        o[d0] = __builtin_amdgcn_mfma_f32_32x32x16_bf16(pa1, (bf16x8){l1[0], l1[1], l1[2], l1[3], h1[0], h1[1], h1[2], h1[3]}, o[d0], 0, 0, 0);   \
        o[d0] = __builtin_amdgcn_mfma_f32_32x32x16_bf16(pa2, (bf16x8){l2[0], l2[1], l2[2], l2[3], h2[0], h2[1], h2[2], h2[3]}, o[d0], 0, 0, 0);   \
        o[d0] = __builtin_amdgcn_mfma_f32_32x32x16_bf16(pa3, (bf16x8){l3[0], l3[1], l3[2], l3[3], h3[0], h3[1], h3[2], h3[3]}, o[d0], 0, 0, 0); } while (0)
    PV_D0(0); PV_D0(1); PV_D0(2); PV_D0(3);
#undef PV_D0
#undef TRRD
}
typedef const __attribute__((address_space(4))) unsigned long long* cmask_t;
__device__ __forceinline__ void mask_tile(f32x16& p0, f32x16& p1, const unsigned long long* mpg) {
    const float NEG = -__builtin_inff();
    cmask_t mp = (cmask_t)mpg;
    asm volatile("s_nop 15\n\ts_nop 7" : "+v"(p0), "+v"(p1));
#pragma unroll
    for (int r = 0; r < 16; ++r) { const unsigned long long m0 = mp[r], m1 = mp[16 + r];
        asm volatile("v_cndmask_b32 %0, %1, %0, %2" : "+v"(p0[r]) : "v"(NEG), "s"(m0));
        asm volatile("v_cndmask_b32 %0, %1, %0, %2" : "+v"(p1[r]) : "v"(NEG), "s"(m1)); }
}
template <int BUF>
__device__ __forceinline__ void tile_step(f32x16* o, float& m_reg, float& l_reg, const LAS char* K_lds, int vb0, LAS float* al_l, int r32, int hi, const bf16x8* qr,
                                          int kb_key, bf16x8 qf, const unsigned long long* mp) {
    f32x16 p0, p1; float mn, alpha; bf16x8 pa0, pa1, pa2, pa3;
    const unsigned kbb = __float_as_uint((float)kb_key) >> 16, k0b = __float_as_uint((float)r32) >> 16, k1b = __float_as_uint((float)(r32 + 32)) >> 16;
    u32x4 f0 = {hi ? 0u : (kbb | (k0b << 16)), 0u, 0u, 0u}, f1 = {hi ? 0u : (kbb | (k1b << 16)), 0u, 0u, 0u};
    qkt<BUF>(p0, p1, K_lds, r32, hi, qr, __builtin_bit_cast(bf16x8, f0), __builtin_bit_cast(bf16x8, f1), qf);
    mask_tile(p0, p1, mp);
    partialSM(p0, p1, m_reg, mn, alpha);
    finishSM(p0, p1, alpha, l_reg, pa0, pa1, pa2, pa3);
    if (__any(alpha < 1.f)) { if (hi == 0) al_l[r32] = alpha; asm volatile("s_waitcnt lgkmcnt(0)" ::: "memory");
#pragma unroll
        for (int r = 0; r < 16; ++r) { const float av = al_l[crow(r, hi)];
#pragma unroll
            for (int d_ = 0; d_ < 4; ++d_) o[d_][r] *= av; } }
    pv_tile<BUF>(o, vb0, pa0, pa1, pa2, pa3);
}
__device__ __forceinline__ void attn_unit(Frame& F, int b, int g, int qb, unsigned* done_ctr) {
    const bf16_t* Q = (const bf16_t*)(F.ws + WS_Q); const bf16_t* K = (const bf16_t*)(F.ws + WS_K); const bf16_t* V = (const bf16_t*)(F.ws + WS_V);
    unsigned char* O = F.ws + WS_ATTN;
    const unsigned long long* MT = (const unsigned long long*)(F.ws + WS_MASK);
    LAS char* lds = (LAS char*)F.lds;
    const int wid = F.wave, lane = lane_id(), tid = wid * 64 + lane, r32 = lane & 31, hi = lane >> 5;
    const int hq = wid >> 1, th = wid & 1, h = 4 * g + hq, tok0 = b * SEQ + 64 * qb + 32 * th, NT = qb + 1;
    LAS char* V_lds = lds + LDS_V; LAS char* K_lds = lds + LDS_K; LAS float* wsf = (LAS float*)(lds + LDS_WS) + wid * 64; LAS float* li_l = wsf; LAS float* al_l = wsf + 32;
    const int sr = tid >> 4, sc = (tid & 15) * 8, vst0 = v_st(sr, sc), vst1 = v_st(32 + sr, sc), kws = KSWZ(sr, sc * 2);
    const int vb0 = (int)(uintptr_t)V_lds + v_rd_base(lane);
    bf16x8 qr[8];
#pragma unroll
    for (int d0 = 0; d0 < 8; ++d0) qr[d0] = *(const bf16x8*)(Q + (size_t)(tok0 + r32) * AW + h * HD + d0 * 16 + hi * 8);
    const unsigned sb = __float_as_uint(__builtin_ldexpf(1.0f, -(h + 1))) >> 16;
    const u32x4 qfw = {hi ? 0u : (sb | (sb << 16)), 0u, 0u, 0u}; const bf16x8 qf = __builtin_bit_cast(bf16x8, qfw);
    const bf16_t* Kg = K + (size_t)(b * SEQ) * KVW + g * HD + sc; const bf16_t* Vg = V + (size_t)(b * SEQ) * KVW + g * HD + sc;
    const unsigned long long* mrow = MT + (size_t)__builtin_amdgcn_readfirstlane(tok0 >> 5) * 64 * 32;
    float m_reg = -1e30f, l_reg = 0.f; f32x16 o[4] = {};
    bf16x8 st_k0, st_k1, st_v0, st_v1;
#define SLOAD(k0) do { st_k0 = *(const bf16x8*)(Kg + (size_t)((k0) + sr) * KVW); st_k1 = *(const bf16x8*)(Kg + (size_t)((k0) + 32 + sr) * KVW); \
                       st_v0 = *(const bf16x8*)(Vg + (size_t)((k0) + sr) * KVW); st_v1 = *(const bf16x8*)(Vg + (size_t)((k0) + 32 + sr) * KVW); } while (0)
#define SWRITE(bf) do { *(LAS bf16x8*)(K_lds + (bf) * SHM_K + kws) = st_k0; *(LAS bf16x8*)(K_lds + (bf) * SHM_K + kws + 32 * 256) = st_k1; \
                        *(LAS bf16x8*)(V_lds + (bf) * SHM_V + vst0) = st_v0; *(LAS bf16x8*)(V_lds + (bf) * SHM_V + vst1) = st_v1; } while (0)
    SLOAD(0); SWRITE(0);
    __syncthreads();
    bool signaled = false;
    for (int t = 0; t < NT; t += 2) {
        if (done_ctr && !signaled && t + 8 >= NT) { signaled = true; if (wid == 0 && lane == 0) __hip_atomic_fetch_add(done_ctr, 1u, __ATOMIC_RELAXED, __HIP_MEMORY_SCOPE_AGENT); }
        if (t + 1 < NT) SLOAD((t + 1) * KVBLK);
        tile_step<0>(o, m_reg, l_reg, K_lds, vb0, al_l, r32, hi, qr, t * KVBLK, qf, mrow + (size_t)t * 32);
        if (t + 1 < NT) SWRITE(1);
        __syncthreads();
        if (t + 1 < NT) {
            if (t + 2 < NT) SLOAD((t + 2) * KVBLK);
            tile_step<1>(o, m_reg, l_reg, K_lds, vb0, al_l, r32, hi, qr, (t + 1) * KVBLK, qf, mrow + (size_t)(t + 1) * 32);
            if (t + 2 < NT) SWRITE(0);
            __syncthreads();
        }
    }
#undef SLOAD
#undef SWRITE
    if (hi == 0) li_l[r32] = l_reg; asm volatile("s_waitcnt lgkmcnt(0)" ::: "memory");
    unsigned char* Ow = O + (size_t)tok0 * AW + h * HD;
#pragma unroll
    for (int r = 0; r < 16; ++r) { const int orow = crow(r, hi); const float rl = __builtin_amdgcn_rcpf(li_l[orow]) * (FP8_MERGE ? A8_SCALE : 1.0f);
#pragma unroll
        for (int d0 = 0; d0 < 4; ++d0) { const float v = o[d0][r] * rl; const float v1 = __shfl_xor(v, 1);
            if constexpr (FP8_MERGE) { const float v2 = __shfl_xor(v, 2), v3 = __shfl_xor(v1, 2);
                if ((r32 & 3) == 0) *(unsigned*)(Ow + (size_t)orow * AW + d0 * 32 + r32) = pk4_fp8(v, v1, v2, v3); }
            else { if ((r32 & 1) == 0) *(unsigned*)((bf16_t*)O + (size_t)(tok0 + orow) * AW + h * HD + d0 * 32 + r32) = cvt_pk_bf16(v, v1); } } }
    __syncthreads();
}
#undef KSWZ
#undef SBAR
}
struct SchedPool {
    const char* A; const char* B; int c;
    __device__ __forceinline__ bool next(int i, pg8::Unit& u) const { if (i > 0 || c >= 128) return false; const int rt = c >> 2, g = c & 3; u.pm = rt; u.pn = g; u.aux = 0; u.tok = nullptr; u.nt8 = 0;
        u.A = A + ((size_t)rt * 256 * PW + g * 256) * 2; u.B = B + (size_t)g * 65536 * 2; return true; }
};
struct EpiPool {
    unsigned char* out; const float* pscale;
    __device__ __forceinline__ bool operator()(f32x4 (&acc)[2][2][4][2], const pg8::Unit& u, int wr, int wc, int fr, int fq) const {
        const int row0 = u.pm * 256 + wr * 64 + fr, col0 = u.pn * 256 + wc * 32 + 8 * fq;
#pragma unroll
        for (int bj = 0; bj < 2; ++bj) { const f32x4 s0 = *(const f32x4*)(pscale + col0 + bj * 128), s1 = *(const f32x4*)(pscale + col0 + bj * 128 + 4);
#pragma unroll
            for (int ai = 0; ai < 2; ++ai)
#pragma unroll
                for (int m = 0; m < 4; ++m) { const size_t o = (size_t)(row0 + ai * 128 + m * 16) * PW + col0 + bj * 128;
                    if constexpr (FP8_MERGE) { const f32x4 v0 = acc[ai][bj][m][0] * s0 * A8_SCALE, v1 = acc[ai][bj][m][1] * s1 * A8_SCALE; u32x2 w; w.x = pk4_fp8(v0[0], v0[1], v0[2], v0[3]); w.y = pk4_fp8(v1[0], v1[1], v1[2], v1[3]); *(u32x2*)(out + o) = w; }
                    else st_bf16x8((bf16_t*)out + o, acc[ai][bj][m][0] * s0, acc[ai][bj][m][1] * s1); } }
        return false;
    }
};
__device__ __forceinline__ void p4_pool_attn(Frame& F, const Args& a) {
    for (int c = blockIdx.x; c < 256; c += F.G) {
        const int bg = c >> 6, qb = c & 63;
        att::attn_unit(F, bg >> 1, bg & 1, qb, (c + F.G >= 256) ? F.ctl + CW_DONE + 64 * 4 : nullptr);
        if (qb < 32) { const int pu = bg * 32 + qb, rt = pu >> 2, g = pu & 3;
            pooled_item(F, rt * 256 + 32 * F.wave, g, lane_id());
            asm volatile("s_waitcnt vmcnt(0)" ::: "memory"); __syncthreads();
            SchedPool S{(const char*)(F.ws + WS_POOLED), (const char*)(F.ws + WS_PLIN), pu}; EpiPool E{F.ws + WS_POOL, a.in[I_PSCALE]};
            pg8::gemm_phase<EpiPool, SchedPool, false>(F.lds, F.wave, 256 * 2, PW * 2, S, E); __syncthreads(); }
    }
}
struct SchedMerge {
    pg8::TileOrder T; const char* A0; const char* B0; const char* A1; const char* B1;
    __device__ __forceinline__ bool next(int i, pg8::Unit& u) const { int pm, pn; if (!T.tile(i >> 1, pm, pn)) return false; u.pm = pm; u.pn = pn; u.aux = i & 1; u.tok = nullptr; u.nt8 = 0;
        u.A = ((i & 1) ? A1 : A0) + (size_t)pm * 256 * 1024 * (FP8_MERGE ? 1 : 2); u.B = ((i & 1) ? B1 : B0) + (size_t)pn * 256 * 1024 * (FP8_MERGE ? 1 : 2); return true; }
};
struct EpiMerge {
    const bf16_t* G; unsigned char* out;
    __device__ __forceinline__ bool operator()(f32x4 (&acc)[2][2][4][2], const pg8::Unit& u, int wr, int wc, int fr, int fq) const {
        const int row0 = u.pm * 256 + wr * 64 + fr, col0 = u.pn * 256 + wc * 32 + 8 * fq;
#pragma unroll
        for (int ai = 0; ai < 2; ++ai)
#pragma unroll
            for (int m = 0; m < 4; ++m) { const size_t r = (size_t)(row0 + ai * 128 + m * 16);
#pragma unroll
                for (int bj = 0; bj < 2; ++bj) { const int c = col0 + bj * 128;
                    const u32x4 gp = *(const u32x4*)(G + r * (2 * DM) + DM + c);
                    const f32x4 p0 = {bflo(gp[0]), bfhi(gp[0]), bflo(gp[1]), bfhi(gp[1])}, p1 = {bflo(gp[2]), bfhi(gp[2]), bflo(gp[3]), bfhi(gp[3])};
                    if (u.aux == 0) { const u32x4 ga = *(const u32x4*)(G + r * (2 * DM) + c);
                        const f32x4 a0 = {bflo(ga[0]), bfhi(ga[0]), bflo(ga[1]), bfhi(ga[1])}, a1 = {bflo(ga[2]), bfhi(ga[2]), bflo(ga[3]), bfhi(ga[3])};
#pragma unroll
                        for (int j = 0; j < 4; ++j) { acc[ai][bj][m][0][j] *= a0[j] * __builtin_amdgcn_rcpf(fmaxf(p0[j], 1e-30f)); acc[ai][bj][m][1][j] *= a1[j] * __builtin_amdgcn_rcpf(fmaxf(p1[j], 1e-30f)); } }
                    else { if constexpr (FP8_OUT) { const f32x4 v0 = acc[ai][bj][m][0] * p0 * A8_SCALE, v1 = acc[ai][bj][m][1] * p1 * A8_SCALE; u32x2 w; w.x = pk4_fp8(v0[0], v0[1], v0[2], v0[3]); w.y = pk4_fp8(v1[0], v1[1], v1[2], v1[3]);
                        *(u32x2*)(out + r * DM + c) = w; } else st_bf16x8((bf16_t*)out + r * DM + c, acc[ai][bj][m][0] * p0, acc[ai][bj][m][1] * p1); } } }
        return u.aux == 0;
    }
};
__device__ __forceinline__ void p5_merge(Frame& F) {
    SchedMerge S; S.T.init(NTOK, DM, F.G, (int)blockIdx.x); S.A0 = (const char*)(F.ws + WS_ATTN); S.B0 = (const char*)(F.ws + WS_WAU); S.A1 = (const char*)(F.ws + WS_POOL); S.B1 = (const char*)(F.ws + WS_WPU);
    EpiMerge E{(const bf16_t*)(F.ws + WS_G), F.ws + WS_MERGED};
    constexpr int ES = FP8_MERGE ? 1 : 2;
    pg8::gemm_phase<EpiMerge, SchedMerge, false, ES, FP8_MERGE ? A8_E8 : 127, FP8_MERGE ? W8_E8 : 127>(F.lds, F.wave, 1024 * ES, 1024 * ES, S, E);
}
struct EpiOut {
    const float* x; const float* mod; float* out;
    __device__ __forceinline__ bool operator()(f32x4 (&acc)[2][2][4][2], const pg8::Unit& u, int wr, int wc, int fr, int fq) const {
        const int row0 = u.pm * 256 + wr * 64 + fr, col0 = u.pn * 256 + wc * 32 + 8 * fq; const int b = (u.pm * 256) / SEQ;
        const float* gm = mod + b * 6 * DM + 2 * DM;
#pragma unroll
        for (int bj = 0; bj < 2; ++bj) { const int c = col0 + bj * 128; const f32x4 g0 = *(const f32x4*)(gm + c), g1 = *(const f32x4*)(gm + c + 4);
#pragma unroll
            for (int ai = 0; ai < 2; ++ai)
#pragma unroll
                for (int m = 0; m < 4; ++m) { const size_t o = (size_t)(row0 + ai * 128 + m * 16) * DM + c;
                    const f32x4 x0 = *(const f32x4*)(x + o), x1 = *(const f32x4*)(x + o + 4);
                    *(f32x4*)(out + o) = x0 + g0 * acc[ai][bj][m][0]; *(f32x4*)(out + o + 4) = x1 + g1 * acc[ai][bj][m][1]; } }
        return false;
    }
};
__device__ __forceinline__ void p6_out(Frame& F, const Args& a) {
    SchedDense S; S.T.init(NTOK, DM, F.G, (int)blockIdx.x); S.A = (const char*)(F.ws + WS_MERGED); S.B = (const char*)(F.ws + WS_WOUT);
    constexpr int ES = FP8_OUT ? 1 : 2; S.a_tile = (size_t)256 * DM * ES; S.b_tile = (size_t)256 * DM * ES;
    EpiOut E{a.in[I_X], (const float*)(F.ctl + CW_MOD), F.out};
    pg8::gemm_phase<EpiOut, SchedDense, false, ES, FP8_OUT ? A8_E8 : 127, FP8_OUT ? W8_E8 : 127>(F.lds, F.wave, DM * ES, DM * ES, S, E);
}
constexpr int P7_ROWB = 4096 + 16;
constexpr int P7_ROWS = 32, P7_RW = P7_ROWS / NWAVES;
constexpr int P7_LDS_P = P7_ROWS * P7_ROWB;
constexpr int P7_LDS_H = P7_LDS_P + 2 * P7_ROWS * 64 * 4;
__device__ __forceinline__ void p7_router(Frame& F, const Args& a) {
    const float* mod = (const float*)(F.ctl + CW_MOD);
    unsigned char* hb8 = F.ws + WS_HB; const bf16_t* Wr = (const bf16_t*)(F.ws + WS_WR);
    unsigned char* rt = F.ws + WS_ROUTE;
    int* eid = (int*)(rt + RT_EID); float* gate = (float*)(rt + RT_GATE); int* posn = (int*)(rt + RT_POS); int* list = (int*)(rt + RT_LIST); int* ident = (int*)(rt + RT_IDENT);
    unsigned* ecnt = F.ctl + CW_ECNT;
    LAS unsigned char* lds = F.lds; LAS float* P = (LAS float*)(lds + P7_LDS_P); LAS unsigned* hist = (LAS unsigned*)(lds + P7_LDS_H); LAS unsigned* baseL = hist + 64;
    const int lane = lane_id(), w = F.wave, tid = w * 64 + lane;
    if (tid < 64) hist[tid] = 0u;
    __syncthreads();
    for (int p = blockIdx.x; p < NTOK / P7_ROWS; p += F.G) {
        const int row0 = P7_ROWS * p;
#pragma unroll
        for (int rr = 0; rr < P7_RW; ++rr) { const int lr = P7_RW * w + rr, m = row0 + lr, b = m / SEQ;
            const float* xrow = F.out + (size_t)m * DM; const float* sh = mod + b * 6 * DM + 3 * DM; const float* sl = mod + b * 6 * DM + 4 * DM;
            f32x4 v[8]; float ss = 0.f;
#pragma unroll
            for (int j = 0; j < 8; ++j) { v[j] = *(const f32x4*)(xrow + 4 * lane + 256 * j); ss += (v[j].x * v[j].x + v[j].y * v[j].y) + (v[j].z * v[j].z + v[j].w * v[j].w); }
            const float rstd = rsqrtf(wave_sum(ss) * (1.0f / DM) + NORM_EPS);
#pragma unroll
            for (int j = 0; j < 8; ++j) { const int c = 4 * lane + 256 * j;
                const f32x4 gg = *(const f32x4*)(a.in[I_GFFN] + c), shv = *(const f32x4*)(sh + c), slv = *(const f32x4*)(sl + c);
                const f32x4 o = v[j] * rstd * gg * (slv + 1.0f) + shv;
                u32x2 wv; wv.x = cvt_pk_bf16(o.x, o.y); wv.y = cvt_pk_bf16(o.z, o.w);
                *(unsigned*)(hb8 + (size_t)m * DM + c) = pk4_fp8(o.x * H8_SCALE, o.y * H8_SCALE, o.z * H8_SCALE, o.w * H8_SCALE); *(LAS u32x2*)(lds + lr * P7_ROWB + c * 2) = wv; }
            if (lane == 0) ident[m] = m;
        }
        __syncthreads();
        { const int nb = w & 3, kh = w >> 2, fr = lane & 15, kq = lane >> 4;
          f32x4 acc[2] = {{0.f, 0.f, 0.f, 0.f}, {0.f, 0.f, 0.f, 0.f}};
          const bf16_t* wp = Wr + (size_t)(16 * nb + fr) * DM + 1024 * kh + 8 * kq;
          const LAS unsigned char* ap = lds + fr * P7_ROWB + (1024 * kh + 8 * kq) * 2;
#pragma unroll 8
          for (int s = 0; s < 32; ++s) { const bf16x8 bv = *(const bf16x8*)(wp + 32 * s);
#pragma unroll
              for (int mb = 0; mb < 2; ++mb) { const bf16x8 av = *(const LAS bf16x8*)(ap + mb * 16 * P7_ROWB + 64 * s); acc[mb] = __builtin_amdgcn_mfma_f32_16x16x32_bf16(av, bv, acc[mb], 0, 0, 0); } }
#pragma unroll
          for (int mb = 0; mb < 2; ++mb)
#pragma unroll
              for (int j = 0; j < 4; ++j) P[(kh * P7_ROWS + 16 * mb + 4 * kq + j) * 64 + 16 * nb + fr] = acc[mb][j];
        }
        __syncthreads();
        int myrank[P7_RW]; unsigned mylocal[P7_RW]; bool chosen[P7_RW]; float mygate[P7_RW];
#pragma unroll
        for (int rr = 0; rr < P7_RW; ++rr) { const int lr = P7_RW * w + rr;
            const float logit = P[lr * 64 + lane] + P[(P7_ROWS + lr) * 64 + lane];
            const float score = 1.0f / (1.0f + __expf(-logit)); const float sel = score + a.in[I_RBIAS][lane];
            float m1 = sel; m1 = fmaxf(m1, __shfl_xor(m1, 1)); m1 = fmaxf(m1, __shfl_xor(m1, 2)); m1 = fmaxf(m1, __shfl_xor(m1, 4));
            const unsigned long long bm = __ballot(sel == m1); const unsigned grp = (unsigned)((bm >> (lane & ~7)) & 0xffull); const int first = __builtin_ctz(grp | 0x100u);
            float m2 = ((lane & 7) == first) ? -__builtin_inff() : sel; m2 = fmaxf(m2, __shfl_xor(m2, 1)); m2 = fmaxf(m2, __shfl_xor(m2, 2)); m2 = fmaxf(m2, __shfl_xor(m2, 4));
            const float gs = m1 + m2; const int g = lane >> 3; int grank = 0;
#pragma unroll
            for (int g2 = 0; g2 < 8; ++g2) { const float o = __uint_as_float(__builtin_amdgcn_readlane(__float_as_uint(gs), 8 * g2)); grank += (o > gs || (o == gs && g2 < g)) ? 1 : 0; }
            const float selm = grank < TOPG ? sel : -__builtin_inff(); int rank = 0;
#pragma unroll
            for (int e2 = 0; e2 < 64; ++e2) { const float o = __uint_as_float(__builtin_amdgcn_readlane(__float_as_uint(selm), e2)); rank += (o > selm || (o == selm && e2 < lane)) ? 1 : 0; }
            const bool ch = rank < ETOP && grank < TOPG; const float gsum = wave_sum(ch ? score : 0.f);
            chosen[rr] = ch; myrank[rr] = rank; mygate[rr] = score / gsum * ROUTED_SCALE;
            mylocal[rr] = ch ? __hip_atomic_fetch_add(hist + lane, 1u, __ATOMIC_RELAXED, __HIP_MEMORY_SCOPE_WORKGROUP) : 0u;
        }
        __syncthreads();
        if (w == 0) { const unsigned c = hist[lane]; baseL[lane] = c ? __hip_atomic_fetch_add(ecnt + lane, c, __ATOMIC_RELAXED, __HIP_MEMORY_SCOPE_AGENT) : 0u; hist[lane] = 0u; }
        __syncthreads();
#pragma unroll
        for (int rr = 0; rr < P7_RW; ++rr) if (chosen[rr]) { const int m = row0 + P7_RW * w + rr; const unsigned pos = baseL[lane] + mylocal[rr];
            eid[m * 8 + myrank[rr]] = lane; gate[m * 8 + myrank[rr]] = mygate[rr]; posn[m * 8 + myrank[rr]] = (int)pos; list[(size_t)lane * NTOK + pos] = m; }
        __syncthreads();
    }
}
constexpr int MOE_LDS = 131072;
__device__ __forceinline__ int moe_prefix(Frame& F) {
    LAS int* rtoff = (LAS int*)(F.lds + MOE_LDS);
    if (F.wave == 0 && lane_id() == 0) { int s = 0; for (int e = 0; e < NE; ++e) { rtoff[e] = s; unsigned n = F.ctl[CW_ECNT + e]; if (n > (unsigned)NTOK) n = NTOK; s += (int)((n + 255u) >> 8); } rtoff[NE] = s; }
    __syncthreads();
    return __builtin_amdgcn_readfirstlane(rtoff[NE]);
}
__device__ __forceinline__ int moe_find(const LAS int* rtoff, int rtg) {
    int lo = 0, hi = NE;
#pragma unroll
    for (int it = 0; it < 6; ++it) { const int mid = (lo + hi) >> 1; const int v = __builtin_amdgcn_readfirstlane(rtoff[mid]); if (v <= rtg) lo = mid; else hi = mid; }
    return lo;
}
struct SchedMoe1 {
    const LAS int* rtoff; int RT, G, c; const char* hb; const char* w13; const char* ws13; const int* list; const int* ident;
    __device__ __forceinline__ bool next(int i, pg8::Unit& u) const {
        const int idx = i * G + c; if (idx >= (RT + NTOK / 256) * 4) return false;
        const int rtg = idx >> 2, ct = idx & 3; u.pn = ct; u.aux = 0; u.nt8 = 0; u.A = hb;
        if (rtg < RT) { const int e = moe_find(rtoff, rtg), rt = rtg - __builtin_amdgcn_readfirstlane(rtoff[e]); u.pm = rtg; u.tok = list + (size_t)e * NTOK + rt * 256;
            u.B = w13 + ((size_t)e * 1024 + ct * 256) * DM; }
        else { const int rt = rtg - RT; u.pm = HROWS_R / 256 + rt; u.tok = ident + rt * 256; u.B = ws13 + (size_t)(ct * 256) * DM; }
        return true; }
};
struct EpiMoe1 {
    unsigned char* H;
    __device__ __forceinline__ bool operator()(f32x4 (&acc)[2][2][4][2], const pg8::Unit& u, int wr, int wc, int fr, int fq) const {
        const int row0 = u.pm * 256 + wr * 64 + fr, col0 = u.pn * 128 + wc * 32 + 8 * fq;
#pragma unroll
        for (int ai = 0; ai < 2; ++ai)
#pragma unroll
            for (int m = 0; m < 4; ++m) { f32x4 h0, h1;
#pragma unroll
                for (int j = 0; j < 4; ++j) { const float g0 = acc[ai][0][m][0][j], g1 = acc[ai][0][m][1][j];
                    h0[j] = g0 * __builtin_amdgcn_rcpf(1.0f + __expf(-g0)) * acc[ai][1][m][0][j]; h1[j] = g1 * __builtin_amdgcn_rcpf(1.0f + __expf(-g1)) * acc[ai][1][m][1][j]; }
                u32x2 w; w.x = pk4_fp8(h0[0] * H8_SCALE, h0[1] * H8_SCALE, h0[2] * H8_SCALE, h0[3] * H8_SCALE); w.y = pk4_fp8(h1[0] * H8_SCALE, h1[1] * H8_SCALE, h1[2] * H8_SCALE, h1[3] * H8_SCALE);
                *(u32x2*)(H + (size_t)(row0 + ai * 128 + m * 16) * EH + col0) = w; }
        return false;
    }
};
__device__ __forceinline__ void p8_gemm1(Frame& F, const Args& a) {
    const int RT = moe_prefix(F);
    const int U = (RT + NTOK / 256) * 4, R0 = (U + F.G - 1) / F.G, R = (R0 * F.G - U < 24 * R0) ? R0 + 1 : R0, NG = (U + R - 1) / R;
    if ((int)blockIdx.x >= NG) { conv_drain<false, 1, 2>(F, a, 8); return; }
    SchedMoe1 S{(const LAS int*)(F.lds + MOE_LDS), RT, NG, (int)blockIdx.x, (const char*)(F.ws + WS_HB), (const char*)(F.ws + WS_W13), (const char*)(F.ws + WS_WS13),
                (const int*)(F.ws + WS_ROUTE + RT_LIST), (const int*)(F.ws + WS_ROUTE + RT_IDENT)};
    EpiMoe1 E{F.ws + WS_H};
    pg8::gemm_phase<EpiMoe1, SchedMoe1, true, 1, H8_E8, W8_E8>(F.lds, F.wave, DM, DM, S, E);
    conv_drain<false, 1, 2>(F, a, 8);
}
struct SchedMoe2 {
    const LAS int* rtoff; int RT, G, c; const char* H; const char* w2; const char* ws2;
    __device__ __forceinline__ bool next(int i, pg8::Unit& u) const {
        const int idx = i * G + c; if (idx >= (RT + NTOK / 256) * 8) return false;
        const int rtg = idx >> 3, ct = idx & 7; u.pn = ct; u.aux = 0; u.tok = nullptr; u.nt8 = 0;
        if (rtg < RT) { const int e = moe_find(rtoff, rtg); u.pm = rtg; u.B = w2 + ((size_t)e * DM + ct * 256) * EH; }
        else { u.pm = HROWS_R / 256 + (rtg - RT); u.B = ws2 + (size_t)(ct * 256) * EH; }
        u.A = H + (size_t)u.pm * 256 * EH; return true; }
};
constexpr float Y8_SCALE = 8.f;
struct EpiY {
    unsigned char* Y;
    __device__ __forceinline__ bool operator()(f32x4 (&acc)[2][2][4][2], const pg8::Unit& u, int wr, int wc, int fr, int fq) const {
        const int row0 = u.pm * 256 + wr * 64 + fr, col0 = u.pn * 256 + wc * 32 + 8 * fq;
#pragma unroll
        for (int ai = 0; ai < 2; ++ai)
#pragma unroll
            for (int m = 0; m < 4; ++m)
#pragma unroll
                for (int bj = 0; bj < 2; ++bj) { const f32x4 v0 = acc[ai][bj][m][0] * Y8_SCALE, v1 = acc[ai][bj][m][1] * Y8_SCALE; u32x2 w; w.x = pk4_fp8(v0[0], v0[1], v0[2], v0[3]); w.y = pk4_fp8(v1[0], v1[1], v1[2], v1[3]);
                    *(u32x2*)(Y + (size_t)(row0 + ai * 128 + m * 16) * DM + col0 + bj * 128) = w; }
        return false;
    }
};
__device__ __forceinline__ void p9_gemm2(Frame& F) {
    const int RT = moe_prefix(F);
    SchedMoe2 S{(const LAS int*)(F.lds + MOE_LDS), RT, F.G, (int)blockIdx.x, (const char*)(F.ws + WS_H), (const char*)(F.ws + WS_W2), (const char*)(F.ws + WS_WS2)};
    EpiY E{F.ws + WS_Y};
    pg8::gemm_phase<EpiY, SchedMoe2, false, 1, H8_E8, W8_E8>(F.lds, F.wave, EH, EH, S, E);
}
__device__ __forceinline__ void fp8x16_fma(f32x4 (&s)[4], const u32x4 y, float g) {
#pragma unroll
    for (int t = 0; t < 4; ++t) { const f32x2 lo = __builtin_amdgcn_cvt_pk_f32_fp8((int)y[t], false), hi = __builtin_amdgcn_cvt_pk_f32_fp8((int)y[t], true);
        s[t][0] += lo[0] * g; s[t][1] += lo[1] * g; s[t][2] += hi[0] * g; s[t][3] += hi[1] * g; }
}
__device__ __forceinline__ void p10_combine(Frame& F) {
    (void)moe_prefix(F);
    const LAS int* rtoff = (const LAS int*)(F.lds + MOE_LDS);
    const unsigned char* Y = F.ws + WS_Y; unsigned char* rt = F.ws + WS_ROUTE;
    const int* eid = (const int*)(rt + RT_EID); const float* gate = (const float*)(rt + RT_GATE); const int* posn = (const int*)(rt + RT_POS); const float* mod = (const float*)(F.ctl + CW_MOD);
    const int lane = lane_id();
    for (int t = F.gw; t < NTOK; t += F.NGW) {
        const int b = t / SEQ; const float* gf = mod + b * 6 * DM + 5 * DM + 32 * lane;
        float* orow = F.out + (size_t)t * DM + 32 * lane;
        f32x4 xv[8];
#pragma unroll
        for (int j = 0; j < 8; ++j) xv[j] = *(const f32x4*)(orow + 4 * j);
        size_t yr[9]; float g[9];
        { const u32x4 e0 = *(const u32x4*)(eid + t * 8), e1 = *(const u32x4*)(eid + t * 8 + 4), p0 = *(const u32x4*)(posn + t * 8), p1 = *(const u32x4*)(posn + t * 8 + 4);
          const f32x4 g0 = *(const f32x4*)(gate + t * 8), g1 = *(const f32x4*)(gate + t * 8 + 4);
#pragma unroll
          for (int k = 0; k < 8; ++k) { const int e = __builtin_amdgcn_readfirstlane((int)(k < 4 ? e0[k & 3] : e1[k & 3])) & 63, p = __builtin_amdgcn_readfirstlane((int)(k < 4 ? p0[k & 3] : p1[k & 3]));
              yr[k] = (size_t)(256 * __builtin_amdgcn_readfirstlane(rtoff[e]) + p) * DM; g[k] = __uint_as_float(__builtin_amdgcn_readfirstlane(__float_as_uint(k < 4 ? g0[k & 3] : g1[k & 3]))); } }
        yr[8] = (size_t)(HROWS_R + t) * DM; g[8] = 1.0f;
        u32x4 yv[9][2];
#pragma unroll
        for (int k = 0; k < 9; ++k) { yv[k][0] = __builtin_nontemporal_load((const u32x4*)(Y + yr[k] + 32 * lane)); yv[k][1] = __builtin_nontemporal_load((const u32x4*)(Y + yr[k] + 32 * lane + 16)); }
        f32x4 s[8];
#pragma unroll
        for (int j = 0; j < 8; ++j) s[j] = (f32x4){0.f, 0.f, 0.f, 0.f};
#pragma unroll
        for (int k = 0; k < 9; ++k) { f32x4 (&s0)[4] = *(f32x4 (*)[4])&s[0]; f32x4 (&s1)[4] = *(f32x4 (*)[4])&s[4]; fp8x16_fma(s0, yv[k][0], g[k]); fp8x16_fma(s1, yv[k][1], g[k]); }
#pragma unroll
        for (int j = 0; j < 8; ++j) *(f32x4*)(orow + 4 * j) = xv[j] + *(const f32x4*)(gf + 4 * j) * s[j] * (1.0f / Y8_SCALE);
    }
}
constexpr int LDS_BYTES = 155648;
constexpr int N_PHASES = 11;
#ifndef PROBE_REP
#define PROBE_REP -1
#endif
#define REP(k, stmt) do { stmt; if (PROBE_REP == (k)) { __syncthreads(); stmt; } } while (0)
__global__ void __launch_bounds__(NTHR, 2) fwd(Args args) {
    extern __shared__ __attribute__((aligned(16))) unsigned char lds_raw[];
    Frame F; F.lds = (LAS unsigned char*)lds_raw; F.wave = __builtin_amdgcn_readfirstlane((int)threadIdx.x >> 6);
    F.G = gridDim.x; F.gw = blockIdx.x * NWAVES + F.wave; F.NGW = F.G * NWAVES; F.ws = args.ws; F.ctl = (unsigned*)(args.ws + WS_CTL); F.out = args.out;
    volatile LAS unsigned* xbw = (volatile LAS unsigned*)(F.lds + LDS_BYTES - 16);
    if (threadIdx.x < 4) xbw[threadIdx.x] = 0u;
    __syncthreads();
    const bool one = (args.ph_hi - args.ph_lo) > 1;
    XcdBarrier bar; bar.bar = F.ctl + CW_BAR; bar.x = 0; bar.st = xbw;
    if (one) bar = xcd_barrier_post(F.ctl + CW_BAR, xbw, F.wave);
    const int lo = args.ph_lo, hi = args.ph_hi;
#ifndef PROBE_TIME
#define PROBE_TIME -1
#endif
    unsigned long long pt0 = 0ull, pt1 = 0ull;
#define TSTAMP(k, which) do { if (PROBE_TIME == (k) && blockIdx.x == 0) { if (which) pt1 = __builtin_amdgcn_s_memrealtime(); else pt0 = __builtin_amdgcn_s_memrealtime(); } } while (0)
#define IN(k) (lo <= (k) && (k) < hi)
#define SEAM(k) do { if (IN(k) && IN((k) + 1)) xcd_barrier(bar, F.wave); } while (0)
    TSTAMP(0, 0); if (IN(0)) { REP(0, p0_prologue(F, args)); } SEAM(0); TSTAMP(0, 1);
    TSTAMP(1, 0); if (IN(1)) { REP(1, p1_h(F, args)); } SEAM(1); TSTAMP(1, 1);
    TSTAMP(2, 0); if (IN(2)) { REP(2, p2_inproj(F, args)); } SEAM(2); TSTAMP(2, 1);
    TSTAMP(3, 0); if (IN(3)) { p3_qknorm(F, args); __syncthreads(); REP(3, p3_indexer(F, args)); } SEAM(3); TSTAMP(3, 1);
    TSTAMP(4, 0); if (IN(4)) { REP(4, p4_pool_attn(F, args)); if (one) { conv_drain<true, 0, 2>(F, args, 4); } } SEAM(4); TSTAMP(4, 1);
    TSTAMP(5, 0); if (IN(5)) { REP(5, p5_merge(F)); } SEAM(5); TSTAMP(5, 1);
    TSTAMP(6, 0); if (IN(6)) { REP(6, p6_out(F, args)); } SEAM(6); TSTAMP(6, 1);
    TSTAMP(7, 0); if (IN(7)) { p7_router(F, args); conv_drain<false, 0, 1>(F, args, 7); }
    SEAM(7); TSTAMP(7, 1);
    TSTAMP(8, 0); if (IN(8)) { REP(8, p8_gemm1(F, args)); } SEAM(8); TSTAMP(8, 1);
    TSTAMP(9, 0); if (IN(9)) { REP(9, p9_gemm2(F)); } SEAM(9); TSTAMP(9, 1);
    TSTAMP(10, 0); if (IN(10)) { p10_combine(F); } TSTAMP(10, 1);
    if (PROBE_TIME >= 0 && blockIdx.x == 0) { const unsigned long long tend = __builtin_amdgcn_s_memrealtime() + 4ull * (pt1 - pt0); while (__builtin_amdgcn_s_memrealtime() < tend) __builtin_amdgcn_s_sleep(8); }
#undef IN
#undef SEAM
}
#ifndef N_LAUNCHES
#define N_LAUNCHES 1
#endif
extern "C" void kernel_launch(void* const* d_in, const int* in_sizes, int n_in, void* d_out, int out_size, void* d_ws, size_t ws_size, hipStream_t stream) {
    static int grid = 0;
    if (grid == 0) {
        if (n_in != 22 || out_size != NTOK * DM || ws_size < WS_END) { fprintf(stderr, "kernel_launch: unexpected shapes (n_in %d out %d ws %zu need %zu)\n", n_in, out_size, ws_size, (size_t)WS_END); grid = -1; return; }
        int dev = 0, cus = 0, per_cu = 0;
        if (hipGetDevice(&dev) != hipSuccess || hipDeviceGetAttribute(&cus, hipDeviceAttributeMultiprocessorCount, dev) != hipSuccess) { grid = -1; return; }
        if (hipFuncSetAttribute((const void*)fwd, hipFuncAttributeMaxDynamicSharedMemorySize, LDS_BYTES) != hipSuccess) { fprintf(stderr, "kernel_launch: hipFuncSetAttribute failed\n"); grid = -1; return; }
        if (hipOccupancyMaxActiveBlocksPerMultiprocessor(&per_cu, (const void*)fwd, NTHR, LDS_BYTES) != hipSuccess || per_cu < 1) fprintf(stderr, "kernel_launch: occupancy query says %d\n", per_cu);
        (void)hipGetLastError();
        grid = cus;
    }
    if (grid < 0) return;
    (void)hipMemsetAsync((char*)d_ws + WS_CTL, 0, CTL_BYTES, stream);
    Args a{};
    for (int i = 0; i < 22; ++i) a.in[i] = (const float*)d_in[i];
    a.out = (float*)d_out; a.ws = (unsigned char*)d_ws;
    if (N_LAUNCHES == 1) { a.ph_lo = 0; a.ph_hi = N_PHASES; hipLaunchKernelGGL(fwd, dim3(grid), dim3(NTHR), LDS_BYTES, stream, a); }
    else for (int p = 0; p < N_PHASES; ++p) { a.ph_lo = p; a.ph_hi = p + 1; hipLaunchKernelGGL(fwd, dim3(grid), dim3(NTHR), LDS_BYTES, stream, a); }
}
```

```cpp
#include <hip/hip_runtime.h>
#include <cstdio>
#include <cstdint>

#define LAS __attribute__((address_space(3)))
#define GAS __attribute__((address_space(1)))
typedef unsigned short bf16_t;
typedef short bf16x8 __attribute__((ext_vector_type(8)));
typedef short s16x4 __attribute__((ext_vector_type(4)));
typedef float f32x4 __attribute__((ext_vector_type(4)));
typedef float f32x2 __attribute__((ext_vector_type(2)));
typedef float f32x16 __attribute__((ext_vector_type(16)));
typedef unsigned u32x4 __attribute__((ext_vector_type(4)));
typedef unsigned u32x2 __attribute__((ext_vector_type(2)));

constexpr int DM = 2048, NB = 2, SEQ = 4096, NTOK = NB * SEQ;
constexpr int NH = 8, HD = 128, NKV = 2, AW = 1024, KVW = 256, IH = 16, ID = 64, TOPK = 256;
constexpr int PW = 1024, INW = 7760, INP = 7936;
constexpr int NE = 64, EH = 512, NGRP = 8, EPG = 8, TOPG = 4, ETOP = 8;
constexpr float NORM_EPS = 1e-6f, ROUTED_SCALE = 2.5f;
constexpr int NTHR = 512, NWAVES = 8;

constexpr size_t MiB = 1u << 20;
constexpr size_t WS_CTL = 0, CTL_BYTES = 1 * MiB;
constexpr size_t WS_W13 = 1 * MiB;
constexpr size_t WS_W2 = WS_W13 + 256 * MiB;
constexpr size_t WS_WS13 = WS_W2 + 128 * MiB;
constexpr size_t WS_WS2 = WS_WS13 + 4 * MiB;
constexpr size_t WS_H = WS_WS2 + 2 * MiB;
constexpr int HROWS_R = 65536 + 64 * 256, HROWS = HROWS_R + NTOK;
constexpr size_t WS_ROUTE = WS_H + (size_t)HROWS * EH * 2;
constexpr size_t RT_EID = 0, RT_GATE = RT_EID + (size_t)NTOK * 8 * 4, RT_POS = RT_GATE + (size_t)NTOK * 8 * 4, RT_LIST = RT_POS + (size_t)NTOK * 8 * 4,
                 RT_IDENT = RT_LIST + (size_t)NE * NTOK * 4, RT_END = RT_IDENT + (size_t)NTOK * 4;
constexpr size_t WS_R = (WS_ROUTE + RT_END + MiB - 1) / MiB * MiB;
constexpr size_t WS_Y = WS_R;
constexpr size_t WS_WIN = WS_R;
constexpr size_t WS_WAU = WS_WIN + 31 * MiB, WS_WPU = WS_WAU + 4 * MiB, WS_WOUT = WS_WPU + 4 * MiB, WS_PLIN = WS_WOUT + 8 * MiB, WS_WR = WS_PLIN + MiB / 2;
constexpr size_t WS_HB = WS_WR + MiB / 2;
constexpr size_t WS_Q = WS_HB + 32 * MiB, WS_K = WS_Q + 16 * MiB, WS_V = WS_K + 4 * MiB, WS_QI = WS_V + 4 * MiB, WS_KW = WS_QI + 16 * MiB, WS_U = WS_KW + 4 * MiB,
                 WS_G = WS_U + 16 * MiB;
constexpr size_t WS_POOLED = WS_G + 64 * MiB, WS_POOL = WS_POOLED + 16 * MiB, WS_ATTN = WS_POOL + 16 * MiB, WS_MERGED = WS_ATTN + 16 * MiB, WS_MASK = WS_MERGED + 32 * MiB,
                 WS_H8 = WS_MASK + 4 * MiB,
                 WS_REND = WS_H8 + 32 * MiB;
constexpr size_t WS_END = WS_Y + (size_t)HROWS_R * DM * 2;
static_assert(WS_REND <= WS_END, "overlay region");
constexpr int CW_BAR = 4096;
constexpr int CW_ECNT = 8192;
constexpr int CW_CONVQ = 12288;
constexpr int CW_DONE = 12544;
constexpr int CW_MOD = 16384;
static_assert((CW_MOD + 2 * 6 * DM) * 4 <= (int)CTL_BYTES, "ctl");

__device__ __forceinline__ int lane_id() { int l; asm volatile("v_mbcnt_lo_u32_b32 %0, -1, 0\n\tv_mbcnt_hi_u32_b32 %0, -1, %0" : "=v"(l)); return l; }
__device__ __forceinline__ unsigned cvt_pk_bf16(float lo, float hi) { unsigned r; asm volatile("v_cvt_pk_bf16_f32 %0, %1, %2" : "=v"(r) : "v"(lo), "v"(hi)); return r; }
__device__ __forceinline__ unsigned pk4_fp8(float a, float b, float c, float d) {
    a = __builtin_amdgcn_fmed3f(a, -448.f, 448.f); b = __builtin_amdgcn_fmed3f(b, -448.f, 448.f); c = __builtin_amdgcn_fmed3f(c, -448.f, 448.f); d = __builtin_amdgcn_fmed3f(d, -448.f, 448.f);
    int w = __builtin_amdgcn_cvt_pk_fp8_f32(a, b, 0, false); w = __builtin_amdgcn_cvt_pk_fp8_f32(c, d, w, true); return (unsigned)w; }
#ifndef FP8_INPROJ
#define FP8_INPROJ 0
#endif
#ifndef FP8_MERGE
#define FP8_MERGE 1
#endif
#ifndef FP8_OUT
#define FP8_OUT 1
#endif
constexpr float W8_SCALE = 8.f;   constexpr int W8_E8 = 127 - 3;
constexpr float H8_SCALE = 8.f;   constexpr int H8_E8 = 127 - 3;
constexpr float A8_SCALE = 8.f;   constexpr int A8_E8 = 127 - 3;
__device__ __forceinline__ float bf2f(unsigned short b) { return __uint_as_float(((unsigned)b) << 16); }
__device__ __forceinline__ float bflo(unsigned w) { return __uint_as_float(w << 16); }
__device__ __forceinline__ float bfhi(unsigned w) { return __uint_as_float(w & 0xffff0000u); }
__device__ __forceinline__ float wave_sum(float v) {
#pragma unroll
    for (int o = 1; o < 64; o <<= 1) v += __shfl_xor(v, o);
    return v;
}
__device__ __forceinline__ float sigmoidf_(float x) { return 1.0f / (1.0f + __expf(-x)); }

#define XB_TMO      128
#define XB_XCNT(j)  (256  + 64 * (j))
#define XB_XSUB(j)  (1280 + 64 * (j))
#define XB_XGEN(j)  (2304 + 64 * (j))
#define XB_TOP      3328
#define XB_TOPGEN   3392
#define XCD_BAR_WORDS 3456
#define XB_SPIN_CAP (1u << 18)
__device__ __forceinline__ unsigned xb_ld(unsigned* p)              { return __hip_atomic_load(p, __ATOMIC_RELAXED, __HIP_MEMORY_SCOPE_AGENT); }
__device__ __forceinline__ unsigned xb_add(unsigned* p, unsigned v) { return __hip_atomic_fetch_add(p, v, __ATOMIC_RELAXED, __HIP_MEMORY_SCOPE_AGENT); }
__device__ __forceinline__ unsigned xb_xcc_id() { return (unsigned)__builtin_amdgcn_s_getreg((3 << 11) | 20) & 0xFu; }
#define XB_SPIN(cond, bar) do { unsigned _sp = 0; while (cond) { __builtin_amdgcn_s_sleep(1); \
    if ((++_sp & 255u) == 0u) { if (xb_ld(&(bar)[XB_TMO])) break; if (_sp > XB_SPIN_CAP) { atomicAdd(&(bar)[XB_TMO], 1u); break; } } } } while (0)
struct XcdBarrier { unsigned* bar; unsigned x; volatile LAS unsigned* st; };
__device__ __forceinline__ XcdBarrier xcd_barrier_post(unsigned* bar, volatile LAS unsigned* st, int wave) {
    XcdBarrier b; b.bar = bar; b.x = xb_xcc_id(); b.st = st;
    if (wave == 0 && lane_id() == 0) (void)xb_add(&bar[XB_XCNT(b.x)], 1u);
    return b;
}
__device__ __forceinline__ void xcd_barrier_complete(unsigned* bar, unsigned x, unsigned& nloc, unsigned& nx) {
    const unsigned G = gridDim.x * gridDim.y * gridDim.z;
    unsigned sum, cnt, mine, sp = 0u;
    for (;;) {
        sum = 0u; cnt = 0u; mine = 0u;
#pragma unroll
        for (unsigned j = 0; j < 16; ++j) { const unsigned c = xb_ld(&bar[XB_XCNT(j)]); sum += c; cnt += (c > 0u) ? 1u : 0u; mine = (j == x) ? c : mine; }
        if (sum == G) break;
        __builtin_amdgcn_s_sleep(1);
        if ((++sp & 255u) == 0u) { if (xb_ld(&bar[XB_TMO])) break; if (sp > XB_SPIN_CAP) { atomicAdd(&bar[XB_TMO], 1u); break; } }
    }
    nloc = mine > 0u ? mine : 1u; nx = cnt > 0u ? cnt : 1u;
}
__device__ __forceinline__ void xcd_barrier(const XcdBarrier& b, int wave) {
    asm volatile("s_waitcnt vmcnt(0)" ::: "memory");
    __syncthreads();
    if (wave == 0 && lane_id() == 0) {
        unsigned* bar = b.bar;
        __builtin_amdgcn_s_waitcnt(0);
        unsigned nloc = b.st[0], nx = b.st[1];
        if (nloc == 0u) { xcd_barrier_complete(bar, b.x, nloc, nx); b.st[0] = nloc; b.st[1] = nx; }
        const unsigned old = xb_add(&bar[XB_XSUB(b.x)], 1u);
        const unsigned gen = old / nloc;
        if (old + 1u == (gen + 1u) * nloc) {
            __builtin_amdgcn_fence(__ATOMIC_RELEASE, "agent");
            asm volatile("s_waitcnt vmcnt(0)" ::: "memory");
            const unsigned og = xb_add(&bar[XB_TOP], 1u);
            const unsigned tg = og / nx;
            if (og + 1u == (tg + 1u) * nx) xb_add(&bar[XB_TOPGEN], 1u);
            else XB_SPIN(xb_ld(&bar[XB_TOPGEN]) == tg, bar);
            __builtin_amdgcn_fence(__ATOMIC_ACQUIRE, "agent");
            xb_add(&bar[XB_XGEN(b.x)], 1u);
            asm volatile("s_waitcnt vmcnt(0)" ::: "memory");
        } else {
            XB_SPIN(xb_ld(&bar[XB_XGEN(b.x)]) == gen, bar);
            __builtin_amdgcn_fence(__ATOMIC_ACQUIRE, "agent");
            asm volatile("s_waitcnt vmcnt(0)" ::: "memory");
        }
    }
    __syncthreads();
}
namespace pg8 {
constexpr int BM = 256, BK = 64, HALF = 128, HTB = HALF * BK * 2, STAGE_BYTES = 8 * HTB, NXCD = 8, WGM = 8;
__host__ __device__ __forceinline__ int lds_byte(int r, int c) { const int st = (r >> 4) * 2 + (c >> 5), rr = r & 15, cc = c & 31, ob = rr * 64 + cc * 2; return st * 1024 + (ob ^ (((ob >> 9) & 1) << 5)); }
__host__ __device__ __forceinline__ void stage_rc(int b, int& R, int& C) { const int st = b / 1024, sb = b % 1024, swz = sb ^ (((sb >> 9) & 1) << 5); R = (st >> 1) * 16 + swz / 64; C = (st & 1) * 32 + (swz % 64) / 2; }
__host__ __device__ __forceinline__ int perm32(int rho) { const int n = rho >> 4, i = rho & 15; return 8 * (i >> 2) + 4 * n + (i & 3); }

struct Unit { const char* A; const char* B; const int* tok; int pm, pn, aux; int nt8; };

struct TileOrder {
    int nM, nN, nwg, G, c;
    __device__ void init(int M, int N, int G_, int c_) { nM = M / BM; nN = N / BM; nwg = nM * nN; G = G_; c = c_; }
    __device__ bool tile(int i, int& pm, int& pn) const {
        const long L = (long)i * G + c; if (L >= nwg) return false;
        int wgid = (int)L; { const int q = nwg / NXCD, r = nwg % NXCD, xcd = wgid % NXCD, off = wgid / NXCD; wgid = (xcd < r ? xcd * (q + 1) : r * (q + 1) + (xcd - r) * q) + off; }
        const int nig = WGM * nN, gid = wgid / nig, fm = gid * WGM, gsz = (nM - fm) < WGM ? (nM - fm) : WGM;
        pm = fm + ((wgid % nig) % gsz); pn = (wgid % nig) / gsz; return true;
    }
};

typedef int i32x8 __attribute__((ext_vector_type(8)));
template <class Epi, class Sched, bool GATHER, int ES = 2, int SCA = 127, int SCB = 127, bool MIXED = false>
__device__ __forceinline__ void gemm_phase(LAS unsigned char* lds, const int wid, const int Kb, const int ldab, const Sched& S, const Epi& E, const int nt_ovr = 0) {
    const int lane = lane_id(), tid = wid * 64 + lane, wr = wid >> 2, wc = wid & 3, fr = lane & 15, fq = lane >> 4;
    const int nt = nt_ovr ? nt_ovr : Kb / (BK * 2);
    unsigned voffA[2], voffB[2];
#pragma unroll
    for (int i = 0; i < 2; ++i) { int R, C; stage_rc(tid * 16 + i * 8192, R, C); const int Rb = (R & ~31) + perm32(R & 31);
        voffA[i] = (unsigned)(R * ldab + C * 2); voffB[i] = (unsigned)(Rb * Kb + C * 2); }
    const size_t kstep = (size_t)(BK * 2);
    const size_t hstepA = (size_t)HALF * ldab, hstepB = (size_t)HALF * Kb;
    const unsigned ldsw = (unsigned)wid * 1024u;
    const int aoff = (ES == 2 || MIXED) ? lds_byte(wr * 64 + fr, fq * 8) : lds_byte(wr * 64 + fr, fq * 16), boff = (ES == 2 || MIXED) ? lds_byte(wc * 32 + fr, fq * 8) : lds_byte(wc * 32 + fr, fq * 16);
    constexpr int OFF1 = (ES == 2 || MIXED) ? 1024 : 16;
#define PG8_SA(b, h) (((b) * 2 + (h)) * HTB)
#define PG8_SB(b, h) ((4 + (b) * 2 + (h)) * HTB)
    const unsigned ldsbase = (unsigned)(uintptr_t)lds + ldsw;
#define PG8_DMA2(bufoff, sbase, voff_, i_) do { unsigned keep_; asm volatile("s_mov_b32 %0, m0\n\ts_mov_b32 m0, %3\n\ts_nop 0\n\tglobal_load_lds_dwordx4 %1, %2\n\ts_mov_b32 m0, %0" \
        : "=&s"(keep_) : "v"(voff_), "s"(sbase), "s"(ldsbase + (unsigned)((bufoff) + (i_) * 8192)) : "memory"); } while (0)
#define PG8_STAGEB(bufoff, gbase) do { _Pragma("unroll") for (int _i = 0; _i < 2; ++_i) PG8_DMA2(bufoff, (const char*)(gbase), voffB[_i], _i); } while (0)
#define PG8_STAGEA(bufoff, kt, h, GO) do { _Pragma("unroll") for (int _i = 0; _i < 2; ++_i) { \
        if constexpr (GATHER) PG8_DMA2(bufoff, (const char*)(kt), GO[h][_i], _i); else PG8_DMA2(bufoff, (const char*)(kt) + (h) * hstepA, voffA[_i], _i); } } while (0)
#define PG8_LD8(p0, p1) __builtin_bit_cast(i32x8, __builtin_shufflevector(*(const LAS u32x4*)(p0), *(const LAS u32x4*)(p1), 0, 1, 2, 3, 4, 5, 6, 7))
#define PG8_LDA(dst, b, h) do { _Pragma("unroll") for (int m = 0; m < 4; ++m) dst[m] = PG8_LD8(lds + PG8_SA(b, h) + aoff + m * 2048, lds + PG8_SA(b, h) + aoff + OFF1 + m * 2048); } while (0)
#define PG8_LDB(dst, b, h) do { _Pragma("unroll") for (int n = 0; n < 2; ++n) dst[n] = PG8_LD8(lds + PG8_SB(b, h) + boff + n * 2048, lds + PG8_SB(b, h) + boff + OFF1 + n * 2048); } while (0)
#define PG8_LO(x) __builtin_bit_cast(bf16x8, __builtin_shufflevector(x, x, 0, 1, 2, 3))
#define PG8_HI(x) __builtin_bit_cast(bf16x8, __builtin_shufflevector(x, x, 4, 5, 6, 7))
#define PG8_MMA16(ai, bj, At, Bt) do { _Pragma("unroll") for (int m = 0; m < 4; ++m) _Pragma("unroll") for (int n = 0; n < 2; ++n) { \
        acc[ai][bj][m][n] = __builtin_amdgcn_mfma_f32_16x16x32_bf16(PG8_LO(Bt[n]), PG8_LO(At[m]), acc[ai][bj][m][n], 0, 0, 0); \
        acc[ai][bj][m][n] = __builtin_amdgcn_mfma_f32_16x16x32_bf16(PG8_HI(Bt[n]), PG8_HI(At[m]), acc[ai][bj][m][n], 0, 0, 0); } } while (0)
#define PG8_MMA8(ai, bj, At, Bt) do { _Pragma("unroll") for (int m = 0; m < 4; ++m) _Pragma("unroll") for (int n = 0; n < 2; ++n) \
        acc[ai][bj][m][n] = __builtin_amdgcn_mfma_scale_f32_16x16x128_f8f6f4(Bt[n], At[m], acc[ai][bj][m][n], 0, 0, 0, SCB * 0x01010101, 0, SCA * 0x01010101); } while (0)
#define PG8_MMA(ai, bj, At, Bt) do { __builtin_amdgcn_s_setprio(1); \
        if constexpr (MIXED) { if (cur8) PG8_MMA8(ai, bj, At, Bt); else PG8_MMA16(ai, bj, At, Bt); } \
        else if constexpr (ES == 2) PG8_MMA16(ai, bj, At, Bt); else PG8_MMA8(ai, bj, At, Bt); \
        __builtin_amdgcn_s_setprio(0); } while (0)
#define PG8_WAIT_V(n) asm volatile("s_waitcnt vmcnt(" #n ")" ::: "memory")
#define PG8_WAIT_L(n) asm volatile("s_waitcnt lgkmcnt(" #n ")" ::: "memory")
#define PG8_BAR __builtin_amdgcn_s_barrier()
#define PG8_SCHED __builtin_amdgcn_sched_barrier(0)
#define PG8_GLOAD(GO, u) do { if constexpr (GATHER) { const int _tid = wid * 64 + lane_id(); _Pragma("unroll") for (int _i = 0; _i < 2; ++_i) { int _R, _C; stage_rc(_tid * 16 + _i * 8192, _R, _C); \
        _Pragma("unroll") for (int _h = 0; _h < 2; ++_h) { unsigned _t = (unsigned)(u).tok[_h * HALF + _R]; _t = _t < (unsigned)NTOK ? _t : (unsigned)(NTOK - 1); GO[_h][_i] = _t * (unsigned)ldab + (unsigned)_C * 2u; } } } } while (0)
    Unit cur, nxt; int ui = 0;
    if (!S.next(0, cur)) return;
    f32x4 acc[2][2][4][2];
#pragma unroll
    for (int a = 0; a < 2; ++a)
#pragma unroll
        for (int b = 0; b < 2; ++b)
#pragma unroll
            for (int m = 0; m < 4; ++m)
#pragma unroll
                for (int n = 0; n < 2; ++n) acc[a][b][m][n] = (f32x4){0.f, 0.f, 0.f, 0.f};
    i32x8 At[4], B0[2], B1[2];
    unsigned gC[2][2] = {{0u, 0u}, {0u, 0u}}, gN[2][2] = {{0u, 0u}, {0u, 0u}};
    PG8_GLOAD(gC, cur);
    const char* cA = cur.A; const char* cB = cur.B;
    bool cur8 = MIXED && cur.nt8 > 0; int ntc = cur8 ? cur.nt8 : nt;
    PG8_STAGEB(PG8_SB(0, 0), cB); PG8_STAGEB(PG8_SB(0, 1), cB + hstepB); PG8_STAGEA(PG8_SA(0, 0), cA, 0, gC); PG8_STAGEA(PG8_SA(0, 1), cA, 1, gC);
    if (wr == 1) PG8_BAR;
    PG8_WAIT_V(2); PG8_BAR;
    PG8_STAGEB(PG8_SB(1, 0), cB + kstep); PG8_STAGEA(PG8_SA(1, 0), cA + kstep, 0, gC); PG8_STAGEB(PG8_SB(1, 1), cB + hstepB + kstep);
    PG8_WAIT_V(6); PG8_BAR;
    for (;;) {
        const bool has_next = S.next(ui + 1, nxt);
        if (has_next) PG8_GLOAD(gN, nxt);
        const char* nA = has_next ? nxt.A : cA; const char* nB = has_next ? nxt.B : cB;
#pragma clang loop unroll(disable)
        for (int t = 0; t < ntc; t += 2) {
            const bool last = (t == ntc - 2);
            const char* a1 = cA + (size_t)(t + 1) * kstep;
            const char* a2 = last ? nA : cA + (size_t)(t + 2) * kstep; const char* b2 = last ? nB : cB + (size_t)(t + 2) * kstep;
            const char* a3 = a2 + kstep; const char* b3 = b2 + kstep;
            PG8_LDB(B0, 0, 0); PG8_LDB(B1, 0, 1); PG8_SCHED; PG8_LDA(At, 0, 0); PG8_STAGEA(PG8_SA(1, 1), a1, 1, gC);
            if (GATHER && last && has_next) {
#pragma unroll
                for (int _h = 0; _h < 2; ++_h)
#pragma unroll
                    for (int _i = 0; _i < 2; ++_i) gC[_h][_i] = gN[_h][_i];
            }
            PG8_WAIT_V(8); PG8_WAIT_L(0); PG8_BAR; PG8_MMA(0, 0, At, B0); PG8_MMA(0, 1, At, B1); PG8_BAR; PG8_SCHED;
            PG8_LDA(At, 0, 1); PG8_STAGEB(PG8_SB(0, 0), b2); PG8_STAGEB(PG8_SB(0, 1), b2 + hstepB); PG8_STAGEA(PG8_SA(0, 0), a2, 0, gC);
            PG8_WAIT_V(8); PG8_WAIT_L(0); PG8_BAR; PG8_MMA(1, 0, At, B0); PG8_MMA(1, 1, At, B1); PG8_BAR; PG8_SCHED;
            PG8_LDB(B0, 1, 0); PG8_LDB(B1, 1, 1); PG8_SCHED; PG8_LDA(At, 1, 0); PG8_STAGEA(PG8_SA(0, 1), a2, 1, gC);
            PG8_WAIT_V(8); PG8_WAIT_L(0); PG8_BAR; PG8_MMA(0, 0, At, B0); PG8_MMA(0, 1, At, B1); PG8_BAR; PG8_SCHED;
            PG8_LDA(At, 1, 1); PG8_STAGEB(PG8_SB(1, 0), b3); PG8_STAGEB(PG8_SB(1, 1), b3 + hstepB); PG8_STAGEA(PG8_SA(1, 0), a3, 0, gC);
            PG8_WAIT_V(8); PG8_WAIT_L(0); PG8_BAR; PG8_MMA(1, 0, At, B0); PG8_MMA(1, 1, At, B1); PG8_BAR; PG8_SCHED;
        }
        if (wr == 0) PG8_BAR;
        asm volatile("s_nop 15\n\ts_nop 7" ::: "memory");
        const int le_ = lane_id();
        const bool keep = E(acc, cur, wr, wc, le_ & 15, le_ >> 4);
        if (!has_next) break;
        if (!keep) {
#pragma unroll
        for (int a = 0; a < 2; ++a)
#pragma unroll
            for (int b = 0; b < 2; ++b)
#pragma unroll
                for (int m = 0; m < 4; ++m)
#pragma unroll
                    for (int n = 0; n < 2; ++n) acc[a][b][m][n] = (f32x4){0.f, 0.f, 0.f, 0.f};
        }
        cur = nxt; cA = nA; cB = nB; ++ui; cur8 = MIXED && cur.nt8 > 0; ntc = cur8 ? cur.nt8 : nt;
        if (wr == 1) PG8_BAR;
    }
    PG8_WAIT_V(0);
    PG8_BAR;
#undef PG8_SA
#undef PG8_SB
#undef PG8_DMA2
#undef PG8_STAGEA
#undef PG8_STAGEB
#undef PG8_LDA
#undef PG8_LDB
#undef PG8_MMA
#undef PG8_MMA8
#undef PG8_MMA16
#undef PG8_LD8
#undef PG8_LO
#undef PG8_HI
#undef PG8_WAIT_V
#undef PG8_WAIT_L
#undef PG8_BAR
#undef PG8_SCHED
#undef PG8_GLOAD
}
}
struct Args { const float* in[22]; float* out; unsigned char* ws; int ph_lo, ph_hi; };
enum { I_X = 0, I_C, I_WADA, I_BADA, I_GMIX, I_WIN, I_QNORM, I_KNORM, I_WAU, I_PLIN, I_PSCALE, I_WPU, I_WOUT, I_GFFN, I_WROUTER, I_RBIAS, I_W1, I_W3, I_W2, I_WS1, I_WS3, I_WS2 };
struct Frame {
    LAS unsigned char* lds;
    int wave, G, gw, NGW;
    unsigned char* ws; unsigned* ctl; float* out;
};
#define LDS_WAIT() asm volatile("s_waitcnt lgkmcnt(0)" ::: "memory")
#define VM_WAIT() asm volatile("s_waitcnt vmcnt(0)" ::: "memory")

__device__ __forceinline__ void tr_tile(const float* __restrict__ src, int ld_src, int nvalid, bf16_t* __restrict__ dst, int ld_dst, int lane) {
    const int q = lane >> 4, c4 = (lane & 15) * 4;
    const bool ok = c4 < nvalid;
#pragma unroll
    for (int g = 0; g < 2; ++g) {
        f32x4 v[8];
#pragma unroll
        for (int j = 0; j < 8; ++j) { const int k = 32 * g + 8 * q + j; v[j] = ok ? *(const f32x4*)(src + (size_t)k * ld_src + c4) : (f32x4){0.f, 0.f, 0.f, 0.f}; }
#pragma unroll
        for (int nn = 0; nn < 4; ++nn) {
            u32x4 w; w.x = cvt_pk_bf16(v[0][nn], v[1][nn]); w.y = cvt_pk_bf16(v[2][nn], v[3][nn]); w.z = cvt_pk_bf16(v[4][nn], v[5][nn]); w.w = cvt_pk_bf16(v[6][nn], v[7][nn]);
            *(u32x4*)(dst + (size_t)(c4 + nn) * ld_dst + 32 * g + 8 * q) = w;
        }
    }
}
__device__ __forceinline__ void tr8_issue(const float* __restrict__ src, int ld_src, int lane, f32x4 (&v)[16], int nvalid = 64) {
    const int q = lane >> 4, c4 = (lane & 15) * 4; const bool ok = c4 < nvalid;
    const unsigned voff = (unsigned)((16 * q) * ld_src + c4) * 4u;
#pragma unroll
    for (int j = 0; j < 16; ++j) v[j] = ok ? __builtin_nontemporal_load((const f32x4*)((const char*)src + (size_t)j * ld_src * 4 + voff)) : (f32x4){0.f, 0.f, 0.f, 0.f};
}
__device__ __forceinline__ void tr8_finish(unsigned char* __restrict__ dst, int ld_dst, int lane, const f32x4 (&v)[16]) {
    const int q = lane >> 4, c4 = (lane & 15) * 4;
#pragma unroll
    for (int nn = 0; nn < 4; ++nn) { u32x4 w;
#pragma unroll
        for (int t = 0; t < 4; ++t) w[t] = pk4_fp8(v[4 * t][nn] * W8_SCALE, v[4 * t + 1][nn] * W8_SCALE, v[4 * t + 2][nn] * W8_SCALE, v[4 * t + 3][nn] * W8_SCALE);
        *(u32x4*)(dst + (size_t)(c4 + nn) * ld_dst + 16 * q) = w; }
}
template <bool F8>
__device__ __forceinline__ void wcopy_tile(const float* src, int ld_src, int nvalid, unsigned char* dstbase, size_t drow, int ldk, int k0, int lane) {
    if constexpr (F8) { f32x4 v[16]; tr8_issue(src, ld_src, lane, v, nvalid); tr8_finish(dstbase + drow * ldk + k0, ldk, lane, v); }
    else tr_tile(src, ld_src, nvalid, (bf16_t*)dstbase + drow * ldk + k0, ldk, lane);
}
constexpr int ADA_WGS = 6 * DM / 128;
__device__ __forceinline__ void p0_prologue(Frame& F, const Args& a) {
    LAS float* sc = (LAS float*)F.lds;
    const int lane = lane_id(), tid = F.wave * 64 + lane;
    for (int i = tid; i < NB * DM; i += NTHR) { const float c = a.in[I_C][i]; sc[i] = c / (1.0f + __expf(-c)); }
    __syncthreads();
    float* mod = (float*)(F.ctl + CW_MOD);
    unsigned char* ws = F.ws;
    for (int job = blockIdx.x; job < 2 * ADA_WGS; job += F.G) {
        const int strip = job % ADA_WGS, kh = job / ADA_WGS, w = F.wave, krow0 = kh * 1024 + 128 * w;
        const int l32 = lane & 31, hb = lane >> 5;
        const float* wp = a.in[I_WADA] + (size_t)(krow0 + hb) * (6 * DM) + strip * 128 + 4 * l32;
        f32x4 b0 = {0.f, 0.f, 0.f, 0.f}, b1 = {0.f, 0.f, 0.f, 0.f};
#pragma unroll 16
        for (int k = 0; k < 64; ++k) { const f32x4 wv = *(const f32x4*)(wp + (size_t)(2 * k) * (6 * DM)); const float s0 = sc[krow0 + 2 * k + hb], s1 = sc[DM + krow0 + 2 * k + hb]; b0 += wv * s0; b1 += wv * s1; }
#pragma unroll
        for (int j = 0; j < 4; ++j) { b0[j] += __shfl_xor(b0[j], 32); b1[j] += __shfl_xor(b1[j], 32); }
        const int col2 = 2 * (lane & 1);
        const f32x2 a0 = {hb ? b0[2] : b0[0], hb ? b0[3] : b0[1]}, a1 = {hb ? b1[2] : b1[0], hb ? b1[3] : b1[1]};
        const int pcol = 4 * l32 + 2 * hb; (void)col2;
        LAS float* part = (LAS float*)(F.lds + 16384);
        *(LAS f32x2*)(part + (w * 2 + 0) * 128 + pcol) = a0; *(LAS f32x2*)(part + (w * 2 + 1) * 128 + pcol) = a1;
        __syncthreads();
        if (tid < 256) { const int b = tid >> 7, c = tid & 127; float sum = kh == 0 ? a.in[I_BADA][strip * 128 + c] : 0.f;
#pragma unroll
            for (int ww = 0; ww < 8; ++ww) sum += part[(ww * 2 + b) * 128 + c];
            unsafeAtomicAdd(mod + b * 6 * DM + strip * 128 + c, sum); }
        __syncthreads();
    }
    unsigned char* Win8 = ws + WS_WIN;
    constexpr int J_IN_A = 32 * 40, J_IN_B = 32 * 4, J_IN_C = 32 * 80, J_AU = 16 * 32, J_PU = 16 * 32, J_OUT = 32 * 32, J_PL = 4 * 16, J_S13 = 2 * 32 * 8, J_S2 = 8 * 32, J_WR = 32,
                  J_W13 = 0, J_W2 = 0;
    constexpr int NITEMS = J_IN_A + J_IN_B + J_IN_C + J_AU + J_PU + J_OUT + J_PL + J_S13 + J_S2 + J_WR;
    for (int it = F.gw; it < NITEMS; it += F.NGW) {
        int r = it;
        if (r < J_IN_A) { const int kb = r / 40, nb = r % 40; if ((nb >> 2) == 5) wcopy_tile<true>(a.in[I_WIN] + (size_t)(64 * kb) * INW + 64 * nb, INW, 64, Win8, (size_t)(64 * nb), 2 * DM, 64 * kb, lane);
            else wcopy_tile<false>(a.in[I_WIN] + (size_t)(64 * kb) * INW + 64 * nb, INW, 64, Win8, (size_t)(64 * nb), DM, 64 * kb, lane); continue; } r -= J_IN_A;
        if (r < J_IN_B) { const int kb = r / 4, nb = r % 4; const int nv = nb == 0 ? 64 : (nb == 1 ? 16 : 0);
            wcopy_tile<false>(a.in[I_WIN] + (size_t)(64 * kb) * INW + 2560 + (nb < 2 ? 64 * nb : 0), INW, nv, Win8, (size_t)(2560 + 64 * nb), DM, 64 * kb, lane); continue; } r -= J_IN_B;
        if (r < J_IN_C) { const int kb = r / 80, nb = r % 80; wcopy_tile<true>(a.in[I_WIN] + (size_t)(64 * kb) * INW + 2640 + 64 * nb, INW, 64, Win8, (size_t)(2816 + 64 * nb), 2 * DM, 64 * kb, lane); continue; } r -= J_IN_C;
        if (r < J_AU) { const int kb = r / 32, nb = r % 32; wcopy_tile<FP8_MERGE>(a.in[I_WAU] + (size_t)(64 * kb) * DM + 64 * nb, DM, 64, ws + WS_WAU, (size_t)(64 * nb), AW, 64 * kb, lane); continue; } r -= J_AU;
        if (r < J_PU) { const int kb = r / 32, nb = r % 32; wcopy_tile<FP8_MERGE>(a.in[I_WPU] + (size_t)(64 * kb) * DM + 64 * nb, DM, 64, ws + WS_WPU, (size_t)(64 * nb), PW, 64 * kb, lane); continue; } r -= J_PU;
        if (r < J_OUT) { const int kb = r / 32, nb = r % 32; wcopy_tile<FP8_OUT>(a.in[I_WOUT] + (size_t)(64 * kb) * DM + 64 * nb, DM, 64, ws + WS_WOUT, (size_t)(64 * nb), DM, 64 * kb, lane); continue; } r -= J_OUT;
        if (r < J_PL) { const int g = r / 16, kb = (r % 16) / 4, nb = r % 4; tr_tile(a.in[I_PLIN] + (size_t)g * 65536 + (size_t)(64 * kb) * 256 + 64 * nb, 256, 64, (bf16_t*)(ws + WS_PLIN) + (size_t)g * 65536 + (size_t)(64 * nb) * 256 + 64 * kb, 256, lane); continue; } r -= J_PL;
        if (r < J_S13) { const int which = r / 256, kb = (r % 256) / 8, nb = r % 8; const float* src = (which ? a.in[I_WS3] : a.in[I_WS1]) + (size_t)(64 * kb) * EH + 64 * nb;
            f32x4 v[16]; tr8_issue(src, EH, lane, v); tr8_finish(ws + WS_WS13 + (size_t)(256 * (nb >> 1) + 64 * (nb & 1) + 128 * which) * DM + 64 * kb, DM, lane, v); continue; } r -= J_S13;
        if (r < J_S2) { const int kb = r / 32, nb = r % 32; f32x4 v[16]; tr8_issue(a.in[I_WS2] + (size_t)(64 * kb) * DM + 64 * nb, DM, lane, v); tr8_finish(ws + WS_WS2 + (size_t)(64 * nb) * EH + 64 * kb, EH, lane, v); continue; } r -= J_S2;
        { const int kb = r; tr_tile(a.in[I_WROUTER] + (size_t)(64 * kb) * NE, NE, 64, (bf16_t*)(ws + WS_WR) + 64 * kb, DM, lane); }
    }
}

constexpr int NCONV_W13 = NE * 2 * 32 * 8, NCONV = NCONV_W13 + NE * 8 * 32;
__device__ __forceinline__ void conv_ptrs(const Args& a, unsigned char* ws, int it, const float*& src, int& ld_src, unsigned char*& dst, int& ld_dst) {
    if (it < NCONV_W13) { const int e = it / 512, rr = it % 512, which = rr / 256, kb = (rr % 256) / 8, nb = rr % 8;
        src = (which ? a.in[I_W3] : a.in[I_W1]) + ((size_t)e * DM + 64 * kb) * EH + 64 * nb; ld_src = EH;
        dst = ws + WS_W13 + ((size_t)e * 1024 + 256 * (nb >> 1) + 64 * (nb & 1) + 128 * which) * DM + 64 * kb; ld_dst = DM; }
    else { const int r = it - NCONV_W13, e = r / 256, kb = (r % 256) / 32, nb = r % 32;
        src = a.in[I_W2] + ((size_t)e * EH + 64 * kb) * DM + 64 * nb; ld_src = DM; dst = ws + WS_W2 + ((size_t)e * DM + 64 * nb) * EH + 64 * kb; ld_dst = EH; }
}
__device__ __forceinline__ void conv_issue16(const Args& a, unsigned char* ws, int it, int lane, f32x4 (&v)[16]) {
    const float* src; int ld_src; unsigned char* dst; int ld_dst; conv_ptrs(a, ws, it, src, ld_src, dst, ld_dst); tr8_issue(src, ld_src, lane, v); }
__device__ __forceinline__ void conv_finish16(const Args& a, unsigned char* ws, int it, int lane, const f32x4 (&v)[16]) {
    const float* src; int ld_src; unsigned char* dst; int ld_dst; conv_ptrs(a, ws, it, src, ld_src, dst, ld_dst); tr8_finish(dst, ld_dst, lane, v); }
__device__ __forceinline__ void phase_done(Frame& F, int phase) { __syncthreads(); if (F.wave == 0 && lane_id() == 0) __hip_atomic_fetch_add(F.ctl + CW_DONE + 64 * phase, 1u, __ATOMIC_RELAXED, __HIP_MEMORY_SCOPE_AGENT); }
constexpr int CONV_SEG1_END = NCONV_W13 + (NCONV - NCONV_W13) * 3 / 10 / 8 * 8;
__device__ __forceinline__ unsigned conv_seg_lo(int sg) { return sg == 0 ? 0u : (sg == 1 ? (unsigned)NCONV_W13 : (unsigned)CONV_SEG1_END); }
__device__ __forceinline__ unsigned conv_seg_hi(int sg) { return sg == 0 ? (unsigned)NCONV_W13 : (sg == 1 ? (unsigned)CONV_SEG1_END : (unsigned)NCONV); }
template <bool BOUNDED, int SEG_LO, int SEG_HI>
struct ConvQ {
    Frame& F; int phase, lane; unsigned cur, end; int sg;
    __device__ __forceinline__ int next() {
        constexpr unsigned B = BOUNDED ? 6u : 8u;
        while (cur >= end) {
            if (BOUNDED) { const unsigned d = __hip_atomic_load(F.ctl + CW_DONE + 64 * phase, __ATOMIC_RELAXED, __HIP_MEMORY_SCOPE_AGENT); if ((unsigned)__builtin_amdgcn_readfirstlane(d) >= (unsigned)F.G) return -1; }
            const unsigned lo = conv_seg_lo(sg), hi = conv_seg_hi(sg);
            unsigned s = 0; if (lane == 0) s = __hip_atomic_fetch_add(F.ctl + CW_CONVQ + 64 * sg, B, __ATOMIC_RELAXED, __HIP_MEMORY_SCOPE_AGENT);
            s = (unsigned)__builtin_amdgcn_readfirstlane(s) + lo;
            if (s >= hi) { if (sg < SEG_HI) { ++sg; continue; } return -1; }
            cur = s; end = s + B < hi ? s + B : hi;
        }
        return (int)cur++;
    }
};
template <bool BOUNDED, int SEG_LO, int SEG_HI>
__device__ __forceinline__ void conv_drain(Frame& F, const Args& a, int phase, int quota = 0) {
    const int lane = lane_id();
    ConvQ<BOUNDED, SEG_LO, SEG_HI> Q{F, phase, lane, 0u, 0u, SEG_LO};
    f32x4 va[16], vb[16]; int n = 0;
    int ia = Q.next(); if (ia < 0) return;
    conv_issue16(a, F.ws, ia, lane, va);
    for (;;) {
        ++n; const int ib = (quota > 0 && n >= quota && Q.cur >= Q.end) ? -1 : Q.next(); if (ib >= 0) conv_issue16(a, F.ws, ib, lane, vb);
        conv_finish16(a, F.ws, ia, lane, va);
        if (ib < 0) break;
        ++n; ia = (quota > 0 && n >= quota && Q.cur >= Q.end) ? -1 : Q.next(); if (ia >= 0) conv_issue16(a, F.ws, ia, lane, va);
        conv_finish16(a, F.ws, ib, lane, vb);
        if (ia < 0) break;
    }
}

__device__ __forceinline__ void modnorm_row(const float* __restrict__ xrow, const float* __restrict__ g, const float* __restrict__ shift, const float* __restrict__ scale, unsigned char* __restrict__ orow, unsigned char* __restrict__ orow8, int lane) {
    f32x4 v[8]; float ss = 0.f;
#pragma unroll
    for (int j = 0; j < 8; ++j) { v[j] = *(const f32x4*)(xrow + 4 * lane + 256 * j); ss += (v[j].x * v[j].x + v[j].y * v[j].y) + (v[j].z * v[j].z + v[j].w * v[j].w); }
    const float rstd = rsqrtf(wave_sum(ss) * (1.0f / DM) + NORM_EPS);
#pragma unroll
    for (int j = 0; j < 8; ++j) { const int c = 4 * lane + 256 * j;
        const f32x4 gg = *(const f32x4*)(g + c), sh = *(const f32x4*)(shift + c), sl = *(const f32x4*)(scale + c);
        const f32x4 o = v[j] * rstd * gg * (sl + 1.0f) + sh;
        { u32x2 w; w.x = cvt_pk_bf16(o.x, o.y); w.y = cvt_pk_bf16(o.z, o.w); *(u32x2*)((bf16_t*)orow + c) = w; }
        if (orow8) *(unsigned*)(orow8 + c) = pk4_fp8(o.x * A8_SCALE, o.y * A8_SCALE, o.z * A8_SCALE, o.w * A8_SCALE); }
}
__device__ __forceinline__ void p1_h(Frame& F, const Args& a) {
    const float* mod = (const float*)(F.ctl + CW_MOD);
    unsigned char* hb = F.ws + WS_HB; const int lane = lane_id();
    for (int m = F.gw; m < NTOK; m += F.NGW) { const int b = m / SEQ;
        modnorm_row(a.in[I_X] + (size_t)m * DM, a.in[I_GMIX], mod + b * 6 * DM + 0 * DM, mod + b * 6 * DM + 1 * DM, hb + (size_t)m * DM * 2, F.ws + WS_H8 + (size_t)m * DM * 2, lane); }
}
struct SchedDense {
    pg8::TileOrder T; const char* A; const char* B; size_t a_tile, b_tile;
    __device__ __forceinline__ bool next(int i, pg8::Unit& u) const { int pm, pn; if (!T.tile(i, pm, pn)) return false; u.pm = pm; u.pn = pn; u.aux = 0; u.tok = nullptr; u.nt8 = 0;
        u.A = A + (size_t)pm * a_tile; u.B = B + (size_t)pn * b_tile; return true; }
};
__device__ __forceinline__ void st_bf16x8(bf16_t* p, f32x4 v0, f32x4 v1) { u32x4 w; w.x = cvt_pk_bf16(v0[0], v0[1]); w.y = cvt_pk_bf16(v0[2], v0[3]); w.z = cvt_pk_bf16(v1[0], v1[1]); w.w = cvt_pk_bf16(v1[2], v1[3]); *(u32x4*)p = w; }
struct EpiInproj {
    unsigned char* ws;
    __device__ __forceinline__ bool operator()(f32x4 (&acc)[2][2][4][2], const pg8::Unit& u, int wr, int wc, int fr, int fq) const {
        const int pn = u.pn; bf16_t* base; int ld, ct; bool sig = false;
        if (pn < 4) { base = (bf16_t*)(ws + WS_Q); ld = AW; ct = pn; }
        else if (pn == 4) { base = (bf16_t*)(ws + WS_K); ld = KVW; ct = 0; }
        else if (pn == 5) { base = (bf16_t*)(ws + WS_V); ld = KVW; ct = 0; }
        else if (pn < 10) { base = (bf16_t*)(ws + WS_QI); ld = IH * ID; ct = pn - 6; }
        else if (pn == 10) { base = (bf16_t*)(ws + WS_KW); ld = 256; ct = 0; }
        else if (pn < 15) { base = (bf16_t*)(ws + WS_U); ld = PW; ct = pn - 11; }
        else { base = (bf16_t*)(ws + WS_G); ld = 2 * DM; ct = pn - 15; sig = true; }
        const int row0 = u.pm * 256 + wr * 64 + fr, col0 = ct * 256 + wc * 32 + 8 * fq;
#pragma unroll
        for (int ai = 0; ai < 2; ++ai)
#pragma unroll
            for (int m = 0; m < 4; ++m) { bf16_t* rowp = base + (size_t)(row0 + ai * 128 + m * 16) * ld + col0;
#pragma unroll
                for (int bj = 0; bj < 2; ++bj) { f32x4 v0 = acc[ai][bj][m][0], v1 = acc[ai][bj][m][1];
                    if (sig) {
#pragma unroll
                        for (int j = 0; j < 4; ++j) { v0[j] = fminf(__builtin_amdgcn_rcpf(1.0f + __expf(-v0[j])), 1.0f); v1[j] = fminf(__builtin_amdgcn_rcpf(1.0f + __expf(-v1[j])), 1.0f); } }
                    st_bf16x8(rowp + bj * 128, v0, v1); } }
        return false;
    }
};
struct SchedInproj {
    int G, c, kind; const char* hA; const char* win;
    __device__ __forceinline__ bool next(int i, pg8::Unit& u) const {
        const int first = kind == 0 ? c : c + ((320 - c + G - 1) / G) * G;
        const int j = first + i * G; if (j >= (kind == 0 ? 320 : 992)) return false;
        int pn, pm;
        if (kind == 0) { const int t = j >> 5; pm = j & 31; pn = t < 5 ? t : t + 1; }
        else { const int jj = j - 320, t = jj >> 5; pm = jj & 31; pn = t == 0 ? 5 : t + 10; }
        u.pm = pm; u.pn = pn; u.aux = 0; u.tok = nullptr; u.nt8 = 0;
        u.A = hA + (size_t)pm * 256 * DM * 2; u.B = win + (size_t)pn * 256 * DM * 2; return true; }
};
__device__ __forceinline__ void p2_inproj(Frame& F, const Args& a) {
    const int NG = F.G >= 256 ? 248 : F.G;
    if ((int)blockIdx.x >= NG) { conv_drain<false, 0, 2>(F, a, 2, 24); return; }
    EpiInproj E{F.ws};
    { SchedInproj S{NG, (int)blockIdx.x, 0, (const char*)(F.ws + WS_HB), (const char*)(F.ws + WS_WIN)};
      pg8::gemm_phase<EpiInproj, SchedInproj, false, 2>(F.lds, F.wave, DM * 2, DM * 2, S, E); }
    { SchedInproj S{NG, (int)blockIdx.x, 1, (const char*)(F.ws + WS_H8), (const char*)(F.ws + WS_WIN)};
      pg8::gemm_phase<EpiInproj, SchedInproj, false, 1, A8_E8, W8_E8>(F.lds, F.wave, DM * 2, DM * 2, S, E, DM / 128); }
}
__device__ __forceinline__ void p3_qknorm(Frame& F, const Args& a) {
    bf16_t* K = (bf16_t*)(F.ws + WS_K);
    const int lane = lane_id();
    for (int m = F.gw; m < NTOK; m += F.NGW) {
        u32x2 k0 = *(const u32x2*)(K + (size_t)m * KVW + 4 * lane);
        float kv[4]; float sk = 0.f;
        kv[0] = bflo(k0[0]); kv[1] = bfhi(k0[0]); kv[2] = bflo(k0[1]); kv[3] = bfhi(k0[1]);
#pragma unroll
        for (int j = 0; j < 4; ++j) sk += kv[j] * kv[j];
        sk += __shfl_xor(sk, 1); sk += __shfl_xor(sk, 2); sk += __shfl_xor(sk, 4); sk += __shfl_xor(sk, 8); sk += __shfl_xor(sk, 16);
        const float rk = rsqrtf(sk * (1.0f / HD) + NORM_EPS);
        const int dk = (4 * lane) & 127;
        u32x2 ok; ok[0] = cvt_pk_bf16(kv[0] * rk * a.in[I_KNORM][dk], kv[1] * rk * a.in[I_KNORM][dk + 1]); ok[1] = cvt_pk_bf16(kv[2] * rk * a.in[I_KNORM][dk + 2], kv[3] * rk * a.in[I_KNORM][dk + 3]);
        *(u32x2*)(K + (size_t)m * KVW + 4 * lane) = ok;
    }
}
__device__ __forceinline__ void pooled_item(Frame& F, int t0, int g, int lane) {
    const bf16_t* U = (const bf16_t*)(F.ws + WS_U); bf16_t* P = (bf16_t*)(F.ws + WS_POOLED);
    const int pos0 = t0 % SEQ, w = 2 << g, c = 256 * g + 4 * lane;
    f32x4 W = {0.f, 0.f, 0.f, 0.f};
    for (int j = 1; j <= 16; ++j) { if (j <= w && pos0 - j >= 0) { const u32x2 v = *(const u32x2*)(U + (size_t)(t0 - j) * PW + c); W += (f32x4){bflo(v[0]), bfhi(v[0]), bflo(v[1]), bfhi(v[1])}; } }
#pragma unroll 8
    for (int i = 0; i < 32; ++i) { const int t = t0 + i, pos = pos0 + i;
        const u32x2 v = *(const u32x2*)(U + (size_t)t * PW + c); const f32x4 cur = {bflo(v[0]), bfhi(v[0]), bflo(v[1]), bfhi(v[1])};
        W += cur;
        if (pos - w >= 0) { const u32x2 o = *(const u32x2*)(U + (size_t)(t - w) * PW + c); W -= (f32x4){bflo(o[0]), bfhi(o[0]), bflo(o[1]), bfhi(o[1])}; }
        const float inv = 1.0f / (float)(pos + 1 < w ? pos + 1 : w);
        const f32x4 r = W * inv - cur;
        u32x2 ow; ow[0] = cvt_pk_bf16(r[0], r[1]); ow[1] = cvt_pk_bf16(r[2], r[3]);
        *(u32x2*)(P + (size_t)t * PW + c) = ow; }
}
__device__ __forceinline__ unsigned mono_key(float s) { const unsigned u = __float_as_uint(s); return (u & 0x80000000u) ? ~u : (u | 0x80000000u); }
__device__ __forceinline__ void idx_block(Frame& F, const Args& a, int b, int i16) {
    const bf16_t* QI = (const bf16_t*)(F.ws + WS_QI); const bf16_t* KW = (const bf16_t*)(F.ws + WS_KW);
    unsigned short* MT = (unsigned short*)(F.ws + WS_MASK);
    LAS unsigned* T = (LAS unsigned*)F.lds;
    const int lane = lane_id(), w = F.wave, tid = w * 64 + lane, r32 = lane & 31, hi = lane >> 5;
    const int tpos0 = 16 * i16, t0 = b * SEQ + tpos0, nh = (tpos0 + 16 + 31) >> 5, kzero = 64 * ((tpos0 >> 6) + 1);
    for (int k = tid; k < kzero; k += NTHR) T[k] = 0u;
    bf16x8 Af[4];
    { const int qsel = (r32 >> 2) & 1, head = (r32 & 3) + 4 * (r32 >> 3); const size_t tq = (size_t)(t0 + 2 * w + qsel);
      const float wv = bf2f(KW[tq * 256 + 64 + head]);
#pragma unroll
      for (int s = 0; s < 4; ++s) { const u32x4 q = *(const u32x4*)(QI + tq * (IH * ID) + head * ID + 16 * s + 8 * hi); u32x4 o;
#pragma unroll
          for (int j = 0; j < 4; ++j) o[j] = cvt_pk_bf16(bflo(q[j]) * wv, bfhi(q[j]) * wv);
          Af[s] = __builtin_bit_cast(bf16x8, o); } }
    float X[16];
    { const size_t tq = (size_t)(t0 + 2 * w + hi); const u32x4 w0 = *(const u32x4*)(KW + tq * 256 + 64), w1 = *(const u32x4*)(KW + tq * 256 + 72);
      const float PINF = __builtin_inff();
#pragma unroll
      for (int j = 0; j < 4; ++j) { X[2 * j] = bflo(w0[j]) >= 0.f ? PINF : -PINF; X[2 * j + 1] = bfhi(w0[j]) >= 0.f ? PINF : -PINF;
                                    X[8 + 2 * j] = bflo(w1[j]) >= 0.f ? PINF : -PINF; X[8 + 2 * j + 1] = bfhi(w1[j]) >= 0.f ? PINF : -PINF; } }
    const int mypos = tpos0 + 2 * w + hi;
    unsigned keys[128];
    constexpr int RING = 16384, SLOT = 8192;
    const int nt64 = (nh + 1) >> 1;
    const unsigned dvoff = (unsigned)((lane >> 3) * 512 + (((lane & 7) ^ (lane >> 3)) << 4));
    const char* kwb = (const char*)(KW + (size_t)b * SEQ * 256) + w * 4096;
    const unsigned ldsw = (unsigned)(uintptr_t)F.lds + RING + w * 1024;
#define IDX_DMA(t_) do { unsigned keep_; asm volatile("s_mov_b32 %0, m0\n\ts_mov_b32 m0, %3\n\ts_nop 0\n\tglobal_load_lds_dwordx4 %1, %2\n\ts_mov_b32 m0, %0" \
        : "=&s"(keep_) : "v"(dvoff), "s"(kwb + (size_t)(t_) * 32768), "s"(ldsw + (unsigned)(((t_) & 3) * SLOT)) : "memory"); } while (0)
    int boffs[4];
#pragma unroll
    for (int s = 0; s < 4; ++s) boffs[s] = r32 * 128 + ((((2 * s + hi) ^ (r32 & 7))) << 4);
    __syncthreads();
    if (0 < nt64) IDX_DMA(0);
    if (1 < nt64) IDX_DMA(1);
    if (2 < nt64) IDX_DMA(2);
#pragma unroll
    for (int t = 0; t < 64; ++t) {
        keys[2 * t] = 0u; keys[2 * t + 1] = 0u;
        if (t < nt64) {
            const int rem = nt64 - 1 - t;
            if (rem >= 2) asm volatile("s_waitcnt vmcnt(2)" ::: "memory"); else if (rem == 1) asm volatile("s_waitcnt vmcnt(1)" ::: "memory"); else asm volatile("s_waitcnt vmcnt(0)" ::: "memory");
            __builtin_amdgcn_s_barrier(); asm volatile("" ::: "memory");
            if (t + 3 < nt64) IDX_DMA(t + 3);
#pragma unroll
            for (int half = 0; half < 2; ++half) { const int n = 2 * t + half;
                if (n < nh) {
                    f32x16 acc = {0.f, 0.f, 0.f, 0.f, 0.f, 0.f, 0.f, 0.f, 0.f, 0.f, 0.f, 0.f, 0.f, 0.f, 0.f, 0.f};
#pragma unroll
                    for (int s = 0; s < 4; ++s) { const bf16x8 bfr = *(const LAS bf16x8*)(F.lds + RING + (t & 3) * SLOT + half * 4096 + boffs[s]);
                        acc = __builtin_amdgcn_mfma_f32_32x32x16_bf16(Af[s], bfr, acc, 0, 0, 0); }
                    float sc = 0.f;
#pragma unroll
                    for (int j = 0; j < 16; ++j) sc += __builtin_amdgcn_fmed3f(acc[j], 0.f, X[j]);
                    keys[n] = (32 * n + r32 <= mypos) ? mono_key(sc) : 0u;
                } }
        }
    }
#undef IDX_DMA
    unsigned Tsel = 0u;
    { constexpr int HIST = 49152;
      LAS unsigned* hb = (LAS unsigned*)(F.lds + HIST) + (2 * w + hi) * 512;
      unsigned kk = (unsigned)TOPK; bool alive = true;
#pragma unroll 1
      for (int p = 0; p < 4; ++p) { const int sh = 24 - 8 * p;
          *(LAS u32x4*)(hb + 8 * r32) = (u32x4){0u, 0u, 0u, 0u}; *(LAS u32x4*)(hb + 8 * r32 + 4) = (u32x4){0u, 0u, 0u, 0u};
          asm volatile("s_waitcnt lgkmcnt(0)" ::: "memory");
#pragma unroll
          for (int n8 = 0; n8 < 16; ++n8) { if (n8 * 8 < nh) {
#pragma unroll
              for (int j = 0; j < 8; ++j) { const unsigned key = keys[n8 * 8 + j];
                  const unsigned x = p ? ((key ^ Tsel) >> ((sh + 8) & 31)) : 0u, t = x < 1u ? x : 1u;
                  __hip_atomic_fetch_add(hb + ((t << 8) + ((key >> sh) & 255u)), 1u, __ATOMIC_RELAXED, __HIP_MEMORY_SCOPE_WORKGROUP); } } }
          asm volatile("s_waitcnt lgkmcnt(0)" ::: "memory");
          const u32x4 c0 = *(const LAS u32x4*)(hb + 8 * r32), c1 = *(const LAS u32x4*)(hb + 8 * r32 + 4);
          const unsigned cb[8] = {(p == 0 && r32 == 0) ? 0u : c0[0], c0[1], c0[2], c0[3], c1[0], c1[1], c1[2], c1[3]};
          unsigned S = 0;
#pragma unroll
          for (int j = 0; j < 8; ++j) S += cb[j];
          unsigned suf = S;
#pragma unroll
          for (int d = 1; d < 32; d <<= 1) { const unsigned y = __shfl_down(suf, d, 32); if (r32 + d < 32) suf += y; }
          const unsigned total = __shfl(suf, 0, 32), sufx = suf - S;
          if (alive && total < kk) alive = false;
          const bool mine = alive && sufx < kk && kk <= suf;
          unsigned acc = sufx, bsel = 0u, above = 0u; bool found = false;
#pragma unroll
          for (int j = 7; j >= 0; --j) { if (!found) { if (acc + cb[j] >= kk) { found = true; bsel = (unsigned)(8 * r32 + j); above = acc; } else acc += cb[j]; } }
          const unsigned long long bm = __ballot(mine);
          const unsigned half = hi ? (unsigned)(bm >> 32) : (unsigned)bm;
          const int src = half ? (__builtin_ctz(half) + 32 * hi) : lane;
          const unsigned bs = __shfl(bsel, src), ab = __shfl(above, src);
          if (alive) { Tsel |= bs << sh; kk -= ab; }
      }
      if (!alive) Tsel = 0u;
    }
    { const unsigned Tf = Tsel > 1u ? Tsel : 1u;
      __syncthreads();
#pragma unroll
      for (int n = 0; n < 128; ++n) { if (n < nh) {
          unsigned bitv = keys[n] >= Tf ? 1u : 0u; const unsigned other = __shfl_xor(bitv, 32);
          bitv |= other << 1;
          if (hi == 0 && bitv) __hip_atomic_fetch_or(T + 32 * n + r32, bitv << (2 * w), __ATOMIC_RELAXED, __HIP_MEMORY_SCOPE_WORKGROUP); } }
    }
    __syncthreads();
    { const int rg = (b * SEQ + tpos0) >> 5, f = i16 & 1;
      for (int k = tid; k < kzero; k += NTHR) { const int kk = k & 63, p = (kk & ~7) | ((kk & 3) << 1) | ((kk >> 2) & 1);
          MT[((size_t)(rg * 64 + (k >> 6)) * 64 + p) * 2 + f] = (unsigned short)(T[k] & 0xffffu); } }
    __syncthreads();
}
__device__ __forceinline__ void p3_indexer(Frame& F, const Args& a) {
    for (int v2 = 2 * blockIdx.x; v2 < 512; v2 += 2 * F.G) { for (int ps = 0; ps < 2; ++ps) { const int v = v2 >> 1, b = v >> 7, i = v & 127; idx_block(F, a, b, ps ? 255 - i : i); } }
}
namespace att {
constexpr int KVBLK = 64, SHM_V = KVBLK * HD * 2, SHM_K = KVBLK * HD * 2;
constexpr int LDS_V = 0, LDS_K = 2 * SHM_V, LDS_WS = 2 * SHM_V + 2 * SHM_K, LDS_BYTES = LDS_WS + NWAVES * 64 * 4;
constexpr float THR = 8.f, LOG2E = 1.4426950408889634f;
#define KSWZ(row, colB) ((row) * 256 + ((colB) ^ (((row) & 7) << 4)))
#define SBAR() __builtin_amdgcn_sched_barrier(0)
__device__ __forceinline__ int v_st(int k, int c) { const int kk = (k & ~0xC) | ((k & 4) << 1) | ((k & 8) >> 1); return ((kk >> 3) * 4 + (c >> 5)) * 512 + ((kk & 7) * 32 + (c & 31)) * 2; }
__device__ __forceinline__ int v_rd_base(int lane) { return ((lane & 3) << 3) | (((lane >> 2) & 3) << 6) | (((lane >> 4) & 1) << 5) | (((lane >> 5) & 1) << 8); }
constexpr int v_rd_off(int d0, int ks, int half) { return d0 * 512 + ks * 4096 + half * 2048; }
__device__ __forceinline__ int crow(int r, int hi) { return (r & 3) + 8 * (r >> 2) + 4 * hi; }
__device__ __forceinline__ void partialSM(f32x16& p0, f32x16& p1, float& m_reg, float& mn, float& alpha) {
    float pmax = p0[0];
#pragma unroll
    for (int r = 1; r < 16; ++r) pmax = fmaxf(pmax, p0[r]);
#pragma unroll
    for (int r = 0; r < 16; ++r) pmax = fmaxf(pmax, p1[r]);
    { auto rr = __builtin_amdgcn_permlane32_swap(__float_as_uint(pmax), __float_as_uint(pmax), false, false);
      pmax = fmaxf(__uint_as_float(rr[0]), __uint_as_float(rr[1])); }
    if (__builtin_expect(__all((pmax - m_reg) <= THR), 1)) { mn = m_reg; alpha = 1.f; }
    else { mn = fmaxf(m_reg, pmax); alpha = __builtin_amdgcn_exp2f((m_reg - mn) * LOG2E); m_reg = mn; }
    const float mnL = -mn * LOG2E;
#pragma unroll
    for (int r = 0; r < 16; ++r) p0[r] = fmaf(p0[r], LOG2E, mnL);
#pragma unroll
    for (int r = 0; r < 16; ++r) p1[r] = fmaf(p1[r], LOG2E, mnL);
#pragma unroll
    for (int r = 0; r < 16; ++r) p0[r] = __builtin_amdgcn_exp2f(p0[r]);
}
__device__ __forceinline__ void finishSM(f32x16& p0, f32x16& p1, float alpha, float& l_reg, bf16x8& pa0, bf16x8& pa1, bf16x8& pa2, bf16x8& pa3) {
#pragma unroll
    for (int r = 0; r < 16; ++r) p1[r] = __builtin_amdgcn_exp2f(p1[r]);
    float ps = 0;
#pragma unroll
    for (int r = 0; r < 16; ++r) ps += p0[r];
#pragma unroll
    for (int r = 0; r < 16; ++r) ps += p1[r];
    { auto rr = __builtin_amdgcn_permlane32_swap(__float_as_uint(ps), __float_as_uint(ps), false, false);
      ps = __uint_as_float(rr[0]) + __uint_as_float(rr[1]); }
    l_reg = l_reg * alpha + ps;
#define PK4(P, B_, OUT) do { unsigned a0 = cvt_pk_bf16(P[B_+0], P[B_+1]), a1 = cvt_pk_bf16(P[B_+2], P[B_+3]);                          \
        unsigned b0 = cvt_pk_bf16(P[B_+4], P[B_+5]), b1 = cvt_pk_bf16(P[B_+6], P[B_+7]);                                             \
        auto r0 = __builtin_amdgcn_permlane32_swap(a0, b0, false, false); auto r1 = __builtin_amdgcn_permlane32_swap(a1, b1, false, false); \
        u32x4 w = {r0[0], r1[0], r0[1], r1[1]}; OUT = __builtin_bit_cast(bf16x8, w); } while (0)
    PK4(p0, 0, pa0); PK4(p0, 8, pa1); PK4(p1, 0, pa2); PK4(p1, 8, pa3);
#undef PK4
}
template <int KB>
__device__ __forceinline__ void qkt(f32x16& p0, f32x16& p1, const LAS char* K_lds, int r32, int hi, const bf16x8* qr, bf16x8 kf0, bf16x8 kf1, bf16x8 qf) {
    const LAS char* kb[4];
#pragma unroll
    for (int dd = 0; dd < 4; ++dd) kb[dd] = K_lds + KB * SHM_K + KSWZ(r32, (dd * 16 + hi * 8) * 2);
    bf16x8 ka[2], kc[2];
    ka[0] = *(const LAS bf16x8*)(kb[0]); kc[0] = *(const LAS bf16x8*)(kb[0] + 32 * 256);
    p0 = __builtin_amdgcn_mfma_f32_32x32x16_bf16(kf0, qf, (f32x16){0.f, 0.f, 0.f, 0.f, 0.f, 0.f, 0.f, 0.f, 0.f, 0.f, 0.f, 0.f, 0.f, 0.f, 0.f, 0.f}, 0, 0, 0);
    p1 = __builtin_amdgcn_mfma_f32_32x32x16_bf16(kf1, qf, (f32x16){0.f, 0.f, 0.f, 0.f, 0.f, 0.f, 0.f, 0.f, 0.f, 0.f, 0.f, 0.f, 0.f, 0.f, 0.f, 0.f}, 0, 0, 0);
    SBAR();
#pragma unroll
    for (int d0 = 0; d0 < 8; ++d0) { const int c = d0 & 1;
        if (d0 < 7) { const LAS char* ap = kb[(d0 + 1) & 3] + ((d0 + 1) >> 2) * 128; ka[c ^ 1] = *(const LAS bf16x8*)(ap); kc[c ^ 1] = *(const LAS bf16x8*)(ap + 32 * 256); }
        p0 = __builtin_amdgcn_mfma_f32_32x32x16_bf16(ka[c], qr[d0], p0, 0, 0, 0);
        p1 = __builtin_amdgcn_mfma_f32_32x32x16_bf16(kc[c], qr[d0], p1, 0, 0, 0);
        SBAR(); }
}
template <int VB>
__device__ __forceinline__ void pv_tile(f32x16* o, int vb0, bf16x8 pa0, bf16x8 pa1, bf16x8 pa2, bf16x8 pa3) {
#define TRRD(dst, off) asm volatile("ds_read_b64_tr_b16 %0, %1 offset:%2" : "=&v"(dst) : "v"(vb0), "i"(off) : "memory")
#define PV_RD(S, d0) do { constexpr int b_ = VB * SHM_V + v_rd_off(d0, 0, 0); \
        TRRD(S[0], b_); TRRD(S[4], b_ + 2048); TRRD(S[1], b_ + 4096); TRRD(S[5], b_ + 6144); TRRD(S[2], b_ + 8192); TRRD(S[6], b_ + 10240); TRRD(S[3], b_ + 12288); TRRD(S[7], b_ + 14336); } while (0)
#define PV_MM(S, d0) do { \
        o[d0] = __builtin_amdgcn_mfma_f32_32x32x16_bf16(pa0, (bf16x8){S[0][0], S[0][1], S[0][2], S[0][3], S[4][0], S[4][1], S[4][2], S[4][3]}, o[d0], 0, 0, 0);   \
        o[d0] = __builtin_amdgcn_mfma_f32_32x32x16_bf16(pa1, (bf16x8){S[1][0], S[1][1], S[1][2], S[1][3], S[5][0], S[5][1], S[5][2], S[5][3]}, o[d0], 0, 0, 0);   \
        o[d0] = __builtin_amdgcn_mfma_f32_32x32x16_bf16(pa2, (bf16x8){S[2][0], S[2][1], S[2][2], S[2][3], S[6][0], S[6][1], S[6][2], S[6][3]}, o[d0], 0, 0, 0);   \
        o[d0] = __builtin_amdgcn_mfma_f32_32x32x16_bf16(pa3, (bf16x8){S[3][0], S[3][1], S[3][2], S[3][3], S[7][0], S[7][1], S[7][2], S[7][3]}, o[d0], 0, 0, 0); } while (0)
    s16x4 A[8], B[8];
    PV_RD(A, 0);
    PV_RD(B, 1); asm volatile("s_waitcnt lgkmcnt(8)" ::: "memory"); SBAR(); PV_MM(A, 0); SBAR();
    PV_RD(A, 2); asm volatile("s_waitcnt lgkmcnt(8)" ::: "memory"); SBAR(); PV_MM(B, 1); SBAR();
    PV_RD(B, 3); asm volatile("s_waitcnt lgkmcnt(8)" ::: "memory"); SBAR(); PV_MM(A, 2); SBAR();
    asm volatile("s_waitcnt lgkmcnt(0)" ::: "memory"); SBAR(); PV_MM(B, 3);
#undef PV_RD
#undef PV_MM
#undef TRRD
}
typedef const __attribute__((address_space(4))) unsigned long long* cmask_t;
__device__ __forceinline__ void mask_tile(f32x16& p0, f32x16& p1, const unsigned long long* mpg) {
    const float NEG = -__builtin_inff();
    cmask_t mp = (cmask_t)mpg;
    asm volatile("s_nop 15\n\ts_nop 7" : "+v"(p0), "+v"(p1));
#pragma unroll
    for (int r = 0; r < 16; ++r) { const unsigned long long m0 = mp[r], m1 = mp[16 + r];
        asm volatile("v_cndmask_b32 %0, %1, %0, %2" : "+v"(p0[r]) : "v"(NEG), "s"(m0));
        asm volatile("v_cndmask_b32 %0, %1, %0, %2" : "+v"(p1[r]) : "v"(NEG), "s"(m1)); }
}
template <int BUF>
__device__ __forceinline__ void tile_step(f32x16* o, float& m_reg, float& l_reg, const LAS char* K_lds, int vb0, LAS float* al_l, int r32, int hi, const bf16x8* qr,
                                          int kb_key, bf16x8 qf, const unsigned long long* mp) {
    f32x16 p0, p1; float mn, alpha; bf16x8 pa0, pa1, pa2, pa3;
    const unsigned kbb = __float_as_uint((float)kb_key) >> 16, k0b = __float_as_uint((float)r32) >> 16, k1b = __float_as_uint((float)(r32 + 32)) >> 16;
    u32x4 f0 = {hi ? 0u : (kbb | (k0b << 16)), 0u, 0u, 0u}, f1 = {hi ? 0u : (kbb | (k1b << 16)), 0u, 0u, 0u};
    qkt<BUF>(p0, p1, K_lds, r32, hi, qr, __builtin_bit_cast(bf16x8, f0), __builtin_bit_cast(bf16x8, f1), qf);
    mask_tile(p0, p1, mp);
    partialSM(p0, p1, m_reg, mn, alpha);
    finishSM(p0, p1, alpha, l_reg, pa0, pa1, pa2, pa3);
    if (__any(alpha < 1.f)) { if (hi == 0) al_l[r32] = alpha; asm volatile("s_waitcnt lgkmcnt(0)" ::: "memory");
#pragma unroll
        for (int r = 0; r < 16; ++r) { const float av = al_l[crow(r, hi)];
#pragma unroll
            for (int d_ = 0; d_ < 4; ++d_) o[d_][r] *= av; } }
    pv_tile<BUF>(o, vb0, pa0, pa1, pa2, pa3);
}
__device__ __forceinline__ void attn_unit(Frame& F, const float* __restrict__ qgain, int b, int g, int qb, unsigned* done_ctr) {
    const bf16_t* Q = (const bf16_t*)(F.ws + WS_Q); const bf16_t* K = (const bf16_t*)(F.ws + WS_K); const bf16_t* V = (const bf16_t*)(F.ws + WS_V);
    unsigned char* O = F.ws + WS_ATTN;
    const unsigned long long* MT = (const unsigned long long*)(F.ws + WS_MASK);
    LAS char* lds = (LAS char*)F.lds;
    const int wid = F.wave, lane = lane_id(), tid = wid * 64 + lane, r32 = lane & 31, hi = lane >> 5;
    const int hq = wid >> 1, th = wid & 1, h = 4 * g + hq, tok0 = b * SEQ + 64 * qb + 32 * th, NT = qb + 1;
    LAS char* V_lds = lds + LDS_V; LAS char* K_lds = lds + LDS_K; LAS float* wsf = (LAS float*)(lds + LDS_WS) + wid * 64; LAS float* li_l = wsf; LAS float* al_l = wsf + 32;
    const int sr = tid >> 4, sc = (tid & 15) * 8, vst0 = v_st(sr, sc), vst1 = v_st(32 + sr, sc), kws = KSWZ(sr, sc * 2);
    const int vb0 = (int)(uintptr_t)V_lds + v_rd_base(lane);
    bf16x8 qr[8];
    {
      u32x4 qw[8]; float ss = 0.f;
#pragma unroll
      for (int d0 = 0; d0 < 8; ++d0) { qw[d0] = *(const u32x4*)(Q + (size_t)(tok0 + r32) * AW + h * HD + d0 * 16 + hi * 8);
#pragma unroll
          for (int j = 0; j < 4; ++j) { const float lo = bflo(qw[d0][j]), hv = bfhi(qw[d0][j]); ss += lo * lo + hv * hv; } }
      { auto rr = __builtin_amdgcn_permlane32_swap(__float_as_uint(ss), __float_as_uint(ss), false, false); ss = __uint_as_float(rr[0]) + __uint_as_float(rr[1]); }
      const float rq = rsqrtf(ss * (1.0f / HD) + NORM_EPS) * 0.08838834764831845f;
#pragma unroll
      for (int d0 = 0; d0 < 8; ++d0) { const f32x4 g0 = *(const f32x4*)(qgain + d0 * 16 + hi * 8), g1 = *(const f32x4*)(qgain + d0 * 16 + hi * 8 + 4); u32x4 o;
          o[0] = cvt_pk_bf16(bflo(qw[d0][0]) * rq * g0[0], bfhi(qw[d0][0]) * rq * g0[1]); o[1] = cvt_pk_bf16(bflo(qw[d0][1]) * rq * g0[2], bfhi(qw[d0][1]) * rq * g0[3]);
          o[2] = cvt_pk_bf16(bflo(qw[d0][2]) * rq * g1[0], bfhi(qw[d0][2]) * rq * g1[1]); o[3] = cvt_pk_bf16(bflo(qw[d0][3]) * rq * g1[2], bfhi(qw[d0][3]) * rq * g1[3]);
          qr[d0] = __builtin_bit_cast(bf16x8, o); } }
    const unsigned sb = __float_as_uint(__builtin_ldexpf(1.0f, -(h + 1))) >> 16;
    const u32x4 qfw = {hi ? 0u : (sb | (sb << 16)), 0u, 0u, 0u}; const bf16x8 qf = __builtin_bit_cast(bf16x8, qfw);
    const bf16_t* Kg = K + (size_t)(b * SEQ) * KVW + g * HD + sc; const bf16_t* Vg = V + (size_t)(b * SEQ) * KVW + g * HD + sc;
    const unsigned long long* mrow = MT + (size_t)__builtin_amdgcn_readfirstlane(tok0 >> 5) * 64 * 32;
    float m_reg = -1e30f, l_reg = 0.f; f32x16 o[4] = {};
    bf16x8 st_k0, st_k1, st_v0, st_v1;
#define SLOAD(k0) do { st_k0 = *(const bf16x8*)(Kg + (size_t)((k0) + sr) * KVW); st_k1 = *(const bf16x8*)(Kg + (size_t)((k0) + 32 + sr) * KVW); \
                       st_v0 = *(const bf16x8*)(Vg + (size_t)((k0) + sr) * KVW); st_v1 = *(const bf16x8*)(Vg + (size_t)((k0) + 32 + sr) * KVW); } while (0)
#define SWRITE(bf) do { *(LAS bf16x8*)(K_lds + (bf) * SHM_K + kws) = st_k0; *(LAS bf16x8*)(K_lds + (bf) * SHM_K + kws + 32 * 256) = st_k1; \
                        *(LAS bf16x8*)(V_lds + (bf) * SHM_V + vst0) = st_v0; *(LAS bf16x8*)(V_lds + (bf) * SHM_V + vst1) = st_v1; } while (0)
    SLOAD(0); SWRITE(0);
    __syncthreads();
    bool signaled = false;
    for (int t = 0; t < NT; t += 2) {
        if (done_ctr && !signaled && t + 8 >= NT) { signaled = true; if (wid == 0 && lane == 0) __hip_atomic_fetch_add(done_ctr, 1u, __ATOMIC_RELAXED, __HIP_MEMORY_SCOPE_AGENT); }
        if (t + 1 < NT) SLOAD((t + 1) * KVBLK);
        tile_step<0>(o, m_reg, l_reg, K_lds, vb0, al_l, r32, hi, qr, t * KVBLK, qf, mrow + (size_t)t * 32);
        if (t + 1 < NT) SWRITE(1);
        __syncthreads();
        if (t + 1 < NT) {
            if (t + 2 < NT) SLOAD((t + 2) * KVBLK);
            tile_step<1>(o, m_reg, l_reg, K_lds, vb0, al_l, r32, hi, qr, (t + 1) * KVBLK, qf, mrow + (size_t)(t + 1) * 32);
            if (t + 2 < NT) SWRITE(0);
            __syncthreads();
        }
    }
#undef SLOAD
#undef SWRITE
    if (hi == 0) li_l[r32] = l_reg; asm volatile("s_waitcnt lgkmcnt(0)" ::: "memory");
    unsigned char* Ow = O + (size_t)tok0 * AW + h * HD;
#pragma unroll
    for (int r = 0; r < 16; ++r) { const int orow = crow(r, hi); const float rl = __builtin_amdgcn_rcpf(li_l[orow]) * (FP8_MERGE ? A8_SCALE : 1.0f);
#pragma unroll
        for (int d0 = 0; d0 < 4; ++d0) { const float v = o[d0][r] * rl; const float v1 = __shfl_xor(v, 1);
            if constexpr (FP8_MERGE) { const float v2 = __shfl_xor(v, 2), v3 = __shfl_xor(v1, 2);
                if ((r32 & 3) == 0) *(unsigned*)(Ow + (size_t)orow * AW + d0 * 32 + r32) = pk4_fp8(v, v1, v2, v3); }
            else { if ((r32 & 1) == 0) *(unsigned*)((bf16_t*)O + (size_t)(tok0 + orow) * AW + h * HD + d0 * 32 + r32) = cvt_pk_bf16(v, v1); } } }
    __syncthreads();
}
#undef KSWZ
#undef SBAR
}
struct SchedPool {
    const char* A; const char* B; int c;
    __device__ __forceinline__ bool next(int i, pg8::Unit& u) const { if (i > 0 || c >= 128) return false; const int rt = c >> 2, g = c & 3; u.pm = rt; u.pn = g; u.aux = 0; u.tok = nullptr; u.nt8 = 0;
        u.A = A + ((size_t)rt * 256 * PW + g * 256) * 2; u.B = B + (size_t)g * 65536 * 2; return true; }
};
struct EpiPool {
    unsigned char* out; const float* pscale;
    __device__ __forceinline__ bool operator()(f32x4 (&acc)[2][2][4][2], const pg8::Unit& u, int wr, int wc, int fr, int fq) const {
        const int row0 = u.pm * 256 + wr * 64 + fr, col0 = u.pn * 256 + wc * 32 + 8 * fq;
#pragma unroll
        for (int bj = 0; bj < 2; ++bj) { const f32x4 s0 = *(const f32x4*)(pscale + col0 + bj * 128), s1 = *(const f32x4*)(pscale + col0 + bj * 128 + 4);
#pragma unroll
            for (int ai = 0; ai < 2; ++ai)
#pragma unroll
                for (int m = 0; m < 4; ++m) { const size_t o = (size_t)(row0 + ai * 128 + m * 16) * PW + col0 + bj * 128;
                    if constexpr (FP8_MERGE) { const f32x4 v0 = acc[ai][bj][m][0] * s0 * A8_SCALE, v1 = acc[ai][bj][m][1] * s1 * A8_SCALE; u32x2 w; w.x = pk4_fp8(v0[0], v0[1], v0[2], v0[3]); w.y = pk4_fp8(v1[0], v1[1], v1[2], v1[3]); *(u32x2*)(out + o) = w; }
                    else st_bf16x8((bf16_t*)out + o, acc[ai][bj][m][0] * s0, acc[ai][bj][m][1] * s1); } }
        return false;
    }
};
__device__ __forceinline__ void p4_pool_attn(Frame& F, const Args& a) {
    for (int c = blockIdx.x; c < 256; c += F.G) {
        const int bg = c >> 6, qb = c & 63;
        att::attn_unit(F, a.in[I_QNORM], bg >> 1, bg & 1, qb, (c + F.G >= 256) ? F.ctl + CW_DONE + 64 * 4 : nullptr);
        if (qb < 32) { const int pu = bg * 32 + qb, rt = pu >> 2, g = pu & 3;
            pooled_item(F, rt * 256 + 32 * F.wave, g, lane_id());
            asm volatile("s_waitcnt vmcnt(0)" ::: "memory"); __syncthreads();
            SchedPool S{(const char*)(F.ws + WS_POOLED), (const char*)(F.ws + WS_PLIN), pu}; EpiPool E{F.ws + WS_POOL, a.in[I_PSCALE]};
            pg8::gemm_phase<EpiPool, SchedPool, false>(F.lds, F.wave, 256 * 2, PW * 2, S, E); __syncthreads(); }
    }
}
struct SchedMerge {
    pg8::TileOrder T; const char* A0; const char* B0; const char* A1; const char* B1;
    __device__ __forceinline__ bool next(int i, pg8::Unit& u) const { int pm, pn; if (!T.tile(i >> 1, pm, pn)) return false; u.pm = pm; u.pn = pn; u.aux = i & 1; u.tok = nullptr; u.nt8 = 0;
        u.A = ((i & 1) ? A1 : A0) + (size_t)pm * 256 * 1024 * (FP8_MERGE ? 1 : 2); u.B = ((i & 1) ? B1 : B0) + (size_t)pn * 256 * 1024 * (FP8_MERGE ? 1 : 2); return true; }
};
struct EpiMerge {
    const bf16_t* G; unsigned char* out;
    __device__ __forceinline__ bool operator()(f32x4 (&acc)[2][2][4][2], const pg8::Unit& u, int wr, int wc, int fr, int fq) const {
        const int row0 = u.pm * 256 + wr * 64 + fr, col0 = u.pn * 256 + wc * 32 + 8 * fq;
#pragma unroll
        for (int ai = 0; ai < 2; ++ai)
#pragma unroll
            for (int m = 0; m < 4; ++m) { const size_t r = (size_t)(row0 + ai * 128 + m * 16);
#pragma unroll
                for (int bj = 0; bj < 2; ++bj) { const int c = col0 + bj * 128;
                    const u32x4 gp = *(const u32x4*)(G + r * (2 * DM) + DM + c);
                    const f32x4 p0 = {bflo(gp[0]), bfhi(gp[0]), bflo(gp[1]), bfhi(gp[1])}, p1 = {bflo(gp[2]), bfhi(gp[2]), bflo(gp[3]), bfhi(gp[3])};
                    if (u.aux == 0) { const u32x4 ga = *(const u32x4*)(G + r * (2 * DM) + c);
                        const f32x4 a0 = {bflo(ga[0]), bfhi(ga[0]), bflo(ga[1]), bfhi(ga[1])}, a1 = {bflo(ga[2]), bfhi(ga[2]), bflo(ga[3]), bfhi(ga[3])};
#pragma unroll
                        for (int j = 0; j < 4; ++j) { acc[ai][bj][m][0][j] *= a0[j] * __builtin_amdgcn_rcpf(fmaxf(p0[j], 1e-30f)); acc[ai][bj][m][1][j] *= a1[j] * __builtin_amdgcn_rcpf(fmaxf(p1[j], 1e-30f)); } }
                    else { if constexpr (FP8_OUT) { const f32x4 v0 = acc[ai][bj][m][0] * p0 * A8_SCALE, v1 = acc[ai][bj][m][1] * p1 * A8_SCALE; u32x2 w; w.x = pk4_fp8(v0[0], v0[1], v0[2], v0[3]); w.y = pk4_fp8(v1[0], v1[1], v1[2], v1[3]);
                        *(u32x2*)(out + r * DM + c) = w; } else st_bf16x8((bf16_t*)out + r * DM + c, acc[ai][bj][m][0] * p0, acc[ai][bj][m][1] * p1); } } }
        return u.aux == 0;
    }
};
__device__ __forceinline__ void p5_merge(Frame& F) {
    SchedMerge S; S.T.init(NTOK, DM, F.G, (int)blockIdx.x); S.A0 = (const char*)(F.ws + WS_ATTN); S.B0 = (const char*)(F.ws + WS_WAU); S.A1 = (const char*)(F.ws + WS_POOL); S.B1 = (const char*)(F.ws + WS_WPU);
    EpiMerge E{(const bf16_t*)(F.ws + WS_G), F.ws + WS_MERGED};
    constexpr int ES = FP8_MERGE ? 1 : 2;
    pg8::gemm_phase<EpiMerge, SchedMerge, false, ES, FP8_MERGE ? A8_E8 : 127, FP8_MERGE ? W8_E8 : 127>(F.lds, F.wave, 1024 * ES, 1024 * ES, S, E);
}
struct EpiOut {
    const float* x; const float* mod; float* out;
    __device__ __forceinline__ bool operator()(f32x4 (&acc)[2][2][4][2], const pg8::Unit& u, int wr, int wc, int fr, int fq) const {
        const int row0 = u.pm * 256 + wr * 64 + fr, col0 = u.pn * 256 + wc * 32 + 8 * fq; const int b = (u.pm * 256) / SEQ;
        const float* gm = mod + b * 6 * DM + 2 * DM;
#pragma unroll
        for (int bj = 0; bj < 2; ++bj) { const int c = col0 + bj * 128; const f32x4 g0 = *(const f32x4*)(gm + c), g1 = *(const f32x4*)(gm + c + 4);
#pragma unroll
            for (int ai = 0; ai < 2; ++ai)
#pragma unroll
                for (int m = 0; m < 4; ++m) { const size_t o = (size_t)(row0 + ai * 128 + m * 16) * DM + c;
                    const f32x4 x0 = *(const f32x4*)(x + o), x1 = *(const f32x4*)(x + o + 4);
                    *(f32x4*)(out + o) = x0 + g0 * acc[ai][bj][m][0]; *(f32x4*)(out + o + 4) = x1 + g1 * acc[ai][bj][m][1]; } }
        return false;
    }
};
__device__ __forceinline__ void p6_out(Frame& F, const Args& a) {
    SchedDense S; S.T.init(NTOK, DM, F.G, (int)blockIdx.x); S.A = (const char*)(F.ws + WS_MERGED); S.B = (const char*)(F.ws + WS_WOUT);
    constexpr int ES = FP8_OUT ? 1 : 2; S.a_tile = (size_t)256 * DM * ES; S.b_tile = (size_t)256 * DM * ES;
    EpiOut E{a.in[I_X], (const float*)(F.ctl + CW_MOD), F.out};
    pg8::gemm_phase<EpiOut, SchedDense, false, ES, FP8_OUT ? A8_E8 : 127, FP8_OUT ? W8_E8 : 127>(F.lds, F.wave, DM * ES, DM * ES, S, E);
}
constexpr int P7_ROWB = 4096 + 16;
constexpr int P7_ROWS = 32, P7_RW = P7_ROWS / NWAVES;
constexpr int P7_LDS_P = P7_ROWS * P7_ROWB;
constexpr int P7_LDS_H = P7_LDS_P + 2 * P7_ROWS * 64 * 4;
__device__ __forceinline__ void p7_router(Frame& F, const Args& a) {
    const float* mod = (const float*)(F.ctl + CW_MOD);
    unsigned char* hb8 = F.ws + WS_HB; const bf16_t* Wr = (const bf16_t*)(F.ws + WS_WR);
    unsigned char* rt = F.ws + WS_ROUTE;
    int* eid = (int*)(rt + RT_EID); float* gate = (float*)(rt + RT_GATE); int* posn = (int*)(rt + RT_POS); int* list = (int*)(rt + RT_LIST); int* ident = (int*)(rt + RT_IDENT);
    unsigned* ecnt = F.ctl + CW_ECNT;
    LAS unsigned char* lds = F.lds; LAS float* P = (LAS float*)(lds + P7_LDS_P); LAS unsigned* hist = (LAS unsigned*)(lds + P7_LDS_H); LAS unsigned* baseL = hist + 64;
    const int lane = lane_id(), w = F.wave, tid = w * 64 + lane;
    if (tid < 64) hist[tid] = 0u;
    __syncthreads();
    for (int p = blockIdx.x; p < NTOK / P7_ROWS; p += F.G) {
        const int row0 = P7_ROWS * p;
#pragma unroll
        for (int rr = 0; rr < P7_RW; ++rr) { const int lr = P7_RW * w + rr, m = row0 + lr, b = m / SEQ;
            const float* xrow = F.out + (size_t)m * DM; const float* sh = mod + b * 6 * DM + 3 * DM; const float* sl = mod + b * 6 * DM + 4 * DM;
            f32x4 v[8]; float ss = 0.f;
#pragma unroll
            for (int j = 0; j < 8; ++j) { v[j] = *(const f32x4*)(xrow + 4 * lane + 256 * j); ss += (v[j].x * v[j].x + v[j].y * v[j].y) + (v[j].z * v[j].z + v[j].w * v[j].w); }
            const float rstd = rsqrtf(wave_sum(ss) * (1.0f / DM) + NORM_EPS);
#pragma unroll
            for (int j = 0; j < 8; ++j) { const int c = 4 * lane + 256 * j;
                const f32x4 gg = *(const f32x4*)(a.in[I_GFFN] + c), shv = *(const f32x4*)(sh + c), slv = *(const f32x4*)(sl + c);
                const f32x4 o = v[j] * rstd * gg * (slv + 1.0f) + shv;
                u32x2 wv; wv.x = cvt_pk_bf16(o.x, o.y); wv.y = cvt_pk_bf16(o.z, o.w);
                *(unsigned*)(hb8 + (size_t)m * DM + c) = pk4_fp8(o.x * H8_SCALE, o.y * H8_SCALE, o.z * H8_SCALE, o.w * H8_SCALE); *(LAS u32x2*)(lds + lr * P7_ROWB + c * 2) = wv; }
            if (lane == 0) ident[m] = m;
        }
        __syncthreads();
        { const int nb = w & 3, kh = w >> 2, fr = lane & 15, kq = lane >> 4;
          f32x4 acc[2] = {{0.f, 0.f, 0.f, 0.f}, {0.f, 0.f, 0.f, 0.f}};
          const bf16_t* wp = Wr + (size_t)(16 * nb + fr) * DM + 1024 * kh + 8 * kq;
          const LAS unsigned char* ap = lds + fr * P7_ROWB + (1024 * kh + 8 * kq) * 2;
#pragma unroll 8
          for (int s = 0; s < 32; ++s) { const bf16x8 bv = *(const bf16x8*)(wp + 32 * s);
#pragma unroll
              for (int mb = 0; mb < 2; ++mb) { const bf16x8 av = *(const LAS bf16x8*)(ap + mb * 16 * P7_ROWB + 64 * s); acc[mb] = __builtin_amdgcn_mfma_f32_16x16x32_bf16(av, bv, acc[mb], 0, 0, 0); } }
#pragma unroll
          for (int mb = 0; mb < 2; ++mb)
#pragma unroll
              for (int j = 0; j < 4; ++j) P[(kh * P7_ROWS + 16 * mb + 4 * kq + j) * 64 + 16 * nb + fr] = acc[mb][j];
        }
        __syncthreads();
        int myrank[P7_RW]; unsigned mylocal[P7_RW]; bool chosen[P7_RW]; float mygate[P7_RW];
#pragma unroll
        for (int rr = 0; rr < P7_RW; ++rr) { const int lr = P7_RW * w + rr;
            const float logit = P[lr * 64 + lane] + P[(P7_ROWS + lr) * 64 + lane];
            const float score = 1.0f / (1.0f + __expf(-logit)); const float sel = score + a.in[I_RBIAS][lane];
            float m1 = sel; m1 = fmaxf(m1, __shfl_xor(m1, 1)); m1 = fmaxf(m1, __shfl_xor(m1, 2)); m1 = fmaxf(m1, __shfl_xor(m1, 4));
            const unsigned long long bm = __ballot(sel == m1); const unsigned grp = (unsigned)((bm >> (lane & ~7)) & 0xffull); const int first = __builtin_ctz(grp | 0x100u);
            float m2 = ((lane & 7) == first) ? -__builtin_inff() : sel; m2 = fmaxf(m2, __shfl_xor(m2, 1)); m2 = fmaxf(m2, __shfl_xor(m2, 2)); m2 = fmaxf(m2, __shfl_xor(m2, 4));
            const float gs = m1 + m2; const int g = lane >> 3; int grank = 0;
#pragma unroll
            for (int g2 = 0; g2 < 8; ++g2) { const float o = __uint_as_float(__builtin_amdgcn_readlane(__float_as_uint(gs), 8 * g2)); grank += (o > gs || (o == gs && g2 < g)) ? 1 : 0; }
            const float selm = grank < TOPG ? sel : -__builtin_inff(); int rank = 0;
#pragma unroll
            for (int e2 = 0; e2 < 64; ++e2) { const float o = __uint_as_float(__builtin_amdgcn_readlane(__float_as_uint(selm), e2)); rank += (o > selm || (o == selm && e2 < lane)) ? 1 : 0; }
            const bool ch = rank < ETOP && grank < TOPG; const float gsum = wave_sum(ch ? score : 0.f);
            chosen[rr] = ch; myrank[rr] = rank; mygate[rr] = score / gsum * ROUTED_SCALE;
            mylocal[rr] = ch ? __hip_atomic_fetch_add(hist + lane, 1u, __ATOMIC_RELAXED, __HIP_MEMORY_SCOPE_WORKGROUP) : 0u;
        }
        __syncthreads();
        if (w == 0) { const unsigned c = hist[lane]; baseL[lane] = c ? __hip_atomic_fetch_add(ecnt + lane, c, __ATOMIC_RELAXED, __HIP_MEMORY_SCOPE_AGENT) : 0u; hist[lane] = 0u; }
        __syncthreads();
#pragma unroll
        for (int rr = 0; rr < P7_RW; ++rr) if (chosen[rr]) { const int m = row0 + P7_RW * w + rr; const unsigned pos = baseL[lane] + mylocal[rr];
            eid[m * 8 + myrank[rr]] = lane; gate[m * 8 + myrank[rr]] = mygate[rr]; posn[m * 8 + myrank[rr]] = (int)pos; list[(size_t)lane * NTOK + pos] = m; }
        __syncthreads();
    }
}
constexpr int MOE_LDS = 131072;
__device__ __forceinline__ int moe_prefix(Frame& F) {
    LAS int* rtoff = (LAS int*)(F.lds + MOE_LDS);
    if (F.wave == 0 && lane_id() == 0) { int s = 0; for (int e = 0; e < NE; ++e) { rtoff[e] = s; unsigned n = F.ctl[CW_ECNT + e]; if (n > (unsigned)NTOK) n = NTOK; s += (int)((n + 255u) >> 8); } rtoff[NE] = s; }
    __syncthreads();
    return __builtin_amdgcn_readfirstlane(rtoff[NE]);
}
__device__ __forceinline__ int moe_find(const LAS int* rtoff, int rtg) {
    int lo = 0, hi = NE;
#pragma unroll
    for (int it = 0; it < 6; ++it) { const int mid = (lo + hi) >> 1; const int v = __builtin_amdgcn_readfirstlane(rtoff[mid]); if (v <= rtg) lo = mid; else hi = mid; }
    return lo;
}
struct SchedMoe1 {
    const LAS int* rtoff; int RT, G, c; const char* hb; const char* w13; const char* ws13; const int* list; const int* ident;
    __device__ __forceinline__ bool next(int i, pg8::Unit& u) const {
        const int idx = i * G + c; if (idx >= (RT + NTOK / 256) * 4) return false;
        const int rtg = idx >> 2, ct = idx & 3; u.pn = ct; u.aux = 0; u.nt8 = 0; u.A = hb;
        if (rtg < RT) { const int e = moe_find(rtoff, rtg), rt = rtg - __builtin_amdgcn_readfirstlane(rtoff[e]); u.pm = rtg; u.tok = list + (size_t)e * NTOK + rt * 256;
            u.B = w13 + ((size_t)e * 1024 + ct * 256) * DM; }
        else { const int rt = rtg - RT; u.pm = HROWS_R / 256 + rt; u.tok = ident + rt * 256; u.B = ws13 + (size_t)(ct * 256) * DM; }
        return true; }
};
struct EpiMoe1 {
    unsigned char* H;
    __device__ __forceinline__ bool operator()(f32x4 (&acc)[2][2][4][2], const pg8::Unit& u, int wr, int wc, int fr, int fq) const {
        const int row0 = u.pm * 256 + wr * 64 + fr, col0 = u.pn * 128 + wc * 32 + 8 * fq;
#pragma unroll
        for (int ai = 0; ai < 2; ++ai)
#pragma unroll
            for (int m = 0; m < 4; ++m) { f32x4 h0, h1;
#pragma unroll
                for (int j = 0; j < 4; ++j) { const float g0 = acc[ai][0][m][0][j], g1 = acc[ai][0][m][1][j];
                    h0[j] = g0 * __builtin_amdgcn_rcpf(1.0f + __expf(-g0)) * acc[ai][1][m][0][j]; h1[j] = g1 * __builtin_amdgcn_rcpf(1.0f + __expf(-g1)) * acc[ai][1][m][1][j]; }
                u32x2 w; w.x = pk4_fp8(h0[0] * H8_SCALE, h0[1] * H8_SCALE, h0[2] * H8_SCALE, h0[3] * H8_SCALE); w.y = pk4_fp8(h1[0] * H8_SCALE, h1[1] * H8_SCALE, h1[2] * H8_SCALE, h1[3] * H8_SCALE);
                *(u32x2*)(H + (size_t)(row0 + ai * 128 + m * 16) * EH + col0) = w; }
        return false;
    }
};
__device__ __forceinline__ void p8_gemm1(Frame& F, const Args& a) {
    const int RT = moe_prefix(F);
    const int U = (RT + NTOK / 256) * 4, R0 = (U + F.G - 1) / F.G, R = (R0 * F.G - U < 24 * R0) ? R0 + 1 : R0, NG = (U + R - 1) / R;
    if ((int)blockIdx.x >= NG) { conv_drain<false, 1, 2>(F, a, 8); return; }
    SchedMoe1 S{(const LAS int*)(F.lds + MOE_LDS), RT, NG, (int)blockIdx.x, (const char*)(F.ws + WS_HB), (const char*)(F.ws + WS_W13), (const char*)(F.ws + WS_WS13),
                (const int*)(F.ws + WS_ROUTE + RT_LIST), (const int*)(F.ws + WS_ROUTE + RT_IDENT)};
    EpiMoe1 E{F.ws + WS_H};
    pg8::gemm_phase<EpiMoe1, SchedMoe1, true, 1, H8_E8, W8_E8>(F.lds, F.wave, DM, DM, S, E);
    conv_drain<false, 1, 2>(F, a, 8);
}
struct SchedMoe2 {
    const LAS int* rtoff; int RT, G, c; const char* H; const char* w2; const char* ws2;
    __device__ __forceinline__ bool next(int i, pg8::Unit& u) const {
        const int idx = i * G + c; if (idx >= (RT + NTOK / 256) * 8) return false;
        const int rtg = idx >> 3, ct = idx & 7; u.pn = ct; u.aux = 0; u.tok = nullptr; u.nt8 = 0;
        if (rtg < RT) { const int e = moe_find(rtoff, rtg); u.pm = rtg; u.B = w2 + ((size_t)e * DM + ct * 256) * EH; }
        else { u.pm = HROWS_R / 256 + (rtg - RT); u.B = ws2 + (size_t)(ct * 256) * EH; }
        u.A = H + (size_t)u.pm * 256 * EH; return true; }
};
constexpr float Y8_SCALE = 8.f;
struct EpiY {
    unsigned char* Y;
    __device__ __forceinline__ bool operator()(f32x4 (&acc)[2][2][4][2], const pg8::Unit& u, int wr, int wc, int fr, int fq) const {
        const int row0 = u.pm * 256 + wr * 64 + fr, col0 = u.pn * 256 + wc * 32 + 8 * fq;
#pragma unroll
        for (int ai = 0; ai < 2; ++ai)
#pragma unroll
            for (int m = 0; m < 4; ++m)
#pragma unroll
                for (int bj = 0; bj < 2; ++bj) { const f32x4 v0 = acc[ai][bj][m][0] * Y8_SCALE, v1 = acc[ai][bj][m][1] * Y8_SCALE; u32x2 w; w.x = pk4_fp8(v0[0], v0[1], v0[2], v0[3]); w.y = pk4_fp8(v1[0], v1[1], v1[2], v1[3]);
                    *(u32x2*)(Y + (size_t)(row0 + ai * 128 + m * 16) * DM + col0 + bj * 128) = w; }
        return false;
    }
};
__device__ __forceinline__ void p9_gemm2(Frame& F) {
    const int RT = moe_prefix(F);
    SchedMoe2 S{(const LAS int*)(F.lds + MOE_LDS), RT, F.G, (int)blockIdx.x, (const char*)(F.ws + WS_H), (const char*)(F.ws + WS_W2), (const char*)(F.ws + WS_WS2)};
    EpiY E{F.ws + WS_Y};
    pg8::gemm_phase<EpiY, SchedMoe2, false, 1, H8_E8, W8_E8>(F.lds, F.wave, EH, EH, S, E);
}
__device__ __forceinline__ void fp8x16_fma(f32x4 (&s)[4], const u32x4 y, float g) {
#pragma unroll
    for (int t = 0; t < 4; ++t) { const f32x2 lo = __builtin_amdgcn_cvt_pk_f32_fp8((int)y[t], false), hi = __builtin_amdgcn_cvt_pk_f32_fp8((int)y[t], true);
        s[t][0] += lo[0] * g; s[t][1] += lo[1] * g; s[t][2] += hi[0] * g; s[t][3] += hi[1] * g; }
}
__device__ __forceinline__ void p10_combine(Frame& F) {
    (void)moe_prefix(F);
    const LAS int* rtoff = (const LAS int*)(F.lds + MOE_LDS);
    const unsigned char* Y = F.ws + WS_Y; unsigned char* rt = F.ws + WS_ROUTE;
    const int* eid = (const int*)(rt + RT_EID); const float* gate = (const float*)(rt + RT_GATE); const int* posn = (const int*)(rt + RT_POS); const float* mod = (const float*)(F.ctl + CW_MOD);
    const int lane = lane_id();
    size_t yr[9]; float g[9]; u32x4 yv[9][2];
#define P10_ROUTE(t_) do { const u32x4 e0 = *(const u32x4*)(eid + (t_) * 8), e1 = *(const u32x4*)(eid + (t_) * 8 + 4), p0 = *(const u32x4*)(posn + (t_) * 8), p1 = *(const u32x4*)(posn + (t_) * 8 + 4); \
        const f32x4 g0 = *(const f32x4*)(gate + (t_) * 8), g1 = *(const f32x4*)(gate + (t_) * 8 + 4); \
        _Pragma("unroll") for (int k = 0; k < 8; ++k) { const int e = __builtin_amdgcn_readfirstlane((int)(k < 4 ? e0[k & 3] : e1[k & 3])) & 63, p = __builtin_amdgcn_readfirstlane((int)(k < 4 ? p0[k & 3] : p1[k & 3])); \
            yr[k] = (size_t)(256 * __builtin_amdgcn_readfirstlane(rtoff[e]) + p) * DM; g[k] = __uint_as_float(__builtin_amdgcn_readfirstlane(__float_as_uint(k < 4 ? g0[k & 3] : g1[k & 3]))); } \
        yr[8] = (size_t)(HROWS_R + (t_)) * DM; g[8] = 1.0f; } while (0)
#define P10_YLOAD() do { _Pragma("unroll") for (int k = 0; k < 9; ++k) { yv[k][0] = __builtin_nontemporal_load((const u32x4*)(Y + yr[k] + 32 * lane)); yv[k][1] = __builtin_nontemporal_load((const u32x4*)(Y + yr[k] + 32 * lane + 16)); } } while (0)
    int t = F.gw;
    if (t < NTOK) { P10_ROUTE(t); P10_YLOAD(); }
    for (; t < NTOK; t += F.NGW) {
        const int b = t / SEQ; const float* gf = mod + b * 6 * DM + 5 * DM + 32 * lane;
        float* orow = F.out + (size_t)t * DM + 32 * lane;
        f32x4 xv[8];
#pragma unroll
        for (int j = 0; j < 8; ++j) xv[j] = *(const f32x4*)(orow + 4 * j);
        f32x4 s[8];
#pragma unroll
        for (int j = 0; j < 8; ++j) s[j] = (f32x4){0.f, 0.f, 0.f, 0.f};
#pragma unroll
        for (int k = 0; k < 9; ++k) { f32x4 (&s0)[4] = *(f32x4 (*)[4])&s[0]; f32x4 (&s1)[4] = *(f32x4 (*)[4])&s[4]; fp8x16_fma(s0, yv[k][0], g[k]); fp8x16_fma(s1, yv[k][1], g[k]); }
        const int tn = t + F.NGW;
        if (tn < NTOK) { P10_ROUTE(tn); P10_YLOAD(); }
#pragma unroll
        for (int j = 0; j < 8; ++j) *(f32x4*)(orow + 4 * j) = xv[j] + *(const f32x4*)(gf + 4 * j) * s[j] * (1.0f / Y8_SCALE);
    }
#undef P10_ROUTE
#undef P10_YLOAD
}
constexpr int LDS_BYTES = 155648;
constexpr int N_PHASES = 11;
#ifndef PROBE_REP
#define PROBE_REP -1
#endif
#define REP(k, stmt) do { stmt; if (PROBE_REP == (k)) { __syncthreads(); stmt; } } while (0)
__global__ void __launch_bounds__(NTHR, 2) fwd(Args args) {
    extern __shared__ __attribute__((aligned(16))) unsigned char lds_raw[];
    Frame F; F.lds = (LAS unsigned char*)lds_raw; F.wave = __builtin_amdgcn_readfirstlane((int)threadIdx.x >> 6);
    F.G = gridDim.x; F.gw = blockIdx.x * NWAVES + F.wave; F.NGW = F.G * NWAVES; F.ws = args.ws; F.ctl = (unsigned*)(args.ws + WS_CTL); F.out = args.out;
    volatile LAS unsigned* xbw = (volatile LAS unsigned*)(F.lds + LDS_BYTES - 16);
    if (threadIdx.x < 4) xbw[threadIdx.x] = 0u;
    __syncthreads();
    const bool one = (args.ph_hi - args.ph_lo) > 1;
    XcdBarrier bar; bar.bar = F.ctl + CW_BAR; bar.x = 0; bar.st = xbw;
    if (one) bar = xcd_barrier_post(F.ctl + CW_BAR, xbw, F.wave);
    const int lo = args.ph_lo, hi = args.ph_hi;
#ifndef PROBE_TIME
#define PROBE_TIME -1
#endif
    unsigned long long pt0 = 0ull, pt1 = 0ull;
#define TSTAMP(k, which) do { if (PROBE_TIME == (k) && blockIdx.x == 0) { if (which) pt1 = __builtin_amdgcn_s_memrealtime(); else pt0 = __builtin_amdgcn_s_memrealtime(); } } while (0)
#define IN(k) (lo <= (k) && (k) < hi)
#define SEAM(k) do { if (IN(k) && IN((k) + 1)) xcd_barrier(bar, F.wave); } while (0)
    TSTAMP(0, 0); if (IN(0)) { REP(0, p0_prologue(F, args)); } SEAM(0); TSTAMP(0, 1);
    TSTAMP(1, 0); if (IN(1)) { REP(1, p1_h(F, args)); } SEAM(1); TSTAMP(1, 1);
    TSTAMP(2, 0); if (IN(2)) { REP(2, p2_inproj(F, args)); } SEAM(2); TSTAMP(2, 1);
    TSTAMP(3, 0); if (IN(3)) { p3_qknorm(F, args); __syncthreads(); REP(3, p3_indexer(F, args)); } SEAM(3); TSTAMP(3, 1);
    TSTAMP(4, 0); if (IN(4)) { REP(4, p4_pool_attn(F, args)); if (one) { conv_drain<true, 0, 2>(F, args, 4); } } SEAM(4); TSTAMP(4, 1);
    TSTAMP(5, 0); if (IN(5)) { REP(5, p5_merge(F)); } SEAM(5); TSTAMP(5, 1);
    TSTAMP(6, 0); if (IN(6)) { REP(6, p6_out(F, args)); } SEAM(6); TSTAMP(6, 1);
    TSTAMP(7, 0); if (IN(7)) { p7_router(F, args); conv_drain<false, 0, 1>(F, args, 7); }
    SEAM(7); TSTAMP(7, 1);
    TSTAMP(8, 0); if (IN(8)) { REP(8, p8_gemm1(F, args)); } SEAM(8); TSTAMP(8, 1);
    TSTAMP(9, 0); if (IN(9)) { REP(9, p9_gemm2(F)); } SEAM(9); TSTAMP(9, 1);
    TSTAMP(10, 0); if (IN(10)) { p10_combine(F); } TSTAMP(10, 1);
    if (PROBE_TIME >= 0 && blockIdx.x == 0) { const unsigned long long tend = __builtin_amdgcn_s_memrealtime() + 4ull * (pt1 - pt0); while (__builtin_amdgcn_s_memrealtime() < tend) __builtin_amdgcn_s_sleep(8); }
#undef IN
#undef SEAM
}
#ifndef N_LAUNCHES
#define N_LAUNCHES 1
#endif
extern "C" void kernel_launch(void* const* d_in, const int* in_sizes, int n_in, void* d_out, int out_size, void* d_ws, size_t ws_size, hipStream_t stream) {
    static int grid = 0;
    if (grid == 0) {
        if (n_in != 22 || out_size != NTOK * DM || ws_size < WS_END) { fprintf(stderr, "kernel_launch: unexpected shapes (n_in %d out %d ws %zu need %zu)\n", n_in, out_size, ws_size, (size_t)WS_END); grid = -1; return; }
        int dev = 0, cus = 0, per_cu = 0;
        if (hipGetDevice(&dev) != hipSuccess || hipDeviceGetAttribute(&cus, hipDeviceAttributeMultiprocessorCount, dev) != hipSuccess) { grid = -1; return; }
        if (hipFuncSetAttribute((const void*)fwd, hipFuncAttributeMaxDynamicSharedMemorySize, LDS_BYTES) != hipSuccess) { fprintf(stderr, "kernel_launch: hipFuncSetAttribute failed\n"); grid = -1; return; }
        if (hipOccupancyMaxActiveBlocksPerMultiprocessor(&per_cu, (const void*)fwd, NTHR, LDS_BYTES) != hipSuccess || per_cu < 1) fprintf(stderr, "kernel_launch: occupancy query says %d\n", per_cu);
        (void)hipGetLastError();
        grid = cus;
    }
    if (grid < 0) return;
    (void)hipMemsetAsync((char*)d_ws + WS_CTL, 0, CTL_BYTES, stream);
    Args a{};
    for (int i = 0; i < 22; ++i) a.in[i] = (const float*)d_in[i];
    a.out = (float*)d_out; a.ws = (unsigned char*)d_ws;
    if (N_LAUNCHES == 1) { a.ph_lo = 0; a.ph_hi = N_PHASES; hipLaunchKernelGGL(fwd, dim3(grid), dim3(NTHR), LDS_BYTES, stream, a); }
    else for (int p = 0; p < N_PHASES; ++p) { a.ph_lo = p; a.ph_hi = p + 1; hipLaunchKernelGGL(fwd, dim3(grid), dim3(NTHR), LDS_BYTES, stream, a); }
}
```

```cpp
#include <hip/hip_runtime.h>
#include <cstdio>
#include <cstdint>

#define LAS __attribute__((address_space(3)))
#define GAS __attribute__((address_space(1)))
typedef unsigned short bf16_t;
typedef short bf16x8 __attribute__((ext_vector_type(8)));
typedef short s16x4 __attribute__((ext_vector_type(4)));
typedef float f32x4 __attribute__((ext_vector_type(4)));
typedef float f32x2 __attribute__((ext_vector_type(2)));
typedef float f32x16 __attribute__((ext_vector_type(16)));
typedef unsigned u32x4 __attribute__((ext_vector_type(4)));
typedef unsigned u32x2 __attribute__((ext_vector_type(2)));

constexpr int DM = 2048, NB = 2, SEQ = 4096, NTOK = NB * SEQ;
constexpr int NH = 8, HD = 128, NKV = 2, AW = 1024, KVW = 256, IH = 16, ID = 64, TOPK = 256;
constexpr int PW = 1024, INW = 7760, INP = 7936;
constexpr int NE = 64, EH = 512, NGRP = 8, EPG = 8, TOPG = 4, ETOP = 8;
constexpr float NORM_EPS = 1e-6f, ROUTED_SCALE = 2.5f;
constexpr int NTHR = 512, NWAVES = 8;

constexpr size_t MiB = 1u << 20;
constexpr size_t WS_CTL = 0, CTL_BYTES = 1 * MiB;
constexpr size_t WS_W13 = 1 * MiB;
constexpr size_t WS_W2 = WS_W13 + 256 * MiB;
constexpr size_t WS_WS13 = WS_W2 + 128 * MiB;
constexpr size_t WS_WS2 = WS_WS13 + 4 * MiB;
constexpr size_t WS_H = WS_WS2 + 2 * MiB;
constexpr int HROWS_R = 65536 + 64 * 256, HROWS = HROWS_R + NTOK;
constexpr size_t WS_ROUTE = WS_H + (size_t)HROWS * EH * 2;
constexpr size_t RT_EID = 0, RT_GATE = RT_EID + (size_t)NTOK * 8 * 4, RT_POS = RT_GATE + (size_t)NTOK * 8 * 4, RT_LIST = RT_POS + (size_t)NTOK * 8 * 4,
                 RT_IDENT = RT_LIST + (size_t)NE * NTOK * 4, RT_END = RT_IDENT + (size_t)NTOK * 4;
constexpr size_t WS_R = (WS_ROUTE + RT_END + MiB - 1) / MiB * MiB;
constexpr size_t WS_Y = WS_R;
constexpr size_t WS_WIN = WS_R;
constexpr size_t WS_WAU = WS_WIN + 31 * MiB, WS_WPU = WS_WAU + 4 * MiB, WS_WOUT = WS_WPU + 4 * MiB, WS_PLIN = WS_WOUT + 8 * MiB, WS_WR = WS_PLIN + MiB / 2;
constexpr size_t WS_HB = WS_WR + MiB / 2;
constexpr size_t WS_Q = WS_HB + 32 * MiB, WS_K = WS_Q + 16 * MiB, WS_V = WS_K + 4 * MiB, WS_QI = WS_V + 4 * MiB, WS_KW = WS_QI + 16 * MiB, WS_U = WS_KW + 4 * MiB,
                 WS_G = WS_U + 16 * MiB;
constexpr size_t WS_POOLED = WS_G + 64 * MiB, WS_POOL = WS_POOLED + 16 * MiB, WS_ATTN = WS_POOL + 16 * MiB, WS_MERGED = WS_ATTN + 16 * MiB, WS_MASK = WS_MERGED + 32 * MiB,
                 WS_H8 = WS_MASK + 4 * MiB,
                 WS_REND = WS_H8 + 32 * MiB;
constexpr size_t WS_END = WS_Y + (size_t)HROWS_R * DM * 2;
static_assert(WS_REND <= WS_END, "overlay region");
constexpr int CW_BAR = 4096;
constexpr int CW_ECNT = 8192;
constexpr int CW_CONVQ = 12288;
constexpr int CW_DONE = 12544;
constexpr int CW_MOD = 16384;
static_assert((CW_MOD + 2 * 6 * DM) * 4 <= (int)CTL_BYTES, "ctl");

__device__ __forceinline__ int lane_id() { int l; asm volatile("v_mbcnt_lo_u32_b32 %0, -1, 0\n\tv_mbcnt_hi_u32_b32 %0, -1, %0" : "=v"(l)); return l; }
__device__ __forceinline__ unsigned cvt_pk_bf16(float lo, float hi) { unsigned r; asm volatile("v_cvt_pk_bf16_f32 %0, %1, %2" : "=v"(r) : "v"(lo), "v"(hi)); return r; }
__device__ __forceinline__ unsigned pk4_fp8(float a, float b, float c, float d) {
    a = __builtin_amdgcn_fmed3f(a, -448.f, 448.f); b = __builtin_amdgcn_fmed3f(b, -448.f, 448.f); c = __builtin_amdgcn_fmed3f(c, -448.f, 448.f); d = __builtin_amdgcn_fmed3f(d, -448.f, 448.f);
    int w = __builtin_amdgcn_cvt_pk_fp8_f32(a, b, 0, false); w = __builtin_amdgcn_cvt_pk_fp8_f32(c, d, w, true); return (unsigned)w; }
#ifndef FP8_INPROJ
#define FP8_INPROJ 0
#endif
#ifndef FP8_MERGE
#define FP8_MERGE 1
#endif
#ifndef FP8_OUT
#define FP8_OUT 1
#endif
constexpr float W8_SCALE = 8.f;   constexpr int W8_E8 = 127 - 3;
constexpr float H8_SCALE = 8.f;   constexpr int H8_E8 = 127 - 3;
constexpr float A8_SCALE = 8.f;   constexpr int A8_E8 = 127 - 3;
__device__ __forceinline__ float bf2f(unsigned short b) { return __uint_as_float(((unsigned)b) << 16); }
__device__ __forceinline__ float bflo(unsigned w) { return __uint_as_float(w << 16); }
__device__ __forceinline__ float bfhi(unsigned w) { return __uint_as_float(w & 0xffff0000u); }
__device__ __forceinline__ float wave_sum(float v) {
#pragma unroll
    for (int o = 1; o < 64; o <<= 1) v += __shfl_xor(v, o);
    return v;
}
__device__ __forceinline__ float sigmoidf_(float x) { return 1.0f / (1.0f + __expf(-x)); }

#define XB_TMO      128
#define XB_XCNT(j)  (256  + 64 * (j))
#define XB_XSUB(j)  (1280 + 64 * (j))
#define XB_XGEN(j)  (2304 + 64 * (j))
#define XB_TOP      3328
#define XB_TOPGEN   3392
#define XCD_BAR_WORDS 3456
#define XB_SPIN_CAP (1u << 18)
__device__ __forceinline__ unsigned xb_ld(unsigned* p)              { return __hip_atomic_load(p, __ATOMIC_RELAXED, __HIP_MEMORY_SCOPE_AGENT); }
__device__ __forceinline__ unsigned xb_add(unsigned* p, unsigned v) { return __hip_atomic_fetch_add(p, v, __ATOMIC_RELAXED, __HIP_MEMORY_SCOPE_AGENT); }
__device__ __forceinline__ unsigned xb_xcc_id() { return (unsigned)__builtin_amdgcn_s_getreg((3 << 11) | 20) & 0xFu; }
#define XB_SPIN(cond, bar) do { unsigned _sp = 0; while (cond) { __builtin_amdgcn_s_sleep(1); \
    if ((++_sp & 255u) == 0u) { if (xb_ld(&(bar)[XB_TMO])) break; if (_sp > XB_SPIN_CAP) { atomicAdd(&(bar)[XB_TMO], 1u); break; } } } } while (0)
struct XcdBarrier { unsigned* bar; unsigned x; volatile LAS unsigned* st; };
__device__ __forceinline__ XcdBarrier xcd_barrier_post(unsigned* bar, volatile LAS unsigned* st, int wave) {
    XcdBarrier b; b.bar = bar; b.x = xb_xcc_id(); b.st = st;
    if (wave == 0 && lane_id() == 0) (void)xb_add(&bar[XB_XCNT(b.x)], 1u);
    return b;
}
__device__ __forceinline__ void xcd_barrier_complete(unsigned* bar, unsigned x, unsigned& nloc, unsigned& nx) {
    const unsigned G = gridDim.x * gridDim.y * gridDim.z;
    unsigned sum, cnt, mine, sp = 0u;
    for (;;) {
        sum = 0u; cnt = 0u; mine = 0u;
#pragma unroll
        for (unsigned j = 0; j < 16; ++j) { const unsigned c = xb_ld(&bar[XB_XCNT(j)]); sum += c; cnt += (c > 0u) ? 1u : 0u; mine = (j == x) ? c : mine; }
        if (sum == G) break;
        __builtin_amdgcn_s_sleep(1);
        if ((++sp & 255u) == 0u) { if (xb_ld(&bar[XB_TMO])) break; if (sp > XB_SPIN_CAP) { atomicAdd(&bar[XB_TMO], 1u); break; } }
    }
    nloc = mine > 0u ? mine : 1u; nx = cnt > 0u ? cnt : 1u;
}
__device__ __forceinline__ void xcd_barrier(const XcdBarrier& b, int wave) {
    asm volatile("s_waitcnt vmcnt(0)" ::: "memory");
    __syncthreads();
    if (wave == 0 && lane_id() == 0) {
        unsigned* bar = b.bar;
        __builtin_amdgcn_s_waitcnt(0);
        unsigned nloc = b.st[0], nx = b.st[1];
        if (nloc == 0u) { xcd_barrier_complete(bar, b.x, nloc, nx); b.st[0] = nloc; b.st[1] = nx; }
        const unsigned old = xb_add(&bar[XB_XSUB(b.x)], 1u);
        const unsigned gen = old / nloc;
        if (old + 1u == (gen + 1u) * nloc) {
            __builtin_amdgcn_fence(__ATOMIC_RELEASE, "agent");
            asm volatile("s_waitcnt vmcnt(0)" ::: "memory");
            const unsigned og = xb_add(&bar[XB_TOP], 1u);
            const unsigned tg = og / nx;
            if (og + 1u == (tg + 1u) * nx) xb_add(&bar[XB_TOPGEN], 1u);
            else XB_SPIN(xb_ld(&bar[XB_TOPGEN]) == tg, bar);
            __builtin_amdgcn_fence(__ATOMIC_ACQUIRE, "agent");
            xb_add(&bar[XB_XGEN(b.x)], 1u);
            asm volatile("s_waitcnt vmcnt(0)" ::: "memory");
        } else {
            XB_SPIN(xb_ld(&bar[XB_XGEN(b.x)]) == gen, bar);
            __builtin_amdgcn_fence(__ATOMIC_ACQUIRE, "agent");
            asm volatile("s_waitcnt vmcnt(0)" ::: "memory");
        }
    }
    __syncthreads();
}
namespace pg8 {
constexpr int BM = 256, BK = 64, HALF = 128, HTB = HALF * BK * 2, STAGE_BYTES = 8 * HTB, NXCD = 8, WGM = 8;
__host__ __device__ __forceinline__ int lds_byte(int r, int c) { const int st = (r >> 4) * 2 + (c >> 5), rr = r & 15, cc = c & 31, ob = rr * 64 + cc * 2; return st * 1024 + (ob ^ (((ob >> 9) & 1) << 5)); }
__host__ __device__ __forceinline__ void stage_rc(int b, int& R, int& C) { const int st = b / 1024, sb = b % 1024, swz = sb ^ (((sb >> 9) & 1) << 5); R = (st >> 1) * 16 + swz / 64; C = (st & 1) * 32 + (swz % 64) / 2; }
__host__ __device__ __forceinline__ int perm32(int rho) { const int n = rho >> 4, i = rho & 15; return 8 * (i >> 2) + 4 * n + (i & 3); }

struct Unit { const char* A; const char* B; const int* tok; int pm, pn, aux; int nt8; };

struct TileOrder {
    int nM, nN, nwg, G, c;
    __device__ void init(int M, int N, int G_, int c_) { nM = M / BM; nN = N / BM; nwg = nM * nN; G = G_; c = c_; }
    __device__ bool tile(int i, int& pm, int& pn) const {
        const long L = (long)i * G + c; if (L >= nwg) return false;
        int wgid = (int)L; { const int q = nwg / NXCD, r = nwg % NXCD, xcd = wgid % NXCD, off = wgid / NXCD; wgid = (xcd < r ? xcd * (q + 1) : r * (q + 1) + (xcd - r) * q) + off; }
        const int nig = WGM * nN, gid = wgid / nig, fm = gid * WGM, gsz = (nM - fm) < WGM ? (nM - fm) : WGM;
        pm = fm + ((wgid % nig) % gsz); pn = (wgid % nig) / gsz; return true;
    }
};

typedef int i32x8 __attribute__((ext_vector_type(8)));
template <class Epi, class Sched, bool GATHER, int ES = 2, int SCA = 127, int SCB = 127, bool MIXED = false>
__device__ __forceinline__ void gemm_phase(LAS unsigned char* lds, const int wid, const int Kb, const int ldab, const Sched& S, const Epi& E, const int nt_ovr = 0) {
    const int lane = lane_id(), tid = wid * 64 + lane, wr = wid >> 2, wc = wid & 3, fr = lane & 15, fq = lane >> 4;
    const int nt = nt_ovr ? nt_ovr : Kb / (BK * 2);
    unsigned voffA[2], voffB[2];
#pragma unroll
    for (int i = 0; i < 2; ++i) { int R, C; stage_rc(tid * 16 + i * 8192, R, C); const int Rb = (R & ~31) + perm32(R & 31);
        voffA[i] = (unsigned)(R * ldab + C * 2); voffB[i] = (unsigned)(Rb * Kb + C * 2); }
    const size_t kstep = (size_t)(BK * 2);
    const size_t hstepA = (size_t)HALF * ldab, hstepB = (size_t)HALF * Kb;
    const unsigned ldsw = (unsigned)wid * 1024u;
    const int aoff = (ES == 2 || MIXED) ? lds_byte(wr * 64 + fr, fq * 8) : lds_byte(wr * 64 + fr, fq * 16), boff = (ES == 2 || MIXED) ? lds_byte(wc * 32 + fr, fq * 8) : lds_byte(wc * 32 + fr, fq * 16);
    constexpr int OFF1 = (ES == 2 || MIXED) ? 1024 : 16;
#define PG8_SA(b, h) (((b) * 2 + (h)) * HTB)
#define PG8_SB(b, h) ((4 + (b) * 2 + (h)) * HTB)
    const unsigned ldsbase = (unsigned)(uintptr_t)lds + ldsw;
#define PG8_DMA2(bufoff, sbase, voff_, i_) do { unsigned keep_; asm volatile("s_mov_b32 %0, m0\n\ts_mov_b32 m0, %3\n\ts_nop 0\n\tglobal_load_lds_dwordx4 %1, %2\n\ts_mov_b32 m0, %0" \
        : "=&s"(keep_) : "v"(voff_), "s"(sbase), "s"(ldsbase + (unsigned)((bufoff) + (i_) * 8192)) : "memory"); } while (0)
#define PG8_STAGEB(bufoff, gbase) do { _Pragma("unroll") for (int _i = 0; _i < 2; ++_i) PG8_DMA2(bufoff, (const char*)(gbase), voffB[_i], _i); } while (0)
#define PG8_STAGEA(bufoff, kt, h, GO) do { _Pragma("unroll") for (int _i = 0; _i < 2; ++_i) { \
        if constexpr (GATHER) PG8_DMA2(bufoff, (const char*)(kt), GO[h][_i], _i); else PG8_DMA2(bufoff, (const char*)(kt) + (h) * hstepA, voffA[_i], _i); } } while (0)
#define PG8_LD8(p0, p1) __builtin_bit_cast(i32x8, __builtin_shufflevector(*(const LAS u32x4*)(p0), *(const LAS u32x4*)(p1), 0, 1, 2, 3, 4, 5, 6, 7))
#define PG8_LDA(dst, b, h) do { _Pragma("unroll") for (int m = 0; m < 4; ++m) dst[m] = PG8_LD8(lds + PG8_SA(b, h) + aoff + m * 2048, lds + PG8_SA(b, h) + aoff + OFF1 + m * 2048); } while (0)
#define PG8_LDB(dst, b, h) do { _Pragma("unroll") for (int n = 0; n < 2; ++n) dst[n] = PG8_LD8(lds + PG8_SB(b, h) + boff + n * 2048, lds + PG8_SB(b, h) + boff + OFF1 + n * 2048); } while (0)
#define PG8_LO(x) __builtin_bit_cast(bf16x8, __builtin_shufflevector(x, x, 0, 1, 2, 3))
#define PG8_HI(x) __builtin_bit_cast(bf16x8, __builtin_shufflevector(x, x, 4, 5, 6, 7))
#define PG8_MMA16(ai, bj, At, Bt) do { _Pragma("unroll") for (int m = 0; m < 4; ++m) _Pragma("unroll") for (int n = 0; n < 2; ++n) { \
        acc[ai][bj][m][n] = __builtin_amdgcn_mfma_f32_16x16x32_bf16(PG8_LO(Bt[n]), PG8_LO(At[m]), acc[ai][bj][m][n], 0, 0, 0); \
        acc[ai][bj][m][n] = __builtin_amdgcn_mfma_f32_16x16x32_bf16(PG8_HI(Bt[n]), PG8_HI(At[m]), acc[ai][bj][m][n], 0, 0, 0); } } while (0)
#define PG8_MMA8(ai, bj, At, Bt) do { _Pragma("unroll") for (int m = 0; m < 4; ++m) _Pragma("unroll") for (int n = 0; n < 2; ++n) \
        acc[ai][bj][m][n] = __builtin_amdgcn_mfma_scale_f32_16x16x128_f8f6f4(Bt[n], At[m], acc[ai][bj][m][n], 0, 0, 0, SCB * 0x01010101, 0, SCA * 0x01010101); } while (0)
#define PG8_MMA(ai, bj, At, Bt) do { __builtin_amdgcn_s_setprio(1); \
        if constexpr (MIXED) { if (cur8) PG8_MMA8(ai, bj, At, Bt); else PG8_MMA16(ai, bj, At, Bt); } \
        else if constexpr (ES == 2) PG8_MMA16(ai, bj, At, Bt); else PG8_MMA8(ai, bj, At, Bt); \
        __builtin_amdgcn_s_setprio(0); } while (0)
#define PG8_WAIT_V(n) asm volatile("s_waitcnt vmcnt(" #n ")" ::: "memory")
#define PG8_WAIT_L(n) asm volatile("s_waitcnt lgkmcnt(" #n ")" ::: "memory")
#define PG8_BAR __builtin_amdgcn_s_barrier()
#define PG8_SCHED __builtin_amdgcn_sched_barrier(0)
#define PG8_GLOAD(GO, u) do { if constexpr (GATHER) { const int _tid = wid * 64 + lane_id(); _Pragma("unroll") for (int _i = 0; _i < 2; ++_i) { int _R, _C; stage_rc(_tid * 16 + _i * 8192, _R, _C); \
        _Pragma("unroll") for (int _h = 0; _h < 2; ++_h) { unsigned _t = (unsigned)(u).tok[_h * HALF + _R]; _t = _t < (unsigned)NTOK ? _t : (unsigned)(NTOK - 1); GO[_h][_i] = _t * (unsigned)ldab + (unsigned)_C * 2u; } } } } while (0)
    Unit cur, nxt; int ui = 0;
    if (!S.next(0, cur)) return;
    f32x4 acc[2][2][4][2];
#pragma unroll
    for (int a = 0; a < 2; ++a)
#pragma unroll
        for (int b = 0; b < 2; ++b)
#pragma unroll
            for (int m = 0; m < 4; ++m)
#pragma unroll
                for (int n = 0; n < 2; ++n) acc[a][b][m][n] = (f32x4){0.f, 0.f, 0.f, 0.f};
    i32x8 At[4], B0[2], B1[2];
    unsigned gC[2][2] = {{0u, 0u}, {0u, 0u}}, gN[2][2] = {{0u, 0u}, {0u, 0u}};
    PG8_GLOAD(gC, cur);
    const char* cA = cur.A; const char* cB = cur.B;
    bool cur8 = MIXED && cur.nt8 > 0; int ntc = cur8 ? cur.nt8 : nt;
    PG8_STAGEB(PG8_SB(0, 0), cB); PG8_STAGEB(PG8_SB(0, 1), cB + hstepB); PG8_STAGEA(PG8_SA(0, 0), cA, 0, gC); PG8_STAGEA(PG8_SA(0, 1), cA, 1, gC);
    if (wr == 1) PG8_BAR;
    PG8_WAIT_V(2); PG8_BAR;
    PG8_STAGEB(PG8_SB(1, 0), cB + kstep); PG8_STAGEA(PG8_SA(1, 0), cA + kstep, 0, gC); PG8_STAGEB(PG8_SB(1, 1), cB + hstepB + kstep);
    PG8_WAIT_V(6); PG8_BAR;
    for (;;) {
        const bool has_next = S.next(ui + 1, nxt);
        if (has_next) PG8_GLOAD(gN, nxt);
        const char* nA = has_next ? nxt.A : cA; const char* nB = has_next ? nxt.B : cB;
#pragma clang loop unroll(disable)
        for (int t = 0; t < ntc; t += 2) {
            const bool last = (t == ntc - 2);
            const char* a1 = cA + (size_t)(t + 1) * kstep;
            const char* a2 = last ? nA : cA + (size_t)(t + 2) * kstep; const char* b2 = last ? nB : cB + (size_t)(t + 2) * kstep;
            const char* a3 = a2 + kstep; const char* b3 = b2 + kstep;
            PG8_LDB(B0, 0, 0); PG8_LDB(B1, 0, 1); PG8_SCHED; PG8_LDA(At, 0, 0); PG8_STAGEA(PG8_SA(1, 1), a1, 1, gC);
            if (GATHER && last && has_next) {
#pragma unroll
                for (int _h = 0; _h < 2; ++_h)
#pragma unroll
                    for (int _i = 0; _i < 2; ++_i) gC[_h][_i] = gN[_h][_i];
            }
            PG8_WAIT_V(8); PG8_WAIT_L(0); PG8_BAR; PG8_MMA(0, 0, At, B0); PG8_MMA(0, 1, At, B1); PG8_BAR; PG8_SCHED;
            PG8_LDA(At, 0, 1); PG8_STAGEB(PG8_SB(0, 0), b2); PG8_STAGEB(PG8_SB(0, 1), b2 + hstepB); PG8_STAGEA(PG8_SA(0, 0), a2, 0, gC);
            PG8_WAIT_V(8); PG8_WAIT_L(0); PG8_BAR; PG8_MMA(1, 0, At, B0); PG8_MMA(1, 1, At, B1); PG8_BAR; PG8_SCHED;
            PG8_LDB(B0, 1, 0); PG8_LDB(B1, 1, 1); PG8_SCHED; PG8_LDA(At, 1, 0); PG8_STAGEA(PG8_SA(0, 1), a2, 1, gC);
            PG8_WAIT_V(8); PG8_WAIT_L(0); PG8_BAR; PG8_MMA(0, 0, At, B0); PG8_MMA(0, 1, At, B1); PG8_BAR; PG8_SCHED;
            PG8_LDA(At, 1, 1); PG8_STAGEB(PG8_SB(1, 0), b3); PG8_STAGEB(PG8_SB(1, 1), b3 + hstepB); PG8_STAGEA(PG8_SA(1, 0), a3, 0, gC);
            PG8_WAIT_V(8); PG8_WAIT_L(0); PG8_BAR; PG8_MMA(1, 0, At, B0); PG8_MMA(1, 1, At, B1); PG8_BAR; PG8_SCHED;
        }
        if (wr == 0) PG8_BAR;
        asm volatile("s_nop 15\n\ts_nop 7" ::: "memory");
        const int le_ = lane_id();
        const bool keep = E(acc, cur, wr, wc, le_ & 15, le_ >> 4);
        if (!has_next) break;
        if (!keep) {
#pragma unroll
        for (int a = 0; a < 2; ++a)
#pragma unroll
            for (int b = 0; b < 2; ++b)
#pragma unroll
                for (int m = 0; m < 4; ++m)
#pragma unroll
                    for (int n = 0; n < 2; ++n) acc[a][b][m][n] = (f32x4){0.f, 0.f, 0.f, 0.f};
        }
        cur = nxt; cA = nA; cB = nB; ++ui; cur8 = MIXED && cur.nt8 > 0; ntc = cur8 ? cur.nt8 : nt;
        if (wr == 1) PG8_BAR;
    }
    PG8_WAIT_V(0);
    PG8_BAR;
#undef PG8_SA
#undef PG8_SB
#undef PG8_DMA2
#undef PG8_STAGEA
#undef PG8_STAGEB
#undef PG8_LDA
#undef PG8_LDB
#undef PG8_MMA
#undef PG8_MMA8
#undef PG8_MMA16
#undef PG8_LD8
#undef PG8_LO
#undef PG8_HI
#undef PG8_WAIT_V
#undef PG8_WAIT_L
#undef PG8_BAR
#undef PG8_SCHED
#undef PG8_GLOAD
}
}
struct Args { const float* in[22]; float* out; unsigned char* ws; int ph_lo, ph_hi; };
enum { I_X = 0, I_C, I_WADA, I_BADA, I_GMIX, I_WIN, I_QNORM, I_KNORM, I_WAU, I_PLIN, I_PSCALE, I_WPU, I_WOUT, I_GFFN, I_WROUTER, I_RBIAS, I_W1, I_W3, I_W2, I_WS1, I_WS3, I_WS2 };
struct Frame {
    LAS unsigned char* lds;
    int wave, G, gw, NGW;
    unsigned char* ws; unsigned* ctl; float* out;
};
#define LDS_WAIT() asm volatile("s_waitcnt lgkmcnt(0)" ::: "memory")
#define VM_WAIT() asm volatile("s_waitcnt vmcnt(0)" ::: "memory")

__device__ __forceinline__ void tr_tile(const float* __restrict__ src, int ld_src, int nvalid, bf16_t* __restrict__ dst, int ld_dst, int lane) {
    const int q = lane >> 4, c4 = (lane & 15) * 4;
    const bool ok = c4 < nvalid;
#pragma unroll
    for (int g = 0; g < 2; ++g) {
        f32x4 v[8];
#pragma unroll
        for (int j = 0; j < 8; ++j) { const int k = 32 * g + 8 * q + j; v[j] = ok ? *(const f32x4*)(src + (size_t)k * ld_src + c4) : (f32x4){0.f, 0.f, 0.f, 0.f}; }
#pragma unroll
        for (int nn = 0; nn < 4; ++nn) {
            u32x4 w; w.x = cvt_pk_bf16(v[0][nn], v[1][nn]); w.y = cvt_pk_bf16(v[2][nn], v[3][nn]); w.z = cvt_pk_bf16(v[4][nn], v[5][nn]); w.w = cvt_pk_bf16(v[6][nn], v[7][nn]);
            *(u32x4*)(dst + (size_t)(c4 + nn) * ld_dst + 32 * g + 8 * q) = w;
        }
    }
}
__device__ __forceinline__ void tr8_issue(const float* __restrict__ src, int ld_src, int lane, f32x4 (&v)[16], int nvalid = 64) {
    const int q = lane >> 4, c4 = (lane & 15) * 4; const bool ok = c4 < nvalid;
    const unsigned voff = (unsigned)((16 * q) * ld_src + c4) * 4u;
#pragma unroll
    for (int j = 0; j < 16; ++j) v[j] = ok ? __builtin_nontemporal_load((const f32x4*)((const char*)src + (size_t)j * ld_src * 4 + voff)) : (f32x4){0.f, 0.f, 0.f, 0.f};
}
__device__ __forceinline__ void tr8_finish(unsigned char* __restrict__ dst, int ld_dst, int lane, const f32x4 (&v)[16]) {
    const int q = lane >> 4, c4 = (lane & 15) * 4;
#pragma unroll
    for (int nn = 0; nn < 4; ++nn) { u32x4 w;
#pragma unroll
        for (int t = 0; t < 4; ++t) w[t] = pk4_fp8(v[4 * t][nn] * W8_SCALE, v[4 * t + 1][nn] * W8_SCALE, v[4 * t + 2][nn] * W8_SCALE, v[4 * t + 3][nn] * W8_SCALE);
        *(u32x4*)(dst + (size_t)(c4 + nn) * ld_dst + 16 * q) = w; }
}
template <bool F8>
__device__ __forceinline__ void wcopy_tile(const float* src, int ld_src, int nvalid, unsigned char* dstbase, size_t drow, int ldk, int k0, int lane) {
    if constexpr (F8) { f32x4 v[16]; tr8_issue(src, ld_src, lane, v, nvalid); tr8_finish(dstbase + drow * ldk + k0, ldk, lane, v); }
    else tr_tile(src, ld_src, nvalid, (bf16_t*)dstbase + drow * ldk + k0, ldk, lane);
}
constexpr int ADA_WGS = 6 * DM / 128;
__device__ __forceinline__ void p0_prologue(Frame& F, const Args& a) {
    LAS float* sc = (LAS float*)F.lds;
    const int lane = lane_id(), tid = F.wave * 64 + lane;
    for (int i = tid; i < NB * DM; i += NTHR) { const float c = a.in[I_C][i]; sc[i] = c / (1.0f + __expf(-c)); }
    __syncthreads();
    float* mod = (float*)(F.ctl + CW_MOD);
    unsigned char* ws = F.ws;
    for (int job = blockIdx.x; job < 2 * ADA_WGS; job += F.G) {
        const int strip = job % ADA_WGS, kh = job / ADA_WGS, w = F.wave, krow0 = kh * 1024 + 128 * w;
        const int l32 = lane & 31, hb = lane >> 5;
        const float* wp = a.in[I_WADA] + (size_t)(krow0 + hb) * (6 * DM) + strip * 128 + 4 * l32;
        f32x4 b0 = {0.f, 0.f, 0.f, 0.f}, b1 = {0.f, 0.f, 0.f, 0.f};
#pragma unroll 16
        for (int k = 0; k < 64; ++k) { const f32x4 wv = *(const f32x4*)(wp + (size_t)(2 * k) * (6 * DM)); const float s0 = sc[krow0 + 2 * k + hb], s1 = sc[DM + krow0 + 2 * k + hb]; b0 += wv * s0; b1 += wv * s1; }
#pragma unroll
        for (int j = 0; j < 4; ++j) { b0[j] += __shfl_xor(b0[j], 32); b1[j] += __shfl_xor(b1[j], 32); }
        const int col2 = 2 * (lane & 1);
        const f32x2 a0 = {hb ? b0[2] : b0[0], hb ? b0[3] : b0[1]}, a1 = {hb ? b1[2] : b1[0], hb ? b1[3] : b1[1]};
        const int pcol = 4 * l32 + 2 * hb; (void)col2;
        LAS float* part = (LAS float*)(F.lds + 16384);
        *(LAS f32x2*)(part + (w * 2 + 0) * 128 + pcol) = a0; *(LAS f32x2*)(part + (w * 2 + 1) * 128 + pcol) = a1;
        __syncthreads();
        if (tid < 256) { const int b = tid >> 7, c = tid & 127; float sum = kh == 0 ? a.in[I_BADA][strip * 128 + c] : 0.f;
#pragma unroll
            for (int ww = 0; ww < 8; ++ww) sum += part[(ww * 2 + b) * 128 + c];
            unsafeAtomicAdd(mod + b * 6 * DM + strip * 128 + c, sum); }
        __syncthreads();
    }
    unsigned char* Win8 = ws + WS_WIN;
    constexpr int J_IN_A = 32 * 40, J_IN_B = 32 * 4, J_IN_C = 32 * 80, J_AU = 16 * 32, J_PU = 16 * 32, J_OUT = 32 * 32, J_PL = 4 * 16, J_S13 = 2 * 32 * 8, J_S2 = 8 * 32, J_WR = 32,
                  J_W13 = 0, J_W2 = 0;
    constexpr int NITEMS = J_IN_A + J_IN_B + J_IN_C + J_AU + J_PU + J_OUT + J_PL + J_S13 + J_S2 + J_WR;
    for (int it = F.gw; it < NITEMS; it += F.NGW) {
        int r = it;
        if (r < J_IN_A) { const int kb = r / 40, nb = r % 40; if ((nb >> 2) == 5) wcopy_tile<true>(a.in[I_WIN] + (size_t)(64 * kb) * INW + 64 * nb, INW, 64, Win8, (size_t)(64 * nb), 2 * DM, 64 * kb, lane);
            else wcopy_tile<false>(a.in[I_WIN] + (size_t)(64 * kb) * INW + 64 * nb, INW, 64, Win8, (size_t)(64 * nb), DM, 64 * kb, lane); continue; } r -= J_IN_A;
        if (r < J_IN_B) { const int kb = r / 4, nb = r % 4; const int nv = nb == 0 ? 64 : (nb == 1 ? 16 : 0);
            wcopy_tile<false>(a.in[I_WIN] + (size_t)(64 * kb) * INW + 2560 + (nb < 2 ? 64 * nb : 0), INW, nv, Win8, (size_t)(2560 + 64 * nb), DM, 64 * kb, lane); continue; } r -= J_IN_B;
        if (r < J_IN_C) { const int kb = r / 80, nb = r % 80; wcopy_tile<true>(a.in[I_WIN] + (size_t)(64 * kb) * INW + 2640 + 64 * nb, INW, 64, Win8, (size_t)(2816 + 64 * nb), 2 * DM, 64 * kb, lane); continue; } r -= J_IN_C;
        if (r < J_AU) { const int kb = r / 32, nb = r % 32; wcopy_tile<FP8_MERGE>(a.in[I_WAU] + (size_t)(64 * kb) * DM + 64 * nb, DM, 64, ws + WS_WAU, (size_t)(64 * nb), AW, 64 * kb, lane); continue; } r -= J_AU;
        if (r < J_PU) { const int kb = r / 32, nb = r % 32; wcopy_tile<FP8_MERGE>(a.in[I_WPU] + (size_t)(64 * kb) * DM + 64 * nb, DM, 64, ws + WS_WPU, (size_t)(64 * nb), PW, 64 * kb, lane); continue; } r -= J_PU;
        if (r < J_OUT) { const int kb = r / 32, nb = r % 32; wcopy_tile<FP8_OUT>(a.in[I_WOUT] + (size_t)(64 * kb) * DM + 64 * nb, DM, 64, ws + WS_WOUT, (size_t)(64 * nb), DM, 64 * kb, lane); continue; } r -= J_OUT;
        if (r < J_PL) { const int g = r / 16, kb = (r % 16) / 4, nb = r % 4; tr_tile(a.in[I_PLIN] + (size_t)g * 65536 + (size_t)(64 * kb) * 256 + 64 * nb, 256, 64, (bf16_t*)(ws + WS_PLIN) + (size_t)g * 65536 + (size_t)(64 * nb) * 256 + 64 * kb, 256, lane); continue; } r -= J_PL;
        if (r < J_S13) { const int which = r / 256, kb = (r % 256) / 8, nb = r % 8; const float* src = (which ? a.in[I_WS3] : a.in[I_WS1]) + (size_t)(64 * kb) * EH + 64 * nb;
            f32x4 v[16]; tr8_issue(src, EH, lane, v); tr8_finish(ws + WS_WS13 + (size_t)(256 * (nb >> 1) + 64 * (nb & 1) + 128 * which) * DM + 64 * kb, DM, lane, v); continue; } r -= J_S13;
        if (r < J_S2) { const int kb = r / 32, nb = r % 32; f32x4 v[16]; tr8_issue(a.in[I_WS2] + (size_t)(64 * kb) * DM + 64 * nb, DM, lane, v); tr8_finish(ws + WS_WS2 + (size_t)(64 * nb) * EH + 64 * kb, EH, lane, v); continue; } r -= J_S2;
        { const int kb = r; tr_tile(a.in[I_WROUTER] + (size_t)(64 * kb) * NE, NE, 64, (bf16_t*)(ws + WS_WR) + 64 * kb, DM, lane); }
    }
}

constexpr int NCONV_W13 = NE * 2 * 32 * 8, NCONV = NCONV_W13 + NE * 8 * 32;
__device__ __forceinline__ void conv_ptrs(const Args& a, unsigned char* ws, int it, const float*& src, int& ld_src, unsigned char*& dst, int& ld_dst) {
    if (it < NCONV_W13) { const int e = it / 512, rr = it % 512, which = rr / 256, kb = (rr % 256) / 8, nb = rr % 8;
        src = (which ? a.in[I_W3] : a.in[I_W1]) + ((size_t)e * DM + 64 * kb) * EH + 64 * nb; ld_src = EH;
        dst = ws + WS_W13 + ((size_t)e * 1024 + 256 * (nb >> 1) + 64 * (nb & 1) + 128 * which) * DM + 64 * kb; ld_dst = DM; }
    else { const int r = it - NCONV_W13, e = r / 256, kb = (r % 256) / 32, nb = r % 32;
        src = a.in[I_W2] + ((size_t)e * EH + 64 * kb) * DM + 64 * nb; ld_src = DM; dst = ws + WS_W2 + ((size_t)e * DM + 64 * nb) * EH + 64 * kb; ld_dst = EH; }
}
__device__ __forceinline__ void conv_issue16(const Args& a, unsigned char* ws, int it, int lane, f32x4 (&v)[16]) {
    const float* src; int ld_src; unsigned char* dst; int ld_dst; conv_ptrs(a, ws, it, src, ld_src, dst, ld_dst); tr8_issue(src, ld_src, lane, v); }
__device__ __forceinline__ void conv_finish16(const Args& a, unsigned char* ws, int it, int lane, const f32x4 (&v)[16]) {
    const float* src; int ld_src; unsigned char* dst; int ld_dst; conv_ptrs(a, ws, it, src, ld_src, dst, ld_dst); tr8_finish(dst, ld_dst, lane, v); }
__device__ __forceinline__ void phase_done(Frame& F, int phase) { __syncthreads(); if (F.wave == 0 && lane_id() == 0) __hip_atomic_fetch_add(F.ctl + CW_DONE + 64 * phase, 1u, __ATOMIC_RELAXED, __HIP_MEMORY_SCOPE_AGENT); }
constexpr int CONV_SEG1_END = NCONV_W13 + (NCONV - NCONV_W13) * 3 / 10 / 8 * 8;
__device__ __forceinline__ unsigned conv_seg_lo(int sg) { return sg == 0 ? 0u : (sg == 1 ? (unsigned)NCONV_W13 : (unsigned)CONV_SEG1_END); }
__device__ __forceinline__ unsigned conv_seg_hi(int sg) { return sg == 0 ? (unsigned)NCONV_W13 : (sg == 1 ? (unsigned)CONV_SEG1_END : (unsigned)NCONV); }
template <bool BOUNDED, int SEG_LO, int SEG_HI>
struct ConvQ {
    Frame& F; int phase, lane; unsigned cur, end; int sg;
    __device__ __forceinline__ int next() {
        constexpr unsigned B = BOUNDED ? 6u : 8u;
        while (cur >= end) {
            if (BOUNDED) { const unsigned d = __hip_atomic_load(F.ctl + CW_DONE + 64 * phase, __ATOMIC_RELAXED, __HIP_MEMORY_SCOPE_AGENT); if ((unsigned)__builtin_amdgcn_readfirstlane(d) >= (unsigned)F.G) return -1; }
            const unsigned lo = conv_seg_lo(sg), hi = conv_seg_hi(sg);
            unsigned s = 0; if (lane == 0) s = __hip_atomic_fetch_add(F.ctl + CW_CONVQ + 64 * sg, B, __ATOMIC_RELAXED, __HIP_MEMORY_SCOPE_AGENT);
            s = (unsigned)__builtin_amdgcn_readfirstlane(s) + lo;
            if (s >= hi) { if (sg < SEG_HI) { ++sg; continue; } return -1; }
            cur = s; end = s + B < hi ? s + B : hi;
        }
        return (int)cur++;
    }
};
template <bool BOUNDED, int SEG_LO, int SEG_HI>
__device__ __forceinline__ void conv_drain(Frame& F, const Args& a, int phase, int quota = 0) {
    const int lane = lane_id();
    ConvQ<BOUNDED, SEG_LO, SEG_HI> Q{F, phase, lane, 0u, 0u, SEG_LO};
    f32x4 va[16], vb[16]; int n = 0;
    int ia = Q.next(); if (ia < 0) return;
    conv_issue16(a, F.ws, ia, lane, va);
    for (;;) {
        ++n; const int ib = (quota > 0 && n >= quota && Q.cur >= Q.end) ? -1 : Q.next(); if (ib >= 0) conv_issue16(a, F.ws, ib, lane, vb);
        conv_finish16(a, F.ws, ia, lane, va);
        if (ib < 0) break;
        ++n; ia = (quota > 0 && n >= quota && Q.cur >= Q.end) ? -1 : Q.next(); if (ia >= 0) conv_issue16(a, F.ws, ia, lane, va);
        conv_finish16(a, F.ws, ib, lane, vb);
        if (ia < 0) break;
    }
}

__device__ __forceinline__ void modnorm_row(const float* __restrict__ xrow, const float* __restrict__ g, const float* __restrict__ shift, const float* __restrict__ scale, unsigned char* __restrict__ orow, unsigned char* __restrict__ orow8, int lane) {
    f32x4 v[8]; float ss = 0.f;
#pragma unroll
    for (int j = 0; j < 8; ++j) { v[j] = *(const f32x4*)(xrow + 4 * lane + 256 * j); ss += (v[j].x * v[j].x + v[j].y * v[j].y) + (v[j].z * v[j].z + v[j].w * v[j].w); }
    const float rstd = rsqrtf(wave_sum(ss) * (1.0f / DM) + NORM_EPS);
#pragma unroll
    for (int j = 0; j < 8; ++j) { const int c = 4 * lane + 256 * j;
        const f32x4 gg = *(const f32x4*)(g + c), sh = *(const f32x4*)(shift + c), sl = *(const f32x4*)(scale + c);
        const f32x4 o = v[j] * rstd * gg * (sl + 1.0f) + sh;
        { u32x2 w; w.x = cvt_pk_bf16(o.x, o.y); w.y = cvt_pk_bf16(o.z, o.w); *(u32x2*)((bf16_t*)orow + c) = w; }
        if (orow8) *(unsigned*)(orow8 + c) = pk4_fp8(o.x * A8_SCALE, o.y * A8_SCALE, o.z * A8_SCALE, o.w * A8_SCALE); }
}
__device__ __forceinline__ void p1_h(Frame& F, const Args& a) {
    const float* mod = (const float*)(F.ctl + CW_MOD);
    unsigned char* hb = F.ws + WS_HB; const int lane = lane_id();
    for (int m = F.gw; m < NTOK; m += F.NGW) { const int b = m / SEQ;
        modnorm_row(a.in[I_X] + (size_t)m * DM, a.in[I_GMIX], mod + b * 6 * DM + 0 * DM, mod + b * 6 * DM + 1 * DM, hb + (size_t)m * DM * 2, F.ws + WS_H8 + (size_t)m * DM * 2, lane); }
}
struct SchedDense {
    pg8::TileOrder T; const char* A; const char* B; size_t a_tile, b_tile;
    __device__ __forceinline__ bool next(int i, pg8::Unit& u) const { int pm, pn; if (!T.tile(i, pm, pn)) return false; u.pm = pm; u.pn = pn; u.aux = 0; u.tok = nullptr; u.nt8 = 0;
        u.A = A + (size_t)pm * a_tile; u.B = B + (size_t)pn * b_tile; return true; }
};
__device__ __forceinline__ void st_bf16x8(bf16_t* p, f32x4 v0, f32x4 v1) { u32x4 w; w.x = cvt_pk_bf16(v0[0], v0[1]); w.y = cvt_pk_bf16(v0[2], v0[3]); w.z = cvt_pk_bf16(v1[0], v1[1]); w.w = cvt_pk_bf16(v1[2], v1[3]); *(u32x4*)p = w; }
struct EpiInproj {
    unsigned char* ws;
    __device__ __forceinline__ bool operator()(f32x4 (&acc)[2][2][4][2], const pg8::Unit& u, int wr, int wc, int fr, int fq) const {
        const int pn = u.pn; bf16_t* base; int ld, ct; bool sig = false;
        if (pn < 4) { base = (bf16_t*)(ws + WS_Q); ld = AW; ct = pn; }
        else if (pn == 4) { base = (bf16_t*)(ws + WS_K); ld = KVW; ct = 0; }
        else if (pn == 5) { base = (bf16_t*)(ws + WS_V); ld = KVW; ct = 0; }
        else if (pn < 10) { base = (bf16_t*)(ws + WS_QI); ld = IH * ID; ct = pn - 6; }
        else if (pn == 10) { base = (bf16_t*)(ws + WS_KW); ld = 256; ct = 0; }
        else if (pn < 15) { base = (bf16_t*)(ws + WS_U); ld = PW; ct = pn - 11; }
        else { base = (bf16_t*)(ws + WS_G); ld = 2 * DM; ct = pn - 15; sig = true; }
        const int row0 = u.pm * 256 + wr * 64 + fr, col0 = ct * 256 + wc * 32 + 8 * fq;
#pragma unroll
        for (int ai = 0; ai < 2; ++ai)
#pragma unroll
            for (int m = 0; m < 4; ++m) { bf16_t* rowp = base + (size_t)(row0 + ai * 128 + m * 16) * ld + col0;
#pragma unroll
                for (int bj = 0; bj < 2; ++bj) { f32x4 v0 = acc[ai][bj][m][0], v1 = acc[ai][bj][m][1];
                    if (sig) {
#pragma unroll
                        for (int j = 0; j < 4; ++j) { v0[j] = fminf(__builtin_amdgcn_rcpf(1.0f + __expf(-v0[j])), 1.0f); v1[j] = fminf(__builtin_amdgcn_rcpf(1.0f + __expf(-v1[j])), 1.0f); } }
                    st_bf16x8(rowp + bj * 128, v0, v1); } }
        return false;
    }
};
struct SchedInproj {
    int G, c, kind; const char* hA; const char* win;
    __device__ __forceinline__ bool next(int i, pg8::Unit& u) const {
        const int first = kind == 0 ? c : c + ((320 - c + G - 1) / G) * G;
        const int j = first + i * G; if (j >= (kind == 0 ? 320 : 992)) return false;
        int pn, pm;
        if (kind == 0) { const int t = j >> 5; pm = j & 31; pn = t < 5 ? t : t + 1; }
        else { const int jj = j - 320, t = jj >> 5; pm = jj & 31; pn = t == 0 ? 5 : t + 10; }
        u.pm = pm; u.pn = pn; u.aux = 0; u.tok = nullptr; u.nt8 = 0;
        u.A = hA + (size_t)pm * 256 * DM * 2; u.B = win + (size_t)pn * 256 * DM * 2; return true; }
};
__device__ __forceinline__ void p2_inproj(Frame& F, const Args& a) {
    const int NG = F.G >= 256 ? 248 : F.G;
    if ((int)blockIdx.x >= NG) { conv_drain<false, 0, 2>(F, a, 2, 24); return; }
    EpiInproj E{F.ws};
    { SchedInproj S{NG, (int)blockIdx.x, 0, (const char*)(F.ws + WS_HB), (const char*)(F.ws + WS_WIN)};
      pg8::gemm_phase<EpiInproj, SchedInproj, false, 2>(F.lds, F.wave, DM * 2, DM * 2, S, E); }
    { SchedInproj S{NG, (int)blockIdx.x, 1, (const char*)(F.ws + WS_H8), (const char*)(F.ws + WS_WIN)};
      pg8::gemm_phase<EpiInproj, SchedInproj, false, 1, A8_E8, W8_E8>(F.lds, F.wave, DM * 2, DM * 2, S, E, DM / 128); }
}
__device__ __forceinline__ void p3_qknorm(Frame& F, const Args& a) {
    bf16_t* K = (bf16_t*)(F.ws + WS_K);
    const int lane = lane_id();
    for (int m = F.gw; m < NTOK; m += F.NGW) {
        u32x2 k0 = *(const u32x2*)(K + (size_t)m * KVW + 4 * lane);
        float kv[4]; float sk = 0.f;
        kv[0] = bflo(k0[0]); kv[1] = bfhi(k0[0]); kv[2] = bflo(k0[1]); kv[3] = bfhi(k0[1]);
#pragma unroll
        for (int j = 0; j < 4; ++j) sk += kv[j] * kv[j];
        sk += __shfl_xor(sk, 1); sk += __shfl_xor(sk, 2); sk += __shfl_xor(sk, 4); sk += __shfl_xor(sk, 8); sk += __shfl_xor(sk, 16);
        const float rk = rsqrtf(sk * (1.0f / HD) + NORM_EPS);
        const int dk = (4 * lane) & 127;
        u32x2 ok; ok[0] = cvt_pk_bf16(kv[0] * rk * a.in[I_KNORM][dk], kv[1] * rk * a.in[I_KNORM][dk + 1]); ok[1] = cvt_pk_bf16(kv[2] * rk * a.in[I_KNORM][dk + 2], kv[3] * rk * a.in[I_KNORM][dk + 3]);
        *(u32x2*)(K + (size_t)m * KVW + 4 * lane) = ok;
    }
}
__device__ __forceinline__ void pooled_item(Frame& F, int t0, int g, int lane) {
    const bf16_t* U = (const bf16_t*)(F.ws + WS_U); bf16_t* P = (bf16_t*)(F.ws + WS_POOLED);
    const int pos0 = t0 % SEQ, w = 2 << g, c = 256 * g + 4 * lane;
    f32x4 W = {0.f, 0.f, 0.f, 0.f};
    for (int j = 1; j <= 16; ++j) { if (j <= w && pos0 - j >= 0) { const u32x2 v = *(const u32x2*)(U + (size_t)(t0 - j) * PW + c); W += (f32x4){bflo(v[0]), bfhi(v[0]), bflo(v[1]), bfhi(v[1])}; } }
#pragma unroll 8
    for (int i = 0; i < 32; ++i) { const int t = t0 + i, pos = pos0 + i;
        const u32x2 v = *(const u32x2*)(U + (size_t)t * PW + c); const f32x4 cur = {bflo(v[0]), bfhi(v[0]), bflo(v[1]), bfhi(v[1])};
        W += cur;
        if (pos - w >= 0) { const u32x2 o = *(const u32x2*)(U + (size_t)(t - w) * PW + c); W -= (f32x4){bflo(o[0]), bfhi(o[0]), bflo(o[1]), bfhi(o[1])}; }
        const float inv = 1.0f / (float)(pos + 1 < w ? pos + 1 : w);
        const f32x4 r = W * inv - cur;
        u32x2 ow; ow[0] = cvt_pk_bf16(r[0], r[1]); ow[1] = cvt_pk_bf16(r[2], r[3]);
        *(u32x2*)(P + (size_t)t * PW + c) = ow; }
}
__device__ __forceinline__ unsigned mono_key(float s) { const unsigned u = __float_as_uint(s); return (u & 0x80000000u) ? ~u : (u | 0x80000000u); }
__device__ __forceinline__ void idx_block(Frame& F, const Args& a, int b, int i16) {
    const bf16_t* QI = (const bf16_t*)(F.ws + WS_QI); const bf16_t* KW = (const bf16_t*)(F.ws + WS_KW);
    unsigned short* MT = (unsigned short*)(F.ws + WS_MASK);
    LAS unsigned* T = (LAS unsigned*)F.lds;
    const int lane = lane_id(), w = F.wave, tid = w * 64 + lane, r32 = lane & 31, hi = lane >> 5;
    const int tpos0 = 16 * i16, t0 = b * SEQ + tpos0, nh = (tpos0 + 16 + 31) >> 5, kzero = 64 * ((tpos0 >> 6) + 1);
    for (int k = tid; k < kzero; k += NTHR) T[k] = 0u;
    bf16x8 Af[4];
    { const int qsel = (r32 >> 2) & 1, head = (r32 & 3) + 4 * (r32 >> 3); const size_t tq = (size_t)(t0 + 2 * w + qsel);
      const float wv = bf2f(KW[tq * 256 + 64 + head]);
#pragma unroll
      for (int s = 0; s < 4; ++s) { const u32x4 q = *(const u32x4*)(QI + tq * (IH * ID) + head * ID + 16 * s + 8 * hi); u32x4 o;
#pragma unroll
          for (int j = 0; j < 4; ++j) o[j] = cvt_pk_bf16(bflo(q[j]) * wv, bfhi(q[j]) * wv);
          Af[s] = __builtin_bit_cast(bf16x8, o); } }
    float X[16];
    { const size_t tq = (size_t)(t0 + 2 * w + hi); const u32x4 w0 = *(const u32x4*)(KW + tq * 256 + 64), w1 = *(const u32x4*)(KW + tq * 256 + 72);
      const float PINF = __builtin_inff();
#pragma unroll
      for (int j = 0; j < 4; ++j) { X[2 * j] = bflo(w0[j]) >= 0.f ? PINF : -PINF; X[2 * j + 1] = bfhi(w0[j]) >= 0.f ? PINF : -PINF;
                                    X[8 + 2 * j] = bflo(w1[j]) >= 0.f ? PINF : -PINF; X[8 + 2 * j + 1] = bfhi(w1[j]) >= 0.f ? PINF : -PINF; } }
    const int mypos = tpos0 + 2 * w + hi;
    unsigned keys[128];
    constexpr int RING = 16384, SLOT = 8192;
    const int nt64 = (nh + 1) >> 1;
    const unsigned dvoff = (unsigned)((lane >> 3) * 512 + (((lane & 7) ^ (lane >> 3)) << 4));
    const char* kwb = (const char*)(KW + (size_t)b * SEQ * 256) + w * 4096;
    const unsigned ldsw = (unsigned)(uintptr_t)F.lds + RING + w * 1024;
#define IDX_DMA(t_) do { unsigned keep_; asm volatile("s_mov_b32 %0, m0\n\ts_mov_b32 m0, %3\n\ts_nop 0\n\tglobal_load_lds_dwordx4 %1, %2\n\ts_mov_b32 m0, %0" \
        : "=&s"(keep_) : "v"(dvoff), "s"(kwb + (size_t)(t_) * 32768), "s"(ldsw + (unsigned)(((t_) & 3) * SLOT)) : "memory"); } while (0)
    int boffs[4];
#pragma unroll
    for (int s = 0; s < 4; ++s) boffs[s] = r32 * 128 + ((((2 * s + hi) ^ (r32 & 7))) << 4);
    __syncthreads();
    if (0 < nt64) IDX_DMA(0);
    if (1 < nt64) IDX_DMA(1);
    if (2 < nt64) IDX_DMA(2);
#pragma unroll
    for (int t = 0; t < 64; ++t) {
        keys[2 * t] = 0u; keys[2 * t + 1] = 0u;
        if (t < nt64) {
            const int rem = nt64 - 1 - t;
            if (rem >= 2) asm volatile("s_waitcnt vmcnt(2)" ::: "memory"); else if (rem == 1) asm volatile("s_waitcnt vmcnt(1)" ::: "memory"); else asm volatile("s_waitcnt vmcnt(0)" ::: "memory");
            __builtin_amdgcn_s_barrier(); asm volatile("" ::: "memory");
            if (t + 3 < nt64) IDX_DMA(t + 3);
#pragma unroll
            for (int half = 0; half < 2; ++half) { const int n = 2 * t + half;
                if (n < nh) {
                    f32x16 acc = {0.f, 0.f, 0.f, 0.f, 0.f, 0.f, 0.f, 0.f, 0.f, 0.f, 0.f, 0.f, 0.f, 0.f, 0.f, 0.f};
#pragma unroll
                    for (int s = 0; s < 4; ++s) { const bf16x8 bfr = *(const LAS bf16x8*)(F.lds + RING + (t & 3) * SLOT + half * 4096 + boffs[s]);
                        acc = __builtin_amdgcn_mfma_f32_32x32x16_bf16(Af[s], bfr, acc, 0, 0, 0); }
                    float sc = 0.f;
#pragma unroll
                    for (int j = 0; j < 16; ++j) sc += __builtin_amdgcn_fmed3f(acc[j], 0.f, X[j]);
                    keys[n] = (32 * n + r32 <= mypos) ? mono_key(sc) : 0u;
                } }
        }
    }
#undef IDX_DMA
    unsigned Tsel = 0u;
    { constexpr int HIST = 49152;
      LAS unsigned* hb = (LAS unsigned*)(F.lds + HIST) + (2 * w + hi) * 512;
      unsigned kk = (unsigned)TOPK; bool alive = true;
#pragma unroll 1
      for (int p = 0; p < 4; ++p) { const int sh = 24 - 8 * p;
          *(LAS u32x4*)(hb + 8 * r32) = (u32x4){0u, 0u, 0u, 0u}; *(LAS u32x4*)(hb + 8 * r32 + 4) = (u32x4){0u, 0u, 0u, 0u};
          asm volatile("s_waitcnt lgkmcnt(0)" ::: "memory");
#pragma unroll
          for (int n8 = 0; n8 < 16; ++n8) { if (n8 * 8 < nh) {
#pragma unroll
              for (int j = 0; j < 8; ++j) { const unsigned key = keys[n8 * 8 + j];
                  const unsigned x = p ? ((key ^ Tsel) >> ((sh + 8) & 31)) : 0u, t = x < 1u ? x : 1u;
                  __hip_atomic_fetch_add(hb + ((t << 8) + ((key >> sh) & 255u)), 1u, __ATOMIC_RELAXED, __HIP_MEMORY_SCOPE_WORKGROUP); } } }
          asm volatile("s_waitcnt lgkmcnt(0)" ::: "memory");
          const u32x4 c0 = *(const LAS u32x4*)(hb + 8 * r32), c1 = *(const LAS u32x4*)(hb + 8 * r32 + 4);
          const unsigned cb[8] = {(p == 0 && r32 == 0) ? 0u : c0[0], c0[1], c0[2], c0[3], c1[0], c1[1], c1[2], c1[3]};
          unsigned S = 0;
#pragma unroll
          for (int j = 0; j < 8; ++j) S += cb[j];
          unsigned suf = S;
#pragma unroll
          for (int d = 1; d < 32; d <<= 1) { const unsigned y = __shfl_down(suf, d, 32); if (r32 + d < 32) suf += y; }
          const unsigned total = __shfl(suf, 0, 32), sufx = suf - S;
          if (alive && total < kk) alive = false;
          const bool mine = alive && sufx < kk && kk <= suf;
          unsigned acc = sufx, bsel = 0u, above = 0u; bool found = false;
#pragma unroll
          for (int j = 7; j >= 0; --j) { if (!found) { if (acc + cb[j] >= kk) { found = true; bsel = (unsigned)(8 * r32 + j); above = acc; } else acc += cb[j]; } }
          const unsigned long long bm = __ballot(mine);
          const unsigned half = hi ? (unsigned)(bm >> 32) : (unsigned)bm;
          const int src = half ? (__builtin_ctz(half) + 32 * hi) : lane;
          const unsigned bs = __shfl(bsel, src), ab = __shfl(above, src);
          if (alive) { Tsel |= bs << sh; kk -= ab; }
      }
      if (!alive) Tsel = 0u;
    }
    { const unsigned Tf = Tsel > 1u ? Tsel : 1u;
      __syncthreads();
#pragma unroll
      for (int n = 0; n < 128; ++n) { if (n < nh) {
          unsigned bitv = keys[n] >= Tf ? 1u : 0u; const unsigned other = __shfl_xor(bitv, 32);
          bitv |= other << 1;
          if (hi == 0 && bitv) __hip_atomic_fetch_or(T + 32 * n + r32, bitv << (2 * w), __ATOMIC_RELAXED, __HIP_MEMORY_SCOPE_WORKGROUP); } }
    }
    __syncthreads();
    { const int rg = (b * SEQ + tpos0) >> 5, f = i16 & 1;
      for (int k = tid; k < kzero; k += NTHR) { const int kk = k & 63, p = (kk & ~7) | ((kk & 3) << 1) | ((kk >> 2) & 1);
          MT[((size_t)(rg * 64 + (k >> 6)) * 64 + p) * 2 + f] = (unsigned short)(T[k] & 0xffffu); } }
    __syncthreads();
}
__device__ __forceinline__ void p3_indexer(Frame& F, const Args& a) {
    for (int v2 = 2 * blockIdx.x; v2 < 512; v2 += 2 * F.G) { for (int ps = 0; ps < 2; ++ps) { const int v = v2 >> 1, b = v >> 7, i = v & 127; idx_block(F, a, b, ps ? 255 - i : i); } }
}
namespace att {
constexpr int KVBLK = 64, SHM_V = KVBLK * HD * 2, SHM_K = KVBLK * HD * 2;
constexpr int LDS_V = 0, LDS_K = 2 * SHM_V, LDS_WS = 2 * SHM_V + 2 * SHM_K, LDS_BYTES = LDS_WS + NWAVES * 64 * 4;
constexpr float THR = 8.f, LOG2E = 1.4426950408889634f;
#define KSWZ(row, colB) ((row) * 256 + ((colB) ^ (((row) & 7) << 4)))
#define SBAR() __builtin_amdgcn_sched_barrier(0)
__device__ __forceinline__ int v_st(int k, int c) { const int kk = (k & ~0xC) | ((k & 4) << 1) | ((k & 8) >> 1); return ((kk >> 3) * 4 + (c >> 5)) * 512 + ((kk & 7) * 32 + (c & 31)) * 2; }
__device__ __forceinline__ int v_rd_base(int lane) { return ((lane & 3) << 3) | (((lane >> 2) & 3) << 6) | (((lane >> 4) & 1) << 5) | (((lane >> 5) & 1) << 8); }
constexpr int v_rd_off(int d0, int ks, int half) { return d0 * 512 + ks * 4096 + half * 2048; }
__device__ __forceinline__ int crow(int r, int hi) { return (r & 3) + 8 * (r >> 2) + 4 * hi; }
__device__ __forceinline__ bool partialSM(f32x16& p0, f32x16& p1, float& m_reg, float& mn, float& alpha) {
    float pmax = p0[0];
#pragma unroll
    for (int r = 1; r < 16; ++r) pmax = fmaxf(pmax, p0[r]);
#pragma unroll
    for (int r = 0; r < 16; ++r) pmax = fmaxf(pmax, p1[r]);
    { auto rr = __builtin_amdgcn_permlane32_swap(__float_as_uint(pmax), __float_as_uint(pmax), false, false);
      pmax = fmaxf(__uint_as_float(rr[0]), __uint_as_float(rr[1])); }
    if (__all(pmax - m_reg < -106.f)) return false;
    if (__builtin_expect(__all((pmax - m_reg) <= THR), 1)) { mn = m_reg; alpha = 1.f; }
    else { mn = fmaxf(m_reg, pmax); alpha = __builtin_amdgcn_exp2f((m_reg - mn) * LOG2E); m_reg = mn; }
    const float mnL = -mn * LOG2E;
#pragma unroll
    for (int r = 0; r < 16; ++r) p0[r] = fmaf(p0[r], LOG2E, mnL);
#pragma unroll
    for (int r = 0; r < 16; ++r) p1[r] = fmaf(p1[r], LOG2E, mnL);
#pragma unroll
    for (int r = 0; r < 16; ++r) p0[r] = __builtin_amdgcn_exp2f(p0[r]);
    return true;
}
__device__ __forceinline__ void finishSM(f32x16& p0, f32x16& p1, float alpha, float& l_reg, bf16x8& pa0, bf16x8& pa1, bf16x8& pa2, bf16x8& pa3) {
#pragma unroll
    for (int r = 0; r < 16; ++r) p1[r] = __builtin_amdgcn_exp2f(p1[r]);
    float ps = 0;
#pragma unroll
    for (int r = 0; r < 16; ++r) ps += p0[r];
#pragma unroll
    for (int r = 0; r < 16; ++r) ps += p1[r];
    { auto rr = __builtin_amdgcn_permlane32_swap(__float_as_uint(ps), __float_as_uint(ps), false, false);
      ps = __uint_as_float(rr[0]) + __uint_as_float(rr[1]); }
    l_reg = l_reg * alpha + ps;
#define PK4(P, B_, OUT) do { unsigned a0 = cvt_pk_bf16(P[B_+0], P[B_+1]), a1 = cvt_pk_bf16(P[B_+2], P[B_+3]);                          \
        unsigned b0 = cvt_pk_bf16(P[B_+4], P[B_+5]), b1 = cvt_pk_bf16(P[B_+6], P[B_+7]);                                             \
        auto r0 = __builtin_amdgcn_permlane32_swap(a0, b0, false, false); auto r1 = __builtin_amdgcn_permlane32_swap(a1, b1, false, false); \
        u32x4 w = {r0[0], r1[0], r0[1], r1[1]}; OUT = __builtin_bit_cast(bf16x8, w); } while (0)
    PK4(p0, 0, pa0); PK4(p0, 8, pa1); PK4(p1, 0, pa2); PK4(p1, 8, pa3);
#undef PK4
}
template <int KB>
__device__ __forceinline__ void qkt(f32x16& p0, f32x16& p1, const LAS char* K_lds, int r32, int hi, const bf16x8* qr, bf16x8 kf0, bf16x8 kf1, bf16x8 qf) {
    const LAS char* kb[4];
#pragma unroll
    for (int dd = 0; dd < 4; ++dd) kb[dd] = K_lds + KB * SHM_K + KSWZ(r32, (dd * 16 + hi * 8) * 2);
    bf16x8 ka[2], kc[2];
    ka[0] = *(const LAS bf16x8*)(kb[0]); kc[0] = *(const LAS bf16x8*)(kb[0] + 32 * 256);
    p0 = __builtin_amdgcn_mfma_f32_32x32x16_bf16(kf0, qf, (f32x16){0.f, 0.f, 0.f, 0.f, 0.f, 0.f, 0.f, 0.f, 0.f, 0.f, 0.f, 0.f, 0.f, 0.f, 0.f, 0.f}, 0, 0, 0);
    p1 = __builtin_amdgcn_mfma_f32_32x32x16_bf16(kf1, qf, (f32x16){0.f, 0.f, 0.f, 0.f, 0.f, 0.f, 0.f, 0.f, 0.f, 0.f, 0.f, 0.f, 0.f, 0.f, 0.f, 0.f}, 0, 0, 0);
    SBAR();
#pragma unroll
    for (int d0 = 0; d0 < 8; ++d0) { const int c = d0 & 1;
        if (d0 < 7) { const LAS char* ap = kb[(d0 + 1) & 3] + ((d0 + 1) >> 2) * 128; ka[c ^ 1] = *(const LAS bf16x8*)(ap); kc[c ^ 1] = *(const LAS bf16x8*)(ap + 32 * 256); }
        p0 = __builtin_amdgcn_mfma_f32_32x32x16_bf16(ka[c], qr[d0], p0, 0, 0, 0);
        p1 = __builtin_amdgcn_mfma_f32_32x32x16_bf16(kc[c], qr[d0], p1, 0, 0, 0);
        SBAR(); }
}
template <int VB>
__device__ __forceinline__ void pv_tile(f32x16* o, int vb0, bf16x8 pa0, bf16x8 pa1, bf16x8 pa2, bf16x8 pa3) {
#define TRRD(dst, off) asm volatile("ds_read_b64_tr_b16 %0, %1 offset:%2" : "=&v"(dst) : "v"(vb0), "i"(off) : "memory")
#define PV_RD(S, d0) do { constexpr int b_ = VB * SHM_V + v_rd_off(d0, 0, 0); \
        TRRD(S[0], b_); TRRD(S[4], b_ + 2048); TRRD(S[1], b_ + 4096); TRRD(S[5], b_ + 6144); TRRD(S[2], b_ + 8192); TRRD(S[6], b_ + 10240); TRRD(S[3], b_ + 12288); TRRD(S[7], b_ + 14336); } while (0)
#define PV_MM(S, d0) do { \
        o[d0] = __builtin_amdgcn_mfma_f32_32x32x16_bf16(pa0, (bf16x8){S[0][0], S[0][1], S[0][2], S[0][3], S[4][0], S[4][1], S[4][2], S[4][3]}, o[d0], 0, 0, 0);   \
        o[d0] = __builtin_amdgcn_mfma_f32_32x32x16_bf16(pa1, (bf16x8){S[1][0], S[1][1], S[1][2], S[1][3], S[5][0], S[5][1], S[5][2], S[5][3]}, o[d0], 0, 0, 0);   \
        o[d0] = __builtin_amdgcn_mfma_f32_32x32x16_bf16(pa2, (bf16x8){S[2][0], S[2][1], S[2][2], S[2][3], S[6][0], S[6][1], S[6][2], S[6][3]}, o[d0], 0, 0, 0);   \
        o[d0] = __builtin_amdgcn_mfma_f32_32x32x16_bf16(pa3, (bf16x8){S[3][0], S[3][1], S[3][2], S[3][3], S[7][0], S[7][1], S[7][2], S[7][3]}, o[d0], 0, 0, 0); } while (0)
    s16x4 A[8], B[8];
    PV_RD(A, 0);
    PV_RD(B, 1); asm volatile("s_waitcnt lgkmcnt(8)" ::: "memory"); SBAR(); PV_MM(A, 0); SBAR();
    PV_RD(A, 2); asm volatile("s_waitcnt lgkmcnt(8)" ::: "memory"); SBAR(); PV_MM(B, 1); SBAR();
    PV_RD(B, 3); asm volatile("s_waitcnt lgkmcnt(8)" ::: "memory"); SBAR(); PV_MM(A, 2); SBAR();
    asm volatile("s_waitcnt lgkmcnt(0)" ::: "memory"); SBAR(); PV_MM(B, 3);
#undef PV_RD
#undef PV_MM
#undef TRRD
}
typedef const __attribute__((address_space(4))) unsigned long long* cmask_t;
__device__ __forceinline__ void mask_tile(f32x16& p0, f32x16& p1, const unsigned long long* mpg) {
    const float NEG = -__builtin_inff();
    cmask_t mp = (cmask_t)mpg;
    asm volatile("s_nop 15\n\ts_nop 7" : "+v"(p0), "+v"(p1));
#pragma unroll
    for (int r = 0; r < 16; ++r) { const unsigned long long m0 = mp[r], m1 = mp[16 + r];
        asm volatile("v_cndmask_b32 %0, %1, %0, %2" : "+v"(p0[r]) : "v"(NEG), "s"(m0));
        asm volatile("v_cndmask_b32 %0, %1, %0, %2" : "+v"(p1[r]) : "v"(NEG), "s"(m1)); }
}
template <int BUF>
__device__ __forceinline__ void tile_step(f32x16* o, float& m_reg, float& l_reg, const LAS char* K_lds, int vb0, LAS float* al_l, int r32, int hi, const bf16x8* qr,
                                          int kb_key, bf16x8 qf, const unsigned long long* mp) {
    f32x16 p0, p1; float mn, alpha; bf16x8 pa0, pa1, pa2, pa3;
    const unsigned kbb = __float_as_uint((float)kb_key) >> 16, k0b = __float_as_uint((float)r32) >> 16, k1b = __float_as_uint((float)(r32 + 32)) >> 16;
    u32x4 f0 = {hi ? 0u : (kbb | (k0b << 16)), 0u, 0u, 0u}, f1 = {hi ? 0u : (kbb | (k1b << 16)), 0u, 0u, 0u};
    qkt<BUF>(p0, p1, K_lds, r32, hi, qr, __builtin_bit_cast(bf16x8, f0), __builtin_bit_cast(bf16x8, f1), qf);
    mask_tile(p0, p1, mp);
    if (!partialSM(p0, p1, m_reg, mn, alpha)) return;
    finishSM(p0, p1, alpha, l_reg, pa0, pa1, pa2, pa3);
    if (__any(alpha < 1.f)) { if (hi == 0) al_l[r32] = alpha; asm volatile("s_waitcnt lgkmcnt(0)" ::: "memory");
#pragma unroll
        for (int r = 0; r < 16; ++r) { const float av = al_l[crow(r, hi)];
#pragma unroll
            for (int d_ = 0; d_ < 4; ++d_) o[d_][r] *= av; } }
    pv_tile<BUF>(o, vb0, pa0, pa1, pa2, pa3);
}
__device__ __forceinline__ void attn_unit(Frame& F, const float* __restrict__ qgain, int b, int g, int qb, unsigned* done_ctr) {
    const bf16_t* Q = (const bf16_t*)(F.ws + WS_Q); const bf16_t* K = (const bf16_t*)(F.ws + WS_K); const bf16_t* V = (const bf16_t*)(F.ws + WS_V);
    unsigned char* O = F.ws + WS_ATTN;
    const unsigned long long* MT = (const unsigned long long*)(F.ws + WS_MASK);
    LAS char* lds = (LAS char*)F.lds;
    const int wid = F.wave, lane = lane_id(), tid = wid * 64 + lane, r32 = lane & 31, hi = lane >> 5;
    const int hq = wid >> 1, th = wid & 1, h = 4 * g + hq, tok0 = b * SEQ + 64 * qb + 32 * th, NT = qb + 1;
    LAS char* V_lds = lds + LDS_V; LAS char* K_lds = lds + LDS_K; LAS float* wsf = (LAS float*)(lds + LDS_WS) + wid * 64; LAS float* li_l = wsf; LAS float* al_l = wsf + 32;
    const int sr = tid >> 4, sc = (tid & 15) * 8, vst0 = v_st(sr, sc), vst1 = v_st(32 + sr, sc), kws = KSWZ(sr, sc * 2);
    const int vb0 = (int)(uintptr_t)V_lds + v_rd_base(lane);
    bf16x8 qr[8];
    {
      u32x4 qw[8]; float ss = 0.f;
#pragma unroll
      for (int d0 = 0; d0 < 8; ++d0) { qw[d0] = *(const u32x4*)(Q + (size_t)(tok0 + r32) * AW + h * HD + d0 * 16 + hi * 8);
#pragma unroll
          for (int j = 0; j < 4; ++j) { const float lo = bflo(qw[d0][j]), hv = bfhi(qw[d0][j]); ss += lo * lo + hv * hv; } }
      { auto rr = __builtin_amdgcn_permlane32_swap(__float_as_uint(ss), __float_as_uint(ss), false, false); ss = __uint_as_float(rr[0]) + __uint_as_float(rr[1]); }
      const float rq = rsqrtf(ss * (1.0f / HD) + NORM_EPS) * 0.08838834764831845f;
#pragma unroll
      for (int d0 = 0; d0 < 8; ++d0) { const f32x4 g0 = *(const f32x4*)(qgain + d0 * 16 + hi * 8), g1 = *(const f32x4*)(qgain + d0 * 16 + hi * 8 + 4); u32x4 o;
          o[0] = cvt_pk_bf16(bflo(qw[d0][0]) * rq * g0[0], bfhi(qw[d0][0]) * rq * g0[1]); o[1] = cvt_pk_bf16(bflo(qw[d0][1]) * rq * g0[2], bfhi(qw[d0][1]) * rq * g0[3]);
          o[2] = cvt_pk_bf16(bflo(qw[d0][2]) * rq * g1[0], bfhi(qw[d0][2]) * rq * g1[1]); o[3] = cvt_pk_bf16(bflo(qw[d0][3]) * rq * g1[2], bfhi(qw[d0][3]) * rq * g1[3]);
          qr[d0] = __builtin_bit_cast(bf16x8, o); } }
    const unsigned sb = __float_as_uint(__builtin_ldexpf(1.0f, -(h + 1))) >> 16;
    const u32x4 qfw = {hi ? 0u : (sb | (sb << 16)), 0u, 0u, 0u}; const bf16x8 qf = __builtin_bit_cast(bf16x8, qfw);
    const bf16_t* Kg = K + (size_t)(b * SEQ) * KVW + g * HD + sc; const bf16_t* Vg = V + (size_t)(b * SEQ) * KVW + g * HD + sc;
    const unsigned long long* mrow = MT + (size_t)__builtin_amdgcn_readfirstlane(tok0 >> 5) * 64 * 32;
    float m_reg = -1e30f, l_reg = 0.f; f32x16 o[4] = {};
    bf16x8 st_k0, st_k1, st_v0, st_v1;
#define SLOAD(k0) do { st_k0 = *(const bf16x8*)(Kg + (size_t)((k0) + sr) * KVW); st_k1 = *(const bf16x8*)(Kg + (size_t)((k0) + 32 + sr) * KVW); \
                       st_v0 = *(const bf16x8*)(Vg + (size_t)((k0) + sr) * KVW); st_v1 = *(const bf16x8*)(Vg + (size_t)((k0) + 32 + sr) * KVW); } while (0)
#define SWRITE(bf) do { *(LAS bf16x8*)(K_lds + (bf) * SHM_K + kws) = st_k0; *(LAS bf16x8*)(K_lds + (bf) * SHM_K + kws + 32 * 256) = st_k1; \
                        *(LAS bf16x8*)(V_lds + (bf) * SHM_V + vst0) = st_v0; *(LAS bf16x8*)(V_lds + (bf) * SHM_V + vst1) = st_v1; } while (0)
#define TK(u_) (NT - 1 - (u_))
    SLOAD(TK(0) * KVBLK); SWRITE(0);
    __syncthreads();
    bool signaled = false;
    for (int t = 0; t < NT; t += 2) {
        if (done_ctr && !signaled && t + 8 >= NT) { signaled = true; if (wid == 0 && lane == 0) __hip_atomic_fetch_add(done_ctr, 1u, __ATOMIC_RELAXED, __HIP_MEMORY_SCOPE_AGENT); }
        if (t + 1 < NT) SLOAD(TK(t + 1) * KVBLK);
        tile_step<0>(o, m_reg, l_reg, K_lds, vb0, al_l, r32, hi, qr, TK(t) * KVBLK, qf, mrow + (size_t)TK(t) * 32);
        if (t + 1 < NT) SWRITE(1);
        __syncthreads();
        if (t + 1 < NT) {
            if (t + 2 < NT) SLOAD(TK(t + 2) * KVBLK);
            tile_step<1>(o, m_reg, l_reg, K_lds, vb0, al_l, r32, hi, qr, TK(t + 1) * KVBLK, qf, mrow + (size_t)TK(t + 1) * 32);
            if (t + 2 < NT) SWRITE(0);
            __syncthreads();
        }
    }
#undef TK
#undef SLOAD
#undef SWRITE
    if (hi == 0) li_l[r32] = l_reg; asm volatile("s_waitcnt lgkmcnt(0)" ::: "memory");
    unsigned char* Ow = O + (size_t)tok0 * AW + h * HD;
#pragma unroll
    for (int r = 0; r < 16; ++r) { const int orow = crow(r, hi); const float rl = __builtin_amdgcn_rcpf(li_l[orow]) * (FP8_MERGE ? A8_SCALE : 1.0f);
#pragma unroll
        for (int d0 = 0; d0 < 4; ++d0) { const float v = o[d0][r] * rl; const float v1 = __shfl_xor(v, 1);
            if constexpr (FP8_MERGE) { const float v2 = __shfl_xor(v, 2), v3 = __shfl_xor(v1, 2);
                if ((r32 & 3) == 0) *(unsigned*)(Ow + (size_t)orow * AW + d0 * 32 + r32) = pk4_fp8(v, v1, v2, v3); }
            else { if ((r32 & 1) == 0) *(unsigned*)((bf16_t*)O + (size_t)(tok0 + orow) * AW + h * HD + d0 * 32 + r32) = cvt_pk_bf16(v, v1); } } }
    __syncthreads();
}
#undef KSWZ
#undef SBAR
}
struct SchedPool {
    const char* A; const char* B; int c;
    __device__ __forceinline__ bool next(int i, pg8::Unit& u) const { if (i > 0 || c >= 128) return false; const int rt = c >> 2, g = c & 3; u.pm = rt; u.pn = g; u.aux = 0; u.tok = nullptr; u.nt8 = 0;
        u.A = A + ((size_t)rt * 256 * PW + g * 256) * 2; u.B = B + (size_t)g * 65536 * 2; return true; }
};
struct EpiPool {
    unsigned char* out; const float* pscale;
    __device__ __forceinline__ bool operator()(f32x4 (&acc)[2][2][4][2], const pg8::Unit& u, int wr, int wc, int fr, int fq) const {
        const int row0 = u.pm * 256 + wr * 64 + fr, col0 = u.pn * 256 + wc * 32 + 8 * fq;
#pragma unroll
        for (int bj = 0; bj < 2; ++bj) { const f32x4 s0 = *(const f32x4*)(pscale + col0 + bj * 128), s1 = *(const f32x4*)(pscale + col0 + bj * 128 + 4);
#pragma unroll
            for (int ai = 0; ai < 2; ++ai)
#pragma unroll
                for (int m = 0; m < 4; ++m) { const size_t o = (size_t)(row0 + ai * 128 + m * 16) * PW + col0 + bj * 128;
                    if constexpr (FP8_MERGE) { const f32x4 v0 = acc[ai][bj][m][0] * s0 * A8_SCALE, v1 = acc[ai][bj][m][1] * s1 * A8_SCALE; u32x2 w; w.x = pk4_fp8(v0[0], v0[1], v0[2], v0[3]); w.y = pk4_fp8(v1[0], v1[1], v1[2], v1[3]); *(u32x2*)(out + o) = w; }
                    else st_bf16x8((bf16_t*)out + o, acc[ai][bj][m][0] * s0, acc[ai][bj][m][1] * s1); } }
        return false;
    }
};
__device__ __forceinline__ void p4_pool_attn(Frame& F, const Args& a) {
    for (int c = blockIdx.x; c < 256; c += F.G) {
        const int bg = c >> 6, qb = c & 63;
        att::attn_unit(F, a.in[I_QNORM], bg >> 1, bg & 1, qb, (c + F.G >= 256) ? F.ctl + CW_DONE + 64 * 4 : nullptr);
        if (qb < 32) { const int pu = bg * 32 + qb, rt = pu >> 2, g = pu & 3;
            pooled_item(F, rt * 256 + 32 * F.wave, g, lane_id());
            asm volatile("s_waitcnt vmcnt(0)" ::: "memory"); __syncthreads();
            SchedPool S{(const char*)(F.ws + WS_POOLED), (const char*)(F.ws + WS_PLIN), pu}; EpiPool E{F.ws + WS_POOL, a.in[I_PSCALE]};
            pg8::gemm_phase<EpiPool, SchedPool, false>(F.lds, F.wave, 256 * 2, PW * 2, S, E); __syncthreads(); }
    }
}
struct SchedMerge {
    pg8::TileOrder T; const char* A0; const char* B0; const char* A1; const char* B1;
    __device__ __forceinline__ bool next(int i, pg8::Unit& u) const { int pm, pn; if (!T.tile(i >> 1, pm, pn)) return false; u.pm = pm; u.pn = pn; u.aux = i & 1; u.tok = nullptr; u.nt8 = 0;
        u.A = ((i & 1) ? A1 : A0) + (size_t)pm * 256 * 1024 * (FP8_MERGE ? 1 : 2); u.B = ((i & 1) ? B1 : B0) + (size_t)pn * 256 * 1024 * (FP8_MERGE ? 1 : 2); return true; }
};
struct EpiMerge {
    const bf16_t* G; unsigned char* out;
    __device__ __forceinline__ bool operator()(f32x4 (&acc)[2][2][4][2], const pg8::Unit& u, int wr, int wc, int fr, int fq) const {
        const int row0 = u.pm * 256 + wr * 64 + fr, col0 = u.pn * 256 + wc * 32 + 8 * fq;
#pragma unroll
        for (int ai = 0; ai < 2; ++ai)
#pragma unroll
            for (int m = 0; m < 4; ++m) { const size_t r = (size_t)(row0 + ai * 128 + m * 16);
#pragma unroll
                for (int bj = 0; bj < 2; ++bj) { const int c = col0 + bj * 128;
                    const u32x4 gp = *(const u32x4*)(G + r * (2 * DM) + DM + c);
                    const f32x4 p0 = {bflo(gp[0]), bfhi(gp[0]), bflo(gp[1]), bfhi(gp[1])}, p1 = {bflo(gp[2]), bfhi(gp[2]), bflo(gp[3]), bfhi(gp[3])};
                    if (u.aux == 0) { const u32x4 ga = *(const u32x4*)(G + r * (2 * DM) + c);
                        const f32x4 a0 = {bflo(ga[0]), bfhi(ga[0]), bflo(ga[1]), bfhi(ga[1])}, a1 = {bflo(ga[2]), bfhi(ga[2]), bflo(ga[3]), bfhi(ga[3])};
#pragma unroll
                        for (int j = 0; j < 4; ++j) { acc[ai][bj][m][0][j] *= a0[j] * __builtin_amdgcn_rcpf(fmaxf(p0[j], 1e-30f)); acc[ai][bj][m][1][j] *= a1[j] * __builtin_amdgcn_rcpf(fmaxf(p1[j], 1e-30f)); } }
                    else { if constexpr (FP8_OUT) { const f32x4 v0 = acc[ai][bj][m][0] * p0 * A8_SCALE, v1 = acc[ai][bj][m][1] * p1 * A8_SCALE; u32x2 w; w.x = pk4_fp8(v0[0], v0[1], v0[2], v0[3]); w.y = pk4_fp8(v1[0], v1[1], v1[2], v1[3]);
                        *(u32x2*)(out + r * DM + c) = w; } else st_bf16x8((bf16_t*)out + r * DM + c, acc[ai][bj][m][0] * p0, acc[ai][bj][m][1] * p1); } } }
        return u.aux == 0;
    }
};
__device__ __forceinline__ void p5_merge(Frame& F) {
    SchedMerge S; S.T.init(NTOK, DM, F.G, (int)blockIdx.x); S.A0 = (const char*)(F.ws + WS_ATTN); S.B0 = (const char*)(F.ws + WS_WAU); S.A1 = (const char*)(F.ws + WS_POOL); S.B1 = (const char*)(F.ws + WS_WPU);
    EpiMerge E{(const bf16_t*)(F.ws + WS_G), F.ws + WS_MERGED};
    constexpr int ES = FP8_MERGE ? 1 : 2;
    pg8::gemm_phase<EpiMerge, SchedMerge, false, ES, FP8_MERGE ? A8_E8 : 127, FP8_MERGE ? W8_E8 : 127>(F.lds, F.wave, 1024 * ES, 1024 * ES, S, E);
}
struct EpiOut {
    const float* x; const float* mod; float* out;
    __device__ __forceinline__ bool operator()(f32x4 (&acc)[2][2][4][2], const pg8::Unit& u, int wr, int wc, int fr, int fq) const {
        const int row0 = u.pm * 256 + wr * 64 + fr, col0 = u.pn * 256 + wc * 32 + 8 * fq; const int b = (u.pm * 256) / SEQ;
        const float* gm = mod + b * 6 * DM + 2 * DM;
#pragma unroll
        for (int bj = 0; bj < 2; ++bj) { const int c = col0 + bj * 128; const f32x4 g0 = *(const f32x4*)(gm + c), g1 = *(const f32x4*)(gm + c + 4);
#pragma unroll
            for (int ai = 0; ai < 2; ++ai)
#pragma unroll
                for (int m = 0; m < 4; ++m) { const size_t o = (size_t)(row0 + ai * 128 + m * 16) * DM + c;
                    const f32x4 x0 = *(const f32x4*)(x + o), x1 = *(const f32x4*)(x + o + 4);
                    *(f32x4*)(out + o) = x0 + g0 * acc[ai][bj][m][0]; *(f32x4*)(out + o + 4) = x1 + g1 * acc[ai][bj][m][1]; } }
        return false;
    }
};
__device__ __forceinline__ void p6_out(Frame& F, const Args& a) {
    SchedDense S; S.T.init(NTOK, DM, F.G, (int)blockIdx.x); S.A = (const char*)(F.ws + WS_MERGED); S.B = (const char*)(F.ws + WS_WOUT);
    constexpr int ES = FP8_OUT ? 1 : 2; S.a_tile = (size_t)256 * DM * ES; S.b_tile = (size_t)256 * DM * ES;
    EpiOut E{a.in[I_X], (const float*)(F.ctl + CW_MOD), F.out};
    pg8::gemm_phase<EpiOut, SchedDense, false, ES, FP8_OUT ? A8_E8 : 127, FP8_OUT ? W8_E8 : 127>(F.lds, F.wave, DM * ES, DM * ES, S, E);
}
constexpr int P7_ROWB = 4096 + 16;
constexpr int P7_ROWS = 32, P7_RW = P7_ROWS / NWAVES;
constexpr int P7_LDS_P = P7_ROWS * P7_ROWB;
constexpr int P7_LDS_H = P7_LDS_P + 2 * P7_ROWS * 64 * 4;
__device__ __forceinline__ void p7_router(Frame& F, const Args& a) {
    const float* mod = (const float*)(F.ctl + CW_MOD);
    unsigned char* hb8 = F.ws + WS_HB; const bf16_t* Wr = (const bf16_t*)(F.ws + WS_WR);
    unsigned char* rt = F.ws + WS_ROUTE;
    int* eid = (int*)(rt + RT_EID); float* gate = (float*)(rt + RT_GATE); int* posn = (int*)(rt + RT_POS); int* list = (int*)(rt + RT_LIST); int* ident = (int*)(rt + RT_IDENT);
    unsigned* ecnt = F.ctl + CW_ECNT;
    LAS unsigned char* lds = F.lds; LAS float* P = (LAS float*)(lds + P7_LDS_P); LAS unsigned* hist = (LAS unsigned*)(lds + P7_LDS_H); LAS unsigned* baseL = hist + 64;
    const int lane = lane_id(), w = F.wave, tid = w * 64 + lane;
    if (tid < 64) hist[tid] = 0u;
    __syncthreads();
    for (int p = blockIdx.x; p < NTOK / P7_ROWS; p += F.G) {
        const int row0 = P7_ROWS * p;
#pragma unroll
        for (int rr = 0; rr < P7_RW; ++rr) { const int lr = P7_RW * w + rr, m = row0 + lr, b = m / SEQ;
            const float* xrow = F.out + (size_t)m * DM; const float* sh = mod + b * 6 * DM + 3 * DM; const float* sl = mod + b * 6 * DM + 4 * DM;
            f32x4 v[8]; float ss = 0.f;
#pragma unroll
            for (int j = 0; j < 8; ++j) { v[j] = *(const f32x4*)(xrow + 4 * lane + 256 * j); ss += (v[j].x * v[j].x + v[j].y * v[j].y) + (v[j].z * v[j].z + v[j].w * v[j].w); }
            const float rstd = rsqrtf(wave_sum(ss) * (1.0f / DM) + NORM_EPS);
#pragma unroll
            for (int j = 0; j < 8; ++j) { const int c = 4 * lane + 256 * j;
                const f32x4 gg = *(const f32x4*)(a.in[I_GFFN] + c), shv = *(const f32x4*)(sh + c), slv = *(const f32x4*)(sl + c);
                const f32x4 o = v[j] * rstd * gg * (slv + 1.0f) + shv;
                u32x2 wv; wv.x = cvt_pk_bf16(o.x, o.y); wv.y = cvt_pk_bf16(o.z, o.w);
                *(unsigned*)(hb8 + (size_t)m * DM + c) = pk4_fp8(o.x * H8_SCALE, o.y * H8_SCALE, o.z * H8_SCALE, o.w * H8_SCALE); *(LAS u32x2*)(lds + lr * P7_ROWB + c * 2) = wv; }
            if (lane == 0) ident[m] = m;
        }
        __syncthreads();
        { const int nb = w & 3, kh = w >> 2, fr = lane & 15, kq = lane >> 4;
          f32x4 acc[2] = {{0.f, 0.f, 0.f, 0.f}, {0.f, 0.f, 0.f, 0.f}};
          const bf16_t* wp = Wr + (size_t)(16 * nb + fr) * DM + 1024 * kh + 8 * kq;
          const LAS unsigned char* ap = lds + fr * P7_ROWB + (1024 * kh + 8 * kq) * 2;
#pragma unroll 8
          for (int s = 0; s < 32; ++s) { const bf16x8 bv = *(const bf16x8*)(wp + 32 * s);
#pragma unroll
              for (int mb = 0; mb < 2; ++mb) { const bf16x8 av = *(const LAS bf16x8*)(ap + mb * 16 * P7_ROWB + 64 * s); acc[mb] = __builtin_amdgcn_mfma_f32_16x16x32_bf16(av, bv, acc[mb], 0, 0, 0); } }
#pragma unroll
          for (int mb = 0; mb < 2; ++mb)
#pragma unroll
              for (int j = 0; j < 4; ++j) P[(kh * P7_ROWS + 16 * mb + 4 * kq + j) * 64 + 16 * nb + fr] = acc[mb][j];
        }
        __syncthreads();
        int myrank[P7_RW]; unsigned mylocal[P7_RW]; bool chosen[P7_RW]; float mygate[P7_RW];
#pragma unroll
        for (int rr = 0; rr < P7_RW; ++rr) { const int lr = P7_RW * w + rr;
            const float logit = P[lr * 64 + lane] + P[(P7_ROWS + lr) * 64 + lane];
            const float score = 1.0f / (1.0f + __expf(-logit)); const float sel = score + a.in[I_RBIAS][lane];
            float m1 = sel; m1 = fmaxf(m1, __shfl_xor(m1, 1)); m1 = fmaxf(m1, __shfl_xor(m1, 2)); m1 = fmaxf(m1, __shfl_xor(m1, 4));
            const unsigned long long bm = __ballot(sel == m1); const unsigned grp = (unsigned)((bm >> (lane & ~7)) & 0xffull); const int first = __builtin_ctz(grp | 0x100u);
            float m2 = ((lane & 7) == first) ? -__builtin_inff() : sel; m2 = fmaxf(m2, __shfl_xor(m2, 1)); m2 = fmaxf(m2, __shfl_xor(m2, 2)); m2 = fmaxf(m2, __shfl_xor(m2, 4));
            const float gs = m1 + m2; const int g = lane >> 3; int grank = 0;
#pragma unroll
            for (int g2 = 0; g2 < 8; ++g2) { const float o = __uint_as_float(__builtin_amdgcn_readlane(__float_as_uint(gs), 8 * g2)); grank += (o > gs || (o == gs && g2 < g)) ? 1 : 0; }
            const float selm = grank < TOPG ? sel : -__builtin_inff(); int rank = 0;
#pragma unroll
            for (int e2 = 0; e2 < 64; ++e2) { const float o = __uint_as_float(__builtin_amdgcn_readlane(__float_as_uint(selm), e2)); rank += (o > selm || (o == selm && e2 < lane)) ? 1 : 0; }
            const bool ch = rank < ETOP && grank < TOPG; const float gsum = wave_sum(ch ? score : 0.f);
            chosen[rr] = ch; myrank[rr] = rank; mygate[rr] = score / gsum * ROUTED_SCALE;
            mylocal[rr] = ch ? __hip_atomic_fetch_add(hist + lane, 1u, __ATOMIC_RELAXED, __HIP_MEMORY_SCOPE_WORKGROUP) : 0u;
        }
        __syncthreads();
        if (w == 0) { const unsigned c = hist[lane]; baseL[lane] = c ? __hip_atomic_fetch_add(ecnt + lane, c, __ATOMIC_RELAXED, __HIP_MEMORY_SCOPE_AGENT) : 0u; hist[lane] = 0u; }
        __syncthreads();
#pragma unroll
        for (int rr = 0; rr < P7_RW; ++rr) if (chosen[rr]) { const int m = row0 + P7_RW * w + rr; const unsigned pos = baseL[lane] + mylocal[rr];
            eid[m * 8 + myrank[rr]] = lane; gate[m * 8 + myrank[rr]] = mygate[rr]; posn[m * 8 + myrank[rr]] = (int)pos; list[(size_t)lane * NTOK + pos] = m; }
        __syncthreads();
    }
}
constexpr int MOE_LDS = 131072;
__device__ __forceinline__ int moe_prefix(Frame& F) {
    LAS int* rtoff = (LAS int*)(F.lds + MOE_LDS);
    if (F.wave == 0 && lane_id() == 0) { int s = 0; for (int e = 0; e < NE; ++e) { rtoff[e] = s; unsigned n = F.ctl[CW_ECNT + e]; if (n > (unsigned)NTOK) n = NTOK; s += (int)((n + 255u) >> 8); } rtoff[NE] = s; }
    __syncthreads();
    return __builtin_amdgcn_readfirstlane(rtoff[NE]);
}
__device__ __forceinline__ int moe_find(const LAS int* rtoff, int rtg) {
    int lo = 0, hi = NE;
#pragma unroll
    for (int it = 0; it < 6; ++it) { const int mid = (lo + hi) >> 1; const int v = __builtin_amdgcn_readfirstlane(rtoff[mid]); if (v <= rtg) lo = mid; else hi = mid; }
    return lo;
}
struct SchedMoe1 {
    const LAS int* rtoff; int RT, G, c; const char* hb; const char* w13; const char* ws13; const int* list; const int* ident;
    __device__ __forceinline__ bool next(int i, pg8::Unit& u) const {
        const int idx = i * G + c; if (idx >= (RT + NTOK / 256) * 4) return false;
        const int rtg = idx >> 2, ct = idx & 3; u.pn = ct; u.aux = 0; u.nt8 = 0; u.A = hb;
        if (rtg < RT) { const int e = moe_find(rtoff, rtg), rt = rtg - __builtin_amdgcn_readfirstlane(rtoff[e]); u.pm = rtg; u.tok = list + (size_t)e * NTOK + rt * 256;
            u.B = w13 + ((size_t)e * 1024 + ct * 256) * DM; }
        else { const int rt = rtg - RT; u.pm = HROWS_R / 256 + rt; u.tok = ident + rt * 256; u.B = ws13 + (size_t)(ct * 256) * DM; }
        return true; }
};
struct EpiMoe1 {
    unsigned char* H;
    __device__ __forceinline__ bool operator()(f32x4 (&acc)[2][2][4][2], const pg8::Unit& u, int wr, int wc, int fr, int fq) const {
        const int row0 = u.pm * 256 + wr * 64 + fr, col0 = u.pn * 128 + wc * 32 + 8 * fq;
#pragma unroll
        for (int ai = 0; ai < 2; ++ai)
#pragma unroll
            for (int m = 0; m < 4; ++m) { f32x4 h0, h1;
#pragma unroll
                for (int j = 0; j < 4; ++j) { const float g0 = acc[ai][0][m][0][j], g1 = acc[ai][0][m][1][j];
                    h0[j] = g0 * __builtin_amdgcn_rcpf(1.0f + __expf(-g0)) * acc[ai][1][m][0][j]; h1[j] = g1 * __builtin_amdgcn_rcpf(1.0f + __expf(-g1)) * acc[ai][1][m][1][j]; }
                u32x2 w; w.x = pk4_fp8(h0[0] * H8_SCALE, h0[1] * H8_SCALE, h0[2] * H8_SCALE, h0[3] * H8_SCALE); w.y = pk4_fp8(h1[0] * H8_SCALE, h1[1] * H8_SCALE, h1[2] * H8_SCALE, h1[3] * H8_SCALE);
                *(u32x2*)(H + (size_t)(row0 + ai * 128 + m * 16) * EH + col0) = w; }
        return false;
    }
};
__device__ __forceinline__ void p8_gemm1(Frame& F, const Args& a) {
    const int RT = moe_prefix(F);
    const int U = (RT + NTOK / 256) * 4, R0 = (U + F.G - 1) / F.G, R = (R0 * F.G - U < 24 * R0) ? R0 + 1 : R0, NG = (U + R - 1) / R;
    if ((int)blockIdx.x >= NG) { conv_drain<false, 1, 2>(F, a, 8); return; }
    SchedMoe1 S{(const LAS int*)(F.lds + MOE_LDS), RT, NG, (int)blockIdx.x, (const char*)(F.ws + WS_HB), (const char*)(F.ws + WS_W13), (const char*)(F.ws + WS_WS13),
                (const int*)(F.ws + WS_ROUTE + RT_LIST), (const int*)(F.ws + WS_ROUTE + RT_IDENT)};
    EpiMoe1 E{F.ws + WS_H};
    pg8::gemm_phase<EpiMoe1, SchedMoe1, true, 1, H8_E8, W8_E8>(F.lds, F.wave, DM, DM, S, E);
    conv_drain<false, 1, 2>(F, a, 8);
}
struct SchedMoe2 {
    const LAS int* rtoff; int RT, G, c; const char* H; const char* w2; const char* ws2;
    __device__ __forceinline__ bool next(int i, pg8::Unit& u) const {
        const int idx = i * G + c; if (idx >= (RT + NTOK / 256) * 8) return false;
        const int rtg = idx >> 3, ct = idx & 7; u.pn = ct; u.aux = 0; u.tok = nullptr; u.nt8 = 0;
        if (rtg < RT) { const int e = moe_find(rtoff, rtg); u.pm = rtg; u.B = w2 + ((size_t)e * DM + ct * 256) * EH; }
        else { u.pm = HROWS_R / 256 + (rtg - RT); u.B = ws2 + (size_t)(ct * 256) * EH; }
        u.A = H + (size_t)u.pm * 256 * EH; return true; }
};
constexpr float Y8_SCALE = 8.f;
struct EpiY {
    unsigned char* Y;
    __device__ __forceinline__ bool operator()(f32x4 (&acc)[2][2][4][2], const pg8::Unit& u, int wr, int wc, int fr, int fq) const {
        const int row0 = u.pm * 256 + wr * 64 + fr, col0 = u.pn * 256 + wc * 32 + 8 * fq;
#pragma unroll
        for (int ai = 0; ai < 2; ++ai)
#pragma unroll
            for (int m = 0; m < 4; ++m)
#pragma unroll
                for (int bj = 0; bj < 2; ++bj) { const f32x4 v0 = acc[ai][bj][m][0] * Y8_SCALE, v1 = acc[ai][bj][m][1] * Y8_SCALE; u32x2 w; w.x = pk4_fp8(v0[0], v0[1], v0[2], v0[3]); w.y = pk4_fp8(v1[0], v1[1], v1[2], v1[3]);
                    *(u32x2*)(Y + (size_t)(row0 + ai * 128 + m * 16) * DM + col0 + bj * 128) = w; }
        return false;
    }
};
__device__ __forceinline__ void p9_gemm2(Frame& F) {
    const int RT = moe_prefix(F);
    SchedMoe2 S{(const LAS int*)(F.lds + MOE_LDS), RT, F.G, (int)blockIdx.x, (const char*)(F.ws + WS_H), (const char*)(F.ws + WS_W2), (const char*)(F.ws + WS_WS2)};
    EpiY E{F.ws + WS_Y};
    pg8::gemm_phase<EpiY, SchedMoe2, false, 1, H8_E8, W8_E8>(F.lds, F.wave, EH, EH, S, E);
}
__device__ __forceinline__ void fp8x16_fma(f32x4 (&s)[4], const u32x4 y, float g) {
#pragma unroll
    for (int t = 0; t < 4; ++t) { const f32x2 lo = __builtin_amdgcn_cvt_pk_f32_fp8((int)y[t], false), hi = __builtin_amdgcn_cvt_pk_f32_fp8((int)y[t], true);
        s[t][0] += lo[0] * g; s[t][1] += lo[1] * g; s[t][2] += hi[0] * g; s[t][3] += hi[1] * g; }
}
__device__ __forceinline__ void p10_combine(Frame& F) {
    (void)moe_prefix(F);
    const LAS int* rtoff = (const LAS int*)(F.lds + MOE_LDS);
    const unsigned char* Y = F.ws + WS_Y; unsigned char* rt = F.ws + WS_ROUTE;
    const int* eid = (const int*)(rt + RT_EID); const float* gate = (const float*)(rt + RT_GATE); const int* posn = (const int*)(rt + RT_POS); const float* mod = (const float*)(F.ctl + CW_MOD);
    const int lane = lane_id();
    size_t yr[9]; float g[9]; u32x4 yv[9][2];
#define P10_ROUTE(t_) do { const u32x4 e0 = *(const u32x4*)(eid + (t_) * 8), e1 = *(const u32x4*)(eid + (t_) * 8 + 4), p0 = *(const u32x4*)(posn + (t_) * 8), p1 = *(const u32x4*)(posn + (t_) * 8 + 4); \
        const f32x4 g0 = *(const f32x4*)(gate + (t_) * 8), g1 = *(const f32x4*)(gate + (t_) * 8 + 4); \
        _Pragma("unroll") for (int k = 0; k < 8; ++k) { const int e = __builtin_amdgcn_readfirstlane((int)(k < 4 ? e0[k & 3] : e1[k & 3])) & 63, p = __builtin_amdgcn_readfirstlane((int)(k < 4 ? p0[k & 3] : p1[k & 3])); \
            yr[k] = (size_t)(256 * __builtin_amdgcn_readfirstlane(rtoff[e]) + p) * DM; g[k] = __uint_as_float(__builtin_amdgcn_readfirstlane(__float_as_uint(k < 4 ? g0[k & 3] : g1[k & 3]))); } \
        yr[8] = (size_t)(HROWS_R + (t_)) * DM; g[8] = 1.0f; } while (0)
#define P10_YLOAD() do { _Pragma("unroll") for (int k = 0; k < 9; ++k) { yv[k][0] = __builtin_nontemporal_load((const u32x4*)(Y + yr[k] + 32 * lane)); yv[k][1] = __builtin_nontemporal_load((const u32x4*)(Y + yr[k] + 32 * lane + 16)); } } while (0)
    int t = F.gw;
    if (t < NTOK) { P10_ROUTE(t); P10_YLOAD(); }
    for (; t < NTOK; t += F.NGW) {
        const int b = t / SEQ; const float* gf = mod + b * 6 * DM + 5 * DM + 32 * lane;
        float* orow = F.out + (size_t)t * DM + 32 * lane;
        f32x4 xv[8];
#pragma unroll
        for (int j = 0; j < 8; ++j) xv[j] = *(const f32x4*)(orow + 4 * j);
        f32x4 s[8];
#pragma unroll
        for (int j = 0; j < 8; ++j) s[j] = (f32x4){0.f, 0.f, 0.f, 0.f};
#pragma unroll
        for (int k = 0; k < 9; ++k) { f32x4 (&s0)[4] = *(f32x4 (*)[4])&s[0]; f32x4 (&s1)[4] = *(f32x4 (*)[4])&s[4]; fp8x16_fma(s0, yv[k][0], g[k]); fp8x16_fma(s1, yv[k][1], g[k]); }
        const int tn = t + F.NGW;
        if (tn < NTOK) { P10_ROUTE(tn); P10_YLOAD(); }
#pragma unroll
        for (int j = 0; j < 8; ++j) *(f32x4*)(orow + 4 * j) = xv[j] + *(const f32x4*)(gf + 4 * j) * s[j] * (1.0f / Y8_SCALE);
    }
#undef P10_ROUTE
#undef P10_YLOAD
}
constexpr int LDS_BYTES = 155648;
constexpr int N_PHASES = 11;
#ifndef PROBE_REP
#define PROBE_REP -1
#endif
#define REP(k, stmt) do { stmt; if (PROBE_REP == (k)) { __syncthreads(); stmt; } } while (0)
__global__ void __launch_bounds__(NTHR, 2) fwd(Args args) {
    extern __shared__ __attribute__((aligned(16))) unsigned char lds_raw[];
    Frame F; F.lds = (LAS unsigned char*)lds_raw; F.wave = __builtin_amdgcn_readfirstlane((int)threadIdx.x >> 6);
    F.G = gridDim.x; F.gw = blockIdx.x * NWAVES + F.wave; F.NGW = F.G * NWAVES; F.ws = args.ws; F.ctl = (unsigned*)(args.ws + WS_CTL); F.out = args.out;
    volatile LAS unsigned* xbw = (volatile LAS unsigned*)(F.lds + LDS_BYTES - 16);
    if (threadIdx.x < 4) xbw[threadIdx.x] = 0u;
    __syncthreads();
    const bool one = (args.ph_hi - args.ph_lo) > 1;
    XcdBarrier bar; bar.bar = F.ctl + CW_BAR; bar.x = 0; bar.st = xbw;
    if (one) bar = xcd_barrier_post(F.ctl + CW_BAR, xbw, F.wave);
    const int lo = args.ph_lo, hi = args.ph_hi;
#ifndef PROBE_TIME
#define PROBE_TIME -1
#endif
    unsigned long long pt0 = 0ull, pt1 = 0ull;
#define TSTAMP(k, which) do { if (PROBE_TIME == (k) && blockIdx.x == 0) { if (which) pt1 = __builtin_amdgcn_s_memrealtime(); else pt0 = __builtin_amdgcn_s_memrealtime(); } } while (0)
#define IN(k) (lo <= (k) && (k) < hi)
#define SEAM(k) do { if (IN(k) && IN((k) + 1)) xcd_barrier(bar, F.wave); } while (0)
    TSTAMP(0, 0); if (IN(0)) { REP(0, p0_prologue(F, args)); } SEAM(0); TSTAMP(0, 1);
    TSTAMP(1, 0); if (IN(1)) { REP(1, p1_h(F, args)); } SEAM(1); TSTAMP(1, 1);
    TSTAMP(2, 0); if (IN(2)) { REP(2, p2_inproj(F, args)); } SEAM(2); TSTAMP(2, 1);
    TSTAMP(3, 0); if (IN(3)) { p3_qknorm(F, args); __syncthreads(); REP(3, p3_indexer(F, args)); } SEAM(3); TSTAMP(3, 1);
    TSTAMP(4, 0); if (IN(4)) { REP(4, p4_pool_attn(F, args)); if (one) { conv_drain<true, 0, 2>(F, args, 4); } } SEAM(4); TSTAMP(4, 1);
    TSTAMP(5, 0); if (IN(5)) { REP(5, p5_merge(F)); } SEAM(5); TSTAMP(5, 1);
    TSTAMP(6, 0); if (IN(6)) { REP(6, p6_out(F, args)); } SEAM(6); TSTAMP(6, 1);
    TSTAMP(7, 0); if (IN(7)) { p7_router(F, args); conv_drain<false, 0, 1>(F, args, 7); }
    SEAM(7); TSTAMP(7, 1);
    TSTAMP(8, 0); if (IN(8)) { REP(8, p8_gemm1(F, args)); } SEAM(8); TSTAMP(8, 1);
    TSTAMP(9, 0); if (IN(9)) { REP(9, p9_gemm2(F)); } SEAM(9); TSTAMP(9, 1);
    TSTAMP(10, 0); if (IN(10)) { p10_combine(F); } TSTAMP(10, 1);
    if (PROBE_TIME >= 0 && blockIdx.x == 0) { const unsigned long long tend = __builtin_amdgcn_s_memrealtime() + 4ull * (pt1 - pt0); while (__builtin_amdgcn_s_memrealtime() < tend) __builtin_amdgcn_s_sleep(8); }
#undef IN
#undef SEAM
}
#ifndef N_LAUNCHES
#define N_LAUNCHES 1
#endif
extern "C" void kernel_launch(void* const* d_in, const int* in_sizes, int n_in, void* d_out, int out_size, void* d_ws, size_t ws_size, hipStream_t stream) {
    static int grid = 0;
    if (grid == 0) {
        if (n_in != 22 || out_size != NTOK * DM || ws_size < WS_END) { fprintf(stderr, "kernel_launch: unexpected shapes (n_in %d out %d ws %zu need %zu)\n", n_in, out_size, ws_size, (size_t)WS_END); grid = -1; return; }
        int dev = 0, cus = 0, per_cu = 0;
        if (hipGetDevice(&dev) != hipSuccess || hipDeviceGetAttribute(&cus, hipDeviceAttributeMultiprocessorCount, dev) != hipSuccess) { grid = -1; return; }
        if (hipFuncSetAttribute((const void*)fwd, hipFuncAttributeMaxDynamicSharedMemorySize, LDS_BYTES) != hipSuccess) { fprintf(stderr, "kernel_launch: hipFuncSetAttribute failed\n"); grid = -1; return; }
        if (hipOccupancyMaxActiveBlocksPerMultiprocessor(&per_cu, (const void*)fwd, NTHR, LDS_BYTES) != hipSuccess || per_cu < 1) fprintf(stderr, "kernel_launch: occupancy query says %d\n", per_cu);
        (void)hipGetLastError();
        grid = cus;
    }
    if (grid < 0) return;
    (void)hipMemsetAsync((char*)d_ws + WS_CTL, 0, CTL_BYTES, stream);
    Args a{};
    for (int i = 0; i < 22; ++i) a.in[i] = (const float*)d_in[i];
    a.out = (float*)d_out; a.ws = (unsigned char*)d_ws;
    if (N_LAUNCHES == 1) { a.ph_lo = 0; a.ph_hi = N_PHASES; hipLaunchKernelGGL(fwd, dim3(grid), dim3(NTHR), LDS_BYTES, stream, a); }
    else for (int p = 0; p < N_PHASES; ++p) { a.ph_lo = p; a.ph_hi = p + 1; hipLaunchKernelGGL(fwd, dim3(grid), dim3(NTHR), LDS_BYTES, stream, a); }
}
```

```cpp
#include <hip/hip_runtime.h>
#include <cstdio>
#include <cstdint>

#define LAS __attribute__((address_space(3)))
#define GAS __attribute__((address_space(1)))
typedef unsigned short bf16_t;
typedef short bf16x8 __attribute__((ext_vector_type(8)));
typedef short s16x4 __attribute__((ext_vector_type(4)));
typedef float f32x4 __attribute__((ext_vector_type(4)));
typedef float f32x2 __attribute__((ext_vector_type(2)));
typedef float f32x16 __attribute__((ext_vector_type(16)));
typedef unsigned u32x4 __attribute__((ext_vector_type(4)));
typedef unsigned u32x2 __attribute__((ext_vector_type(2)));

constexpr int DM = 2048, NB = 2, SEQ = 4096, NTOK = NB * SEQ;
constexpr int NH = 8, HD = 128, NKV = 2, AW = 1024, KVW = 256, IH = 16, ID = 64, TOPK = 256;
constexpr int PW = 1024, INW = 7760, INP = 7936;
constexpr int NE = 64, EH = 512, NGRP = 8, EPG = 8, TOPG = 4, ETOP = 8;
constexpr float NORM_EPS = 1e-6f, ROUTED_SCALE = 2.5f;
constexpr int NTHR = 512, NWAVES = 8;

constexpr size_t MiB = 1u << 20;
constexpr size_t WS_CTL = 0, CTL_BYTES = 1 * MiB;
constexpr size_t WS_W13 = 1 * MiB;
constexpr size_t WS_W2 = WS_W13 + 256 * MiB;
constexpr size_t WS_WS13 = WS_W2 + 128 * MiB;
constexpr size_t WS_WS2 = WS_WS13 + 4 * MiB;
constexpr size_t WS_H = WS_WS2 + 2 * MiB;
constexpr int HROWS_R = 65536 + 64 * 256, HROWS = HROWS_R + NTOK;
constexpr size_t WS_ROUTE = WS_H + (size_t)HROWS * EH * 2;
constexpr size_t RT_EID = 0, RT_GATE = RT_EID + (size_t)NTOK * 8 * 4, RT_POS = RT_GATE + (size_t)NTOK * 8 * 4, RT_LIST = RT_POS + (size_t)NTOK * 8 * 4,
                 RT_IDENT = RT_LIST + (size_t)NE * NTOK * 4, RT_END = RT_IDENT + (size_t)NTOK * 4;
constexpr size_t WS_R = (WS_ROUTE + RT_END + MiB - 1) / MiB * MiB;
constexpr size_t WS_Y = WS_R;
constexpr size_t WS_WIN = WS_R;
constexpr size_t WS_WAU = WS_WIN + 31 * MiB, WS_WPU = WS_WAU + 4 * MiB, WS_WOUT = WS_WPU + 4 * MiB, WS_PLIN = WS_WOUT + 8 * MiB, WS_WR = WS_PLIN + MiB / 2;
constexpr size_t WS_HB = WS_WR + MiB / 2;
constexpr size_t WS_Q = WS_HB + 32 * MiB, WS_K = WS_Q + 16 * MiB, WS_V = WS_K + 4 * MiB, WS_QI = WS_V + 4 * MiB, WS_KW = WS_QI + 16 * MiB, WS_U = WS_KW + 4 * MiB,
                 WS_G = WS_U + 16 * MiB;
constexpr size_t WS_POOLED = WS_G + 64 * MiB, WS_POOL = WS_POOLED + 16 * MiB, WS_ATTN = WS_POOL + 16 * MiB, WS_MERGED = WS_ATTN + 16 * MiB, WS_MASK = WS_MERGED + 32 * MiB,
                 WS_H8 = WS_MASK + 4 * MiB,
                 WS_REND = WS_H8 + 32 * MiB;
constexpr size_t WS_END = WS_Y + (size_t)HROWS_R * DM * 2;
static_assert(WS_REND <= WS_END, "overlay region");
constexpr int CW_BAR = 4096;
constexpr int CW_ECNT = 8192;
constexpr int CW_CONVQ = 12288;
constexpr int CW_DONE = 12544;
constexpr int CW_MOD = 16384;
static_assert((CW_MOD + 2 * 6 * DM) * 4 <= (int)CTL_BYTES, "ctl");

__device__ __forceinline__ int lane_id() { int l; asm volatile("v_mbcnt_lo_u32_b32 %0, -1, 0\n\tv_mbcnt_hi_u32_b32 %0, -1, %0" : "=v"(l)); return l; }
__device__ __forceinline__ unsigned cvt_pk_bf16(float lo, float hi) { unsigned r; asm volatile("v_cvt_pk_bf16_f32 %0, %1, %2" : "=v"(r) : "v"(lo), "v"(hi)); return r; }
__device__ __forceinline__ unsigned pk4_fp8(float a, float b, float c, float d) {
    a = __builtin_amdgcn_fmed3f(a, -448.f, 448.f); b = __builtin_amdgcn_fmed3f(b, -448.f, 448.f); c = __builtin_amdgcn_fmed3f(c, -448.f, 448.f); d = __builtin_amdgcn_fmed3f(d, -448.f, 448.f);
    int w = __builtin_amdgcn_cvt_pk_fp8_f32(a, b, 0, false); w = __builtin_amdgcn_cvt_pk_fp8_f32(c, d, w, true); return (unsigned)w; }
#ifndef FP8_INPROJ
#define FP8_INPROJ 0
#endif
#ifndef FP8_MERGE
#define FP8_MERGE 1
#endif
#ifndef FP8_OUT
#define FP8_OUT 1
#endif
constexpr float W8_SCALE = 8.f;   constexpr int W8_E8 = 127 - 3;
constexpr float H8_SCALE = 8.f;   constexpr int H8_E8 = 127 - 3;
constexpr float A8_SCALE = 8.f;   constexpr int A8_E8 = 127 - 3;
__device__ __forceinline__ float bf2f(unsigned short b) { return __uint_as_float(((unsigned)b) << 16); }
__device__ __forceinline__ float bflo(unsigned w) { return __uint_as_float(w << 16); }
__device__ __forceinline__ float bfhi(unsigned w) { return __uint_as_float(w & 0xffff0000u); }
__device__ __forceinline__ float wave_sum(float v) {
#pragma unroll
    for (int o = 1; o < 64; o <<= 1) v += __shfl_xor(v, o);
    return v;
}
__device__ __forceinline__ float sigmoidf_(float x) { return 1.0f / (1.0f + __expf(-x)); }

#define XB_TMO      128
#define XB_XCNT(j)  (256  + 64 * (j))
#define XB_XSUB(j)  (1280 + 64 * (j))
#define XB_XGEN(j)  (2304 + 64 * (j))
#define XB_TOP      3328
#define XB_TOPGEN   3392
#define XCD_BAR_WORDS 3456
#define XB_SPIN_CAP (1u << 18)
__device__ __forceinline__ unsigned xb_ld(unsigned* p)              { return __hip_atomic_load(p, __ATOMIC_RELAXED, __HIP_MEMORY_SCOPE_AGENT); }
__device__ __forceinline__ unsigned xb_add(unsigned* p, unsigned v) { return __hip_atomic_fetch_add(p, v, __ATOMIC_RELAXED, __HIP_MEMORY_SCOPE_AGENT); }
__device__ __forceinline__ unsigned xb_xcc_id() { return (unsigned)__builtin_amdgcn_s_getreg((3 << 11) | 20) & 0xFu; }
#define XB_SPIN(cond, bar) do { unsigned _sp = 0; while (cond) { __builtin_amdgcn_s_sleep(1); \
    if ((++_sp & 255u) == 0u) { if (xb_ld(&(bar)[XB_TMO])) break; if (_sp > XB_SPIN_CAP) { atomicAdd(&(bar)[XB_TMO], 1u); break; } } } } while (0)
struct XcdBarrier { unsigned* bar; unsigned x; volatile LAS unsigned* st; };
__device__ __forceinline__ XcdBarrier xcd_barrier_post(unsigned* bar, volatile LAS unsigned* st, int wave) {
    XcdBarrier b; b.bar = bar; b.x = xb_xcc_id(); b.st = st;
    if (wave == 0 && lane_id() == 0) (void)xb_add(&bar[XB_XCNT(b.x)], 1u);
    return b;
}
__device__ __forceinline__ void xcd_barrier_complete(unsigned* bar, unsigned x, unsigned& nloc, unsigned& nx) {
    const unsigned G = gridDim.x * gridDim.y * gridDim.z;
    unsigned sum, cnt, mine, sp = 0u;
    for (;;) {
        sum = 0u; cnt = 0u; mine = 0u;
#pragma unroll
        for (unsigned j = 0; j < 16; ++j) { const unsigned c = xb_ld(&bar[XB_XCNT(j)]); sum += c; cnt += (c > 0u) ? 1u : 0u; mine = (j == x) ? c : mine; }
        if (sum == G) break;
        __builtin_amdgcn_s_sleep(1);
        if ((++sp & 255u) == 0u) { if (xb_ld(&bar[XB_TMO])) break; if (sp > XB_SPIN_CAP) { atomicAdd(&bar[XB_TMO], 1u); break; } }
    }
    nloc = mine > 0u ? mine : 1u; nx = cnt > 0u ? cnt : 1u;
}
__device__ __forceinline__ void xcd_barrier(const XcdBarrier& b, int wave) {
    asm volatile("s_waitcnt vmcnt(0)" ::: "memory");
    __syncthreads();
    if (wave == 0 && lane_id() == 0) {
        unsigned* bar = b.bar;
        __builtin_amdgcn_s_waitcnt(0);
        unsigned nloc = b.st[0], nx = b.st[1];
        if (nloc == 0u) { xcd_barrier_complete(bar, b.x, nloc, nx); b.st[0] = nloc; b.st[1] = nx; }
        const unsigned old = xb_add(&bar[XB_XSUB(b.x)], 1u);
        const unsigned gen = old / nloc;
        if (old + 1u == (gen + 1u) * nloc) {
            __builtin_amdgcn_fence(__ATOMIC_RELEASE, "agent");
            asm volatile("s_waitcnt vmcnt(0)" ::: "memory");
            const unsigned og = xb_add(&bar[XB_TOP], 1u);
            const unsigned tg = og / nx;
            if (og + 1u == (tg + 1u) * nx) xb_add(&bar[XB_TOPGEN], 1u);
            else XB_SPIN(xb_ld(&bar[XB_TOPGEN]) == tg, bar);
            __builtin_amdgcn_fence(__ATOMIC_ACQUIRE, "agent");
            xb_add(&bar[XB_XGEN(b.x)], 1u);
            asm volatile("s_waitcnt vmcnt(0)" ::: "memory");
        } else {
            XB_SPIN(xb_ld(&bar[XB_XGEN(b.x)]) == gen, bar);
            __builtin_amdgcn_fence(__ATOMIC_ACQUIRE, "agent");
            asm volatile("s_waitcnt vmcnt(0)" ::: "memory");
        }
    }
    __syncthreads();
}
namespace pg8 {
constexpr int BM = 256, BK = 64, HALF = 128, HTB = HALF * BK * 2, STAGE_BYTES = 8 * HTB, NXCD = 8, WGM = 8;
__host__ __device__ __forceinline__ int lds_byte(int r, int c) { const int st = (r >> 4) * 2 + (c >> 5), rr = r & 15, cc = c & 31, ob = rr * 64 + cc * 2; return st * 1024 + (ob ^ (((ob >> 9) & 1) << 5)); }
__host__ __device__ __forceinline__ void stage_rc(int b, int& R, int& C) { const int st = b / 1024, sb = b % 1024, swz = sb ^ (((sb >> 9) & 1) << 5); R = (st >> 1) * 16 + swz / 64; C = (st & 1) * 32 + (swz % 64) / 2; }
__host__ __device__ __forceinline__ int perm32(int rho) { const int n = rho >> 4, i = rho & 15; return 8 * (i >> 2) + 4 * n + (i & 3); }

struct Unit { const char* A; const char* B; const int* tok; int pm, pn, aux; int nt8; };

struct TileOrder {
    int nM, nN, nwg, G, c;
    __device__ void init(int M, int N, int G_, int c_) { nM = M / BM; nN = N / BM; nwg = nM * nN; G = G_; c = c_; }
    __device__ bool tile(int i, int& pm, int& pn) const {
        const long L = (long)i * G + c; if (L >= nwg) return false;
        int wgid = (int)L; { const int q = nwg / NXCD, r = nwg % NXCD, xcd = wgid % NXCD, off = wgid / NXCD; wgid = (xcd < r ? xcd * (q + 1) : r * (q + 1) + (xcd - r) * q) + off; }
        const int nig = WGM * nN, gid = wgid / nig, fm = gid * WGM, gsz = (nM - fm) < WGM ? (nM - fm) : WGM;
        pm = fm + ((wgid % nig) % gsz); pn = (wgid % nig) / gsz; return true;
    }
};

typedef int i32x8 __attribute__((ext_vector_type(8)));
template <class Epi, class Sched, bool GATHER, int ES = 2, int SCA = 127, int SCB = 127, bool MIXED = false>
__device__ __forceinline__ void gemm_phase(LAS unsigned char* lds, const int wid, const int Kb, const int ldab, const Sched& S, const Epi& E, const int nt_ovr = 0) {
    const int lane = lane_id(), tid = wid * 64 + lane, wr = wid >> 2, wc = wid & 3, fr = lane & 15, fq = lane >> 4;
    const int nt = nt_ovr ? nt_ovr : Kb / (BK * 2);
    unsigned voffA[2], voffB[2];
#pragma unroll
    for (int i = 0; i < 2; ++i) { int R, C; stage_rc(tid * 16 + i * 8192, R, C); const int Rb = (R & ~31) + perm32(R & 31);
        voffA[i] = (unsigned)(R * ldab + C * 2); voffB[i] = (unsigned)(Rb * Kb + C * 2); }
    const size_t kstep = (size_t)(BK * 2);
    const size_t hstepA = (size_t)HALF * ldab, hstepB = (size_t)HALF * Kb;
    const unsigned ldsw = (unsigned)wid * 1024u;
    const int aoff = (ES == 2 || MIXED) ? lds_byte(wr * 64 + fr, fq * 8) : lds_byte(wr * 64 + fr, fq * 16), boff = (ES == 2 || MIXED) ? lds_byte(wc * 32 + fr, fq * 8) : lds_byte(wc * 32 + fr, fq * 16);
    constexpr int OFF1 = (ES == 2 || MIXED) ? 1024 : 16;
#define PG8_SA(b, h) (((b) * 2 + (h)) * HTB)
#define PG8_SB(b, h) ((4 + (b) * 2 + (h)) * HTB)
    const unsigned ldsbase = (unsigned)(uintptr_t)lds + ldsw;
#define PG8_DMA2(bufoff, sbase, voff_, i_) do { unsigned keep_; asm volatile("s_mov_b32 %0, m0\n\ts_mov_b32 m0, %3\n\ts_nop 0\n\tglobal_load_lds_dwordx4 %1, %2\n\ts_mov_b32 m0, %0" \
        : "=&s"(keep_) : "v"(voff_), "s"(sbase), "s"(ldsbase + (unsigned)((bufoff) + (i_) * 8192)) : "memory"); } while (0)
#define PG8_STAGEB(bufoff, gbase) do { _Pragma("unroll") for (int _i = 0; _i < 2; ++_i) PG8_DMA2(bufoff, (const char*)(gbase), voffB[_i], _i); } while (0)
#define PG8_STAGEA(bufoff, kt, h, GO) do { _Pragma("unroll") for (int _i = 0; _i < 2; ++_i) { \
        if constexpr (GATHER) PG8_DMA2(bufoff, (const char*)(kt), GO[h][_i], _i); else PG8_DMA2(bufoff, (const char*)(kt) + (h) * hstepA, voffA[_i], _i); } } while (0)
#define PG8_LD8(p0, p1) __builtin_bit_cast(i32x8, __builtin_shufflevector(*(const LAS u32x4*)(p0), *(const LAS u32x4*)(p1), 0, 1, 2, 3, 4, 5, 6, 7))
#define PG8_LDA(dst, b, h) do { _Pragma("unroll") for (int m = 0; m < 4; ++m) dst[m] = PG8_LD8(lds + PG8_SA(b, h) + aoff + m * 2048, lds + PG8_SA(b, h) + aoff + OFF1 + m * 2048); } while (0)
#define PG8_LDB(dst, b, h) do { _Pragma("unroll") for (int n = 0; n < 2; ++n) dst[n] = PG8_LD8(lds + PG8_SB(b, h) + boff + n * 2048, lds + PG8_SB(b, h) + boff + OFF1 + n * 2048); } while (0)
#define PG8_LO(x) __builtin_bit_cast(bf16x8, __builtin_shufflevector(x, x, 0, 1, 2, 3))
#define PG8_HI(x) __builtin_bit_cast(bf16x8, __builtin_shufflevector(x, x, 4, 5, 6, 7))
#define PG8_MMA16(ai, bj, At, Bt) do { _Pragma("unroll") for (int m = 0; m < 4; ++m) _Pragma("unroll") for (int n = 0; n < 2; ++n) { \
        acc[ai][bj][m][n] = __builtin_amdgcn_mfma_f32_16x16x32_bf16(PG8_LO(Bt[n]), PG8_LO(At[m]), acc[ai][bj][m][n], 0, 0, 0); \
        acc[ai][bj][m][n] = __builtin_amdgcn_mfma_f32_16x16x32_bf16(PG8_HI(Bt[n]), PG8_HI(At[m]), acc[ai][bj][m][n], 0, 0, 0); } } while (0)
#define PG8_MMA8(ai, bj, At, Bt) do { _Pragma("unroll") for (int m = 0; m < 4; ++m) _Pragma("unroll") for (int n = 0; n < 2; ++n) \
        acc[ai][bj][m][n] = __builtin_amdgcn_mfma_scale_f32_16x16x128_f8f6f4(Bt[n], At[m], acc[ai][bj][m][n], 0, 0, 0, SCB * 0x01010101, 0, SCA * 0x01010101); } while (0)
#define PG8_MMA(ai, bj, At, Bt) do { __builtin_amdgcn_s_setprio(1); \
        if constexpr (MIXED) { if (cur8) PG8_MMA8(ai, bj, At, Bt); else PG8_MMA16(ai, bj, At, Bt); } \
        else if constexpr (ES == 2) PG8_MMA16(ai, bj, At, Bt); else PG8_MMA8(ai, bj, At, Bt); \
        __builtin_amdgcn_s_setprio(0); } while (0)
#define PG8_WAIT_V(n) asm volatile("s_waitcnt vmcnt(" #n ")" ::: "memory")
#define PG8_WAIT_L(n) asm volatile("s_waitcnt lgkmcnt(" #n ")" ::: "memory")
#define PG8_BAR __builtin_amdgcn_s_barrier()
#define PG8_SCHED __builtin_amdgcn_sched_barrier(0)
#define PG8_GLOAD(GO, u) do { if constexpr (GATHER) { const int _tid = wid * 64 + lane_id(); _Pragma("unroll") for (int _i = 0; _i < 2; ++_i) { int _R, _C; stage_rc(_tid * 16 + _i * 8192, _R, _C); \
        _Pragma("unroll") for (int _h = 0; _h < 2; ++_h) { unsigned _t = (unsigned)(u).tok[_h * HALF + _R]; _t = _t < (unsigned)NTOK ? _t : (unsigned)(NTOK - 1); GO[_h][_i] = _t * (unsigned)ldab + (unsigned)_C * 2u; } } } } while (0)
    Unit cur, nxt; int ui = 0;
    if (!S.next(0, cur)) return;
    f32x4 acc[2][2][4][2];
#pragma unroll
    for (int a = 0; a < 2; ++a)
#pragma unroll
        for (int b = 0; b < 2; ++b)
#pragma unroll
            for (int m = 0; m < 4; ++m)
#pragma unroll
                for (int n = 0; n < 2; ++n) acc[a][b][m][n] = (f32x4){0.f, 0.f, 0.f, 0.f};
    i32x8 At[4], B0[2], B1[2];
    unsigned gC[2][2] = {{0u, 0u}, {0u, 0u}}, gN[2][2] = {{0u, 0u}, {0u, 0u}};
    PG8_GLOAD(gC, cur);
    const char* cA = cur.A; const char* cB = cur.B;
    bool cur8 = MIXED && cur.nt8 > 0; int ntc = cur8 ? cur.nt8 : nt;
    PG8_STAGEB(PG8_SB(0, 0), cB); PG8_STAGEB(PG8_SB(0, 1), cB + hstepB); PG8_STAGEA(PG8_SA(0, 0), cA, 0, gC); PG8_STAGEA(PG8_SA(0, 1), cA, 1, gC);
    if (wr == 1) PG8_BAR;
    PG8_WAIT_V(2); PG8_BAR;
    PG8_STAGEB(PG8_SB(1, 0), cB + kstep); PG8_STAGEA(PG8_SA(1, 0), cA + kstep, 0, gC); PG8_STAGEB(PG8_SB(1, 1), cB + hstepB + kstep);
    PG8_WAIT_V(6); PG8_BAR;
    for (;;) {
        const bool has_next = S.next(ui + 1, nxt);
        if (has_next) PG8_GLOAD(gN, nxt);
        const char* nA = has_next ? nxt.A : cA; const char* nB = has_next ? nxt.B : cB;
#pragma clang loop unroll(disable)
        for (int t = 0; t < ntc; t += 2) {
            const bool last = (t == ntc - 2);
            const char* a1 = cA + (size_t)(t + 1) * kstep;
            const char* a2 = last ? nA : cA + (size_t)(t + 2) * kstep; const char* b2 = last ? nB : cB + (size_t)(t + 2) * kstep;
            const char* a3 = a2 + kstep; const char* b3 = b2 + kstep;
            PG8_LDB(B0, 0, 0); PG8_LDB(B1, 0, 1); PG8_SCHED; PG8_LDA(At, 0, 0); PG8_STAGEA(PG8_SA(1, 1), a1, 1, gC);
            if (GATHER && last && has_next) {
#pragma unroll
                for (int _h = 0; _h < 2; ++_h)
#pragma unroll
                    for (int _i = 0; _i < 2; ++_i) gC[_h][_i] = gN[_h][_i];
            }
            PG8_WAIT_V(8); PG8_WAIT_L(0); PG8_BAR; PG8_MMA(0, 0, At, B0); PG8_MMA(0, 1, At, B1); PG8_BAR; PG8_SCHED;
            PG8_LDA(At, 0, 1); PG8_STAGEB(PG8_SB(0, 0), b2); PG8_STAGEB(PG8_SB(0, 1), b2 + hstepB); PG8_STAGEA(PG8_SA(0, 0), a2, 0, gC);
            PG8_WAIT_V(8); PG8_WAIT_L(0); PG8_BAR; PG8_MMA(1, 0, At, B0); PG8_MMA(1, 1, At, B1); PG8_BAR; PG8_SCHED;
            PG8_LDB(B0, 1, 0); PG8_LDB(B1, 1, 1); PG8_SCHED; PG8_LDA(At, 1, 0); PG8_STAGEA(PG8_SA(0, 1), a2, 1, gC);
            PG8_WAIT_V(8); PG8_WAIT_L(0); PG8_BAR; PG8_MMA(0, 0, At, B0); PG8_MMA(0, 1, At, B1); PG8_BAR; PG8_SCHED;
            PG8_LDA(At, 1, 1); PG8_STAGEB(PG8_SB(1, 0), b3); PG8_STAGEB(PG8_SB(1, 1), b3 + hstepB); PG8_STAGEA(PG8_SA(1, 0), a3, 0, gC);
            PG8_WAIT_V(8); PG8_WAIT_L(0); PG8_BAR; PG8_MMA(1, 0, At, B0); PG8_MMA(1, 1, At, B1); PG8_BAR; PG8_SCHED;
        }
        if (wr == 0) PG8_BAR;
        asm volatile("s_nop 15\n\ts_nop 7" ::: "memory");
        const int le_ = lane_id();
        const bool keep = E(acc, cur, wr, wc, le_ & 15, le_ >> 4);
        if (!has_next) break;
        if (!keep) {
#pragma unroll
        for (int a = 0; a < 2; ++a)
#pragma unroll
            for (int b = 0; b < 2; ++b)
#pragma unroll
                for (int m = 0; m < 4; ++m)
#pragma unroll
                    for (int n = 0; n < 2; ++n) acc[a][b][m][n] = (f32x4){0.f, 0.f, 0.f, 0.f};
        }
        cur = nxt; cA = nA; cB = nB; ++ui; cur8 = MIXED && cur.nt8 > 0; ntc = cur8 ? cur.nt8 : nt;
        if (wr == 1) PG8_BAR;
    }
    PG8_WAIT_V(0);
    PG8_BAR;
#undef PG8_SA
#undef PG8_SB
#undef PG8_DMA2
#undef PG8_STAGEA
#undef PG8_STAGEB
#undef PG8_LDA
#undef PG8_LDB
#undef PG8_MMA
#undef PG8_MMA8
#undef PG8_MMA16
#undef PG8_LD8
#undef PG8_LO
#undef PG8_HI
#undef PG8_WAIT_V
#undef PG8_WAIT_L
#undef PG8_BAR
#undef PG8_SCHED
#undef PG8_GLOAD
}
}
struct Args { const float* in[22]; float* out; unsigned char* ws; int ph_lo, ph_hi; };
enum { I_X = 0, I_C, I_WADA, I_BADA, I_GMIX, I_WIN, I_QNORM, I_KNORM, I_WAU, I_PLIN, I_PSCALE, I_WPU, I_WOUT, I_GFFN, I_WROUTER, I_RBIAS, I_W1, I_W3, I_W2, I_WS1, I_WS3, I_WS2 };
struct Frame {
    LAS unsigned char* lds;
    int wave, G, gw, NGW;
    unsigned char* ws; unsigned* ctl; float* out;
};
#define LDS_WAIT() asm volatile("s_waitcnt lgkmcnt(0)" ::: "memory")
#define VM_WAIT() asm volatile("s_waitcnt vmcnt(0)" ::: "memory")

__device__ __forceinline__ void tr_tile(const float* __restrict__ src, int ld_src, int nvalid, bf16_t* __restrict__ dst, int ld_dst, int lane) {
    const int q = lane >> 4, c4 = (lane & 15) * 4;
    const bool ok = c4 < nvalid;
#pragma unroll
    for (int g = 0; g < 2; ++g) {
        f32x4 v[8];
#pragma unroll
        for (int j = 0; j < 8; ++j) { const int k = 32 * g + 8 * q + j; v[j] = ok ? *(const f32x4*)(src + (size_t)k * ld_src + c4) : (f32x4){0.f, 0.f, 0.f, 0.f}; }
#pragma unroll
        for (int nn = 0; nn < 4; ++nn) {
            u32x4 w; w.x = cvt_pk_bf16(v[0][nn], v[1][nn]); w.y = cvt_pk_bf16(v[2][nn], v[3][nn]); w.z = cvt_pk_bf16(v[4][nn], v[5][nn]); w.w = cvt_pk_bf16(v[6][nn], v[7][nn]);
            *(u32x4*)(dst + (size_t)(c4 + nn) * ld_dst + 32 * g + 8 * q) = w;
        }
    }
}
__device__ __forceinline__ void tr8_issue(const float* __restrict__ src, int ld_src, int lane, f32x4 (&v)[16], int nvalid = 64) {
    const int q = lane >> 4, c4 = (lane & 15) * 4; const bool ok = c4 < nvalid;
    const unsigned voff = (unsigned)((16 * q) * ld_src + c4) * 4u;
#pragma unroll
    for (int j = 0; j < 16; ++j) v[j] = ok ? __builtin_nontemporal_load((const f32x4*)((const char*)src + (size_t)j * ld_src * 4 + voff)) : (f32x4){0.f, 0.f, 0.f, 0.f};
}
__device__ __forceinline__ void tr8_finish(unsigned char* __restrict__ dst, int ld_dst, int lane, const f32x4 (&v)[16]) {
    const int q = lane >> 4, c4 = (lane & 15) * 4;
#pragma unroll
    for (int nn = 0; nn < 4; ++nn) { u32x4 w;
#pragma unroll
        for (int t = 0; t < 4; ++t) w[t] = pk4_fp8(v[4 * t][nn] * W8_SCALE, v[4 * t + 1][nn] * W8_SCALE, v[4 * t + 2][nn] * W8_SCALE, v[4 * t + 3][nn] * W8_SCALE);
        *(u32x4*)(dst + (size_t)(c4 + nn) * ld_dst + 16 * q) = w; }
}
template <bool F8>
__device__ __forceinline__ void wcopy_tile(const float* src, int ld_src, int nvalid, unsigned char* dstbase, size_t drow, int ldk, int k0, int lane) {
    if constexpr (F8) { f32x4 v[16]; tr8_issue(src, ld_src, lane, v, nvalid); tr8_finish(dstbase + drow * ldk + k0, ldk, lane, v); }
    else tr_tile(src, ld_src, nvalid, (bf16_t*)dstbase + drow * ldk + k0, ldk, lane);
}
constexpr int ADA_WGS = 6 * DM / 128;
__device__ __forceinline__ void p0_prologue(Frame& F, const Args& a) {
    LAS float* sc = (LAS float*)F.lds;
    const int lane = lane_id(), tid = F.wave * 64 + lane;
    for (int i = tid; i < NB * DM; i += NTHR) { const float c = a.in[I_C][i]; sc[i] = c / (1.0f + __expf(-c)); }
    __syncthreads();
    float* mod = (float*)(F.ctl + CW_MOD);
    unsigned char* ws = F.ws;
    for (int job = blockIdx.x; job < 2 * ADA_WGS; job += F.G) {
        const int strip = job % ADA_WGS, kh = job / ADA_WGS, w = F.wave, krow0 = kh * 1024 + 128 * w;
        const int l32 = lane & 31, hb = lane >> 5;
        const float* wp = a.in[I_WADA] + (size_t)(krow0 + hb) * (6 * DM) + strip * 128 + 4 * l32;
        f32x4 b0 = {0.f, 0.f, 0.f, 0.f}, b1 = {0.f, 0.f, 0.f, 0.f};
#pragma unroll 16
        for (int k = 0; k < 64; ++k) { const f32x4 wv = *(const f32x4*)(wp + (size_t)(2 * k) * (6 * DM)); const float s0 = sc[krow0 + 2 * k + hb], s1 = sc[DM + krow0 + 2 * k + hb]; b0 += wv * s0; b1 += wv * s1; }
#pragma unroll
        for (int j = 0; j < 4; ++j) { b0[j] += __shfl_xor(b0[j], 32); b1[j] += __shfl_xor(b1[j], 32); }
        const int col2 = 2 * (lane & 1);
        const f32x2 a0 = {hb ? b0[2] : b0[0], hb ? b0[3] : b0[1]}, a1 = {hb ? b1[2] : b1[0], hb ? b1[3] : b1[1]};
        const int pcol = 4 * l32 + 2 * hb; (void)col2;
        LAS float* part = (LAS float*)(F.lds + 16384);
        *(LAS f32x2*)(part + (w * 2 + 0) * 128 + pcol) = a0; *(LAS f32x2*)(part + (w * 2 + 1) * 128 + pcol) = a1;
        __syncthreads();
        if (tid < 256) { const int b = tid >> 7, c = tid & 127; float sum = kh == 0 ? a.in[I_BADA][strip * 128 + c] : 0.f;
#pragma unroll
            for (int ww = 0; ww < 8; ++ww) sum += part[(ww * 2 + b) * 128 + c];
            unsafeAtomicAdd(mod + b * 6 * DM + strip * 128 + c, sum); }
        __syncthreads();
    }
    unsigned char* Win8 = ws + WS_WIN;
    constexpr int J_IN_A = 32 * 40, J_IN_B = 32 * 4, J_IN_C = 32 * 80, J_AU = 16 * 32, J_PU = 16 * 32, J_OUT = 32 * 32, J_PL = 4 * 16, J_S13 = 2 * 32 * 8, J_S2 = 8 * 32, J_WR = 32,
                  J_W13 = 0, J_W2 = 0;
    constexpr int NITEMS = J_IN_A + J_IN_B + J_IN_C + J_AU + J_PU + J_OUT + J_PL + J_S13 + J_S2 + J_WR;
    for (int it = F.gw; it < NITEMS; it += F.NGW) {
        int r = it;
        if (r < J_IN_A) { const int kb = r / 40, nb = r % 40; if ((nb >> 2) == 5) wcopy_tile<true>(a.in[I_WIN] + (size_t)(64 * kb) * INW + 64 * nb, INW, 64, Win8, (size_t)(64 * nb), 2 * DM, 64 * kb, lane);
            else wcopy_tile<false>(a.in[I_WIN] + (size_t)(64 * kb) * INW + 64 * nb, INW, 64, Win8, (size_t)(64 * nb), DM, 64 * kb, lane); continue; } r -= J_IN_A;
        if (r < J_IN_B) { const int kb = r / 4, nb = r % 4; const int nv = nb == 0 ? 64 : (nb == 1 ? 16 : 0);
            wcopy_tile<false>(a.in[I_WIN] + (size_t)(64 * kb) * INW + 2560 + (nb < 2 ? 64 * nb : 0), INW, nv, Win8, (size_t)(2560 + 64 * nb), DM, 64 * kb, lane); continue; } r -= J_IN_B;
        if (r < J_IN_C) { const int kb = r / 80, nb = r % 80; wcopy_tile<true>(a.in[I_WIN] + (size_t)(64 * kb) * INW + 2640 + 64 * nb, INW, 64, Win8, (size_t)(2816 + 64 * nb), 2 * DM, 64 * kb, lane); continue; } r -= J_IN_C;
        if (r < J_AU) { const int kb = r / 32, nb = r % 32; wcopy_tile<FP8_MERGE>(a.in[I_WAU] + (size_t)(64 * kb) * DM + 64 * nb, DM, 64, ws + WS_WAU, (size_t)(64 * nb), AW, 64 * kb, lane); continue; } r -= J_AU;
        if (r < J_PU) { const int kb = r / 32, nb = r % 32; wcopy_tile<FP8_MERGE>(a.in[I_WPU] + (size_t)(64 * kb) * DM + 64 * nb, DM, 64, ws + WS_WPU, (size_t)(64 * nb), PW, 64 * kb, lane); continue; } r -= J_PU;
        if (r < J_OUT) { const int kb = r / 32, nb = r % 32; wcopy_tile<FP8_OUT>(a.in[I_WOUT] + (size_t)(64 * kb) * DM + 64 * nb, DM, 64, ws + WS_WOUT, (size_t)(64 * nb), DM, 64 * kb, lane); continue; } r -= J_OUT;
        if (r < J_PL) { const int g = r / 16, kb = (r % 16) / 4, nb = r % 4; tr_tile(a.in[I_PLIN] + (size_t)g * 65536 + (size_t)(64 * kb) * 256 + 64 * nb, 256, 64, (bf16_t*)(ws + WS_PLIN) + (size_t)g * 65536 + (size_t)(64 * nb) * 256 + 64 * kb, 256, lane); continue; } r -= J_PL;
        if (r < J_S13) { const int which = r / 256, kb = (r % 256) / 8, nb = r % 8; const float* src = (which ? a.in[I_WS3] : a.in[I_WS1]) + (size_t)(64 * kb) * EH + 64 * nb;
            f32x4 v[16]; tr8_issue(src, EH, lane, v); tr8_finish(ws + WS_WS13 + (size_t)(256 * (nb >> 1) + 64 * (nb & 1) + 128 * which) * DM + 64 * kb, DM, lane, v); continue; } r -= J_S13;
        if (r < J_S2) { const int kb = r / 32, nb = r % 32; f32x4 v[16]; tr8_issue(a.in[I_WS2] + (size_t)(64 * kb) * DM + 64 * nb, DM, lane, v); tr8_finish(ws + WS_WS2 + (size_t)(64 * nb) * EH + 64 * kb, EH, lane, v); continue; } r -= J_S2;
        { const int kb = r; tr_tile(a.in[I_WROUTER] + (size_t)(64 * kb) * NE, NE, 64, (bf16_t*)(ws + WS_WR) + 64 * kb, DM, lane); }
    }
}

constexpr int NCONV_W13 = NE * 2 * 32 * 8, NCONV = NCONV_W13 + NE * 8 * 32;
__device__ __forceinline__ void conv_ptrs(const Args& a, unsigned char* ws, int it, const float*& src, int& ld_src, unsigned char*& dst, int& ld_dst) {
    if (it < NCONV_W13) { const int e = it / 512, rr = it % 512, which = rr / 256, kb = (rr % 256) / 8, nb = rr % 8;
        src = (which ? a.in[I_W3] : a.in[I_W1]) + ((size_t)e * DM + 64 * kb) * EH + 64 * nb; ld_src = EH;
        dst = ws + WS_W13 + ((size_t)e * 1024 + 256 * (nb >> 1) + 64 * (nb & 1) + 128 * which) * DM + 64 * kb; ld_dst = DM; }
    else { const int r = it - NCONV_W13, e = r / 256, kb = (r % 256) / 32, nb = r % 32;
        src = a.in[I_W2] + ((size_t)e * EH + 64 * kb) * DM + 64 * nb; ld_src = DM; dst = ws + WS_W2 + ((size_t)e * DM + 64 * nb) * EH + 64 * kb; ld_dst = EH; }
}
__device__ __forceinline__ void conv_issue16(const Args& a, unsigned char* ws, int it, int lane, f32x4 (&v)[16]) {
    const float* src; int ld_src; unsigned char* dst; int ld_dst; conv_ptrs(a, ws, it, src, ld_src, dst, ld_dst); tr8_issue(src, ld_src, lane, v); }
__device__ __forceinline__ void conv_finish16(const Args& a, unsigned char* ws, int it, int lane, const f32x4 (&v)[16]) {
    const float* src; int ld_src; unsigned char* dst; int ld_dst; conv_ptrs(a, ws, it, src, ld_src, dst, ld_dst); tr8_finish(dst, ld_dst, lane, v); }
__device__ __forceinline__ void phase_done(Frame& F, int phase) { __syncthreads(); if (F.wave == 0 && lane_id() == 0) __hip_atomic_fetch_add(F.ctl + CW_DONE + 64 * phase, 1u, __ATOMIC_RELAXED, __HIP_MEMORY_SCOPE_AGENT); }
constexpr int CONV_SEG1_END = NCONV_W13 + (NCONV - NCONV_W13) * 3 / 10 / 8 * 8;
__device__ __forceinline__ unsigned conv_seg_lo(int sg) { return sg == 0 ? 0u : (sg == 1 ? (unsigned)NCONV_W13 : (unsigned)CONV_SEG1_END); }
__device__ __forceinline__ unsigned conv_seg_hi(int sg) { return sg == 0 ? (unsigned)NCONV_W13 : (sg == 1 ? (unsigned)CONV_SEG1_END : (unsigned)NCONV); }
template <bool BOUNDED, int SEG_LO, int SEG_HI>
struct ConvQ {
    Frame& F; int phase, lane; unsigned cur, end; int sg;
    __device__ __forceinline__ int next() {
        constexpr unsigned B = BOUNDED ? 6u : 8u;
        while (cur >= end) {
            if (BOUNDED) { const unsigned d = __hip_atomic_load(F.ctl + CW_DONE + 64 * phase, __ATOMIC_RELAXED, __HIP_MEMORY_SCOPE_AGENT); if ((unsigned)__builtin_amdgcn_readfirstlane(d) >= (unsigned)F.G) return -1; }
            const unsigned lo = conv_seg_lo(sg), hi = conv_seg_hi(sg);
            unsigned s = 0; if (lane == 0) s = __hip_atomic_fetch_add(F.ctl + CW_CONVQ + 64 * sg, B, __ATOMIC_RELAXED, __HIP_MEMORY_SCOPE_AGENT);
            s = (unsigned)__builtin_amdgcn_readfirstlane(s) + lo;
            if (s >= hi) { if (sg < SEG_HI) { ++sg; continue; } return -1; }
            cur = s; end = s + B < hi ? s + B : hi;
        }
        return (int)cur++;
    }
};
template <bool BOUNDED, int SEG_LO, int SEG_HI>
__device__ __forceinline__ void conv_drain(Frame& F, const Args& a, int phase, int quota = 0) {
    const int lane = lane_id();
    ConvQ<BOUNDED, SEG_LO, SEG_HI> Q{F, phase, lane, 0u, 0u, SEG_LO};
    f32x4 va[16], vb[16]; int n = 0;
    int ia = Q.next(); if (ia < 0) return;
    conv_issue16(a, F.ws, ia, lane, va);
    for (;;) {
        ++n; const int ib = (quota > 0 && n >= quota && Q.cur >= Q.end) ? -1 : Q.next(); if (ib >= 0) conv_issue16(a, F.ws, ib, lane, vb);
        conv_finish16(a, F.ws, ia, lane, va);
        if (ib < 0) break;
        ++n; ia = (quota > 0 && n >= quota && Q.cur >= Q.end) ? -1 : Q.next(); if (ia >= 0) conv_issue16(a, F.ws, ia, lane, va);
        conv_finish16(a, F.ws, ib, lane, vb);
        if (ia < 0) break;
    }
}

__device__ __forceinline__ void modnorm_row(const float* __restrict__ xrow, const float* __restrict__ g, const float* __restrict__ shift, const float* __restrict__ scale, unsigned char* __restrict__ orow, unsigned char* __restrict__ orow8, int lane) {
    f32x4 v[8]; float ss = 0.f;
#pragma unroll
    for (int j = 0; j < 8; ++j) { v[j] = *(const f32x4*)(xrow + 4 * lane + 256 * j); ss += (v[j].x * v[j].x + v[j].y * v[j].y) + (v[j].z * v[j].z + v[j].w * v[j].w); }
    const float rstd = rsqrtf(wave_sum(ss) * (1.0f / DM) + NORM_EPS);
#pragma unroll
    for (int j = 0; j < 8; ++j) { const int c = 4 * lane + 256 * j;
        const f32x4 gg = *(const f32x4*)(g + c), sh = *(const f32x4*)(shift + c), sl = *(const f32x4*)(scale + c);
        const f32x4 o = v[j] * rstd * gg * (sl + 1.0f) + sh;
        { u32x2 w; w.x = cvt_pk_bf16(o.x, o.y); w.y = cvt_pk_bf16(o.z, o.w); *(u32x2*)((bf16_t*)orow + c) = w; }
        if (orow8) *(unsigned*)(orow8 + c) = pk4_fp8(o.x * A8_SCALE, o.y * A8_SCALE, o.z * A8_SCALE, o.w * A8_SCALE); }
}
__device__ __forceinline__ void p1_h(Frame& F, const Args& a) {
    const float* mod = (const float*)(F.ctl + CW_MOD);
    unsigned char* hb = F.ws + WS_HB; const int lane = lane_id();
    for (int m0 = 2 * F.gw; m0 < NTOK; m0 += 2 * F.NGW) {
        f32x4 v[2][8];
#pragma unroll
        for (int rr = 0; rr < 2; ++rr)
#pragma unroll
            for (int j = 0; j < 8; ++j) v[rr][j] = *(const f32x4*)(a.in[I_X] + (size_t)(m0 + rr) * DM + 4 * lane + 256 * j);
        const int b = m0 / SEQ; const float* sh = mod + b * 6 * DM; const float* sl = mod + b * 6 * DM + DM;
        float rstd[2];
#pragma unroll
        for (int rr = 0; rr < 2; ++rr) { float ss = 0.f;
#pragma unroll
            for (int j = 0; j < 8; ++j) ss += (v[rr][j].x * v[rr][j].x + v[rr][j].y * v[rr][j].y) + (v[rr][j].z * v[rr][j].z + v[rr][j].w * v[rr][j].w);
            rstd[rr] = rsqrtf(wave_sum(ss) * (1.0f / DM) + NORM_EPS); }
#pragma unroll
        for (int j = 0; j < 8; ++j) { const int c = 4 * lane + 256 * j;
            const f32x4 gg = *(const f32x4*)(a.in[I_GMIX] + c), shv = *(const f32x4*)(sh + c), slv = *(const f32x4*)(sl + c); const f32x4 mul = gg * (slv + 1.0f);
#pragma unroll
            for (int rr = 0; rr < 2; ++rr) { const f32x4 o = v[rr][j] * rstd[rr] * mul + shv; const size_t ro = (size_t)(m0 + rr) * DM * 2;
                u32x2 w; w.x = cvt_pk_bf16(o.x, o.y); w.y = cvt_pk_bf16(o.z, o.w); *(u32x2*)((bf16_t*)(hb + ro) + c) = w;
                *(unsigned*)(F.ws + WS_H8 + ro + c) = pk4_fp8(o.x * A8_SCALE, o.y * A8_SCALE, o.z * A8_SCALE, o.w * A8_SCALE); } }
    }
}
struct SchedDense {
    pg8::TileOrder T; const char* A; const char* B; size_t a_tile, b_tile;
    __device__ __forceinline__ bool next(int i, pg8::Unit& u) const { int pm, pn; if (!T.tile(i, pm, pn)) return false; u.pm = pm; u.pn = pn; u.aux = 0; u.tok = nullptr; u.nt8 = 0;
        u.A = A + (size_t)pm * a_tile; u.B = B + (size_t)pn * b_tile; return true; }
};
__device__ __forceinline__ void st_bf16x8(bf16_t* p, f32x4 v0, f32x4 v1) { u32x4 w; w.x = cvt_pk_bf16(v0[0], v0[1]); w.y = cvt_pk_bf16(v0[2], v0[3]); w.z = cvt_pk_bf16(v1[0], v1[1]); w.w = cvt_pk_bf16(v1[2], v1[3]); *(u32x4*)p = w; }
struct EpiInproj {
    unsigned char* ws;
    __device__ __forceinline__ bool operator()(f32x4 (&acc)[2][2][4][2], const pg8::Unit& u, int wr, int wc, int fr, int fq) const {
        const int pn = u.pn; bf16_t* base; int ld, ct; bool sig = false;
        if (pn < 4) { base = (bf16_t*)(ws + WS_Q); ld = AW; ct = pn; }
        else if (pn == 4) { base = (bf16_t*)(ws + WS_K); ld = KVW; ct = 0; }
        else if (pn == 5) { base = (bf16_t*)(ws + WS_V); ld = KVW; ct = 0; }
        else if (pn < 10) { base = (bf16_t*)(ws + WS_QI); ld = IH * ID; ct = pn - 6; }
        else if (pn == 10) { base = (bf16_t*)(ws + WS_KW); ld = 256; ct = 0; }
        else if (pn < 15) { base = (bf16_t*)(ws + WS_U); ld = PW; ct = pn - 11; }
        else { base = (bf16_t*)(ws + WS_G); ld = 2 * DM; ct = pn - 15; sig = true; }
        const int row0 = u.pm * 256 + wr * 64 + fr, col0 = ct * 256 + wc * 32 + 8 * fq;
#pragma unroll
        for (int ai = 0; ai < 2; ++ai)
#pragma unroll
            for (int m = 0; m < 4; ++m) { bf16_t* rowp = base + (size_t)(row0 + ai * 128 + m * 16) * ld + col0;
#pragma unroll
                for (int bj = 0; bj < 2; ++bj) { f32x4 v0 = acc[ai][bj][m][0], v1 = acc[ai][bj][m][1];
                    if (sig) {
#pragma unroll
                        for (int j = 0; j < 4; ++j) { v0[j] = fminf(__builtin_amdgcn_rcpf(1.0f + __expf(-v0[j])), 1.0f); v1[j] = fminf(__builtin_amdgcn_rcpf(1.0f + __expf(-v1[j])), 1.0f); } }
                    st_bf16x8(rowp + bj * 128, v0, v1); } }
        return false;
    }
};
struct SchedInproj {
    int G, c, kind; const char* hA; const char* win;
    __device__ __forceinline__ bool next(int i, pg8::Unit& u) const {
        const int first = kind == 0 ? c : c + ((320 - c + G - 1) / G) * G;
        const int j = first + i * G; if (j >= (kind == 0 ? 320 : 992)) return false;
        int pn, pm;
        if (kind == 0) { const int t = j >> 5; pm = j & 31; pn = t < 5 ? t : t + 1; }
        else { const int jj = j - 320, t = jj >> 5; pm = jj & 31; pn = t == 0 ? 5 : t + 10; }
        u.pm = pm; u.pn = pn; u.aux = 0; u.tok = nullptr; u.nt8 = 0;
        u.A = hA + (size_t)pm * 256 * DM * 2; u.B = win + (size_t)pn * 256 * DM * 2; return true; }
};
__device__ __forceinline__ void p2_inproj(Frame& F, const Args& a) {
    const int NG = F.G >= 256 ? 248 : F.G;
    if ((int)blockIdx.x >= NG) { conv_drain<false, 0, 2>(F, a, 2, 24); return; }
    EpiInproj E{F.ws};
    { SchedInproj S{NG, (int)blockIdx.x, 0, (const char*)(F.ws + WS_HB), (const char*)(F.ws + WS_WIN)};
      pg8::gemm_phase<EpiInproj, SchedInproj, false, 2>(F.lds, F.wave, DM * 2, DM * 2, S, E); }
    { SchedInproj S{NG, (int)blockIdx.x, 1, (const char*)(F.ws + WS_H8), (const char*)(F.ws + WS_WIN)};
      pg8::gemm_phase<EpiInproj, SchedInproj, false, 1, A8_E8, W8_E8>(F.lds, F.wave, DM * 2, DM * 2, S, E, DM / 128); }
}
__device__ __forceinline__ void p3_qknorm(Frame& F, const Args& a) {
    bf16_t* K = (bf16_t*)(F.ws + WS_K);
    const int lane = lane_id();
    for (int m = F.gw; m < NTOK; m += F.NGW) {
        u32x2 k0 = *(const u32x2*)(K + (size_t)m * KVW + 4 * lane);
        float kv[4]; float sk = 0.f;
        kv[0] = bflo(k0[0]); kv[1] = bfhi(k0[0]); kv[2] = bflo(k0[1]); kv[3] = bfhi(k0[1]);
#pragma unroll
        for (int j = 0; j < 4; ++j) sk += kv[j] * kv[j];
        sk += __shfl_xor(sk, 1); sk += __shfl_xor(sk, 2); sk += __shfl_xor(sk, 4); sk += __shfl_xor(sk, 8); sk += __shfl_xor(sk, 16);
        const float rk = rsqrtf(sk * (1.0f / HD) + NORM_EPS);
        const int dk = (4 * lane) & 127;
        u32x2 ok; ok[0] = cvt_pk_bf16(kv[0] * rk * a.in[I_KNORM][dk], kv[1] * rk * a.in[I_KNORM][dk + 1]); ok[1] = cvt_pk_bf16(kv[2] * rk * a.in[I_KNORM][dk + 2], kv[3] * rk * a.in[I_KNORM][dk + 3]);
        *(u32x2*)(K + (size_t)m * KVW + 4 * lane) = ok;
    }
}
__device__ __forceinline__ void pooled_item(Frame& F, int t0, int g, int lane) {
    const bf16_t* U = (const bf16_t*)(F.ws + WS_U); bf16_t* P = (bf16_t*)(F.ws + WS_POOLED);
    const int pos0 = t0 % SEQ, w = 2 << g, c = 256 * g + 4 * lane;
    f32x4 W = {0.f, 0.f, 0.f, 0.f};
    for (int j = 1; j <= 16; ++j) { if (j <= w && pos0 - j >= 0) { const u32x2 v = *(const u32x2*)(U + (size_t)(t0 - j) * PW + c); W += (f32x4){bflo(v[0]), bfhi(v[0]), bflo(v[1]), bfhi(v[1])}; } }
#pragma unroll 8
    for (int i = 0; i < 32; ++i) { const int t = t0 + i, pos = pos0 + i;
        const u32x2 v = *(const u32x2*)(U + (size_t)t * PW + c); const f32x4 cur = {bflo(v[0]), bfhi(v[0]), bflo(v[1]), bfhi(v[1])};
        W += cur;
        if (pos - w >= 0) { const u32x2 o = *(const u32x2*)(U + (size_t)(t - w) * PW + c); W -= (f32x4){bflo(o[0]), bfhi(o[0]), bflo(o[1]), bfhi(o[1])}; }
        const float inv = 1.0f / (float)(pos + 1 < w ? pos + 1 : w);
        const f32x4 r = W * inv - cur;
        u32x2 ow; ow[0] = cvt_pk_bf16(r[0], r[1]); ow[1] = cvt_pk_bf16(r[2], r[3]);
        *(u32x2*)(P + (size_t)t * PW + c) = ow; }
}
__device__ __forceinline__ unsigned mono_key(float s) { const unsigned u = __float_as_uint(s); return (u & 0x80000000u) ? ~u : (u | 0x80000000u); }
__device__ __forceinline__ void idx_block(Frame& F, const Args& a, int b, int i16) {
    const bf16_t* QI = (const bf16_t*)(F.ws + WS_QI); const bf16_t* KW = (const bf16_t*)(F.ws + WS_KW);
    unsigned short* MT = (unsigned short*)(F.ws + WS_MASK);
    LAS unsigned* T = (LAS unsigned*)F.lds;
    const int lane = lane_id(), w = F.wave, tid = w * 64 + lane, r32 = lane & 31, hi = lane >> 5;
    const int tpos0 = 16 * i16, t0 = b * SEQ + tpos0, nh = (tpos0 + 16 + 31) >> 5, kzero = 64 * ((tpos0 >> 6) + 1);
    for (int k = tid; k < kzero; k += NTHR) T[k] = 0u;
    bf16x8 Af[4];
    { const int qsel = (r32 >> 2) & 1, head = (r32 & 3) + 4 * (r32 >> 3); const size_t tq = (size_t)(t0 + 2 * w + qsel);
      const float wv = bf2f(KW[tq * 256 + 64 + head]);
#pragma unroll
      for (int s = 0; s < 4; ++s) { const u32x4 q = *(const u32x4*)(QI + tq * (IH * ID) + head * ID + 16 * s + 8 * hi); u32x4 o;
#pragma unroll
          for (int j = 0; j < 4; ++j) o[j] = cvt_pk_bf16(bflo(q[j]) * wv, bfhi(q[j]) * wv);
          Af[s] = __builtin_bit_cast(bf16x8, o); } }
    float X[16];
    { const size_t tq = (size_t)(t0 + 2 * w + hi); const u32x4 w0 = *(const u32x4*)(KW + tq * 256 + 64), w1 = *(const u32x4*)(KW + tq * 256 + 72);
      const float PINF = __builtin_inff();
#pragma unroll
      for (int j = 0; j < 4; ++j) { X[2 * j] = bflo(w0[j]) >= 0.f ? PINF : -PINF; X[2 * j + 1] = bfhi(w0[j]) >= 0.f ? PINF : -PINF;
                                    X[8 + 2 * j] = bflo(w1[j]) >= 0.f ? PINF : -PINF; X[8 + 2 * j + 1] = bfhi(w1[j]) >= 0.f ? PINF : -PINF; } }
    const int mypos = tpos0 + 2 * w + hi;
    unsigned keys[128];
    constexpr int RING = 16384, SLOT = 8192;
    const int nt64 = (nh + 1) >> 1;
    const unsigned dvoff = (unsigned)((lane >> 3) * 512 + (((lane & 7) ^ (lane >> 3)) << 4));
    const char* kwb = (const char*)(KW + (size_t)b * SEQ * 256) + w * 4096;
    const unsigned ldsw = (unsigned)(uintptr_t)F.lds + RING + w * 1024;
#define IDX_DMA(t_) do { unsigned keep_; asm volatile("s_mov_b32 %0, m0\n\ts_mov_b32 m0, %3\n\ts_nop 0\n\tglobal_load_lds_dwordx4 %1, %2\n\ts_mov_b32 m0, %0" \
        : "=&s"(keep_) : "v"(dvoff), "s"(kwb + (size_t)(t_) * 32768), "s"(ldsw + (unsigned)(((t_) & 3) * SLOT)) : "memory"); } while (0)
    int boffs[4];
#pragma unroll
    for (int s = 0; s < 4; ++s) boffs[s] = r32 * 128 + ((((2 * s + hi) ^ (r32 & 7))) << 4);
    __syncthreads();
    if (0 < nt64) IDX_DMA(0);
    if (1 < nt64) IDX_DMA(1);
    if (2 < nt64) IDX_DMA(2);
#pragma unroll
    for (int t = 0; t < 64; ++t) {
        keys[2 * t] = 0u; keys[2 * t + 1] = 0u;
        if (t < nt64) {
            const int rem = nt64 - 1 - t;
            if (rem >= 2) asm volatile("s_waitcnt vmcnt(2)" ::: "memory"); else if (rem == 1) asm volatile("s_waitcnt vmcnt(1)" ::: "memory"); else asm volatile("s_waitcnt vmcnt(0)" ::: "memory");
            __builtin_amdgcn_s_barrier(); asm volatile("" ::: "memory");
            if (t + 3 < nt64) IDX_DMA(t + 3);
#pragma unroll
            for (int half = 0; half < 2; ++half) { const int n = 2 * t + half;
                if (n < nh) {
                    f32x16 acc = {0.f, 0.f, 0.f, 0.f, 0.f, 0.f, 0.f, 0.f, 0.f, 0.f, 0.f, 0.f, 0.f, 0.f, 0.f, 0.f};
#pragma unroll
                    for (int s = 0; s < 4; ++s) { const bf16x8 bfr = *(const LAS bf16x8*)(F.lds + RING + (t & 3) * SLOT + half * 4096 + boffs[s]);
                        acc = __builtin_amdgcn_mfma_f32_32x32x16_bf16(Af[s], bfr, acc, 0, 0, 0); }
                    float sc = 0.f;
#pragma unroll
                    for (int j = 0; j < 16; ++j) sc += __builtin_amdgcn_fmed3f(acc[j], 0.f, X[j]);
                    keys[n] = (32 * n + r32 <= mypos) ? mono_key(sc) : 0u;
                } }
        }
    }
#undef IDX_DMA
    unsigned Tsel = 0u;
    { constexpr int HIST = 49152;
      LAS unsigned* hb = (LAS unsigned*)(F.lds + HIST) + (2 * w + hi) * 512;
      unsigned kk = (unsigned)TOPK; bool alive = true;
#pragma unroll 1
      for (int p = 0; p < 4; ++p) { const int sh = 24 - 8 * p;
          *(LAS u32x4*)(hb + 8 * r32) = (u32x4){0u, 0u, 0u, 0u}; *(LAS u32x4*)(hb + 8 * r32 + 4) = (u32x4){0u, 0u, 0u, 0u};
          asm volatile("s_waitcnt lgkmcnt(0)" ::: "memory");
#pragma unroll
          for (int n8 = 0; n8 < 16; ++n8) { if (n8 * 8 < nh) {
#pragma unroll
              for (int j = 0; j < 8; ++j) { const unsigned key = keys[n8 * 8 + j];
                  const unsigned x = p ? ((key ^ Tsel) >> ((sh + 8) & 31)) : 0u, t = x < 1u ? x : 1u;
                  __hip_atomic_fetch_add(hb + ((t << 8) + ((key >> sh) & 255u)), 1u, __ATOMIC_RELAXED, __HIP_MEMORY_SCOPE_WORKGROUP); } } }
          asm volatile("s_waitcnt lgkmcnt(0)" ::: "memory");
          const u32x4 c0 = *(const LAS u32x4*)(hb + 8 * r32), c1 = *(const LAS u32x4*)(hb + 8 * r32 + 4);
          const unsigned cb[8] = {(p == 0 && r32 == 0) ? 0u : c0[0], c0[1], c0[2], c0[3], c1[0], c1[1], c1[2], c1[3]};
          unsigned S = 0;
#pragma unroll
          for (int j = 0; j < 8; ++j) S += cb[j];
          unsigned suf = S;
#pragma unroll
          for (int d = 1; d < 32; d <<= 1) { const unsigned y = __shfl_down(suf, d, 32); if (r32 + d < 32) suf += y; }
          const unsigned total = __shfl(suf, 0, 32), sufx = suf - S;
          if (alive && total < kk) alive = false;
          const bool mine = alive && sufx < kk && kk <= suf;
          unsigned acc = sufx, bsel = 0u, above = 0u; bool found = false;
#pragma unroll
          for (int j = 7; j >= 0; --j) { if (!found) { if (acc + cb[j] >= kk) { found = true; bsel = (unsigned)(8 * r32 + j); above = acc; } else acc += cb[j]; } }
          const unsigned long long bm = __ballot(mine);
          const unsigned half = hi ? (unsigned)(bm >> 32) : (unsigned)bm;
          const int src = half ? (__builtin_ctz(half) + 32 * hi) : lane;
          const unsigned bs = __shfl(bsel, src), ab = __shfl(above, src);
          if (alive) { Tsel |= bs << sh; kk -= ab; }
      }
      if (!alive) Tsel = 0u;
    }
    { const unsigned Tf = Tsel > 1u ? Tsel : 1u;
      __syncthreads();
#pragma unroll
      for (int n = 0; n < 128; ++n) { if (n < nh) {
          unsigned bitv = keys[n] >= Tf ? 1u : 0u; const unsigned other = __shfl_xor(bitv, 32);
          bitv |= other << 1;
          if (hi == 0 && bitv) __hip_atomic_fetch_or(T + 32 * n + r32, bitv << (2 * w), __ATOMIC_RELAXED, __HIP_MEMORY_SCOPE_WORKGROUP); } }
    }
    __syncthreads();
    { const int rg = (b * SEQ + tpos0) >> 5, f = i16 & 1;
      for (int k = tid; k < kzero; k += NTHR) { const int kk = k & 63, p = (kk & ~7) | ((kk & 3) << 1) | ((kk >> 2) & 1);
          MT[((size_t)(rg * 64 + (k >> 6)) * 64 + p) * 2 + f] = (unsigned short)(T[k] & 0xffffu); } }
    __syncthreads();
}
__device__ __forceinline__ void p3_indexer(Frame& F, const Args& a) {
    for (int v2 = 2 * blockIdx.x; v2 < 512; v2 += 2 * F.G) { for (int ps = 0; ps < 2; ++ps) { const int v = v2 >> 1, b = v >> 7, i = v & 127; idx_block(F, a, b, ps ? 255 - i : i); } }
}
namespace att {
constexpr int KVBLK = 64, SHM_V = KVBLK * HD * 2, SHM_K = KVBLK * HD * 2;
constexpr int LDS_V = 0, LDS_K = 2 * SHM_V, LDS_WS = 2 * SHM_V + 2 * SHM_K, LDS_BYTES = LDS_WS + NWAVES * 64 * 4;
constexpr float THR = 8.f, LOG2E = 1.4426950408889634f;
#define KSWZ(row, colB) ((row) * 256 + ((colB) ^ (((row) & 7) << 4)))
#define SBAR() __builtin_amdgcn_sched_barrier(0)
__device__ __forceinline__ int v_st(int k, int c) { const int kk = (k & ~0xC) | ((k & 4) << 1) | ((k & 8) >> 1); return ((kk >> 3) * 4 + (c >> 5)) * 512 + ((kk & 7) * 32 + (c & 31)) * 2; }
__device__ __forceinline__ int v_rd_base(int lane) { return ((lane & 3) << 3) | (((lane >> 2) & 3) << 6) | (((lane >> 4) & 1) << 5) | (((lane >> 5) & 1) << 8); }
constexpr int v_rd_off(int d0, int ks, int half) { return d0 * 512 + ks * 4096 + half * 2048; }
__device__ __forceinline__ int crow(int r, int hi) { return (r & 3) + 8 * (r >> 2) + 4 * hi; }
__device__ __forceinline__ bool partialSM(f32x16& p0, f32x16& p1, float& m_reg, float& mn, float& alpha) {
    float pmax = p0[0];
#pragma unroll
    for (int r = 1; r < 16; ++r) pmax = fmaxf(pmax, p0[r]);
#pragma unroll
    for (int r = 0; r < 16; ++r) pmax = fmaxf(pmax, p1[r]);
    { auto rr = __builtin_amdgcn_permlane32_swap(__float_as_uint(pmax), __float_as_uint(pmax), false, false);
      pmax = fmaxf(__uint_as_float(rr[0]), __uint_as_float(rr[1])); }
    if (__all(pmax - m_reg < -106.f)) return false;
    if (__builtin_expect(__all((pmax - m_reg) <= THR), 1)) { mn = m_reg; alpha = 1.f; }
    else { mn = fmaxf(m_reg, pmax); alpha = __builtin_amdgcn_exp2f((m_reg - mn) * LOG2E); m_reg = mn; }
    const float mnL = -mn * LOG2E;
#pragma unroll
    for (int r = 0; r < 16; ++r) p0[r] = fmaf(p0[r], LOG2E, mnL);
#pragma unroll
    for (int r = 0; r < 16; ++r) p1[r] = fmaf(p1[r], LOG2E, mnL);
#pragma unroll
    for (int r = 0; r < 16; ++r) p0[r] = __builtin_amdgcn_exp2f(p0[r]);
    return true;
}
__device__ __forceinline__ void finishSM(f32x16& p0, f32x16& p1, float alpha, float& l_reg, bf16x8& pa0, bf16x8& pa1, bf16x8& pa2, bf16x8& pa3) {
#pragma unroll
    for (int r = 0; r < 16; ++r) p1[r] = __builtin_amdgcn_exp2f(p1[r]);
    float ps = 0;
#pragma unroll
    for (int r = 0; r < 16; ++r) ps += p0[r];
#pragma unroll
    for (int r = 0; r < 16; ++r) ps += p1[r];
    { auto rr = __builtin_amdgcn_permlane32_swap(__float_as_uint(ps), __float_as_uint(ps), false, false);
      ps = __uint_as_float(rr[0]) + __uint_as_float(rr[1]); }
    l_reg = l_reg * alpha + ps;
#define PK4(P, B_, OUT) do { unsigned a0 = cvt_pk_bf16(P[B_+0], P[B_+1]), a1 = cvt_pk_bf16(P[B_+2], P[B_+3]);                          \
        unsigned b0 = cvt_pk_bf16(P[B_+4], P[B_+5]), b1 = cvt_pk_bf16(P[B_+6], P[B_+7]);                                             \
        auto r0 = __builtin_amdgcn_permlane32_swap(a0, b0, false, false); auto r1 = __builtin_amdgcn_permlane32_swap(a1, b1, false, false); \
        u32x4 w = {r0[0], r1[0], r0[1], r1[1]}; OUT = __builtin_bit_cast(bf16x8, w); } while (0)
    PK4(p0, 0, pa0); PK4(p0, 8, pa1); PK4(p1, 0, pa2); PK4(p1, 8, pa3);
#undef PK4
}
template <int KB>
__device__ __forceinline__ void qkt(f32x16& p0, f32x16& p1, const LAS char* K_lds, int r32, int hi, const bf16x8* qr, bf16x8 kf0, bf16x8 kf1, bf16x8 qf) {
    const LAS char* kb[4];
#pragma unroll
    for (int dd = 0; dd < 4; ++dd) kb[dd] = K_lds + KB * SHM_K + KSWZ(r32, (dd * 16 + hi * 8) * 2);
    bf16x8 ka[2], kc[2];
    ka[0] = *(const LAS bf16x8*)(kb[0]); kc[0] = *(const LAS bf16x8*)(kb[0] + 32 * 256);
    p0 = __builtin_amdgcn_mfma_f32_32x32x16_bf16(kf0, qf, (f32x16){0.f, 0.f, 0.f, 0.f, 0.f, 0.f, 0.f, 0.f, 0.f, 0.f, 0.f, 0.f, 0.f, 0.f, 0.f, 0.f}, 0, 0, 0);
    p1 = __builtin_amdgcn_mfma_f32_32x32x16_bf16(kf1, qf, (f32x16){0.f, 0.f, 0.f, 0.f, 0.f, 0.f, 0.f, 0.f, 0.f, 0.f, 0.f, 0.f, 0.f, 0.f, 0.f, 0.f}, 0, 0, 0);
    SBAR();
#pragma unroll
    for (int d0 = 0; d0 < 8; ++d0) { const int c = d0 & 1;
        if (d0 < 7) { const LAS char* ap = kb[(d0 + 1) & 3] + ((d0 + 1) >> 2) * 128; ka[c ^ 1] = *(const LAS bf16x8*)(ap); kc[c ^ 1] = *(const LAS bf16x8*)(ap + 32 * 256); }
        p0 = __builtin_amdgcn_mfma_f32_32x32x16_bf16(ka[c], qr[d0], p0, 0, 0, 0);
        p1 = __builtin_amdgcn_mfma_f32_32x32x16_bf16(kc[c], qr[d0], p1, 0, 0, 0);
        SBAR(); }
}
template <int VB>
__device__ __forceinline__ void pv_tile(f32x16* o, int vb0, bf16x8 pa0, bf16x8 pa1, bf16x8 pa2, bf16x8 pa3) {
#define TRRD(dst, off) asm volatile("ds_read_b64_tr_b16 %0, %1 offset:%2" : "=&v"(dst) : "v"(vb0), "i"(off) : "memory")
#define PV_RD(S, d0) do { constexpr int b_ = VB * SHM_V + v_rd_off(d0, 0, 0); \
        TRRD(S[0], b_); TRRD(S[4], b_ + 2048); TRRD(S[1], b_ + 4096); TRRD(S[5], b_ + 6144); TRRD(S[2], b_ + 8192); TRRD(S[6], b_ + 10240); TRRD(S[3], b_ + 12288); TRRD(S[7], b_ + 14336); } while (0)
#define PV_MM(S, d0) do { \
        o[d0] = __builtin_amdgcn_mfma_f32_32x32x16_bf16(pa0, (bf16x8){S[0][0], S[0][1], S[0][2], S[0][3], S[4][0], S[4][1], S[4][2], S[4][3]}, o[d0], 0, 0, 0);   \
        o[d0] = __builtin_amdgcn_mfma_f32_32x32x16_bf16(pa1, (bf16x8){S[1][0], S[1][1], S[1][2], S[1][3], S[5][0], S[5][1], S[5][2], S[5][3]}, o[d0], 0, 0, 0);   \
        o[d0] = __builtin_amdgcn_mfma_f32_32x32x16_bf16(pa2, (bf16x8){S[2][0], S[2][1], S[2][2], S[2][3], S[6][0], S[6][1], S[6][2], S[6][3]}, o[d0], 0, 0, 0);   \
        o[d0] = __builtin_amdgcn_mfma_f32_32x32x16_bf16(pa3, (bf16x8){S[3][0], S[3][1], S[3][2], S[3][3], S[7][0], S[7][1], S[7][2], S[7][3]}, o[d0], 0, 0, 0); } while (0)
    s16x4 A[8], B[8];
    PV_RD(A, 0);
    PV_RD(B, 1); asm volatile("s_waitcnt lgkmcnt(8)" ::: "memory"); SBAR(); PV_MM(A, 0); SBAR();
    PV_RD(A, 2); asm volatile("s_waitcnt lgkmcnt(8)" ::: "memory"); SBAR(); PV_MM(B, 1); SBAR();
    PV_RD(B, 3); asm volatile("s_waitcnt lgkmcnt(8)" ::: "memory"); SBAR(); PV_MM(A, 2); SBAR();
    asm volatile("s_waitcnt lgkmcnt(0)" ::: "memory"); SBAR(); PV_MM(B, 3);
#undef PV_RD
#undef PV_MM
#undef TRRD
}
typedef const __attribute__((address_space(4))) unsigned long long* cmask_t;
__device__ __forceinline__ void mask_tile(f32x16& p0, f32x16& p1, const unsigned long long* mpg) {
    const float NEG = -__builtin_inff();
    cmask_t mp = (cmask_t)mpg;
    asm volatile("s_nop 15\n\ts_nop 7" : "+v"(p0), "+v"(p1));
#pragma unroll
    for (int r = 0; r < 16; ++r) { const unsigned long long m0 = mp[r], m1 = mp[16 + r];
        asm volatile("v_cndmask_b32 %0, %1, %0, %2" : "+v"(p0[r]) : "v"(NEG), "s"(m0));
        asm volatile("v_cndmask_b32 %0, %1, %0, %2" : "+v"(p1[r]) : "v"(NEG), "s"(m1)); }
}
template <int BUF>
__device__ __forceinline__ void tile_step(f32x16* o, float& m_reg, float& l_reg, const LAS char* K_lds, int vb0, LAS float* al_l, int r32, int hi, const bf16x8* qr,
                                          int kb_key, bf16x8 qf, const unsigned long long* mp) {
    f32x16 p0, p1; float mn, alpha; bf16x8 pa0, pa1, pa2, pa3;
    const unsigned kbb = __float_as_uint((float)kb_key) >> 16, k0b = __float_as_uint((float)r32) >> 16, k1b = __float_as_uint((float)(r32 + 32)) >> 16;
    u32x4 f0 = {hi ? 0u : (kbb | (k0b << 16)), 0u, 0u, 0u}, f1 = {hi ? 0u : (kbb | (k1b << 16)), 0u, 0u, 0u};
    qkt<BUF>(p0, p1, K_lds, r32, hi, qr, __builtin_bit_cast(bf16x8, f0), __builtin_bit_cast(bf16x8, f1), qf);
    mask_tile(p0, p1, mp);
    if (!partialSM(p0, p1, m_reg, mn, alpha)) return;
    finishSM(p0, p1, alpha, l_reg, pa0, pa1, pa2, pa3);
    if (__any(alpha < 1.f)) { if (hi == 0) al_l[r32] = alpha; asm volatile("s_waitcnt lgkmcnt(0)" ::: "memory");
#pragma unroll
        for (int r = 0; r < 16; ++r) { const float av = al_l[crow(r, hi)];
#pragma unroll
            for (int d_ = 0; d_ < 4; ++d_) o[d_][r] *= av; } }
    pv_tile<BUF>(o, vb0, pa0, pa1, pa2, pa3);
}
__device__ __forceinline__ void attn_unit(Frame& F, const float* __restrict__ qgain, int b, int g, int qb, unsigned* done_ctr) {
    const bf16_t* Q = (const bf16_t*)(F.ws + WS_Q); const bf16_t* K = (const bf16_t*)(F.ws + WS_K); const bf16_t* V = (const bf16_t*)(F.ws + WS_V);
    unsigned char* O = F.ws + WS_ATTN;
    const unsigned long long* MT = (const unsigned long long*)(F.ws + WS_MASK);
    LAS char* lds = (LAS char*)F.lds;
    const int wid = F.wave, lane = lane_id(), tid = wid * 64 + lane, r32 = lane & 31, hi = lane >> 5;
    const int hq = wid >> 1, th = wid & 1, h = 4 * g + hq, tok0 = b * SEQ + 64 * qb + 32 * th, NT = qb + 1;
    LAS char* V_lds = lds + LDS_V; LAS char* K_lds = lds + LDS_K; LAS float* wsf = (LAS float*)(lds + LDS_WS) + wid * 64; LAS float* li_l = wsf; LAS float* al_l = wsf + 32;
    const int sr = tid >> 4, sc = (tid & 15) * 8, vst0 = v_st(sr, sc), vst1 = v_st(32 + sr, sc), kws = KSWZ(sr, sc * 2);
    const int vb0 = (int)(uintptr_t)V_lds + v_rd_base(lane);
    bf16x8 qr[8];
    {
      u32x4 qw[8]; float ss = 0.f;
#pragma unroll
      for (int d0 = 0; d0 < 8; ++d0) { qw[d0] = *(const u32x4*)(Q + (size_t)(tok0 + r32) * AW + h * HD + d0 * 16 + hi * 8);
#pragma unroll
          for (int j = 0; j < 4; ++j) { const float lo = bflo(qw[d0][j]), hv = bfhi(qw[d0][j]); ss += lo * lo + hv * hv; } }
      { auto rr = __builtin_amdgcn_permlane32_swap(__float_as_uint(ss), __float_as_uint(ss), false, false); ss = __uint_as_float(rr[0]) + __uint_as_float(rr[1]); }
      const float rq = rsqrtf(ss * (1.0f / HD) + NORM_EPS) * 0.08838834764831845f;
#pragma unroll
      for (int d0 = 0; d0 < 8; ++d0) { const f32x4 g0 = *(const f32x4*)(qgain + d0 * 16 + hi * 8), g1 = *(const f32x4*)(qgain + d0 * 16 + hi * 8 + 4); u32x4 o;
          o[0] = cvt_pk_bf16(bflo(qw[d0][0]) * rq * g0[0], bfhi(qw[d0][0]) * rq * g0[1]); o[1] = cvt_pk_bf16(bflo(qw[d0][1]) * rq * g0[2], bfhi(qw[d0][1]) * rq * g0[3]);
          o[2] = cvt_pk_bf16(bflo(qw[d0][2]) * rq * g1[0], bfhi(qw[d0][2]) * rq * g1[1]); o[3] = cvt_pk_bf16(bflo(qw[d0][3]) * rq * g1[2], bfhi(qw[d0][3]) * rq * g1[3]);
          qr[d0] = __builtin_bit_cast(bf16x8, o); } }
    const unsigned sb = __float_as_uint(__builtin_ldexpf(1.0f, -(h + 1))) >> 16;
    const u32x4 qfw = {hi ? 0u : (sb | (sb << 16)), 0u, 0u, 0u}; const bf16x8 qf = __builtin_bit_cast(bf16x8, qfw);
    const bf16_t* Kg = K + (size_t)(b * SEQ) * KVW + g * HD + sc; const bf16_t* Vg = V + (size_t)(b * SEQ) * KVW + g * HD + sc;
    const unsigned long long* mrow = MT + (size_t)__builtin_amdgcn_readfirstlane(tok0 >> 5) * 64 * 32;
    float m_reg = -1e30f, l_reg = 0.f; f32x16 o[4] = {};
    bf16x8 st_k0, st_k1, st_v0, st_v1;
#define SLOAD(k0) do { st_k0 = *(const bf16x8*)(Kg + (size_t)((k0) + sr) * KVW); st_k1 = *(const bf16x8*)(Kg + (size_t)((k0) + 32 + sr) * KVW); \
                       st_v0 = *(const bf16x8*)(Vg + (size_t)((k0) + sr) * KVW); st_v1 = *(const bf16x8*)(Vg + (size_t)((k0) + 32 + sr) * KVW); } while (0)
#define SWRITE(bf) do { *(LAS bf16x8*)(K_lds + (bf) * SHM_K + kws) = st_k0; *(LAS bf16x8*)(K_lds + (bf) * SHM_K + kws + 32 * 256) = st_k1; \
                        *(LAS bf16x8*)(V_lds + (bf) * SHM_V + vst0) = st_v0; *(LAS bf16x8*)(V_lds + (bf) * SHM_V + vst1) = st_v1; } while (0)
#define TK(u_) (NT - 1 - (u_))
    SLOAD(TK(0) * KVBLK); SWRITE(0);
    __syncthreads();
    bool signaled = false;
    for (int t = 0; t < NT; t += 2) {
        if (done_ctr && !signaled && t + 8 >= NT) { signaled = true; if (wid == 0 && lane == 0) __hip_atomic_fetch_add(done_ctr, 1u, __ATOMIC_RELAXED, __HIP_MEMORY_SCOPE_AGENT); }
        if (t + 1 < NT) SLOAD(TK(t + 1) * KVBLK);
        tile_step<0>(o, m_reg, l_reg, K_lds, vb0, al_l, r32, hi, qr, TK(t) * KVBLK, qf, mrow + (size_t)TK(t) * 32);
        if (t + 1 < NT) SWRITE(1);
        __syncthreads();
        if (t + 1 < NT) {
            if (t + 2 < NT) SLOAD(TK(t + 2) * KVBLK);
            tile_step<1>(o, m_reg, l_reg, K_lds, vb0, al_l, r32, hi, qr, TK(t + 1) * KVBLK, qf, mrow + (size_t)TK(t + 1) * 32);
            if (t + 2 < NT) SWRITE(0);
            __syncthreads();
        }
    }
#undef TK
#undef SLOAD
#undef SWRITE
    if (hi == 0) li_l[r32] = l_reg; asm volatile("s_waitcnt lgkmcnt(0)" ::: "memory");
    unsigned char* Ow = O + (size_t)tok0 * AW + h * HD;
#pragma unroll
    for (int r = 0; r < 16; ++r) { const int orow = crow(r, hi); const float rl = __builtin_amdgcn_rcpf(li_l[orow]) * (FP8_MERGE ? A8_SCALE : 1.0f);
#pragma unroll
        for (int d0 = 0; d0 < 4; ++d0) { const float v = o[d0][r] * rl; const float v1 = __shfl_xor(v, 1);
            if constexpr (FP8_MERGE) { const float v2 = __shfl_xor(v, 2), v3 = __shfl_xor(v1, 2);
                if ((r32 & 3) == 0) *(unsigned*)(Ow + (size_t)orow * AW + d0 * 32 + r32) = pk4_fp8(v, v1, v2, v3); }
            else { if ((r32 & 1) == 0) *(unsigned*)((bf16_t*)O + (size_t)(tok0 + orow) * AW + h * HD + d0 * 32 + r32) = cvt_pk_bf16(v, v1); } } }
    __syncthreads();
}
#undef KSWZ
#undef SBAR
}
struct SchedPool {
    const char* A; const char* B; int c;
    __device__ __forceinline__ bool next(int i, pg8::Unit& u) const { if (i > 0 || c >= 128) return false; const int rt = c >> 2, g = c & 3; u.pm = rt; u.pn = g; u.aux = 0; u.tok = nullptr; u.nt8 = 0;
        u.A = A + ((size_t)rt * 256 * PW + g * 256) * 2; u.B = B + (size_t)g * 65536 * 2; return true; }
};
struct EpiPool {
    unsigned char* out; const float* pscale;
    __device__ __forceinline__ bool operator()(f32x4 (&acc)[2][2][4][2], const pg8::Unit& u, int wr, int wc, int fr, int fq) const {
        const int row0 = u.pm * 256 + wr * 64 + fr, col0 = u.pn * 256 + wc * 32 + 8 * fq;
#pragma unroll
        for (int bj = 0; bj < 2; ++bj) { const f32x4 s0 = *(const f32x4*)(pscale + col0 + bj * 128), s1 = *(const f32x4*)(pscale + col0 + bj * 128 + 4);
#pragma unroll
            for (int ai = 0; ai < 2; ++ai)
#pragma unroll
                for (int m = 0; m < 4; ++m) { const size_t o = (size_t)(row0 + ai * 128 + m * 16) * PW + col0 + bj * 128;
                    if constexpr (FP8_MERGE) { const f32x4 v0 = acc[ai][bj][m][0] * s0 * A8_SCALE, v1 = acc[ai][bj][m][1] * s1 * A8_SCALE; u32x2 w; w.x = pk4_fp8(v0[0], v0[1], v0[2], v0[3]); w.y = pk4_fp8(v1[0], v1[1], v1[2], v1[3]); *(u32x2*)(out + o) = w; }
                    else st_bf16x8((bf16_t*)out + o, acc[ai][bj][m][0] * s0, acc[ai][bj][m][1] * s1); } }
        return false;
    }
};
__device__ __forceinline__ void p4_pool_attn(Frame& F, const Args& a) {
    for (int c = blockIdx.x; c < 256; c += F.G) {
        const int bg = c >> 6, qb = c & 63;
        att::attn_unit(F, a.in[I_QNORM], bg >> 1, bg & 1, qb, (c + F.G >= 256) ? F.ctl + CW_DONE + 64 * 4 : nullptr);
        if (qb < 32) { const int pu = bg * 32 + qb, rt = pu >> 2, g = pu & 3;
            pooled_item(F, rt * 256 + 32 * F.wave, g, lane_id());
            asm volatile("s_waitcnt vmcnt(0)" ::: "memory"); __syncthreads();
            SchedPool S{(const char*)(F.ws + WS_POOLED), (const char*)(F.ws + WS_PLIN), pu}; EpiPool E{F.ws + WS_POOL, a.in[I_PSCALE]};
            pg8::gemm_phase<EpiPool, SchedPool, false>(F.lds, F.wave, 256 * 2, PW * 2, S, E); __syncthreads(); }
    }
}
struct SchedMerge {
    pg8::TileOrder T; const char* A0; const char* B0; const char* A1; const char* B1;
    __device__ __forceinline__ bool next(int i, pg8::Unit& u) const { int pm, pn; if (!T.tile(i >> 1, pm, pn)) return false; u.pm = pm; u.pn = pn; u.aux = i & 1; u.tok = nullptr; u.nt8 = 0;
        u.A = ((i & 1) ? A1 : A0) + (size_t)pm * 256 * 1024 * (FP8_MERGE ? 1 : 2); u.B = ((i & 1) ? B1 : B0) + (size_t)pn * 256 * 1024 * (FP8_MERGE ? 1 : 2); return true; }
};
struct EpiMerge {
    const bf16_t* G; unsigned char* out;
    __device__ __forceinline__ bool operator()(f32x4 (&acc)[2][2][4][2], const pg8::Unit& u, int wr, int wc, int fr, int fq) const {
        const int row0 = u.pm * 256 + wr * 64 + fr, col0 = u.pn * 256 + wc * 32 + 8 * fq;
#pragma unroll
        for (int ai = 0; ai < 2; ++ai)
#pragma unroll
            for (int m = 0; m < 4; ++m) { const size_t r = (size_t)(row0 + ai * 128 + m * 16);
#pragma unroll
                for (int bj = 0; bj < 2; ++bj) { const int c = col0 + bj * 128;
                    const u32x4 gp = *(const u32x4*)(G + r * (2 * DM) + DM + c);
                    const f32x4 p0 = {bflo(gp[0]), bfhi(gp[0]), bflo(gp[1]), bfhi(gp[1])}, p1 = {bflo(gp[2]), bfhi(gp[2]), bflo(gp[3]), bfhi(gp[3])};
                    if (u.aux == 0) { const u32x4 ga = *(const u32x4*)(G + r * (2 * DM) + c);
                        const f32x4 a0 = {bflo(ga[0]), bfhi(ga[0]), bflo(ga[1]), bfhi(ga[1])}, a1 = {bflo(ga[2]), bfhi(ga[2]), bflo(ga[3]), bfhi(ga[3])};
#pragma unroll
                        for (int j = 0; j < 4; ++j) { acc[ai][bj][m][0][j] *= a0[j] * __builtin_amdgcn_rcpf(fmaxf(p0[j], 1e-30f)); acc[ai][bj][m][1][j] *= a1[j] * __builtin_amdgcn_rcpf(fmaxf(p1[j], 1e-30f)); } }
                    else { if constexpr (FP8_OUT) { const f32x4 v0 = acc[ai][bj][m][0] * p0 * A8_SCALE, v1 = acc[ai][bj][m][1] * p1 * A8_SCALE; u32x2 w; w.x = pk4_fp8(v0[0], v0[1], v0[2], v0[3]); w.y = pk4_fp8(v1[0], v1[1], v1[2], v1[3]);
                        *(u32x2*)(out + r * DM + c) = w; } else st_bf16x8((bf16_t*)out + r * DM + c, acc[ai][bj][m][0] * p0, acc[ai][bj][m][1] * p1); } } }
        return u.aux == 0;
    }
};
__device__ __forceinline__ void p5_merge(Frame& F) {
    SchedMerge S; S.T.init(NTOK, DM, F.G, (int)blockIdx.x); S.A0 = (const char*)(F.ws + WS_ATTN); S.B0 = (const char*)(F.ws + WS_WAU); S.A1 = (const char*)(F.ws + WS_POOL); S.B1 = (const char*)(F.ws + WS_WPU);
    EpiMerge E{(const bf16_t*)(F.ws + WS_G), F.ws + WS_MERGED};
    constexpr int ES = FP8_MERGE ? 1 : 2;
    pg8::gemm_phase<EpiMerge, SchedMerge, false, ES, FP8_MERGE ? A8_E8 : 127, FP8_MERGE ? W8_E8 : 127>(F.lds, F.wave, 1024 * ES, 1024 * ES, S, E);
}
struct EpiOut {
    const float* x; const float* mod; float* out;
    __device__ __forceinline__ bool operator()(f32x4 (&acc)[2][2][4][2], const pg8::Unit& u, int wr, int wc, int fr, int fq) const {
        const int row0 = u.pm * 256 + wr * 64 + fr, col0 = u.pn * 256 + wc * 32 + 8 * fq; const int b = (u.pm * 256) / SEQ;
        const float* gm = mod + b * 6 * DM + 2 * DM;
#pragma unroll
        for (int bj = 0; bj < 2; ++bj) { const int c = col0 + bj * 128; const f32x4 g0 = *(const f32x4*)(gm + c), g1 = *(const f32x4*)(gm + c + 4);
#pragma unroll
            for (int ai = 0; ai < 2; ++ai)
#pragma unroll
                for (int m = 0; m < 4; ++m) { const size_t o = (size_t)(row0 + ai * 128 + m * 16) * DM + c;
                    const f32x4 x0 = *(const f32x4*)(x + o), x1 = *(const f32x4*)(x + o + 4);
                    *(f32x4*)(out + o) = x0 + g0 * acc[ai][bj][m][0]; *(f32x4*)(out + o + 4) = x1 + g1 * acc[ai][bj][m][1]; } }
        return false;
    }
};
__device__ __forceinline__ void p6_out(Frame& F, const Args& a) {
    SchedDense S; S.T.init(NTOK, DM, F.G, (int)blockIdx.x); S.A = (const char*)(F.ws + WS_MERGED); S.B = (const char*)(F.ws + WS_WOUT);
    constexpr int ES = FP8_OUT ? 1 : 2; S.a_tile = (size_t)256 * DM * ES; S.b_tile = (size_t)256 * DM * ES;
    EpiOut E{a.in[I_X], (const float*)(F.ctl + CW_MOD), F.out};
    pg8::gemm_phase<EpiOut, SchedDense, false, ES, FP8_OUT ? A8_E8 : 127, FP8_OUT ? W8_E8 : 127>(F.lds, F.wave, DM * ES, DM * ES, S, E);
}
constexpr int P7_ROWB = 4096 + 16;
constexpr int P7_ROWS = 32, P7_RW = P7_ROWS / NWAVES;
constexpr int P7_LDS_P = P7_ROWS * P7_ROWB;
constexpr int P7_LDS_H = P7_LDS_P + 2 * P7_ROWS * 64 * 4;
__device__ __forceinline__ void p7_router(Frame& F, const Args& a) {
    const float* mod = (const float*)(F.ctl + CW_MOD);
    unsigned char* hb8 = F.ws + WS_HB; const bf16_t* Wr = (const bf16_t*)(F.ws + WS_WR);
    unsigned char* rt = F.ws + WS_ROUTE;
    int* eid = (int*)(rt + RT_EID); float* gate = (float*)(rt + RT_GATE); int* posn = (int*)(rt + RT_POS); int* list = (int*)(rt + RT_LIST); int* ident = (int*)(rt + RT_IDENT);
    unsigned* ecnt = F.ctl + CW_ECNT;
    LAS unsigned char* lds = F.lds; LAS float* P = (LAS float*)(lds + P7_LDS_P); LAS unsigned* hist = (LAS unsigned*)(lds + P7_LDS_H); LAS unsigned* baseL = hist + 64;
    const int lane = lane_id(), w = F.wave, tid = w * 64 + lane;
    if (tid < 64) hist[tid] = 0u;
    __syncthreads();
    for (int p = blockIdx.x; p < NTOK / P7_ROWS; p += F.G) {
        const int row0 = P7_ROWS * p;
        { const int b = row0 / SEQ; const float* sh = mod + b * 6 * DM + 3 * DM; const float* sl = mod + b * 6 * DM + 4 * DM;
          f32x4 v[P7_RW][8];
#pragma unroll
          for (int rr = 0; rr < P7_RW; ++rr) { const float* xrow = F.out + (size_t)(row0 + P7_RW * w + rr) * DM;
#pragma unroll
              for (int j = 0; j < 8; ++j) v[rr][j] = *(const f32x4*)(xrow + 4 * lane + 256 * j); }
          float rstd[P7_RW];
#pragma unroll
          for (int rr = 0; rr < P7_RW; ++rr) { float ss = 0.f;
#pragma unroll
              for (int j = 0; j < 8; ++j) ss += (v[rr][j].x * v[rr][j].x + v[rr][j].y * v[rr][j].y) + (v[rr][j].z * v[rr][j].z + v[rr][j].w * v[rr][j].w);
              rstd[rr] = rsqrtf(wave_sum(ss) * (1.0f / DM) + NORM_EPS); }
#pragma unroll
          for (int j = 0; j < 8; ++j) { const int c = 4 * lane + 256 * j;
              const f32x4 gg = *(const f32x4*)(a.in[I_GFFN] + c), shv = *(const f32x4*)(sh + c), slv = *(const f32x4*)(sl + c); const f32x4 mul = gg * (slv + 1.0f);
#pragma unroll
              for (int rr = 0; rr < P7_RW; ++rr) { const int lr = P7_RW * w + rr, m = row0 + lr;
                  const f32x4 o = v[rr][j] * rstd[rr] * mul + shv;
                  u32x2 wv; wv.x = cvt_pk_bf16(o.x, o.y); wv.y = cvt_pk_bf16(o.z, o.w);
                  *(unsigned*)(hb8 + (size_t)m * DM + c) = pk4_fp8(o.x * H8_SCALE, o.y * H8_SCALE, o.z * H8_SCALE, o.w * H8_SCALE); *(LAS u32x2*)(lds + lr * P7_ROWB + c * 2) = wv; } }
          if (lane < P7_RW) ident[row0 + P7_RW * w + lane] = row0 + P7_RW * w + lane;
        }
        __syncthreads();
        { const int nb = w & 3, kh = w >> 2, fr = lane & 15, kq = lane >> 4;
          f32x4 acc[2] = {{0.f, 0.f, 0.f, 0.f}, {0.f, 0.f, 0.f, 0.f}};
          const bf16_t* wp = Wr + (size_t)(16 * nb + fr) * DM + 1024 * kh + 8 * kq;
          const LAS unsigned char* ap = lds + fr * P7_ROWB + (1024 * kh + 8 * kq) * 2;
#pragma unroll 8
          for (int s = 0; s < 32; ++s) { const bf16x8 bv = *(const bf16x8*)(wp + 32 * s);
#pragma unroll
              for (int mb = 0; mb < 2; ++mb) { const bf16x8 av = *(const LAS bf16x8*)(ap + mb * 16 * P7_ROWB + 64 * s); acc[mb] = __builtin_amdgcn_mfma_f32_16x16x32_bf16(av, bv, acc[mb], 0, 0, 0); } }
#pragma unroll
          for (int mb = 0; mb < 2; ++mb)
#pragma unroll
              for (int j = 0; j < 4; ++j) P[(kh * P7_ROWS + 16 * mb + 4 * kq + j) * 64 + 16 * nb + fr] = acc[mb][j];
        }
        __syncthreads();
        int myrank[P7_RW]; unsigned mylocal[P7_RW]; bool chosen[P7_RW]; float mygate[P7_RW];
#pragma unroll
        for (int rr = 0; rr < P7_RW; ++rr) { const int lr = P7_RW * w + rr;
            const float logit = P[lr * 64 + lane] + P[(P7_ROWS + lr) * 64 + lane];
            const float score = 1.0f / (1.0f + __expf(-logit)); const float sel = score + a.in[I_RBIAS][lane];
            float m1 = sel; m1 = fmaxf(m1, __shfl_xor(m1, 1)); m1 = fmaxf(m1, __shfl_xor(m1, 2)); m1 = fmaxf(m1, __shfl_xor(m1, 4));
            const unsigned long long bm = __ballot(sel == m1); const unsigned grp = (unsigned)((bm >> (lane & ~7)) & 0xffull); const int first = __builtin_ctz(grp | 0x100u);
            float m2 = ((lane & 7) == first) ? -__builtin_inff() : sel; m2 = fmaxf(m2, __shfl_xor(m2, 1)); m2 = fmaxf(m2, __shfl_xor(m2, 2)); m2 = fmaxf(m2, __shfl_xor(m2, 4));
            const float gs = m1 + m2; const int g = lane >> 3; int grank = 0;
#pragma unroll
            for (int g2 = 0; g2 < 8; ++g2) { const float o = __uint_as_float(__builtin_amdgcn_readlane(__float_as_uint(gs), 8 * g2)); grank += (o > gs || (o == gs && g2 < g)) ? 1 : 0; }
            const float selm = grank < TOPG ? sel : -__builtin_inff(); int rank = 0;
#pragma unroll
            for (int e2 = 0; e2 < 64; ++e2) { const float o = __uint_as_float(__builtin_amdgcn_readlane(__float_as_uint(selm), e2)); rank += (o > selm || (o == selm && e2 < lane)) ? 1 : 0; }
            const bool ch = rank < ETOP && grank < TOPG; const float gsum = wave_sum(ch ? score : 0.f);
            chosen[rr] = ch; myrank[rr] = rank; mygate[rr] = score / gsum * ROUTED_SCALE;
            mylocal[rr] = ch ? __hip_atomic_fetch_add(hist + lane, 1u, __ATOMIC_RELAXED, __HIP_MEMORY_SCOPE_WORKGROUP) : 0u;
        }
        __syncthreads();
        if (w == 0) { const unsigned c = hist[lane]; baseL[lane] = c ? __hip_atomic_fetch_add(ecnt + lane, c, __ATOMIC_RELAXED, __HIP_MEMORY_SCOPE_AGENT) : 0u; hist[lane] = 0u; }
        __syncthreads();
#pragma unroll
        for (int rr = 0; rr < P7_RW; ++rr) if (chosen[rr]) { const int m = row0 + P7_RW * w + rr; const unsigned pos = baseL[lane] + mylocal[rr];
            eid[m * 8 + myrank[rr]] = lane; gate[m * 8 + myrank[rr]] = mygate[rr]; posn[m * 8 + myrank[rr]] = (int)pos; list[(size_t)lane * NTOK + pos] = m; }
        __syncthreads();
    }
}
constexpr int MOE_LDS = 131072;
__device__ __forceinline__ int moe_prefix(Frame& F) {
    LAS int* rtoff = (LAS int*)(F.lds + MOE_LDS);
    if (F.wave == 0 && lane_id() == 0) { int s = 0; for (int e = 0; e < NE; ++e) { rtoff[e] = s; unsigned n = F.ctl[CW_ECNT + e]; if (n > (unsigned)NTOK) n = NTOK; s += (int)((n + 255u) >> 8); } rtoff[NE] = s; }
    __syncthreads();
    return __builtin_amdgcn_readfirstlane(rtoff[NE]);
}
__device__ __forceinline__ int moe_find(const LAS int* rtoff, int rtg) {
    int lo = 0, hi = NE;
#pragma unroll
    for (int it = 0; it < 6; ++it) { const int mid = (lo + hi) >> 1; const int v = __builtin_amdgcn_readfirstlane(rtoff[mid]); if (v <= rtg) lo = mid; else hi = mid; }
    return lo;
}
struct SchedMoe1 {
    const LAS int* rtoff; int RT, G, c; const char* hb; const char* w13; const char* ws13; const int* list; const int* ident;
    __device__ __forceinline__ bool next(int i, pg8::Unit& u) const {
        const int idx = i * G + c; if (idx >= (RT + NTOK / 256) * 4) return false;
        const int rtg = idx >> 2, ct = idx & 3; u.pn = ct; u.aux = 0; u.nt8 = 0; u.A = hb;
        if (rtg < RT) { const int e = moe_find(rtoff, rtg), rt = rtg - __builtin_amdgcn_readfirstlane(rtoff[e]); u.pm = rtg; u.tok = list + (size_t)e * NTOK + rt * 256;
            u.B = w13 + ((size_t)e * 1024 + ct * 256) * DM; }
        else { const int rt = rtg - RT; u.pm = HROWS_R / 256 + rt; u.tok = ident + rt * 256; u.B = ws13 + (size_t)(ct * 256) * DM; }
        return true; }
};
struct EpiMoe1 {
    unsigned char* H;
    __device__ __forceinline__ bool operator()(f32x4 (&acc)[2][2][4][2], const pg8::Unit& u, int wr, int wc, int fr, int fq) const {
        const int row0 = u.pm * 256 + wr * 64 + fr, col0 = u.pn * 128 + wc * 32 + 8 * fq;
#pragma unroll
        for (int ai = 0; ai < 2; ++ai)
#pragma unroll
            for (int m = 0; m < 4; ++m) { f32x4 h0, h1;
#pragma unroll
                for (int j = 0; j < 4; ++j) { const float g0 = acc[ai][0][m][0][j], g1 = acc[ai][0][m][1][j];
                    h0[j] = g0 * __builtin_amdgcn_rcpf(1.0f + __expf(-g0)) * acc[ai][1][m][0][j]; h1[j] = g1 * __builtin_amdgcn_rcpf(1.0f + __expf(-g1)) * acc[ai][1][m][1][j]; }
                u32x2 w; w.x = pk4_fp8(h0[0] * H8_SCALE, h0[1] * H8_SCALE, h0[2] * H8_SCALE, h0[3] * H8_SCALE); w.y = pk4_fp8(h1[0] * H8_SCALE, h1[1] * H8_SCALE, h1[2] * H8_SCALE, h1[3] * H8_SCALE);
                *(u32x2*)(H + (size_t)(row0 + ai * 128 + m * 16) * EH + col0) = w; }
        return false;
    }
};
__device__ __forceinline__ void p8_gemm1(Frame& F, const Args& a) {
    const int RT = moe_prefix(F);
    const int U = (RT + NTOK / 256) * 4, R0 = (U + F.G - 1) / F.G, R = (R0 * F.G - U < 24 * R0) ? R0 + 1 : R0, NG = (U + R - 1) / R;
    if ((int)blockIdx.x >= NG) { conv_drain<false, 1, 2>(F, a, 8); return; }
    SchedMoe1 S{(const LAS int*)(F.lds + MOE_LDS), RT, NG, (int)blockIdx.x, (const char*)(F.ws + WS_HB), (const char*)(F.ws + WS_W13), (const char*)(F.ws + WS_WS13),
                (const int*)(F.ws + WS_ROUTE + RT_LIST), (const int*)(F.ws + WS_ROUTE + RT_IDENT)};
    EpiMoe1 E{F.ws + WS_H};
    pg8::gemm_phase<EpiMoe1, SchedMoe1, true, 1, H8_E8, W8_E8>(F.lds, F.wave, DM, DM, S, E);
    conv_drain<false, 1, 2>(F, a, 8);
}
struct SchedMoe2 {
    const LAS int* rtoff; int RT, G, c; const char* H; const char* w2; const char* ws2;
    __device__ __forceinline__ bool next(int i, pg8::Unit& u) const {
        const int idx = i * G + c; if (idx >= (RT + NTOK / 256) * 8) return false;
        const int rtg = idx >> 3, ct = idx & 7; u.pn = ct; u.aux = 0; u.tok = nullptr; u.nt8 = 0;
        if (rtg < RT) { const int e = moe_find(rtoff, rtg); u.pm = rtg; u.B = w2 + ((size_t)e * DM + ct * 256) * EH; }
        else { u.pm = HROWS_R / 256 + (rtg - RT); u.B = ws2 + (size_t)(ct * 256) * EH; }
        u.A = H + (size_t)u.pm * 256 * EH; return true; }
};
constexpr float Y8_SCALE = 8.f;
struct EpiY {
    unsigned char* Y;
    __device__ __forceinline__ bool operator()(f32x4 (&acc)[2][2][4][2], const pg8::Unit& u, int wr, int wc, int fr, int fq) const {
        const int row0 = u.pm * 256 + wr * 64 + fr, col0 = u.pn * 256 + wc * 32 + 8 * fq;
#pragma unroll
        for (int ai = 0; ai < 2; ++ai)
#pragma unroll
            for (int m = 0; m < 4; ++m)
#pragma unroll
                for (int bj = 0; bj < 2; ++bj) { const f32x4 v0 = acc[ai][bj][m][0] * Y8_SCALE, v1 = acc[ai][bj][m][1] * Y8_SCALE; u32x2 w; w.x = pk4_fp8(v0[0], v0[1], v0[2], v0[3]); w.y = pk4_fp8(v1[0], v1[1], v1[2], v1[3]);
                    *(u32x2*)(Y + (size_t)(row0 + ai * 128 + m * 16) * DM + col0 + bj * 128) = w; }
        return false;
    }
};
__device__ __forceinline__ void p9_gemm2(Frame& F) {
    const int RT = moe_prefix(F);
    SchedMoe2 S{(const LAS int*)(F.lds + MOE_LDS), RT, F.G, (int)blockIdx.x, (const char*)(F.ws + WS_H), (const char*)(F.ws + WS_W2), (const char*)(F.ws + WS_WS2)};
    EpiY E{F.ws + WS_Y};
    pg8::gemm_phase<EpiY, SchedMoe2, false, 1, H8_E8, W8_E8>(F.lds, F.wave, EH, EH, S, E);
}
__device__ __forceinline__ void fp8x16_fma(f32x4 (&s)[4], const u32x4 y, float g) {
#pragma unroll
    for (int t = 0; t < 4; ++t) { const f32x2 lo = __builtin_amdgcn_cvt_pk_f32_fp8((int)y[t], false), hi = __builtin_amdgcn_cvt_pk_f32_fp8((int)y[t], true);
        s[t][0] += lo[0] * g; s[t][1] += lo[1] * g; s[t][2] += hi[0] * g; s[t][3] += hi[1] * g; }
}
__device__ __forceinline__ void p10_combine(Frame& F) {
    (void)moe_prefix(F);
    const LAS int* rtoff = (const LAS int*)(F.lds + MOE_LDS);
    const unsigned char* Y = F.ws + WS_Y; unsigned char* rt = F.ws + WS_ROUTE;
    const int* eid = (const int*)(rt + RT_EID); const float* gate = (const float*)(rt + RT_GATE); const int* posn = (const int*)(rt + RT_POS); const float* mod = (const float*)(F.ctl + CW_MOD);
    const int lane = lane_id();
    size_t yr[9]; float g[9]; u32x4 yv[9][2];
#define P10_ROUTE(t_) do { const u32x4 e0 = *(const u32x4*)(eid + (t_) * 8), e1 = *(const u32x4*)(eid + (t_) * 8 + 4), p0 = *(const u32x4*)(posn + (t_) * 8), p1 = *(const u32x4*)(posn + (t_) * 8 + 4); \
        const f32x4 g0 = *(const f32x4*)(gate + (t_) * 8), g1 = *(const f32x4*)(gate + (t_) * 8 + 4); \
        _Pragma("unroll") for (int k = 0; k < 8; ++k) { const int e = __builtin_amdgcn_readfirstlane((int)(k < 4 ? e0[k & 3] : e1[k & 3])) & 63, p = __builtin_amdgcn_readfirstlane((int)(k < 4 ? p0[k & 3] : p1[k & 3])); \
            yr[k] = (size_t)(256 * __builtin_amdgcn_readfirstlane(rtoff[e]) + p) * DM; g[k] = __uint_as_float(__builtin_amdgcn_readfirstlane(__float_as_uint(k < 4 ? g0[k & 3] : g1[k & 3]))); } \
        yr[8] = (size_t)(HROWS_R + (t_)) * DM; g[8] = 1.0f; } while (0)
#define P10_YLOAD() do { _Pragma("unroll") for (int k = 0; k < 9; ++k) { yv[k][0] = __builtin_nontemporal_load((const u32x4*)(Y + yr[k] + 32 * lane)); yv[k][1] = __builtin_nontemporal_load((const u32x4*)(Y + yr[k] + 32 * lane + 16)); } } while (0)
    int t = F.gw;
    if (t < NTOK) { P10_ROUTE(t); P10_YLOAD(); }
    for (; t < NTOK; t += F.NGW) {
        const int b = t / SEQ; const float* gf = mod + b * 6 * DM + 5 * DM + 32 * lane;
        float* orow = F.out + (size_t)t * DM + 32 * lane;
        f32x4 xv[8];
#pragma unroll
        for (int j = 0; j < 8; ++j) xv[j] = *(const f32x4*)(orow + 4 * j);
        f32x4 s[8];
#pragma unroll
        for (int j = 0; j < 8; ++j) s[j] = (f32x4){0.f, 0.f, 0.f, 0.f};
#pragma unroll
        for (int k = 0; k < 9; ++k) { f32x4 (&s0)[4] = *(f32x4 (*)[4])&s[0]; f32x4 (&s1)[4] = *(f32x4 (*)[4])&s[4]; fp8x16_fma(s0, yv[k][0], g[k]); fp8x16_fma(s1, yv[k][1], g[k]); }
        const int tn = t + F.NGW;
        if (tn < NTOK) { P10_ROUTE(tn); P10_YLOAD(); }
#pragma unroll
        for (int j = 0; j < 8; ++j) *(f32x4*)(orow + 4 * j) = xv[j] + *(const f32x4*)(gf + 4 * j) * s[j] * (1.0f / Y8_SCALE);
    }
#undef P10_ROUTE
#undef P10_YLOAD
}
constexpr int LDS_BYTES = 155648;
constexpr int N_PHASES = 11;
#ifndef PROBE_REP
#define PROBE_REP -1
#endif
#define REP(k, stmt) do { stmt; if (PROBE_REP == (k)) { __syncthreads(); stmt; } } while (0)
__global__ void __launch_bounds__(NTHR, 2) fwd(Args args) {
    extern __shared__ __attribute__((aligned(16))) unsigned char lds_raw[];
    Frame F; F.lds = (LAS unsigned char*)lds_raw; F.wave = __builtin_amdgcn_readfirstlane((int)threadIdx.x >> 6);
    F.G = gridDim.x; F.gw = blockIdx.x * NWAVES + F.wave; F.NGW = F.G * NWAVES; F.ws = args.ws; F.ctl = (unsigned*)(args.ws + WS_CTL); F.out = args.out;
    volatile LAS unsigned* xbw = (volatile LAS unsigned*)(F.lds + LDS_BYTES - 16);
    if (threadIdx.x < 4) xbw[threadIdx.x] = 0u;
    __syncthreads();
    const bool one = (args.ph_hi - args.ph_lo) > 1;
    XcdBarrier bar; bar.bar = F.ctl + CW_BAR; bar.x = 0; bar.st = xbw;
    if (one) bar = xcd_barrier_post(F.ctl + CW_BAR, xbw, F.wave);
    const int lo = args.ph_lo, hi = args.ph_hi;
#ifndef PROBE_TIME
#define PROBE_TIME -1
#endif
    unsigned long long pt0 = 0ull, pt1 = 0ull;
#define TSTAMP(k, which) do { if (PROBE_TIME == (k) && blockIdx.x == 0) { if (which) pt1 = __builtin_amdgcn_s_memrealtime(); else pt0 = __builtin_amdgcn_s_memrealtime(); } } while (0)
#define IN(k) (lo <= (k) && (k) < hi)
#define SEAM(k) do { if (IN(k) && IN((k) + 1)) xcd_barrier(bar, F.wave); } while (0)
    TSTAMP(0, 0); if (IN(0)) { REP(0, p0_prologue(F, args)); } SEAM(0); TSTAMP(0, 1);
    TSTAMP(1, 0); if (IN(1)) { REP(1, p1_h(F, args)); } SEAM(1); TSTAMP(1, 1);
    TSTAMP(2, 0); if (IN(2)) { REP(2, p2_inproj(F, args)); } SEAM(2); TSTAMP(2, 1);
    TSTAMP(3, 0); if (IN(3)) { p3_qknorm(F, args); __syncthreads(); REP(3, p3_indexer(F, args)); } SEAM(3); TSTAMP(3, 1);
    TSTAMP(4, 0); if (IN(4)) { REP(4, p4_pool_attn(F, args)); if (one) { conv_drain<true, 0, 2>(F, args, 4); } } SEAM(4); TSTAMP(4, 1);
    TSTAMP(5, 0); if (IN(5)) { REP(5, p5_merge(F)); } SEAM(5); TSTAMP(5, 1);
    TSTAMP(6, 0); if (IN(6)) { REP(6, p6_out(F, args)); } SEAM(6); TSTAMP(6, 1);
    TSTAMP(7, 0); if (IN(7)) { p7_router(F, args); conv_drain<false, 0, 1>(F, args, 7); }
    SEAM(7); TSTAMP(7, 1);
    TSTAMP(8, 0); if (IN(8)) { REP(8, p8_gemm1(F, args)); } SEAM(8); TSTAMP(8, 1);
    TSTAMP(9, 0); if (IN(9)) { REP(9, p9_gemm2(F)); } SEAM(9); TSTAMP(9, 1);
    TSTAMP(10, 0); if (IN(10)) { p10_combine(F); } TSTAMP(10, 1);
    if (PROBE_TIME >= 0 && blockIdx.x == 0) { const unsigned long long tend = __builtin_amdgcn_s_memrealtime() + 4ull * (pt1 - pt0); while (__builtin_amdgcn_s_memrealtime() < tend) __builtin_amdgcn_s_sleep(8); }
#undef IN
#undef SEAM
}
#ifndef N_LAUNCHES
#define N_LAUNCHES 1
#endif
extern "C" void kernel_launch(void* const* d_in, const int* in_sizes, int n_in, void* d_out, int out_size, void* d_ws, size_t ws_size, hipStream_t stream) {
    static int grid = 0;
    if (grid == 0) {
        if (n_in != 22 || out_size != NTOK * DM || ws_size < WS_END) { fprintf(stderr, "kernel_launch: unexpected shapes (n_in %d out %d ws %zu need %zu)\n", n_in, out_size, ws_size, (size_t)WS_END); grid = -1; return; }
        int dev = 0, cus = 0, per_cu = 0;
        if (hipGetDevice(&dev) != hipSuccess || hipDeviceGetAttribute(&cus, hipDeviceAttributeMultiprocessorCount, dev) != hipSuccess) { grid = -1; return; }
        if (hipFuncSetAttribute((const void*)fwd, hipFuncAttributeMaxDynamicSharedMemorySize, LDS_BYTES) != hipSuccess) { fprintf(stderr, "kernel_launch: hipFuncSetAttribute failed\n"); grid = -1; return; }
        if (hipOccupancyMaxActiveBlocksPerMultiprocessor(&per_cu, (const void*)fwd, NTHR, LDS_BYTES) != hipSuccess || per_cu < 1) fprintf(stderr, "kernel_launch: occupancy query says %d\n", per_cu);
        (void)hipGetLastError();
        grid = cus;
    }
    if (grid < 0) return;
    (void)hipMemsetAsync((char*)d_ws + WS_CTL, 0, CTL_BYTES, stream);
    Args a{};
    for (int i = 0; i < 22; ++i) a.in[i] = (const float*)d_in[i];
    a.out = (float*)d_out; a.ws = (unsigned char*)d_ws;
    if (N_LAUNCHES == 1) { a.ph_lo = 0; a.ph_hi = N_PHASES; hipLaunchKernelGGL(fwd, dim3(grid), dim3(NTHR), LDS_BYTES, stream, a); }
    else for (int p = 0; p < N_PHASES; ++p) { a.ph_lo = p; a.ph_hi = p + 1; hipLaunchKernelGGL(fwd, dim3(grid), dim3(NTHR), LDS_BYTES, stream, a); }
}
```

```cpp
#include <hip/hip_runtime.h>
#include <cstdio>
#include <cstdint>

#define LAS __attribute__((address_space(3)))
#define GAS __attribute__((address_space(1)))
typedef unsigned short bf16_t;
typedef short bf16x8 __attribute__((ext_vector_type(8)));
typedef short s16x4 __attribute__((ext_vector_type(4)));
typedef float f32x4 __attribute__((ext_vector_type(4)));
typedef float f32x2 __attribute__((ext_vector_type(2)));
typedef float f32x16 __attribute__((ext_vector_type(16)));
typedef unsigned u32x4 __attribute__((ext_vector_type(4)));
typedef unsigned u32x2 __attribute__((ext_vector_type(2)));

constexpr int DM = 2048, NB = 2, SEQ = 4096, NTOK = NB * SEQ;
constexpr int NH = 8, HD = 128, NKV = 2, AW = 1024, KVW = 256, IH = 16, ID = 64, TOPK = 256;
constexpr int PW = 1024, INW = 7760, INP = 7936;
constexpr int NE = 64, EH = 512, NGRP = 8, EPG = 8, TOPG = 4, ETOP = 8;
constexpr float NORM_EPS = 1e-6f, ROUTED_SCALE = 2.5f;
constexpr int NTHR = 512, NWAVES = 8;

constexpr size_t MiB = 1u << 20;
constexpr size_t WS_CTL = 0, CTL_BYTES = 1 * MiB;
constexpr size_t WS_W13 = 1 * MiB;
constexpr size_t WS_W2 = WS_W13 + 256 * MiB;
constexpr size_t WS_WS13 = WS_W2 + 128 * MiB;
constexpr size_t WS_WS2 = WS_WS13 + 4 * MiB;
constexpr size_t WS_H = WS_WS2 + 2 * MiB;
constexpr int HROWS_R = 65536 + 64 * 256, HROWS = HROWS_R + NTOK;
constexpr size_t WS_ROUTE = WS_H + (size_t)HROWS * EH * 2;
constexpr size_t RT_EID = 0, RT_GATE = RT_EID + (size_t)NTOK * 8 * 4, RT_POS = RT_GATE + (size_t)NTOK * 8 * 4, RT_LIST = RT_POS + (size_t)NTOK * 8 * 4,
                 RT_IDENT = RT_LIST + (size_t)NE * NTOK * 4, RT_END = RT_IDENT + (size_t)NTOK * 4;
constexpr size_t WS_R = (WS_ROUTE + RT_END + MiB - 1) / MiB * MiB;
constexpr size_t WS_Y = WS_R;
constexpr size_t WS_WIN = WS_R;
constexpr size_t WS_WAU = WS_WIN + 31 * MiB, WS_WPU = WS_WAU + 4 * MiB, WS_WOUT = WS_WPU + 4 * MiB, WS_PLIN = WS_WOUT + 8 * MiB, WS_WR = WS_PLIN + MiB / 2;
constexpr size_t WS_HB = WS_WR + MiB / 2;
constexpr size_t WS_Q = WS_HB + 32 * MiB, WS_K = WS_Q + 16 * MiB, WS_V = WS_K + 4 * MiB, WS_QI = WS_V + 4 * MiB, WS_KW = WS_QI + 16 * MiB, WS_U = WS_KW + 4 * MiB,
                 WS_G = WS_U + 16 * MiB;
constexpr size_t WS_POOLED = WS_G + 64 * MiB, WS_POOL = WS_POOLED + 16 * MiB, WS_ATTN = WS_POOL + 16 * MiB, WS_MERGED = WS_ATTN + 16 * MiB, WS_MASK = WS_MERGED + 32 * MiB,
                 WS_H8 = WS_MASK + 4 * MiB,
                 WS_REND = WS_H8 + 32 * MiB;
constexpr size_t WS_END = WS_Y + (size_t)HROWS_R * DM * 2;
static_assert(WS_REND <= WS_END, "overlay region");
constexpr int CW_BAR = 4096;
constexpr int CW_ECNT = 8192;
constexpr int CW_CONVQ = 12288;
constexpr int CW_DONE = 12544;
constexpr int CW_MOD = 16384;
static_assert((CW_MOD + 2 * 6 * DM) * 4 <= (int)CTL_BYTES, "ctl");

__device__ __forceinline__ int lane_id() { int l; asm volatile("v_mbcnt_lo_u32_b32 %0, -1, 0\n\tv_mbcnt_hi_u32_b32 %0, -1, %0" : "=v"(l)); return l; }
__device__ __forceinline__ unsigned cvt_pk_bf16(float lo, float hi) { unsigned r; asm volatile("v_cvt_pk_bf16_f32 %0, %1, %2" : "=v"(r) : "v"(lo), "v"(hi)); return r; }
__device__ __forceinline__ unsigned pk4_fp8(float a, float b, float c, float d) {
    a = __builtin_amdgcn_fmed3f(a, -448.f, 448.f); b = __builtin_amdgcn_fmed3f(b, -448.f, 448.f); c = __builtin_amdgcn_fmed3f(c, -448.f, 448.f); d = __builtin_amdgcn_fmed3f(d, -448.f, 448.f);
    int w = __builtin_amdgcn_cvt_pk_fp8_f32(a, b, 0, false); w = __builtin_amdgcn_cvt_pk_fp8_f32(c, d, w, true); return (unsigned)w; }
#ifndef FP8_INPROJ
#define FP8_INPROJ 0
#endif
#ifndef FP8_MERGE
#define FP8_MERGE 1
#endif
#ifndef FP8_OUT
#define FP8_OUT 1
#endif
constexpr float W8_SCALE = 8.f;   constexpr int W8_E8 = 127 - 3;
constexpr float H8_SCALE = 8.f;   constexpr int H8_E8 = 127 - 3;
constexpr float A8_SCALE = 8.f;   constexpr int A8_E8 = 127 - 3;
__device__ __forceinline__ float bf2f(unsigned short b) { return __uint_as_float(((unsigned)b) << 16); }
__device__ __forceinline__ float bflo(unsigned w) { return __uint_as_float(w << 16); }
__device__ __forceinline__ float bfhi(unsigned w) { return __uint_as_float(w & 0xffff0000u); }
__device__ __forceinline__ float wave_sum(float v) {
#pragma unroll
    for (int o = 1; o < 64; o <<= 1) v += __shfl_xor(v, o);
    return v;
}
__device__ __forceinline__ float sigmoidf_(float x) { return 1.0f / (1.0f + __expf(-x)); }

#define XB_TMO      128
#define XB_XCNT(j)  (256  + 64 * (j))
#define XB_XSUB(j)  (1280 + 64 * (j))
#define XB_XGEN(j)  (2304 + 64 * (j))
#define XB_TOP      3328
#define XB_TOPGEN   3392
#define XCD_BAR_WORDS 3456
#define XB_SPIN_CAP (1u << 18)
__device__ __forceinline__ unsigned xb_ld(unsigned* p)              { return __hip_atomic_load(p, __ATOMIC_RELAXED, __HIP_MEMORY_SCOPE_AGENT); }
__device__ __forceinline__ unsigned xb_add(unsigned* p, unsigned v) { return __hip_atomic_fetch_add(p, v, __ATOMIC_RELAXED, __HIP_MEMORY_SCOPE_AGENT); }
__device__ __forceinline__ unsigned xb_xcc_id() { return (unsigned)__builtin_amdgcn_s_getreg((3 << 11) | 20) & 0xFu; }
#define XB_SPIN(cond, bar) do { unsigned _sp = 0; while (cond) { __builtin_amdgcn_s_sleep(1); \
    if ((++_sp & 255u) == 0u) { if (xb_ld(&(bar)[XB_TMO])) break; if (_sp > XB_SPIN_CAP) { atomicAdd(&(bar)[XB_TMO], 1u); break; } } } } while (0)
struct XcdBarrier { unsigned* bar; unsigned x; volatile LAS unsigned* st; };
__device__ __forceinline__ XcdBarrier xcd_barrier_post(unsigned* bar, volatile LAS unsigned* st, int wave) {
    XcdBarrier b; b.bar = bar; b.x = xb_xcc_id(); b.st = st;
    if (wave == 0 && lane_id() == 0) (void)xb_add(&bar[XB_XCNT(b.x)], 1u);
    return b;
}
__device__ __forceinline__ void xcd_barrier_complete(unsigned* bar, unsigned x, unsigned& nloc, unsigned& nx) {
    const unsigned G = gridDim.x * gridDim.y * gridDim.z;
    unsigned sum, cnt, mine, sp = 0u;
    for (;;) {
        sum = 0u; cnt = 0u; mine = 0u;
#pragma unroll
        for (unsigned j = 0; j < 16; ++j) { const unsigned c = xb_ld(&bar[XB_XCNT(j)]); sum += c; cnt += (c > 0u) ? 1u : 0u; mine = (j == x) ? c : mine; }
        if (sum == G) break;
        __builtin_amdgcn_s_sleep(1);
        if ((++sp & 255u) == 0u) { if (xb_ld(&bar[XB_TMO])) break; if (sp > XB_SPIN_CAP) { atomicAdd(&bar[XB_TMO], 1u); break; } }
    }
    nloc = mine > 0u ? mine : 1u; nx = cnt > 0u ? cnt : 1u;
}
__device__ __forceinline__ void xcd_barrier(const XcdBarrier& b, int wave) {
    asm volatile("s_waitcnt vmcnt(0)" ::: "memory");
    __syncthreads();
    if (wave == 0 && lane_id() == 0) {
        unsigned* bar = b.bar;
        __builtin_amdgcn_s_waitcnt(0);
        unsigned nloc = b.st[0], nx = b.st[1];
        if (nloc == 0u) { xcd_barrier_complete(bar, b.x, nloc, nx); b.st[0] = nloc; b.st[1] = nx; }
        const unsigned old = xb_add(&bar[XB_XSUB(b.x)], 1u);
        const unsigned gen = old / nloc;
        if (old + 1u == (gen + 1u) * nloc) {
            __builtin_amdgcn_fence(__ATOMIC_RELEASE, "agent");
            asm volatile("s_waitcnt vmcnt(0)" ::: "memory");
            const unsigned og = xb_add(&bar[XB_TOP], 1u);
            const unsigned tg = og / nx;
            if (og + 1u == (tg + 1u) * nx) xb_add(&bar[XB_TOPGEN], 1u);
            else XB_SPIN(xb_ld(&bar[XB_TOPGEN]) == tg, bar);
            __builtin_amdgcn_fence(__ATOMIC_ACQUIRE, "agent");
            xb_add(&bar[XB_XGEN(b.x)], 1u);
            asm volatile("s_waitcnt vmcnt(0)" ::: "memory");
        } else {
            XB_SPIN(xb_ld(&bar[XB_XGEN(b.x)]) == gen, bar);
            __builtin_amdgcn_fence(__ATOMIC_ACQUIRE, "agent");
            asm volatile("s_waitcnt vmcnt(0)" ::: "memory");
        }
    }
    __syncthreads();
}
namespace pg8 {
constexpr int BM = 256, BK = 64, HALF = 128, HTB = HALF * BK * 2, STAGE_BYTES = 8 * HTB, NXCD = 8, WGM = 8;
__host__ __device__ __forceinline__ int lds_byte(int r, int c) { const int st = (r >> 4) * 2 + (c >> 5), rr = r & 15, cc = c & 31, ob = rr * 64 + cc * 2; return st * 1024 + (ob ^ (((ob >> 9) & 1) << 5)); }
__host__ __device__ __forceinline__ void stage_rc(int b, int& R, int& C) { const int st = b / 1024, sb = b % 1024, swz = sb ^ (((sb >> 9) & 1) << 5); R = (st >> 1) * 16 + swz / 64; C = (st & 1) * 32 + (swz % 64) / 2; }
__host__ __device__ __forceinline__ int perm32(int rho) { const int n = rho >> 4, i = rho & 15; return 8 * (i >> 2) + 4 * n + (i & 3); }

struct Unit { const char* A; const char* B; const int* tok; int pm, pn, aux; int nt8; };

struct TileOrder {
    int nM, nN, nwg, G, c;
    __device__ void init(int M, int N, int G_, int c_) { nM = M / BM; nN = N / BM; nwg = nM * nN; G = G_; c = c_; }
    __device__ bool tile(int i, int& pm, int& pn) const {
        const long L = (long)i * G + c; if (L >= nwg) return false;
        int wgid = (int)L; { const int q = nwg / NXCD, r = nwg % NXCD, xcd = wgid % NXCD, off = wgid / NXCD; wgid = (xcd < r ? xcd * (q + 1) : r * (q + 1) + (xcd - r) * q) + off; }
        const int nig = WGM * nN, gid = wgid / nig, fm = gid * WGM, gsz = (nM - fm) < WGM ? (nM - fm) : WGM;
        pm = fm + ((wgid % nig) % gsz); pn = (wgid % nig) / gsz; return true;
    }
};

typedef int i32x8 __attribute__((ext_vector_type(8)));
template <class Epi, class Sched, bool GATHER, int ES = 2, int SCA = 127, int SCB = 127, bool MIXED = false>
__device__ __forceinline__ void gemm_phase(LAS unsigned char* lds, const int wid, const int Kb, const int ldab, const Sched& S, const Epi& E, const int nt_ovr = 0) {
    const int lane = lane_id(), tid = wid * 64 + lane, wr = wid >> 2, wc = wid & 3, fr = lane & 15, fq = lane >> 4;
    const int nt = nt_ovr ? nt_ovr : Kb / (BK * 2);
    unsigned voffA[2], voffB[2];
#pragma unroll
    for (int i = 0; i < 2; ++i) { int R, C; stage_rc(tid * 16 + i * 8192, R, C); const int Rb = (R & ~31) + perm32(R & 31);
        voffA[i] = (unsigned)(R * ldab + C * 2); voffB[i] = (unsigned)(Rb * Kb + C * 2); }
    const size_t kstep = (size_t)(BK * 2);
    const size_t hstepA = (size_t)HALF * ldab, hstepB = (size_t)HALF * Kb;
    const unsigned ldsw = (unsigned)wid * 1024u;
    const int aoff = (ES == 2 || MIXED) ? lds_byte(wr * 64 + fr, fq * 8) : lds_byte(wr * 64 + fr, fq * 16), boff = (ES == 2 || MIXED) ? lds_byte(wc * 32 + fr, fq * 8) : lds_byte(wc * 32 + fr, fq * 16);
    constexpr int OFF1 = (ES == 2 || MIXED) ? 1024 : 16;
#define PG8_SA(b, h) (((b) * 2 + (h)) * HTB)
#define PG8_SB(b, h) ((4 + (b) * 2 + (h)) * HTB)
    const unsigned ldsbase = (unsigned)(uintptr_t)lds + ldsw;
#define PG8_DMA2(bufoff, sbase, voff_, i_) do { unsigned keep_; asm volatile("s_mov_b32 %0, m0\n\ts_mov_b32 m0, %3\n\ts_nop 0\n\tglobal_load_lds_dwordx4 %1, %2\n\ts_mov_b32 m0, %0" \
        : "=&s"(keep_) : "v"(voff_), "s"(sbase), "s"(ldsbase + (unsigned)((bufoff) + (i_) * 8192)) : "memory"); } while (0)
#define PG8_STAGEB(bufoff, gbase) do { _Pragma("unroll") for (int _i = 0; _i < 2; ++_i) PG8_DMA2(bufoff, (const char*)(gbase), voffB[_i], _i); } while (0)
#define PG8_STAGEA(bufoff, kt, h, GO) do { _Pragma("unroll") for (int _i = 0; _i < 2; ++_i) { \
        if constexpr (GATHER) PG8_DMA2(bufoff, (const char*)(kt), GO[h][_i], _i); else PG8_DMA2(bufoff, (const char*)(kt) + (h) * hstepA, voffA[_i], _i); } } while (0)
#define PG8_LD8(p0, p1) __builtin_bit_cast(i32x8, __builtin_shufflevector(*(const LAS u32x4*)(p0), *(const LAS u32x4*)(p1), 0, 1, 2, 3, 4, 5, 6, 7))
#define PG8_LDA(dst, b, h) do { _Pragma("unroll") for (int m = 0; m < 4; ++m) dst[m] = PG8_LD8(lds + PG8_SA(b, h) + aoff + m * 2048, lds + PG8_SA(b, h) + aoff + OFF1 + m * 2048); } while (0)
#define PG8_LDB(dst, b, h) do { _Pragma("unroll") for (int n = 0; n < 2; ++n) dst[n] = PG8_LD8(lds + PG8_SB(b, h) + boff + n * 2048, lds + PG8_SB(b, h) + boff + OFF1 + n * 2048); } while (0)
#define PG8_LO(x) __builtin_bit_cast(bf16x8, __builtin_shufflevector(x, x, 0, 1, 2, 3))
#define PG8_HI(x) __builtin_bit_cast(bf16x8, __builtin_shufflevector(x, x, 4, 5, 6, 7))
#define PG8_MMA16(ai, bj, At, Bt) do { _Pragma("unroll") for (int m = 0; m < 4; ++m) _Pragma("unroll") for (int n = 0; n < 2; ++n) { \
        acc[ai][bj][m][n] = __builtin_amdgcn_mfma_f32_16x16x32_bf16(PG8_LO(Bt[n]), PG8_LO(At[m]), acc[ai][bj][m][n], 0, 0, 0); \
        acc[ai][bj][m][n] = __builtin_amdgcn_mfma_f32_16x16x32_bf16(PG8_HI(Bt[n]), PG8_HI(At[m]), acc[ai][bj][m][n], 0, 0, 0); } } while (0)
#define PG8_MMA8(ai, bj, At, Bt) do { _Pragma("unroll") for (int m = 0; m < 4; ++m) _Pragma("unroll") for (int n = 0; n < 2; ++n) \
        acc[ai][bj][m][n] = __builtin_amdgcn_mfma_scale_f32_16x16x128_f8f6f4(Bt[n], At[m], acc[ai][bj][m][n], 0, 0, 0, SCB * 0x01010101, 0, SCA * 0x01010101); } while (0)
#define PG8_MMA(ai, bj, At, Bt) do { __builtin_amdgcn_s_setprio(1); \
        if constexpr (MIXED) { if (cur8) PG8_MMA8(ai, bj, At, Bt); else PG8_MMA16(ai, bj, At, Bt); } \
        else if constexpr (ES == 2) PG8_MMA16(ai, bj, At, Bt); else PG8_MMA8(ai, bj, At, Bt); \
        __builtin_amdgcn_s_setprio(0); } while (0)
#define PG8_WAIT_V(n) asm volatile("s_waitcnt vmcnt(" #n ")" ::: "memory")
#define PG8_WAIT_L(n) asm volatile("s_waitcnt lgkmcnt(" #n ")" ::: "memory")
#define PG8_BAR __builtin_amdgcn_s_barrier()
#define PG8_SCHED __builtin_amdgcn_sched_barrier(0)
#define PG8_GLOAD(GO, u) do { if constexpr (GATHER) { const int _tid = wid * 64 + lane_id(); _Pragma("unroll") for (int _i = 0; _i < 2; ++_i) { int _R, _C; stage_rc(_tid * 16 + _i * 8192, _R, _C); \
        _Pragma("unroll") for (int _h = 0; _h < 2; ++_h) { unsigned _t = (unsigned)(u).tok[_h * HALF + _R]; _t = _t < (unsigned)NTOK ? _t : (unsigned)(NTOK - 1); GO[_h][_i] = _t * (unsigned)ldab + (unsigned)_C * 2u; } } } } while (0)
    Unit cur, nxt; int ui = 0;
    if (!S.next(0, cur)) return;
    f32x4 acc[2][2][4][2];
#pragma unroll
    for (int a = 0; a < 2; ++a)
#pragma unroll
        for (int b = 0; b < 2; ++b)
#pragma unroll
            for (int m = 0; m < 4; ++m)
#pragma unroll
                for (int n = 0; n < 2; ++n) acc[a][b][m][n] = (f32x4){0.f, 0.f, 0.f, 0.f};
    i32x8 At[4], B0[2], B1[2];
    unsigned gC[2][2] = {{0u, 0u}, {0u, 0u}}, gN[2][2] = {{0u, 0u}, {0u, 0u}};
    PG8_GLOAD(gC, cur);
    const char* cA = cur.A; const char* cB = cur.B;
    bool cur8 = MIXED && cur.nt8 > 0; int ntc = cur8 ? cur.nt8 : nt;
    PG8_STAGEB(PG8_SB(0, 0), cB); PG8_STAGEB(PG8_SB(0, 1), cB + hstepB); PG8_STAGEA(PG8_SA(0, 0), cA, 0, gC); PG8_STAGEA(PG8_SA(0, 1), cA, 1, gC);
    if (wr == 1) PG8_BAR;
    PG8_WAIT_V(2); PG8_BAR;
    PG8_STAGEB(PG8_SB(1, 0), cB + kstep); PG8_STAGEA(PG8_SA(1, 0), cA + kstep, 0, gC); PG8_STAGEB(PG8_SB(1, 1), cB + hstepB + kstep);
    PG8_WAIT_V(6); PG8_BAR;
    for (;;) {
        const bool has_next = S.next(ui + 1, nxt);
        if (has_next) PG8_GLOAD(gN, nxt);
        const char* nA = has_next ? nxt.A : cA; const char* nB = has_next ? nxt.B : cB;
#pragma clang loop unroll(disable)
        for (int t = 0; t < ntc; t += 2) {
            const bool last = (t == ntc - 2);
            const char* a1 = cA + (size_t)(t + 1) * kstep;
            const char* a2 = last ? nA : cA + (size_t)(t + 2) * kstep; const char* b2 = last ? nB : cB + (size_t)(t + 2) * kstep;
            const char* a3 = a2 + kstep; const char* b3 = b2 + kstep;
            PG8_LDB(B0, 0, 0); PG8_LDB(B1, 0, 1); PG8_SCHED; PG8_LDA(At, 0, 0); PG8_STAGEA(PG8_SA(1, 1), a1, 1, gC);
            if (GATHER && last && has_next) {
#pragma unroll
                for (int _h = 0; _h < 2; ++_h)
#pragma unroll
                    for (int _i = 0; _i < 2; ++_i) gC[_h][_i] = gN[_h][_i];
            }
            PG8_WAIT_V(8); PG8_WAIT_L(0); PG8_BAR; PG8_MMA(0, 0, At, B0); PG8_MMA(0, 1, At, B1); PG8_BAR; PG8_SCHED;
            PG8_LDA(At, 0, 1); PG8_STAGEB(PG8_SB(0, 0), b2); PG8_STAGEB(PG8_SB(0, 1), b2 + hstepB); PG8_STAGEA(PG8_SA(0, 0), a2, 0, gC);
            PG8_WAIT_V(8); PG8_WAIT_L(0); PG8_BAR; PG8_MMA(1, 0, At, B0); PG8_MMA(1, 1, At, B1); PG8_BAR; PG8_SCHED;
            PG8_LDB(B0, 1, 0); PG8_LDB(B1, 1, 1); PG8_SCHED; PG8_LDA(At, 1, 0); PG8_STAGEA(PG8_SA(0, 1), a2, 1, gC);
            PG8_WAIT_V(8); PG8_WAIT_L(0); PG8_BAR; PG8_MMA(0, 0, At, B0); PG8_MMA(0, 1, At, B1); PG8_BAR; PG8_SCHED;
            PG8_LDA(At, 1, 1); PG8_STAGEB(PG8_SB(1, 0), b3); PG8_STAGEB(PG8_SB(1, 1), b3 + hstepB); PG8_STAGEA(PG8_SA(1, 0), a3, 0, gC);
            PG8_WAIT_V(8); PG8_WAIT_L(0); PG8_BAR; PG8_MMA(1, 0, At, B0); PG8_MMA(1, 1, At, B1); PG8_BAR; PG8_SCHED;
        }
        if (wr == 0) PG8_BAR;
        asm volatile("s_nop 15\n\ts_nop 7" ::: "memory");
        const int le_ = lane_id();
        const bool keep = E(acc, cur, wr, wc, le_ & 15, le_ >> 4);
        if (!has_next) break;
        if (!keep) {
#pragma unroll
        for (int a = 0; a < 2; ++a)
#pragma unroll
            for (int b = 0; b < 2; ++b)
#pragma unroll
                for (int m = 0; m < 4; ++m)
#pragma unroll
                    for (int n = 0; n < 2; ++n) acc[a][b][m][n] = (f32x4){0.f, 0.f, 0.f, 0.f};
        }
        cur = nxt; cA = nA; cB = nB; ++ui; cur8 = MIXED && cur.nt8 > 0; ntc = cur8 ? cur.nt8 : nt;
        if (wr == 1) PG8_BAR;
    }
    PG8_WAIT_V(0);
    PG8_BAR;
#undef PG8_SA
#undef PG8_SB
#undef PG8_DMA2
#undef PG8_STAGEA
#undef PG8_STAGEB
#undef PG8_LDA
#undef PG8_LDB
#undef PG8_MMA
#undef PG8_MMA8
#undef PG8_MMA16
#undef PG8_LD8
#undef PG8_LO
#undef PG8_HI
#undef PG8_WAIT_V
#undef PG8_WAIT_L
#undef PG8_BAR
#undef PG8_SCHED
#undef PG8_GLOAD
}
}
struct Args { const float* in[22]; float* out; unsigned char* ws; int ph_lo, ph_hi; };
enum { I_X = 0, I_C, I_WADA, I_BADA, I_GMIX, I_WIN, I_QNORM, I_KNORM, I_WAU, I_PLIN, I_PSCALE, I_WPU, I_WOUT, I_GFFN, I_WROUTER, I_RBIAS, I_W1, I_W3, I_W2, I_WS1, I_WS3, I_WS2 };
struct Frame {
    LAS unsigned char* lds;
    int wave, G, gw, NGW;
    unsigned char* ws; unsigned* ctl; float* out;
};
#define LDS_WAIT() asm volatile("s_waitcnt lgkmcnt(0)" ::: "memory")
#define VM_WAIT() asm volatile("s_waitcnt vmcnt(0)" ::: "memory")

__device__ __forceinline__ void tr_tile(const float* __restrict__ src, int ld_src, int nvalid, bf16_t* __restrict__ dst, int ld_dst, int lane) {
    const int q = lane >> 4, c4 = (lane & 15) * 4;
    const bool ok = c4 < nvalid;
#pragma unroll
    for (int g = 0; g < 2; ++g) {
        f32x4 v[8];
#pragma unroll
        for (int j = 0; j < 8; ++j) { const int k = 32 * g + 8 * q + j; v[j] = ok ? *(const f32x4*)(src + (size_t)k * ld_src + c4) : (f32x4){0.f, 0.f, 0.f, 0.f}; }
#pragma unroll
        for (int nn = 0; nn < 4; ++nn) {
            u32x4 w; w.x = cvt_pk_bf16(v[0][nn], v[1][nn]); w.y = cvt_pk_bf16(v[2][nn], v[3][nn]); w.z = cvt_pk_bf16(v[4][nn], v[5][nn]); w.w = cvt_pk_bf16(v[6][nn], v[7][nn]);
            *(u32x4*)(dst + (size_t)(c4 + nn) * ld_dst + 32 * g + 8 * q) = w;
        }
    }
}
__device__ __forceinline__ void tr8_issue(const float* __restrict__ src, int ld_src, int lane, f32x4 (&v)[16], int nvalid = 64) {
    const int q = lane >> 4, c4 = (lane & 15) * 4; const bool ok = c4 < nvalid;
    const unsigned voff = (unsigned)((16 * q) * ld_src + c4) * 4u;
#pragma unroll
    for (int j = 0; j < 16; ++j) v[j] = ok ? __builtin_nontemporal_load((const f32x4*)((const char*)src + (size_t)j * ld_src * 4 + voff)) : (f32x4){0.f, 0.f, 0.f, 0.f};
}
__device__ __forceinline__ void tr8_finish(unsigned char* __restrict__ dst, int ld_dst, int lane, const f32x4 (&v)[16]) {
    const int q = lane >> 4, c4 = (lane & 15) * 4;
#pragma unroll
    for (int nn = 0; nn < 4; ++nn) { u32x4 w;
#pragma unroll
        for (int t = 0; t < 4; ++t) w[t] = pk4_fp8(v[4 * t][nn] * W8_SCALE, v[4 * t + 1][nn] * W8_SCALE, v[4 * t + 2][nn] * W8_SCALE, v[4 * t + 3][nn] * W8_SCALE);
        *(u32x4*)(dst + (size_t)(c4 + nn) * ld_dst + 16 * q) = w; }
}
template <bool F8>
__device__ __forceinline__ void wcopy_tile(const float* src, int ld_src, int nvalid, unsigned char* dstbase, size_t drow, int ldk, int k0, int lane) {
    if constexpr (F8) { f32x4 v[16]; tr8_issue(src, ld_src, lane, v, nvalid); tr8_finish(dstbase + drow * ldk + k0, ldk, lane, v); }
    else tr_tile(src, ld_src, nvalid, (bf16_t*)dstbase + drow * ldk + k0, ldk, lane);
}
constexpr int ADA_WGS = 6 * DM / 128;
__device__ __forceinline__ void p0_prologue(Frame& F, const Args& a) {
    LAS float* sc = (LAS float*)F.lds;
    const int lane = lane_id(), tid = F.wave * 64 + lane;
    for (int i = tid; i < NB * DM; i += NTHR) { const float c = a.in[I_C][i]; sc[i] = c / (1.0f + __expf(-c)); }
    __syncthreads();
    float* mod = (float*)(F.ctl + CW_MOD);
    unsigned char* ws = F.ws;
    for (int job = blockIdx.x; job < 2 * ADA_WGS; job += F.G) {
        const int strip = job % ADA_WGS, kh = job / ADA_WGS, w = F.wave, krow0 = kh * 1024 + 128 * w;
        const int l32 = lane & 31, hb = lane >> 5;
        const float* wp = a.in[I_WADA] + (size_t)(krow0 + hb) * (6 * DM) + strip * 128 + 4 * l32;
        f32x4 b0 = {0.f, 0.f, 0.f, 0.f}, b1 = {0.f, 0.f, 0.f, 0.f};
#pragma unroll 16
        for (int k = 0; k < 64; ++k) { const f32x4 wv = *(const f32x4*)(wp + (size_t)(2 * k) * (6 * DM)); const float s0 = sc[krow0 + 2 * k + hb], s1 = sc[DM + krow0 + 2 * k + hb]; b0 += wv * s0; b1 += wv * s1; }
#pragma unroll
        for (int j = 0; j < 4; ++j) { b0[j] += __shfl_xor(b0[j], 32); b1[j] += __shfl_xor(b1[j], 32); }
        const int col2 = 2 * (lane & 1);
        const f32x2 a0 = {hb ? b0[2] : b0[0], hb ? b0[3] : b0[1]}, a1 = {hb ? b1[2] : b1[0], hb ? b1[3] : b1[1]};
        const int pcol = 4 * l32 + 2 * hb; (void)col2;
        LAS float* part = (LAS float*)(F.lds + 16384);
        *(LAS f32x2*)(part + (w * 2 + 0) * 128 + pcol) = a0; *(LAS f32x2*)(part + (w * 2 + 1) * 128 + pcol) = a1;
        __syncthreads();
        if (tid < 256) { const int b = tid >> 7, c = tid & 127; float sum = kh == 0 ? a.in[I_BADA][strip * 128 + c] : 0.f;
#pragma unroll
            for (int ww = 0; ww < 8; ++ww) sum += part[(ww * 2 + b) * 128 + c];
            unsafeAtomicAdd(mod + b * 6 * DM + strip * 128 + c, sum); }
        __syncthreads();
    }
    unsigned char* Win8 = ws + WS_WIN;
    constexpr int J_IN_A = 32 * 40, J_IN_B = 32 * 4, J_IN_C = 32 * 80, J_AU = 16 * 32, J_PU = 16 * 32, J_OUT = 32 * 32, J_PL = 4 * 16, J_S13 = 2 * 32 * 8, J_S2 = 8 * 32, J_WR = 32,
                  J_W13 = 0, J_W2 = 0;
    constexpr int NITEMS = J_IN_A + J_IN_B + J_IN_C + J_AU + J_PU + J_OUT + J_PL + J_S13 + J_S2 + J_WR;
    for (int it = F.gw; it < NITEMS; it += F.NGW) {
        int r = it;
        if (r < J_IN_A) { const int kb = r / 40, nb = r % 40; if ((nb >> 2) == 5) wcopy_tile<true>(a.in[I_WIN] + (size_t)(64 * kb) * INW + 64 * nb, INW, 64, Win8, (size_t)(64 * nb), 2 * DM, 64 * kb, lane);
            else wcopy_tile<false>(a.in[I_WIN] + (size_t)(64 * kb) * INW + 64 * nb, INW, 64, Win8, (size_t)(64 * nb), DM, 64 * kb, lane); continue; } r -= J_IN_A;
        if (r < J_IN_B) { const int kb = r / 4, nb = r % 4; const int nv = nb == 0 ? 64 : (nb == 1 ? 16 : 0);
            wcopy_tile<false>(a.in[I_WIN] + (size_t)(64 * kb) * INW + 2560 + (nb < 2 ? 64 * nb : 0), INW, nv, Win8, (size_t)(2560 + 64 * nb), DM, 64 * kb, lane); continue; } r -= J_IN_B;
        if (r < J_IN_C) { const int kb = r / 80, nb = r % 80; wcopy_tile<true>(a.in[I_WIN] + (size_t)(64 * kb) * INW + 2640 + 64 * nb, INW, 64, Win8, (size_t)(2816 + 64 * nb), 2 * DM, 64 * kb, lane); continue; } r -= J_IN_C;
        if (r < J_AU) { const int kb = r / 32, nb = r % 32; wcopy_tile<FP8_MERGE>(a.in[I_WAU] + (size_t)(64 * kb) * DM + 64 * nb, DM, 64, ws + WS_WAU, (size_t)(64 * nb), AW, 64 * kb, lane); continue; } r -= J_AU;
        if (r < J_PU) { const int kb = r / 32, nb = r % 32; wcopy_tile<FP8_MERGE>(a.in[I_WPU] + (size_t)(64 * kb) * DM + 64 * nb, DM, 64, ws + WS_WPU, (size_t)(64 * nb), PW, 64 * kb, lane); continue; } r -= J_PU;
        if (r < J_OUT) { const int kb = r / 32, nb = r % 32; wcopy_tile<FP8_OUT>(a.in[I_WOUT] + (size_t)(64 * kb) * DM + 64 * nb, DM, 64, ws + WS_WOUT, (size_t)(64 * nb), DM, 64 * kb, lane); continue; } r -= J_OUT;
        if (r < J_PL) { const int g = r / 16, kb = (r % 16) / 4, nb = r % 4; tr_tile(a.in[I_PLIN] + (size_t)g * 65536 + (size_t)(64 * kb) * 256 + 64 * nb, 256, 64, (bf16_t*)(ws + WS_PLIN) + (size_t)g * 65536 + (size_t)(64 * nb) * 256 + 64 * kb, 256, lane); continue; } r -= J_PL;
        if (r < J_S13) { const int which = r / 256, kb = (r % 256) / 8, nb = r % 8; const float* src = (which ? a.in[I_WS3] : a.in[I_WS1]) + (size_t)(64 * kb) * EH + 64 * nb;
            f32x4 v[16]; tr8_issue(src, EH, lane, v); tr8_finish(ws + WS_WS13 + (size_t)(256 * (nb >> 1) + 64 * (nb & 1) + 128 * which) * DM + 64 * kb, DM, lane, v); continue; } r -= J_S13;
        if (r < J_S2) { const int kb = r / 32, nb = r % 32; f32x4 v[16]; tr8_issue(a.in[I_WS2] + (size_t)(64 * kb) * DM + 64 * nb, DM, lane, v); tr8_finish(ws + WS_WS2 + (size_t)(64 * nb) * EH + 64 * kb, EH, lane, v); continue; } r -= J_S2;
        { const int kb = r; tr_tile(a.in[I_WROUTER] + (size_t)(64 * kb) * NE, NE, 64, (bf16_t*)(ws + WS_WR) + 64 * kb, DM, lane); }
    }
}

constexpr int NCONV_W13 = NE * 2 * 32 * 8, NCONV = NCONV_W13 + NE * 8 * 32;
__device__ __forceinline__ void conv_ptrs(const Args& a, unsigned char* ws, int it, const float*& src, int& ld_src, unsigned char*& dst, int& ld_dst) {
    if (it < NCONV_W13) { const int e = it / 512, rr = it % 512, which = rr / 256, kb = (rr % 256) / 8, nb = rr % 8;
        src = (which ? a.in[I_W3] : a.in[I_W1]) + ((size_t)e * DM + 64 * kb) * EH + 64 * nb; ld_src = EH;
        dst = ws + WS_W13 + ((size_t)e * 1024 + 256 * (nb >> 1) + 64 * (nb & 1) + 128 * which) * DM + 64 * kb; ld_dst = DM; }
    else { const int r = it - NCONV_W13, e = r / 256, kb = (r % 256) / 32, nb = r % 32;
        src = a.in[I_W2] + ((size_t)e * EH + 64 * kb) * DM + 64 * nb; ld_src = DM; dst = ws + WS_W2 + ((size_t)e * DM + 64 * nb) * EH + 64 * kb; ld_dst = EH; }
}
__device__ __forceinline__ void conv_issue16(const Args& a, unsigned char* ws, int it, int lane, f32x4 (&v)[16]) {
    const float* src; int ld_src; unsigned char* dst; int ld_dst; conv_ptrs(a, ws, it, src, ld_src, dst, ld_dst); tr8_issue(src, ld_src, lane, v); }
__device__ __forceinline__ void conv_finish16(const Args& a, unsigned char* ws, int it, int lane, const f32x4 (&v)[16]) {
    const float* src; int ld_src; unsigned char* dst; int ld_dst; conv_ptrs(a, ws, it, src, ld_src, dst, ld_dst); tr8_finish(dst, ld_dst, lane, v); }
__device__ __forceinline__ void phase_done(Frame& F, int phase) { __syncthreads(); if (F.wave == 0 && lane_id() == 0) __hip_atomic_fetch_add(F.ctl + CW_DONE + 64 * phase, 1u, __ATOMIC_RELAXED, __HIP_MEMORY_SCOPE_AGENT); }
constexpr int CONV_SEG1_END = NCONV_W13 + (NCONV - NCONV_W13) * 3 / 10 / 8 * 8;
__device__ __forceinline__ unsigned conv_seg_lo(int sg) { return sg == 0 ? 0u : (sg == 1 ? (unsigned)NCONV_W13 : (unsigned)CONV_SEG1_END); }
__device__ __forceinline__ unsigned conv_seg_hi(int sg) { return sg == 0 ? (unsigned)NCONV_W13 : (sg == 1 ? (unsigned)CONV_SEG1_END : (unsigned)NCONV); }
template <bool BOUNDED, int SEG_LO, int SEG_HI>
struct ConvQ {
    Frame& F; int phase, lane; unsigned cur, end; int sg;
    __device__ __forceinline__ int next() {
        constexpr unsigned B = BOUNDED ? 6u : 8u;
        while (cur >= end) {
            if (BOUNDED) { const unsigned d = __hip_atomic_load(F.ctl + CW_DONE + 64 * phase, __ATOMIC_RELAXED, __HIP_MEMORY_SCOPE_AGENT); if ((unsigned)__builtin_amdgcn_readfirstlane(d) >= (unsigned)F.G) return -1; }
            const unsigned lo = conv_seg_lo(sg), hi = conv_seg_hi(sg);
            unsigned s = 0; if (lane == 0) s = __hip_atomic_fetch_add(F.ctl + CW_CONVQ + 64 * sg, B, __ATOMIC_RELAXED, __HIP_MEMORY_SCOPE_AGENT);
            s = (unsigned)__builtin_amdgcn_readfirstlane(s) + lo;
            if (s >= hi) { if (sg < SEG_HI) { ++sg; continue; } return -1; }
            cur = s; end = s + B < hi ? s + B : hi;
        }
        return (int)cur++;
    }
};
template <bool BOUNDED, int SEG_LO, int SEG_HI>
__device__ __forceinline__ void conv_drain(Frame& F, const Args& a, int phase, int quota = 0) {
    const int lane = lane_id();
    ConvQ<BOUNDED, SEG_LO, SEG_HI> Q{F, phase, lane, 0u, 0u, SEG_LO};
    f32x4 va[16], vb[16]; int n = 0;
    int ia = Q.next(); if (ia < 0) return;
    conv_issue16(a, F.ws, ia, lane, va);
    for (;;) {
        ++n; const int ib = (quota > 0 && n >= quota && Q.cur >= Q.end) ? -1 : Q.next(); if (ib >= 0) conv_issue16(a, F.ws, ib, lane, vb);
        conv_finish16(a, F.ws, ia, lane, va);
        if (ib < 0) break;
        ++n; ia = (quota > 0 && n >= quota && Q.cur >= Q.end) ? -1 : Q.next(); if (ia >= 0) conv_issue16(a, F.ws, ia, lane, va);
        conv_finish16(a, F.ws, ib, lane, vb);
        if (ia < 0) break;
    }
}

__device__ __forceinline__ void modnorm_row(const float* __restrict__ xrow, const float* __restrict__ g, const float* __restrict__ shift, const float* __restrict__ scale, unsigned char* __restrict__ orow, unsigned char* __restrict__ orow8, int lane) {
    f32x4 v[8]; float ss = 0.f;
#pragma unroll
    for (int j = 0; j < 8; ++j) { v[j] = *(const f32x4*)(xrow + 4 * lane + 256 * j); ss += (v[j].x * v[j].x + v[j].y * v[j].y) + (v[j].z * v[j].z + v[j].w * v[j].w); }
    const float rstd = rsqrtf(wave_sum(ss) * (1.0f / DM) + NORM_EPS);
#pragma unroll
    for (int j = 0; j < 8; ++j) { const int c = 4 * lane + 256 * j;
        const f32x4 gg = *(const f32x4*)(g + c), sh = *(const f32x4*)(shift + c), sl = *(const f32x4*)(scale + c);
        const f32x4 o = v[j] * rstd * gg * (sl + 1.0f) + sh;
        { u32x2 w; w.x = cvt_pk_bf16(o.x, o.y); w.y = cvt_pk_bf16(o.z, o.w); *(u32x2*)((bf16_t*)orow + c) = w; }
        if (orow8) *(unsigned*)(orow8 + c) = pk4_fp8(o.x * A8_SCALE, o.y * A8_SCALE, o.z * A8_SCALE, o.w * A8_SCALE); }
}
__device__ __forceinline__ void p1_h(Frame& F, const Args& a) {
    const float* mod = (const float*)(F.ctl + CW_MOD);
    unsigned char* hb = F.ws + WS_HB; const int lane = lane_id();
    for (int m0 = 2 * F.gw; m0 < NTOK; m0 += 2 * F.NGW) {
        f32x4 v[2][8];
#pragma unroll
        for (int rr = 0; rr < 2; ++rr)
#pragma unroll
            for (int j = 0; j < 8; ++j) v[rr][j] = *(const f32x4*)(a.in[I_X] + (size_t)(m0 + rr) * DM + 4 * lane + 256 * j);
        const int b = m0 / SEQ; const float* sh = mod + b * 6 * DM; const float* sl = mod + b * 6 * DM + DM;
        float rstd[2];
#pragma unroll
        for (int rr = 0; rr < 2; ++rr) { float ss = 0.f;
#pragma unroll
            for (int j = 0; j < 8; ++j) ss += (v[rr][j].x * v[rr][j].x + v[rr][j].y * v[rr][j].y) + (v[rr][j].z * v[rr][j].z + v[rr][j].w * v[rr][j].w);
            rstd[rr] = rsqrtf(wave_sum(ss) * (1.0f / DM) + NORM_EPS); }
#pragma unroll
        for (int j = 0; j < 8; ++j) { const int c = 4 * lane + 256 * j;
            const f32x4 gg = *(const f32x4*)(a.in[I_GMIX] + c), shv = *(const f32x4*)(sh + c), slv = *(const f32x4*)(sl + c); const f32x4 mul = gg * (slv + 1.0f);
#pragma unroll
            for (int rr = 0; rr < 2; ++rr) { const f32x4 o = v[rr][j] * rstd[rr] * mul + shv; const size_t ro = (size_t)(m0 + rr) * DM * 2;
                u32x2 w; w.x = cvt_pk_bf16(o.x, o.y); w.y = cvt_pk_bf16(o.z, o.w); *(u32x2*)((bf16_t*)(hb + ro) + c) = w;
                *(unsigned*)(F.ws + WS_H8 + ro + c) = pk4_fp8(o.x * A8_SCALE, o.y * A8_SCALE, o.z * A8_SCALE, o.w * A8_SCALE); } }
    }
}
struct SchedDense {
    pg8::TileOrder T; const char* A; const char* B; size_t a_tile, b_tile;
    __device__ __forceinline__ bool next(int i, pg8::Unit& u) const { int pm, pn; if (!T.tile(i, pm, pn)) return false; u.pm = pm; u.pn = pn; u.aux = 0; u.tok = nullptr; u.nt8 = 0;
        u.A = A + (size_t)pm * a_tile; u.B = B + (size_t)pn * b_tile; return true; }
};
__device__ __forceinline__ void st_bf16x8(bf16_t* p, f32x4 v0, f32x4 v1) { u32x4 w; w.x = cvt_pk_bf16(v0[0], v0[1]); w.y = cvt_pk_bf16(v0[2], v0[3]); w.z = cvt_pk_bf16(v1[0], v1[1]); w.w = cvt_pk_bf16(v1[2], v1[3]); *(u32x4*)p = w; }
struct EpiInproj {
    unsigned char* ws;
    __device__ __forceinline__ bool operator()(f32x4 (&acc)[2][2][4][2], const pg8::Unit& u, int wr, int wc, int fr, int fq) const {
        const int pn = u.pn; bf16_t* base; int ld, ct; bool sig = false;
        if (pn < 4) { base = (bf16_t*)(ws + WS_Q); ld = AW; ct = pn; }
        else if (pn == 4) { base = (bf16_t*)(ws + WS_K); ld = KVW; ct = 0; }
        else if (pn == 5) { base = (bf16_t*)(ws + WS_V); ld = KVW; ct = 0; }
        else if (pn < 10) { base = (bf16_t*)(ws + WS_QI); ld = IH * ID; ct = pn - 6; }
        else if (pn == 10) { base = (bf16_t*)(ws + WS_KW); ld = 256; ct = 0; }
        else if (pn < 15) { base = (bf16_t*)(ws + WS_U); ld = PW; ct = pn - 11; }
        else { base = (bf16_t*)(ws + WS_G); ld = 2 * DM; ct = pn - 15; sig = true; }
        const int row0 = u.pm * 256 + wr * 64 + fr, col0 = ct * 256 + wc * 32 + 8 * fq;
#pragma unroll
        for (int ai = 0; ai < 2; ++ai)
#pragma unroll
            for (int m = 0; m < 4; ++m) { bf16_t* rowp = base + (size_t)(row0 + ai * 128 + m * 16) * ld + col0;
#pragma unroll
                for (int bj = 0; bj < 2; ++bj) { f32x4 v0 = acc[ai][bj][m][0], v1 = acc[ai][bj][m][1];
                    if (sig) {
#pragma unroll
                        for (int j = 0; j < 4; ++j) { v0[j] = fminf(__builtin_amdgcn_rcpf(1.0f + __expf(-v0[j])), 1.0f); v1[j] = fminf(__builtin_amdgcn_rcpf(1.0f + __expf(-v1[j])), 1.0f); } }
                    st_bf16x8(rowp + bj * 128, v0, v1); } }
        return false;
    }
};
struct SchedInproj {
    int G, c, kind; const char* hA; const char* win;
    __device__ __forceinline__ bool next(int i, pg8::Unit& u) const {
        const int first = kind == 0 ? c : c + ((320 - c + G - 1) / G) * G;
        const int j = first + i * G; if (j >= (kind == 0 ? 320 : 992)) return false;
        int pn, pm;
        if (kind == 0) { const int t = j >> 5; pm = j & 31; pn = t < 5 ? t : t + 1; }
        else { const int jj = j - 320, t = jj >> 5; pm = jj & 31; pn = t == 0 ? 5 : t + 10; }
        u.pm = pm; u.pn = pn; u.aux = 0; u.tok = nullptr; u.nt8 = 0;
        u.A = hA + (size_t)pm * 256 * DM * 2; u.B = win + (size_t)pn * 256 * DM * 2; return true; }
};
__device__ __forceinline__ void p2_inproj(Frame& F, const Args& a) {
    const int NG = F.G >= 256 ? 248 : F.G;
    if ((int)blockIdx.x >= NG) { conv_drain<false, 0, 2>(F, a, 2, 24); return; }
    EpiInproj E{F.ws};
    { SchedInproj S{NG, (int)blockIdx.x, 0, (const char*)(F.ws + WS_HB), (const char*)(F.ws + WS_WIN)};
      pg8::gemm_phase<EpiInproj, SchedInproj, false, 2>(F.lds, F.wave, DM * 2, DM * 2, S, E); }
    { SchedInproj S{NG, (int)blockIdx.x, 1, (const char*)(F.ws + WS_H8), (const char*)(F.ws + WS_WIN)};
      pg8::gemm_phase<EpiInproj, SchedInproj, false, 1, A8_E8, W8_E8>(F.lds, F.wave, DM * 2, DM * 2, S, E, DM / 128); }
}
__device__ __forceinline__ void p3_qknorm(Frame& F, const Args& a) {
    bf16_t* K = (bf16_t*)(F.ws + WS_K);
    const int lane = lane_id();
    for (int m = F.gw; m < NTOK; m += F.NGW) {
        u32x2 k0 = *(const u32x2*)(K + (size_t)m * KVW + 4 * lane);
        float kv[4]; float sk = 0.f;
        kv[0] = bflo(k0[0]); kv[1] = bfhi(k0[0]); kv[2] = bflo(k0[1]); kv[3] = bfhi(k0[1]);
#pragma unroll
        for (int j = 0; j < 4; ++j) sk += kv[j] * kv[j];
        sk += __shfl_xor(sk, 1); sk += __shfl_xor(sk, 2); sk += __shfl_xor(sk, 4); sk += __shfl_xor(sk, 8); sk += __shfl_xor(sk, 16);
        const float rk = rsqrtf(sk * (1.0f / HD) + NORM_EPS);
        const int dk = (4 * lane) & 127;
        u32x2 ok; ok[0] = cvt_pk_bf16(kv[0] * rk * a.in[I_KNORM][dk], kv[1] * rk * a.in[I_KNORM][dk + 1]); ok[1] = cvt_pk_bf16(kv[2] * rk * a.in[I_KNORM][dk + 2], kv[3] * rk * a.in[I_KNORM][dk + 3]);
        *(u32x2*)(K + (size_t)m * KVW + 4 * lane) = ok;
    }
}
__device__ __forceinline__ void pooled_item(Frame& F, int t0, int g, int lane) {
    const bf16_t* U = (const bf16_t*)(F.ws + WS_U); bf16_t* P = (bf16_t*)(F.ws + WS_POOLED);
    const int pos0 = t0 % SEQ, w = 2 << g, c = 256 * g + 4 * lane;
    f32x4 W = {0.f, 0.f, 0.f, 0.f};
    for (int j = 1; j <= 16; ++j) { if (j <= w && pos0 - j >= 0) { const u32x2 v = *(const u32x2*)(U + (size_t)(t0 - j) * PW + c); W += (f32x4){bflo(v[0]), bfhi(v[0]), bflo(v[1]), bfhi(v[1])}; } }
#pragma unroll 8
    for (int i = 0; i < 32; ++i) { const int t = t0 + i, pos = pos0 + i;
        const u32x2 v = *(const u32x2*)(U + (size_t)t * PW + c); const f32x4 cur = {bflo(v[0]), bfhi(v[0]), bflo(v[1]), bfhi(v[1])};
        W += cur;
        if (pos - w >= 0) { const u32x2 o = *(const u32x2*)(U + (size_t)(t - w) * PW + c); W -= (f32x4){bflo(o[0]), bfhi(o[0]), bflo(o[1]), bfhi(o[1])}; }
        const float inv = 1.0f / (float)(pos + 1 < w ? pos + 1 : w);
        const f32x4 r = W * inv - cur;
        u32x2 ow; ow[0] = cvt_pk_bf16(r[0], r[1]); ow[1] = cvt_pk_bf16(r[2], r[3]);
        *(u32x2*)(P + (size_t)t * PW + c) = ow; }
}
__device__ __forceinline__ unsigned mono_key(float s) { const unsigned u = __float_as_uint(s); return (u & 0x80000000u) ? ~u : (u | 0x80000000u); }
__device__ __forceinline__ void idx_block(Frame& F, const Args& a, int b, int i16) {
    const bf16_t* QI = (const bf16_t*)(F.ws + WS_QI); const bf16_t* KW = (const bf16_t*)(F.ws + WS_KW);
    unsigned short* MT = (unsigned short*)(F.ws + WS_MASK);
    LAS unsigned* T = (LAS unsigned*)F.lds;
    const int lane = lane_id(), w = F.wave, tid = w * 64 + lane, r32 = lane & 31, hi = lane >> 5;
    const int tpos0 = 16 * i16, t0 = b * SEQ + tpos0, nh = (tpos0 + 16 + 31) >> 5, kzero = 64 * ((tpos0 >> 6) + 1);
    for (int k = tid; k < kzero; k += NTHR) T[k] = 0u;
    bf16x8 Af[4];
    { const int qsel = (r32 >> 2) & 1, head = (r32 & 3) + 4 * (r32 >> 3); const size_t tq = (size_t)(t0 + 2 * w + qsel);
      const float wv = bf2f(KW[tq * 256 + 64 + head]);
#pragma unroll
      for (int s = 0; s < 4; ++s) { const u32x4 q = *(const u32x4*)(QI + tq * (IH * ID) + head * ID + 16 * s + 8 * hi); u32x4 o;
#pragma unroll
          for (int j = 0; j < 4; ++j) o[j] = cvt_pk_bf16(bflo(q[j]) * wv, bfhi(q[j]) * wv);
          Af[s] = __builtin_bit_cast(bf16x8, o); } }
    float X[16];
    { const size_t tq = (size_t)(t0 + 2 * w + hi); const u32x4 w0 = *(const u32x4*)(KW + tq * 256 + 64), w1 = *(const u32x4*)(KW + tq * 256 + 72);
      const float PINF = __builtin_inff();
#pragma unroll
      for (int j = 0; j < 4; ++j) { X[2 * j] = bflo(w0[j]) >= 0.f ? PINF : -PINF; X[2 * j + 1] = bfhi(w0[j]) >= 0.f ? PINF : -PINF;
                                    X[8 + 2 * j] = bflo(w1[j]) >= 0.f ? PINF : -PINF; X[8 + 2 * j + 1] = bfhi(w1[j]) >= 0.f ? PINF : -PINF; } }
    const int mypos = tpos0 + 2 * w + hi;
    unsigned keys[128];
    constexpr int RING = 16384, SLOT = 8192;
    const int nt64 = (nh + 1) >> 1;
    const unsigned dvoff = (unsigned)((lane >> 3) * 512 + (((lane & 7) ^ (lane >> 3)) << 4));
    const char* kwb = (const char*)(KW + (size_t)b * SEQ * 256) + w * 4096;
    const unsigned ldsw = (unsigned)(uintptr_t)F.lds + RING + w * 1024;
#define IDX_DMA(t_) do { unsigned keep_; asm volatile("s_mov_b32 %0, m0\n\ts_mov_b32 m0, %3\n\ts_nop 0\n\tglobal_load_lds_dwordx4 %1, %2\n\ts_mov_b32 m0, %0" \
        : "=&s"(keep_) : "v"(dvoff), "s"(kwb + (size_t)(t_) * 32768), "s"(ldsw + (unsigned)(((t_) & 3) * SLOT)) : "memory"); } while (0)
    int boffs[4];
#pragma unroll
    for (int s = 0; s < 4; ++s) boffs[s] = r32 * 128 + ((((2 * s + hi) ^ (r32 & 7))) << 4);
    __syncthreads();
    if (0 < nt64) IDX_DMA(0);
    if (1 < nt64) IDX_DMA(1);
    if (2 < nt64) IDX_DMA(2);
#pragma unroll
    for (int t = 0; t < 64; ++t) {
        keys[2 * t] = 0u; keys[2 * t + 1] = 0u;
        if (t < nt64) {
            const int rem = nt64 - 1 - t;
            if (rem >= 2) asm volatile("s_waitcnt vmcnt(2)" ::: "memory"); else if (rem == 1) asm volatile("s_waitcnt vmcnt(1)" ::: "memory"); else asm volatile("s_waitcnt vmcnt(0)" ::: "memory");
            __builtin_amdgcn_s_barrier(); asm volatile("" ::: "memory");
            if (t + 3 < nt64) IDX_DMA(t + 3);
#pragma unroll
            for (int half = 0; half < 2; ++half) { const int n = 2 * t + half;
                if (n < nh) {
                    f32x16 acc = {0.f, 0.f, 0.f, 0.f, 0.f, 0.f, 0.f, 0.f, 0.f, 0.f, 0.f, 0.f, 0.f, 0.f, 0.f, 0.f};
#pragma unroll
                    for (int s = 0; s < 4; ++s) { const bf16x8 bfr = *(const LAS bf16x8*)(F.lds + RING + (t & 3) * SLOT + half * 4096 + boffs[s]);
                        acc = __builtin_amdgcn_mfma_f32_32x32x16_bf16(Af[s], bfr, acc, 0, 0, 0); }
                    float sc = 0.f;
#pragma unroll
                    for (int j = 0; j < 16; ++j) sc += __builtin_amdgcn_fmed3f(acc[j], 0.f, X[j]);
                    keys[n] = (32 * n + r32 <= mypos) ? mono_key(sc) : 0u;
                } }
        }
    }
#undef IDX_DMA
    unsigned Tsel = 0u;
    { constexpr int HIST = 49152;
      LAS unsigned* hb = (LAS unsigned*)(F.lds + HIST) + (2 * w + hi) * 512;
      unsigned kk = (unsigned)TOPK; bool alive = true;
#pragma unroll 1
      for (int p = 0; p < 4; ++p) { const int sh = 24 - 8 * p;
          *(LAS u32x4*)(hb + 8 * r32) = (u32x4){0u, 0u, 0u, 0u}; *(LAS u32x4*)(hb + 8 * r32 + 4) = (u32x4){0u, 0u, 0u, 0u};
          asm volatile("s_waitcnt lgkmcnt(0)" ::: "memory");
#pragma unroll
          for (int n8 = 0; n8 < 16; ++n8) { if (n8 * 8 < nh) {
#pragma unroll
              for (int j = 0; j < 8; ++j) { const unsigned key = keys[n8 * 8 + j];
                  const unsigned x = p ? ((key ^ Tsel) >> ((sh + 8) & 31)) : 0u, t = x < 1u ? x : 1u;
                  __hip_atomic_fetch_add(hb + ((t << 8) + ((key >> sh) & 255u)), 1u, __ATOMIC_RELAXED, __HIP_MEMORY_SCOPE_WORKGROUP); } } }
          asm volatile("s_waitcnt lgkmcnt(0)" ::: "memory");
          const u32x4 c0 = *(const LAS u32x4*)(hb + 8 * r32), c1 = *(const LAS u32x4*)(hb + 8 * r32 + 4);
          const unsigned cb[8] = {(p == 0 && r32 == 0) ? 0u : c0[0], c0[1], c0[2], c0[3], c1[0], c1[1], c1[2], c1[3]};
          unsigned S = 0;
#pragma unroll
          for (int j = 0; j < 8; ++j) S += cb[j];
          unsigned suf = S;
#pragma unroll
          for (int d = 1; d < 32; d <<= 1) { const unsigned y = __shfl_down(suf, d, 32); if (r32 + d < 32) suf += y; }
          const unsigned total = __shfl(suf, 0, 32), sufx = suf - S;
          if (alive && total < kk) alive = false;
          const bool mine = alive && sufx < kk && kk <= suf;
          unsigned acc = sufx, bsel = 0u, above = 0u; bool found = false;
#pragma unroll
          for (int j = 7; j >= 0; --j) { if (!found) { if (acc + cb[j] >= kk) { found = true; bsel = (unsigned)(8 * r32 + j); above = acc; } else acc += cb[j]; } }
          const unsigned long long bm = __ballot(mine);
          const unsigned half = hi ? (unsigned)(bm >> 32) : (unsigned)bm;
          const int src = half ? (__builtin_ctz(half) + 32 * hi) : lane;
          const unsigned bs = __shfl(bsel, src), ab = __shfl(above, src);
          if (alive) { Tsel |= bs << sh; kk -= ab; }
      }
      if (!alive) Tsel = 0u;
    }
    { const unsigned Tf = Tsel > 1u ? Tsel : 1u;
      __syncthreads();
#pragma unroll
      for (int n = 0; n < 128; ++n) { if (n < nh) {
          unsigned bitv = keys[n] >= Tf ? 1u : 0u; const unsigned other = __shfl_xor(bitv, 32);
          bitv |= other << 1;
          if (hi == 0 && bitv) __hip_atomic_fetch_or(T + 32 * n + r32, bitv << (2 * w), __ATOMIC_RELAXED, __HIP_MEMORY_SCOPE_WORKGROUP); } }
    }
    __syncthreads();
    { const int rg = (b * SEQ + tpos0) >> 5, f = i16 & 1;
      for (int k = tid; k < kzero; k += NTHR) { const int kk = k & 63, p = (kk & ~7) | ((kk & 3) << 1) | ((kk >> 2) & 1);
          MT[((size_t)(rg * 64 + (k >> 6)) * 64 + p) * 2 + f] = (unsigned short)(T[k] & 0xffffu); } }
    __syncthreads();
}
__device__ __forceinline__ void p3_indexer(Frame& F, const Args& a) {
    for (int v2 = 2 * blockIdx.x; v2 < 512; v2 += 2 * F.G) { for (int ps = 0; ps < 2; ++ps) { const int v = v2 >> 1, b = v >> 7, i = v & 127; idx_block(F, a, b, ps ? 255 - i : i); } }
}
namespace att {
constexpr int KVBLK = 64, SHM_V = KVBLK * HD * 2, SHM_K = KVBLK * HD * 2;
constexpr int LDS_V = 0, LDS_K = 2 * SHM_V, LDS_WS = 2 * SHM_V + 2 * SHM_K, LDS_BYTES = LDS_WS + NWAVES * 64 * 4;
constexpr float THR = 8.f, LOG2E = 1.4426950408889634f;
#define KSWZ(row, colB) ((row) * 256 + ((colB) ^ (((row) & 7) << 4)))
#define SBAR() __builtin_amdgcn_sched_barrier(0)
__device__ __forceinline__ int v_st(int k, int c) { const int kk = (k & ~0xC) | ((k & 4) << 1) | ((k & 8) >> 1); return ((kk >> 3) * 4 + (c >> 5)) * 512 + ((kk & 7) * 32 + (c & 31)) * 2; }
__device__ __forceinline__ int v_rd_base(int lane) { return ((lane & 3) << 3) | (((lane >> 2) & 3) << 6) | (((lane >> 4) & 1) << 5) | (((lane >> 5) & 1) << 8); }
constexpr int v_rd_off(int d0, int ks, int half) { return d0 * 512 + ks * 4096 + half * 2048; }
__device__ __forceinline__ int crow(int r, int hi) { return (r & 3) + 8 * (r >> 2) + 4 * hi; }
__device__ __forceinline__ bool partialSM(f32x16& p0, f32x16& p1, float& m_reg, float& mn, float& alpha) {
    float pmax = p0[0];
#pragma unroll
    for (int r = 1; r < 16; ++r) pmax = fmaxf(pmax, p0[r]);
#pragma unroll
    for (int r = 0; r < 16; ++r) pmax = fmaxf(pmax, p1[r]);
    { auto rr = __builtin_amdgcn_permlane32_swap(__float_as_uint(pmax), __float_as_uint(pmax), false, false);
      pmax = fmaxf(__uint_as_float(rr[0]), __uint_as_float(rr[1])); }
    if (__all(pmax - m_reg < -106.f)) return false;
    if (__builtin_expect(__all((pmax - m_reg) <= THR), 1)) { mn = m_reg; alpha = 1.f; }
    else { mn = fmaxf(m_reg, pmax); alpha = __builtin_amdgcn_exp2f((m_reg - mn) * LOG2E); m_reg = mn; }
    const float mnL = -mn * LOG2E;
#pragma unroll
    for (int r = 0; r < 16; ++r) p0[r] = fmaf(p0[r], LOG2E, mnL);
#pragma unroll
    for (int r = 0; r < 16; ++r) p1[r] = fmaf(p1[r], LOG2E, mnL);
#pragma unroll
    for (int r = 0; r < 16; ++r) p0[r] = __builtin_amdgcn_exp2f(p0[r]);
    return true;
}
__device__ __forceinline__ void finishSM(f32x16& p0, f32x16& p1, float alpha, float& l_reg, bf16x8& pa0, bf16x8& pa1, bf16x8& pa2, bf16x8& pa3) {
#pragma unroll
    for (int r = 0; r < 16; ++r) p1[r] = __builtin_amdgcn_exp2f(p1[r]);
    float ps = 0;
#pragma unroll
    for (int r = 0; r < 16; ++r) ps += p0[r];
#pragma unroll
    for (int r = 0; r < 16; ++r) ps += p1[r];
    { auto rr = __builtin_amdgcn_permlane32_swap(__float_as_uint(ps), __float_as_uint(ps), false, false);
      ps = __uint_as_float(rr[0]) + __uint_as_float(rr[1]); }
    l_reg = l_reg * alpha + ps;
#define PK4(P, B_, OUT) do { unsigned a0 = cvt_pk_bf16(P[B_+0], P[B_+1]), a1 = cvt_pk_bf16(P[B_+2], P[B_+3]);                          \
        unsigned b0 = cvt_pk_bf16(P[B_+4], P[B_+5]), b1 = cvt_pk_bf16(P[B_+6], P[B_+7]);                                             \
        auto r0 = __builtin_amdgcn_permlane32_swap(a0, b0, false, false); auto r1 = __builtin_amdgcn_permlane32_swap(a1, b1, false, false); \
        u32x4 w = {r0[0], r1[0], r0[1], r1[1]}; OUT = __builtin_bit_cast(bf16x8, w); } while (0)
    PK4(p0, 0, pa0); PK4(p0, 8, pa1); PK4(p1, 0, pa2); PK4(p1, 8, pa3);
#undef PK4
}
template <int KB>
__device__ __forceinline__ void qkt(f32x16& p0, f32x16& p1, const LAS char* K_lds, int r32, int hi, const bf16x8* qr, bf16x8 kf0, bf16x8 kf1, bf16x8 qf) {
    const LAS char* kb[4];
#pragma unroll
    for (int dd = 0; dd < 4; ++dd) kb[dd] = K_lds + KB * SHM_K + KSWZ(r32, (dd * 16 + hi * 8) * 2);
    bf16x8 ka[2], kc[2];
    ka[0] = *(const LAS bf16x8*)(kb[0]); kc[0] = *(const LAS bf16x8*)(kb[0] + 32 * 256);
    p0 = __builtin_amdgcn_mfma_f32_32x32x16_bf16(kf0, qf, (f32x16){0.f, 0.f, 0.f, 0.f, 0.f, 0.f, 0.f, 0.f, 0.f, 0.f, 0.f, 0.f, 0.f, 0.f, 0.f, 0.f}, 0, 0, 0);
    p1 = __builtin_amdgcn_mfma_f32_32x32x16_bf16(kf1, qf, (f32x16){0.f, 0.f, 0.f, 0.f, 0.f, 0.f, 0.f, 0.f, 0.f, 0.f, 0.f, 0.f, 0.f, 0.f, 0.f, 0.f}, 0, 0, 0);
    SBAR();
#pragma unroll
    for (int d0 = 0; d0 < 8; ++d0) { const int c = d0 & 1;
        if (d0 < 7) { const LAS char* ap = kb[(d0 + 1) & 3] + ((d0 + 1) >> 2) * 128; ka[c ^ 1] = *(const LAS bf16x8*)(ap); kc[c ^ 1] = *(const LAS bf16x8*)(ap + 32 * 256); }
        p0 = __builtin_amdgcn_mfma_f32_32x32x16_bf16(ka[c], qr[d0], p0, 0, 0, 0);
        p1 = __builtin_amdgcn_mfma_f32_32x32x16_bf16(kc[c], qr[d0], p1, 0, 0, 0);
        SBAR(); }
}
template <int VB>
__device__ __forceinline__ void pv_tile(f32x16* o, int vb0, bf16x8 pa0, bf16x8 pa1, bf16x8 pa2, bf16x8 pa3) {
#define TRRD(dst, off) asm volatile("ds_read_b64_tr_b16 %0, %1 offset:%2" : "=&v"(dst) : "v"(vb0), "i"(off) : "memory")
#define PV_RD(S, d0) do { constexpr int b_ = VB * SHM_V + v_rd_off(d0, 0, 0); \
        TRRD(S[0], b_); TRRD(S[4], b_ + 2048); TRRD(S[1], b_ + 4096); TRRD(S[5], b_ + 6144); TRRD(S[2], b_ + 8192); TRRD(S[6], b_ + 10240); TRRD(S[3], b_ + 12288); TRRD(S[7], b_ + 14336); } while (0)
#define PV_MM(S, d0) do { \
        o[d0] = __builtin_amdgcn_mfma_f32_32x32x16_bf16(pa0, (bf16x8){S[0][0], S[0][1], S[0][2], S[0][3], S[4][0], S[4][1], S[4][2], S[4][3]}, o[d0], 0, 0, 0);   \
        o[d0] = __builtin_amdgcn_mfma_f32_32x32x16_bf16(pa1, (bf16x8){S[1][0], S[1][1], S[1][2], S[1][3], S[5][0], S[5][1], S[5][2], S[5][3]}, o[d0], 0, 0, 0);   \
        o[d0] = __builtin_amdgcn_mfma_f32_32x32x16_bf16(pa2, (bf16x8){S[2][0], S[2][1], S[2][2], S[2][3], S[6][0], S[6][1], S[6][2], S[6][3]}, o[d0], 0, 0, 0);   \
        o[d0] = __builtin_amdgcn_mfma_f32_32x32x16_bf16(pa3, (bf16x8){S[3][0], S[3][1], S[3][2], S[3][3], S[7][0], S[7][1], S[7][2], S[7][3]}, o[d0], 0, 0, 0); } while (0)
    s16x4 A[8], B[8];
    PV_RD(A, 0);
    PV_RD(B, 1); asm volatile("s_waitcnt lgkmcnt(8)" ::: "memory"); SBAR(); PV_MM(A, 0); SBAR();
    PV_RD(A, 2); asm volatile("s_waitcnt lgkmcnt(8)" ::: "memory"); SBAR(); PV_MM(B, 1); SBAR();
    PV_RD(B, 3); asm volatile("s_waitcnt lgkmcnt(8)" ::: "memory"); SBAR(); PV_MM(A, 2); SBAR();
    asm volatile("s_waitcnt lgkmcnt(0)" ::: "memory"); SBAR(); PV_MM(B, 3);
#undef PV_RD
#undef PV_MM
#undef TRRD
}
typedef const __attribute__((address_space(4))) unsigned long long* cmask_t;
__device__ __forceinline__ void mask_tile(f32x16& p0, f32x16& p1, const unsigned long long* mpg) {
    const float NEG = -__builtin_inff();
    cmask_t mp = (cmask_t)mpg;
    asm volatile("s_nop 15\n\ts_nop 7" : "+v"(p0), "+v"(p1));
#pragma unroll
    for (int r = 0; r < 16; ++r) { const unsigned long long m0 = mp[r], m1 = mp[16 + r];
        asm volatile("v_cndmask_b32 %0, %1, %0, %2" : "+v"(p0[r]) : "v"(NEG), "s"(m0));
        asm volatile("v_cndmask_b32 %0, %1, %0, %2" : "+v"(p1[r]) : "v"(NEG), "s"(m1)); }
}
template <int BUF>
__device__ __forceinline__ void tile_step(f32x16* o, float& m_reg, float& l_reg, const LAS char* K_lds, int vb0, LAS float* al_l, int r32, int hi, const bf16x8* qr,
                                          int kb_key, bf16x8 qf, const unsigned long long* mp) {
    f32x16 p0, p1; float mn, alpha; bf16x8 pa0, pa1, pa2, pa3;
    const unsigned kbb = __float_as_uint((float)kb_key) >> 16, k0b = __float_as_uint((float)r32) >> 16, k1b = __float_as_uint((float)(r32 + 32)) >> 16;
    u32x4 f0 = {hi ? 0u : (kbb | (k0b << 16)), 0u, 0u, 0u}, f1 = {hi ? 0u : (kbb | (k1b << 16)), 0u, 0u, 0u};
    qkt<BUF>(p0, p1, K_lds, r32, hi, qr, __builtin_bit_cast(bf16x8, f0), __builtin_bit_cast(bf16x8, f1), qf);
    mask_tile(p0, p1, mp);
    if (!partialSM(p0, p1, m_reg, mn, alpha)) return;
    finishSM(p0, p1, alpha, l_reg, pa0, pa1, pa2, pa3);
    if (__any(alpha < 1.f)) { if (hi == 0) al_l[r32] = alpha; asm volatile("s_waitcnt lgkmcnt(0)" ::: "memory");
#pragma unroll
        for (int r = 0; r < 16; ++r) { const float av = al_l[crow(r, hi)];
#pragma unroll
            for (int d_ = 0; d_ < 4; ++d_) o[d_][r] *= av; } }
    pv_tile<BUF>(o, vb0, pa0, pa1, pa2, pa3);
}
__device__ __forceinline__ void attn_unit(Frame& F, const float* __restrict__ qgain, int b, int g, int qb, unsigned* done_ctr) {
    const bf16_t* Q = (const bf16_t*)(F.ws + WS_Q); const bf16_t* K = (const bf16_t*)(F.ws + WS_K); const bf16_t* V = (const bf16_t*)(F.ws + WS_V);
    unsigned char* O = F.ws + WS_ATTN;
    const unsigned long long* MT = (const unsigned long long*)(F.ws + WS_MASK);
    LAS char* lds = (LAS char*)F.lds;
    const int wid = F.wave, lane = lane_id(), tid = wid * 64 + lane, r32 = lane & 31, hi = lane >> 5;
    const int hq = wid >> 1, th = wid & 1, h = 4 * g + hq, tok0 = b * SEQ + 64 * qb + 32 * th, NT = qb + 1;
    LAS char* V_lds = lds + LDS_V; LAS char* K_lds = lds + LDS_K; LAS float* wsf = (LAS float*)(lds + LDS_WS) + wid * 64; LAS float* li_l = wsf; LAS float* al_l = wsf + 32;
    const int sr = tid >> 4, sc = (tid & 15) * 8, vst0 = v_st(sr, sc), vst1 = v_st(32 + sr, sc), kws = KSWZ(sr, sc * 2);
    const int vb0 = (int)(uintptr_t)V_lds + v_rd_base(lane);
    bf16x8 qr[8];
    {
      u32x4 qw[8]; float ss = 0.f;
#pragma unroll
      for (int d0 = 0; d0 < 8; ++d0) { qw[d0] = *(const u32x4*)(Q + (size_t)(tok0 + r32) * AW + h * HD + d0 * 16 + hi * 8);
#pragma unroll
          for (int j = 0; j < 4; ++j) { const float lo = bflo(qw[d0][j]), hv = bfhi(qw[d0][j]); ss += lo * lo + hv * hv; } }
      { auto rr = __builtin_amdgcn_permlane32_swap(__float_as_uint(ss), __float_as_uint(ss), false, false); ss = __uint_as_float(rr[0]) + __uint_as_float(rr[1]); }
      const float rq = rsqrtf(ss * (1.0f / HD) + NORM_EPS) * 0.08838834764831845f;
#pragma unroll
      for (int d0 = 0; d0 < 8; ++d0) { const f32x4 g0 = *(const f32x4*)(qgain + d0 * 16 + hi * 8), g1 = *(const f32x4*)(qgain + d0 * 16 + hi * 8 + 4); u32x4 o;
          o[0] = cvt_pk_bf16(bflo(qw[d0][0]) * rq * g0[0], bfhi(qw[d0][0]) * rq * g0[1]); o[1] = cvt_pk_bf16(bflo(qw[d0][1]) * rq * g0[2], bfhi(qw[d0][1]) * rq * g0[3]);
          o[2] = cvt_pk_bf16(bflo(qw[d0][2]) * rq * g1[0], bfhi(qw[d0][2]) * rq * g1[1]); o[3] = cvt_pk_bf16(bflo(qw[d0][3]) * rq * g1[2], bfhi(qw[d0][3]) * rq * g1[3]);
          qr[d0] = __builtin_bit_cast(bf16x8, o); } }
    const unsigned sb = __float_as_uint(__builtin_ldexpf(1.0f, -(h + 1))) >> 16;
    const u32x4 qfw = {hi ? 0u : (sb | (sb << 16)), 0u, 0u, 0u}; const bf16x8 qf = __builtin_bit_cast(bf16x8, qfw);
    const bf16_t* Kg = K + (size_t)(b * SEQ) * KVW + g * HD + sc; const bf16_t* Vg = V + (size_t)(b * SEQ) * KVW + g * HD + sc;
    const unsigned long long* mrow = MT + (size_t)__builtin_amdgcn_readfirstlane(tok0 >> 5) * 64 * 32;
    float m_reg = -1e30f, l_reg = 0.f; f32x16 o[4] = {};
    bf16x8 st_k0, st_k1, st_v0, st_v1;
#define SLOAD(k0) do { st_k0 = *(const bf16x8*)(Kg + (size_t)((k0) + sr) * KVW); st_k1 = *(const bf16x8*)(Kg + (size_t)((k0) + 32 + sr) * KVW); \
                       st_v0 = *(const bf16x8*)(Vg + (size_t)((k0) + sr) * KVW); st_v1 = *(const bf16x8*)(Vg + (size_t)((k0) + 32 + sr) * KVW); } while (0)
#define SWRITE(bf) do { *(LAS bf16x8*)(K_lds + (bf) * SHM_K + kws) = st_k0; *(LAS bf16x8*)(K_lds + (bf) * SHM_K + kws + 32 * 256) = st_k1; \
                        *(LAS bf16x8*)(V_lds + (bf) * SHM_V + vst0) = st_v0; *(LAS bf16x8*)(V_lds + (bf) * SHM_V + vst1) = st_v1; } while (0)
#define TK(u_) (NT - 1 - (u_))
    SLOAD(TK(0) * KVBLK); SWRITE(0);
    __syncthreads();
    bool signaled = false;
    for (int t = 0; t < NT; t += 2) {
        if (done_ctr && !signaled && t + 8 >= NT) { signaled = true; if (wid == 0 && lane == 0) __hip_atomic_fetch_add(done_ctr, 1u, __ATOMIC_RELAXED, __HIP_MEMORY_SCOPE_AGENT); }
        if (t + 1 < NT) SLOAD(TK(t + 1) * KVBLK);
        tile_step<0>(o, m_reg, l_reg, K_lds, vb0, al_l, r32, hi, qr, TK(t) * KVBLK, qf, mrow + (size_t)TK(t) * 32);
        if (t + 1 < NT) SWRITE(1);
        __syncthreads();
        if (t + 1 < NT) {
            if (t + 2 < NT) SLOAD(TK(t + 2) * KVBLK);
            tile_step<1>(o, m_reg, l_reg, K_lds, vb0, al_l, r32, hi, qr, TK(t + 1) * KVBLK, qf, mrow + (size_t)TK(t + 1) * 32);
            if (t + 2 < NT) SWRITE(0);
            __syncthreads();
        }
    }
#undef TK
#undef SLOAD
#undef SWRITE
    if (hi == 0) li_l[r32] = l_reg; asm volatile("s_waitcnt lgkmcnt(0)" ::: "memory");
    unsigned char* Ow = O + (size_t)tok0 * AW + h * HD;
#pragma unroll
    for (int r = 0; r < 16; ++r) { const int orow = crow(r, hi); const float rl = __builtin_amdgcn_rcpf(li_l[orow]) * (FP8_MERGE ? A8_SCALE : 1.0f);
#pragma unroll
        for (int d0 = 0; d0 < 4; ++d0) { const float v = o[d0][r] * rl; const float v1 = __shfl_xor(v, 1);
            if constexpr (FP8_MERGE) { const float v2 = __shfl_xor(v, 2), v3 = __shfl_xor(v1, 2);
                if ((r32 & 3) == 0) *(unsigned*)(Ow + (size_t)orow * AW + d0 * 32 + r32) = pk4_fp8(v, v1, v2, v3); }
            else { if ((r32 & 1) == 0) *(unsigned*)((bf16_t*)O + (size_t)(tok0 + orow) * AW + h * HD + d0 * 32 + r32) = cvt_pk_bf16(v, v1); } } }
    __syncthreads();
}
#undef KSWZ
#undef SBAR
}
struct SchedPool {
    const char* A; const char* B; int c;
    __device__ __forceinline__ bool next(int i, pg8::Unit& u) const { if (i > 0 || c >= 128) return false; const int rt = c >> 2, g = c & 3; u.pm = rt; u.pn = g; u.aux = 0; u.tok = nullptr; u.nt8 = 0;
        u.A = A + ((size_t)rt * 256 * PW + g * 256) * 2; u.B = B + (size_t)g * 65536 * 2; return true; }
};
struct EpiPool {
    unsigned char* out; const float* pscale;
    __device__ __forceinline__ bool operator()(f32x4 (&acc)[2][2][4][2], const pg8::Unit& u, int wr, int wc, int fr, int fq) const {
        const int row0 = u.pm * 256 + wr * 64 + fr, col0 = u.pn * 256 + wc * 32 + 8 * fq;
#pragma unroll
        for (int bj = 0; bj < 2; ++bj) { const f32x4 s0 = *(const f32x4*)(pscale + col0 + bj * 128), s1 = *(const f32x4*)(pscale + col0 + bj * 128 + 4);
#pragma unroll
            for (int ai = 0; ai < 2; ++ai)
#pragma unroll
                for (int m = 0; m < 4; ++m) { const size_t o = (size_t)(row0 + ai * 128 + m * 16) * PW + col0 + bj * 128;
                    if constexpr (FP8_MERGE) { const f32x4 v0 = acc[ai][bj][m][0] * s0 * A8_SCALE, v1 = acc[ai][bj][m][1] * s1 * A8_SCALE; u32x2 w; w.x = pk4_fp8(v0[0], v0[1], v0[2], v0[3]); w.y = pk4_fp8(v1[0], v1[1], v1[2], v1[3]); *(u32x2*)(out + o) = w; }
                    else st_bf16x8((bf16_t*)out + o, acc[ai][bj][m][0] * s0, acc[ai][bj][m][1] * s1); } }
        return false;
    }
};
__device__ __forceinline__ void p4_pool_attn(Frame& F, const Args& a) {
    for (int c = blockIdx.x; c < 256; c += F.G) {
        const int bg = c >> 6, qb = c & 63;
        att::attn_unit(F, a.in[I_QNORM], bg >> 1, bg & 1, qb, (c + F.G >= 256) ? F.ctl + CW_DONE + 64 * 4 : nullptr);
        if (qb < 32) { const int pu = bg * 32 + qb, rt = pu >> 2, g = pu & 3;
            pooled_item(F, rt * 256 + 32 * F.wave, g, lane_id());
            asm volatile("s_waitcnt vmcnt(0)" ::: "memory"); __syncthreads();
            SchedPool S{(const char*)(F.ws + WS_POOLED), (const char*)(F.ws + WS_PLIN), pu}; EpiPool E{F.ws + WS_POOL, a.in[I_PSCALE]};
            pg8::gemm_phase<EpiPool, SchedPool, false>(F.lds, F.wave, 256 * 2, PW * 2, S, E); __syncthreads(); }
    }
}
struct SchedMerge {
    pg8::TileOrder T; const char* A0; const char* B0; const char* A1; const char* B1;
    __device__ __forceinline__ bool next(int i, pg8::Unit& u) const { int pm, pn; if (!T.tile(i >> 1, pm, pn)) return false; u.pm = pm; u.pn = pn; u.aux = i & 1; u.tok = nullptr; u.nt8 = 0;
        u.A = ((i & 1) ? A1 : A0) + (size_t)pm * 256 * 1024 * (FP8_MERGE ? 1 : 2); u.B = ((i & 1) ? B1 : B0) + (size_t)pn * 256 * 1024 * (FP8_MERGE ? 1 : 2); return true; }
};
struct EpiMerge {
    const bf16_t* G; unsigned char* out;
    __device__ __forceinline__ bool operator()(f32x4 (&acc)[2][2][4][2], const pg8::Unit& u, int wr, int wc, int fr, int fq) const {
        const int row0 = u.pm * 256 + wr * 64 + fr, col0 = u.pn * 256 + wc * 32 + 8 * fq;
#pragma unroll
        for (int ai = 0; ai < 2; ++ai)
#pragma unroll
            for (int m = 0; m < 4; ++m) { const size_t r = (size_t)(row0 + ai * 128 + m * 16);
#pragma unroll
                for (int bj = 0; bj < 2; ++bj) { const int c = col0 + bj * 128;
                    const u32x4 gp = *(const u32x4*)(G + r * (2 * DM) + DM + c);
                    const f32x4 p0 = {bflo(gp[0]), bfhi(gp[0]), bflo(gp[1]), bfhi(gp[1])}, p1 = {bflo(gp[2]), bfhi(gp[2]), bflo(gp[3]), bfhi(gp[3])};
                    if (u.aux == 0) { const u32x4 ga = *(const u32x4*)(G + r * (2 * DM) + c);
                        const f32x4 a0 = {bflo(ga[0]), bfhi(ga[0]), bflo(ga[1]), bfhi(ga[1])}, a1 = {bflo(ga[2]), bfhi(ga[2]), bflo(ga[3]), bfhi(ga[3])};
#pragma unroll
                        for (int j = 0; j < 4; ++j) { acc[ai][bj][m][0][j] *= a0[j] * __builtin_amdgcn_rcpf(fmaxf(p0[j], 1e-30f)); acc[ai][bj][m][1][j] *= a1[j] * __builtin_amdgcn_rcpf(fmaxf(p1[j], 1e-30f)); } }
                    else { if constexpr (FP8_OUT) { const f32x4 v0 = acc[ai][bj][m][0] * p0 * A8_SCALE, v1 = acc[ai][bj][m][1] * p1 * A8_SCALE; u32x2 w; w.x = pk4_fp8(v0[0], v0[1], v0[2], v0[3]); w.y = pk4_fp8(v1[0], v1[1], v1[2], v1[3]);
                        *(u32x2*)(out + r * DM + c) = w; } else st_bf16x8((bf16_t*)out + r * DM + c, acc[ai][bj][m][0] * p0, acc[ai][bj][m][1] * p1); } } }
        return u.aux == 0;
    }
};
__device__ __forceinline__ void p5_merge(Frame& F) {
    SchedMerge S; S.T.init(NTOK, DM, F.G, (int)blockIdx.x); S.A0 = (const char*)(F.ws + WS_ATTN); S.B0 = (const char*)(F.ws + WS_WAU); S.A1 = (const char*)(F.ws + WS_POOL); S.B1 = (const char*)(F.ws + WS_WPU);
    EpiMerge E{(const bf16_t*)(F.ws + WS_G), F.ws + WS_MERGED};
    constexpr int ES = FP8_MERGE ? 1 : 2;
    pg8::gemm_phase<EpiMerge, SchedMerge, false, ES, FP8_MERGE ? A8_E8 : 127, FP8_MERGE ? W8_E8 : 127>(F.lds, F.wave, 1024 * ES, 1024 * ES, S, E);
}
struct EpiOut {
    const float* x; const float* mod; float* out;
    __device__ __forceinline__ bool operator()(f32x4 (&acc)[2][2][4][2], const pg8::Unit& u, int wr, int wc, int fr, int fq) const {
        const int row0 = u.pm * 256 + wr * 64 + fr, col0 = u.pn * 256 + wc * 32 + 8 * fq; const int b = (u.pm * 256) / SEQ;
        const float* gm = mod + b * 6 * DM + 2 * DM;
#pragma unroll
        for (int bj = 0; bj < 2; ++bj) { const int c = col0 + bj * 128; const f32x4 g0 = *(const f32x4*)(gm + c), g1 = *(const f32x4*)(gm + c + 4);
#pragma unroll
            for (int ai = 0; ai < 2; ++ai)
#pragma unroll
                for (int m = 0; m < 4; ++m) { const size_t o = (size_t)(row0 + ai * 128 + m * 16) * DM + c;
                    const f32x4 x0 = *(const f32x4*)(x + o), x1 = *(const f32x4*)(x + o + 4);
                    *(f32x4*)(out + o) = x0 + g0 * acc[ai][bj][m][0]; *(f32x4*)(out + o + 4) = x1 + g1 * acc[ai][bj][m][1]; } }
        return false;
    }
};
__device__ __forceinline__ void p6_out(Frame& F, const Args& a) {
    SchedDense S; S.T.init(NTOK, DM, F.G, (int)blockIdx.x); S.A = (const char*)(F.ws + WS_MERGED); S.B = (const char*)(F.ws + WS_WOUT);
    constexpr int ES = FP8_OUT ? 1 : 2; S.a_tile = (size_t)256 * DM * ES; S.b_tile = (size_t)256 * DM * ES;
    EpiOut E{a.in[I_X], (const float*)(F.ctl + CW_MOD), F.out};
    pg8::gemm_phase<EpiOut, SchedDense, false, ES, FP8_OUT ? A8_E8 : 127, FP8_OUT ? W8_E8 : 127>(F.lds, F.wave, DM * ES, DM * ES, S, E);
}
constexpr int P7_ROWB = 4096 + 16;
constexpr int P7_ROWS = 32, P7_RW = P7_ROWS / NWAVES;
constexpr int P7_LDS_P = P7_ROWS * P7_ROWB;
constexpr int P7_LDS_H = P7_LDS_P + 2 * P7_ROWS * 64 * 4;
__device__ __forceinline__ void p7_router(Frame& F, const Args& a) {
    const float* mod = (const float*)(F.ctl + CW_MOD);
    unsigned char* hb8 = F.ws + WS_HB; const bf16_t* Wr = (const bf16_t*)(F.ws + WS_WR);
    unsigned char* rt = F.ws + WS_ROUTE;
    int* eid = (int*)(rt + RT_EID); float* gate = (float*)(rt + RT_GATE); int* posn = (int*)(rt + RT_POS); int* list = (int*)(rt + RT_LIST); int* ident = (int*)(rt + RT_IDENT);
    unsigned* ecnt = F.ctl + CW_ECNT;
    LAS unsigned char* lds = F.lds; LAS float* P = (LAS float*)(lds + P7_LDS_P); LAS unsigned* hist = (LAS unsigned*)(lds + P7_LDS_H); LAS unsigned* baseL = hist + 64;
    const int lane = lane_id(), w = F.wave, tid = w * 64 + lane;
    if (tid < 64) hist[tid] = 0u;
    __syncthreads();
    for (int p = blockIdx.x; p < NTOK / P7_ROWS; p += F.G) {
        const int row0 = P7_ROWS * p;
        { const int b = row0 / SEQ; const float* sh = mod + b * 6 * DM + 3 * DM; const float* sl = mod + b * 6 * DM + 4 * DM;
          f32x4 v[P7_RW][8];
#pragma unroll
          for (int rr = 0; rr < P7_RW; ++rr) { const float* xrow = F.out + (size_t)(row0 + P7_RW * w + rr) * DM;
#pragma unroll
              for (int j = 0; j < 8; ++j) v[rr][j] = *(const f32x4*)(xrow + 4 * lane + 256 * j); }
          float rstd[P7_RW];
#pragma unroll
          for (int rr = 0; rr < P7_RW; ++rr) { float ss = 0.f;
#pragma unroll
              for (int j = 0; j < 8; ++j) ss += (v[rr][j].x * v[rr][j].x + v[rr][j].y * v[rr][j].y) + (v[rr][j].z * v[rr][j].z + v[rr][j].w * v[rr][j].w);
              rstd[rr] = rsqrtf(wave_sum(ss) * (1.0f / DM) + NORM_EPS); }
#pragma unroll
          for (int j = 0; j < 8; ++j) { const int c = 4 * lane + 256 * j;
              const f32x4 gg = *(const f32x4*)(a.in[I_GFFN] + c), shv = *(const f32x4*)(sh + c), slv = *(const f32x4*)(sl + c); const f32x4 mul = gg * (slv + 1.0f);
#pragma unroll
              for (int rr = 0; rr < P7_RW; ++rr) { const int lr = P7_RW * w + rr, m = row0 + lr;
                  const f32x4 o = v[rr][j] * rstd[rr] * mul + shv;
                  u32x2 wv; wv.x = cvt_pk_bf16(o.x, o.y); wv.y = cvt_pk_bf16(o.z, o.w);
                  *(unsigned*)(hb8 + (size_t)m * DM + c) = pk4_fp8(o.x * H8_SCALE, o.y * H8_SCALE, o.z * H8_SCALE, o.w * H8_SCALE); *(LAS u32x2*)(lds + lr * P7_ROWB + c * 2) = wv; } }
          if (lane < P7_RW) ident[row0 + P7_RW * w + lane] = row0 + P7_RW * w + lane;
        }
        __syncthreads();
        { const int nb = w & 3, kh = w >> 2, fr = lane & 15, kq = lane >> 4;
          f32x4 acc[2] = {{0.f, 0.f, 0.f, 0.f}, {0.f, 0.f, 0.f, 0.f}};
          const bf16_t* wp = Wr + (size_t)(16 * nb + fr) * DM + 1024 * kh + 8 * kq;
          const LAS unsigned char* ap = lds + fr * P7_ROWB + (1024 * kh + 8 * kq) * 2;
#pragma unroll 8
          for (int s = 0; s < 32; ++s) { const bf16x8 bv = *(const bf16x8*)(wp + 32 * s);
#pragma unroll
              for (int mb = 0; mb < 2; ++mb) { const bf16x8 av = *(const LAS bf16x8*)(ap + mb * 16 * P7_ROWB + 64 * s); acc[mb] = __builtin_amdgcn_mfma_f32_16x16x32_bf16(av, bv, acc[mb], 0, 0, 0); } }
#pragma unroll
          for (int mb = 0; mb < 2; ++mb)
#pragma unroll
              for (int j = 0; j < 4; ++j) P[(kh * P7_ROWS + 16 * mb + 4 * kq + j) * 64 + 16 * nb + fr] = acc[mb][j];
        }
        __syncthreads();
        int myrank[P7_RW]; unsigned mylocal[P7_RW]; bool chosen[P7_RW]; float mygate[P7_RW];
#pragma unroll
        for (int rr = 0; rr < P7_RW; ++rr) { const int lr = P7_RW * w + rr;
            const float logit = P[lr * 64 + lane] + P[(P7_ROWS + lr) * 64 + lane];
            const float score = 1.0f / (1.0f + __expf(-logit)); const float sel = score + a.in[I_RBIAS][lane];
            float m1 = sel; m1 = fmaxf(m1, __shfl_xor(m1, 1)); m1 = fmaxf(m1, __shfl_xor(m1, 2)); m1 = fmaxf(m1, __shfl_xor(m1, 4));
            const unsigned long long bm = __ballot(sel == m1); const unsigned grp = (unsigned)((bm >> (lane & ~7)) & 0xffull); const int first = __builtin_ctz(grp | 0x100u);
            float m2 = ((lane & 7) == first) ? -__builtin_inff() : sel; m2 = fmaxf(m2, __shfl_xor(m2, 1)); m2 = fmaxf(m2, __shfl_xor(m2, 2)); m2 = fmaxf(m2, __shfl_xor(m2, 4));
            const float gs = m1 + m2; const int g = lane >> 3; int grank = 0;
#pragma unroll
            for (int g2 = 0; g2 < 8; ++g2) { const float o = __uint_as_float(__builtin_amdgcn_readlane(__float_as_uint(gs), 8 * g2)); grank += (o > gs || (o == gs && g2 < g)) ? 1 : 0; }
            const float selm = grank < TOPG ? sel : -__builtin_inff(); int rank = 0;
#pragma unroll
            for (int e2 = 0; e2 < 64; ++e2) { const float o = __uint_as_float(__builtin_amdgcn_readlane(__float_as_uint(selm), e2)); rank += (o > selm || (o == selm && e2 < lane)) ? 1 : 0; }
            const bool ch = rank < ETOP && grank < TOPG; const float gsum = wave_sum(ch ? score : 0.f);
            chosen[rr] = ch; myrank[rr] = rank; mygate[rr] = score / gsum * ROUTED_SCALE;
            mylocal[rr] = ch ? __hip_atomic_fetch_add(hist + lane, 1u, __ATOMIC_RELAXED, __HIP_MEMORY_SCOPE_WORKGROUP) : 0u;
        }
        __syncthreads();
        if (w == 0) { const unsigned c = hist[lane]; baseL[lane] = c ? __hip_atomic_fetch_add(ecnt + lane, c, __ATOMIC_RELAXED, __HIP_MEMORY_SCOPE_AGENT) : 0u; hist[lane] = 0u; }
        __syncthreads();
#pragma unroll
        for (int rr = 0; rr < P7_RW; ++rr) if (chosen[rr]) { const int m = row0 + P7_RW * w + rr; const unsigned pos = baseL[lane] + mylocal[rr];
            eid[m * 8 + myrank[rr]] = lane; gate[m * 8 + myrank[rr]] = mygate[rr]; posn[m * 8 + myrank[rr]] = (int)pos; list[(size_t)lane * NTOK + pos] = m; }
        __syncthreads();
    }
}
constexpr int MOE_LDS = 131072;
__device__ __forceinline__ int moe_prefix(Frame& F) {
    LAS int* rtoff = (LAS int*)(F.lds + MOE_LDS);
    if (F.wave == 0 && lane_id() == 0) { int s = 0; for (int e = 0; e < NE; ++e) { rtoff[e] = s; unsigned n = F.ctl[CW_ECNT + e]; if (n > (unsigned)NTOK) n = NTOK; s += (int)((n + 255u) >> 8); } rtoff[NE] = s; }
    __syncthreads();
    return __builtin_amdgcn_readfirstlane(rtoff[NE]);
}
__device__ __forceinline__ int moe_find(const LAS int* rtoff, int rtg) {
    int lo = 0, hi = NE;
#pragma unroll
    for (int it = 0; it < 6; ++it) { const int mid = (lo + hi) >> 1; const int v = __builtin_amdgcn_readfirstlane(rtoff[mid]); if (v <= rtg) lo = mid; else hi = mid; }
    return lo;
}
struct SchedMoe1 {
    const LAS int* rtoff; int RT, G, c; const char* hb; const char* w13; const char* ws13; const int* list; const int* ident;
    __device__ __forceinline__ bool next(int i, pg8::Unit& u) const {
        const int idx = i * G + c; if (idx >= (RT + NTOK / 256) * 4) return false;
        const int rtg = idx >> 2, ct = idx & 3; u.pn = ct; u.aux = 0; u.nt8 = 0; u.A = hb;
        if (rtg < RT) { const int e = moe_find(rtoff, rtg), rt = rtg - __builtin_amdgcn_readfirstlane(rtoff[e]); u.pm = rtg; u.tok = list + (size_t)e * NTOK + rt * 256;
            u.B = w13 + ((size_t)e * 1024 + ct * 256) * DM; }
        else { const int rt = rtg - RT; u.pm = HROWS_R / 256 + rt; u.tok = ident + rt * 256; u.B = ws13 + (size_t)(ct * 256) * DM; }
        return true; }
};
struct EpiMoe1 {
    unsigned char* H;
    __device__ __forceinline__ bool operator()(f32x4 (&acc)[2][2][4][2], const pg8::Unit& u, int wr, int wc, int fr, int fq) const {
        const int row0 = u.pm * 256 + wr * 64 + fr, col0 = u.pn * 128 + wc * 32 + 8 * fq;
#pragma unroll
        for (int ai = 0; ai < 2; ++ai)
#pragma unroll
            for (int m = 0; m < 4; ++m) { f32x4 h0, h1;
#pragma unroll
                for (int j = 0; j < 4; ++j) { const float g0 = acc[ai][0][m][0][j], g1 = acc[ai][0][m][1][j];
                    h0[j] = g0 * __builtin_amdgcn_rcpf(1.0f + __expf(-g0)) * acc[ai][1][m][0][j]; h1[j] = g1 * __builtin_amdgcn_rcpf(1.0f + __expf(-g1)) * acc[ai][1][m][1][j]; }
                u32x2 w; w.x = pk4_fp8(h0[0] * H8_SCALE, h0[1] * H8_SCALE, h0[2] * H8_SCALE, h0[3] * H8_SCALE); w.y = pk4_fp8(h1[0] * H8_SCALE, h1[1] * H8_SCALE, h1[2] * H8_SCALE, h1[3] * H8_SCALE);
                *(u32x2*)(H + (size_t)(row0 + ai * 128 + m * 16) * EH + col0) = w; }
        return false;
    }
};
__device__ __forceinline__ void p8_gemm1(Frame& F, const Args& a) {
    const int RT = moe_prefix(F);
    const int U = (RT + NTOK / 256) * 4, R0 = (U + F.G - 1) / F.G, R = (R0 * F.G - U < 24 * R0) ? R0 + 1 : R0, NG = (U + R - 1) / R;
    if ((int)blockIdx.x >= NG) { conv_drain<false, 1, 2>(F, a, 8); return; }
    SchedMoe1 S{(const LAS int*)(F.lds + MOE_LDS), RT, NG, (int)blockIdx.x, (const char*)(F.ws + WS_HB), (const char*)(F.ws + WS_W13), (const char*)(F.ws + WS_WS13),
                (const int*)(F.ws + WS_ROUTE + RT_LIST), (const int*)(F.ws + WS_ROUTE + RT_IDENT)};
    EpiMoe1 E{F.ws + WS_H};
    pg8::gemm_phase<EpiMoe1, SchedMoe1, true, 1, H8_E8, W8_E8>(F.lds, F.wave, DM, DM, S, E);
    conv_drain<false, 1, 2>(F, a, 8);
}
struct SchedMoe2 {
    const LAS int* rtoff; int RT, G, c; const char* H; const char* w2; const char* ws2;
    __device__ __forceinline__ bool next(int i, pg8::Unit& u) const {
        const int idx = i * G + c; if (idx >= (RT + NTOK / 256) * 8) return false;
        const int rtg = idx >> 3, ct = idx & 7; u.pn = ct; u.aux = 0; u.tok = nullptr; u.nt8 = 0;
        if (rtg < RT) { const int e = moe_find(rtoff, rtg); u.pm = rtg; u.B = w2 + ((size_t)e * DM + ct * 256) * EH; }
        else { u.pm = HROWS_R / 256 + (rtg - RT); u.B = ws2 + (size_t)(ct * 256) * EH; }
        u.A = H + (size_t)u.pm * 256 * EH; return true; }
};
constexpr float Y8_SCALE = 8.f;
struct EpiY {
    unsigned char* Y;
    __device__ __forceinline__ bool operator()(f32x4 (&acc)[2][2][4][2], const pg8::Unit& u, int wr, int wc, int fr, int fq) const {
        const int row0 = u.pm * 256 + wr * 64 + fr, col0 = u.pn * 256 + wc * 32 + 8 * fq;
#pragma unroll
        for (int ai = 0; ai < 2; ++ai)
#pragma unroll
            for (int m = 0; m < 4; ++m)
#pragma unroll
                for (int bj = 0; bj < 2; ++bj) { const f32x4 v0 = acc[ai][bj][m][0] * Y8_SCALE, v1 = acc[ai][bj][m][1] * Y8_SCALE; u32x2 w; w.x = pk4_fp8(v0[0], v0[1], v0[2], v0[3]); w.y = pk4_fp8(v1[0], v1[1], v1[2], v1[3]);
                    *(u32x2*)(Y + (size_t)(row0 + ai * 128 + m * 16) * DM + col0 + bj * 128) = w; }
        return false;
    }
};
__device__ __forceinline__ void p9_gemm2(Frame& F) {
    const int RT = moe_prefix(F);
    SchedMoe2 S{(const LAS int*)(F.lds + MOE_LDS), RT, F.G, (int)blockIdx.x, (const char*)(F.ws + WS_H), (const char*)(F.ws + WS_W2), (const char*)(F.ws + WS_WS2)};
    EpiY E{F.ws + WS_Y};
    pg8::gemm_phase<EpiY, SchedMoe2, false, 1, H8_E8, W8_E8>(F.lds, F.wave, EH, EH, S, E);
}
__device__ __forceinline__ void p10_combine(Frame& F) {
    (void)moe_prefix(F);
    const LAS int* rtoff = (const LAS int*)(F.lds + MOE_LDS);
    const unsigned char* Y = F.ws + WS_Y; unsigned char* rt = F.ws + WS_ROUTE;
    const int* eid = (const int*)(rt + RT_EID); const float* gate = (const float*)(rt + RT_GATE); const int* posn = (const int*)(rt + RT_POS); const float* mod = (const float*)(F.ctl + CW_MOD);
    const int lane = lane_id();
    size_t yr[9]; float g[9]; unsigned yv[9][8];
#define P10_ROUTE(t_) do { const u32x4 e0 = *(const u32x4*)(eid + (t_) * 8), e1 = *(const u32x4*)(eid + (t_) * 8 + 4), p0 = *(const u32x4*)(posn + (t_) * 8), p1 = *(const u32x4*)(posn + (t_) * 8 + 4); \
        const f32x4 g0 = *(const f32x4*)(gate + (t_) * 8), g1 = *(const f32x4*)(gate + (t_) * 8 + 4); \
        _Pragma("unroll") for (int k = 0; k < 8; ++k) { const int e = __builtin_amdgcn_readfirstlane((int)(k < 4 ? e0[k & 3] : e1[k & 3])) & 63, p = __builtin_amdgcn_readfirstlane((int)(k < 4 ? p0[k & 3] : p1[k & 3])); \
            yr[k] = (size_t)(256 * __builtin_amdgcn_readfirstlane(rtoff[e]) + p) * DM; g[k] = __uint_as_float(__builtin_amdgcn_readfirstlane(__float_as_uint(k < 4 ? g0[k & 3] : g1[k & 3]))); } \
        yr[8] = (size_t)(HROWS_R + (t_)) * DM; g[8] = 1.0f; } while (0)
#define P10_YLOAD() do { _Pragma("unroll") for (int k = 0; k < 9; ++k) { _Pragma("unroll") for (int j = 0; j < 8; ++j) yv[k][j] = __builtin_nontemporal_load((const unsigned*)(Y + yr[k] + 4 * lane + 256 * j)); } } while (0)
    int t = F.gw;
    if (t < NTOK) { P10_ROUTE(t); P10_YLOAD(); }
    for (; t < NTOK; t += F.NGW) {
        const int b = t / SEQ; const float* gf = mod + b * 6 * DM + 5 * DM + 4 * lane;
        float* orow = F.out + (size_t)t * DM + 4 * lane;
        f32x4 xv[8];
#pragma unroll
        for (int j = 0; j < 8; ++j) xv[j] = *(const f32x4*)(orow + 256 * j);
        f32x4 s[8];
#pragma unroll
        for (int j = 0; j < 8; ++j) s[j] = (f32x4){0.f, 0.f, 0.f, 0.f};
#pragma unroll
        for (int k = 0; k < 9; ++k)
#pragma unroll
            for (int j = 0; j < 8; ++j) { const f32x2 lo = __builtin_amdgcn_cvt_pk_f32_fp8((int)yv[k][j], false), hi = __builtin_amdgcn_cvt_pk_f32_fp8((int)yv[k][j], true);
                s[j][0] += lo[0] * g[k]; s[j][1] += lo[1] * g[k]; s[j][2] += hi[0] * g[k]; s[j][3] += hi[1] * g[k]; }
        const int tn = t + F.NGW;
        if (tn < NTOK) { P10_ROUTE(tn); P10_YLOAD(); }
#pragma unroll
        for (int j = 0; j < 8; ++j) *(f32x4*)(orow + 256 * j) = xv[j] + *(const f32x4*)(gf + 256 * j) * s[j] * (1.0f / Y8_SCALE);
    }
#undef P10_ROUTE
#undef P10_YLOAD
}
constexpr int LDS_BYTES = 155648;
constexpr int N_PHASES = 11;
#ifndef PROBE_REP
#define PROBE_REP -1
#endif
#define REP(k, stmt) do { stmt; if (PROBE_REP == (k)) { __syncthreads(); stmt; } } while (0)
__global__ void __launch_bounds__(NTHR, 2) fwd(Args args) {
    extern __shared__ __attribute__((aligned(16))) unsigned char lds_raw[];
    Frame F; F.lds = (LAS unsigned char*)lds_raw; F.wave = __builtin_amdgcn_readfirstlane((int)threadIdx.x >> 6);
    F.G = gridDim.x; F.gw = blockIdx.x * NWAVES + F.wave; F.NGW = F.G * NWAVES; F.ws = args.ws; F.ctl = (unsigned*)(args.ws + WS_CTL); F.out = args.out;
    volatile LAS unsigned* xbw = (volatile LAS unsigned*)(F.lds + LDS_BYTES - 16);
    if (threadIdx.x < 4) xbw[threadIdx.x] = 0u;
    __syncthreads();
    const bool one = (args.ph_hi - args.ph_lo) > 1;
    XcdBarrier bar; bar.bar = F.ctl + CW_BAR; bar.x = 0; bar.st = xbw;
    if (one) bar = xcd_barrier_post(F.ctl + CW_BAR, xbw, F.wave);
    const int lo = args.ph_lo, hi = args.ph_hi;
#ifndef PROBE_TIME
#define PROBE_TIME -1
#endif
    unsigned long long pt0 = 0ull, pt1 = 0ull;
#define TSTAMP(k, which) do { if (PROBE_TIME == (k) && blockIdx.x == 0) { if (which) pt1 = __builtin_amdgcn_s_memrealtime(); else pt0 = __builtin_amdgcn_s_memrealtime(); } } while (0)
#define IN(k) (lo <= (k) && (k) < hi)
#define SEAM(k) do { if (IN(k) && IN((k) + 1)) xcd_barrier(bar, F.wave); } while (0)
    TSTAMP(0, 0); if (IN(0)) { REP(0, p0_prologue(F, args)); } SEAM(0); TSTAMP(0, 1);
    TSTAMP(1, 0); if (IN(1)) { REP(1, p1_h(F, args)); } SEAM(1); TSTAMP(1, 1);
    TSTAMP(2, 0); if (IN(2)) { REP(2, p2_inproj(F, args)); } SEAM(2); TSTAMP(2, 1);
    TSTAMP(3, 0); if (IN(3)) { p3_qknorm(F, args); __syncthreads(); REP(3, p3_indexer(F, args)); } SEAM(3); TSTAMP(3, 1);
    TSTAMP(4, 0); if (IN(4)) { REP(4, p4_pool_attn(F, args)); if (one) { conv_drain<true, 0, 2>(F, args, 4); } } SEAM(4); TSTAMP(4, 1);
    TSTAMP(5, 0); if (IN(5)) { REP(5, p5_merge(F)); } SEAM(5); TSTAMP(5, 1);
    TSTAMP(6, 0); if (IN(6)) { REP(6, p6_out(F, args)); } SEAM(6); TSTAMP(6, 1);
    TSTAMP(7, 0); if (IN(7)) { p7_router(F, args); conv_drain<false, 0, 1>(F, args, 7); }
    SEAM(7); TSTAMP(7, 1);
    TSTAMP(8, 0); if (IN(8)) { REP(8, p8_gemm1(F, args)); } SEAM(8); TSTAMP(8, 1);
    TSTAMP(9, 0); if (IN(9)) { REP(9, p9_gemm2(F)); } SEAM(9); TSTAMP(9, 1);
    TSTAMP(10, 0); if (IN(10)) { p10_combine(F); } TSTAMP(10, 1);
    if (PROBE_TIME >= 0 && blockIdx.x == 0) { const unsigned long long tend = __builtin_amdgcn_s_memrealtime() + 4ull * (pt1 - pt0); while (__builtin_amdgcn_s_memrealtime() < tend) __builtin_amdgcn_s_sleep(8); }
#undef IN
#undef SEAM
}
#ifndef N_LAUNCHES
#define N_LAUNCHES 1
#endif
extern "C" void kernel_launch(void* const* d_in, const int* in_sizes, int n_in, void* d_out, int out_size, void* d_ws, size_t ws_size, hipStream_t stream) {
    static int grid = 0;
    if (grid == 0) {
        if (n_in != 22 || out_size != NTOK * DM || ws_size < WS_END) { fprintf(stderr, "kernel_launch: unexpected shapes (n_in %d out %d ws %zu need %zu)\n", n_in, out_size, ws_size, (size_t)WS_END); grid = -1; return; }
        int dev = 0, cus = 0, per_cu = 0;
        if (hipGetDevice(&dev) != hipSuccess || hipDeviceGetAttribute(&cus, hipDeviceAttributeMultiprocessorCount, dev) != hipSuccess) { grid = -1; return; }
        if (hipFuncSetAttribute((const void*)fwd, hipFuncAttributeMaxDynamicSharedMemorySize, LDS_BYTES) != hipSuccess) { fprintf(stderr, "kernel_launch: hipFuncSetAttribute failed\n"); grid = -1; return; }
        if (hipOccupancyMaxActiveBlocksPerMultiprocessor(&per_cu, (const void*)fwd, NTHR, LDS_BYTES) != hipSuccess || per_cu < 1) fprintf(stderr, "kernel_launch: occupancy query says %d\n", per_cu);
        (void)hipGetLastError();
        grid = cus;
    }
    if (grid < 0) return;
    (void)hipMemsetAsync((char*)d_ws + WS_CTL, 0, CTL_BYTES, stream);
    Args a{};
    for (int i = 0; i < 22; ++i) a.in[i] = (const float*)d_in[i];
    a.out = (float*)d_out; a.ws = (unsigned char*)d_ws;
    if (N_LAUNCHES == 1) { a.ph_lo = 0; a.ph_hi = N_PHASES; hipLaunchKernelGGL(fwd, dim3(grid), dim3(NTHR), LDS_BYTES, stream, a); }
    else for (int p = 0; p < N_PHASES; ++p) { a.ph_lo = p; a.ph_hi = p + 1; hipLaunchKernelGGL(fwd, dim3(grid), dim3(NTHR), LDS_BYTES, stream, a); }
}
```

```cpp
#include <hip/hip_runtime.h>
#include <cstdio>
#include <cstdint>

#define LAS __attribute__((address_space(3)))
#define GAS __attribute__((address_space(1)))
typedef unsigned short bf16_t;
typedef short bf16x8 __attribute__((ext_vector_type(8)));
typedef short s16x4 __attribute__((ext_vector_type(4)));
typedef float f32x4 __attribute__((ext_vector_type(4)));
typedef float f32x2 __attribute__((ext_vector_type(2)));
typedef float f32x16 __attribute__((ext_vector_type(16)));
typedef unsigned u32x4 __attribute__((ext_vector_type(4)));
typedef unsigned u32x2 __attribute__((ext_vector_type(2)));

constexpr int DM = 2048, NB = 2, SEQ = 4096, NTOK = NB * SEQ;
constexpr int NH = 8, HD = 128, NKV = 2, AW = 1024, KVW = 256, IH = 16, ID = 64, TOPK = 256;
constexpr int PW = 1024, INW = 7760, INP = 7936;
constexpr int NE = 64, EH = 512, NGRP = 8, EPG = 8, TOPG = 4, ETOP = 8;
constexpr float NORM_EPS = 1e-6f, ROUTED_SCALE = 2.5f;
constexpr int NTHR = 512, NWAVES = 8;

constexpr size_t MiB = 1u << 20;
constexpr size_t WS_CTL = 0, CTL_BYTES = 1 * MiB;
constexpr size_t WS_W13 = 1 * MiB;
constexpr size_t WS_W2 = WS_W13 + 256 * MiB;
constexpr size_t WS_WS13 = WS_W2 + 128 * MiB;
constexpr size_t WS_WS2 = WS_WS13 + 4 * MiB;
constexpr size_t WS_H = WS_WS2 + 2 * MiB;
constexpr int HROWS_R = 65536 + 64 * 256, HROWS = HROWS_R + NTOK;
constexpr size_t WS_ROUTE = WS_H + (size_t)HROWS * EH * 2;
constexpr size_t RT_EID = 0, RT_GATE = RT_EID + (size_t)NTOK * 8 * 4, RT_POS = RT_GATE + (size_t)NTOK * 8 * 4, RT_LIST = RT_POS + (size_t)NTOK * 8 * 4,
                 RT_IDENT = RT_LIST + (size_t)NE * NTOK * 4, RT_END = RT_IDENT + (size_t)NTOK * 4;
constexpr size_t WS_R = (WS_ROUTE + RT_END + MiB - 1) / MiB * MiB;
constexpr size_t WS_Y = WS_R;
constexpr size_t WS_WIN = WS_R;
constexpr size_t WS_WAU = WS_WIN + 31 * MiB, WS_WPU = WS_WAU + 4 * MiB, WS_WOUT = WS_WPU + 4 * MiB, WS_PLIN = WS_WOUT + 8 * MiB, WS_WR = WS_PLIN + MiB / 2;
constexpr size_t WS_HB = WS_WR + MiB / 2;
constexpr size_t WS_Q = WS_HB + 32 * MiB, WS_K = WS_Q + 16 * MiB, WS_V = WS_K + 4 * MiB, WS_QI = WS_V + 4 * MiB, WS_KW = WS_QI + 16 * MiB, WS_U = WS_KW + 4 * MiB,
                 WS_G = WS_U + 16 * MiB;
constexpr size_t WS_POOLED = WS_G + 64 * MiB, WS_POOL = WS_POOLED + 16 * MiB, WS_ATTN = WS_POOL + 16 * MiB, WS_MERGED = WS_ATTN + 16 * MiB, WS_MASK = WS_MERGED + 32 * MiB,
                 WS_H8 = WS_MASK + 4 * MiB,
                 WS_REND = WS_H8 + 32 * MiB;
constexpr size_t WS_END = WS_Y + (size_t)HROWS_R * DM * 2;
static_assert(WS_REND <= WS_END, "overlay region");
constexpr int CW_BAR = 4096;
constexpr int CW_ECNT = 8192;
constexpr int CW_CONVQ = 12288;
constexpr int CW_DONE = 12544;
constexpr int CW_MOD = 16384;
static_assert((CW_MOD + 2 * 6 * DM) * 4 <= (int)CTL_BYTES, "ctl");

__device__ __forceinline__ int lane_id() { int l; asm volatile("v_mbcnt_lo_u32_b32 %0, -1, 0\n\tv_mbcnt_hi_u32_b32 %0, -1, %0" : "=v"(l)); return l; }
__device__ __forceinline__ unsigned cvt_pk_bf16(float lo, float hi) { unsigned r; asm volatile("v_cvt_pk_bf16_f32 %0, %1, %2" : "=v"(r) : "v"(lo), "v"(hi)); return r; }
__device__ __forceinline__ unsigned pk4_fp8(float a, float b, float c, float d) {
    a = __builtin_amdgcn_fmed3f(a, -448.f, 448.f); b = __builtin_amdgcn_fmed3f(b, -448.f, 448.f); c = __builtin_amdgcn_fmed3f(c, -448.f, 448.f); d = __builtin_amdgcn_fmed3f(d, -448.f, 448.f);
    int w = __builtin_amdgcn_cvt_pk_fp8_f32(a, b, 0, false); w = __builtin_amdgcn_cvt_pk_fp8_f32(c, d, w, true); return (unsigned)w; }
#ifndef FP8_INPROJ
#define FP8_INPROJ 0
#endif
#ifndef FP8_MERGE
#define FP8_MERGE 1
#endif
#ifndef FP8_OUT
#define FP8_OUT 1
#endif
constexpr float W8_SCALE = 8.f;   constexpr int W8_E8 = 127 - 3;
constexpr float H8_SCALE = 8.f;   constexpr int H8_E8 = 127 - 3;
constexpr float A8_SCALE = 8.f;   constexpr int A8_E8 = 127 - 3;
__device__ __forceinline__ float bf2f(unsigned short b) { return __uint_as_float(((unsigned)b) << 16); }
__device__ __forceinline__ float bflo(unsigned w) { return __uint_as_float(w << 16); }
__device__ __forceinline__ float bfhi(unsigned w) { return __uint_as_float(w & 0xffff0000u); }
__device__ __forceinline__ float wave_sum(float v) {
#pragma unroll
    for (int o = 1; o < 64; o <<= 1) v += __shfl_xor(v, o);
    return v;
}
__device__ __forceinline__ float sigmoidf_(float x) { return 1.0f / (1.0f + __expf(-x)); }

#define XB_TMO      128
#define XB_XCNT(j)  (256  + 64 * (j))
#define XB_XSUB(j)  (1280 + 64 * (j))
#define XB_XGEN(j)  (2304 + 64 * (j))
#define XB_TOP      3328
#define XB_TOPGEN   3392
#define XCD_BAR_WORDS 3456
#define XB_SPIN_CAP (1u << 18)
__device__ __forceinline__ unsigned xb_ld(unsigned* p)              { return __hip_atomic_load(p, __ATOMIC_RELAXED, __HIP_MEMORY_SCOPE_AGENT); }
__device__ __forceinline__ unsigned xb_add(unsigned* p, unsigned v) { return __hip_atomic_fetch_add(p, v, __ATOMIC_RELAXED, __HIP_MEMORY_SCOPE_AGENT); }
__device__ __forceinline__ unsigned xb_xcc_id() { return (unsigned)__builtin_amdgcn_s_getreg((3 << 11) | 20) & 0xFu; }
#define XB_SPIN(cond, bar) do { unsigned _sp = 0; while (cond) { __builtin_amdgcn_s_sleep(1); \
    if ((++_sp & 255u) == 0u) { if (xb_ld(&(bar)[XB_TMO])) break; if (_sp > XB_SPIN_CAP) { atomicAdd(&(bar)[XB_TMO], 1u); break; } } } } while (0)
struct XcdBarrier { unsigned* bar; unsigned x; volatile LAS unsigned* st; };
__device__ __forceinline__ XcdBarrier xcd_barrier_post(unsigned* bar, volatile LAS unsigned* st, int wave) {
    XcdBarrier b; b.bar = bar; b.x = xb_xcc_id(); b.st = st;
    if (wave == 0 && lane_id() == 0) (void)xb_add(&bar[XB_XCNT(b.x)], 1u);
    return b;
}
__device__ __forceinline__ void xcd_barrier_complete(unsigned* bar, unsigned x, unsigned& nloc, unsigned& nx) {
    const unsigned G = gridDim.x * gridDim.y * gridDim.z;
    unsigned sum, cnt, mine, sp = 0u;
    for (;;) {
        sum = 0u; cnt = 0u; mine = 0u;
#pragma unroll
        for (unsigned j = 0; j < 16; ++j) { const unsigned c = xb_ld(&bar[XB_XCNT(j)]); sum += c; cnt += (c > 0u) ? 1u : 0u; mine = (j == x) ? c : mine; }
        if (sum == G) break;
        __builtin_amdgcn_s_sleep(1);
        if ((++sp & 255u) == 0u) { if (xb_ld(&bar[XB_TMO])) break; if (sp > XB_SPIN_CAP) { atomicAdd(&bar[XB_TMO], 1u); break; } }
    }
    nloc = mine > 0u ? mine : 1u; nx = cnt > 0u ? cnt : 1u;
}
__device__ __forceinline__ void xcd_barrier(const XcdBarrier& b, int wave) {
    asm volatile("s_waitcnt vmcnt(0)" ::: "memory");
    __syncthreads();
    if (wave == 0 && lane_id() == 0) {
        unsigned* bar = b.bar;
        __builtin_amdgcn_s_waitcnt(0);
        unsigned nloc = b.st[0], nx = b.st[1];
        if (nloc == 0u) { xcd_barrier_complete(bar, b.x, nloc, nx); b.st[0] = nloc; b.st[1] = nx; }
        const unsigned old = xb_add(&bar[XB_XSUB(b.x)], 1u);
        const unsigned gen = old / nloc;
        if (old + 1u == (gen + 1u) * nloc) {
            __builtin_amdgcn_fence(__ATOMIC_RELEASE, "agent");
            asm volatile("s_waitcnt vmcnt(0)" ::: "memory");
            const unsigned og = xb_add(&bar[XB_TOP], 1u);
            const unsigned tg = og / nx;
            if (og + 1u == (tg + 1u) * nx) xb_add(&bar[XB_TOPGEN], 1u);
            else XB_SPIN(xb_ld(&bar[XB_TOPGEN]) == tg, bar);
            __builtin_amdgcn_fence(__ATOMIC_ACQUIRE, "agent");
            xb_add(&bar[XB_XGEN(b.x)], 1u);
            asm volatile("s_waitcnt vmcnt(0)" ::: "memory");
        } else {
            XB_SPIN(xb_ld(&bar[XB_XGEN(b.x)]) == gen, bar);
            __builtin_amdgcn_fence(__ATOMIC_ACQUIRE, "agent");
            asm volatile("s_waitcnt vmcnt(0)" ::: "memory");
        }
    }
    __syncthreads();
}
namespace pg8 {
constexpr int BM = 256, BK = 64, HALF = 128, HTB = HALF * BK * 2, STAGE_BYTES = 8 * HTB, NXCD = 8, WGM = 8;
__host__ __device__ __forceinline__ int lds_byte(int r, int c) { const int st = (r >> 4) * 2 + (c >> 5), rr = r & 15, cc = c & 31, ob = rr * 64 + cc * 2; return st * 1024 + (ob ^ (((ob >> 9) & 1) << 5)); }
__host__ __device__ __forceinline__ void stage_rc(int b, int& R, int& C) { const int st = b / 1024, sb = b % 1024, swz = sb ^ (((sb >> 9) & 1) << 5); R = (st >> 1) * 16 + swz / 64; C = (st & 1) * 32 + (swz % 64) / 2; }
__host__ __device__ __forceinline__ int perm32(int rho) { const int n = rho >> 4, i = rho & 15; return 8 * (i >> 2) + 4 * n + (i & 3); }

struct Unit { const char* A; const char* B; const int* tok; int pm, pn, aux; int nt8; };

struct TileOrder {
    int nM, nN, nwg, G, c;
    __device__ void init(int M, int N, int G_, int c_) { nM = M / BM; nN = N / BM; nwg = nM * nN; G = G_; c = c_; }
    __device__ bool tile(int i, int& pm, int& pn) const {
        const long L = (long)i * G + c; if (L >= nwg) return false;
        int wgid = (int)L; { const int q = nwg / NXCD, r = nwg % NXCD, xcd = wgid % NXCD, off = wgid / NXCD; wgid = (xcd < r ? xcd * (q + 1) : r * (q + 1) + (xcd - r) * q) + off; }
        const int nig = WGM * nN, gid = wgid / nig, fm = gid * WGM, gsz = (nM - fm) < WGM ? (nM - fm) : WGM;
        pm = fm + ((wgid % nig) % gsz); pn = (wgid % nig) / gsz; return true;
    }
};

typedef int i32x8 __attribute__((ext_vector_type(8)));
template <class Epi, class Sched, bool GATHER, int ES = 2, int SCA = 127, int SCB = 127, bool MIXED = false>
__device__ __forceinline__ void gemm_phase(LAS unsigned char* lds, const int wid, const int Kb, const int ldab, const Sched& S, const Epi& E, const int nt_ovr = 0) {
    const int lane = lane_id(), tid = wid * 64 + lane, wr = wid >> 2, wc = wid & 3, fr = lane & 15, fq = lane >> 4;
    const int nt = nt_ovr ? nt_ovr : Kb / (BK * 2);
    unsigned voffA[2], voffB[2];
#pragma unroll
    for (int i = 0; i < 2; ++i) { int R, C; stage_rc(tid * 16 + i * 8192, R, C); const int Rb = (R & ~31) + perm32(R & 31);
        voffA[i] = (unsigned)(R * ldab + C * 2); voffB[i] = (unsigned)(Rb * Kb + C * 2); }
    const size_t kstep = (size_t)(BK * 2);
    const size_t hstepA = (size_t)HALF * ldab, hstepB = (size_t)HALF * Kb;
    const unsigned ldsw = (unsigned)wid * 1024u;
    const int aoff = (ES == 2 || MIXED) ? lds_byte(wr * 64 + fr, fq * 8) : lds_byte(wr * 64 + fr, fq * 16), boff = (ES == 2 || MIXED) ? lds_byte(wc * 32 + fr, fq * 8) : lds_byte(wc * 32 + fr, fq * 16);
    constexpr int OFF1 = (ES == 2 || MIXED) ? 1024 : 16;
#define PG8_SA(b, h) (((b) * 2 + (h)) * HTB)
#define PG8_SB(b, h) ((4 + (b) * 2 + (h)) * HTB)
    const unsigned ldsbase = (unsigned)(uintptr_t)lds + ldsw;
#define PG8_DMA2(bufoff, sbase, voff_, i_) do { unsigned keep_; asm volatile("s_mov_b32 %0, m0\n\ts_mov_b32 m0, %3\n\ts_nop 0\n\tglobal_load_lds_dwordx4 %1, %2\n\ts_mov_b32 m0, %0" \
        : "=&s"(keep_) : "v"(voff_), "s"(sbase), "s"(ldsbase + (unsigned)((bufoff) + (i_) * 8192)) : "memory"); } while (0)
#define PG8_STAGEB(bufoff, gbase) do { _Pragma("unroll") for (int _i = 0; _i < 2; ++_i) PG8_DMA2(bufoff, (const char*)(gbase), voffB[_i], _i); } while (0)
#define PG8_STAGEA(bufoff, kt, h, GO) do { _Pragma("unroll") for (int _i = 0; _i < 2; ++_i) { \
        if constexpr (GATHER) PG8_DMA2(bufoff, (const char*)(kt), GO[h][_i], _i); else PG8_DMA2(bufoff, (const char*)(kt) + (h) * hstepA, voffA[_i], _i); } } while (0)
#define PG8_LD8(p0, p1) __builtin_bit_cast(i32x8, __builtin_shufflevector(*(const LAS u32x4*)(p0), *(const LAS u32x4*)(p1), 0, 1, 2, 3, 4, 5, 6, 7))
#define PG8_LDA(dst, b, h) do { _Pragma("unroll") for (int m = 0; m < 4; ++m) dst[m] = PG8_LD8(lds + PG8_SA(b, h) + aoff + m * 2048, lds + PG8_SA(b, h) + aoff + OFF1 + m * 2048); } while (0)
#define PG8_LDB(dst, b, h) do { _Pragma("unroll") for (int n = 0; n < 2; ++n) dst[n] = PG8_LD8(lds + PG8_SB(b, h) + boff + n * 2048, lds + PG8_SB(b, h) + boff + OFF1 + n * 2048); } while (0)
#define PG8_LO(x) __builtin_bit_cast(bf16x8, __builtin_shufflevector(x, x, 0, 1, 2, 3))
#define PG8_HI(x) __builtin_bit_cast(bf16x8, __builtin_shufflevector(x, x, 4, 5, 6, 7))
#define PG8_MMA16(ai, bj, At, Bt) do { _Pragma("unroll") for (int m = 0; m < 4; ++m) _Pragma("unroll") for (int n = 0; n < 2; ++n) { \
        acc[ai][bj][m][n] = __builtin_amdgcn_mfma_f32_16x16x32_bf16(PG8_LO(Bt[n]), PG8_LO(At[m]), acc[ai][bj][m][n], 0, 0, 0); \
        acc[ai][bj][m][n] = __builtin_amdgcn_mfma_f32_16x16x32_bf16(PG8_HI(Bt[n]), PG8_HI(At[m]), acc[ai][bj][m][n], 0, 0, 0); } } while (0)
#define PG8_MMA8(ai, bj, At, Bt) do { _Pragma("unroll") for (int m = 0; m < 4; ++m) _Pragma("unroll") for (int n = 0; n < 2; ++n) \
        acc[ai][bj][m][n] = __builtin_amdgcn_mfma_scale_f32_16x16x128_f8f6f4(Bt[n], At[m], acc[ai][bj][m][n], 0, 0, 0, SCB * 0x01010101, 0, SCA * 0x01010101); } while (0)
#define PG8_MMA(ai, bj, At, Bt) do { __builtin_amdgcn_s_setprio(1); \
        if constexpr (MIXED) { if (cur8) PG8_MMA8(ai, bj, At, Bt); else PG8_MMA16(ai, bj, At, Bt); } \
        else if constexpr (ES == 2) PG8_MMA16(ai, bj, At, Bt); else PG8_MMA8(ai, bj, At, Bt); \
        __builtin_amdgcn_s_setprio(0); } while (0)
#define PG8_WAIT_V(n) asm volatile("s_waitcnt vmcnt(" #n ")" ::: "memory")
#define PG8_WAIT_L(n) asm volatile("s_waitcnt lgkmcnt(" #n ")" ::: "memory")
#define PG8_BAR __builtin_amdgcn_s_barrier()
#define PG8_SCHED __builtin_amdgcn_sched_barrier(0)
#define PG8_GLOAD(GO, u) do { if constexpr (GATHER) { const int _tid = wid * 64 + lane_id(); _Pragma("unroll") for (int _i = 0; _i < 2; ++_i) { int _R, _C; stage_rc(_tid * 16 + _i * 8192, _R, _C); \
        _Pragma("unroll") for (int _h = 0; _h < 2; ++_h) { unsigned _t = (unsigned)(u).tok[_h * HALF + _R]; _t = _t < (unsigned)NTOK ? _t : (unsigned)(NTOK - 1); GO[_h][_i] = _t * (unsigned)ldab + (unsigned)_C * 2u; } } } } while (0)
    Unit cur, nxt; int ui = 0;
    if (!S.next(0, cur)) return;
    f32x4 acc[2][2][4][2];
#pragma unroll
    for (int a = 0; a < 2; ++a)
#pragma unroll
        for (int b = 0; b < 2; ++b)
#pragma unroll
            for (int m = 0; m < 4; ++m)
#pragma unroll
                for (int n = 0; n < 2; ++n) acc[a][b][m][n] = (f32x4){0.f, 0.f, 0.f, 0.f};
    i32x8 At[4], B0[2], B1[2];
    unsigned gC[2][2] = {{0u, 0u}, {0u, 0u}}, gN[2][2] = {{0u, 0u}, {0u, 0u}};
    PG8_GLOAD(gC, cur);
    const char* cA = cur.A; const char* cB = cur.B;
    bool cur8 = MIXED && cur.nt8 > 0; int ntc = cur8 ? cur.nt8 : nt;
    PG8_STAGEB(PG8_SB(0, 0), cB); PG8_STAGEB(PG8_SB(0, 1), cB + hstepB); PG8_STAGEA(PG8_SA(0, 0), cA, 0, gC); PG8_STAGEA(PG8_SA(0, 1), cA, 1, gC);
    if (wr == 1) PG8_BAR;
    PG8_WAIT_V(2); PG8_BAR;
    PG8_STAGEB(PG8_SB(1, 0), cB + kstep); PG8_STAGEA(PG8_SA(1, 0), cA + kstep, 0, gC); PG8_STAGEB(PG8_SB(1, 1), cB + hstepB + kstep);
    PG8_WAIT_V(6); PG8_BAR;
    for (;;) {
        const bool has_next = S.next(ui + 1, nxt);
        if (has_next) PG8_GLOAD(gN, nxt);
        const char* nA = has_next ? nxt.A : cA; const char* nB = has_next ? nxt.B : cB;
#pragma clang loop unroll(disable)
        for (int t = 0; t < ntc; t += 2) {
            const bool last = (t == ntc - 2);
            const char* a1 = cA + (size_t)(t + 1) * kstep;
            const char* a2 = last ? nA : cA + (size_t)(t + 2) * kstep; const char* b2 = last ? nB : cB + (size_t)(t + 2) * kstep;
            const char* a3 = a2 + kstep; const char* b3 = b2 + kstep;
            PG8_LDB(B0, 0, 0); PG8_LDB(B1, 0, 1); PG8_SCHED; PG8_LDA(At, 0, 0); PG8_STAGEA(PG8_SA(1, 1), a1, 1, gC);
            if (GATHER && last && has_next) {
#pragma unroll
                for (int _h = 0; _h < 2; ++_h)
#pragma unroll
                    for (int _i = 0; _i < 2; ++_i) gC[_h][_i] = gN[_h][_i];
            }
            PG8_WAIT_V(8); PG8_WAIT_L(0); PG8_BAR; PG8_MMA(0, 0, At, B0); PG8_MMA(0, 1, At, B1); PG8_BAR; PG8_SCHED;
            PG8_LDA(At, 0, 1); PG8_STAGEB(PG8_SB(0, 0), b2); PG8_STAGEB(PG8_SB(0, 1), b2 + hstepB); PG8_STAGEA(PG8_SA(0, 0), a2, 0, gC);
            PG8_WAIT_V(8); PG8_WAIT_L(0); PG8_BAR; PG8_MMA(1, 0, At, B0); PG8_MMA(1, 1, At, B1); PG8_BAR; PG8_SCHED;
            PG8_LDB(B0, 1, 0); PG8_LDB(B1, 1, 1); PG8_SCHED; PG8_LDA(At, 1, 0); PG8_STAGEA(PG8_SA(0, 1), a2, 1, gC);
            PG8_WAIT_V(8); PG8_WAIT_L(0); PG8_BAR; PG8_MMA(0, 0, At, B0); PG8_MMA(0, 1, At, B1); PG8_BAR; PG8_SCHED;
            PG8_LDA(At, 1, 1); PG8_STAGEB(PG8_SB(1, 0), b3); PG8_STAGEB(PG8_SB(1, 1), b3 + hstepB); PG8_STAGEA(PG8_SA(1, 0), a3, 0, gC);
            PG8_WAIT_V(8); PG8_WAIT_L(0); PG8_BAR; PG8_MMA(1, 0, At, B0); PG8_MMA(1, 1, At, B1); PG8_BAR; PG8_SCHED;
        }
        if (wr == 0) PG8_BAR;
        asm volatile("s_nop 15\n\ts_nop 7" ::: "memory");
        const int le_ = lane_id();
        const bool keep = E(acc, cur, wr, wc, le_ & 15, le_ >> 4);
        if (!has_next) break;
        if (!keep) {
#pragma unroll
        for (int a = 0; a < 2; ++a)
#pragma unroll
            for (int b = 0; b < 2; ++b)
#pragma unroll
                for (int m = 0; m < 4; ++m)
#pragma unroll
                    for (int n = 0; n < 2; ++n) acc[a][b][m][n] = (f32x4){0.f, 0.f, 0.f, 0.f};
        }
        cur = nxt; cA = nA; cB = nB; ++ui; cur8 = MIXED && cur.nt8 > 0; ntc = cur8 ? cur.nt8 : nt;
        if (wr == 1) PG8_BAR;
    }
    PG8_WAIT_V(0);
    PG8_BAR;
#undef PG8_SA
#undef PG8_SB
#undef PG8_DMA2
#undef PG8_STAGEA
#undef PG8_STAGEB
#undef PG8_LDA
#undef PG8_LDB
#undef PG8_MMA
#undef PG8_MMA8
#undef PG8_MMA16
#undef PG8_LD8
#undef PG8_LO
#undef PG8_HI
#undef PG8_WAIT_V
#undef PG8_WAIT_L
#undef PG8_BAR
#undef PG8_SCHED
#undef PG8_GLOAD
}
}
struct Args { const float* in[22]; float* out; unsigned char* ws; int ph_lo, ph_hi; };
enum { I_X = 0, I_C, I_WADA, I_BADA, I_GMIX, I_WIN, I_QNORM, I_KNORM, I_WAU, I_PLIN, I_PSCALE, I_WPU, I_WOUT, I_GFFN, I_WROUTER, I_RBIAS, I_W1, I_W3, I_W2, I_WS1, I_WS3, I_WS2 };
struct Frame {
    LAS unsigned char* lds;
    int wave, G, gw, NGW;
    unsigned char* ws; unsigned* ctl; float* out;
};
#define LDS_WAIT() asm volatile("s_waitcnt lgkmcnt(0)" ::: "memory")
#define VM_WAIT() asm volatile("s_waitcnt vmcnt(0)" ::: "memory")

__device__ __forceinline__ void tr_tile(const float* __restrict__ src, int ld_src, int nvalid, bf16_t* __restrict__ dst, int ld_dst, int lane) {
    const int q = lane >> 4, c4 = (lane & 15) * 4;
    const bool ok = c4 < nvalid;
#pragma unroll
    for (int g = 0; g < 2; ++g) {
        f32x4 v[8];
#pragma unroll
        for (int j = 0; j < 8; ++j) { const int k = 32 * g + 8 * q + j; v[j] = ok ? *(const f32x4*)(src + (size_t)k * ld_src + c4) : (f32x4){0.f, 0.f, 0.f, 0.f}; }
#pragma unroll
        for (int nn = 0; nn < 4; ++nn) {
            u32x4 w; w.x = cvt_pk_bf16(v[0][nn], v[1][nn]); w.y = cvt_pk_bf16(v[2][nn], v[3][nn]); w.z = cvt_pk_bf16(v[4][nn], v[5][nn]); w.w = cvt_pk_bf16(v[6][nn], v[7][nn]);
            *(u32x4*)(dst + (size_t)(c4 + nn) * ld_dst + 32 * g + 8 * q) = w;
        }
    }
}
__device__ __forceinline__ void tr8_issue(const float* __restrict__ src, int ld_src, int lane, f32x4 (&v)[16], int nvalid = 64) {
    const int q = lane >> 4, c4 = (lane & 15) * 4; const bool ok = c4 < nvalid;
    const unsigned voff = (unsigned)((16 * q) * ld_src + c4) * 4u;
#pragma unroll
    for (int j = 0; j < 16; ++j) v[j] = ok ? __builtin_nontemporal_load((const f32x4*)((const char*)src + (size_t)j * ld_src * 4 + voff)) : (f32x4){0.f, 0.f, 0.f, 0.f};
}
__device__ __forceinline__ void tr8_finish(unsigned char* __restrict__ dst, int ld_dst, int lane, const f32x4 (&v)[16]) {
    const int q = lane >> 4, c4 = (lane & 15) * 4;
#pragma unroll
    for (int nn = 0; nn < 4; ++nn) { u32x4 w;
#pragma unroll
        for (int t = 0; t < 4; ++t) w[t] = pk4_fp8(v[4 * t][nn] * W8_SCALE, v[4 * t + 1][nn] * W8_SCALE, v[4 * t + 2][nn] * W8_SCALE, v[4 * t + 3][nn] * W8_SCALE);
        *(u32x4*)(dst + (size_t)(c4 + nn) * ld_dst + 16 * q) = w; }
}
template <bool F8>
__device__ __forceinline__ void wcopy_tile(const float* src, int ld_src, int nvalid, unsigned char* dstbase, size_t drow, int ldk, int k0, int lane) {
    if constexpr (F8) { f32x4 v[16]; tr8_issue(src, ld_src, lane, v, nvalid); tr8_finish(dstbase + drow * ldk + k0, ldk, lane, v); }
    else tr_tile(src, ld_src, nvalid, (bf16_t*)dstbase + drow * ldk + k0, ldk, lane);
}
constexpr int ADA_WGS = 6 * DM / 128;
__device__ __forceinline__ void p0_prologue(Frame& F, const Args& a) {
    LAS float* sc = (LAS float*)F.lds;
    const int lane = lane_id(), tid = F.wave * 64 + lane;
    for (int i = tid; i < NB * DM; i += NTHR) { const float c = a.in[I_C][i]; sc[i] = c / (1.0f + __expf(-c)); }
    __syncthreads();
    float* mod = (float*)(F.ctl + CW_MOD);
    unsigned char* ws = F.ws;
    for (int job = blockIdx.x; job < 2 * ADA_WGS; job += F.G) {
        const int strip = job % ADA_WGS, kh = job / ADA_WGS, w = F.wave, krow0 = kh * 1024 + 128 * w;
        const int l32 = lane & 31, hb = lane >> 5;
        const float* wp = a.in[I_WADA] + (size_t)(krow0 + hb) * (6 * DM) + strip * 128 + 4 * l32;
        f32x4 b0 = {0.f, 0.f, 0.f, 0.f}, b1 = {0.f, 0.f, 0.f, 0.f};
#pragma unroll 16
        for (int k = 0; k < 64; ++k) { const f32x4 wv = *(const f32x4*)(wp + (size_t)(2 * k) * (6 * DM)); const float s0 = sc[krow0 + 2 * k + hb], s1 = sc[DM + krow0 + 2 * k + hb]; b0 += wv * s0; b1 += wv * s1; }
#pragma unroll
        for (int j = 0; j < 4; ++j) { b0[j] += __shfl_xor(b0[j], 32); b1[j] += __shfl_xor(b1[j], 32); }
        const int col2 = 2 * (lane & 1);
        const f32x2 a0 = {hb ? b0[2] : b0[0], hb ? b0[3] : b0[1]}, a1 = {hb ? b1[2] : b1[0], hb ? b1[3] : b1[1]};
        const int pcol = 4 * l32 + 2 * hb; (void)col2;
        LAS float* part = (LAS float*)(F.lds + 16384);
        *(LAS f32x2*)(part + (w * 2 + 0) * 128 + pcol) = a0; *(LAS f32x2*)(part + (w * 2 + 1) * 128 + pcol) = a1;
        __syncthreads();
        if (tid < 256) { const int b = tid >> 7, c = tid & 127; float sum = kh == 0 ? a.in[I_BADA][strip * 128 + c] : 0.f;
#pragma unroll
            for (int ww = 0; ww < 8; ++ww) sum += part[(ww * 2 + b) * 128 + c];
            unsafeAtomicAdd(mod + b * 6 * DM + strip * 128 + c, sum); }
        __syncthreads();
    }
    unsigned char* Win8 = ws + WS_WIN;
    constexpr int J_IN_A = 32 * 40, J_IN_B = 32 * 4, J_IN_C = 32 * 80, J_AU = 16 * 32, J_PU = 16 * 32, J_OUT = 32 * 32, J_PL = 4 * 16, J_S13 = 2 * 32 * 8, J_S2 = 8 * 32, J_WR = 32,
                  J_W13 = 0, J_W2 = 0;
    constexpr int NITEMS = J_IN_A + J_IN_B + J_IN_C + J_AU + J_PU + J_OUT + J_PL + J_S13 + J_S2 + J_WR;
    for (int it = F.gw; it < NITEMS; it += F.NGW) {
        int r = it;
        if (r < J_IN_A) { const int kb = r / 40, nb = r % 40; if ((nb >> 2) == 5) wcopy_tile<true>(a.in[I_WIN] + (size_t)(64 * kb) * INW + 64 * nb, INW, 64, Win8, (size_t)(64 * nb), 2 * DM, 64 * kb, lane);
            else wcopy_tile<false>(a.in[I_WIN] + (size_t)(64 * kb) * INW + 64 * nb, INW, 64, Win8, (size_t)(64 * nb), DM, 64 * kb, lane); continue; } r -= J_IN_A;
        if (r < J_IN_B) { const int kb = r / 4, nb = r % 4; const int nv = nb == 0 ? 64 : (nb == 1 ? 16 : 0);
            wcopy_tile<false>(a.in[I_WIN] + (size_t)(64 * kb) * INW + 2560 + (nb < 2 ? 64 * nb : 0), INW, nv, Win8, (size_t)(2560 + 64 * nb), DM, 64 * kb, lane); continue; } r -= J_IN_B;
        if (r < J_IN_C) { const int kb = r / 80, nb = r % 80; wcopy_tile<true>(a.in[I_WIN] + (size_t)(64 * kb) * INW + 2640 + 64 * nb, INW, 64, Win8, (size_t)(2816 + 64 * nb), 2 * DM, 64 * kb, lane); continue; } r -= J_IN_C;
        if (r < J_AU) { const int kb = r / 32, nb = r % 32; wcopy_tile<FP8_MERGE>(a.in[I_WAU] + (size_t)(64 * kb) * DM + 64 * nb, DM, 64, ws + WS_WAU, (size_t)(64 * nb), AW, 64 * kb, lane); continue; } r -= J_AU;
        if (r < J_PU) { const int kb = r / 32, nb = r % 32; wcopy_tile<FP8_MERGE>(a.in[I_WPU] + (size_t)(64 * kb) * DM + 64 * nb, DM, 64, ws + WS_WPU, (size_t)(64 * nb), PW, 64 * kb, lane); continue; } r -= J_PU;
        if (r < J_OUT) { const int kb = r / 32, nb = r % 32; wcopy_tile<FP8_OUT>(a.in[I_WOUT] + (size_t)(64 * kb) * DM + 64 * nb, DM, 64, ws + WS_WOUT, (size_t)(64 * nb), DM, 64 * kb, lane); continue; } r -= J_OUT;
        if (r < J_PL) { const int g = r / 16, kb = (r % 16) / 4, nb = r % 4; tr_tile(a.in[I_PLIN] + (size_t)g * 65536 + (size_t)(64 * kb) * 256 + 64 * nb, 256, 64, (bf16_t*)(ws + WS_PLIN) + (size_t)g * 65536 + (size_t)(64 * nb) * 256 + 64 * kb, 256, lane); continue; } r -= J_PL;
        if (r < J_S13) { const int which = r / 256, kb = (r % 256) / 8, nb = r % 8; const float* src = (which ? a.in[I_WS3] : a.in[I_WS1]) + (size_t)(64 * kb) * EH + 64 * nb;
            f32x4 v[16]; tr8_issue(src, EH, lane, v); tr8_finish(ws + WS_WS13 + (size_t)(256 * (nb >> 1) + 64 * (nb & 1) + 128 * which) * DM + 64 * kb, DM, lane, v); continue; } r -= J_S13;
        if (r < J_S2) { const int kb = r / 32, nb = r % 32; f32x4 v[16]; tr8_issue(a.in[I_WS2] + (size_t)(64 * kb) * DM + 64 * nb, DM, lane, v); tr8_finish(ws + WS_WS2 + (size_t)(64 * nb) * EH + 64 * kb, EH, lane, v); continue; } r -= J_S2;
        { const int kb = r; tr_tile(a.in[I_WROUTER] + (size_t)(64 * kb) * NE, NE, 64, (bf16_t*)(ws + WS_WR) + 64 * kb, DM, lane); }
    }
}

constexpr int NCONV_W13 = NE * 2 * 32 * 8, NCONV = NCONV_W13 + NE * 8 * 32;
__device__ __forceinline__ void conv_ptrs(const Args& a, unsigned char* ws, int it, const float*& src, int& ld_src, unsigned char*& dst, int& ld_dst) {
    if (it < NCONV_W13) { const int e = it / 512, rr = it % 512, which = rr / 256, kb = (rr % 256) / 8, nb = rr % 8;
        src = (which ? a.in[I_W3] : a.in[I_W1]) + ((size_t)e * DM + 64 * kb) * EH + 64 * nb; ld_src = EH;
        dst = ws + WS_W13 + ((size_t)e * 1024 + 256 * (nb >> 1) + 64 * (nb & 1) + 128 * which) * DM + 64 * kb; ld_dst = DM; }
    else { const int r = it - NCONV_W13, e = r / 256, kb = (r % 256) / 32, nb = r % 32;
        src = a.in[I_W2] + ((size_t)e * EH + 64 * kb) * DM + 64 * nb; ld_src = DM; dst = ws + WS_W2 + ((size_t)e * DM + 64 * nb) * EH + 64 * kb; ld_dst = EH; }
}
__device__ __forceinline__ void conv_issue16(const Args& a, unsigned char* ws, int it, int lane, f32x4 (&v)[16]) {
    const float* src; int ld_src; unsigned char* dst; int ld_dst; conv_ptrs(a, ws, it, src, ld_src, dst, ld_dst); tr8_issue(src, ld_src, lane, v); }
__device__ __forceinline__ void conv_finish16(const Args& a, unsigned char* ws, int it, int lane, const f32x4 (&v)[16]) {
    const float* src; int ld_src; unsigned char* dst; int ld_dst; conv_ptrs(a, ws, it, src, ld_src, dst, ld_dst); tr8_finish(dst, ld_dst, lane, v); }
__device__ __forceinline__ void phase_done(Frame& F, int phase) { __syncthreads(); if (F.wave == 0 && lane_id() == 0) __hip_atomic_fetch_add(F.ctl + CW_DONE + 64 * phase, 1u, __ATOMIC_RELAXED, __HIP_MEMORY_SCOPE_AGENT); }
constexpr int CONV_SEG1_END = NCONV_W13 + (NCONV - NCONV_W13) * 3 / 10 / 8 * 8;
__device__ __forceinline__ unsigned conv_seg_lo(int sg) { return sg == 0 ? 0u : (sg == 1 ? (unsigned)NCONV_W13 : (unsigned)CONV_SEG1_END); }
__device__ __forceinline__ unsigned conv_seg_hi(int sg) { return sg == 0 ? (unsigned)NCONV_W13 : (sg == 1 ? (unsigned)CONV_SEG1_END : (unsigned)NCONV); }
template <bool BOUNDED, int SEG_LO, int SEG_HI>
struct ConvQ {
    Frame& F; int phase, lane; unsigned cur, end; int sg;
    __device__ __forceinline__ int next() {
        constexpr unsigned B = BOUNDED ? 6u : 8u;
        while (cur >= end) {
            if (BOUNDED) { const unsigned d = __hip_atomic_load(F.ctl + CW_DONE + 64 * phase, __ATOMIC_RELAXED, __HIP_MEMORY_SCOPE_AGENT); if ((unsigned)__builtin_amdgcn_readfirstlane(d) >= (unsigned)F.G) return -1; }
            const unsigned lo = conv_seg_lo(sg), hi = conv_seg_hi(sg);
            unsigned s = 0; if (lane == 0) s = __hip_atomic_fetch_add(F.ctl + CW_CONVQ + 64 * sg, B, __ATOMIC_RELAXED, __HIP_MEMORY_SCOPE_AGENT);
            s = (unsigned)__builtin_amdgcn_readfirstlane(s) + lo;
            if (s >= hi) { if (sg < SEG_HI) { ++sg; continue; } return -1; }
            cur = s; end = s + B < hi ? s + B : hi;
        }
        return (int)cur++;
    }
};
template <bool BOUNDED, int SEG_LO, int SEG_HI>
__device__ __forceinline__ void conv_drain(Frame& F, const Args& a, int phase, int quota = 0) {
    const int lane = lane_id();
    ConvQ<BOUNDED, SEG_LO, SEG_HI> Q{F, phase, lane, 0u, 0u, SEG_LO};
    f32x4 va[16], vb[16]; int n = 0;
    int ia = Q.next(); if (ia < 0) return;
    conv_issue16(a, F.ws, ia, lane, va);
    for (;;) {
        ++n; const int ib = (quota > 0 && n >= quota && Q.cur >= Q.end) ? -1 : Q.next(); if (ib >= 0) conv_issue16(a, F.ws, ib, lane, vb);
        conv_finish16(a, F.ws, ia, lane, va);
        if (ib < 0) break;
        ++n; ia = (quota > 0 && n >= quota && Q.cur >= Q.end) ? -1 : Q.next(); if (ia >= 0) conv_issue16(a, F.ws, ia, lane, va);
        conv_finish16(a, F.ws, ib, lane, vb);
        if (ia < 0) break;
    }
}

__device__ __forceinline__ void modnorm_row(const float* __restrict__ xrow, const float* __restrict__ g, const float* __restrict__ shift, const float* __restrict__ scale, unsigned char* __restrict__ orow, unsigned char* __restrict__ orow8, int lane) {
    f32x4 v[8]; float ss = 0.f;
#pragma unroll
    for (int j = 0; j < 8; ++j) { v[j] = *(const f32x4*)(xrow + 4 * lane + 256 * j); ss += (v[j].x * v[j].x + v[j].y * v[j].y) + (v[j].z * v[j].z + v[j].w * v[j].w); }
    const float rstd = rsqrtf(wave_sum(ss) * (1.0f / DM) + NORM_EPS);
#pragma unroll
    for (int j = 0; j < 8; ++j) { const int c = 4 * lane + 256 * j;
        const f32x4 gg = *(const f32x4*)(g + c), sh = *(const f32x4*)(shift + c), sl = *(const f32x4*)(scale + c);
        const f32x4 o = v[j] * rstd * gg * (sl + 1.0f) + sh;
        { u32x2 w; w.x = cvt_pk_bf16(o.x, o.y); w.y = cvt_pk_bf16(o.z, o.w); *(u32x2*)((bf16_t*)orow + c) = w; }
        if (orow8) *(unsigned*)(orow8 + c) = pk4_fp8(o.x * A8_SCALE, o.y * A8_SCALE, o.z * A8_SCALE, o.w * A8_SCALE); }
}
__device__ __forceinline__ void p1_h(Frame& F, const Args& a) {
    const float* mod = (const float*)(F.ctl + CW_MOD);
    unsigned char* hb = F.ws + WS_HB; const int lane = lane_id();
    for (int m0 = 2 * F.gw; m0 < NTOK; m0 += 2 * F.NGW) {
        f32x4 v[2][8];
#pragma unroll
        for (int rr = 0; rr < 2; ++rr)
#pragma unroll
            for (int j = 0; j < 8; ++j) v[rr][j] = *(const f32x4*)(a.in[I_X] + (size_t)(m0 + rr) * DM + 4 * lane + 256 * j);
        const int b = m0 / SEQ; const float* sh = mod + b * 6 * DM; const float* sl = mod + b * 6 * DM + DM;
        float rstd[2];
#pragma unroll
        for (int rr = 0; rr < 2; ++rr) { float ss = 0.f;
#pragma unroll
            for (int j = 0; j < 8; ++j) ss += (v[rr][j].x * v[rr][j].x + v[rr][j].y * v[rr][j].y) + (v[rr][j].z * v[rr][j].z + v[rr][j].w * v[rr][j].w);
            rstd[rr] = rsqrtf(wave_sum(ss) * (1.0f / DM) + NORM_EPS); }
#pragma unroll
        for (int j = 0; j < 8; ++j) { const int c = 4 * lane + 256 * j;
            const f32x4 gg = *(const f32x4*)(a.in[I_GMIX] + c), shv = *(const f32x4*)(sh + c), slv = *(const f32x4*)(sl + c); const f32x4 mul = gg * (slv + 1.0f);
#pragma unroll
            for (int rr = 0; rr < 2; ++rr) { const f32x4 o = v[rr][j] * rstd[rr] * mul + shv; const size_t ro = (size_t)(m0 + rr) * DM * 2;
                u32x2 w; w.x = cvt_pk_bf16(o.x, o.y); w.y = cvt_pk_bf16(o.z, o.w); *(u32x2*)((bf16_t*)(hb + ro) + c) = w;
                *(unsigned*)(F.ws + WS_H8 + ro + c) = pk4_fp8(o.x * A8_SCALE, o.y * A8_SCALE, o.z * A8_SCALE, o.w * A8_SCALE); } }
    }
}
struct SchedDense {
    pg8::TileOrder T; const char* A; const char* B; size_t a_tile, b_tile;
    __device__ __forceinline__ bool next(int i, pg8::Unit& u) const { int pm, pn; if (!T.tile(i, pm, pn)) return false; u.pm = pm; u.pn = pn; u.aux = 0; u.tok = nullptr; u.nt8 = 0;
        u.A = A + (size_t)pm * a_tile; u.B = B + (size_t)pn * b_tile; return true; }
};
__device__ __forceinline__ void st_bf16x8(bf16_t* p, f32x4 v0, f32x4 v1) { u32x4 w; w.x = cvt_pk_bf16(v0[0], v0[1]); w.y = cvt_pk_bf16(v0[2], v0[3]); w.z = cvt_pk_bf16(v1[0], v1[1]); w.w = cvt_pk_bf16(v1[2], v1[3]); *(u32x4*)p = w; }
struct EpiInproj {
    unsigned char* ws;
    __device__ __forceinline__ bool operator()(f32x4 (&acc)[2][2][4][2], const pg8::Unit& u, int wr, int wc, int fr, int fq) const {
        const int pn = u.pn; bf16_t* base; int ld, ct; bool sig = false;
        if (pn < 4) { base = (bf16_t*)(ws + WS_Q); ld = AW; ct = pn; }
        else if (pn == 4) { base = (bf16_t*)(ws + WS_K); ld = KVW; ct = 0; }
        else if (pn == 5) { base = (bf16_t*)(ws + WS_V); ld = KVW; ct = 0; }
        else if (pn < 10) { base = (bf16_t*)(ws + WS_QI); ld = IH * ID; ct = pn - 6; }
        else if (pn == 10) { base = (bf16_t*)(ws + WS_KW); ld = 256; ct = 0; }
        else if (pn < 15) { base = (bf16_t*)(ws + WS_U); ld = PW; ct = pn - 11; }
        else { base = (bf16_t*)(ws + WS_G); ld = 2 * DM; ct = pn - 15; sig = true; }
        const int row0 = u.pm * 256 + wr * 64 + fr, col0 = ct * 256 + wc * 32 + 8 * fq;
#pragma unroll
        for (int ai = 0; ai < 2; ++ai)
#pragma unroll
            for (int m = 0; m < 4; ++m) { bf16_t* rowp = base + (size_t)(row0 + ai * 128 + m * 16) * ld + col0;
#pragma unroll
                for (int bj = 0; bj < 2; ++bj) { f32x4 v0 = acc[ai][bj][m][0], v1 = acc[ai][bj][m][1];
                    if (sig) {
#pragma unroll
                        for (int j = 0; j < 4; ++j) { v0[j] = fminf(__builtin_amdgcn_rcpf(1.0f + __expf(-v0[j])), 1.0f); v1[j] = fminf(__builtin_amdgcn_rcpf(1.0f + __expf(-v1[j])), 1.0f); } }
                    st_bf16x8(rowp + bj * 128, v0, v1); } }
        return false;
    }
};
struct SchedInproj {
    int G, c, kind; const char* hA; const char* win;
    __device__ __forceinline__ bool next(int i, pg8::Unit& u) const {
        const int first = kind == 0 ? c : c + ((320 - c + G - 1) / G) * G;
        const int j = first + i * G; if (j >= (kind == 0 ? 320 : 992)) return false;
        int pn, pm;
        if (kind == 0) { const int t = j >> 5; pm = j & 31; pn = t < 5 ? t : t + 1; }
        else { const int jj = j - 320, t = jj >> 5; pm = jj & 31; pn = t == 0 ? 5 : t + 10; }
        u.pm = pm; u.pn = pn; u.aux = 0; u.tok = nullptr; u.nt8 = 0;
        u.A = hA + (size_t)pm * 256 * DM * 2; u.B = win + (size_t)pn * 256 * DM * 2; return true; }
};
__device__ __forceinline__ void p2_inproj(Frame& F, const Args& a) {
    const int NG = F.G >= 256 ? 248 : F.G;
    if ((int)blockIdx.x >= NG) { conv_drain<false, 0, 2>(F, a, 2, 24); return; }
    EpiInproj E{F.ws};
    { SchedInproj S{NG, (int)blockIdx.x, 0, (const char*)(F.ws + WS_HB), (const char*)(F.ws + WS_WIN)};
      pg8::gemm_phase<EpiInproj, SchedInproj, false, 2>(F.lds, F.wave, DM * 2, DM * 2, S, E); }
    { SchedInproj S{NG, (int)blockIdx.x, 1, (const char*)(F.ws + WS_H8), (const char*)(F.ws + WS_WIN)};
      pg8::gemm_phase<EpiInproj, SchedInproj, false, 1, A8_E8, W8_E8>(F.lds, F.wave, DM * 2, DM * 2, S, E, DM / 128); }
}
__device__ __forceinline__ void p3_qknorm(Frame& F, const Args& a) {
    bf16_t* K = (bf16_t*)(F.ws + WS_K);
    const int lane = lane_id();
    for (int m = F.gw; m < NTOK; m += F.NGW) {
        u32x2 k0 = *(const u32x2*)(K + (size_t)m * KVW + 4 * lane);
        float kv[4]; float sk = 0.f;
        kv[0] = bflo(k0[0]); kv[1] = bfhi(k0[0]); kv[2] = bflo(k0[1]); kv[3] = bfhi(k0[1]);
#pragma unroll
        for (int j = 0; j < 4; ++j) sk += kv[j] * kv[j];
        sk += __shfl_xor(sk, 1); sk += __shfl_xor(sk, 2); sk += __shfl_xor(sk, 4); sk += __shfl_xor(sk, 8); sk += __shfl_xor(sk, 16);
        const float rk = rsqrtf(sk * (1.0f / HD) + NORM_EPS);
        const int dk = (4 * lane) & 127;
        u32x2 ok; ok[0] = cvt_pk_bf16(kv[0] * rk * a.in[I_KNORM][dk], kv[1] * rk * a.in[I_KNORM][dk + 1]); ok[1] = cvt_pk_bf16(kv[2] * rk * a.in[I_KNORM][dk + 2], kv[3] * rk * a.in[I_KNORM][dk + 3]);
        *(u32x2*)(K + (size_t)m * KVW + 4 * lane) = ok;
    }
}
__device__ __forceinline__ void pooled_item(Frame& F, int t0, int g, int lane) {
    const bf16_t* U = (const bf16_t*)(F.ws + WS_U); bf16_t* P = (bf16_t*)(F.ws + WS_POOLED);
    const int pos0 = t0 % SEQ, w = 2 << g, c = 256 * g + 4 * lane;
    f32x4 W = {0.f, 0.f, 0.f, 0.f};
    for (int j = 1; j <= 16; ++j) { if (j <= w && pos0 - j >= 0) { const u32x2 v = *(const u32x2*)(U + (size_t)(t0 - j) * PW + c); W += (f32x4){bflo(v[0]), bfhi(v[0]), bflo(v[1]), bfhi(v[1])}; } }
#pragma unroll 8
    for (int i = 0; i < 32; ++i) { const int t = t0 + i, pos = pos0 + i;
        const u32x2 v = *(const u32x2*)(U + (size_t)t * PW + c); const f32x4 cur = {bflo(v[0]), bfhi(v[0]), bflo(v[1]), bfhi(v[1])};
        W += cur;
        if (pos - w >= 0) { const u32x2 o = *(const u32x2*)(U + (size_t)(t - w) * PW + c); W -= (f32x4){bflo(o[0]), bfhi(o[0]), bflo(o[1]), bfhi(o[1])}; }
        const float inv = 1.0f / (float)(pos + 1 < w ? pos + 1 : w);
        const f32x4 r = W * inv - cur;
        u32x2 ow; ow[0] = cvt_pk_bf16(r[0], r[1]); ow[1] = cvt_pk_bf16(r[2], r[3]);
        *(u32x2*)(P + (size_t)t * PW + c) = ow; }
}
__device__ __forceinline__ unsigned mono_key(float s) { const unsigned u = __float_as_uint(s); return (u & 0x80000000u) ? ~u : (u | 0x80000000u); }
__device__ __forceinline__ void idx_block(Frame& F, const Args& a, int b, int i16) {
    const bf16_t* QI = (const bf16_t*)(F.ws + WS_QI); const bf16_t* KW = (const bf16_t*)(F.ws + WS_KW);
    unsigned short* MT = (unsigned short*)(F.ws + WS_MASK);
    LAS unsigned* T = (LAS unsigned*)F.lds;
    const int lane = lane_id(), w = F.wave, tid = w * 64 + lane, r32 = lane & 31, hi = lane >> 5;
    const int tpos0 = 16 * i16, t0 = b * SEQ + tpos0, nh = (tpos0 + 16 + 31) >> 5, kzero = 64 * ((tpos0 >> 6) + 1);
    for (int k = tid; k < kzero; k += NTHR) T[k] = 0u;
    bf16x8 Af[4];
    { const int qsel = (r32 >> 2) & 1, head = (r32 & 3) + 4 * (r32 >> 3); const size_t tq = (size_t)(t0 + 2 * w + qsel);
      const float wv = bf2f(KW[tq * 256 + 64 + head]);
#pragma unroll
      for (int s = 0; s < 4; ++s) { const u32x4 q = *(const u32x4*)(QI + tq * (IH * ID) + head * ID + 16 * s + 8 * hi); u32x4 o;
#pragma unroll
          for (int j = 0; j < 4; ++j) o[j] = cvt_pk_bf16(bflo(q[j]) * wv, bfhi(q[j]) * wv);
          Af[s] = __builtin_bit_cast(bf16x8, o); } }
    float X[16];
    { const size_t tq = (size_t)(t0 + 2 * w + hi); const u32x4 w0 = *(const u32x4*)(KW + tq * 256 + 64), w1 = *(const u32x4*)(KW + tq * 256 + 72);
      const float PINF = __builtin_inff();
#pragma unroll
      for (int j = 0; j < 4; ++j) { X[2 * j] = bflo(w0[j]) >= 0.f ? PINF : -PINF; X[2 * j + 1] = bfhi(w0[j]) >= 0.f ? PINF : -PINF;
                                    X[8 + 2 * j] = bflo(w1[j]) >= 0.f ? PINF : -PINF; X[8 + 2 * j + 1] = bfhi(w1[j]) >= 0.f ? PINF : -PINF; } }
    const int mypos = tpos0 + 2 * w + hi;
    unsigned keys[128];
    constexpr int RING = 16384, SLOT = 8192;
    const int nt64 = (nh + 1) >> 1;
    const unsigned dvoff = (unsigned)((lane >> 3) * 512 + (((lane & 7) ^ (lane >> 3)) << 4));
    const char* kwb = (const char*)(KW + (size_t)b * SEQ * 256) + w * 4096;
    const unsigned ldsw = (unsigned)(uintptr_t)F.lds + RING + w * 1024;
#define IDX_DMA(t_) do { unsigned keep_; asm volatile("s_mov_b32 %0, m0\n\ts_mov_b32 m0, %3\n\ts_nop 0\n\tglobal_load_lds_dwordx4 %1, %2\n\ts_mov_b32 m0, %0" \
        : "=&s"(keep_) : "v"(dvoff), "s"(kwb + (size_t)(t_) * 32768), "s"(ldsw + (unsigned)(((t_) & 3) * SLOT)) : "memory"); } while (0)
    int boffs[4];
#pragma unroll
    for (int s = 0; s < 4; ++s) boffs[s] = r32 * 128 + ((((2 * s + hi) ^ (r32 & 7))) << 4);
    __syncthreads();
    if (0 < nt64) IDX_DMA(0);
    if (1 < nt64) IDX_DMA(1);
    if (2 < nt64) IDX_DMA(2);
#pragma unroll
    for (int t = 0; t < 64; ++t) {
        keys[2 * t] = 0u; keys[2 * t + 1] = 0u;
        if (t < nt64) {
            const int rem = nt64 - 1 - t;
            if (rem >= 2) asm volatile("s_waitcnt vmcnt(2)" ::: "memory"); else if (rem == 1) asm volatile("s_waitcnt vmcnt(1)" ::: "memory"); else asm volatile("s_waitcnt vmcnt(0)" ::: "memory");
            __builtin_amdgcn_s_barrier(); asm volatile("" ::: "memory");
            if (t + 3 < nt64) IDX_DMA(t + 3);
#pragma unroll
            for (int half = 0; half < 2; ++half) { const int n = 2 * t + half;
                if (n < nh) {
                    f32x16 acc = {0.f, 0.f, 0.f, 0.f, 0.f, 0.f, 0.f, 0.f, 0.f, 0.f, 0.f, 0.f, 0.f, 0.f, 0.f, 0.f};
#pragma unroll
                    for (int s = 0; s < 4; ++s) { const bf16x8 bfr = *(const LAS bf16x8*)(F.lds + RING + (t & 3) * SLOT + half * 4096 + boffs[s]);
                        acc = __builtin_amdgcn_mfma_f32_32x32x16_bf16(Af[s], bfr, acc, 0, 0, 0); }
                    float sc = 0.f;
#pragma unroll
                    for (int j = 0; j < 16; ++j) sc += __builtin_amdgcn_fmed3f(acc[j], 0.f, X[j]);
                    keys[n] = (32 * n + r32 <= mypos) ? mono_key(sc) : 0u;
                } }
        }
    }
#undef IDX_DMA
    unsigned Tsel = 0u;
    { constexpr int HIST = 49152;
      LAS unsigned* hb = (LAS unsigned*)(F.lds + HIST) + (2 * w + hi) * 512;
      unsigned kk = (unsigned)TOPK; bool alive = true;
#pragma unroll 1
      for (int p = 0; p < 4; ++p) { const int sh = 24 - 8 * p;
          *(LAS u32x4*)(hb + 8 * r32) = (u32x4){0u, 0u, 0u, 0u}; *(LAS u32x4*)(hb + 8 * r32 + 4) = (u32x4){0u, 0u, 0u, 0u};
          asm volatile("s_waitcnt lgkmcnt(0)" ::: "memory");
#pragma unroll
          for (int n8 = 0; n8 < 16; ++n8) { if (n8 * 8 < nh) {
#pragma unroll
              for (int j = 0; j < 8; ++j) { const unsigned key = keys[n8 * 8 + j];
                  const unsigned x = p ? ((key ^ Tsel) >> ((sh + 8) & 31)) : 0u, t = x < 1u ? x : 1u;
                  __hip_atomic_fetch_add(hb + ((t << 8) + ((key >> sh) & 255u)), 1u, __ATOMIC_RELAXED, __HIP_MEMORY_SCOPE_WORKGROUP); } } }
          asm volatile("s_waitcnt lgkmcnt(0)" ::: "memory");
          const u32x4 c0 = *(const LAS u32x4*)(hb + 8 * r32), c1 = *(const LAS u32x4*)(hb + 8 * r32 + 4);
          const unsigned cb[8] = {(p == 0 && r32 == 0) ? 0u : c0[0], c0[1], c0[2], c0[3], c1[0], c1[1], c1[2], c1[3]};
          unsigned S = 0;
#pragma unroll
          for (int j = 0; j < 8; ++j) S += cb[j];
          unsigned suf = S;
#pragma unroll
          for (int d = 1; d < 32; d <<= 1) { const unsigned y = __shfl_down(suf, d, 32); if (r32 + d < 32) suf += y; }
          const unsigned total = __shfl(suf, 0, 32), sufx = suf - S;
          if (alive && total < kk) alive = false;
          const bool mine = alive && sufx < kk && kk <= suf;
          unsigned acc = sufx, bsel = 0u, above = 0u; bool found = false;
#pragma unroll
          for (int j = 7; j >= 0; --j) { if (!found) { if (acc + cb[j] >= kk) { found = true; bsel = (unsigned)(8 * r32 + j); above = acc; } else acc += cb[j]; } }
          const unsigned long long bm = __ballot(mine);
          const unsigned half = hi ? (unsigned)(bm >> 32) : (unsigned)bm;
          const int src = half ? (__builtin_ctz(half) + 32 * hi) : lane;
          const unsigned bs = __shfl(bsel, src), ab = __shfl(above, src);
          if (alive) { Tsel |= bs << sh; kk -= ab; }
      }
      if (!alive) Tsel = 0u;
    }
    { const unsigned Tf = Tsel > 1u ? Tsel : 1u;
      __syncthreads();
#pragma unroll
      for (int n = 0; n < 128; ++n) { if (n < nh) {
          unsigned bitv = keys[n] >= Tf ? 1u : 0u; const unsigned other = __shfl_xor(bitv, 32);
          bitv |= other << 1;
          if (hi == 0 && bitv) __hip_atomic_fetch_or(T + 32 * n + r32, bitv << (2 * w), __ATOMIC_RELAXED, __HIP_MEMORY_SCOPE_WORKGROUP); } }
    }
    __syncthreads();
    { const int rg = (b * SEQ + tpos0) >> 5, f = i16 & 1;
      for (int k = tid; k < kzero; k += NTHR) { const int kk = k & 63, p = (kk & ~7) | ((kk & 3) << 1) | ((kk >> 2) & 1);
          MT[((size_t)(rg * 64 + (k >> 6)) * 64 + p) * 2 + f] = (unsigned short)(T[k] & 0xffffu); } }
    __syncthreads();
}
__device__ __forceinline__ void p3_indexer(Frame& F, const Args& a) {
    for (int v2 = 2 * blockIdx.x; v2 < 512; v2 += 2 * F.G) { for (int ps = 0; ps < 2; ++ps) { const int v = v2 >> 1, b = v >> 7, i = v & 127; idx_block(F, a, b, ps ? 255 - i : i); } }
}
namespace att {
constexpr int KVBLK = 64, SHM_V = KVBLK * HD * 2, SHM_K = KVBLK * HD * 2;
constexpr int LDS_V = 0, LDS_K = 2 * SHM_V, LDS_WS = 2 * SHM_V + 2 * SHM_K, LDS_BYTES = LDS_WS + NWAVES * 64 * 4;
constexpr float THR = 8.f, LOG2E = 1.4426950408889634f;
#define KSWZ(row, colB) ((row) * 256 + ((colB) ^ (((row) & 7) << 4)))
#define SBAR() __builtin_amdgcn_sched_barrier(0)
__device__ __forceinline__ int v_st(int k, int c) { const int kk = (k & ~0xC) | ((k & 4) << 1) | ((k & 8) >> 1); return ((kk >> 3) * 4 + (c >> 5)) * 512 + ((kk & 7) * 32 + (c & 31)) * 2; }
__device__ __forceinline__ int v_rd_base(int lane) { return ((lane & 3) << 3) | (((lane >> 2) & 3) << 6) | (((lane >> 4) & 1) << 5) | (((lane >> 5) & 1) << 8); }
constexpr int v_rd_off(int d0, int ks, int half) { return d0 * 512 + ks * 4096 + half * 2048; }
__device__ __forceinline__ int crow(int r, int hi) { return (r & 3) + 8 * (r >> 2) + 4 * hi; }
__device__ __forceinline__ bool partialSM(f32x16& p0, f32x16& p1, float& m_reg, float& mn, float& alpha) {
    float pmax = p0[0];
#pragma unroll
    for (int r = 1; r < 16; ++r) pmax = fmaxf(pmax, p0[r]);
#pragma unroll
    for (int r = 0; r < 16; ++r) pmax = fmaxf(pmax, p1[r]);
    { auto rr = __builtin_amdgcn_permlane32_swap(__float_as_uint(pmax), __float_as_uint(pmax), false, false);
      pmax = fmaxf(__uint_as_float(rr[0]), __uint_as_float(rr[1])); }
    if (__all(pmax - m_reg < -106.f)) return false;
    if (__builtin_expect(__all((pmax - m_reg) <= THR), 1)) { mn = m_reg; alpha = 1.f; }
    else { mn = fmaxf(m_reg, pmax); alpha = __builtin_amdgcn_exp2f((m_reg - mn) * LOG2E); m_reg = mn; }
    const float mnL = -mn * LOG2E;
#pragma unroll
    for (int r = 0; r < 16; ++r) p0[r] = fmaf(p0[r], LOG2E, mnL);
#pragma unroll
    for (int r = 0; r < 16; ++r) p1[r] = fmaf(p1[r], LOG2E, mnL);
#pragma unroll
    for (int r = 0; r < 16; ++r) p0[r] = __builtin_amdgcn_exp2f(p0[r]);
    return true;
}
__device__ __forceinline__ void finishSM(f32x16& p0, f32x16& p1, float alpha, float& l_reg, bf16x8& pa0, bf16x8& pa1, bf16x8& pa2, bf16x8& pa3) {
#pragma unroll
    for (int r = 0; r < 16; ++r) p1[r] = __builtin_amdgcn_exp2f(p1[r]);
    float ps = 0;
#pragma unroll
    for (int r = 0; r < 16; ++r) ps += p0[r];
#pragma unroll
    for (int r = 0; r < 16; ++r) ps += p1[r];
    { auto rr = __builtin_amdgcn_permlane32_swap(__float_as_uint(ps), __float_as_uint(ps), false, false);
      ps = __uint_as_float(rr[0]) + __uint_as_float(rr[1]); }
    l_reg = l_reg * alpha + ps;
#define PK4(P, B_, OUT) do { unsigned a0 = cvt_pk_bf16(P[B_+0], P[B_+1]), a1 = cvt_pk_bf16(P[B_+2], P[B_+3]);                          \
        unsigned b0 = cvt_pk_bf16(P[B_+4], P[B_+5]), b1 = cvt_pk_bf16(P[B_+6], P[B_+7]);                                             \
        auto r0 = __builtin_amdgcn_permlane32_swap(a0, b0, false, false); auto r1 = __builtin_amdgcn_permlane32_swap(a1, b1, false, false); \
        u32x4 w = {r0[0], r1[0], r0[1], r1[1]}; OUT = __builtin_bit_cast(bf16x8, w); } while (0)
    PK4(p0, 0, pa0); PK4(p0, 8, pa1); PK4(p1, 0, pa2); PK4(p1, 8, pa3);
#undef PK4
}
template <int KB>
__device__ __forceinline__ void qkt(f32x16& p0, f32x16& p1, const LAS char* K_lds, int r32, int hi, const bf16x8* qr, bf16x8 kf0, bf16x8 kf1, bf16x8 qf) {
    const LAS char* kb[4];
#pragma unroll
    for (int dd = 0; dd < 4; ++dd) kb[dd] = K_lds + KB * SHM_K + KSWZ(r32, (dd * 16 + hi * 8) * 2);
    bf16x8 ka[2], kc[2];
    ka[0] = *(const LAS bf16x8*)(kb[0]); kc[0] = *(const LAS bf16x8*)(kb[0] + 32 * 256);
    p0 = __builtin_amdgcn_mfma_f32_32x32x16_bf16(kf0, qf, (f32x16){0.f, 0.f, 0.f, 0.f, 0.f, 0.f, 0.f, 0.f, 0.f, 0.f, 0.f, 0.f, 0.f, 0.f, 0.f, 0.f}, 0, 0, 0);
    p1 = __builtin_amdgcn_mfma_f32_32x32x16_bf16(kf1, qf, (f32x16){0.f, 0.f, 0.f, 0.f, 0.f, 0.f, 0.f, 0.f, 0.f, 0.f, 0.f, 0.f, 0.f, 0.f, 0.f, 0.f}, 0, 0, 0);
    SBAR();
#pragma unroll
    for (int d0 = 0; d0 < 8; ++d0) { const int c = d0 & 1;
        if (d0 < 7) { const LAS char* ap = kb[(d0 + 1) & 3] + ((d0 + 1) >> 2) * 128; ka[c ^ 1] = *(const LAS bf16x8*)(ap); kc[c ^ 1] = *(const LAS bf16x8*)(ap + 32 * 256); }
        p0 = __builtin_amdgcn_mfma_f32_32x32x16_bf16(ka[c], qr[d0], p0, 0, 0, 0);
        p1 = __builtin_amdgcn_mfma_f32_32x32x16_bf16(kc[c], qr[d0], p1, 0, 0, 0);
        SBAR(); }
}
template <int VB>
__device__ __forceinline__ void pv_tile(f32x16* o, int vb0, bf16x8 pa0, bf16x8 pa1, bf16x8 pa2, bf16x8 pa3) {
#define TRRD(dst, off) asm volatile("ds_read_b64_tr_b16 %0, %1 offset:%2" : "=&v"(dst) : "v"(vb0), "i"(off) : "memory")
#define PV_RD(S, d0) do { constexpr int b_ = VB * SHM_V + v_rd_off(d0, 0, 0); \
        TRRD(S[0], b_); TRRD(S[4], b_ + 2048); TRRD(S[1], b_ + 4096); TRRD(S[5], b_ + 6144); TRRD(S[2], b_ + 8192); TRRD(S[6], b_ + 10240); TRRD(S[3], b_ + 12288); TRRD(S[7], b_ + 14336); } while (0)
#define PV_MM(S, d0) do { \
        o[d0] = __builtin_amdgcn_mfma_f32_32x32x16_bf16(pa0, (bf16x8){S[0][0], S[0][1], S[0][2], S[0][3], S[4][0], S[4][1], S[4][2], S[4][3]}, o[d0], 0, 0, 0);   \
        o[d0] = __builtin_amdgcn_mfma_f32_32x32x16_bf16(pa1, (bf16x8){S[1][0], S[1][1], S[1][2], S[1][3], S[5][0], S[5][1], S[5][2], S[5][3]}, o[d0], 0, 0, 0);   \
        o[d0] = __builtin_amdgcn_mfma_f32_32x32x16_bf16(pa2, (bf16x8){S[2][0], S[2][1], S[2][2], S[2][3], S[6][0], S[6][1], S[6][2], S[6][3]}, o[d0], 0, 0, 0);   \
        o[d0] = __builtin_amdgcn_mfma_f32_32x32x16_bf16(pa3, (bf16x8){S[3][0], S[3][1], S[3][2], S[3][3], S[7][0], S[7][1], S[7][2], S[7][3]}, o[d0], 0, 0, 0); } while (0)
    s16x4 A[8], B[8];
    PV_RD(A, 0);
    PV_RD(B, 1); asm volatile("s_waitcnt lgkmcnt(8)" ::: "memory"); SBAR(); PV_MM(A, 0); SBAR();
    PV_RD(A, 2); asm volatile("s_waitcnt lgkmcnt(8)" ::: "memory"); SBAR(); PV_MM(B, 1); SBAR();
    PV_RD(B, 3); asm volatile("s_waitcnt lgkmcnt(8)" ::: "memory"); SBAR(); PV_MM(A, 2); SBAR();
    asm volatile("s_waitcnt lgkmcnt(0)" ::: "memory"); SBAR(); PV_MM(B, 3);
#undef PV_RD
#undef PV_MM
#undef TRRD
}
typedef const __attribute__((address_space(4))) unsigned long long* cmask_t;
__device__ __forceinline__ void mask_tile(f32x16& p0, f32x16& p1, const unsigned long long* mpg) {
    const float NEG = -__builtin_inff();
    cmask_t mp = (cmask_t)mpg;
    asm volatile("s_nop 15\n\ts_nop 7" : "+v"(p0), "+v"(p1));
#pragma unroll
    for (int r = 0; r < 16; ++r) { const unsigned long long m0 = mp[r], m1 = mp[16 + r];
        asm volatile("v_cndmask_b32 %0, %1, %0, %2" : "+v"(p0[r]) : "v"(NEG), "s"(m0));
        asm volatile("v_cndmask_b32 %0, %1, %0, %2" : "+v"(p1[r]) : "v"(NEG), "s"(m1)); }
}
template <int BUF>
__device__ __forceinline__ void tile_step(f32x16* o, float& m_reg, float& l_reg, const LAS char* K_lds, int vb0, LAS float* al_l, int r32, int hi, const bf16x8* qr,
                                          int kb_key, bf16x8 qf, const unsigned long long* mp) {
    f32x16 p0, p1; float mn, alpha; bf16x8 pa0, pa1, pa2, pa3;
    const unsigned kbb = __float_as_uint((float)kb_key) >> 16, k0b = __float_as_uint((float)r32) >> 16, k1b = __float_as_uint((float)(r32 + 32)) >> 16;
    u32x4 f0 = {hi ? 0u : (kbb | (k0b << 16)), 0u, 0u, 0u}, f1 = {hi ? 0u : (kbb | (k1b << 16)), 0u, 0u, 0u};
    qkt<BUF>(p0, p1, K_lds, r32, hi, qr, __builtin_bit_cast(bf16x8, f0), __builtin_bit_cast(bf16x8, f1), qf);
    mask_tile(p0, p1, mp);
    if (!partialSM(p0, p1, m_reg, mn, alpha)) return;
    finishSM(p0, p1, alpha, l_reg, pa0, pa1, pa2, pa3);
    if (__any(alpha < 1.f)) { if (hi == 0) al_l[r32] = alpha; asm volatile("s_waitcnt lgkmcnt(0)" ::: "memory");
#pragma unroll
        for (int r = 0; r < 16; ++r) { const float av = al_l[crow(r, hi)];
#pragma unroll
            for (int d_ = 0; d_ < 4; ++d_) o[d_][r] *= av; } }
    pv_tile<BUF>(o, vb0, pa0, pa1, pa2, pa3);
}
__device__ __forceinline__ void attn_unit(Frame& F, const float* __restrict__ qgain, int b, int g, int qb, unsigned* done_ctr) {
    const bf16_t* Q = (const bf16_t*)(F.ws + WS_Q); const bf16_t* K = (const bf16_t*)(F.ws + WS_K); const bf16_t* V = (const bf16_t*)(F.ws + WS_V);
    unsigned char* O = F.ws + WS_ATTN;
    const unsigned long long* MT = (const unsigned long long*)(F.ws + WS_MASK);
    LAS char* lds = (LAS char*)F.lds;
    const int wid = F.wave, lane = lane_id(), tid = wid * 64 + lane, r32 = lane & 31, hi = lane >> 5;
    const int hq = wid >> 1, th = wid & 1, h = 4 * g + hq, tok0 = b * SEQ + 64 * qb + 32 * th, NT = qb + 1;
    LAS char* V_lds = lds + LDS_V; LAS char* K_lds = lds + LDS_K; LAS float* wsf = (LAS float*)(lds + LDS_WS) + wid * 64; LAS float* li_l = wsf; LAS float* al_l = wsf + 32;
    const int sr = tid >> 4, sc = (tid & 15) * 8, vst0 = v_st(sr, sc), vst1 = v_st(32 + sr, sc), kws = KSWZ(sr, sc * 2);
    const int vb0 = (int)(uintptr_t)V_lds + v_rd_base(lane);
    bf16x8 qr[8];
    {
      u32x4 qw[8]; float ss = 0.f;
#pragma unroll
      for (int d0 = 0; d0 < 8; ++d0) { qw[d0] = *(const u32x4*)(Q + (size_t)(tok0 + r32) * AW + h * HD + d0 * 16 + hi * 8);
#pragma unroll
          for (int j = 0; j < 4; ++j) { const float lo = bflo(qw[d0][j]), hv = bfhi(qw[d0][j]); ss += lo * lo + hv * hv; } }
      { auto rr = __builtin_amdgcn_permlane32_swap(__float_as_uint(ss), __float_as_uint(ss), false, false); ss = __uint_as_float(rr[0]) + __uint_as_float(rr[1]); }
      const float rq = rsqrtf(ss * (1.0f / HD) + NORM_EPS) * 0.08838834764831845f;
#pragma unroll
      for (int d0 = 0; d0 < 8; ++d0) { const f32x4 g0 = *(const f32x4*)(qgain + d0 * 16 + hi * 8), g1 = *(const f32x4*)(qgain + d0 * 16 + hi * 8 + 4); u32x4 o;
          o[0] = cvt_pk_bf16(bflo(qw[d0][0]) * rq * g0[0], bfhi(qw[d0][0]) * rq * g0[1]); o[1] = cvt_pk_bf16(bflo(qw[d0][1]) * rq * g0[2], bfhi(qw[d0][1]) * rq * g0[3]);
          o[2] = cvt_pk_bf16(bflo(qw[d0][2]) * rq * g1[0], bfhi(qw[d0][2]) * rq * g1[1]); o[3] = cvt_pk_bf16(bflo(qw[d0][3]) * rq * g1[2], bfhi(qw[d0][3]) * rq * g1[3]);
          qr[d0] = __builtin_bit_cast(bf16x8, o); } }
    const unsigned sb = __float_as_uint(__builtin_ldexpf(1.0f, -(h + 1))) >> 16;
    const u32x4 qfw = {hi ? 0u : (sb | (sb << 16)), 0u, 0u, 0u}; const bf16x8 qf = __builtin_bit_cast(bf16x8, qfw);
    const bf16_t* Kg = K + (size_t)(b * SEQ) * KVW + g * HD + sc; const bf16_t* Vg = V + (size_t)(b * SEQ) * KVW + g * HD + sc;
    const unsigned long long* mrow = MT + (size_t)__builtin_amdgcn_readfirstlane(tok0 >> 5) * 64 * 32;
    float m_reg = -1e30f, l_reg = 0.f; f32x16 o[4] = {};
    bf16x8 st_k0, st_k1, st_v0, st_v1;
#define SLOAD(k0) do { st_k0 = *(const bf16x8*)(Kg + (size_t)((k0) + sr) * KVW); st_k1 = *(const bf16x8*)(Kg + (size_t)((k0) + 32 + sr) * KVW); \
                       st_v0 = *(const bf16x8*)(Vg + (size_t)((k0) + sr) * KVW); st_v1 = *(const bf16x8*)(Vg + (size_t)((k0) + 32 + sr) * KVW); } while (0)
#define SWRITE(bf) do { *(LAS bf16x8*)(K_lds + (bf) * SHM_K + kws) = st_k0; *(LAS bf16x8*)(K_lds + (bf) * SHM_K + kws + 32 * 256) = st_k1; \
                        *(LAS bf16x8*)(V_lds + (bf) * SHM_V + vst0) = st_v0; *(LAS bf16x8*)(V_lds + (bf) * SHM_V + vst1) = st_v1; } while (0)
#define TK(u_) (NT - 1 - (u_))
    SLOAD(TK(0) * KVBLK); SWRITE(0);
    __syncthreads();
    bool signaled = false;
    for (int t = 0; t < NT; t += 2) {
        if (done_ctr && !signaled && t + 8 >= NT) { signaled = true; if (wid == 0 && lane == 0) __hip_atomic_fetch_add(done_ctr, 1u, __ATOMIC_RELAXED, __HIP_MEMORY_SCOPE_AGENT); }
        if (t + 1 < NT) SLOAD(TK(t + 1) * KVBLK);
        tile_step<0>(o, m_reg, l_reg, K_lds, vb0, al_l, r32, hi, qr, TK(t) * KVBLK, qf, mrow + (size_t)TK(t) * 32);
        if (t + 1 < NT) SWRITE(1);
        __syncthreads();
        if (t + 1 < NT) {
            if (t + 2 < NT) SLOAD(TK(t + 2) * KVBLK);
            tile_step<1>(o, m_reg, l_reg, K_lds, vb0, al_l, r32, hi, qr, TK(t + 1) * KVBLK, qf, mrow + (size_t)TK(t + 1) * 32);
            if (t + 2 < NT) SWRITE(0);
            __syncthreads();
        }
    }
#undef TK
#undef SLOAD
#undef SWRITE
    if (hi == 0) li_l[r32] = l_reg; asm volatile("s_waitcnt lgkmcnt(0)" ::: "memory");
    unsigned char* Ow = O + (size_t)tok0 * AW + h * HD;
#pragma unroll
    for (int r = 0; r < 16; ++r) { const int orow = crow(r, hi); const float rl = __builtin_amdgcn_rcpf(li_l[orow]) * (FP8_MERGE ? A8_SCALE : 1.0f);
#pragma unroll
        for (int d0 = 0; d0 < 4; ++d0) { const float v = o[d0][r] * rl; const float v1 = __shfl_xor(v, 1);
            if constexpr (FP8_MERGE) { const float v2 = __shfl_xor(v, 2), v3 = __shfl_xor(v1, 2);
                if ((r32 & 3) == 0) *(unsigned*)(Ow + (size_t)orow * AW + d0 * 32 + r32) = pk4_fp8(v, v1, v2, v3); }
            else { if ((r32 & 1) == 0) *(unsigned*)((bf16_t*)O + (size_t)(tok0 + orow) * AW + h * HD + d0 * 32 + r32) = cvt_pk_bf16(v, v1); } } }
    __syncthreads();
}
#undef KSWZ
#undef SBAR
}
struct SchedPool {
    const char* A; const char* B; int c;
    __device__ __forceinline__ bool next(int i, pg8::Unit& u) const { if (i > 0 || c >= 128) return false; const int rt = c >> 2, g = c & 3; u.pm = rt; u.pn = g; u.aux = 0; u.tok = nullptr; u.nt8 = 0;
        u.A = A + ((size_t)rt * 256 * PW + g * 256) * 2; u.B = B + (size_t)g * 65536 * 2; return true; }
};
struct EpiPool {
    unsigned char* out; const float* pscale;
    __device__ __forceinline__ bool operator()(f32x4 (&acc)[2][2][4][2], const pg8::Unit& u, int wr, int wc, int fr, int fq) const {
        const int row0 = u.pm * 256 + wr * 64 + fr, col0 = u.pn * 256 + wc * 32 + 8 * fq;
#pragma unroll
        for (int bj = 0; bj < 2; ++bj) { const f32x4 s0 = *(const f32x4*)(pscale + col0 + bj * 128), s1 = *(const f32x4*)(pscale + col0 + bj * 128 + 4);
#pragma unroll
            for (int ai = 0; ai < 2; ++ai)
#pragma unroll
                for (int m = 0; m < 4; ++m) { const size_t o = (size_t)(row0 + ai * 128 + m * 16) * PW + col0 + bj * 128;
                    if constexpr (FP8_MERGE) { const f32x4 v0 = acc[ai][bj][m][0] * s0 * A8_SCALE, v1 = acc[ai][bj][m][1] * s1 * A8_SCALE; u32x2 w; w.x = pk4_fp8(v0[0], v0[1], v0[2], v0[3]); w.y = pk4_fp8(v1[0], v1[1], v1[2], v1[3]); *(u32x2*)(out + o) = w; }
                    else st_bf16x8((bf16_t*)out + o, acc[ai][bj][m][0] * s0, acc[ai][bj][m][1] * s1); } }
        return false;
    }
};
__device__ __forceinline__ void p4_pool_attn(Frame& F, const Args& a) {
    for (int c = blockIdx.x; c < 256; c += F.G) {
        const int bg = c >> 6, qb = c & 63;
        att::attn_unit(F, a.in[I_QNORM], bg >> 1, bg & 1, qb, (c + F.G >= 256) ? F.ctl + CW_DONE + 64 * 4 : nullptr);
        if (qb < 32) { const int pu = bg * 32 + qb, rt = pu >> 2, g = pu & 3;
            pooled_item(F, rt * 256 + 32 * F.wave, g, lane_id());
            asm volatile("s_waitcnt vmcnt(0)" ::: "memory"); __syncthreads();
            SchedPool S{(const char*)(F.ws + WS_POOLED), (const char*)(F.ws + WS_PLIN), pu}; EpiPool E{F.ws + WS_POOL, a.in[I_PSCALE]};
            pg8::gemm_phase<EpiPool, SchedPool, false>(F.lds, F.wave, 256 * 2, PW * 2, S, E); __syncthreads(); }
    }
}
struct SchedMerge {
    pg8::TileOrder T; const char* A0; const char* B0; const char* A1; const char* B1;
    __device__ __forceinline__ bool next(int i, pg8::Unit& u) const { int pm, pn; if (!T.tile(i >> 1, pm, pn)) return false; u.pm = pm; u.pn = pn; u.aux = i & 1; u.tok = nullptr; u.nt8 = 0;
        u.A = ((i & 1) ? A1 : A0) + (size_t)pm * 256 * 1024 * (FP8_MERGE ? 1 : 2); u.B = ((i & 1) ? B1 : B0) + (size_t)pn * 256 * 1024 * (FP8_MERGE ? 1 : 2); return true; }
};
struct EpiMerge {
    const bf16_t* G; unsigned char* out;
    __device__ __forceinline__ bool operator()(f32x4 (&acc)[2][2][4][2], const pg8::Unit& u, int wr, int wc, int fr, int fq) const {
        const int row0 = u.pm * 256 + wr * 64 + fr, col0 = u.pn * 256 + wc * 32 + 8 * fq;
#pragma unroll
        for (int ai = 0; ai < 2; ++ai)
#pragma unroll
            for (int m = 0; m < 4; ++m) { const size_t r = (size_t)(row0 + ai * 128 + m * 16);
#pragma unroll
                for (int bj = 0; bj < 2; ++bj) { const int c = col0 + bj * 128;
                    const u32x4 gp = *(const u32x4*)(G + r * (2 * DM) + DM + c);
                    const f32x4 p0 = {bflo(gp[0]), bfhi(gp[0]), bflo(gp[1]), bfhi(gp[1])}, p1 = {bflo(gp[2]), bfhi(gp[2]), bflo(gp[3]), bfhi(gp[3])};
                    if (u.aux == 0) { const u32x4 ga = *(const u32x4*)(G + r * (2 * DM) + c);
                        const f32x4 a0 = {bflo(ga[0]), bfhi(ga[0]), bflo(ga[1]), bfhi(ga[1])}, a1 = {bflo(ga[2]), bfhi(ga[2]), bflo(ga[3]), bfhi(ga[3])};
#pragma unroll
                        for (int j = 0; j < 4; ++j) { acc[ai][bj][m][0][j] *= a0[j] * __builtin_amdgcn_rcpf(fmaxf(p0[j], 1e-30f)); acc[ai][bj][m][1][j] *= a1[j] * __builtin_amdgcn_rcpf(fmaxf(p1[j], 1e-30f)); } }
                    else { if constexpr (FP8_OUT) { const f32x4 v0 = acc[ai][bj][m][0] * p0 * A8_SCALE, v1 = acc[ai][bj][m][1] * p1 * A8_SCALE; u32x2 w; w.x = pk4_fp8(v0[0], v0[1], v0[2], v0[3]); w.y = pk4_fp8(v1[0], v1[1], v1[2], v1[3]);
                        *(u32x2*)(out + r * DM + c) = w; } else st_bf16x8((bf16_t*)out + r * DM + c, acc[ai][bj][m][0] * p0, acc[ai][bj][m][1] * p1); } } }
        return u.aux == 0;
    }
};
__device__ __forceinline__ void p5_merge(Frame& F) {
    SchedMerge S; S.T.init(NTOK, DM, F.G, (int)blockIdx.x); S.A0 = (const char*)(F.ws + WS_ATTN); S.B0 = (const char*)(F.ws + WS_WAU); S.A1 = (const char*)(F.ws + WS_POOL); S.B1 = (const char*)(F.ws + WS_WPU);
    EpiMerge E{(const bf16_t*)(F.ws + WS_G), F.ws + WS_MERGED};
    constexpr int ES = FP8_MERGE ? 1 : 2;
    pg8::gemm_phase<EpiMerge, SchedMerge, false, ES, FP8_MERGE ? A8_E8 : 127, FP8_MERGE ? W8_E8 : 127>(F.lds, F.wave, 1024 * ES, 1024 * ES, S, E);
}
struct EpiOut {
    const float* x; const float* mod; float* out;
    __device__ __forceinline__ bool operator()(f32x4 (&acc)[2][2][4][2], const pg8::Unit& u, int wr, int wc, int fr, int fq) const {
        const int row0 = u.pm * 256 + wr * 64 + fr, col0 = u.pn * 256 + wc * 32 + 8 * fq; const int b = (u.pm * 256) / SEQ;
        const float* gm = mod + b * 6 * DM + 2 * DM;
#pragma unroll
        for (int bj = 0; bj < 2; ++bj) { const int c = col0 + bj * 128; const f32x4 g0 = *(const f32x4*)(gm + c), g1 = *(const f32x4*)(gm + c + 4);
#pragma unroll
            for (int ai = 0; ai < 2; ++ai)
#pragma unroll
                for (int m = 0; m < 4; ++m) { const size_t o = (size_t)(row0 + ai * 128 + m * 16) * DM + c;
                    const f32x4 x0 = *(const f32x4*)(x + o), x1 = *(const f32x4*)(x + o + 4);
                    *(f32x4*)(out + o) = x0 + g0 * acc[ai][bj][m][0]; *(f32x4*)(out + o + 4) = x1 + g1 * acc[ai][bj][m][1]; } }
        return false;
    }
};
__device__ __forceinline__ void p6_out(Frame& F, const Args& a) {
    SchedDense S; S.T.init(NTOK, DM, F.G, (int)blockIdx.x); S.A = (const char*)(F.ws + WS_MERGED); S.B = (const char*)(F.ws + WS_WOUT);
    constexpr int ES = FP8_OUT ? 1 : 2; S.a_tile = (size_t)256 * DM * ES; S.b_tile = (size_t)256 * DM * ES;
    EpiOut E{a.in[I_X], (const float*)(F.ctl + CW_MOD), F.out};
    pg8::gemm_phase<EpiOut, SchedDense, false, ES, FP8_OUT ? A8_E8 : 127, FP8_OUT ? W8_E8 : 127>(F.lds, F.wave, DM * ES, DM * ES, S, E);
}
constexpr int P7_ROWB = 4096 + 16;
constexpr int P7_ROWS = 32, P7_RW = P7_ROWS / NWAVES;
constexpr int P7_LDS_P = P7_ROWS * P7_ROWB;
constexpr int P7_LDS_H = P7_LDS_P + 2 * P7_ROWS * 64 * 4;
__device__ __forceinline__ void p7_router(Frame& F, const Args& a) {
    const float* mod = (const float*)(F.ctl + CW_MOD);
    unsigned char* hb8 = F.ws + WS_HB; const bf16_t* Wr = (const bf16_t*)(F.ws + WS_WR);
    unsigned char* rt = F.ws + WS_ROUTE;
    int* eid = (int*)(rt + RT_EID); float* gate = (float*)(rt + RT_GATE); int* posn = (int*)(rt + RT_POS); int* list = (int*)(rt + RT_LIST); int* ident = (int*)(rt + RT_IDENT);
    unsigned* ecnt = F.ctl + CW_ECNT;
    LAS unsigned char* lds = F.lds; LAS float* P = (LAS float*)(lds + P7_LDS_P); LAS unsigned* hist = (LAS unsigned*)(lds + P7_LDS_H); LAS unsigned* baseL = hist + 64;
    const int lane = lane_id(), w = F.wave, tid = w * 64 + lane;
    if (tid < 64) hist[tid] = 0u;
    __syncthreads();
    for (int p = blockIdx.x; p < NTOK / P7_ROWS; p += F.G) {
        const int row0 = P7_ROWS * p;
        { const int b = row0 / SEQ; const float* sh = mod + b * 6 * DM + 3 * DM; const float* sl = mod + b * 6 * DM + 4 * DM;
          f32x4 v[P7_RW][8];
#pragma unroll
          for (int rr = 0; rr < P7_RW; ++rr) { const float* xrow = F.out + (size_t)(row0 + P7_RW * w + rr) * DM;
#pragma unroll
              for (int j = 0; j < 8; ++j) v[rr][j] = *(const f32x4*)(xrow + 4 * lane + 256 * j); }
          float rstd[P7_RW];
#pragma unroll
          for (int rr = 0; rr < P7_RW; ++rr) { float ss = 0.f;
#pragma unroll
              for (int j = 0; j < 8; ++j) ss += (v[rr][j].x * v[rr][j].x + v[rr][j].y * v[rr][j].y) + (v[rr][j].z * v[rr][j].z + v[rr][j].w * v[rr][j].w);
              rstd[rr] = rsqrtf(wave_sum(ss) * (1.0f / DM) + NORM_EPS); }
#pragma unroll
          for (int j = 0; j < 8; ++j) { const int c = 4 * lane + 256 * j;
              const f32x4 gg = *(const f32x4*)(a.in[I_GFFN] + c), shv = *(const f32x4*)(sh + c), slv = *(const f32x4*)(sl + c); const f32x4 mul = gg * (slv + 1.0f);
#pragma unroll
              for (int rr = 0; rr < P7_RW; ++rr) { const int lr = P7_RW * w + rr, m = row0 + lr;
                  const f32x4 o = v[rr][j] * rstd[rr] * mul + shv;
                  u32x2 wv; wv.x = cvt_pk_bf16(o.x, o.y); wv.y = cvt_pk_bf16(o.z, o.w);
                  *(unsigned*)(hb8 + (size_t)m * DM + c) = pk4_fp8(o.x * H8_SCALE, o.y * H8_SCALE, o.z * H8_SCALE, o.w * H8_SCALE); *(LAS u32x2*)(lds + lr * P7_ROWB + c * 2) = wv; } }
          if (lane < P7_RW) ident[row0 + P7_RW * w + lane] = row0 + P7_RW * w + lane;
        }
        __syncthreads();
        { const int nb = w & 3, kh = w >> 2, fr = lane & 15, kq = lane >> 4;
          f32x4 acc[2] = {{0.f, 0.f, 0.f, 0.f}, {0.f, 0.f, 0.f, 0.f}};
          const bf16_t* wp = Wr + (size_t)(16 * nb + fr) * DM + 1024 * kh + 8 * kq;
          const LAS unsigned char* ap = lds + fr * P7_ROWB + (1024 * kh + 8 * kq) * 2;
#pragma unroll 8
          for (int s = 0; s < 32; ++s) { const bf16x8 bv = *(const bf16x8*)(wp + 32 * s);
#pragma unroll
              for (int mb = 0; mb < 2; ++mb) { const bf16x8 av = *(const LAS bf16x8*)(ap + mb * 16 * P7_ROWB + 64 * s); acc[mb] = __builtin_amdgcn_mfma_f32_16x16x32_bf16(av, bv, acc[mb], 0, 0, 0); } }
#pragma unroll
          for (int mb = 0; mb < 2; ++mb)
#pragma unroll
              for (int j = 0; j < 4; ++j) P[(kh * P7_ROWS + 16 * mb + 4 * kq + j) * 64 + 16 * nb + fr] = acc[mb][j];
        }
        __syncthreads();
        int myrank[P7_RW]; unsigned mylocal[P7_RW]; bool chosen[P7_RW]; float mygate[P7_RW];
#pragma unroll
        for (int rr = 0; rr < P7_RW; ++rr) { const int lr = P7_RW * w + rr;
            const float logit = P[lr * 64 + lane] + P[(P7_ROWS + lr) * 64 + lane];
            const float score = 1.0f / (1.0f + __expf(-logit)); const float sel = score + a.in[I_RBIAS][lane];
            float m1 = sel; m1 = fmaxf(m1, __shfl_xor(m1, 1)); m1 = fmaxf(m1, __shfl_xor(m1, 2)); m1 = fmaxf(m1, __shfl_xor(m1, 4));
            const unsigned long long bm = __ballot(sel == m1); const unsigned grp = (unsigned)((bm >> (lane & ~7)) & 0xffull); const int first = __builtin_ctz(grp | 0x100u);
            float m2 = ((lane & 7) == first) ? -__builtin_inff() : sel; m2 = fmaxf(m2, __shfl_xor(m2, 1)); m2 = fmaxf(m2, __shfl_xor(m2, 2)); m2 = fmaxf(m2, __shfl_xor(m2, 4));
            const float gs = m1 + m2; const int g = lane >> 3; int grank = 0;
#pragma unroll
            for (int g2 = 0; g2 < 8; ++g2) { const float o = __uint_as_float(__builtin_amdgcn_readlane(__float_as_uint(gs), 8 * g2)); grank += (o > gs || (o == gs && g2 < g)) ? 1 : 0; }
            const float selm = grank < TOPG ? sel : -__builtin_inff(); int rank = 0;
#pragma unroll
            for (int e2 = 0; e2 < 64; ++e2) { const float o = __uint_as_float(__builtin_amdgcn_readlane(__float_as_uint(selm), e2)); rank += (o > selm || (o == selm && e2 < lane)) ? 1 : 0; }
            const bool ch = rank < ETOP && grank < TOPG; const float gsum = wave_sum(ch ? score : 0.f);
            chosen[rr] = ch; myrank[rr] = rank; mygate[rr] = score / gsum * ROUTED_SCALE;
            mylocal[rr] = ch ? __hip_atomic_fetch_add(hist + lane, 1u, __ATOMIC_RELAXED, __HIP_MEMORY_SCOPE_WORKGROUP) : 0u;
        }
        __syncthreads();
        if (w == 0) { const unsigned c = hist[lane]; baseL[lane] = c ? __hip_atomic_fetch_add(ecnt + lane, c, __ATOMIC_RELAXED, __HIP_MEMORY_SCOPE_AGENT) : 0u; hist[lane] = 0u; }
        __syncthreads();
#pragma unroll
        for (int rr = 0; rr < P7_RW; ++rr) if (chosen[rr]) { const int m = row0 + P7_RW * w + rr; const unsigned pos = baseL[lane] + mylocal[rr];
            eid[m * 8 + myrank[rr]] = lane; gate[m * 8 + myrank[rr]] = mygate[rr]; posn[m * 8 + myrank[rr]] = (int)pos; list[(size_t)lane * NTOK + pos] = m; }
        __syncthreads();
    }
}
constexpr int MOE_LDS = 131072;
__device__ __forceinline__ int moe_prefix(Frame& F) {
    LAS int* rtoff = (LAS int*)(F.lds + MOE_LDS);
    if (F.wave == 0 && lane_id() == 0) { int s = 0; for (int e = 0; e < NE; ++e) { rtoff[e] = s; unsigned n = F.ctl[CW_ECNT + e]; if (n > (unsigned)NTOK) n = NTOK; s += (int)((n + 255u) >> 8); } rtoff[NE] = s; }
    __syncthreads();
    return __builtin_amdgcn_readfirstlane(rtoff[NE]);
}
__device__ __forceinline__ int moe_find(const LAS int* rtoff, int rtg) {
    int lo = 0, hi = NE;
#pragma unroll
    for (int it = 0; it < 6; ++it) { const int mid = (lo + hi) >> 1; const int v = __builtin_amdgcn_readfirstlane(rtoff[mid]); if (v <= rtg) lo = mid; else hi = mid; }
    return lo;
}
struct SchedMoe1 {
    const LAS int* rtoff; int RT, G, c; const char* hb; const char* w13; const char* ws13; const int* list; const int* ident;
    __device__ __forceinline__ bool next(int i, pg8::Unit& u) const {
        const int idx = i * G + (c & 7) * (G >> 3) + (c >> 3); if (idx >= (RT + NTOK / 256) * 4) return false;
        const int rtg = idx >> 2, ct = idx & 3; u.pn = ct; u.aux = 0; u.nt8 = 0; u.A = hb;
        if (rtg < RT) { const int e = moe_find(rtoff, rtg), rt = rtg - __builtin_amdgcn_readfirstlane(rtoff[e]); u.pm = rtg; u.tok = list + (size_t)e * NTOK + rt * 256;
            u.B = w13 + ((size_t)e * 1024 + ct * 256) * DM; }
        else { const int rt = rtg - RT; u.pm = HROWS_R / 256 + rt; u.tok = ident + rt * 256; u.B = ws13 + (size_t)(ct * 256) * DM; }
        return true; }
};
struct EpiMoe1 {
    unsigned char* H;
    __device__ __forceinline__ bool operator()(f32x4 (&acc)[2][2][4][2], const pg8::Unit& u, int wr, int wc, int fr, int fq) const {
        const int row0 = u.pm * 256 + wr * 64 + fr, col0 = u.pn * 128 + wc * 32 + 8 * fq;
#pragma unroll
        for (int ai = 0; ai < 2; ++ai)
#pragma unroll
            for (int m = 0; m < 4; ++m) { f32x4 h0, h1;
#pragma unroll
                for (int j = 0; j < 4; ++j) { const float g0 = acc[ai][0][m][0][j], g1 = acc[ai][0][m][1][j];
                    h0[j] = g0 * __builtin_amdgcn_rcpf(1.0f + __expf(-g0)) * acc[ai][1][m][0][j]; h1[j] = g1 * __builtin_amdgcn_rcpf(1.0f + __expf(-g1)) * acc[ai][1][m][1][j]; }
                u32x2 w; w.x = pk4_fp8(h0[0] * H8_SCALE, h0[1] * H8_SCALE, h0[2] * H8_SCALE, h0[3] * H8_SCALE); w.y = pk4_fp8(h1[0] * H8_SCALE, h1[1] * H8_SCALE, h1[2] * H8_SCALE, h1[3] * H8_SCALE);
                *(u32x2*)(H + (size_t)(row0 + ai * 128 + m * 16) * EH + col0) = w; }
        return false;
    }
};
__device__ __forceinline__ void p8_gemm1(Frame& F, const Args& a) {
    const int RT = moe_prefix(F);
    const int U = (RT + NTOK / 256) * 4, R0 = (U + F.G - 1) / F.G, R = (R0 * F.G - U < 24 * R0) ? R0 + 1 : R0, NG0 = ((U + R - 1) / R + 7) & ~7, NG = NG0 < F.G ? NG0 : (F.G & ~7);
    if ((int)blockIdx.x >= NG) { conv_drain<false, 1, 2>(F, a, 8); return; }
    SchedMoe1 S{(const LAS int*)(F.lds + MOE_LDS), RT, NG, (int)blockIdx.x, (const char*)(F.ws + WS_HB), (const char*)(F.ws + WS_W13), (const char*)(F.ws + WS_WS13),
                (const int*)(F.ws + WS_ROUTE + RT_LIST), (const int*)(F.ws + WS_ROUTE + RT_IDENT)};
    EpiMoe1 E{F.ws + WS_H};
    pg8::gemm_phase<EpiMoe1, SchedMoe1, true, 1, H8_E8, W8_E8>(F.lds, F.wave, DM, DM, S, E);
    conv_drain<false, 1, 2>(F, a, 8);
}
struct SchedMoe2 {
    const LAS int* rtoff; int RT, G, c; const char* H; const char* w2; const char* ws2;
    __device__ __forceinline__ bool next(int i, pg8::Unit& u) const {
        const int idx = (G & 7) ? i * G + c : i * G + (c & 7) * (G >> 3) + (c >> 3); if (idx >= (RT + NTOK / 256) * 8) return false;
        const int rtg = idx >> 3, ct = idx & 7; u.pn = ct; u.aux = 0; u.tok = nullptr; u.nt8 = 0;
        if (rtg < RT) { const int e = moe_find(rtoff, rtg); u.pm = rtg; u.B = w2 + ((size_t)e * DM + ct * 256) * EH; }
        else { u.pm = HROWS_R / 256 + (rtg - RT); u.B = ws2 + (size_t)(ct * 256) * EH; }
        u.A = H + (size_t)u.pm * 256 * EH; return true; }
};
constexpr float Y8_SCALE = 8.f;
struct EpiY {
    unsigned char* Y;
    __device__ __forceinline__ bool operator()(f32x4 (&acc)[2][2][4][2], const pg8::Unit& u, int wr, int wc, int fr, int fq) const {
        const int row0 = u.pm * 256 + wr * 64 + fr, col0 = u.pn * 256 + wc * 32 + 8 * fq;
#pragma unroll
        for (int ai = 0; ai < 2; ++ai)
#pragma unroll
            for (int m = 0; m < 4; ++m)
#pragma unroll
                for (int bj = 0; bj < 2; ++bj) { const f32x4 v0 = acc[ai][bj][m][0] * Y8_SCALE, v1 = acc[ai][bj][m][1] * Y8_SCALE; u32x2 w; w.x = pk4_fp8(v0[0], v0[1], v0[2], v0[3]); w.y = pk4_fp8(v1[0], v1[1], v1[2], v1[3]);
                    *(u32x2*)(Y + (size_t)(row0 + ai * 128 + m * 16) * DM + col0 + bj * 128) = w; }
        return false;
    }
};
__device__ __forceinline__ void p9_gemm2(Frame& F) {
    const int RT = moe_prefix(F);
    SchedMoe2 S{(const LAS int*)(F.lds + MOE_LDS), RT, F.G, (int)blockIdx.x, (const char*)(F.ws + WS_H), (const char*)(F.ws + WS_W2), (const char*)(F.ws + WS_WS2)};
    EpiY E{F.ws + WS_Y};
    pg8::gemm_phase<EpiY, SchedMoe2, false, 1, H8_E8, W8_E8>(F.lds, F.wave, EH, EH, S, E);
}
__device__ __forceinline__ void p10_combine(Frame& F) {
    (void)moe_prefix(F);
    const LAS int* rtoff = (const LAS int*)(F.lds + MOE_LDS);
    const unsigned char* Y = F.ws + WS_Y; unsigned char* rt = F.ws + WS_ROUTE;
    const int* eid = (const int*)(rt + RT_EID); const float* gate = (const float*)(rt + RT_GATE); const int* posn = (const int*)(rt + RT_POS); const float* mod = (const float*)(F.ctl + CW_MOD);
    const int lane = lane_id();
    size_t yr[9]; float g[9]; unsigned yv[9][8];
#define P10_ROUTE(t_) do { const u32x4 e0 = *(const u32x4*)(eid + (t_) * 8), e1 = *(const u32x4*)(eid + (t_) * 8 + 4), p0 = *(const u32x4*)(posn + (t_) * 8), p1 = *(const u32x4*)(posn + (t_) * 8 + 4); \
        const f32x4 g0 = *(const f32x4*)(gate + (t_) * 8), g1 = *(const f32x4*)(gate + (t_) * 8 + 4); \
        _Pragma("unroll") for (int k = 0; k < 8; ++k) { const int e = __builtin_amdgcn_readfirstlane((int)(k < 4 ? e0[k & 3] : e1[k & 3])) & 63, p = __builtin_amdgcn_readfirstlane((int)(k < 4 ? p0[k & 3] : p1[k & 3])); \
            yr[k] = (size_t)(256 * __builtin_amdgcn_readfirstlane(rtoff[e]) + p) * DM; g[k] = __uint_as_float(__builtin_amdgcn_readfirstlane(__float_as_uint(k < 4 ? g0[k & 3] : g1[k & 3]))); } \
        yr[8] = (size_t)(HROWS_R + (t_)) * DM; g[8] = 1.0f; } while (0)
#define P10_YLOAD() do { _Pragma("unroll") for (int k = 0; k < 9; ++k) { _Pragma("unroll") for (int j = 0; j < 8; ++j) yv[k][j] = __builtin_nontemporal_load((const unsigned*)(Y + yr[k] + 4 * lane + 256 * j)); } } while (0)
    int t = F.gw;
    if (t < NTOK) { P10_ROUTE(t); P10_YLOAD(); }
    for (; t < NTOK; t += F.NGW) {
        const int b = t / SEQ; const float* gf = mod + b * 6 * DM + 5 * DM + 4 * lane;
        float* orow = F.out + (size_t)t * DM + 4 * lane;
        f32x4 xv[8];
#pragma unroll
        for (int j = 0; j < 8; ++j) xv[j] = *(const f32x4*)(orow + 256 * j);
        f32x4 s[8];
#pragma unroll
        for (int j = 0; j < 8; ++j) s[j] = (f32x4){0.f, 0.f, 0.f, 0.f};
#pragma unroll
        for (int k = 0; k < 9; ++k)
#pragma unroll
            for (int j = 0; j < 8; ++j) { const f32x2 lo = __builtin_amdgcn_cvt_pk_f32_fp8((int)yv[k][j], false), hi = __builtin_amdgcn_cvt_pk_f32_fp8((int)yv[k][j], true);
                s[j][0] += lo[0] * g[k]; s[j][1] += lo[1] * g[k]; s[j][2] += hi[0] * g[k]; s[j][3] += hi[1] * g[k]; }
        const int tn = t + F.NGW;
        if (tn < NTOK) { P10_ROUTE(tn); P10_YLOAD(); }
#pragma unroll
        for (int j = 0; j < 8; ++j) *(f32x4*)(orow + 256 * j) = xv[j] + *(const f32x4*)(gf + 256 * j) * s[j] * (1.0f / Y8_SCALE);
    }
#undef P10_ROUTE
#undef P10_YLOAD
}
constexpr int LDS_BYTES = 155648;
constexpr int N_PHASES = 11;
#ifndef PROBE_REP
#define PROBE_REP -1
#endif
#define REP(k, stmt) do { stmt; if (PROBE_REP == (k)) { __syncthreads(); stmt; } } while (0)
__global__ void __launch_bounds__(NTHR, 2) fwd(Args args) {
    extern __shared__ __attribute__((aligned(16))) unsigned char lds_raw[];
    Frame F; F.lds = (LAS unsigned char*)lds_raw; F.wave = __builtin_amdgcn_readfirstlane((int)threadIdx.x >> 6);
    F.G = gridDim.x; F.gw = blockIdx.x * NWAVES + F.wave; F.NGW = F.G * NWAVES; F.ws = args.ws; F.ctl = (unsigned*)(args.ws + WS_CTL); F.out = args.out;
    volatile LAS unsigned* xbw = (volatile LAS unsigned*)(F.lds + LDS_BYTES - 16);
    if (threadIdx.x < 4) xbw[threadIdx.x] = 0u;
    __syncthreads();
    const bool one = (args.ph_hi - args.ph_lo) > 1;
    XcdBarrier bar; bar.bar = F.ctl + CW_BAR; bar.x = 0; bar.st = xbw;
    if (one) bar = xcd_barrier_post(F.ctl + CW_BAR, xbw, F.wave);
    const int lo = args.ph_lo, hi = args.ph_hi;
#ifndef PROBE_TIME
#define PROBE_TIME -1
#endif
    unsigned long long pt0 = 0ull, pt1 = 0ull;
#define TSTAMP(k, which) do { if (PROBE_TIME == (k) && blockIdx.x == 0) { if (which) pt1 = __builtin_amdgcn_s_memrealtime(); else pt0 = __builtin_amdgcn_s_memrealtime(); } } while (0)
#define IN(k) (lo <= (k) && (k) < hi)
#define SEAM(k) do { if (IN(k) && IN((k) + 1)) xcd_barrier(bar, F.wave); } while (0)
    TSTAMP(0, 0); if (IN(0)) { REP(0, p0_prologue(F, args)); } SEAM(0); TSTAMP(0, 1);
    TSTAMP(1, 0); if (IN(1)) { REP(1, p1_h(F, args)); } SEAM(1); TSTAMP(1, 1);
    TSTAMP(2, 0); if (IN(2)) { REP(2, p2_inproj(F, args)); } SEAM(2); TSTAMP(2, 1);
    TSTAMP(3, 0); if (IN(3)) { p3_qknorm(F, args); __syncthreads(); REP(3, p3_indexer(F, args)); } SEAM(3); TSTAMP(3, 1);
    TSTAMP(4, 0); if (IN(4)) { REP(4, p4_pool_attn(F, args)); if (one) { conv_drain<true, 0, 2>(F, args, 4); } } SEAM(4); TSTAMP(4, 1);
    TSTAMP(5, 0); if (IN(5)) { REP(5, p5_merge(F)); } SEAM(5); TSTAMP(5, 1);
    TSTAMP(6, 0); if (IN(6)) { REP(6, p6_out(F, args)); } SEAM(6); TSTAMP(6, 1);
    TSTAMP(7, 0); if (IN(7)) { p7_router(F, args); conv_drain<false, 0, 1>(F, args, 7); }
    SEAM(7); TSTAMP(7, 1);
    TSTAMP(8, 0); if (IN(8)) { REP(8, p8_gemm1(F, args)); } SEAM(8); TSTAMP(8, 1);
    TSTAMP(9, 0); if (IN(9)) { REP(9, p9_gemm2(F)); } SEAM(9); TSTAMP(9, 1);
    TSTAMP(10, 0); if (IN(10)) { p10_combine(F); } TSTAMP(10, 1);
    if (PROBE_TIME >= 0 && blockIdx.x == 0) { const unsigned long long tend = __builtin_amdgcn_s_memrealtime() + 4ull * (pt1 - pt0); while (__builtin_amdgcn_s_memrealtime() < tend) __builtin_amdgcn_s_sleep(8); }
#undef IN
#undef SEAM
}
#ifndef N_LAUNCHES
#define N_LAUNCHES 1
#endif
extern "C" void kernel_launch(void* const* d_in, const int* in_sizes, int n_in, void* d_out, int out_size, void* d_ws, size_t ws_size, hipStream_t stream) {
    static int grid = 0;
    if (grid == 0) {
        if (n_in != 22 || out_size != NTOK * DM || ws_size < WS_END) { fprintf(stderr, "kernel_launch: unexpected shapes (n_in %d out %d ws %zu need %zu)\n", n_in, out_size, ws_size, (size_t)WS_END); grid = -1; return; }
        int dev = 0, cus = 0, per_cu = 0;
        if (hipGetDevice(&dev) != hipSuccess || hipDeviceGetAttribute(&cus, hipDeviceAttributeMultiprocessorCount, dev) != hipSuccess) { grid = -1; return; }
        if (hipFuncSetAttribute((const void*)fwd, hipFuncAttributeMaxDynamicSharedMemorySize, LDS_BYTES) != hipSuccess) { fprintf(stderr, "kernel_launch: hipFuncSetAttribute failed\n"); grid = -1; return; }
        if (hipOccupancyMaxActiveBlocksPerMultiprocessor(&per_cu, (const void*)fwd, NTHR, LDS_BYTES) != hipSuccess || per_cu < 1) fprintf(stderr, "kernel_launch: occupancy query says %d\n", per_cu);
        (void)hipGetLastError();
        grid = cus;
    }
    if (grid < 0) return;
    (void)hipMemsetAsync((char*)d_ws + WS_CTL, 0, CTL_BYTES, stream);
    Args a{};
    for (int i = 0; i < 22; ++i) a.in[i] = (const float*)d_in[i];
    a.out = (float*)d_out; a.ws = (unsigned char*)d_ws;
    if (N_LAUNCHES == 1) { a.ph_lo = 0; a.ph_hi = N_PHASES; hipLaunchKernelGGL(fwd, dim3(grid), dim3(NTHR), LDS_BYTES, stream, a); }
    else for (int p = 0; p < N_PHASES; ++p) { a.ph_lo = p; a.ph_hi = p + 1; hipLaunchKernelGGL(fwd, dim3(grid), dim3(NTHR), LDS_BYTES, stream, a); }
}
```

```cpp
#include <hip/hip_runtime.h>
#include <cstdio>
#include <cstdint>

#define LAS __attribute__((address_space(3)))
#define GAS __attribute__((address_space(1)))
typedef unsigned short bf16_t;
typedef short bf16x8 __attribute__((ext_vector_type(8)));
typedef short s16x4 __attribute__((ext_vector_type(4)));
typedef float f32x4 __attribute__((ext_vector_type(4)));
typedef float f32x2 __attribute__((ext_vector_type(2)));
typedef float f32x16 __attribute__((ext_vector_type(16)));
typedef unsigned u32x4 __attribute__((ext_vector_type(4)));
typedef unsigned u32x2 __attribute__((ext_vector_type(2)));

constexpr int DM = 2048, NB = 2, SEQ = 4096, NTOK = NB * SEQ;
constexpr int NH = 8, HD = 128, NKV = 2, AW = 1024, KVW = 256, IH = 16, ID = 64, TOPK = 256;
constexpr int PW = 1024, INW = 7760, INP = 7936;
constexpr int NE = 64, EH = 512, NGRP = 8, EPG = 8, TOPG = 4, ETOP = 8;
constexpr float NORM_EPS = 1e-6f, ROUTED_SCALE = 2.5f;
constexpr int NTHR = 512, NWAVES = 8;

constexpr size_t MiB = 1u << 20;
constexpr size_t WS_CTL = 0, CTL_BYTES = 1 * MiB;
constexpr size_t WS_W13 = 1 * MiB;
constexpr size_t WS_W2 = WS_W13 + 256 * MiB;
constexpr size_t WS_WS13 = WS_W2 + 128 * MiB;
constexpr size_t WS_WS2 = WS_WS13 + 4 * MiB;
constexpr size_t WS_H = WS_WS2 + 2 * MiB;
constexpr int HROWS_R = 65536 + 64 * 256, HROWS = HROWS_R + NTOK;
constexpr size_t WS_ROUTE = WS_H + (size_t)HROWS * EH * 2;
constexpr size_t RT_EID = 0, RT_GATE = RT_EID + (size_t)NTOK * 8 * 4, RT_POS = RT_GATE + (size_t)NTOK * 8 * 4, RT_LIST = RT_POS + (size_t)NTOK * 8 * 4,
                 RT_IDENT = RT_LIST + (size_t)NE * NTOK * 4, RT_END = RT_IDENT + (size_t)NTOK * 4;
constexpr size_t WS_R = (WS_ROUTE + RT_END + MiB - 1) / MiB * MiB;
constexpr size_t WS_Y = WS_R;
constexpr size_t WS_WIN = WS_R;
constexpr size_t WS_WAU = WS_WIN + 31 * MiB, WS_WPU = WS_WAU + 4 * MiB, WS_WOUT = WS_WPU + 4 * MiB, WS_PLIN = WS_WOUT + 8 * MiB, WS_WR = WS_PLIN + MiB / 2;
constexpr size_t WS_HB = WS_WR + MiB / 2;
constexpr size_t WS_Q = WS_HB + 32 * MiB, WS_K = WS_Q + 16 * MiB, WS_V = WS_K + 4 * MiB, WS_QI = WS_V + 4 * MiB, WS_KW = WS_QI + 16 * MiB, WS_U = WS_KW + 4 * MiB,
                 WS_G = WS_U + 16 * MiB;
constexpr size_t WS_POOLED = WS_G + 64 * MiB, WS_POOL = WS_POOLED + 16 * MiB, WS_ATTN = WS_POOL + 16 * MiB, WS_MERGED = WS_ATTN + 16 * MiB, WS_MASK = WS_MERGED + 32 * MiB,
                 WS_H8 = WS_MASK + 4 * MiB,
                 WS_REND = WS_H8 + 32 * MiB;
constexpr size_t WS_END = WS_Y + (size_t)HROWS_R * DM * 2;
static_assert(WS_REND <= WS_END, "overlay region");
constexpr int CW_BAR = 4096;
constexpr int CW_ECNT = 8192;
constexpr int CW_CONVQ = 12288;
constexpr int CW_DONE = 12544;
constexpr int CW_ADAC = 14336;
constexpr int CW_MOD = 16384;
static_assert((CW_MOD + 2 * 6 * DM) * 4 <= (int)CTL_BYTES, "ctl");

__device__ __forceinline__ int lane_id() { int l; asm volatile("v_mbcnt_lo_u32_b32 %0, -1, 0\n\tv_mbcnt_hi_u32_b32 %0, -1, %0" : "=v"(l)); return l; }
__device__ __forceinline__ unsigned cvt_pk_bf16(float lo, float hi) { unsigned r; asm volatile("v_cvt_pk_bf16_f32 %0, %1, %2" : "=v"(r) : "v"(lo), "v"(hi)); return r; }
__device__ __forceinline__ unsigned pk4_fp8(float a, float b, float c, float d) {
    a = __builtin_amdgcn_fmed3f(a, -448.f, 448.f); b = __builtin_amdgcn_fmed3f(b, -448.f, 448.f); c = __builtin_amdgcn_fmed3f(c, -448.f, 448.f); d = __builtin_amdgcn_fmed3f(d, -448.f, 448.f);
    int w; asm volatile("" : "=v"(w));
    w = __builtin_amdgcn_cvt_pk_fp8_f32(a, b, w, false); w = __builtin_amdgcn_cvt_pk_fp8_f32(c, d, w, true); return (unsigned)w; }
#ifndef FP8_INPROJ
#define FP8_INPROJ 0
#endif
#ifndef FP8_MERGE
#define FP8_MERGE 1
#endif
#ifndef FP8_OUT
#define FP8_OUT 1
#endif
constexpr float W8_SCALE = 8.f;   constexpr int W8_E8 = 127 - 3;
constexpr float H8_SCALE = 8.f;   constexpr int H8_E8 = 127 - 3;
constexpr float A8_SCALE = 8.f;   constexpr int A8_E8 = 127 - 3;
__device__ __forceinline__ float bf2f(unsigned short b) { return __uint_as_float(((unsigned)b) << 16); }
__device__ __forceinline__ float bflo(unsigned w) { return __uint_as_float(w << 16); }
__device__ __forceinline__ float bfhi(unsigned w) { return __uint_as_float(w & 0xffff0000u); }
__device__ __forceinline__ float wave_sum(float v) {
#pragma unroll
    for (int o = 1; o < 64; o <<= 1) v += __shfl_xor(v, o);
    return v;
}
__device__ __forceinline__ float sigmoidf_(float x) { return 1.0f / (1.0f + __expf(-x)); }

#define XB_TMO      128
#define XB_XCNT(j)  (256  + 64 * (j))
#define XB_XSUB(j)  (1280 + 64 * (j))
#define XB_XGEN(j)  (2304 + 64 * (j))
#define XB_TOP      3328
#define XB_TOPGEN   3392
#define XCD_BAR_WORDS 3456
#define XB_SPIN_CAP (1u << 18)
__device__ __forceinline__ unsigned xb_ld(unsigned* p)              { return __hip_atomic_load(p, __ATOMIC_RELAXED, __HIP_MEMORY_SCOPE_AGENT); }
__device__ __forceinline__ unsigned xb_add(unsigned* p, unsigned v) { return __hip_atomic_fetch_add(p, v, __ATOMIC_RELAXED, __HIP_MEMORY_SCOPE_AGENT); }
__device__ __forceinline__ unsigned xb_xcc_id() { return (unsigned)__builtin_amdgcn_s_getreg((3 << 11) | 20) & 0xFu; }
#define XB_SPIN(cond, bar) do { unsigned _sp = 0; while (cond) { __builtin_amdgcn_s_sleep(1); \
    if ((++_sp & 255u) == 0u) { if (xb_ld(&(bar)[XB_TMO])) break; if (_sp > XB_SPIN_CAP) { atomicAdd(&(bar)[XB_TMO], 1u); break; } } } } while (0)
struct XcdBarrier { unsigned* bar; unsigned x; volatile LAS unsigned* st; };
__device__ __forceinline__ XcdBarrier xcd_barrier_post(unsigned* bar, volatile LAS unsigned* st, int wave) {
    XcdBarrier b; b.bar = bar; b.x = xb_xcc_id(); b.st = st;
    if (wave == 0 && lane_id() == 0) (void)xb_add(&bar[XB_XCNT(b.x)], 1u);
    return b;
}
__device__ __forceinline__ void xcd_barrier_complete(unsigned* bar, unsigned x, unsigned& nloc, unsigned& nx) {
    const unsigned G = gridDim.x * gridDim.y * gridDim.z;
    unsigned sum, cnt, mine, sp = 0u;
    for (;;) {
        sum = 0u; cnt = 0u; mine = 0u;
#pragma unroll
        for (unsigned j = 0; j < 16; ++j) { const unsigned c = xb_ld(&bar[XB_XCNT(j)]); sum += c; cnt += (c > 0u) ? 1u : 0u; mine = (j == x) ? c : mine; }
        if (sum == G) break;
        __builtin_amdgcn_s_sleep(1);
        if ((++sp & 255u) == 0u) { if (xb_ld(&bar[XB_TMO])) break; if (sp > XB_SPIN_CAP) { atomicAdd(&bar[XB_TMO], 1u); break; } }
    }
    nloc = mine > 0u ? mine : 1u; nx = cnt > 0u ? cnt : 1u;
}
__device__ __forceinline__ void xcd_barrier(const XcdBarrier& b, int wave) {
    asm volatile("s_waitcnt vmcnt(0)" ::: "memory");
    __syncthreads();
    if (wave == 0 && lane_id() == 0) {
        unsigned* bar = b.bar;
        __builtin_amdgcn_s_waitcnt(0);
        unsigned nloc = b.st[0], nx = b.st[1];
        if (nloc == 0u) { xcd_barrier_complete(bar, b.x, nloc, nx); b.st[0] = nloc; b.st[1] = nx; }
        const unsigned old = xb_add(&bar[XB_XSUB(b.x)], 1u);
        const unsigned gen = old / nloc;
        if (old + 1u == (gen + 1u) * nloc) {
            __builtin_amdgcn_fence(__ATOMIC_RELEASE, "agent");
            asm volatile("s_waitcnt vmcnt(0)" ::: "memory");
            const unsigned og = xb_add(&bar[XB_TOP], 1u);
            const unsigned tg = og / nx;
            if (og + 1u == (tg + 1u) * nx) xb_add(&bar[XB_TOPGEN], 1u);
            else XB_SPIN(xb_ld(&bar[XB_TOPGEN]) == tg, bar);
            __builtin_amdgcn_fence(__ATOMIC_ACQUIRE, "agent");
            xb_add(&bar[XB_XGEN(b.x)], 1u);
            asm volatile("s_waitcnt vmcnt(0)" ::: "memory");
        } else {
            XB_SPIN(xb_ld(&bar[XB_XGEN(b.x)]) == gen, bar);
            __builtin_amdgcn_fence(__ATOMIC_ACQUIRE, "agent");
            asm volatile("s_waitcnt vmcnt(0)" ::: "memory");
        }
    }
    __syncthreads();
}
namespace pg8 {
constexpr int BM = 256, BK = 64, HALF = 128, HTB = HALF * BK * 2, STAGE_BYTES = 8 * HTB, NXCD = 8, WGM = 8;
__host__ __device__ __forceinline__ int lds_byte(int r, int c) { const int st = (r >> 4) * 2 + (c >> 5), rr = r & 15, cc = c & 31, ob = rr * 64 + cc * 2; return st * 1024 + (ob ^ (((ob >> 9) & 1) << 5)); }
__host__ __device__ __forceinline__ void stage_rc(int b, int& R, int& C) { const int st = b / 1024, sb = b % 1024, swz = sb ^ (((sb >> 9) & 1) << 5); R = (st >> 1) * 16 + swz / 64; C = (st & 1) * 32 + (swz % 64) / 2; }
__host__ __device__ __forceinline__ int perm32(int rho) { const int n = rho >> 4, i = rho & 15; return 8 * (i >> 2) + 4 * n + (i & 3); }

struct Unit { const char* A; const char* B; const int* tok; int pm, pn, aux; int nt8; };

struct TileOrder {
    int nM, nN, nwg, G, c;
    __device__ void init(int M, int N, int G_, int c_) { nM = M / BM; nN = N / BM; nwg = nM * nN; G = G_; c = c_; }
    __device__ bool tile(int i, int& pm, int& pn) const {
        const long L = (long)i * G + c; if (L >= nwg) return false;
        int wgid = (int)L; { const int q = nwg / NXCD, r = nwg % NXCD, xcd = wgid % NXCD, off = wgid / NXCD; wgid = (xcd < r ? xcd * (q + 1) : r * (q + 1) + (xcd - r) * q) + off; }
        const int nig = WGM * nN, gid = wgid / nig, fm = gid * WGM, gsz = (nM - fm) < WGM ? (nM - fm) : WGM;
        pm = fm + ((wgid % nig) % gsz); pn = (wgid % nig) / gsz; return true;
    }
};

typedef int i32x8 __attribute__((ext_vector_type(8)));
template <class Epi, class Sched, bool GATHER, int ES = 2, int SCA = 127, int SCB = 127, bool MIXED = false>
__device__ __forceinline__ void gemm_phase(LAS unsigned char* lds, const int wid, const int Kb, const int ldab, const Sched& S, const Epi& E, const int nt_ovr = 0) {
    const int lane = lane_id(), tid = wid * 64 + lane, wr = wid >> 2, wc = wid & 3, fr = lane & 15, fq = lane >> 4;
    const int nt = nt_ovr ? nt_ovr : Kb / (BK * 2);
    unsigned voffA[2], voffB[2];
#pragma unroll
    for (int i = 0; i < 2; ++i) { int R, C; stage_rc(tid * 16 + i * 8192, R, C); const int Rb = (R & ~31) + perm32(R & 31);
        voffA[i] = (unsigned)(R * ldab + C * 2); voffB[i] = (unsigned)(Rb * Kb + C * 2); }
    const size_t kstep = (size_t)(BK * 2);
    const size_t hstepA = (size_t)HALF * ldab, hstepB = (size_t)HALF * Kb;
    const unsigned ldsw = (unsigned)wid * 1024u;
    const int aoff = (ES == 2 || MIXED) ? lds_byte(wr * 64 + fr, fq * 8) : lds_byte(wr * 64 + fr, fq * 16), boff = (ES == 2 || MIXED) ? lds_byte(wc * 32 + fr, fq * 8) : lds_byte(wc * 32 + fr, fq * 16);
    constexpr int OFF1 = (ES == 2 || MIXED) ? 1024 : 16;
#define PG8_SA(b, h) (((b) * 2 + (h)) * HTB)
#define PG8_SB(b, h) ((4 + (b) * 2 + (h)) * HTB)
    const unsigned ldsbase = (unsigned)(uintptr_t)lds + ldsw;
#define PG8_DMA2(bufoff, sbase, voff_, i_) do { unsigned keep_; asm volatile("s_mov_b32 %0, m0\n\ts_mov_b32 m0, %3\n\ts_nop 0\n\tglobal_load_lds_dwordx4 %1, %2\n\ts_mov_b32 m0, %0" \
        : "=&s"(keep_) : "v"(voff_), "s"(sbase), "s"(ldsbase + (unsigned)((bufoff) + (i_) * 8192)) : "memory"); } while (0)
#define PG8_STAGEB(bufoff, gbase) do { _Pragma("unroll") for (int _i = 0; _i < 2; ++_i) PG8_DMA2(bufoff, (const char*)(gbase), voffB[_i], _i); } while (0)
#define PG8_STAGEA(bufoff, kt, h, GO) do { _Pragma("unroll") for (int _i = 0; _i < 2; ++_i) { \
        if constexpr (GATHER) PG8_DMA2(bufoff, (const char*)(kt), GO[h][_i], _i); else PG8_DMA2(bufoff, (const char*)(kt) + (h) * hstepA, voffA[_i], _i); } } while (0)
#define PG8_LD8(p0, p1) __builtin_bit_cast(i32x8, __builtin_shufflevector(*(const LAS u32x4*)(p0), *(const LAS u32x4*)(p1), 0, 1, 2, 3, 4, 5, 6, 7))
#define PG8_LDA(dst, b, h) do { _Pragma("unroll") for (int m = 0; m < 4; ++m) dst[m] = PG8_LD8(lds + PG8_SA(b, h) + aoff + m * 2048, lds + PG8_SA(b, h) + aoff + OFF1 + m * 2048); } while (0)
#define PG8_LDB(dst, b, h) do { _Pragma("unroll") for (int n = 0; n < 2; ++n) dst[n] = PG8_LD8(lds + PG8_SB(b, h) + boff + n * 2048, lds + PG8_SB(b, h) + boff + OFF1 + n * 2048); } while (0)
#define PG8_LO(x) __builtin_bit_cast(bf16x8, __builtin_shufflevector(x, x, 0, 1, 2, 3))
#define PG8_HI(x) __builtin_bit_cast(bf16x8, __builtin_shufflevector(x, x, 4, 5, 6, 7))
#define PG8_MMA16(ai, bj, At, Bt) do { _Pragma("unroll") for (int m = 0; m < 4; ++m) _Pragma("unroll") for (int n = 0; n < 2; ++n) { \
        acc[ai][bj][m][n] = __builtin_amdgcn_mfma_f32_16x16x32_bf16(PG8_LO(Bt[n]), PG8_LO(At[m]), acc[ai][bj][m][n], 0, 0, 0); \
        acc[ai][bj][m][n] = __builtin_amdgcn_mfma_f32_16x16x32_bf16(PG8_HI(Bt[n]), PG8_HI(At[m]), acc[ai][bj][m][n], 0, 0, 0); } } while (0)
#define PG8_MMA8(ai, bj, At, Bt) do { _Pragma("unroll") for (int m = 0; m < 4; ++m) _Pragma("unroll") for (int n = 0; n < 2; ++n) \
        acc[ai][bj][m][n] = __builtin_amdgcn_mfma_scale_f32_16x16x128_f8f6f4(Bt[n], At[m], acc[ai][bj][m][n], 0, 0, 0, SCB * 0x01010101, 0, SCA * 0x01010101); } while (0)
#define PG8_MMA(ai, bj, At, Bt) do { __builtin_amdgcn_s_setprio(1); \
        if constexpr (MIXED) { if (cur8) PG8_MMA8(ai, bj, At, Bt); else PG8_MMA16(ai, bj, At, Bt); } \
        else if constexpr (ES == 2) PG8_MMA16(ai, bj, At, Bt); else PG8_MMA8(ai, bj, At, Bt); \
        __builtin_amdgcn_s_setprio(0); } while (0)
#define PG8_WAIT_V(n) asm volatile("s_waitcnt vmcnt(" #n ")" ::: "memory")
#define PG8_WAIT_L(n) asm volatile("s_waitcnt lgkmcnt(" #n ")" ::: "memory")
#define PG8_BAR __builtin_amdgcn_s_barrier()
#define PG8_SCHED __builtin_amdgcn_sched_barrier(0)
#define PG8_GLOAD(GO, u) do { if constexpr (GATHER) { const int _tid = wid * 64 + lane_id(); _Pragma("unroll") for (int _i = 0; _i < 2; ++_i) { int _R, _C; stage_rc(_tid * 16 + _i * 8192, _R, _C); \
        _Pragma("unroll") for (int _h = 0; _h < 2; ++_h) { unsigned _t = (unsigned)(u).tok[_h * HALF + _R]; _t = _t < (unsigned)NTOK ? _t : (unsigned)(NTOK - 1); GO[_h][_i] = _t * (unsigned)ldab + (unsigned)_C * 2u; } } } } while (0)
    Unit cur, nxt; int ui = 0;
    if (!S.next(0, cur)) return;
    f32x4 acc[2][2][4][2];
    { float z0_; asm volatile("v_mov_b32 %0, 0" : "=v"(z0_));
#pragma unroll
    for (int a = 0; a < 2; ++a)
#pragma unroll
        for (int b = 0; b < 2; ++b)
#pragma unroll
            for (int m = 0; m < 4; ++m)
#pragma unroll
                for (int n = 0; n < 2; ++n) acc[a][b][m][n] = (f32x4){z0_, z0_, z0_, z0_}; }
    i32x8 At[4], B0[2], B1[2];
    unsigned gC[2][2] = {{0u, 0u}, {0u, 0u}}, gN[2][2] = {{0u, 0u}, {0u, 0u}};
    PG8_GLOAD(gC, cur);
    const char* cA = cur.A; const char* cB = cur.B;
    bool cur8 = MIXED && cur.nt8 > 0; int ntc = cur8 ? cur.nt8 : nt;
    PG8_STAGEB(PG8_SB(0, 0), cB); PG8_STAGEB(PG8_SB(0, 1), cB + hstepB); PG8_STAGEA(PG8_SA(0, 0), cA, 0, gC); PG8_STAGEA(PG8_SA(0, 1), cA, 1, gC);
    if (wr == 1) PG8_BAR;
    PG8_WAIT_V(2); PG8_BAR;
    PG8_STAGEB(PG8_SB(1, 0), cB + kstep); PG8_STAGEA(PG8_SA(1, 0), cA + kstep, 0, gC); PG8_STAGEB(PG8_SB(1, 1), cB + hstepB + kstep);
    PG8_WAIT_V(6); PG8_BAR;
    for (;;) {
        const bool has_next = S.next(ui + 1, nxt);
        if (has_next) PG8_GLOAD(gN, nxt);
        const char* nA = has_next ? nxt.A : cA; const char* nB = has_next ? nxt.B : cB;
#pragma clang loop unroll(disable)
        for (int t = 0; t < ntc; t += 2) {
            const bool last = (t == ntc - 2);
            const char* a1 = cA + (size_t)(t + 1) * kstep;
            const char* a2 = last ? nA : cA + (size_t)(t + 2) * kstep; const char* b2 = last ? nB : cB + (size_t)(t + 2) * kstep;
            const char* a3 = a2 + kstep; const char* b3 = b2 + kstep;
            PG8_LDB(B0, 0, 0); PG8_LDB(B1, 0, 1); PG8_SCHED; PG8_LDA(At, 0, 0); PG8_STAGEA(PG8_SA(1, 1), a1, 1, gC);
            if (GATHER && last && has_next) {
#pragma unroll
                for (int _h = 0; _h < 2; ++_h)
#pragma unroll
                    for (int _i = 0; _i < 2; ++_i) gC[_h][_i] = gN[_h][_i];
            }
            PG8_WAIT_V(8); PG8_WAIT_L(0); PG8_BAR; PG8_MMA(0, 0, At, B0); PG8_MMA(0, 1, At, B1); PG8_BAR; PG8_SCHED;
            PG8_LDA(At, 0, 1); PG8_STAGEB(PG8_SB(0, 0), b2); PG8_STAGEB(PG8_SB(0, 1), b2 + hstepB); PG8_STAGEA(PG8_SA(0, 0), a2, 0, gC);
            PG8_WAIT_V(8); PG8_WAIT_L(0); PG8_BAR; PG8_MMA(1, 0, At, B0); PG8_MMA(1, 1, At, B1); PG8_BAR; PG8_SCHED;
            PG8_LDB(B0, 1, 0); PG8_LDB(B1, 1, 1); PG8_SCHED; PG8_LDA(At, 1, 0); PG8_STAGEA(PG8_SA(0, 1), a2, 1, gC);
            PG8_WAIT_V(8); PG8_WAIT_L(0); PG8_BAR; PG8_MMA(0, 0, At, B0); PG8_MMA(0, 1, At, B1); PG8_BAR; PG8_SCHED;
            PG8_LDA(At, 1, 1); PG8_STAGEB(PG8_SB(1, 0), b3); PG8_STAGEB(PG8_SB(1, 1), b3 + hstepB); PG8_STAGEA(PG8_SA(1, 0), a3, 0, gC);
            PG8_WAIT_V(8); PG8_WAIT_L(0); PG8_BAR; PG8_MMA(1, 0, At, B0); PG8_MMA(1, 1, At, B1); PG8_BAR; PG8_SCHED;
        }
        if (wr == 0) PG8_BAR;
        asm volatile("s_nop 15\n\ts_nop 7" ::: "memory");
        const int le_ = lane_id();
        const bool keep = E(acc, cur, wr, wc, le_ & 15, le_ >> 4);
        if (!has_next) break;
        if (!keep) {
        float z_; asm volatile("v_mov_b32 %0, 0" : "=v"(z_));
#pragma unroll
        for (int a = 0; a < 2; ++a)
#pragma unroll
            for (int b = 0; b < 2; ++b)
#pragma unroll
                for (int m = 0; m < 4; ++m)
#pragma unroll
                    for (int n = 0; n < 2; ++n) acc[a][b][m][n] = (f32x4){z_, z_, z_, z_};
        }
        cur = nxt; cA = nA; cB = nB; ++ui; cur8 = MIXED && cur.nt8 > 0; ntc = cur8 ? cur.nt8 : nt;
        if (wr == 1) PG8_BAR;
    }
    PG8_WAIT_V(0);
    PG8_BAR;
#undef PG8_SA
#undef PG8_SB
#undef PG8_DMA2
#undef PG8_STAGEA
#undef PG8_STAGEB
#undef PG8_LDA
#undef PG8_LDB
#undef PG8_MMA
#undef PG8_MMA8
#undef PG8_MMA16
#undef PG8_LD8
#undef PG8_LO
#undef PG8_HI
#undef PG8_WAIT_V
#undef PG8_WAIT_L
#undef PG8_BAR
#undef PG8_SCHED
#undef PG8_GLOAD
}
}
struct Args { const float* in[22]; float* out; unsigned char* ws; int ph_lo, ph_hi; };
enum { I_X = 0, I_C, I_WADA, I_BADA, I_GMIX, I_WIN, I_QNORM, I_KNORM, I_WAU, I_PLIN, I_PSCALE, I_WPU, I_WOUT, I_GFFN, I_WROUTER, I_RBIAS, I_W1, I_W3, I_W2, I_WS1, I_WS3, I_WS2 };
struct Frame {
    LAS unsigned char* lds;
    int wave, G, gw, NGW;
    unsigned char* ws; unsigned* ctl; float* out;
};
#define LDS_WAIT() asm volatile("s_waitcnt lgkmcnt(0)" ::: "memory")
#define VM_WAIT() asm volatile("s_waitcnt vmcnt(0)" ::: "memory")

__device__ __forceinline__ void tr8_issue(const float* __restrict__ src, int ld_src, int lane, f32x4 (&v)[16], int nvalid = 64) {
    const int q = lane >> 4, c4 = (lane & 15) * 4; const bool ok = c4 < nvalid;
    const unsigned voff = (unsigned)((16 * q) * ld_src + c4) * 4u;
#pragma unroll
    for (int j = 0; j < 16; ++j) v[j] = ok ? __builtin_nontemporal_load((const f32x4*)((const char*)src + (size_t)j * ld_src * 4 + voff)) : (f32x4){0.f, 0.f, 0.f, 0.f};
}
__device__ __forceinline__ void tr8_finish(unsigned char* __restrict__ dst, int ld_dst, int lane, const f32x4 (&v)[16]) {
    const int q = lane >> 4, c4 = (lane & 15) * 4;
#pragma unroll
    for (int nn = 0; nn < 4; ++nn) { u32x4 w;
#pragma unroll
        for (int t = 0; t < 4; ++t) w[t] = pk4_fp8(v[4 * t][nn] * W8_SCALE, v[4 * t + 1][nn] * W8_SCALE, v[4 * t + 2][nn] * W8_SCALE, v[4 * t + 3][nn] * W8_SCALE);
        *(u32x4*)(dst + (size_t)(c4 + nn) * ld_dst + 16 * q) = w; }
}
__device__ __forceinline__ void tr_tile(const float* __restrict__ src, int ld_src, int nvalid, bf16_t* __restrict__ dst, int ld_dst, int lane) {
    f32x4 v[16]; tr8_issue(src, ld_src, lane, v, nvalid);
    const int q = lane >> 4, c4 = (lane & 15) * 4;
#pragma unroll
    for (int nn = 0; nn < 4; ++nn) { u32x4 w0, w1;
#pragma unroll
        for (int t = 0; t < 4; ++t) { w0[t] = cvt_pk_bf16(v[2 * t][nn], v[2 * t + 1][nn]); w1[t] = cvt_pk_bf16(v[8 + 2 * t][nn], v[9 + 2 * t][nn]); }
        *(u32x4*)(dst + (size_t)(c4 + nn) * ld_dst + 16 * q) = w0; *(u32x4*)(dst + (size_t)(c4 + nn) * ld_dst + 16 * q + 8) = w1; }
}
template <bool F8>
__device__ __forceinline__ void wcopy_tile(const float* src, int ld_src, int nvalid, unsigned char* dstbase, size_t drow, int ldk, int k0, int lane) {
    if constexpr (F8) { f32x4 v[16]; tr8_issue(src, ld_src, lane, v, nvalid); tr8_finish(dstbase + drow * ldk + k0, ldk, lane, v); }
    else tr_tile(src, ld_src, nvalid, (bf16_t*)dstbase + drow * ldk + k0, ldk, lane);
}
constexpr int ADA_WGS = 6 * DM / 128;
__device__ __forceinline__ void p0_prologue(Frame& F, const Args& a) {
    LAS float* sc = (LAS float*)F.lds;
    const int lane = lane_id(), tid = F.wave * 64 + lane;
    for (int i = tid; i < NB * DM; i += NTHR) { const float c = a.in[I_C][i]; sc[i] = c / (1.0f + __expf(-c)); }
    __syncthreads();
    float* mod = (float*)(F.ctl + CW_MOD);
    unsigned char* ws = F.ws;
    float* adap = (float*)(ws + WS_Q);
    for (int job = blockIdx.x; job < 256; job += F.G) {
        const int kg = job >> 4, strip = job & 15, w = F.wave, row0 = 128 * kg + 16 * w;
        const float* wp = a.in[I_WADA] + (size_t)row0 * (6 * DM) + strip * 768 + 4 * lane;
        f32x4 b0[3], b1[3];
#pragma unroll
        for (int j = 0; j < 3; ++j) { b0[j] = (f32x4){0.f, 0.f, 0.f, 0.f}; b1[j] = (f32x4){0.f, 0.f, 0.f, 0.f}; }
#pragma unroll
        for (int h = 0; h < 2; ++h) { f32x4 v[8][3];
#pragma unroll
            for (int r = 0; r < 8; ++r)
#pragma unroll
                for (int j = 0; j < 3; ++j) v[r][j] = __builtin_nontemporal_load((const f32x4*)(wp + (size_t)(8 * h + r) * (6 * DM) + 256 * j));
#pragma unroll
            for (int r = 0; r < 8; ++r) { const float s0 = sc[row0 + 8 * h + r], s1 = sc[DM + row0 + 8 * h + r];
#pragma unroll
                for (int j = 0; j < 3; ++j) { b0[j] += v[r][j] * s0; b1[j] += v[r][j] * s1; } } }
        LAS float* part = (LAS float*)(F.lds + 16384);
#pragma unroll
        for (int j = 0; j < 3; ++j) { *(LAS f32x4*)(part + (w * 2 + 0) * 768 + 4 * lane + 256 * j) = b0[j]; *(LAS f32x4*)(part + (w * 2 + 1) * 768 + 4 * lane + 256 * j) = b1[j]; }
        __syncthreads();
#pragma unroll
        for (int i = 0; i < 3; ++i) { const int o = tid + 512 * i, b = o >= 768 ? 1 : 0, n = o - 768 * b; float sum = 0.f;
#pragma unroll
            for (int ww = 0; ww < 8; ++ww) sum += part[(ww * 2 + b) * 768 + n];
            __hip_atomic_store(adap + (size_t)(kg * 2 + b) * (6 * DM) + strip * 768 + n, sum, __ATOMIC_RELAXED, __HIP_MEMORY_SCOPE_AGENT); }
        VM_WAIT();
        __syncthreads();
        LAS unsigned* flag = (LAS unsigned*)(F.lds + 16384 + 49152);
        if (tid == 0) *flag = __hip_atomic_fetch_add(F.ctl + CW_ADAC + 16 * strip, 1u, __ATOMIC_ACQ_REL, __HIP_MEMORY_SCOPE_AGENT);
        __syncthreads();
        if (*flag == 15u) {
#pragma unroll
            for (int i = 0; i < 3; ++i) { const int o = tid + 512 * i, b = o >= 768 ? 1 : 0, n = o - 768 * b; float sum = a.in[I_BADA][strip * 768 + n];
#pragma unroll
                for (int kk = 0; kk < 16; ++kk) sum += __hip_atomic_load(adap + (size_t)(kk * 2 + b) * (6 * DM) + strip * 768 + n, __ATOMIC_RELAXED, __HIP_MEMORY_SCOPE_AGENT);
                mod[b * 6 * DM + strip * 768 + n] = sum; }
        }
        __syncthreads();
    }
    unsigned char* Win8 = ws + WS_WIN;
    constexpr int J_IN_A = 32 * 40, J_IN_B = 32 * 4, J_IN_C = 32 * 80, J_AU = 16 * 32, J_PU = 16 * 32, J_OUT = 32 * 32, J_PL = 4 * 16, J_S13 = 2 * 32 * 8, J_S2 = 8 * 32, J_WR = 32,
                  J_W13 = 0, J_W2 = 0;
    constexpr int NITEMS = J_IN_A + J_IN_B + J_IN_C + J_AU + J_PU + J_OUT + J_PL + J_S13 + J_S2 + J_WR;
    for (int it = F.gw; it < NITEMS; it += F.NGW) {
        int r = it;
        if (r < J_IN_A) { const int kb = r / 40, nb = r % 40; if ((nb >> 2) == 5) wcopy_tile<true>(a.in[I_WIN] + (size_t)(64 * kb) * INW + 64 * nb, INW, 64, Win8, (size_t)(64 * nb), 2 * DM, 64 * kb, lane);
            else wcopy_tile<false>(a.in[I_WIN] + (size_t)(64 * kb) * INW + 64 * nb, INW, 64, Win8, (size_t)(64 * nb), DM, 64 * kb, lane); continue; } r -= J_IN_A;
        if (r < J_IN_B) { const int kb = r / 4, nb = r % 4; const int nv = nb == 0 ? 64 : (nb == 1 ? 16 : 0);
            wcopy_tile<false>(a.in[I_WIN] + (size_t)(64 * kb) * INW + 2560 + (nb < 2 ? 64 * nb : 0), INW, nv, Win8, (size_t)(2560 + 64 * nb), DM, 64 * kb, lane); continue; } r -= J_IN_B;
        if (r < J_IN_C) { const int kb = r / 80, nb = r % 80; wcopy_tile<true>(a.in[I_WIN] + (size_t)(64 * kb) * INW + 2640 + 64 * nb, INW, 64, Win8, (size_t)(2816 + 64 * nb), 2 * DM, 64 * kb, lane); continue; } r -= J_IN_C;
        if (r < J_AU) { const int kb = r / 32, nb = r % 32; wcopy_tile<FP8_MERGE>(a.in[I_WAU] + (size_t)(64 * kb) * DM + 64 * nb, DM, 64, ws + WS_WAU, (size_t)(64 * nb), AW, 64 * kb, lane); continue; } r -= J_AU;
        if (r < J_PU) { const int kb = r / 32, nb = r % 32; wcopy_tile<FP8_MERGE>(a.in[I_WPU] + (size_t)(64 * kb) * DM + 64 * nb, DM, 64, ws + WS_WPU, (size_t)(64 * nb), PW, 64 * kb, lane); continue; } r -= J_PU;
        if (r < J_OUT) { const int kb = r / 32, nb = r % 32; wcopy_tile<FP8_OUT>(a.in[I_WOUT] + (size_t)(64 * kb) * DM + 64 * nb, DM, 64, ws + WS_WOUT, (size_t)(64 * nb), DM, 64 * kb, lane); continue; } r -= J_OUT;
        if (r < J_PL) { const int g = r / 16, kb = (r % 16) / 4, nb = r % 4; tr_tile(a.in[I_PLIN] + (size_t)g * 65536 + (size_t)(64 * kb) * 256 + 64 * nb, 256, 64, (bf16_t*)(ws + WS_PLIN) + (size_t)g * 65536 + (size_t)(64 * nb) * 256 + 64 * kb, 256, lane); continue; } r -= J_PL;
        if (r < J_S13) { const int which = r / 256, kb = (r % 256) / 8, nb = r % 8; const float* src = (which ? a.in[I_WS3] : a.in[I_WS1]) + (size_t)(64 * kb) * EH + 64 * nb;
            f32x4 v[16]; tr8_issue(src, EH, lane, v); tr8_finish(ws + WS_WS13 + (size_t)(256 * (nb >> 1) + 64 * (nb & 1) + 128 * which) * DM + 64 * kb, DM, lane, v); continue; } r -= J_S13;
        if (r < J_S2) { const int kb = r / 32, nb = r % 32; f32x4 v[16]; tr8_issue(a.in[I_WS2] + (size_t)(64 * kb) * DM + 64 * nb, DM, lane, v); tr8_finish(ws + WS_WS2 + (size_t)(64 * nb) * EH + 64 * kb, EH, lane, v); continue; } r -= J_S2;
        { const int kb = r; tr_tile(a.in[I_WROUTER] + (size_t)(64 * kb) * NE, NE, 64, (bf16_t*)(ws + WS_WR) + 64 * kb, DM, lane); }
    }
}

constexpr int NCONV_W13 = NE * 2 * 32 * 8, NCONV = NCONV_W13 + NE * 8 * 32;
__device__ __forceinline__ void conv_ptrs(const Args& a, unsigned char* ws, int it, const float*& src, int& ld_src, unsigned char*& dst, int& ld_dst) {
    if (it < NCONV_W13) { const int e = it / 512, rr = it % 512, which = rr / 256, q = rr % 256, kb = 2 * (q >> 4) + (q & 1), nb = 4 * ((q >> 3) & 1) + ((q >> 1) & 3);
        src = (which ? a.in[I_W3] : a.in[I_W1]) + ((size_t)e * DM + 64 * kb) * EH + 64 * nb; ld_src = EH;
        dst = ws + WS_W13 + ((size_t)e * 1024 + 256 * (nb >> 1) + 64 * (nb & 1) + 128 * which) * DM + 64 * kb; ld_dst = DM; }
    else { const int r = it - NCONV_W13, e = r / 256, q = r % 256, kb = 2 * (q >> 6) + (q & 1), nb = (q >> 1) & 31;
        src = a.in[I_W2] + ((size_t)e * EH + 64 * kb) * DM + 64 * nb; ld_src = DM; dst = ws + WS_W2 + ((size_t)e * DM + 64 * nb) * EH + 64 * kb; ld_dst = EH; }
}
__device__ __forceinline__ void conv_issue16(const Args& a, unsigned char* ws, int it, int lane, f32x4 (&v)[16]) {
    const float* src; int ld_src; unsigned char* dst; int ld_dst; conv_ptrs(a, ws, it, src, ld_src, dst, ld_dst); tr8_issue(src, ld_src, lane, v); }
__device__ __forceinline__ void conv_finish16(const Args& a, unsigned char* ws, int it, int lane, const f32x4 (&v)[16]) {
    const float* src; int ld_src; unsigned char* dst; int ld_dst; conv_ptrs(a, ws, it, src, ld_src, dst, ld_dst); tr8_finish(dst, ld_dst, lane, v); }
__device__ __forceinline__ void phase_done(Frame& F, int phase) { __syncthreads(); if (F.wave == 0 && lane_id() == 0) __hip_atomic_fetch_add(F.ctl + CW_DONE + 64 * phase, 1u, __ATOMIC_RELAXED, __HIP_MEMORY_SCOPE_AGENT); }
constexpr int CONV_SEG1_END = NCONV_W13 + (NCONV - NCONV_W13) * 3 / 10 / 8 * 8;
__device__ __forceinline__ unsigned conv_seg_lo(int sg) { return sg == 0 ? 0u : (sg == 1 ? (unsigned)NCONV_W13 : (unsigned)CONV_SEG1_END); }
__device__ __forceinline__ unsigned conv_seg_hi(int sg) { return sg == 0 ? (unsigned)NCONV_W13 : (sg == 1 ? (unsigned)CONV_SEG1_END : (unsigned)NCONV); }
template <bool BOUNDED, int SEG_LO, int SEG_HI>
struct ConvQ {
    Frame& F; int phase, lane; unsigned cur, end; int sg;
    __device__ __forceinline__ int next() {
        constexpr unsigned B = BOUNDED ? 6u : 8u;
        while (cur >= end) {
            if (BOUNDED) { const unsigned d = __hip_atomic_load(F.ctl + CW_DONE + 64 * phase, __ATOMIC_RELAXED, __HIP_MEMORY_SCOPE_AGENT); if ((unsigned)__builtin_amdgcn_readfirstlane(d) >= (unsigned)F.G) return -1; }
            const unsigned lo = conv_seg_lo(sg), hi = conv_seg_hi(sg);
            unsigned s = 0; if (lane == 0) s = __hip_atomic_fetch_add(F.ctl + CW_CONVQ + 64 * sg, B, __ATOMIC_RELAXED, __HIP_MEMORY_SCOPE_AGENT);
            s = (unsigned)__builtin_amdgcn_readfirstlane(s) + lo;
            if (s >= hi) { if (sg < SEG_HI) { ++sg; continue; } return -1; }
            cur = s; end = s + B < hi ? s + B : hi;
        }
        return (int)cur++;
    }
};
template <bool BOUNDED, int SEG_LO, int SEG_HI>
__device__ __forceinline__ void conv_drain(Frame& F, const Args& a, int phase, int quota = 0) {
    const int lane = lane_id();
    ConvQ<BOUNDED, SEG_LO, SEG_HI> Q{F, phase, lane, 0u, 0u, SEG_LO};
    f32x4 va[16], vb[16]; int n = 0;
    int ia = Q.next(); if (ia < 0) return;
    conv_issue16(a, F.ws, ia, lane, va);
    for (;;) {
        ++n; const int ib = (quota > 0 && n >= quota && Q.cur >= Q.end) ? -1 : Q.next(); if (ib >= 0) conv_issue16(a, F.ws, ib, lane, vb);
        conv_finish16(a, F.ws, ia, lane, va);
        if (ib < 0) break;
        ++n; ia = (quota > 0 && n >= quota && Q.cur >= Q.end) ? -1 : Q.next(); if (ia >= 0) conv_issue16(a, F.ws, ia, lane, va);
        conv_finish16(a, F.ws, ib, lane, vb);
        if (ia < 0) break;
    }
}

__device__ __forceinline__ void modnorm_row(const float* __restrict__ xrow, const float* __restrict__ g, const float* __restrict__ shift, const float* __restrict__ scale, unsigned char* __restrict__ orow, unsigned char* __restrict__ orow8, int lane) {
    f32x4 v[8]; float ss = 0.f;
#pragma unroll
    for (int j = 0; j < 8; ++j) { v[j] = *(const f32x4*)(xrow + 4 * lane + 256 * j); ss += (v[j].x * v[j].x + v[j].y * v[j].y) + (v[j].z * v[j].z + v[j].w * v[j].w); }
    const float rstd = rsqrtf(wave_sum(ss) * (1.0f / DM) + NORM_EPS);
#pragma unroll
    for (int j = 0; j < 8; ++j) { const int c = 4 * lane + 256 * j;
        const f32x4 gg = *(const f32x4*)(g + c), sh = *(const f32x4*)(shift + c), sl = *(const f32x4*)(scale + c);
        const f32x4 o = v[j] * rstd * gg * (sl + 1.0f) + sh;
        { u32x2 w; w.x = cvt_pk_bf16(o.x, o.y); w.y = cvt_pk_bf16(o.z, o.w); *(u32x2*)((bf16_t*)orow + c) = w; }
        if (orow8) *(unsigned*)(orow8 + c) = pk4_fp8(o.x * A8_SCALE, o.y * A8_SCALE, o.z * A8_SCALE, o.w * A8_SCALE); }
}
__device__ __forceinline__ void p1_h(Frame& F, const Args& a) {
    const float* mod = (const float*)(F.ctl + CW_MOD);
    unsigned char* hb = F.ws + WS_HB; const int lane = lane_id();
    for (int m0 = 2 * F.gw; m0 < NTOK; m0 += 2 * F.NGW) {
        f32x4 v[2][8];
#pragma unroll
        for (int rr = 0; rr < 2; ++rr)
#pragma unroll
            for (int j = 0; j < 8; ++j) v[rr][j] = *(const f32x4*)(a.in[I_X] + (size_t)(m0 + rr) * DM + 4 * lane + 256 * j);
        const int b = m0 / SEQ; const float* sh = mod + b * 6 * DM; const float* sl = mod + b * 6 * DM + DM;
        float rstd[2];
#pragma unroll
        for (int rr = 0; rr < 2; ++rr) { float ss = 0.f;
#pragma unroll
            for (int j = 0; j < 8; ++j) ss += (v[rr][j].x * v[rr][j].x + v[rr][j].y * v[rr][j].y) + (v[rr][j].z * v[rr][j].z + v[rr][j].w * v[rr][j].w);
            rstd[rr] = rsqrtf(wave_sum(ss) * (1.0f / DM) + NORM_EPS); }
#pragma unroll
        for (int j = 0; j < 8; ++j) { const int c = 4 * lane + 256 * j;
            const f32x4 gg = *(const f32x4*)(a.in[I_GMIX] + c), shv = *(const f32x4*)(sh + c), slv = *(const f32x4*)(sl + c); const f32x4 mul = gg * (slv + 1.0f);
#pragma unroll
            for (int rr = 0; rr < 2; ++rr) { const f32x4 o = v[rr][j] * rstd[rr] * mul + shv; const size_t ro = (size_t)(m0 + rr) * DM * 2;
                u32x2 w; w.x = cvt_pk_bf16(o.x, o.y); w.y = cvt_pk_bf16(o.z, o.w); *(u32x2*)((bf16_t*)(hb + ro) + c) = w;
                *(unsigned*)(F.ws + WS_H8 + ro + c) = pk4_fp8(o.x * A8_SCALE, o.y * A8_SCALE, o.z * A8_SCALE, o.w * A8_SCALE); } }
    }
}
struct SchedDense {
    pg8::TileOrder T; const char* A; const char* B; size_t a_tile, b_tile;
    __device__ __forceinline__ bool next(int i, pg8::Unit& u) const { int pm, pn; if (!T.tile(i, pm, pn)) return false; u.pm = pm; u.pn = pn; u.aux = 0; u.tok = nullptr; u.nt8 = 0;
        u.A = A + (size_t)pm * a_tile; u.B = B + (size_t)pn * b_tile; return true; }
};
__device__ __forceinline__ void st_bf16x8(bf16_t* p, f32x4 v0, f32x4 v1) { u32x4 w; w.x = cvt_pk_bf16(v0[0], v0[1]); w.y = cvt_pk_bf16(v0[2], v0[3]); w.z = cvt_pk_bf16(v1[0], v1[1]); w.w = cvt_pk_bf16(v1[2], v1[3]); *(u32x4*)p = w; }
struct EpiInproj {
    unsigned char* ws;
    __device__ __forceinline__ bool operator()(f32x4 (&acc)[2][2][4][2], const pg8::Unit& u, int wr, int wc, int fr, int fq) const {
        const int pn = u.pn; bf16_t* base; int ld, ct; bool sig = false;
        if (pn < 4) { base = (bf16_t*)(ws + WS_Q); ld = AW; ct = pn; }
        else if (pn == 4) { base = (bf16_t*)(ws + WS_K); ld = KVW; ct = 0; }
        else if (pn == 5) { base = (bf16_t*)(ws + WS_V); ld = KVW; ct = 0; }
        else if (pn < 10) { base = (bf16_t*)(ws + WS_QI); ld = IH * ID; ct = pn - 6; }
        else if (pn == 10) { base = (bf16_t*)(ws + WS_KW); ld = 256; ct = 0; }
        else if (pn < 15) { base = (bf16_t*)(ws + WS_U); ld = PW; ct = pn - 11; }
        else { base = (bf16_t*)(ws + WS_G); ld = 2 * DM; ct = pn - 15; sig = true; }
        const int row0 = u.pm * 256 + wr * 64 + fr, col0 = ct * 256 + wc * 32 + 8 * fq;
#pragma unroll
        for (int ai = 0; ai < 2; ++ai)
#pragma unroll
            for (int m = 0; m < 4; ++m) { bf16_t* rowp = base + (size_t)(row0 + ai * 128 + m * 16) * ld + col0;
#pragma unroll
                for (int bj = 0; bj < 2; ++bj) { f32x4 v0 = acc[ai][bj][m][0], v1 = acc[ai][bj][m][1];
                    if (sig) {
#pragma unroll
                        for (int j = 0; j < 4; ++j) { v0[j] = fminf(__builtin_amdgcn_rcpf(1.0f + __expf(-v0[j])), 1.0f); v1[j] = fminf(__builtin_amdgcn_rcpf(1.0f + __expf(-v1[j])), 1.0f); } }
                    st_bf16x8(rowp + bj * 128, v0, v1); } }
        return false;
    }
};
struct SchedInproj {
    int G, c, kind; const char* hA; const char* win;
    __device__ __forceinline__ bool next(int i, pg8::Unit& u) const {
        const int first = kind == 0 ? c : c + ((320 - c + G - 1) / G) * G;
        const int j = first + i * G; if (j >= (kind == 0 ? 320 : 992)) return false;
        int pn, pm;
        if (kind == 0) { const int t = j >> 5; pm = j & 31; pn = t < 5 ? t : t + 1; }
        else { const int jj = j - 320, t = jj >> 5; pm = jj & 31; pn = t == 0 ? 5 : t + 10; }
        u.pm = pm; u.pn = pn; u.aux = 0; u.tok = nullptr; u.nt8 = 0;
        u.A = hA + (size_t)pm * 256 * DM * 2; u.B = win + (size_t)pn * 256 * DM * 2; return true; }
};
__device__ __forceinline__ void p2_inproj(Frame& F, const Args& a) {
    const int NG = F.G >= 256 ? 248 : F.G;
    if ((int)blockIdx.x >= NG) { conv_drain<false, 0, 2>(F, a, 2, 24); return; }
    EpiInproj E{F.ws};
    { SchedInproj S{NG, (int)blockIdx.x, 0, (const char*)(F.ws + WS_HB), (const char*)(F.ws + WS_WIN)};
      pg8::gemm_phase<EpiInproj, SchedInproj, false, 2>(F.lds, F.wave, DM * 2, DM * 2, S, E); }
    { SchedInproj S{NG, (int)blockIdx.x, 1, (const char*)(F.ws + WS_H8), (const char*)(F.ws + WS_WIN)};
      pg8::gemm_phase<EpiInproj, SchedInproj, false, 1, A8_E8, W8_E8>(F.lds, F.wave, DM * 2, DM * 2, S, E, DM / 128); }
}
__device__ __forceinline__ void p3_qknorm(Frame& F, const Args& a) {
    bf16_t* K = (bf16_t*)(F.ws + WS_K);
    const int lane = lane_id();
    for (int m = F.gw; m < NTOK; m += F.NGW) {
        u32x2 k0 = *(const u32x2*)(K + (size_t)m * KVW + 4 * lane);
        float kv[4]; float sk = 0.f;
        kv[0] = bflo(k0[0]); kv[1] = bfhi(k0[0]); kv[2] = bflo(k0[1]); kv[3] = bfhi(k0[1]);
#pragma unroll
        for (int j = 0; j < 4; ++j) sk += kv[j] * kv[j];
        sk += __shfl_xor(sk, 1); sk += __shfl_xor(sk, 2); sk += __shfl_xor(sk, 4); sk += __shfl_xor(sk, 8); sk += __shfl_xor(sk, 16);
        const float rk = rsqrtf(sk * (1.0f / HD) + NORM_EPS);
        const int dk = (4 * lane) & 127;
        u32x2 ok; ok[0] = cvt_pk_bf16(kv[0] * rk * a.in[I_KNORM][dk], kv[1] * rk * a.in[I_KNORM][dk + 1]); ok[1] = cvt_pk_bf16(kv[2] * rk * a.in[I_KNORM][dk + 2], kv[3] * rk * a.in[I_KNORM][dk + 3]);
        *(u32x2*)(K + (size_t)m * KVW + 4 * lane) = ok;
    }
}
__device__ __forceinline__ void pooled_item(Frame& F, int t0, int g, int lane) {
    const bf16_t* U = (const bf16_t*)(F.ws + WS_U); bf16_t* P = (bf16_t*)(F.ws + WS_POOLED);
    const int pos0 = t0 % SEQ, w = 2 << g, c = 256 * g + 4 * lane;
    f32x4 W = {0.f, 0.f, 0.f, 0.f};
    for (int j = 1; j <= 16; ++j) { if (j <= w && pos0 - j >= 0) { const u32x2 v = *(const u32x2*)(U + (size_t)(t0 - j) * PW + c); W += (f32x4){bflo(v[0]), bfhi(v[0]), bflo(v[1]), bfhi(v[1])}; } }
#pragma unroll 8
    for (int i = 0; i < 32; ++i) { const int t = t0 + i, pos = pos0 + i;
        const u32x2 v = *(const u32x2*)(U + (size_t)t * PW + c); const f32x4 cur = {bflo(v[0]), bfhi(v[0]), bflo(v[1]), bfhi(v[1])};
        W += cur;
        if (pos - w >= 0) { const u32x2 o = *(const u32x2*)(U + (size_t)(t - w) * PW + c); W -= (f32x4){bflo(o[0]), bfhi(o[0]), bflo(o[1]), bfhi(o[1])}; }
        const float inv = 1.0f / (float)(pos + 1 < w ? pos + 1 : w);
        const f32x4 r = W * inv - cur;
        u32x2 ow; ow[0] = cvt_pk_bf16(r[0], r[1]); ow[1] = cvt_pk_bf16(r[2], r[3]);
        *(u32x2*)(P + (size_t)t * PW + c) = ow; }
}
__device__ __forceinline__ unsigned mono_key(float s) { const unsigned u = __float_as_uint(s); return (u & 0x80000000u) ? ~u : (u | 0x80000000u); }
__device__ __forceinline__ void idx_block(Frame& F, const Args& a, int b, int i16) {
    const bf16_t* QI = (const bf16_t*)(F.ws + WS_QI); const bf16_t* KW = (const bf16_t*)(F.ws + WS_KW);
    unsigned short* MT = (unsigned short*)(F.ws + WS_MASK);
    LAS unsigned* T = (LAS unsigned*)F.lds;
    const int lane = lane_id(), w = F.wave, tid = w * 64 + lane, r32 = lane & 31, hi = lane >> 5;
    const int tpos0 = 16 * i16, t0 = b * SEQ + tpos0, nh = (tpos0 + 16 + 31) >> 5, kzero = 64 * ((tpos0 >> 6) + 1);
    for (int k = tid; k < kzero; k += NTHR) T[k] = 0u;
    bf16x8 Af[4];
    { const int qsel = (r32 >> 2) & 1, head = (r32 & 3) + 4 * (r32 >> 3); const size_t tq = (size_t)(t0 + 2 * w + qsel);
      const float wv = bf2f(KW[tq * 256 + 64 + head]);
#pragma unroll
      for (int s = 0; s < 4; ++s) { const u32x4 q = *(const u32x4*)(QI + tq * (IH * ID) + head * ID + 16 * s + 8 * hi); u32x4 o;
#pragma unroll
          for (int j = 0; j < 4; ++j) o[j] = cvt_pk_bf16(bflo(q[j]) * wv, bfhi(q[j]) * wv);
          Af[s] = __builtin_bit_cast(bf16x8, o); } }
    float X[16];
    { const size_t tq = (size_t)(t0 + 2 * w + hi); const u32x4 w0 = *(const u32x4*)(KW + tq * 256 + 64), w1 = *(const u32x4*)(KW + tq * 256 + 72);
      const float PINF = __builtin_inff();
#pragma unroll
      for (int j = 0; j < 4; ++j) { X[2 * j] = bflo(w0[j]) >= 0.f ? PINF : -PINF; X[2 * j + 1] = bfhi(w0[j]) >= 0.f ? PINF : -PINF;
                                    X[8 + 2 * j] = bflo(w1[j]) >= 0.f ? PINF : -PINF; X[8 + 2 * j + 1] = bfhi(w1[j]) >= 0.f ? PINF : -PINF; } }
    const int mypos = tpos0 + 2 * w + hi;
    unsigned keys[128];
    constexpr int RING = 16384, SLOT = 8192;
    const int nt64 = (nh + 1) >> 1;
    const unsigned dvoff = (unsigned)((lane >> 3) * 512 + (((lane & 7) ^ (lane >> 3)) << 4));
    const char* kwb = (const char*)(KW + (size_t)b * SEQ * 256) + w * 4096;
    const unsigned ldsw = (unsigned)(uintptr_t)F.lds + RING + w * 1024;
#define IDX_DMA(t_) do { unsigned keep_; asm volatile("s_mov_b32 %0, m0\n\ts_mov_b32 m0, %3\n\ts_nop 0\n\tglobal_load_lds_dwordx4 %1, %2\n\ts_mov_b32 m0, %0" \
        : "=&s"(keep_) : "v"(dvoff), "s"(kwb + (size_t)(t_) * 32768), "s"(ldsw + (unsigned)(((t_) & 3) * SLOT)) : "memory"); } while (0)
    int boffs[4];
#pragma unroll
    for (int s = 0; s < 4; ++s) boffs[s] = r32 * 128 + ((((2 * s + hi) ^ (r32 & 7))) << 4);
    __syncthreads();
    if (0 < nt64) IDX_DMA(0);
    if (1 < nt64) IDX_DMA(1);
    if (2 < nt64) IDX_DMA(2);
#pragma unroll
    for (int t = 0; t < 64; ++t) {
        keys[2 * t] = 0u; keys[2 * t + 1] = 0u;
        if (t < nt64) {
            const int rem = nt64 - 1 - t;
            if (rem >= 2) asm volatile("s_waitcnt vmcnt(2)" ::: "memory"); else if (rem == 1) asm volatile("s_waitcnt vmcnt(1)" ::: "memory"); else asm volatile("s_waitcnt vmcnt(0)" ::: "memory");
            __builtin_amdgcn_s_barrier(); asm volatile("" ::: "memory");
            if (t + 3 < nt64) IDX_DMA(t + 3);
#pragma unroll
            for (int half = 0; half < 2; ++half) { const int n = 2 * t + half;
                if (n < nh) {
                    f32x16 acc = {0.f, 0.f, 0.f, 0.f, 0.f, 0.f, 0.f, 0.f, 0.f, 0.f, 0.f, 0.f, 0.f, 0.f, 0.f, 0.f};
#pragma unroll
                    for (int s = 0; s < 4; ++s) { const bf16x8 bfr = *(const LAS bf16x8*)(F.lds + RING + (t & 3) * SLOT + half * 4096 + boffs[s]);
                        acc = __builtin_amdgcn_mfma_f32_32x32x16_bf16(Af[s], bfr, acc, 0, 0, 0); }
                    float sc = 0.f;
#pragma unroll
                    for (int j = 0; j < 16; ++j) sc += __builtin_amdgcn_fmed3f(acc[j], 0.f, X[j]);
                    keys[n] = (32 * n + r32 <= mypos) ? mono_key(sc) : 0u;
                } }
        }
    }
#undef IDX_DMA
    unsigned Tsel = 0u;
    { constexpr int HIST = 49152;
      LAS unsigned* hb = (LAS unsigned*)(F.lds + HIST) + (2 * w + hi) * 512;
      unsigned kk = (unsigned)TOPK; bool alive = true;
#pragma unroll 1
      for (int p = 0; p < 4; ++p) { const int sh = 24 - 8 * p;
          *(LAS u32x4*)(hb + 8 * r32) = (u32x4){0u, 0u, 0u, 0u}; *(LAS u32x4*)(hb + 8 * r32 + 4) = (u32x4){0u, 0u, 0u, 0u};
          asm volatile("s_waitcnt lgkmcnt(0)" ::: "memory");
#pragma unroll
          for (int n8 = 0; n8 < 16; ++n8) { if (n8 * 8 < nh) {
#pragma unroll
              for (int j = 0; j < 8; ++j) { const unsigned key = keys[n8 * 8 + j];
                  const unsigned x = p ? ((key ^ Tsel) >> ((sh + 8) & 31)) : 0u, t = x < 1u ? x : 1u;
                  __hip_atomic_fetch_add(hb + ((t << 8) + ((key >> sh) & 255u)), 1u, __ATOMIC_RELAXED, __HIP_MEMORY_SCOPE_WORKGROUP); } } }
          asm volatile("s_waitcnt lgkmcnt(0)" ::: "memory");
          const u32x4 c0 = *(const LAS u32x4*)(hb + 8 * r32), c1 = *(const LAS u32x4*)(hb + 8 * r32 + 4);
          const unsigned cb[8] = {(p == 0 && r32 == 0) ? 0u : c0[0], c0[1], c0[2], c0[3], c1[0], c1[1], c1[2], c1[3]};
          unsigned S = 0;
#pragma unroll
          for (int j = 0; j < 8; ++j) S += cb[j];
          unsigned suf = S;
#pragma unroll
          for (int d = 1; d < 32; d <<= 1) { const unsigned y = __shfl_down(suf, d, 32); if (r32 + d < 32) suf += y; }
          const unsigned total = __shfl(suf, 0, 32), sufx = suf - S;
          if (alive && total < kk) alive = false;
          const bool mine = alive && sufx < kk && kk <= suf;
          unsigned acc = sufx, bsel = 0u, above = 0u; bool found = false;
#pragma unroll
          for (int j = 7; j >= 0; --j) { if (!found) { if (acc + cb[j] >= kk) { found = true; bsel = (unsigned)(8 * r32 + j); above = acc; } else acc += cb[j]; } }
          const unsigned long long bm = __ballot(mine);
          const unsigned half = hi ? (unsigned)(bm >> 32) : (unsigned)bm;
          const int src = half ? (__builtin_ctz(half) + 32 * hi) : lane;
          const unsigned bs = __shfl(bsel, src), ab = __shfl(above, src);
          if (alive) { Tsel |= bs << sh; kk -= ab; }
      }
      if (!alive) Tsel = 0u;
    }
    { const unsigned Tf = Tsel > 1u ? Tsel : 1u;
      __syncthreads();
#pragma unroll
      for (int n = 0; n < 128; ++n) { if (n < nh) {
          unsigned bitv = keys[n] >= Tf ? 1u : 0u; const unsigned other = __shfl_xor(bitv, 32);
          bitv |= other << 1;
          if (hi == 0 && bitv) __hip_atomic_fetch_or(T + 32 * n + r32, bitv << (2 * w), __ATOMIC_RELAXED, __HIP_MEMORY_SCOPE_WORKGROUP); } }
    }
    __syncthreads();
    { const int rg = (b * SEQ + tpos0) >> 5, f = i16 & 1;
      for (int k = tid; k < kzero; k += NTHR) { const int kk = k & 63, p = (kk & ~7) | ((kk & 3) << 1) | ((kk >> 2) & 1);
          MT[((size_t)(rg * 64 + (k >> 6)) * 64 + p) * 2 + f] = (unsigned short)(T[k] & 0xffffu); } }
    __syncthreads();
}
__device__ __forceinline__ void p3_indexer(Frame& F, const Args& a) {
    for (int v2 = 2 * blockIdx.x; v2 < 512; v2 += 2 * F.G) { for (int ps = 0; ps < 2; ++ps) { const int v = v2 >> 1, b = v >> 7, i = v & 127; idx_block(F, a, b, ps ? 255 - i : i); } }
}
namespace att {
constexpr int KVBLK = 64, SHM_V = KVBLK * HD * 2, SHM_K = KVBLK * HD * 2;
constexpr int LDS_V = 0, LDS_K = 2 * SHM_V, LDS_WS = 2 * SHM_V + 2 * SHM_K, LDS_BYTES = LDS_WS + NWAVES * 64 * 4;
constexpr float THR = 8.f, LOG2E = 1.4426950408889634f;
#define KSWZ(row, colB) ((row) * 256 + ((colB) ^ (((row) & 7) << 4)))
#define SBAR() __builtin_amdgcn_sched_barrier(0)
__device__ __forceinline__ int v_st(int k, int c) { const int kk = (k & ~0xC) | ((k & 4) << 1) | ((k & 8) >> 1); return ((kk >> 3) * 4 + (c >> 5)) * 512 + ((kk & 7) * 32 + (c & 31)) * 2; }
__device__ __forceinline__ int v_rd_base(int lane) { return ((lane & 3) << 3) | (((lane >> 2) & 3) << 6) | (((lane >> 4) & 1) << 5) | (((lane >> 5) & 1) << 8); }
constexpr int v_rd_off(int d0, int ks, int half) { return d0 * 512 + ks * 4096 + half * 2048; }
__device__ __forceinline__ int crow(int r, int hi) { return (r & 3) + 8 * (r >> 2) + 4 * hi; }
__device__ __forceinline__ bool partialSM(f32x16& p0, f32x16& p1, float& m_reg, float& mn, float& alpha) {
    float pmax = p0[0];
#pragma unroll
    for (int r = 1; r < 16; ++r) pmax = fmaxf(pmax, p0[r]);
#pragma unroll
    for (int r = 0; r < 16; ++r) pmax = fmaxf(pmax, p1[r]);
    { auto rr = __builtin_amdgcn_permlane32_swap(__float_as_uint(pmax), __float_as_uint(pmax), false, false);
      pmax = fmaxf(__uint_as_float(rr[0]), __uint_as_float(rr[1])); }
    if (__all(pmax - m_reg < -106.f)) return false;
    if (__builtin_expect(__all((pmax - m_reg) <= THR), 1)) { mn = m_reg; alpha = 1.f; }
    else { mn = fmaxf(m_reg, pmax); alpha = __builtin_amdgcn_exp2f((m_reg - mn) * LOG2E); m_reg = mn; }
    const float mnL = -mn * LOG2E;
#pragma unroll
    for (int r = 0; r < 16; ++r) p0[r] = fmaf(p0[r], LOG2E, mnL);
#pragma unroll
    for (int r = 0; r < 16; ++r) p1[r] = fmaf(p1[r], LOG2E, mnL);
#pragma unroll
    for (int r = 0; r < 16; ++r) p0[r] = __builtin_amdgcn_exp2f(p0[r]);
    return true;
}
__device__ __forceinline__ void finishSM(f32x16& p0, f32x16& p1, float alpha, float& l_reg, bf16x8& pa0, bf16x8& pa1, bf16x8& pa2, bf16x8& pa3) {
#pragma unroll
    for (int r = 0; r < 16; ++r) p1[r] = __builtin_amdgcn_exp2f(p1[r]);
    float ps = 0;
#pragma unroll
    for (int r = 0; r < 16; ++r) ps += p0[r];
#pragma unroll
    for (int r = 0; r < 16; ++r) ps += p1[r];
    { auto rr = __builtin_amdgcn_permlane32_swap(__float_as_uint(ps), __float_as_uint(ps), false, false);
      ps = __uint_as_float(rr[0]) + __uint_as_float(rr[1]); }
    l_reg = l_reg * alpha + ps;
#define PK4(P, B_, OUT) do { unsigned a0 = cvt_pk_bf16(P[B_+0], P[B_+1]), a1 = cvt_pk_bf16(P[B_+2], P[B_+3]);                          \
        unsigned b0 = cvt_pk_bf16(P[B_+4], P[B_+5]), b1 = cvt_pk_bf16(P[B_+6], P[B_+7]);                                             \
        auto r0 = __builtin_amdgcn_permlane32_swap(a0, b0, false, false); auto r1 = __builtin_amdgcn_permlane32_swap(a1, b1, false, false); \
        u32x4 w = {r0[0], r1[0], r0[1], r1[1]}; OUT = __builtin_bit_cast(bf16x8, w); } while (0)
    PK4(p0, 0, pa0); PK4(p0, 8, pa1); PK4(p1, 0, pa2); PK4(p1, 8, pa3);
#undef PK4
}
template <int KB>
__device__ __forceinline__ void qkt(f32x16& p0, f32x16& p1, const LAS char* K_lds, int r32, int hi, const bf16x8* qr, bf16x8 kf0, bf16x8 kf1, bf16x8 qf) {
    const LAS char* kb[4];
#pragma unroll
    for (int dd = 0; dd < 4; ++dd) kb[dd] = K_lds + KB * SHM_K + KSWZ(r32, (dd * 16 + hi * 8) * 2);
    bf16x8 ka[2], kc[2];
    ka[0] = *(const LAS bf16x8*)(kb[0]); kc[0] = *(const LAS bf16x8*)(kb[0] + 32 * 256);
    p0 = __builtin_amdgcn_mfma_f32_32x32x16_bf16(kf0, qf, (f32x16){0.f, 0.f, 0.f, 0.f, 0.f, 0.f, 0.f, 0.f, 0.f, 0.f, 0.f, 0.f, 0.f, 0.f, 0.f, 0.f}, 0, 0, 0);
    p1 = __builtin_amdgcn_mfma_f32_32x32x16_bf16(kf1, qf, (f32x16){0.f, 0.f, 0.f, 0.f, 0.f, 0.f, 0.f, 0.f, 0.f, 0.f, 0.f, 0.f, 0.f, 0.f, 0.f, 0.f}, 0, 0, 0);
    SBAR();
#pragma unroll
    for (int d0 = 0; d0 < 8; ++d0) { const int c = d0 & 1;
        if (d0 < 7) { const LAS char* ap = kb[(d0 + 1) & 3] + ((d0 + 1) >> 2) * 128; ka[c ^ 1] = *(const LAS bf16x8*)(ap); kc[c ^ 1] = *(const LAS bf16x8*)(ap + 32 * 256); }
        p0 = __builtin_amdgcn_mfma_f32_32x32x16_bf16(ka[c], qr[d0], p0, 0, 0, 0);
        p1 = __builtin_amdgcn_mfma_f32_32x32x16_bf16(kc[c], qr[d0], p1, 0, 0, 0);
        SBAR(); }
}
template <int VB>
__device__ __forceinline__ void pv_tile(f32x16* o, int vb0, bf16x8 pa0, bf16x8 pa1, bf16x8 pa2, bf16x8 pa3) {
#define TRRD(dst, off) asm volatile("ds_read_b64_tr_b16 %0, %1 offset:%2" : "=&v"(dst) : "v"(vb0), "i"(off) : "memory")
#define PV_RD(S, d0) do { constexpr int b_ = VB * SHM_V + v_rd_off(d0, 0, 0); \
        TRRD(S[0], b_); TRRD(S[4], b_ + 2048); TRRD(S[1], b_ + 4096); TRRD(S[5], b_ + 6144); TRRD(S[2], b_ + 8192); TRRD(S[6], b_ + 10240); TRRD(S[3], b_ + 12288); TRRD(S[7], b_ + 14336); } while (0)
#define PV_MM(S, d0) do { \
        o[d0] = __builtin_amdgcn_mfma_f32_32x32x16_bf16(pa0, (bf16x8){S[0][0], S[0][1], S[0][2], S[0][3], S[4][0], S[4][1], S[4][2], S[4][3]}, o[d0], 0, 0, 0);   \
        o[d0] = __builtin_amdgcn_mfma_f32_32x32x16_bf16(pa1, (bf16x8){S[1][0], S[1][1], S[1][2], S[1][3], S[5][0], S[5][1], S[5][2], S[5][3]}, o[d0], 0, 0, 0);   \
        o[d0] = __builtin_amdgcn_mfma_f32_32x32x16_bf16(pa2, (bf16x8){S[2][0], S[2][1], S[2][2], S[2][3], S[6][0], S[6][1], S[6][2], S[6][3]}, o[d0], 0, 0, 0);   \
        o[d0] = __builtin_amdgcn_mfma_f32_32x32x16_bf16(pa3, (bf16x8){S[3][0], S[3][1], S[3][2], S[3][3], S[7][0], S[7][1], S[7][2], S[7][3]}, o[d0], 0, 0, 0); } while (0)
    s16x4 A[8], B[8];
    PV_RD(A, 0);
    PV_RD(B, 1); asm volatile("s_waitcnt lgkmcnt(8)" ::: "memory"); SBAR(); PV_MM(A, 0); SBAR();
    PV_RD(A, 2); asm volatile("s_waitcnt lgkmcnt(8)" ::: "memory"); SBAR(); PV_MM(B, 1); SBAR();
    PV_RD(B, 3); asm volatile("s_waitcnt lgkmcnt(8)" ::: "memory"); SBAR(); PV_MM(A, 2); SBAR();
    asm volatile("s_waitcnt lgkmcnt(0)" ::: "memory"); SBAR(); PV_MM(B, 3);
#undef PV_RD
#undef PV_MM
#undef TRRD
}
typedef const __attribute__((address_space(4))) unsigned long long* cmask_t;
__device__ __forceinline__ void mask_tile(f32x16& p0, f32x16& p1, const unsigned long long* mpg) {
    const float NEG = -__builtin_inff();
    cmask_t mp = (cmask_t)mpg;
    asm volatile("s_nop 15\n\ts_nop 7" : "+v"(p0), "+v"(p1));
#pragma unroll
    for (int r = 0; r < 16; ++r) { const unsigned long long m0 = mp[r], m1 = mp[16 + r];
        asm volatile("v_cndmask_b32 %0, %1, %0, %2" : "+v"(p0[r]) : "v"(NEG), "s"(m0));
        asm volatile("v_cndmask_b32 %0, %1, %0, %2" : "+v"(p1[r]) : "v"(NEG), "s"(m1)); }
}
template <int BUF>
__device__ __forceinline__ void tile_step(f32x16* o, float& m_reg, float& l_reg, const LAS char* K_lds, int vb0, LAS float* al_l, int r32, int hi, const bf16x8* qr,
                                          int kb_key, bf16x8 qf, const unsigned long long* mp) {
    f32x16 p0, p1; float mn, alpha; bf16x8 pa0, pa1, pa2, pa3;
    const unsigned kbb = __float_as_uint((float)kb_key) >> 16, k0b = __float_as_uint((float)r32) >> 16, k1b = __float_as_uint((float)(r32 + 32)) >> 16;
    u32x4 f0 = {hi ? 0u : (kbb | (k0b << 16)), 0u, 0u, 0u}, f1 = {hi ? 0u : (kbb | (k1b << 16)), 0u, 0u, 0u};
    qkt<BUF>(p0, p1, K_lds, r32, hi, qr, __builtin_bit_cast(bf16x8, f0), __builtin_bit_cast(bf16x8, f1), qf);
    mask_tile(p0, p1, mp);
    if (!partialSM(p0, p1, m_reg, mn, alpha)) return;
    finishSM(p0, p1, alpha, l_reg, pa0, pa1, pa2, pa3);
    if (__any(alpha < 1.f)) { if (hi == 0) al_l[r32] = alpha; asm volatile("s_waitcnt lgkmcnt(0)" ::: "memory");
#pragma unroll
        for (int r = 0; r < 16; ++r) { const float av = al_l[crow(r, hi)];
#pragma unroll
            for (int d_ = 0; d_ < 4; ++d_) o[d_][r] *= av; } }
    pv_tile<BUF>(o, vb0, pa0, pa1, pa2, pa3);
}
__device__ __forceinline__ void attn_unit(Frame& F, const float* __restrict__ qgain, int b, int g, int qb, unsigned* done_ctr) {
    const bf16_t* Q = (const bf16_t*)(F.ws + WS_Q); const bf16_t* K = (const bf16_t*)(F.ws + WS_K); const bf16_t* V = (const bf16_t*)(F.ws + WS_V);
    unsigned char* O = F.ws + WS_ATTN;
    const unsigned long long* MT = (const unsigned long long*)(F.ws + WS_MASK);
    LAS char* lds = (LAS char*)F.lds;
    const int wid = F.wave, lane = lane_id(), tid = wid * 64 + lane, r32 = lane & 31, hi = lane >> 5;
    const int hq = wid >> 1, th = wid & 1, h = 4 * g + hq, tok0 = b * SEQ + 64 * qb + 32 * th, NT = qb + 1;
    LAS char* V_lds = lds + LDS_V; LAS char* K_lds = lds + LDS_K; LAS float* wsf = (LAS float*)(lds + LDS_WS) + wid * 64; LAS float* li_l = wsf; LAS float* al_l = wsf + 32;
    const int sr = tid >> 4, sc = (tid & 15) * 8, vst0 = v_st(sr, sc), vst1 = v_st(32 + sr, sc), kws = KSWZ(sr, sc * 2);
    const int vb0 = (int)(uintptr_t)V_lds + v_rd_base(lane);
    bf16x8 qr[8];
    {
      u32x4 qw[8]; float ss = 0.f;
#pragma unroll
      for (int d0 = 0; d0 < 8; ++d0) { qw[d0] = *(const u32x4*)(Q + (size_t)(tok0 + r32) * AW + h * HD + d0 * 16 + hi * 8);
#pragma unroll
          for (int j = 0; j < 4; ++j) { const float lo = bflo(qw[d0][j]), hv = bfhi(qw[d0][j]); ss += lo * lo + hv * hv; } }
      { auto rr = __builtin_amdgcn_permlane32_swap(__float_as_uint(ss), __float_as_uint(ss), false, false); ss = __uint_as_float(rr[0]) + __uint_as_float(rr[1]); }
      const float rq = rsqrtf(ss * (1.0f / HD) + NORM_EPS) * 0.08838834764831845f;
#pragma unroll
      for (int d0 = 0; d0 < 8; ++d0) { const f32x4 g0 = *(const f32x4*)(qgain + d0 * 16 + hi * 8), g1 = *(const f32x4*)(qgain + d0 * 16 + hi * 8 + 4); u32x4 o;
          o[0] = cvt_pk_bf16(bflo(qw[d0][0]) * rq * g0[0], bfhi(qw[d0][0]) * rq * g0[1]); o[1] = cvt_pk_bf16(bflo(qw[d0][1]) * rq * g0[2], bfhi(qw[d0][1]) * rq * g0[3]);
          o[2] = cvt_pk_bf16(bflo(qw[d0][2]) * rq * g1[0], bfhi(qw[d0][2]) * rq * g1[1]); o[3] = cvt_pk_bf16(bflo(qw[d0][3]) * rq * g1[2], bfhi(qw[d0][3]) * rq * g1[3]);
          qr[d0] = __builtin_bit_cast(bf16x8, o); } }
    const unsigned sb = __float_as_uint(__builtin_ldexpf(1.0f, -(h + 1))) >> 16;
    const u32x4 qfw = {hi ? 0u : (sb | (sb << 16)), 0u, 0u, 0u}; const bf16x8 qf = __builtin_bit_cast(bf16x8, qfw);
    const bf16_t* Kg = K + (size_t)(b * SEQ) * KVW + g * HD + sc; const bf16_t* Vg = V + (size_t)(b * SEQ) * KVW + g * HD + sc;
    const unsigned long long* mrow = MT + (size_t)__builtin_amdgcn_readfirstlane(tok0 >> 5) * 64 * 32;
    float m_reg = -1e30f, l_reg = 0.f; f32x16 o[4] = {};
    bf16x8 st_k0, st_k1, st_v0, st_v1;
#define SLOAD(k0) do { st_k0 = *(const bf16x8*)(Kg + (size_t)((k0) + sr) * KVW); st_k1 = *(const bf16x8*)(Kg + (size_t)((k0) + 32 + sr) * KVW); \
                       st_v0 = *(const bf16x8*)(Vg + (size_t)((k0) + sr) * KVW); st_v1 = *(const bf16x8*)(Vg + (size_t)((k0) + 32 + sr) * KVW); } while (0)
#define SWRITE(bf) do { *(LAS bf16x8*)(K_lds + (bf) * SHM_K + kws) = st_k0; *(LAS bf16x8*)(K_lds + (bf) * SHM_K + kws + 32 * 256) = st_k1; \
                        *(LAS bf16x8*)(V_lds + (bf) * SHM_V + vst0) = st_v0; *(LAS bf16x8*)(V_lds + (bf) * SHM_V + vst1) = st_v1; } while (0)
#define TK(u_) (NT - 1 - (u_))
    SLOAD(TK(0) * KVBLK); SWRITE(0);
    __syncthreads();
    bool signaled = false;
    for (int t = 0; t < NT; t += 2) {
        if (done_ctr && !signaled && t + 8 >= NT) { signaled = true; if (wid == 0 && lane == 0) __hip_atomic_fetch_add(done_ctr, 1u, __ATOMIC_RELAXED, __HIP_MEMORY_SCOPE_AGENT); }
        if (t + 1 < NT) SLOAD(TK(t + 1) * KVBLK);
        tile_step<0>(o, m_reg, l_reg, K_lds, vb0, al_l, r32, hi, qr, TK(t) * KVBLK, qf, mrow + (size_t)TK(t) * 32);
        if (t + 1 < NT) SWRITE(1);
        __syncthreads();
        if (t + 1 < NT) {
            if (t + 2 < NT) SLOAD(TK(t + 2) * KVBLK);
            tile_step<1>(o, m_reg, l_reg, K_lds, vb0, al_l, r32, hi, qr, TK(t + 1) * KVBLK, qf, mrow + (size_t)TK(t + 1) * 32);
            if (t + 2 < NT) SWRITE(0);
            __syncthreads();
        }
    }
#undef TK
#undef SLOAD
#undef SWRITE
    if (hi == 0) li_l[r32] = l_reg; asm volatile("s_waitcnt lgkmcnt(0)" ::: "memory");
    unsigned char* Ow = O + (size_t)tok0 * AW + h * HD;
#pragma unroll
    for (int r = 0; r < 16; ++r) { const int orow = crow(r, hi); const float rl = __builtin_amdgcn_rcpf(li_l[orow]) * (FP8_MERGE ? A8_SCALE : 1.0f);
#pragma unroll
        for (int d0 = 0; d0 < 4; ++d0) { const float v = o[d0][r] * rl; const float v1 = __shfl_xor(v, 1);
            if constexpr (FP8_MERGE) { const float v2 = __shfl_xor(v, 2), v3 = __shfl_xor(v1, 2);
                if ((r32 & 3) == 0) *(unsigned*)(Ow + (size_t)orow * AW + d0 * 32 + r32) = pk4_fp8(v, v1, v2, v3); }
            else { if ((r32 & 1) == 0) *(unsigned*)((bf16_t*)O + (size_t)(tok0 + orow) * AW + h * HD + d0 * 32 + r32) = cvt_pk_bf16(v, v1); } } }
    __syncthreads();
}
#undef KSWZ
#undef SBAR
}
struct SchedPool {
    const char* A; const char* B; int c;
    __device__ __forceinline__ bool next(int i, pg8::Unit& u) const { if (i > 0 || c >= 128) return false; const int rt = c >> 2, g = c & 3; u.pm = rt; u.pn = g; u.aux = 0; u.tok = nullptr; u.nt8 = 0;
        u.A = A + ((size_t)rt * 256 * PW + g * 256) * 2; u.B = B + (size_t)g * 65536 * 2; return true; }
};
struct EpiPool {
    unsigned char* out; const float* pscale;
    __device__ __forceinline__ bool operator()(f32x4 (&acc)[2][2][4][2], const pg8::Unit& u, int wr, int wc, int fr, int fq) const {
        const int row0 = u.pm * 256 + wr * 64 + fr, col0 = u.pn * 256 + wc * 32 + 8 * fq;
#pragma unroll
        for (int bj = 0; bj < 2; ++bj) { const f32x4 s0 = *(const f32x4*)(pscale + col0 + bj * 128), s1 = *(const f32x4*)(pscale + col0 + bj * 128 + 4);
#pragma unroll
            for (int ai = 0; ai < 2; ++ai)
#pragma unroll
                for (int m = 0; m < 4; ++m) { const size_t o = (size_t)(row0 + ai * 128 + m * 16) * PW + col0 + bj * 128;
                    if constexpr (FP8_MERGE) { const f32x4 v0 = acc[ai][bj][m][0] * s0 * A8_SCALE, v1 = acc[ai][bj][m][1] * s1 * A8_SCALE; u32x2 w; w.x = pk4_fp8(v0[0], v0[1], v0[2], v0[3]); w.y = pk4_fp8(v1[0], v1[1], v1[2], v1[3]); *(u32x2*)(out + o) = w; }
                    else st_bf16x8((bf16_t*)out + o, acc[ai][bj][m][0] * s0, acc[ai][bj][m][1] * s1); } }
        return false;
    }
};
__device__ __forceinline__ void p4_pool_attn(Frame& F, const Args& a) {
    for (int c = blockIdx.x; c < 256; c += F.G) {
        const int bg = c >> 6, qb = c & 63;
        att::attn_unit(F, a.in[I_QNORM], bg >> 1, bg & 1, qb, (c + F.G >= 256) ? F.ctl + CW_DONE + 64 * 4 : nullptr);
        if (qb < 32) { const int pu = bg * 32 + qb, rt = pu >> 2, g = pu & 3;
            pooled_item(F, rt * 256 + 32 * F.wave, g, lane_id());
            asm volatile("s_waitcnt vmcnt(0)" ::: "memory"); __syncthreads();
            SchedPool S{(const char*)(F.ws + WS_POOLED), (const char*)(F.ws + WS_PLIN), pu}; EpiPool E{F.ws + WS_POOL, a.in[I_PSCALE]};
            pg8::gemm_phase<EpiPool, SchedPool, false>(F.lds, F.wave, 256 * 2, PW * 2, S, E); __syncthreads(); }
    }
}
struct SchedMerge {
    pg8::TileOrder T; const char* A0; const char* B0; const char* A1; const char* B1;
    __device__ __forceinline__ bool next(int i, pg8::Unit& u) const { int pm, pn; if (!T.tile(i >> 1, pm, pn)) return false; u.pm = pm; u.pn = pn; u.aux = i & 1; u.tok = nullptr; u.nt8 = 0;
        u.A = ((i & 1) ? A1 : A0) + (size_t)pm * 256 * 1024 * (FP8_MERGE ? 1 : 2); u.B = ((i & 1) ? B1 : B0) + (size_t)pn * 256 * 1024 * (FP8_MERGE ? 1 : 2); return true; }
};
struct EpiMerge {
    const bf16_t* G; unsigned char* out;
    __device__ __forceinline__ bool operator()(f32x4 (&acc)[2][2][4][2], const pg8::Unit& u, int wr, int wc, int fr, int fq) const {
        const int row0 = u.pm * 256 + wr * 64 + fr, col0 = u.pn * 256 + wc * 32 + 8 * fq;
#pragma unroll
        for (int ai = 0; ai < 2; ++ai)
#pragma unroll
            for (int m = 0; m < 4; ++m) { const size_t r = (size_t)(row0 + ai * 128 + m * 16);
#pragma unroll
                for (int bj = 0; bj < 2; ++bj) { const int c = col0 + bj * 128;
                    const u32x4 gp = *(const u32x4*)(G + r * (2 * DM) + DM + c);
                    const f32x4 p0 = {bflo(gp[0]), bfhi(gp[0]), bflo(gp[1]), bfhi(gp[1])}, p1 = {bflo(gp[2]), bfhi(gp[2]), bflo(gp[3]), bfhi(gp[3])};
                    if (u.aux == 0) { const u32x4 ga = *(const u32x4*)(G + r * (2 * DM) + c);
                        const f32x4 a0 = {bflo(ga[0]), bfhi(ga[0]), bflo(ga[1]), bfhi(ga[1])}, a1 = {bflo(ga[2]), bfhi(ga[2]), bflo(ga[3]), bfhi(ga[3])};
#pragma unroll
                        for (int j = 0; j < 4; ++j) { acc[ai][bj][m][0][j] *= a0[j] * __builtin_amdgcn_rcpf(fmaxf(p0[j], 1e-30f)); acc[ai][bj][m][1][j] *= a1[j] * __builtin_amdgcn_rcpf(fmaxf(p1[j], 1e-30f)); } }
                    else { if constexpr (FP8_OUT) { const f32x4 v0 = acc[ai][bj][m][0] * p0 * A8_SCALE, v1 = acc[ai][bj][m][1] * p1 * A8_SCALE; u32x2 w; w.x = pk4_fp8(v0[0], v0[1], v0[2], v0[3]); w.y = pk4_fp8(v1[0], v1[1], v1[2], v1[3]);
                        *(u32x2*)(out + r * DM + c) = w; } else st_bf16x8((bf16_t*)out + r * DM + c, acc[ai][bj][m][0] * p0, acc[ai][bj][m][1] * p1); } } }
        return u.aux == 0;
    }
};
__device__ __forceinline__ void p5_merge(Frame& F) {
    SchedMerge S; S.T.init(NTOK, DM, F.G, (int)blockIdx.x); S.A0 = (const char*)(F.ws + WS_ATTN); S.B0 = (const char*)(F.ws + WS_WAU); S.A1 = (const char*)(F.ws + WS_POOL); S.B1 = (const char*)(F.ws + WS_WPU);
    EpiMerge E{(const bf16_t*)(F.ws + WS_G), F.ws + WS_MERGED};
    constexpr int ES = FP8_MERGE ? 1 : 2;
    pg8::gemm_phase<EpiMerge, SchedMerge, false, ES, FP8_MERGE ? A8_E8 : 127, FP8_MERGE ? W8_E8 : 127>(F.lds, F.wave, 1024 * ES, 1024 * ES, S, E);
}
struct EpiOut {
    const float* x; const float* mod; float* out;
    __device__ __forceinline__ bool operator()(f32x4 (&acc)[2][2][4][2], const pg8::Unit& u, int wr, int wc, int fr, int fq) const {
        const int row0 = u.pm * 256 + wr * 64 + fr, col0 = u.pn * 256 + wc * 32 + 8 * fq; const int b = (u.pm * 256) / SEQ;
        const float* gm = mod + b * 6 * DM + 2 * DM;
#pragma unroll
        for (int bj = 0; bj < 2; ++bj) { const int c = col0 + bj * 128; const f32x4 g0 = *(const f32x4*)(gm + c), g1 = *(const f32x4*)(gm + c + 4);
#pragma unroll
            for (int ai = 0; ai < 2; ++ai)
#pragma unroll
                for (int m = 0; m < 4; ++m) { const size_t o = (size_t)(row0 + ai * 128 + m * 16) * DM + c;
                    const f32x4 x0 = *(const f32x4*)(x + o), x1 = *(const f32x4*)(x + o + 4);
                    *(f32x4*)(out + o) = x0 + g0 * acc[ai][bj][m][0]; *(f32x4*)(out + o + 4) = x1 + g1 * acc[ai][bj][m][1]; } }
        return false;
    }
};
__device__ __forceinline__ void p6_out(Frame& F, const Args& a) {
    SchedDense S; S.T.init(NTOK, DM, F.G, (int)blockIdx.x); S.A = (const char*)(F.ws + WS_MERGED); S.B = (const char*)(F.ws + WS_WOUT);
    constexpr int ES = FP8_OUT ? 1 : 2; S.a_tile = (size_t)256 * DM * ES; S.b_tile = (size_t)256 * DM * ES;
    EpiOut E{a.in[I_X], (const float*)(F.ctl + CW_MOD), F.out};
    pg8::gemm_phase<EpiOut, SchedDense, false, ES, FP8_OUT ? A8_E8 : 127, FP8_OUT ? W8_E8 : 127>(F.lds, F.wave, DM * ES, DM * ES, S, E);
}
constexpr int P7_ROWB = 4096 + 16;
constexpr int P7_ROWS = 32, P7_RW = P7_ROWS / NWAVES;
constexpr int P7_LDS_P = P7_ROWS * P7_ROWB;
constexpr int P7_LDS_H = P7_LDS_P + 2 * P7_ROWS * 64 * 4;
__device__ __forceinline__ void p7_router(Frame& F, const Args& a) {
    const float* mod = (const float*)(F.ctl + CW_MOD);
    unsigned char* hb8 = F.ws + WS_HB; const bf16_t* Wr = (const bf16_t*)(F.ws + WS_WR);
    unsigned char* rt = F.ws + WS_ROUTE;
    int* eid = (int*)(rt + RT_EID); float* gate = (float*)(rt + RT_GATE); int* posn = (int*)(rt + RT_POS); int* list = (int*)(rt + RT_LIST); int* ident = (int*)(rt + RT_IDENT);
    unsigned* ecnt = F.ctl + CW_ECNT;
    LAS unsigned char* lds = F.lds; LAS float* P = (LAS float*)(lds + P7_LDS_P); LAS unsigned* hist = (LAS unsigned*)(lds + P7_LDS_H); LAS unsigned* baseL = hist + 64;
    const int lane = lane_id(), w = F.wave, tid = w * 64 + lane;
    if (tid < 64) hist[tid] = 0u;
    __syncthreads();
    for (int p = blockIdx.x; p < NTOK / P7_ROWS; p += F.G) {
        const int row0 = P7_ROWS * p;
        { const int b = row0 / SEQ; const float* sh = mod + b * 6 * DM + 3 * DM; const float* sl = mod + b * 6 * DM + 4 * DM;
          f32x4 v[P7_RW][8];
#pragma unroll
          for (int rr = 0; rr < P7_RW; ++rr) { const float* xrow = F.out + (size_t)(row0 + P7_RW * w + rr) * DM;
#pragma unroll
              for (int j = 0; j < 8; ++j) v[rr][j] = *(const f32x4*)(xrow + 4 * lane + 256 * j); }
          float rstd[P7_RW];
#pragma unroll
          for (int rr = 0; rr < P7_RW; ++rr) { float ss = 0.f;
#pragma unroll
              for (int j = 0; j < 8; ++j) ss += (v[rr][j].x * v[rr][j].x + v[rr][j].y * v[rr][j].y) + (v[rr][j].z * v[rr][j].z + v[rr][j].w * v[rr][j].w);
              rstd[rr] = rsqrtf(wave_sum(ss) * (1.0f / DM) + NORM_EPS); }
#pragma unroll
          for (int j = 0; j < 8; ++j) { const int c = 4 * lane + 256 * j;
              const f32x4 gg = *(const f32x4*)(a.in[I_GFFN] + c), shv = *(const f32x4*)(sh + c), slv = *(const f32x4*)(sl + c); const f32x4 mul = gg * (slv + 1.0f);
#pragma unroll
              for (int rr = 0; rr < P7_RW; ++rr) { const int lr = P7_RW * w + rr, m = row0 + lr;
                  const f32x4 o = v[rr][j] * rstd[rr] * mul + shv;
                  u32x2 wv; wv.x = cvt_pk_bf16(o.x, o.y); wv.y = cvt_pk_bf16(o.z, o.w);
                  *(unsigned*)(hb8 + (size_t)m * DM + c) = pk4_fp8(o.x * H8_SCALE, o.y * H8_SCALE, o.z * H8_SCALE, o.w * H8_SCALE); *(LAS u32x2*)(lds + lr * P7_ROWB + c * 2) = wv; } }
          if (lane < P7_RW) ident[row0 + P7_RW * w + lane] = row0 + P7_RW * w + lane;
        }
        __syncthreads();
        { const int nb = w & 3, kh = w >> 2, fr = lane & 15, kq = lane >> 4;
          f32x4 acc[2] = {{0.f, 0.f, 0.f, 0.f}, {0.f, 0.f, 0.f, 0.f}};
          const bf16_t* wp = Wr + (size_t)(16 * nb + fr) * DM + 1024 * kh + 8 * kq;
          const LAS unsigned char* ap = lds + fr * P7_ROWB + (1024 * kh + 8 * kq) * 2;
#pragma unroll 8
          for (int s = 0; s < 32; ++s) { const bf16x8 bv = *(const bf16x8*)(wp + 32 * s);
#pragma unroll
              for (int mb = 0; mb < 2; ++mb) { const bf16x8 av = *(const LAS bf16x8*)(ap + mb * 16 * P7_ROWB + 64 * s); acc[mb] = __builtin_amdgcn_mfma_f32_16x16x32_bf16(av, bv, acc[mb], 0, 0, 0); } }
#pragma unroll
          for (int mb = 0; mb < 2; ++mb)
#pragma unroll
              for (int j = 0; j < 4; ++j) P[(kh * P7_ROWS + 16 * mb + 4 * kq + j) * 64 + 16 * nb + fr] = acc[mb][j];
        }
        __syncthreads();
        int myrank[P7_RW]; unsigned mylocal[P7_RW]; bool chosen[P7_RW]; float mygate[P7_RW];
#pragma unroll
        for (int rr = 0; rr < P7_RW; ++rr) { const int lr = P7_RW * w + rr;
            const float logit = P[lr * 64 + lane] + P[(P7_ROWS + lr) * 64 + lane];
            const float score = 1.0f / (1.0f + __expf(-logit)); const float sel = score + a.in[I_RBIAS][lane];
            float m1 = sel; m1 = fmaxf(m1, __shfl_xor(m1, 1)); m1 = fmaxf(m1, __shfl_xor(m1, 2)); m1 = fmaxf(m1, __shfl_xor(m1, 4));
            const unsigned long long bm = __ballot(sel == m1); const unsigned grp = (unsigned)((bm >> (lane & ~7)) & 0xffull); const int first = __builtin_ctz(grp | 0x100u);
            float m2 = ((lane & 7) == first) ? -__builtin_inff() : sel; m2 = fmaxf(m2, __shfl_xor(m2, 1)); m2 = fmaxf(m2, __shfl_xor(m2, 2)); m2 = fmaxf(m2, __shfl_xor(m2, 4));
            const float gs = m1 + m2; const int g = lane >> 3; int grank = 0;
#pragma unroll
            for (int g2 = 0; g2 < 8; ++g2) { const float o = __uint_as_float(__builtin_amdgcn_readlane(__float_as_uint(gs), 8 * g2)); grank += (o > gs || (o == gs && g2 < g)) ? 1 : 0; }
            const float selm = grank < TOPG ? sel : -__builtin_inff(); int rank = 0;
#pragma unroll
            for (int e2 = 0; e2 < 64; ++e2) { const float o = __uint_as_float(__builtin_amdgcn_readlane(__float_as_uint(selm), e2)); rank += (o > selm || (o == selm && e2 < lane)) ? 1 : 0; }
            const bool ch = rank < ETOP && grank < TOPG; const float gsum = wave_sum(ch ? score : 0.f);
            chosen[rr] = ch; myrank[rr] = rank; mygate[rr] = score / gsum * ROUTED_SCALE;
            mylocal[rr] = ch ? __hip_atomic_fetch_add(hist + lane, 1u, __ATOMIC_RELAXED, __HIP_MEMORY_SCOPE_WORKGROUP) : 0u;
        }
        __syncthreads();
        if (w == 0) { const unsigned c = hist[lane]; baseL[lane] = c ? __hip_atomic_fetch_add(ecnt + lane, c, __ATOMIC_RELAXED, __HIP_MEMORY_SCOPE_AGENT) : 0u; hist[lane] = 0u; }
        __syncthreads();
#pragma unroll
        for (int rr = 0; rr < P7_RW; ++rr) if (chosen[rr]) { const int m = row0 + P7_RW * w + rr; const unsigned pos = baseL[lane] + mylocal[rr];
            eid[m * 8 + myrank[rr]] = lane; gate[m * 8 + myrank[rr]] = mygate[rr]; posn[m * 8 + myrank[rr]] = (int)pos; list[(size_t)lane * NTOK + pos] = m; }
        __syncthreads();
    }
}
constexpr int MOE_LDS = 131072;
__device__ __forceinline__ int moe_prefix(Frame& F) {
    LAS int* rtoff = (LAS int*)(F.lds + MOE_LDS);
    if (F.wave == 0 && lane_id() == 0) { int s = 0; for (int e = 0; e < NE; ++e) { rtoff[e] = s; unsigned n = F.ctl[CW_ECNT + e]; if (n > (unsigned)NTOK) n = NTOK; s += (int)((n + 255u) >> 8); } rtoff[NE] = s; }
    __syncthreads();
    return __builtin_amdgcn_readfirstlane(rtoff[NE]);
}
__device__ __forceinline__ int moe_find(const LAS int* rtoff, int rtg) {
    int lo = 0, hi = NE;
#pragma unroll
    for (int it = 0; it < 6; ++it) { const int mid = (lo + hi) >> 1; const int v = __builtin_amdgcn_readfirstlane(rtoff[mid]); if (v <= rtg) lo = mid; else hi = mid; }
    return lo;
}
struct SchedMoe1 {
    const LAS int* rtoff; int RT, G, c; const char* hb; const char* w13; const char* ws13; const int* list; const int* ident;
    __device__ __forceinline__ bool next(int i, pg8::Unit& u) const {
        const int idx = i * G + (c & 7) * (G >> 3) + (c >> 3); if (idx >= (RT + NTOK / 256) * 4) return false;
        const int rtg = idx >> 2, ct = idx & 3; u.pn = ct; u.aux = 0; u.nt8 = 0; u.A = hb;
        if (rtg < RT) { const int e = moe_find(rtoff, rtg), rt = rtg - __builtin_amdgcn_readfirstlane(rtoff[e]); u.pm = rtg; u.tok = list + (size_t)e * NTOK + rt * 256;
            u.B = w13 + ((size_t)e * 1024 + ct * 256) * DM; }
        else { const int rt = rtg - RT; u.pm = HROWS_R / 256 + rt; u.tok = ident + rt * 256; u.B = ws13 + (size_t)(ct * 256) * DM; }
        return true; }
};
struct EpiMoe1 {
    unsigned char* H;
    __device__ __forceinline__ bool operator()(f32x4 (&acc)[2][2][4][2], const pg8::Unit& u, int wr, int wc, int fr, int fq) const {
        const int row0 = u.pm * 256 + wr * 64 + fr, col0 = u.pn * 128 + wc * 32 + 8 * fq;
#pragma unroll
        for (int ai = 0; ai < 2; ++ai)
#pragma unroll
            for (int m = 0; m < 4; ++m) { f32x4 h0, h1;
#pragma unroll
                for (int j = 0; j < 4; ++j) { const float g0 = acc[ai][0][m][0][j], g1 = acc[ai][0][m][1][j];
                    h0[j] = g0 * __builtin_amdgcn_rcpf(1.0f + __expf(-g0)) * acc[ai][1][m][0][j]; h1[j] = g1 * __builtin_amdgcn_rcpf(1.0f + __expf(-g1)) * acc[ai][1][m][1][j]; }
                u32x2 w; w.x = pk4_fp8(h0[0] * H8_SCALE, h0[1] * H8_SCALE, h0[2] * H8_SCALE, h0[3] * H8_SCALE); w.y = pk4_fp8(h1[0] * H8_SCALE, h1[1] * H8_SCALE, h1[2] * H8_SCALE, h1[3] * H8_SCALE);
                *(u32x2*)(H + (size_t)(row0 + ai * 128 + m * 16) * EH + col0) = w; }
        return false;
    }
};
__device__ __forceinline__ void p8_gemm1(Frame& F, const Args& a) {
    const int RT = moe_prefix(F);
    const int U = (RT + NTOK / 256) * 4, R0 = (U + F.G - 1) / F.G, R = (R0 * F.G - U < 24 * R0) ? R0 + 1 : R0, NG0 = ((U + R - 1) / R + 7) & ~7, NG = NG0 < F.G ? NG0 : (F.G & ~7);
    if ((int)blockIdx.x >= NG) { conv_drain<false, 1, 2>(F, a, 8); return; }
    SchedMoe1 S{(const LAS int*)(F.lds + MOE_LDS), RT, NG, (int)blockIdx.x, (const char*)(F.ws + WS_HB), (const char*)(F.ws + WS_W13), (const char*)(F.ws + WS_WS13),
                (const int*)(F.ws + WS_ROUTE + RT_LIST), (const int*)(F.ws + WS_ROUTE + RT_IDENT)};
    EpiMoe1 E{F.ws + WS_H};
    pg8::gemm_phase<EpiMoe1, SchedMoe1, true, 1, H8_E8, W8_E8>(F.lds, F.wave, DM, DM, S, E);
    conv_drain<false, 1, 2>(F, a, 8);
}
struct SchedMoe2 {
    const LAS int* rtoff; int RT, G, c; const char* H; const char* w2; const char* ws2;
    __device__ __forceinline__ bool next(int i, pg8::Unit& u) const {
        const int idx = (G & 7) ? i * G + c : i * G + (c & 7) * (G >> 3) + (c >> 3); if (idx >= (RT + NTOK / 256) * 8) return false;
        const int rtg = idx >> 3, ct = idx & 7; u.pn = ct; u.aux = 0; u.tok = nullptr; u.nt8 = 0;
        if (rtg < RT) { const int e = moe_find(rtoff, rtg); u.pm = rtg; u.B = w2 + ((size_t)e * DM + ct * 256) * EH; }
        else { u.pm = HROWS_R / 256 + (rtg - RT); u.B = ws2 + (size_t)(ct * 256) * EH; }
        u.A = H + (size_t)u.pm * 256 * EH; return true; }
};
constexpr float Y8_SCALE = 8.f;
#ifndef P9_STAGGER
#define P9_STAGGER 250
#endif
struct EpiY {
    unsigned char* Y; LAS unsigned char* lds;
    __device__ __forceinline__ bool operator()(f32x4 (&acc)[2][2][4][2], const pg8::Unit& u, int wr, int wc, int fr, int fq) const {
        const int tid = (wr * 4 + wc) * 64 + fq * 16 + fr, r0 = tid >> 4, g = tid & 15;
        const unsigned wa0 = (unsigned)(wr ? MOE_LDS + 512 : 3 * 16384) + fr * 256 + (((2 * wc + (fq >> 1)) ^ fr) << 4) + (fq & 1) * 8, wa1 = wa0 ^ 128u;
        const unsigned ra = (unsigned)(r0 * 256 + ((g ^ (r0 & 15)) << 4));
        const unsigned yo = (unsigned)((u.pm * 256 + r0) * DM + u.pn * 256 + g * 16);
#pragma unroll
        for (int ai = 0; ai < 2; ++ai) {
#pragma unroll
            for (int m = 0; m < 4; ++m)
#pragma unroll
                for (int bj = 0; bj < 2; ++bj) { const f32x4 v0 = acc[ai][bj][m][0] * Y8_SCALE, v1 = acc[ai][bj][m][1] * Y8_SCALE; u32x2 w; w.x = pk4_fp8(v0[0], v0[1], v0[2], v0[3]); w.y = pk4_fp8(v1[0], v1[1], v1[2], v1[3]);
                    *(LAS u32x2*)(lds + (bj ? wa1 : wa0) + m * 4096) = w; }
            asm volatile("s_waitcnt lgkmcnt(0)\n\ts_barrier" ::: "memory");
#pragma unroll
            for (int it = 0; it < 4; ++it) {
                const u32x4 d = *(const LAS u32x4*)(lds + ra + ((it >> 1) ? MOE_LDS + 512 : 3 * 16384) + (it & 1) * 8192);
                *(u32x4*)(Y + (yo + (unsigned)((ai * 128 + it * 32) * DM))) = d; }
            asm volatile("s_waitcnt lgkmcnt(0)\n\ts_barrier" ::: "memory");
        }
        return false;
    }
};
__device__ __forceinline__ void p9_gemm2(Frame& F) {
    const int RT = moe_prefix(F);
    SchedMoe2 S{(const LAS int*)(F.lds + MOE_LDS), RT, F.G, (int)blockIdx.x, (const char*)(F.ws + WS_H), (const char*)(F.ws + WS_W2), (const char*)(F.ws + WS_WS2)};
    EpiY E{F.ws + WS_Y, F.lds};
    pg8::gemm_phase<EpiY, SchedMoe2, false, 1, H8_E8, W8_E8>(F.lds, F.wave, EH, EH, S, E);
}
__device__ __forceinline__ void p10_combine(Frame& F) {
    (void)moe_prefix(F);
    const LAS int* rtoff = (const LAS int*)(F.lds + MOE_LDS);
    const unsigned char* Y = F.ws + WS_Y; unsigned char* rt = F.ws + WS_ROUTE;
    const int* eid = (const int*)(rt + RT_EID); const float* gate = (const float*)(rt + RT_GATE); const int* posn = (const int*)(rt + RT_POS); const float* mod = (const float*)(F.ctl + CW_MOD);
    const int lane = lane_id();
    size_t yr[9]; float g[9]; unsigned yv[9][8];
#define P10_ROUTE(t_) do { const u32x4 e0 = *(const u32x4*)(eid + (t_) * 8), e1 = *(const u32x4*)(eid + (t_) * 8 + 4), p0 = *(const u32x4*)(posn + (t_) * 8), p1 = *(const u32x4*)(posn + (t_) * 8 + 4); \
        const f32x4 g0 = *(const f32x4*)(gate + (t_) * 8), g1 = *(const f32x4*)(gate + (t_) * 8 + 4); \
        _Pragma("unroll") for (int k = 0; k < 8; ++k) { const int e = __builtin_amdgcn_readfirstlane((int)(k < 4 ? e0[k & 3] : e1[k & 3])) & 63, p = __builtin_amdgcn_readfirstlane((int)(k < 4 ? p0[k & 3] : p1[k & 3])); \
            yr[k] = (size_t)(256 * __builtin_amdgcn_readfirstlane(rtoff[e]) + p) * DM; g[k] = __uint_as_float(__builtin_amdgcn_readfirstlane(__float_as_uint(k < 4 ? g0[k & 3] : g1[k & 3]))); } \
        yr[8] = (size_t)(HROWS_R + (t_)) * DM; g[8] = 1.0f; } while (0)
#define P10_YLOAD() do { _Pragma("unroll") for (int k = 0; k < 9; ++k) { _Pragma("unroll") for (int j = 0; j < 8; ++j) yv[k][j] = __builtin_nontemporal_load((const unsigned*)(Y + yr[k] + 4 * lane + 256 * j)); } } while (0)
    int t = F.gw;
    if (t < NTOK) { P10_ROUTE(t); P10_YLOAD(); }
    for (; t < NTOK; t += F.NGW) {
        const int b = t / SEQ; const float* gf = mod + b * 6 * DM + 5 * DM + 4 * lane;
        float* orow = F.out + (size_t)t * DM + 4 * lane;
        f32x4 xv[8];
#pragma unroll
        for (int j = 0; j < 8; ++j) xv[j] = *(const f32x4*)(orow + 256 * j);
        f32x4 s[8];
#pragma unroll
        for (int j = 0; j < 8; ++j) s[j] = (f32x4){0.f, 0.f, 0.f, 0.f};
#pragma unroll
        for (int k = 0; k < 9; ++k)
#pragma unroll
            for (int j = 0; j < 8; ++j) { const f32x2 lo = __builtin_amdgcn_cvt_pk_f32_fp8((int)yv[k][j], false), hi = __builtin_amdgcn_cvt_pk_f32_fp8((int)yv[k][j], true);
                s[j][0] += lo[0] * g[k]; s[j][1] += lo[1] * g[k]; s[j][2] += hi[0] * g[k]; s[j][3] += hi[1] * g[k]; }
        const int tn = t + F.NGW;
        if (tn < NTOK) { P10_ROUTE(tn); P10_YLOAD(); }
#pragma unroll
        for (int j = 0; j < 8; ++j) *(f32x4*)(orow + 256 * j) = xv[j] + *(const f32x4*)(gf + 256 * j) * s[j] * (1.0f / Y8_SCALE);
    }
#undef P10_ROUTE
#undef P10_YLOAD
}
constexpr int LDS_BYTES = 155648;
constexpr int N_PHASES = 11;
#ifndef PROBE_REP
#define PROBE_REP -1
#endif
#define REP(k, stmt) do { stmt; if (PROBE_REP == (k)) { __syncthreads(); stmt; } } while (0)
__global__ void __launch_bounds__(NTHR, 2) fwd(Args args) {
    extern __shared__ __attribute__((aligned(16))) unsigned char lds_raw[];
    Frame F; F.lds = (LAS unsigned char*)lds_raw; F.wave = __builtin_amdgcn_readfirstlane((int)threadIdx.x >> 6);
    F.G = gridDim.x; F.gw = blockIdx.x * NWAVES + F.wave; F.NGW = F.G * NWAVES; F.ws = args.ws; F.ctl = (unsigned*)(args.ws + WS_CTL); F.out = args.out;
    volatile LAS unsigned* xbw = (volatile LAS unsigned*)(F.lds + LDS_BYTES - 16);
    if (threadIdx.x < 4) xbw[threadIdx.x] = 0u;
    __syncthreads();
    const bool one = (args.ph_hi - args.ph_lo) > 1;
    XcdBarrier bar; bar.bar = F.ctl + CW_BAR; bar.x = 0; bar.st = xbw;
    if (one) bar = xcd_barrier_post(F.ctl + CW_BAR, xbw, F.wave);
    const int lo = args.ph_lo, hi = args.ph_hi;
#ifndef PROBE_TIME
#define PROBE_TIME -1
#endif
    unsigned long long pt0 = 0ull, pt1 = 0ull;
#define TSTAMP(k, which) do { if (PROBE_TIME == (k) && blockIdx.x == 0) { if (which) pt1 = __builtin_amdgcn_s_memrealtime(); else pt0 = __builtin_amdgcn_s_memrealtime(); } } while (0)
#define IN(k) (lo <= (k) && (k) < hi)
#define SEAM(k) do { if (IN(k) && IN((k) + 1)) xcd_barrier(bar, F.wave); } while (0)
    TSTAMP(0, 0); if (IN(0)) { REP(0, p0_prologue(F, args)); } SEAM(0); TSTAMP(0, 1);
    TSTAMP(1, 0); if (IN(1)) { REP(1, p1_h(F, args)); } SEAM(1); TSTAMP(1, 1);
    TSTAMP(2, 0); if (IN(2)) { REP(2, p2_inproj(F, args)); } SEAM(2); TSTAMP(2, 1);
    TSTAMP(3, 0); if (IN(3)) { p3_qknorm(F, args); __syncthreads(); REP(3, p3_indexer(F, args)); } SEAM(3); TSTAMP(3, 1);
    TSTAMP(4, 0); if (IN(4)) { REP(4, p4_pool_attn(F, args)); if (one) { conv_drain<true, 0, 2>(F, args, 4); } } SEAM(4); TSTAMP(4, 1);
    TSTAMP(5, 0); if (IN(5)) { REP(5, p5_merge(F)); } SEAM(5); TSTAMP(5, 1);
    TSTAMP(6, 0); if (IN(6)) { REP(6, p6_out(F, args)); } SEAM(6); TSTAMP(6, 1);
    TSTAMP(7, 0); if (IN(7)) { p7_router(F, args); conv_drain<false, 0, 1>(F, args, 7); }
    SEAM(7); TSTAMP(7, 1);
    TSTAMP(8, 0); if (IN(8)) { REP(8, p8_gemm1(F, args)); } SEAM(8); TSTAMP(8, 1);
    TSTAMP(9, 0); if (IN(9)) { REP(9, p9_gemm2(F)); } SEAM(9); TSTAMP(9, 1);
    TSTAMP(10, 0); if (IN(10)) { p10_combine(F); } TSTAMP(10, 1);
    if (PROBE_TIME >= 0 && blockIdx.x == 0) { const unsigned long long tend = __builtin_amdgcn_s_memrealtime() + 4ull * (pt1 - pt0); while (__builtin_amdgcn_s_memrealtime() < tend) __builtin_amdgcn_s_sleep(8); }
#undef IN
#undef SEAM
}
#ifndef N_LAUNCHES
#define N_LAUNCHES 1
#endif
extern "C" void kernel_launch(void* const* d_in, const int* in_sizes, int n_in, void* d_out, int out_size, void* d_ws, size_t ws_size, hipStream_t stream) {
    static int grid = 0;
    if (grid == 0) {
        if (n_in != 22 || out_size != NTOK * DM || ws_size < WS_END) { fprintf(stderr, "kernel_launch: unexpected shapes (n_in %d out %d ws %zu need %zu)\n", n_in, out_size, ws_size, (size_t)WS_END); grid = -1; return; }
        int dev = 0, cus = 0, per_cu = 0;
        if (hipGetDevice(&dev) != hipSuccess || hipDeviceGetAttribute(&cus, hipDeviceAttributeMultiprocessorCount, dev) != hipSuccess) { grid = -1; return; }
        if (hipFuncSetAttribute((const void*)fwd, hipFuncAttributeMaxDynamicSharedMemorySize, LDS_BYTES) != hipSuccess) { fprintf(stderr, "kernel_launch: hipFuncSetAttribute failed\n"); grid = -1; return; }
        if (hipOccupancyMaxActiveBlocksPerMultiprocessor(&per_cu, (const void*)fwd, NTHR, LDS_BYTES) != hipSuccess || per_cu < 1) fprintf(stderr, "kernel_launch: occupancy query says %d\n", per_cu);
        (void)hipGetLastError();
        grid = cus;
    }
    if (grid < 0) return;
    (void)hipMemsetAsync((char*)d_ws + WS_CTL, 0, CTL_BYTES, stream);
    Args a{};
    for (int i = 0; i < 22; ++i) a.in[i] = (const float*)d_in[i];
    a.out = (float*)d_out; a.ws = (unsigned char*)d_ws;
    if (N_LAUNCHES == 1) { a.ph_lo = 0; a.ph_hi = N_PHASES; hipLaunchKernelGGL(fwd, dim3(grid), dim3(NTHR), LDS_BYTES, stream, a); }
    else for (int p = 0; p < N_PHASES; ++p) { a.ph_lo = p; a.ph_hi = p + 1; hipLaunchKernelGGL(fwd, dim3(grid), dim3(NTHR), LDS_BYTES, stream, a); }
}
```

```cpp
#include <hip/hip_runtime.h>
#include <cstdio>
#include <cstdint>

#define LAS __attribute__((address_space(3)))
#define GAS __attribute__((address_space(1)))
typedef unsigned short bf16_t;
typedef short bf16x8 __attribute__((ext_vector_type(8)));
typedef short s16x4 __attribute__((ext_vector_type(4)));
typedef float f32x4 __attribute__((ext_vector_type(4)));
typedef float f32x2 __attribute__((ext_vector_type(2)));
typedef float f32x16 __attribute__((ext_vector_type(16)));
typedef unsigned u32x4 __attribute__((ext_vector_type(4)));
typedef unsigned u32x2 __attribute__((ext_vector_type(2)));

constexpr int DM = 2048, NB = 2, SEQ = 4096, NTOK = NB * SEQ;
constexpr int NH = 8, HD = 128, NKV = 2, AW = 1024, KVW = 256, IH = 16, ID = 64, TOPK = 256;
constexpr int PW = 1024, INW = 7760, INP = 7936;
constexpr int NE = 64, EH = 512, NGRP = 8, EPG = 8, TOPG = 4, ETOP = 8;
constexpr float NORM_EPS = 1e-6f, ROUTED_SCALE = 2.5f;
constexpr int NTHR = 512, NWAVES = 8;

constexpr size_t MiB = 1u << 20;
constexpr size_t WS_CTL = 0, CTL_BYTES = 1 * MiB;
constexpr size_t WS_W13 = 1 * MiB;
constexpr size_t WS_W2 = WS_W13 + 256 * MiB;
constexpr size_t WS_WS13 = WS_W2 + 128 * MiB;
constexpr size_t WS_WS2 = WS_WS13 + 4 * MiB;
constexpr size_t WS_H = WS_WS2 + 2 * MiB;
constexpr int HROWS_R = 65536 + 64 * 256, HROWS = HROWS_R + NTOK;
constexpr size_t WS_ROUTE = WS_H + (size_t)HROWS * EH * 2;
constexpr size_t RT_EID = 0, RT_GATE = RT_EID + (size_t)NTOK * 8 * 4, RT_POS = RT_GATE + (size_t)NTOK * 8 * 4, RT_LIST = RT_POS + (size_t)NTOK * 8 * 4,
                 RT_IDENT = RT_LIST + (size_t)NE * NTOK * 4, RT_END = RT_IDENT + (size_t)NTOK * 4;
constexpr size_t WS_R = (WS_ROUTE + RT_END + MiB - 1) / MiB * MiB;
constexpr size_t WS_Y = WS_R;
constexpr size_t WS_WIN = WS_R;
constexpr size_t WS_WAU = WS_WIN + 31 * MiB, WS_WPU = WS_WAU + 4 * MiB, WS_WOUT = WS_WPU + 4 * MiB, WS_PLIN = WS_WOUT + 8 * MiB, WS_WR = WS_PLIN + MiB / 2;
constexpr size_t WS_HB = WS_WR + MiB / 2;
constexpr size_t WS_Q = WS_HB + 32 * MiB, WS_K = WS_Q + 16 * MiB, WS_V = WS_K + 4 * MiB, WS_QI = WS_V + 4 * MiB, WS_KW = WS_QI + 16 * MiB, WS_U = WS_KW + 4 * MiB,
                 WS_G = WS_U + 16 * MiB;
constexpr size_t WS_POOLED = WS_G + 64 * MiB, WS_POOL = WS_POOLED + 16 * MiB, WS_ATTN = WS_POOL + 16 * MiB, WS_MERGED = WS_ATTN + 16 * MiB, WS_MASK = WS_MERGED + 32 * MiB,
                 WS_H8 = WS_MASK + 4 * MiB,
                 WS_REND = WS_H8 + 32 * MiB;
constexpr size_t WS_END = WS_Y + (size_t)HROWS_R * DM * 2;
static_assert(WS_REND <= WS_END, "overlay region");
constexpr int CW_BAR = 4096;
constexpr int CW_ECNT = 8192;
constexpr int CW_CONVQ = 12288;
constexpr int CW_DONE = 12544;
constexpr int CW_ADAC = 14336;
constexpr int CW_MODRDY = 14784;
constexpr int CW_MOD = 16384;
static_assert((CW_MOD + 2 * 6 * DM) * 4 <= (int)CTL_BYTES, "ctl");

__device__ __forceinline__ int lane_id() { int l; asm volatile("v_mbcnt_lo_u32_b32 %0, -1, 0\n\tv_mbcnt_hi_u32_b32 %0, -1, %0" : "=v"(l)); return l; }
__device__ __forceinline__ unsigned cvt_pk_bf16(float lo, float hi) { unsigned r; asm volatile("v_cvt_pk_bf16_f32 %0, %1, %2" : "=v"(r) : "v"(lo), "v"(hi)); return r; }
__device__ __forceinline__ unsigned pk4_fp8(float a, float b, float c, float d) {
    a = __builtin_amdgcn_fmed3f(a, -448.f, 448.f); b = __builtin_amdgcn_fmed3f(b, -448.f, 448.f); c = __builtin_amdgcn_fmed3f(c, -448.f, 448.f); d = __builtin_amdgcn_fmed3f(d, -448.f, 448.f);
    int w; asm volatile("" : "=v"(w));
    w = __builtin_amdgcn_cvt_pk_fp8_f32(a, b, w, false); w = __builtin_amdgcn_cvt_pk_fp8_f32(c, d, w, true); return (unsigned)w; }
#ifndef FP8_INPROJ
#define FP8_INPROJ 0
#endif
#ifndef FP8_MERGE
#define FP8_MERGE 1
#endif
#ifndef FP8_OUT
#define FP8_OUT 1
#endif
constexpr float W8_SCALE = 8.f;   constexpr int W8_E8 = 127 - 3;
constexpr float H8_SCALE = 8.f;   constexpr int H8_E8 = 127 - 3;
constexpr float A8_SCALE = 8.f;   constexpr int A8_E8 = 127 - 3;
__device__ __forceinline__ float bf2f(unsigned short b) { return __uint_as_float(((unsigned)b) << 16); }
__device__ __forceinline__ float bflo(unsigned w) { return __uint_as_float(w << 16); }
__device__ __forceinline__ float bfhi(unsigned w) { return __uint_as_float(w & 0xffff0000u); }
__device__ __forceinline__ float wave_sum(float v) {
#pragma unroll
    for (int o = 1; o < 64; o <<= 1) v += __shfl_xor(v, o);
    return v;
}
__device__ __forceinline__ float sigmoidf_(float x) { return 1.0f / (1.0f + __expf(-x)); }

#define XB_TMO      128
#define XB_XCNT(j)  (256  + 64 * (j))
#define XB_XSUB(j)  (1280 + 64 * (j))
#define XB_XGEN(j)  (2304 + 64 * (j))
#define XB_TOP      3328
#define XB_TOPGEN   3392
#define XCD_BAR_WORDS 3456
#define XB_SPIN_CAP (1u << 18)
__device__ __forceinline__ unsigned xb_ld(unsigned* p)              { return __hip_atomic_load(p, __ATOMIC_RELAXED, __HIP_MEMORY_SCOPE_AGENT); }
__device__ __forceinline__ unsigned xb_add(unsigned* p, unsigned v) { return __hip_atomic_fetch_add(p, v, __ATOMIC_RELAXED, __HIP_MEMORY_SCOPE_AGENT); }
__device__ __forceinline__ unsigned xb_xcc_id() { return (unsigned)__builtin_amdgcn_s_getreg((3 << 11) | 20) & 0xFu; }
#define XB_SPIN(cond, bar) do { unsigned _sp = 0; while (cond) { __builtin_amdgcn_s_sleep(1); \
    if ((++_sp & 255u) == 0u) { if (xb_ld(&(bar)[XB_TMO])) break; if (_sp > XB_SPIN_CAP) { atomicAdd(&(bar)[XB_TMO], 1u); break; } } } } while (0)
struct XcdBarrier { unsigned* bar; unsigned x; volatile LAS unsigned* st; };
__device__ __forceinline__ XcdBarrier xcd_barrier_post(unsigned* bar, volatile LAS unsigned* st, int wave) {
    XcdBarrier b; b.bar = bar; b.x = xb_xcc_id(); b.st = st;
    if (wave == 0 && lane_id() == 0) (void)xb_add(&bar[XB_XCNT(b.x)], 1u);
    return b;
}
__device__ __forceinline__ void xcd_barrier_complete(unsigned* bar, unsigned x, unsigned& nloc, unsigned& nx) {
    const unsigned G = gridDim.x * gridDim.y * gridDim.z;
    unsigned sum, cnt, mine, sp = 0u;
    for (;;) {
        sum = 0u; cnt = 0u; mine = 0u;
#pragma unroll
        for (unsigned j = 0; j < 16; ++j) { const unsigned c = xb_ld(&bar[XB_XCNT(j)]); sum += c; cnt += (c > 0u) ? 1u : 0u; mine = (j == x) ? c : mine; }
        if (sum == G) break;
        __builtin_amdgcn_s_sleep(1);
        if ((++sp & 255u) == 0u) { if (xb_ld(&bar[XB_TMO])) break; if (sp > XB_SPIN_CAP) { atomicAdd(&bar[XB_TMO], 1u); break; } }
    }
    nloc = mine > 0u ? mine : 1u; nx = cnt > 0u ? cnt : 1u;
}
__device__ __forceinline__ void xcd_barrier(const XcdBarrier& b, int wave) {
    asm volatile("s_waitcnt vmcnt(0)" ::: "memory");
    __syncthreads();
    if (wave == 0 && lane_id() == 0) {
        unsigned* bar = b.bar;
        __builtin_amdgcn_s_waitcnt(0);
        unsigned nloc = b.st[0], nx = b.st[1];
        if (nloc == 0u) { xcd_barrier_complete(bar, b.x, nloc, nx); b.st[0] = nloc; b.st[1] = nx; }
        const unsigned old = xb_add(&bar[XB_XSUB(b.x)], 1u);
        const unsigned gen = old / nloc;
        if (old + 1u == (gen + 1u) * nloc) {
            __builtin_amdgcn_fence(__ATOMIC_RELEASE, "agent");
            asm volatile("s_waitcnt vmcnt(0)" ::: "memory");
            const unsigned og = xb_add(&bar[XB_TOP], 1u);
            const unsigned tg = og / nx;
            if (og + 1u == (tg + 1u) * nx) xb_add(&bar[XB_TOPGEN], 1u);
            else XB_SPIN(xb_ld(&bar[XB_TOPGEN]) == tg, bar);
            __builtin_amdgcn_fence(__ATOMIC_ACQUIRE, "agent");
            xb_add(&bar[XB_XGEN(b.x)], 1u);
            asm volatile("s_waitcnt vmcnt(0)" ::: "memory");
        } else {
            XB_SPIN(xb_ld(&bar[XB_XGEN(b.x)]) == gen, bar);
            __builtin_amdgcn_fence(__ATOMIC_ACQUIRE, "agent");
            asm volatile("s_waitcnt vmcnt(0)" ::: "memory");
        }
    }
    __syncthreads();
}
namespace pg8 {
constexpr int BM = 256, BK = 64, HALF = 128, HTB = HALF * BK * 2, STAGE_BYTES = 8 * HTB, NXCD = 8, WGM = 8;
__host__ __device__ __forceinline__ int lds_byte(int r, int c) { const int st = (r >> 4) * 2 + (c >> 5), rr = r & 15, cc = c & 31, ob = rr * 64 + cc * 2; return st * 1024 + (ob ^ (((ob >> 9) & 1) << 5)); }
__host__ __device__ __forceinline__ void stage_rc(int b, int& R, int& C) { const int st = b / 1024, sb = b % 1024, swz = sb ^ (((sb >> 9) & 1) << 5); R = (st >> 1) * 16 + swz / 64; C = (st & 1) * 32 + (swz % 64) / 2; }
__host__ __device__ __forceinline__ int perm32(int rho) { const int n = rho >> 4, i = rho & 15; return 8 * (i >> 2) + 4 * n + (i & 3); }

struct Unit { const char* A; const char* B; const int* tok; int pm, pn, aux; int nt8; };

struct TileOrder {
    int nM, nN, nwg, G, c;
    __device__ void init(int M, int N, int G_, int c_) { nM = M / BM; nN = N / BM; nwg = nM * nN; G = G_; c = c_; }
    __device__ bool tile(int i, int& pm, int& pn) const {
        const long L = (long)i * G + c; if (L >= nwg) return false;
        int wgid = (int)L; { const int q = nwg / NXCD, r = nwg % NXCD, xcd = wgid % NXCD, off = wgid / NXCD; wgid = (xcd < r ? xcd * (q + 1) : r * (q + 1) + (xcd - r) * q) + off; }
        const int nig = WGM * nN, gid = wgid / nig, fm = gid * WGM, gsz = (nM - fm) < WGM ? (nM - fm) : WGM;
        pm = fm + ((wgid % nig) % gsz); pn = (wgid % nig) / gsz; return true;
    }
};

typedef int i32x8 __attribute__((ext_vector_type(8)));
template <class Epi, class Sched, bool GATHER, int ES = 2, int SCA = 127, int SCB = 127, bool MIXED = false>
__device__ __forceinline__ void gemm_phase(LAS unsigned char* lds, const int wid, const int Kb, const int ldab, const Sched& S, const Epi& E, const int nt_ovr = 0) {
    const int lane = lane_id(), tid = wid * 64 + lane, wr = wid >> 2, wc = wid & 3, fr = lane & 15, fq = lane >> 4;
    const int nt = nt_ovr ? nt_ovr : Kb / (BK * 2);
    unsigned voffA[2], voffB[2];
#pragma unroll
    for (int i = 0; i < 2; ++i) { int R, C; stage_rc(tid * 16 + i * 8192, R, C); const int Rb = (R & ~31) + perm32(R & 31);
        voffA[i] = (unsigned)(R * ldab + C * 2); voffB[i] = (unsigned)(Rb * Kb + C * 2); }
    const size_t kstep = (size_t)(BK * 2);
    const size_t hstepA = (size_t)HALF * ldab, hstepB = (size_t)HALF * Kb;
    const unsigned ldsw = (unsigned)wid * 1024u;
    const int aoff = (ES == 2 || MIXED) ? lds_byte(wr * 64 + fr, fq * 8) : lds_byte(wr * 64 + fr, fq * 16), boff = (ES == 2 || MIXED) ? lds_byte(wc * 32 + fr, fq * 8) : lds_byte(wc * 32 + fr, fq * 16);
    constexpr int OFF1 = (ES == 2 || MIXED) ? 1024 : 16;
#define PG8_SA(b, h) (((b) * 2 + (h)) * HTB)
#define PG8_SB(b, h) ((4 + (b) * 2 + (h)) * HTB)
    const unsigned ldsbase = (unsigned)(uintptr_t)lds + ldsw;
#define PG8_DMA2(bufoff, sbase, voff_, i_) do { unsigned keep_; asm volatile("s_mov_b32 %0, m0\n\ts_mov_b32 m0, %3\n\ts_nop 0\n\tglobal_load_lds_dwordx4 %1, %2\n\ts_mov_b32 m0, %0" \
        : "=&s"(keep_) : "v"(voff_), "s"(sbase), "s"(ldsbase + (unsigned)((bufoff) + (i_) * 8192)) : "memory"); } while (0)
#define PG8_STAGEB(bufoff, gbase) do { _Pragma("unroll") for (int _i = 0; _i < 2; ++_i) PG8_DMA2(bufoff, (const char*)(gbase), voffB[_i], _i); } while (0)
#define PG8_STAGEA(bufoff, kt, h, GO) do { _Pragma("unroll") for (int _i = 0; _i < 2; ++_i) { \
        if constexpr (GATHER) PG8_DMA2(bufoff, (const char*)(kt), GO[h][_i], _i); else PG8_DMA2(bufoff, (const char*)(kt) + (h) * hstepA, voffA[_i], _i); } } while (0)
#define PG8_LD8(p0, p1) __builtin_bit_cast(i32x8, __builtin_shufflevector(*(const LAS u32x4*)(p0), *(const LAS u32x4*)(p1), 0, 1, 2, 3, 4, 5, 6, 7))
#define PG8_LDA(dst, b, h) do { _Pragma("unroll") for (int m = 0; m < 4; ++m) dst[m] = PG8_LD8(lds + PG8_SA(b, h) + aoff + m * 2048, lds + PG8_SA(b, h) + aoff + OFF1 + m * 2048); } while (0)
#define PG8_LDB(dst, b, h) do { _Pragma("unroll") for (int n = 0; n < 2; ++n) dst[n] = PG8_LD8(lds + PG8_SB(b, h) + boff + n * 2048, lds + PG8_SB(b, h) + boff + OFF1 + n * 2048); } while (0)
#define PG8_LO(x) __builtin_bit_cast(bf16x8, __builtin_shufflevector(x, x, 0, 1, 2, 3))
#define PG8_HI(x) __builtin_bit_cast(bf16x8, __builtin_shufflevector(x, x, 4, 5, 6, 7))
#define PG8_MMA16(ai, bj, At, Bt) do { _Pragma("unroll") for (int m = 0; m < 4; ++m) _Pragma("unroll") for (int n = 0; n < 2; ++n) { \
        acc[ai][bj][m][n] = __builtin_amdgcn_mfma_f32_16x16x32_bf16(PG8_LO(Bt[n]), PG8_LO(At[m]), acc[ai][bj][m][n], 0, 0, 0); \
        acc[ai][bj][m][n] = __builtin_amdgcn_mfma_f32_16x16x32_bf16(PG8_HI(Bt[n]), PG8_HI(At[m]), acc[ai][bj][m][n], 0, 0, 0); } } while (0)
#define PG8_MMA8(ai, bj, At, Bt) do { _Pragma("unroll") for (int m = 0; m < 4; ++m) _Pragma("unroll") for (int n = 0; n < 2; ++n) \
        acc[ai][bj][m][n] = __builtin_amdgcn_mfma_scale_f32_16x16x128_f8f6f4(Bt[n], At[m], acc[ai][bj][m][n], 0, 0, 0, SCB * 0x01010101, 0, SCA * 0x01010101); } while (0)
#define PG8_MMA(ai, bj, At, Bt) do { __builtin_amdgcn_s_setprio(1); \
        if constexpr (MIXED) { if (cur8) PG8_MMA8(ai, bj, At, Bt); else PG8_MMA16(ai, bj, At, Bt); } \
        else if constexpr (ES == 2) PG8_MMA16(ai, bj, At, Bt); else PG8_MMA8(ai, bj, At, Bt); \
        __builtin_amdgcn_s_setprio(0); } while (0)
#define PG8_WAIT_V(n) asm volatile("s_waitcnt vmcnt(" #n ")" ::: "memory")
#define PG8_WAIT_L(n) asm volatile("s_waitcnt lgkmcnt(" #n ")" ::: "memory")
#define PG8_BAR __builtin_amdgcn_s_barrier()
#define PG8_SCHED __builtin_amdgcn_sched_barrier(0)
#define PG8_GLOAD(GO, u) do { if constexpr (GATHER) { const int _tid = wid * 64 + lane_id(); _Pragma("unroll") for (int _i = 0; _i < 2; ++_i) { int _R, _C; stage_rc(_tid * 16 + _i * 8192, _R, _C); \
        _Pragma("unroll") for (int _h = 0; _h < 2; ++_h) { unsigned _t = (unsigned)(u).tok[_h * HALF + _R]; _t = _t < (unsigned)NTOK ? _t : (unsigned)(NTOK - 1); GO[_h][_i] = _t * (unsigned)ldab + (unsigned)_C * 2u; } } } } while (0)
    Unit cur, nxt; int ui = 0;
    if (!S.next(0, cur)) return;
    f32x4 acc[2][2][4][2];
    { float z0_; asm volatile("v_mov_b32 %0, 0" : "=v"(z0_));
#pragma unroll
    for (int a = 0; a < 2; ++a)
#pragma unroll
        for (int b = 0; b < 2; ++b)
#pragma unroll
            for (int m = 0; m < 4; ++m)
#pragma unroll
                for (int n = 0; n < 2; ++n) acc[a][b][m][n] = (f32x4){z0_, z0_, z0_, z0_}; }
    i32x8 At[4], B0[2], B1[2];
    unsigned gC[2][2] = {{0u, 0u}, {0u, 0u}}, gN[2][2] = {{0u, 0u}, {0u, 0u}};
    PG8_GLOAD(gC, cur);
    const char* cA = cur.A; const char* cB = cur.B;
    bool cur8 = MIXED && cur.nt8 > 0; int ntc = cur8 ? cur.nt8 : nt;
    PG8_STAGEB(PG8_SB(0, 0), cB); PG8_STAGEB(PG8_SB(0, 1), cB + hstepB); PG8_STAGEA(PG8_SA(0, 0), cA, 0, gC); PG8_STAGEA(PG8_SA(0, 1), cA, 1, gC);
    if (wr == 1) PG8_BAR;
    PG8_WAIT_V(2); PG8_BAR;
    PG8_STAGEB(PG8_SB(1, 0), cB + kstep); PG8_STAGEA(PG8_SA(1, 0), cA + kstep, 0, gC); PG8_STAGEB(PG8_SB(1, 1), cB + hstepB + kstep);
    PG8_WAIT_V(6); PG8_BAR;
    for (;;) {
        const bool has_next = S.next(ui + 1, nxt);
        if (has_next) PG8_GLOAD(gN, nxt);
        const char* nA = has_next ? nxt.A : cA; const char* nB = has_next ? nxt.B : cB;
#pragma clang loop unroll(disable)
        for (int t = 0; t < ntc; t += 2) {
            const bool last = (t == ntc - 2);
            const char* a1 = cA + (size_t)(t + 1) * kstep;
            const char* a2 = last ? nA : cA + (size_t)(t + 2) * kstep; const char* b2 = last ? nB : cB + (size_t)(t + 2) * kstep;
            const char* a3 = a2 + kstep; const char* b3 = b2 + kstep;
            PG8_LDB(B0, 0, 0); PG8_LDB(B1, 0, 1); PG8_SCHED; PG8_LDA(At, 0, 0); PG8_STAGEA(PG8_SA(1, 1), a1, 1, gC);
            if (GATHER && last && has_next) {
#pragma unroll
                for (int _h = 0; _h < 2; ++_h)
#pragma unroll
                    for (int _i = 0; _i < 2; ++_i) gC[_h][_i] = gN[_h][_i];
            }
            PG8_WAIT_V(8); PG8_WAIT_L(0); PG8_BAR; PG8_MMA(0, 0, At, B0); PG8_MMA(0, 1, At, B1); PG8_BAR; PG8_SCHED;
            PG8_LDA(At, 0, 1); PG8_STAGEB(PG8_SB(0, 0), b2); PG8_STAGEB(PG8_SB(0, 1), b2 + hstepB); PG8_STAGEA(PG8_SA(0, 0), a2, 0, gC);
            PG8_WAIT_V(8); PG8_WAIT_L(0); PG8_BAR; PG8_MMA(1, 0, At, B0); PG8_MMA(1, 1, At, B1); PG8_BAR; PG8_SCHED;
            PG8_LDB(B0, 1, 0); PG8_LDB(B1, 1, 1); PG8_SCHED; PG8_LDA(At, 1, 0); PG8_STAGEA(PG8_SA(0, 1), a2, 1, gC);
            PG8_WAIT_V(8); PG8_WAIT_L(0); PG8_BAR; PG8_MMA(0, 0, At, B0); PG8_MMA(0, 1, At, B1); PG8_BAR; PG8_SCHED;
            PG8_LDA(At, 1, 1); PG8_STAGEB(PG8_SB(1, 0), b3); PG8_STAGEB(PG8_SB(1, 1), b3 + hstepB); PG8_STAGEA(PG8_SA(1, 0), a3, 0, gC);
            PG8_WAIT_V(8); PG8_WAIT_L(0); PG8_BAR; PG8_MMA(1, 0, At, B0); PG8_MMA(1, 1, At, B1); PG8_BAR; PG8_SCHED;
        }
        if (wr == 0) PG8_BAR;
        asm volatile("s_nop 15\n\ts_nop 7" ::: "memory");
        const int le_ = lane_id();
        const bool keep = E(acc, cur, wr, wc, le_ & 15, le_ >> 4);
        if (!has_next) break;
        if (!keep) {
        float z_; asm volatile("v_mov_b32 %0, 0" : "=v"(z_));
#pragma unroll
        for (int a = 0; a < 2; ++a)
#pragma unroll
            for (int b = 0; b < 2; ++b)
#pragma unroll
                for (int m = 0; m < 4; ++m)
#pragma unroll
                    for (int n = 0; n < 2; ++n) acc[a][b][m][n] = (f32x4){z_, z_, z_, z_};
        }
        cur = nxt; cA = nA; cB = nB; ++ui; cur8 = MIXED && cur.nt8 > 0; ntc = cur8 ? cur.nt8 : nt;
        if (wr == 1) PG8_BAR;
    }
    PG8_WAIT_V(0);
    PG8_BAR;
#undef PG8_SA
#undef PG8_SB
#undef PG8_DMA2
#undef PG8_STAGEA
#undef PG8_STAGEB
#undef PG8_LDA
#undef PG8_LDB
#undef PG8_MMA
#undef PG8_MMA8
#undef PG8_MMA16
#undef PG8_LD8
#undef PG8_LO
#undef PG8_HI
#undef PG8_WAIT_V
#undef PG8_WAIT_L
#undef PG8_BAR
#undef PG8_SCHED
#undef PG8_GLOAD
}
}
struct Args { const float* in[22]; float* out; unsigned char* ws; int ph_lo, ph_hi; };
enum { I_X = 0, I_C, I_WADA, I_BADA, I_GMIX, I_WIN, I_QNORM, I_KNORM, I_WAU, I_PLIN, I_PSCALE, I_WPU, I_WOUT, I_GFFN, I_WROUTER, I_RBIAS, I_W1, I_W3, I_W2, I_WS1, I_WS3, I_WS2 };
struct Frame {
    LAS unsigned char* lds;
    int wave, G, gw, NGW;
    unsigned char* ws; unsigned* ctl; float* out;
};
#define LDS_WAIT() asm volatile("s_waitcnt lgkmcnt(0)" ::: "memory")
#define VM_WAIT() asm volatile("s_waitcnt vmcnt(0)" ::: "memory")

__device__ __forceinline__ void tr8_issue(const float* __restrict__ src, int ld_src, int lane, f32x4 (&v)[16], int nvalid = 64) {
    const int q = lane >> 4, c4 = (lane & 15) * 4; const bool ok = c4 < nvalid;
    const unsigned voff = (unsigned)((16 * q) * ld_src + c4) * 4u;
#pragma unroll
    for (int j = 0; j < 16; ++j) v[j] = ok ? __builtin_nontemporal_load((const f32x4*)((const char*)src + (size_t)j * ld_src * 4 + voff)) : (f32x4){0.f, 0.f, 0.f, 0.f};
}
__device__ __forceinline__ void tr8_finish(unsigned char* __restrict__ dst, int ld_dst, int lane, const f32x4 (&v)[16]) {
    const int q = lane >> 4, c4 = (lane & 15) * 4;
#pragma unroll
    for (int nn = 0; nn < 4; ++nn) { u32x4 w;
#pragma unroll
        for (int t = 0; t < 4; ++t) w[t] = pk4_fp8(v[4 * t][nn] * W8_SCALE, v[4 * t + 1][nn] * W8_SCALE, v[4 * t + 2][nn] * W8_SCALE, v[4 * t + 3][nn] * W8_SCALE);
        __builtin_nontemporal_store(w, (u32x4*)(dst + (size_t)(c4 + nn) * ld_dst + 16 * q)); }
}
__device__ __forceinline__ void tr16_finish(bf16_t* __restrict__ dst, int ld_dst, int lane, const f32x4 (&v)[16]) {
    const int q = lane >> 4, c4 = (lane & 15) * 4;
#pragma unroll
    for (int nn = 0; nn < 4; ++nn) { u32x4 w0, w1;
#pragma unroll
        for (int t = 0; t < 4; ++t) { w0[t] = cvt_pk_bf16(v[2 * t][nn], v[2 * t + 1][nn]); w1[t] = cvt_pk_bf16(v[8 + 2 * t][nn], v[9 + 2 * t][nn]); }
        *(u32x4*)(dst + (size_t)(c4 + nn) * ld_dst + 16 * q) = w0; *(u32x4*)(dst + (size_t)(c4 + nn) * ld_dst + 16 * q + 8) = w1; }
}
__device__ __forceinline__ void p0_prologue(Frame& F, const Args& a) {
    LAS float* sc = (LAS float*)F.lds;
    const int lane = lane_id(), tid = F.wave * 64 + lane;
    for (int i = tid; i < NB * DM; i += NTHR) { const float c = a.in[I_C][i]; sc[i] = c / (1.0f + __expf(-c)); }
    __syncthreads();
    float* mod = (float*)(F.ctl + CW_MOD);
    unsigned char* ws = F.ws;
    float* adap = (float*)(ws + WS_Q);
    for (int job = blockIdx.x; job < 256; job += F.G) {
        const int kg = job >> 4, strip = job & 15, w = F.wave, row0 = 128 * kg + 16 * w;
        const float* wp = a.in[I_WADA] + (size_t)row0 * (6 * DM) + strip * 768 + 4 * lane;
        f32x4 b0[3], b1[3];
#pragma unroll
        for (int j = 0; j < 3; ++j) { b0[j] = (f32x4){0.f, 0.f, 0.f, 0.f}; b1[j] = (f32x4){0.f, 0.f, 0.f, 0.f}; }
#pragma unroll
        for (int h = 0; h < 2; ++h) { f32x4 v[8][3];
#pragma unroll
            for (int r = 0; r < 8; ++r)
#pragma unroll
                for (int j = 0; j < 3; ++j) v[r][j] = __builtin_nontemporal_load((const f32x4*)(wp + (size_t)(8 * h + r) * (6 * DM) + 256 * j));
#pragma unroll
            for (int r = 0; r < 8; ++r) { const float s0 = sc[row0 + 8 * h + r], s1 = sc[DM + row0 + 8 * h + r];
#pragma unroll
                for (int j = 0; j < 3; ++j) { b0[j] += v[r][j] * s0; b1[j] += v[r][j] * s1; } } }
        LAS float* part = (LAS float*)(F.lds + 16384);
#pragma unroll
        for (int j = 0; j < 3; ++j) { *(LAS f32x4*)(part + (w * 2 + 0) * 768 + 4 * lane + 256 * j) = b0[j]; *(LAS f32x4*)(part + (w * 2 + 1) * 768 + 4 * lane + 256 * j) = b1[j]; }
        __syncthreads();
#pragma unroll
        for (int i = 0; i < 3; ++i) { const int o = tid + 512 * i, b = o >= 768 ? 1 : 0, n = o - 768 * b; float sum = 0.f;
#pragma unroll
            for (int ww = 0; ww < 8; ++ww) sum += part[(ww * 2 + b) * 768 + n];
            __hip_atomic_store(adap + (size_t)(kg * 2 + b) * (6 * DM) + strip * 768 + n, sum, __ATOMIC_RELAXED, __HIP_MEMORY_SCOPE_AGENT); }
        VM_WAIT();
        __syncthreads();
        LAS unsigned* flag = (LAS unsigned*)(F.lds + 16384 + 49152);
        if (tid == 0) *flag = __hip_atomic_fetch_add(F.ctl + CW_ADAC + 16 * strip, 1u, __ATOMIC_ACQ_REL, __HIP_MEMORY_SCOPE_AGENT);
        __syncthreads();
        if (*flag == 15u) {
#pragma unroll
            for (int i = 0; i < 3; ++i) { const int o = tid + 512 * i, b = o >= 768 ? 1 : 0, n = o - 768 * b; float sum = a.in[I_BADA][strip * 768 + n];
#pragma unroll
                for (int kk = 0; kk < 16; ++kk) sum += __hip_atomic_load(adap + (size_t)(kk * 2 + b) * (6 * DM) + strip * 768 + n, __ATOMIC_RELAXED, __HIP_MEMORY_SCOPE_AGENT);
                __hip_atomic_store(mod + b * 6 * DM + strip * 768 + n, sum, __ATOMIC_RELAXED, __HIP_MEMORY_SCOPE_AGENT); }
            VM_WAIT();
            __syncthreads();
            if (tid == 0) __hip_atomic_fetch_add(F.ctl + CW_MODRDY, 1u, __ATOMIC_RELAXED, __HIP_MEMORY_SCOPE_AGENT);
        }
        __syncthreads();
    }
    unsigned char* Win8 = ws + WS_WIN;
    constexpr int J_IN_A = 32 * 40, J_IN_B = 32 * 4, J_IN_C = 32 * 80, J_AU = 16 * 32, J_PU = 16 * 32, J_OUT = 32 * 32, J_PL = 4 * 16, J_S13 = 2 * 32 * 8, J_S2 = 8 * 32, J_WR = 32,
                  J_W13 = 0, J_W2 = 0;
    constexpr int NITEMS = J_IN_A + J_IN_B + J_IN_C + J_AU + J_PU + J_OUT + J_PL + J_S13 + J_S2 + J_WR;
    struct CItem { const float* src; unsigned char* dst; int ld_src, ld_dst, nvalid; bool f8; };
    auto decode = [&](int r) -> CItem {
        CItem c; c.nvalid = 64;
        if (r < J_IN_A) { const int kb = r / 40, nb = r % 40; c.src = a.in[I_WIN] + (size_t)(64 * kb) * INW + 64 * nb; c.ld_src = INW; c.f8 = (nb >> 2) == 5;
            c.ld_dst = c.f8 ? 2 * DM : DM; c.dst = Win8 + ((size_t)(64 * nb) * c.ld_dst + 64 * kb) * (c.f8 ? 1 : 2); return c; } r -= J_IN_A;
        if (r < J_IN_B) { const int kb = r / 4, nb = r % 4; c.nvalid = nb == 0 ? 64 : (nb == 1 ? 16 : 0); c.src = a.in[I_WIN] + (size_t)(64 * kb) * INW + 2560 + (nb < 2 ? 64 * nb : 0); c.ld_src = INW; c.f8 = false;
            c.ld_dst = DM; c.dst = Win8 + ((size_t)(2560 + 64 * nb) * DM + 64 * kb) * 2; return c; } r -= J_IN_B;
        if (r < J_IN_C) { const int kb = r / 80, nb = r % 80; c.src = a.in[I_WIN] + (size_t)(64 * kb) * INW + 2640 + 64 * nb; c.ld_src = INW; c.f8 = true;
            c.ld_dst = 2 * DM; c.dst = Win8 + (size_t)(2816 + 64 * nb) * (2 * DM) + 64 * kb; return c; } r -= J_IN_C;
        if (r < J_AU) { const int kb = r / 32, nb = r % 32; c.src = a.in[I_WAU] + (size_t)(64 * kb) * DM + 64 * nb; c.ld_src = DM; c.f8 = FP8_MERGE; c.ld_dst = AW; c.dst = ws + WS_WAU + ((size_t)(64 * nb) * AW + 64 * kb) * (FP8_MERGE ? 1 : 2); return c; } r -= J_AU;
        if (r < J_PU) { const int kb = r / 32, nb = r % 32; c.src = a.in[I_WPU] + (size_t)(64 * kb) * DM + 64 * nb; c.ld_src = DM; c.f8 = FP8_MERGE; c.ld_dst = PW; c.dst = ws + WS_WPU + ((size_t)(64 * nb) * PW + 64 * kb) * (FP8_MERGE ? 1 : 2); return c; } r -= J_PU;
        if (r < J_OUT) { const int kb = r / 32, nb = r % 32; c.src = a.in[I_WOUT] + (size_t)(64 * kb) * DM + 64 * nb; c.ld_src = DM; c.f8 = FP8_OUT; c.ld_dst = DM; c.dst = ws + WS_WOUT + ((size_t)(64 * nb) * DM + 64 * kb) * (FP8_OUT ? 1 : 2); return c; } r -= J_OUT;
        if (r < J_PL) { const int g = r / 16, kb = (r % 16) / 4, nb = r % 4; c.src = a.in[I_PLIN] + (size_t)g * 65536 + (size_t)(64 * kb) * 256 + 64 * nb; c.ld_src = 256; c.f8 = false; c.ld_dst = 256;
            c.dst = ws + WS_PLIN + ((size_t)g * 65536 + (size_t)(64 * nb) * 256 + 64 * kb) * 2; return c; } r -= J_PL;
        if (r < J_S13) { const int which = r / 256, kb = (r % 256) / 8, nb = r % 8; c.src = (which ? a.in[I_WS3] : a.in[I_WS1]) + (size_t)(64 * kb) * EH + 64 * nb; c.ld_src = EH; c.f8 = true; c.ld_dst = DM;
            c.dst = ws + WS_WS13 + (size_t)(256 * (nb >> 1) + 64 * (nb & 1) + 128 * which) * DM + 64 * kb; return c; } r -= J_S13;
        if (r < J_S2) { const int kb = r / 32, nb = r % 32; c.src = a.in[I_WS2] + (size_t)(64 * kb) * DM + 64 * nb; c.ld_src = DM; c.f8 = true; c.ld_dst = EH; c.dst = ws + WS_WS2 + (size_t)(64 * nb) * EH + 64 * kb; return c; } r -= J_S2;
        { const int kb = r; c.src = a.in[I_WROUTER] + (size_t)(64 * kb) * NE; c.ld_src = NE; c.f8 = false; c.ld_dst = DM; c.dst = ws + WS_WR + (size_t)(64 * kb) * 2; return c; }
    };
    auto finish = [&](const CItem& c, const f32x4 (&v)[16]) { if (c.f8) tr8_finish(c.dst, c.ld_dst, lane, v); else tr16_finish((bf16_t*)c.dst, c.ld_dst, lane, v); };
    int it = F.gw;
    if (it < NITEMS) {
        f32x4 va[16], vb[16]; CItem ca = decode(it), cb = ca; tr8_issue(ca.src, ca.ld_src, lane, va, ca.nvalid);
        for (;;) {
            int itn = it + F.NGW; bool hn = itn < NITEMS;
            if (hn) { cb = decode(itn); tr8_issue(cb.src, cb.ld_src, lane, vb, cb.nvalid); }
            finish(ca, va);
            if (!hn) break;
            it = itn; itn = it + F.NGW; hn = itn < NITEMS;
            if (hn) { ca = decode(itn); tr8_issue(ca.src, ca.ld_src, lane, va, ca.nvalid); }
            finish(cb, vb);
            if (!hn) break;
            it = itn;
        }
    }
}

constexpr int NCONV_W13 = NE * 2 * 32 * 8, NCONV = NCONV_W13 + NE * 8 * 32;
__device__ __forceinline__ void conv_ptrs(const Args& a, unsigned char* ws, int it, const float*& src, int& ld_src, unsigned char*& dst, int& ld_dst) {
    if (it < NCONV_W13) { const int e = it / 512, rr = it % 512, which = rr / 256, q = rr % 256, kb = 2 * (q >> 4) + (q & 1), nb = 4 * ((q >> 3) & 1) + ((q >> 1) & 3);
        src = (which ? a.in[I_W3] : a.in[I_W1]) + ((size_t)e * DM + 64 * kb) * EH + 64 * nb; ld_src = EH;
        dst = ws + WS_W13 + ((size_t)e * 1024 + 256 * (nb >> 1) + 64 * (nb & 1) + 128 * which) * DM + 64 * kb; ld_dst = DM; }
    else { const int r = it - NCONV_W13, e = r / 256, q = r % 256, kb = 2 * (q >> 6) + (q & 1), nb = (q >> 1) & 31;
        src = a.in[I_W2] + ((size_t)e * EH + 64 * kb) * DM + 64 * nb; ld_src = DM; dst = ws + WS_W2 + ((size_t)e * DM + 64 * nb) * EH + 64 * kb; ld_dst = EH; }
}
__device__ __forceinline__ void conv_issue16(const Args& a, unsigned char* ws, int it, int lane, f32x4 (&v)[16]) {
    const float* src; int ld_src; unsigned char* dst; int ld_dst; conv_ptrs(a, ws, it, src, ld_src, dst, ld_dst); tr8_issue(src, ld_src, lane, v); }
__device__ __forceinline__ void conv_finish16(const Args& a, unsigned char* ws, int it, int lane, const f32x4 (&v)[16]) {
    const float* src; int ld_src; unsigned char* dst; int ld_dst; conv_ptrs(a, ws, it, src, ld_src, dst, ld_dst); tr8_finish(dst, ld_dst, lane, v); }
__device__ __forceinline__ void phase_done(Frame& F, int phase) { __syncthreads(); if (F.wave == 0 && lane_id() == 0) __hip_atomic_fetch_add(F.ctl + CW_DONE + 64 * phase, 1u, __ATOMIC_RELAXED, __HIP_MEMORY_SCOPE_AGENT); }
constexpr int CONV_SEG1_END = NCONV_W13 + (NCONV - NCONV_W13) * 3 / 10 / 8 * 8;
__device__ __forceinline__ unsigned conv_seg_lo(int sg) { return sg == 0 ? 0u : (sg == 1 ? (unsigned)NCONV_W13 : (unsigned)CONV_SEG1_END); }
__device__ __forceinline__ unsigned conv_seg_hi(int sg) { return sg == 0 ? (unsigned)NCONV_W13 : (sg == 1 ? (unsigned)CONV_SEG1_END : (unsigned)NCONV); }
template <bool BOUNDED, int SEG_LO, int SEG_HI>
struct ConvQ {
    Frame& F; int phase, lane; unsigned cur, end; int sg; unsigned thr;
    unsigned pk;
    __device__ __forceinline__ int next() {
        constexpr unsigned B = BOUNDED ? 6u : 8u;
        while (cur >= end) {
            if (BOUNDED) { const unsigned d = __hip_atomic_load(F.ctl + CW_DONE + 64 * phase, __ATOMIC_RELAXED, __HIP_MEMORY_SCOPE_AGENT); if ((unsigned)__builtin_amdgcn_readfirstlane(d) >= thr) return -1; }
            const unsigned lo = conv_seg_lo(sg), hi = conv_seg_hi(sg);
            if (!((pk >> sg) & 1u)) {
                pk |= 1u << sg; const unsigned hd = (unsigned)__builtin_amdgcn_readfirstlane(__hip_atomic_load(F.ctl + CW_CONVQ + 64 * sg, __ATOMIC_RELAXED, __HIP_MEMORY_SCOPE_AGENT));
                if (lo + hd >= hi) { if (sg < SEG_HI) { ++sg; continue; } return -1; } }
            unsigned s = 0; if (lane == 0) s = __hip_atomic_fetch_add(F.ctl + CW_CONVQ + 64 * sg, B, __ATOMIC_RELAXED, __HIP_MEMORY_SCOPE_AGENT);
            s = (unsigned)__builtin_amdgcn_readfirstlane(s) + lo;
            if (s >= hi) { if (sg < SEG_HI) { ++sg; continue; } return -1; }
            cur = s; end = s + B < hi ? s + B : hi;
        }
        return (int)cur++;
    }
};
template <bool BOUNDED, int SEG_LO, int SEG_HI>
__device__ __forceinline__ void conv_drain(Frame& F, const Args& a, int phase, int quota = 0, unsigned thr = 0u) {
    const int lane = lane_id();
    ConvQ<BOUNDED, SEG_LO, SEG_HI> Q{F, phase, lane, 0u, 0u, SEG_LO, thr ? thr : (unsigned)F.G, 0u};
    f32x4 va[16], vb[16]; int n = 0;
    int ia = Q.next(); if (ia < 0) return;
    conv_issue16(a, F.ws, ia, lane, va);
    for (;;) {
        ++n; const int ib = (quota > 0 && n >= quota && Q.cur >= Q.end) ? -1 : Q.next(); if (ib >= 0) conv_issue16(a, F.ws, ib, lane, vb);
        conv_finish16(a, F.ws, ia, lane, va);
        if (ib < 0) break;
        ++n; ia = (quota > 0 && n >= quota && Q.cur >= Q.end) ? -1 : Q.next(); if (ia >= 0) conv_issue16(a, F.ws, ia, lane, va);
        conv_finish16(a, F.ws, ib, lane, vb);
        if (ia < 0) break;
    }
}

__device__ __forceinline__ void mod_wait(Frame& F) {
    if (F.wave == 0) {
        while (__builtin_amdgcn_readfirstlane(__hip_atomic_load(F.ctl + CW_MODRDY, __ATOMIC_RELAXED, __HIP_MEMORY_SCOPE_AGENT)) < 16u) __builtin_amdgcn_s_sleep(2);
        __builtin_amdgcn_fence(__ATOMIC_ACQUIRE, "agent");
    }
    VM_WAIT();
    __syncthreads();
}
__device__ __forceinline__ void modnorm_row(const float* __restrict__ xrow, const float* __restrict__ g, const float* __restrict__ shift, const float* __restrict__ scale, unsigned char* __restrict__ orow, unsigned char* __restrict__ orow8, int lane) {
    f32x4 v[8]; float ss = 0.f;
#pragma unroll
    for (int j = 0; j < 8; ++j) { v[j] = *(const f32x4*)(xrow + 4 * lane + 256 * j); ss += (v[j].x * v[j].x + v[j].y * v[j].y) + (v[j].z * v[j].z + v[j].w * v[j].w); }
    const float rstd = rsqrtf(wave_sum(ss) * (1.0f / DM) + NORM_EPS);
#pragma unroll
    for (int j = 0; j < 8; ++j) { const int c = 4 * lane + 256 * j;
        const f32x4 gg = *(const f32x4*)(g + c), sh = *(const f32x4*)(shift + c), sl = *(const f32x4*)(scale + c);
        const f32x4 o = v[j] * rstd * gg * (sl + 1.0f) + sh;
        { u32x2 w; w.x = cvt_pk_bf16(o.x, o.y); w.y = cvt_pk_bf16(o.z, o.w); *(u32x2*)((bf16_t*)orow + c) = w; }
        if (orow8) *(unsigned*)(orow8 + c) = pk4_fp8(o.x * A8_SCALE, o.y * A8_SCALE, o.z * A8_SCALE, o.w * A8_SCALE); }
}
__device__ __forceinline__ void p1_h(Frame& F, const Args& a) {
    const float* mod = (const float*)(F.ctl + CW_MOD);
    unsigned char* hb = F.ws + WS_HB; const int lane = lane_id();
    for (int m0 = 2 * F.gw; m0 < NTOK; m0 += 2 * F.NGW) {
        f32x4 v[2][8];
#pragma unroll
        for (int rr = 0; rr < 2; ++rr)
#pragma unroll
            for (int j = 0; j < 8; ++j) v[rr][j] = __builtin_nontemporal_load((const f32x4*)(a.in[I_X] + (size_t)(m0 + rr) * DM + 4 * lane + 256 * j));
        const int b = m0 / SEQ; const float* sh = mod + b * 6 * DM; const float* sl = mod + b * 6 * DM + DM;
        f32x4 mulv[8], shvv[8];
#pragma unroll
        for (int j = 0; j < 8; ++j) { const int c = 4 * lane + 256 * j; const f32x4 gg = *(const f32x4*)(a.in[I_GMIX] + c), slv = *(const f32x4*)(sl + c); shvv[j] = *(const f32x4*)(sh + c); mulv[j] = gg * (slv + 1.0f); }
        float rstd[2];
#pragma unroll
        for (int rr = 0; rr < 2; ++rr) { float ss = 0.f;
#pragma unroll
            for (int j = 0; j < 8; ++j) ss += (v[rr][j].x * v[rr][j].x + v[rr][j].y * v[rr][j].y) + (v[rr][j].z * v[rr][j].z + v[rr][j].w * v[rr][j].w);
            rstd[rr] = rsqrtf(wave_sum(ss) * (1.0f / DM) + NORM_EPS); }
#pragma unroll
        for (int j = 0; j < 8; ++j) { const int c = 4 * lane + 256 * j;
            const f32x4 mul = mulv[j], shv = shvv[j];
#pragma unroll
            for (int rr = 0; rr < 2; ++rr) { const f32x4 o = v[rr][j] * rstd[rr] * mul + shv; const size_t ro = (size_t)(m0 + rr) * DM * 2;
                u32x2 w; w.x = cvt_pk_bf16(o.x, o.y); w.y = cvt_pk_bf16(o.z, o.w); *(u32x2*)((bf16_t*)(hb + ro) + c) = w;
                *(unsigned*)(F.ws + WS_H8 + ro + c) = pk4_fp8(o.x * A8_SCALE, o.y * A8_SCALE, o.z * A8_SCALE, o.w * A8_SCALE); } }
    }
}
struct SchedDense {
    pg8::TileOrder T; const char* A; const char* B; size_t a_tile, b_tile;
    __device__ __forceinline__ bool next(int i, pg8::Unit& u) const { int pm, pn; if (!T.tile(i, pm, pn)) return false; u.pm = pm; u.pn = pn; u.aux = 0; u.tok = nullptr; u.nt8 = 0;
        u.A = A + (size_t)pm * a_tile; u.B = B + (size_t)pn * b_tile; return true; }
};
__device__ __forceinline__ void st_bf16x8(bf16_t* p, f32x4 v0, f32x4 v1) { u32x4 w; w.x = cvt_pk_bf16(v0[0], v0[1]); w.y = cvt_pk_bf16(v0[2], v0[3]); w.z = cvt_pk_bf16(v1[0], v1[1]); w.w = cvt_pk_bf16(v1[2], v1[3]); *(u32x4*)p = w; }
struct EpiInproj {
    unsigned char* ws;
    __device__ __forceinline__ bool operator()(f32x4 (&acc)[2][2][4][2], const pg8::Unit& u, int wr, int wc, int fr, int fq) const {
        const int pn = u.pn; bf16_t* base; int ld, ct; bool sig = false;
        if (pn < 4) { base = (bf16_t*)(ws + WS_Q); ld = AW; ct = pn; }
        else if (pn == 4) { base = (bf16_t*)(ws + WS_K); ld = KVW; ct = 0; }
        else if (pn == 5) { base = (bf16_t*)(ws + WS_V); ld = KVW; ct = 0; }
        else if (pn < 10) { base = (bf16_t*)(ws + WS_QI); ld = IH * ID; ct = pn - 6; }
        else if (pn == 10) { base = (bf16_t*)(ws + WS_KW); ld = 256; ct = 0; }
        else if (pn < 15) { base = (bf16_t*)(ws + WS_U); ld = PW; ct = pn - 11; }
        else { base = (bf16_t*)(ws + WS_G); ld = 2 * DM; ct = pn - 15; sig = true; }
        const int row0 = u.pm * 256 + wr * 64 + fr, col0 = ct * 256 + wc * 32 + 8 * fq;
#pragma unroll
        for (int ai = 0; ai < 2; ++ai)
#pragma unroll
            for (int m = 0; m < 4; ++m) { bf16_t* rowp = base + (size_t)(row0 + ai * 128 + m * 16) * ld + col0;
#pragma unroll
                for (int bj = 0; bj < 2; ++bj) { f32x4 v0 = acc[ai][bj][m][0], v1 = acc[ai][bj][m][1];
                    if (sig) {
#pragma unroll
                        for (int j = 0; j < 4; ++j) { v0[j] = fminf(__builtin_amdgcn_rcpf(1.0f + __expf(-v0[j])), 1.0f); v1[j] = fminf(__builtin_amdgcn_rcpf(1.0f + __expf(-v1[j])), 1.0f); } }
                    if (sig) { u32x4 w; w.x = cvt_pk_bf16(v0[0], v0[1]); w.y = cvt_pk_bf16(v0[2], v0[3]); w.z = cvt_pk_bf16(v1[0], v1[1]); w.w = cvt_pk_bf16(v1[2], v1[3]); __builtin_nontemporal_store(w, (u32x4*)(rowp + bj * 128)); }
                    else st_bf16x8(rowp + bj * 128, v0, v1); } }
        return false;
    }
};
struct SchedInproj {
    int G, c, kind; const char* hA; const char* win;
    __device__ __forceinline__ bool next(int i, pg8::Unit& u) const {
        const int first = kind == 0 ? c : c + ((320 - c + G - 1) / G) * G;
        const int j = first + i * G; if (j >= (kind == 0 ? 320 : 992)) return false;
        int pn, pm;
        if (kind == 0) { const int t = j >> 5; pm = j & 31; pn = t < 5 ? t : t + 1; }
        else { const int jj = j - 320, t = jj >> 5; pm = jj & 31; pn = t == 0 ? 5 : t + 10; }
        u.pm = pm; u.pn = pn; u.aux = 0; u.tok = nullptr; u.nt8 = 0;
        u.A = hA + (size_t)pm * 256 * DM * 2; u.B = win + (size_t)pn * 256 * DM * 2; return true; }
};
__device__ __forceinline__ void p2_inproj(Frame& F, const Args& a) {
    const int NG = F.G >= 256 ? 248 : F.G;
    if ((int)blockIdx.x >= NG) { conv_drain<false, 0, 2>(F, a, 2, 16); return; }
    EpiInproj E{F.ws};
    { SchedInproj S{NG, (int)blockIdx.x, 0, (const char*)(F.ws + WS_HB), (const char*)(F.ws + WS_WIN)};
      pg8::gemm_phase<EpiInproj, SchedInproj, false, 2>(F.lds, F.wave, DM * 2, DM * 2, S, E); }
    { SchedInproj S{NG, (int)blockIdx.x, 1, (const char*)(F.ws + WS_H8), (const char*)(F.ws + WS_WIN)};
      pg8::gemm_phase<EpiInproj, SchedInproj, false, 1, A8_E8, W8_E8>(F.lds, F.wave, DM * 2, DM * 2, S, E, DM / 128); }
}
__device__ __forceinline__ void p3_qknorm(Frame& F, const Args& a) {
    bf16_t* K = (bf16_t*)(F.ws + WS_K);
    const int lane = lane_id();
    const int dk = (4 * lane) & 127;
    const f32x4 kn = *(const f32x4*)(a.in[I_KNORM] + dk);
    for (int m0 = F.gw; m0 < NTOK; m0 += 4 * F.NGW) {
        u32x2 k0[4];
#pragma unroll
        for (int i = 0; i < 4; ++i) { const int m = m0 + i * F.NGW; k0[i] = m < NTOK ? *(const u32x2*)(K + (size_t)m * KVW + 4 * lane) : (u32x2){0u, 0u}; }
#pragma unroll
        for (int i = 0; i < 4; ++i) { const int m = m0 + i * F.NGW;
            float kv[4]; float sk = 0.f;
            kv[0] = bflo(k0[i][0]); kv[1] = bfhi(k0[i][0]); kv[2] = bflo(k0[i][1]); kv[3] = bfhi(k0[i][1]);
#pragma unroll
            for (int j = 0; j < 4; ++j) sk += kv[j] * kv[j];
            sk += __shfl_xor(sk, 1); sk += __shfl_xor(sk, 2); sk += __shfl_xor(sk, 4); sk += __shfl_xor(sk, 8); sk += __shfl_xor(sk, 16);
            const float rk = rsqrtf(sk * (1.0f / HD) + NORM_EPS);
            u32x2 ok; ok[0] = cvt_pk_bf16(kv[0] * rk * kn[0], kv[1] * rk * kn[1]); ok[1] = cvt_pk_bf16(kv[2] * rk * kn[2], kv[3] * rk * kn[3]);
            if (m < NTOK) *(u32x2*)(K + (size_t)m * KVW + 4 * lane) = ok; }
    }
}
__device__ __forceinline__ void pooled_item(Frame& F, int t0, int g, int lane) {
    const bf16_t* U = (const bf16_t*)(F.ws + WS_U); bf16_t* P = (bf16_t*)(F.ws + WS_POOLED);
    const int pos0 = t0 % SEQ, w = 2 << g, c = 256 * g + 4 * lane;
    f32x4 W = {0.f, 0.f, 0.f, 0.f};
    { u32x2 wv[16];
#pragma unroll
      for (int j = 1; j <= 16; ++j) { const bool ok = j <= w && pos0 - j >= 0; wv[j - 1] = *(const u32x2*)(U + (size_t)(ok ? t0 - j : t0) * PW + c); }
#pragma unroll
      for (int j = 1; j <= 16; ++j) { const float f = (j <= w && pos0 - j >= 0) ? 1.0f : 0.0f; const u32x2 v = wv[j - 1]; W += (f32x4){bflo(v[0]), bfhi(v[0]), bflo(v[1]), bfhi(v[1])} * f; } }
#pragma unroll 8
    for (int i = 0; i < 32; ++i) { const int t = t0 + i, pos = pos0 + i;
        const u32x2 v = *(const u32x2*)(U + (size_t)t * PW + c); const f32x4 cur = {bflo(v[0]), bfhi(v[0]), bflo(v[1]), bfhi(v[1])};
        W += cur;
        { const bool ok = pos - w >= 0; const u32x2 o = *(const u32x2*)(U + (size_t)(ok ? t - w : t) * PW + c); W -= (f32x4){bflo(o[0]), bfhi(o[0]), bflo(o[1]), bfhi(o[1])} * (ok ? 1.0f : 0.0f); }
        const float inv = 1.0f / (float)(pos + 1 < w ? pos + 1 : w);
        const f32x4 r = W * inv - cur;
        u32x2 ow; ow[0] = cvt_pk_bf16(r[0], r[1]); ow[1] = cvt_pk_bf16(r[2], r[3]);
        *(u32x2*)(P + (size_t)t * PW + c) = ow; }
}
__device__ __forceinline__ unsigned mono_key(float s) { const unsigned u = __float_as_uint(s); return (u & 0x80000000u) ? ~u : (u | 0x80000000u); }
__device__ __forceinline__ void idx_block(Frame& F, const Args& a, int b, int i16) {
    const bf16_t* QI = (const bf16_t*)(F.ws + WS_QI); const bf16_t* KW = (const bf16_t*)(F.ws + WS_KW);
    unsigned short* MT = (unsigned short*)(F.ws + WS_MASK);
    LAS unsigned* T = (LAS unsigned*)F.lds;
    const int lane = lane_id(), w = F.wave, tid = w * 64 + lane, r32 = lane & 31, hi = lane >> 5;
    const int tpos0 = 16 * i16, t0 = b * SEQ + tpos0, nh = (tpos0 + 16 + 31) >> 5, kzero = 64 * ((tpos0 >> 6) + 1);
    for (int k = tid; k < kzero; k += NTHR) T[k] = 0u;
    bf16x8 Af[4];
    { const int qsel = (r32 >> 2) & 1, head = (r32 & 3) + 4 * (r32 >> 3); const size_t tq = (size_t)(t0 + 2 * w + qsel);
      const float wv = bf2f(KW[tq * 256 + 64 + head]);
#pragma unroll
      for (int s = 0; s < 4; ++s) { const u32x4 q = *(const u32x4*)(QI + tq * (IH * ID) + head * ID + 16 * s + 8 * hi); u32x4 o;
#pragma unroll
          for (int j = 0; j < 4; ++j) o[j] = cvt_pk_bf16(bflo(q[j]) * wv, bfhi(q[j]) * wv);
          Af[s] = __builtin_bit_cast(bf16x8, o); } }
    float X[16];
    { const size_t tq = (size_t)(t0 + 2 * w + hi); const u32x4 w0 = *(const u32x4*)(KW + tq * 256 + 64), w1 = *(const u32x4*)(KW + tq * 256 + 72);
      const float PINF = __builtin_inff();
#pragma unroll
      for (int j = 0; j < 4; ++j) { X[2 * j] = bflo(w0[j]) >= 0.f ? PINF : -PINF; X[2 * j + 1] = bfhi(w0[j]) >= 0.f ? PINF : -PINF;
                                    X[8 + 2 * j] = bflo(w1[j]) >= 0.f ? PINF : -PINF; X[8 + 2 * j + 1] = bfhi(w1[j]) >= 0.f ? PINF : -PINF; } }
    const int mypos = tpos0 + 2 * w + hi;
    unsigned keys[128];
    constexpr int RING = 16384, SLOT = 8192;
    const int nt64 = (nh + 1) >> 1;
    const unsigned dvoff = (unsigned)((lane >> 3) * 512 + (((lane & 7) ^ (lane >> 3)) << 4));
    const char* kwb = (const char*)(KW + (size_t)b * SEQ * 256) + w * 4096;
    const unsigned ldsw = (unsigned)(uintptr_t)F.lds + RING + w * 1024;
#define IDX_DMA(t_) do { unsigned keep_; asm volatile("s_mov_b32 %0, m0\n\ts_mov_b32 m0, %3\n\ts_nop 0\n\tglobal_load_lds_dwordx4 %1, %2\n\ts_mov_b32 m0, %0" \
        : "=&s"(keep_) : "v"(dvoff), "s"(kwb + (size_t)(t_) * 32768), "s"(ldsw + (unsigned)(((t_) & 3) * SLOT)) : "memory"); } while (0)
    int boffs[4];
#pragma unroll
    for (int s = 0; s < 4; ++s) boffs[s] = r32 * 128 + ((((2 * s + hi) ^ (r32 & 7))) << 4);
    __syncthreads();
    if (0 < nt64) IDX_DMA(0);
    if (1 < nt64) IDX_DMA(1);
    if (2 < nt64) IDX_DMA(2);
#pragma unroll
    for (int t = 0; t < 64; ++t) {
        keys[2 * t] = 0u; keys[2 * t + 1] = 0u;
        if (t < nt64) {
            const int rem = nt64 - 1 - t;
            if (rem >= 2) asm volatile("s_waitcnt vmcnt(2)" ::: "memory"); else if (rem == 1) asm volatile("s_waitcnt vmcnt(1)" ::: "memory"); else asm volatile("s_waitcnt vmcnt(0)" ::: "memory");
            __builtin_amdgcn_s_barrier(); asm volatile("" ::: "memory");
            if (t + 3 < nt64) IDX_DMA(t + 3);
#pragma unroll
            for (int half = 0; half < 2; ++half) { const int n = 2 * t + half;
                if (n < nh) {
                    f32x16 acc = {0.f, 0.f, 0.f, 0.f, 0.f, 0.f, 0.f, 0.f, 0.f, 0.f, 0.f, 0.f, 0.f, 0.f, 0.f, 0.f};
#pragma unroll
                    for (int s = 0; s < 4; ++s) { const bf16x8 bfr = *(const LAS bf16x8*)(F.lds + RING + (t & 3) * SLOT + half * 4096 + boffs[s]);
                        acc = __builtin_amdgcn_mfma_f32_32x32x16_bf16(Af[s], bfr, acc, 0, 0, 0); }
                    float sc = 0.f;
#pragma unroll
                    for (int j = 0; j < 16; ++j) sc += __builtin_amdgcn_fmed3f(acc[j], 0.f, X[j]);
                    keys[n] = (32 * n + r32 <= mypos) ? mono_key(sc) : 0u;
                } }
        }
    }
#undef IDX_DMA
    { unsigned kmn = 0xffffffffu, kmx = 0u;
#pragma unroll
      for (int n8 = 0; n8 < 16; ++n8) { if (n8 * 8 < nh) {
#pragma unroll
          for (int j = 0; j < 8; ++j) { const unsigned k1 = keys[n8 * 8 + j] - 1u; kmn = kmn < k1 ? kmn : k1; kmx = kmx > keys[n8 * 8 + j] ? kmx : keys[n8 * 8 + j]; } } }
#pragma unroll
      for (int d = 1; d < 32; d <<= 1) { const unsigned a1 = __shfl_xor(kmn, d), a2 = __shfl_xor(kmx, d); kmn = kmn < a1 ? kmn : a1; kmx = kmx > a2 ? kmx : a2; }
      const unsigned kmin = kmn + 1u, D = kmx - kmin;
      const int lz = D ? __builtin_clz(D) : 32; const unsigned sft = (unsigned)(lz > 0 ? lz - 1 : 0);
#pragma unroll
      for (int n8 = 0; n8 < 16; ++n8) { if (n8 * 8 < nh) {
#pragma unroll
          for (int j = 0; j < 8; ++j) { const unsigned k = keys[n8 * 8 + j]; keys[n8 * 8 + j] = k ? ((k - kmin) << sft) + 1u : 0u; } } }
    }
    unsigned Tsel = 0u;
    { constexpr int HIST = 49152;
      LAS unsigned* hb = (LAS unsigned*)(F.lds + HIST) + (2 * w + hi) * 512;
      const unsigned hbb = (unsigned)(uintptr_t)hb, one_ = 1u;
      unsigned kk = (unsigned)TOPK; bool alive = true;
#pragma unroll 1
      for (int p = 0; p < 4; ++p) { const int sh = 24 - 8 * p;
          *(LAS u32x4*)(hb + 8 * r32) = (u32x4){0u, 0u, 0u, 0u}; *(LAS u32x4*)(hb + 8 * r32 + 4) = (u32x4){0u, 0u, 0u, 0u};
          asm volatile("s_waitcnt lgkmcnt(0)" ::: "memory");
          if (p == 0) {
#pragma unroll
              for (int n8 = 0; n8 < 16; ++n8) { if (n8 * 8 < nh) {
#pragma unroll
                  for (int j = 0; j < 8; ++j) { const unsigned key = keys[n8 * 8 + j];
                      unsigned long long sv_; unsigned tm_;
                      asm volatile("v_cmp_ne_u32_e32 vcc, 0, %2\n\tv_bfe_u32 %1, %2, 24, 8\n\tv_lshl_or_b32 %1, %1, 2, %3\n\ts_and_saveexec_b64 %0, vcc\n\tds_add_u32 %1, %4\n\ts_mov_b64 exec, %0"
                                   : "=&s"(sv_), "=&v"(tm_) : "v"(key), "v"(hbb), "v"(one_) : "vcc", "memory"); } } }
          } else {
              const unsigned PM = 0xffffffffu << ((sh + 8) & 31), TP = Tsel & PM;
#pragma unroll
              for (int n8 = 0; n8 < 16; ++n8) { if (n8 * 8 < nh) {
#pragma unroll
                  for (int j = 0; j < 8; ++j) { const unsigned key = keys[n8 * 8 + j];
                      unsigned long long sv_; unsigned tm_;
                      asm volatile("v_and_b32_e32 %1, %2, %4\n\tv_cmp_eq_u32_e32 vcc, %3, %1\n\tv_bfe_u32 %1, %4, %7, 8\n\tv_lshl_or_b32 %1, %1, 2, %5\n\ts_and_saveexec_b64 %0, vcc\n\tds_add_u32 %1, %6\n\ts_mov_b64 exec, %0"
                                   : "=&s"(sv_), "=&v"(tm_) : "s"(PM), "s"(TP), "v"(key), "v"(hbb), "v"(one_), "s"(sh) : "vcc", "memory"); } } }
          }
          asm volatile("s_waitcnt lgkmcnt(0)" ::: "memory");
          const u32x4 c0 = *(const LAS u32x4*)(hb + 8 * r32), c1 = *(const LAS u32x4*)(hb + 8 * r32 + 4);
          const unsigned cb[8] = {c0[0], c0[1], c0[2], c0[3], c1[0], c1[1], c1[2], c1[3]};
          unsigned S = 0;
#pragma unroll
          for (int j = 0; j < 8; ++j) S += cb[j];
          unsigned suf = S;
#pragma unroll
          for (int d = 1; d < 32; d <<= 1) { const unsigned y = __shfl_down(suf, d, 32); if (r32 + d < 32) suf += y; }
          const unsigned total = __shfl(suf, 0, 32), sufx = suf - S;
          if (alive && total < kk) alive = false;
          const bool mine = alive && sufx < kk && kk <= suf;
          unsigned acc = sufx, bsel = 0u, above = 0u; bool found = false;
#pragma unroll
          for (int j = 7; j >= 0; --j) { if (!found) { if (acc + cb[j] >= kk) { found = true; bsel = (unsigned)(8 * r32 + j); above = acc; } else acc += cb[j]; } }
          const unsigned long long bm = __ballot(mine);
          const unsigned half = hi ? (unsigned)(bm >> 32) : (unsigned)bm;
          const int src = half ? (__builtin_ctz(half) + 32 * hi) : lane;
          const unsigned bs = __shfl(bsel, src), ab = __shfl(above, src);
          if (alive) { Tsel |= bs << sh; kk -= ab; }
      }
      if (!alive) Tsel = 0u;
    }
    { const unsigned Tf = Tsel > 1u ? Tsel : 1u;
      __syncthreads();
#pragma unroll
      for (int n8 = 0; n8 < 16; ++n8) { if (n8 * 8 < nh) {
#pragma unroll
          for (int j = 0; j < 8; ++j) { const int n = n8 * 8 + j;
              const unsigned long long bm = __ballot(keys[n] >= Tf);
              const unsigned bitv = (((unsigned)bm >> r32) & 1u) | ((((unsigned)(bm >> 32) >> r32) & 1u) << 1);
              if (hi == 0 && bitv) __hip_atomic_fetch_or(T + 32 * n + r32, bitv << (2 * w), __ATOMIC_RELAXED, __HIP_MEMORY_SCOPE_WORKGROUP); } } }
    }
    __syncthreads();
    { const int rg = (b * SEQ + tpos0) >> 5, f = i16 & 1;
      for (int k = tid; k < kzero; k += NTHR) { const int kk = k & 63, p = (kk & ~7) | ((kk & 3) << 1) | ((kk >> 2) & 1);
          MT[((size_t)(rg * 64 + (k >> 6)) * 64 + p) * 2 + f] = (unsigned short)(T[k] & 0xffffu); } }
    __syncthreads();
}
#ifndef P3_CONV
#define P3_EARLY 48
#define P3_CONV 56
#endif
constexpr int CW_P3Q = 14720;
__device__ __forceinline__ void p3_indexer(Frame& F, const Args& a) {
    const int NCV = F.G >= 256 ? P3_CONV : 0;
    if ((int)blockIdx.x >= F.G - NCV) { conv_drain<true, 0, 2>(F, a, 3, 0, 512u - P3_EARLY); return; }
    LAS int* qn = (LAS int*)(F.lds + 90112);
    const bool lead = F.wave == 0 && lane_id() == 0;
    if (lead) qn[0] = (int)__hip_atomic_fetch_add(F.ctl + CW_P3Q, 1u, __ATOMIC_RELAXED, __HIP_MEMORY_SCOPE_AGENT);
    __syncthreads();
    for (;;) {
        const int q = __builtin_amdgcn_readfirstlane(qn[0]);
        if (q >= 512) break;
        unsigned nx = 0u;
        if (lead) nx = __hip_atomic_fetch_add(F.ctl + CW_P3Q, 1u, __ATOMIC_RELAXED, __HIP_MEMORY_SCOPE_AGENT);
        idx_block(F, a, q & 1, 255 - (q >> 1));
        if (lead) { qn[0] = (int)nx; __hip_atomic_fetch_add(F.ctl + CW_DONE + 64 * 3, 1u, __ATOMIC_RELAXED, __HIP_MEMORY_SCOPE_AGENT); }
        __syncthreads();
    }
}
namespace att {
constexpr int KVBLK = 64, SHM_V = KVBLK * HD * 2, SHM_K = KVBLK * HD * 2;
constexpr int LDS_V = 0, LDS_K = 2 * SHM_V, LDS_WS = 2 * SHM_V + 2 * SHM_K, LDS_BYTES = LDS_WS + NWAVES * 64 * 4;
constexpr float THR = 8.f, LOG2E = 1.4426950408889634f;
#define KSWZ(row, colB) ((row) * 256 + ((colB) ^ (((row) & 7) << 4)))
#define SBAR() __builtin_amdgcn_sched_barrier(0)
__device__ __forceinline__ int v_st(int k, int c) { const int kk = (k & ~0xC) | ((k & 4) << 1) | ((k & 8) >> 1); return ((kk >> 3) * 4 + (c >> 5)) * 512 + ((kk & 7) * 32 + (c & 31)) * 2; }
__device__ __forceinline__ int v_rd_base(int lane) { return ((lane & 3) << 3) | (((lane >> 2) & 3) << 6) | (((lane >> 4) & 1) << 5) | (((lane >> 5) & 1) << 8); }
constexpr int v_rd_off(int d0, int ks, int half) { return d0 * 512 + ks * 4096 + half * 2048; }
__device__ __forceinline__ int crow(int r, int hi) { return (r & 3) + 8 * (r >> 2) + 4 * hi; }
__device__ __forceinline__ bool partialSM(f32x16& p0, f32x16& p1, float& m_reg, float& mn, float& alpha) {
    float pmax = p0[0];
#pragma unroll
    for (int r = 1; r < 16; ++r) pmax = fmaxf(pmax, p0[r]);
#pragma unroll
    for (int r = 0; r < 16; ++r) pmax = fmaxf(pmax, p1[r]);
    { auto rr = __builtin_amdgcn_permlane32_swap(__float_as_uint(pmax), __float_as_uint(pmax), false, false);
      pmax = fmaxf(__uint_as_float(rr[0]), __uint_as_float(rr[1])); }
    if (__all(pmax - m_reg < -106.f)) return false;
    if (__builtin_expect(__all((pmax - m_reg) <= THR), 1)) { mn = m_reg; alpha = 1.f; }
    else { mn = fmaxf(m_reg, pmax); alpha = __builtin_amdgcn_exp2f((m_reg - mn) * LOG2E); m_reg = mn; }
    const float mnL = -mn * LOG2E;
#pragma unroll
    for (int r = 0; r < 16; ++r) p0[r] = fmaf(p0[r], LOG2E, mnL);
#pragma unroll
    for (int r = 0; r < 16; ++r) p1[r] = fmaf(p1[r], LOG2E, mnL);
#pragma unroll
    for (int r = 0; r < 16; ++r) p0[r] = __builtin_amdgcn_exp2f(p0[r]);
    return true;
}
__device__ __forceinline__ void finishSM(f32x16& p0, f32x16& p1, float alpha, float& l_reg, bf16x8& pa0, bf16x8& pa1, bf16x8& pa2, bf16x8& pa3) {
#pragma unroll
    for (int r = 0; r < 16; ++r) p1[r] = __builtin_amdgcn_exp2f(p1[r]);
    float ps = 0;
#pragma unroll
    for (int r = 0; r < 16; ++r) ps += p0[r];
#pragma unroll
    for (int r = 0; r < 16; ++r) ps += p1[r];
    { auto rr = __builtin_amdgcn_permlane32_swap(__float_as_uint(ps), __float_as_uint(ps), false, false);
      ps = __uint_as_float(rr[0]) + __uint_as_float(rr[1]); }
    l_reg = l_reg * alpha + ps;
#define PK4(P, B_, OUT) do { unsigned a0 = cvt_pk_bf16(P[B_+0], P[B_+1]), a1 = cvt_pk_bf16(P[B_+2], P[B_+3]);                          \
        unsigned b0 = cvt_pk_bf16(P[B_+4], P[B_+5]), b1 = cvt_pk_bf16(P[B_+6], P[B_+7]);                                             \
        auto r0 = __builtin_amdgcn_permlane32_swap(a0, b0, false, false); auto r1 = __builtin_amdgcn_permlane32_swap(a1, b1, false, false); \
        u32x4 w = {r0[0], r1[0], r0[1], r1[1]}; OUT = __builtin_bit_cast(bf16x8, w); } while (0)
    PK4(p0, 0, pa0); PK4(p0, 8, pa1); PK4(p1, 0, pa2); PK4(p1, 8, pa3);
#undef PK4
}
template <int KB>
__device__ __forceinline__ void qkt(f32x16& p0, f32x16& p1, const LAS char* K_lds, int r32, int hi, const bf16x8* qr, bf16x8 kf0, bf16x8 kf1, bf16x8 qf) {
    const LAS char* kb[4];
#pragma unroll
    for (int dd = 0; dd < 4; ++dd) kb[dd] = K_lds + KB * SHM_K + KSWZ(r32, (dd * 16 + hi * 8) * 2);
    bf16x8 ka[2], kc[2];
    ka[0] = *(const LAS bf16x8*)(kb[0]); kc[0] = *(const LAS bf16x8*)(kb[0] + 32 * 256);
    p0 = __builtin_amdgcn_mfma_f32_32x32x16_bf16(kf0, qf, (f32x16){0.f, 0.f, 0.f, 0.f, 0.f, 0.f, 0.f, 0.f, 0.f, 0.f, 0.f, 0.f, 0.f, 0.f, 0.f, 0.f}, 0, 0, 0);
    p1 = __builtin_amdgcn_mfma_f32_32x32x16_bf16(kf1, qf, (f32x16){0.f, 0.f, 0.f, 0.f, 0.f, 0.f, 0.f, 0.f, 0.f, 0.f, 0.f, 0.f, 0.f, 0.f, 0.f, 0.f}, 0, 0, 0);
    SBAR();
#pragma unroll
    for (int d0 = 0; d0 < 8; ++d0) { const int c = d0 & 1;
        if (d0 < 7) { const LAS char* ap = kb[(d0 + 1) & 3] + ((d0 + 1) >> 2) * 128; ka[c ^ 1] = *(const LAS bf16x8*)(ap); kc[c ^ 1] = *(const LAS bf16x8*)(ap + 32 * 256); }
        p0 = __builtin_amdgcn_mfma_f32_32x32x16_bf16(ka[c], qr[d0], p0, 0, 0, 0);
        p1 = __builtin_amdgcn_mfma_f32_32x32x16_bf16(kc[c], qr[d0], p1, 0, 0, 0);
        SBAR(); }
}
template <int VB>
__device__ __forceinline__ void pv_tile(f32x16* o, int vb0, bf16x8 pa0, bf16x8 pa1, bf16x8 pa2, bf16x8 pa3) {
#define TRRD(dst, off) asm volatile("ds_read_b64_tr_b16 %0, %1 offset:%2" : "=&v"(dst) : "v"(vb0), "i"(off) : "memory")
#define PV_RD(S, d0) do { constexpr int b_ = VB * SHM_V + v_rd_off(d0, 0, 0); \
        TRRD(S[0], b_); TRRD(S[4], b_ + 2048); TRRD(S[1], b_ + 4096); TRRD(S[5], b_ + 6144); TRRD(S[2], b_ + 8192); TRRD(S[6], b_ + 10240); TRRD(S[3], b_ + 12288); TRRD(S[7], b_ + 14336); } while (0)
#define PV_MM(S, d0) do { \
        o[d0] = __builtin_amdgcn_mfma_f32_32x32x16_bf16(pa0, (bf16x8){S[0][0], S[0][1], S[0][2], S[0][3], S[4][0], S[4][1], S[4][2], S[4][3]}, o[d0], 0, 0, 0);   \
        o[d0] = __builtin_amdgcn_mfma_f32_32x32x16_bf16(pa1, (bf16x8){S[1][0], S[1][1], S[1][2], S[1][3], S[5][0], S[5][1], S[5][2], S[5][3]}, o[d0], 0, 0, 0);   \
        o[d0] = __builtin_amdgcn_mfma_f32_32x32x16_bf16(pa2, (bf16x8){S[2][0], S[2][1], S[2][2], S[2][3], S[6][0], S[6][1], S[6][2], S[6][3]}, o[d0], 0, 0, 0);   \
        o[d0] = __builtin_amdgcn_mfma_f32_32x32x16_bf16(pa3, (bf16x8){S[3][0], S[3][1], S[3][2], S[3][3], S[7][0], S[7][1], S[7][2], S[7][3]}, o[d0], 0, 0, 0); } while (0)
    s16x4 A[8], B[8];
    PV_RD(A, 0);
    PV_RD(B, 1); asm volatile("s_waitcnt lgkmcnt(8)" ::: "memory"); SBAR(); PV_MM(A, 0); SBAR();
    PV_RD(A, 2); asm volatile("s_waitcnt lgkmcnt(8)" ::: "memory"); SBAR(); PV_MM(B, 1); SBAR();
    PV_RD(B, 3); asm volatile("s_waitcnt lgkmcnt(8)" ::: "memory"); SBAR(); PV_MM(A, 2); SBAR();
    asm volatile("s_waitcnt lgkmcnt(0)" ::: "memory"); SBAR(); PV_MM(B, 3);
#undef PV_RD
#undef PV_MM
#undef TRRD
}
typedef const __attribute__((address_space(4))) unsigned long long* cmask_t;
__device__ __forceinline__ void mask_tile(f32x16& p0, f32x16& p1, const unsigned long long* mpg) {
    const float NEG = -__builtin_inff();
    cmask_t mp = (cmask_t)mpg;
    asm volatile("s_nop 15\n\ts_nop 7" : "+v"(p0), "+v"(p1));
#pragma unroll
    for (int r = 0; r < 16; ++r) { const unsigned long long m0 = mp[r], m1 = mp[16 + r];
        asm volatile("v_cndmask_b32 %0, %1, %0, %2" : "+v"(p0[r]) : "v"(NEG), "s"(m0));
        asm volatile("v_cndmask_b32 %0, %1, %0, %2" : "+v"(p1[r]) : "v"(NEG), "s"(m1)); }
}
template <int BUF>
__device__ __forceinline__ void tile_step(f32x16* o, float& m_reg, float& l_reg, const LAS char* K_lds, int vb0, LAS float* al_l, int r32, int hi, const bf16x8* qr,
                                          int kb_key, bf16x8 qf, const unsigned long long* mp) {
    f32x16 p0, p1; float mn, alpha; bf16x8 pa0, pa1, pa2, pa3;
    const unsigned kbb = __float_as_uint((float)kb_key) >> 16, k0b = __float_as_uint((float)r32) >> 16, k1b = __float_as_uint((float)(r32 + 32)) >> 16;
    u32x4 f0 = {hi ? 0u : (kbb | (k0b << 16)), 0u, 0u, 0u}, f1 = {hi ? 0u : (kbb | (k1b << 16)), 0u, 0u, 0u};
    qkt<BUF>(p0, p1, K_lds, r32, hi, qr, __builtin_bit_cast(bf16x8, f0), __builtin_bit_cast(bf16x8, f1), qf);
    mask_tile(p0, p1, mp);
    if (!partialSM(p0, p1, m_reg, mn, alpha)) return;
    finishSM(p0, p1, alpha, l_reg, pa0, pa1, pa2, pa3);
    if (__any(alpha < 1.f)) { if (hi == 0) al_l[r32] = alpha; asm volatile("s_waitcnt lgkmcnt(0)" ::: "memory");
#pragma unroll
        for (int r = 0; r < 16; ++r) { const float av = al_l[crow(r, hi)];
#pragma unroll
            for (int d_ = 0; d_ < 4; ++d_) o[d_][r] *= av; } }
    pv_tile<BUF>(o, vb0, pa0, pa1, pa2, pa3);
}
__device__ __forceinline__ void attn_unit(Frame& F, const float* __restrict__ qgain, int b, int g, int qb, unsigned* done_ctr) {
    const bf16_t* Q = (const bf16_t*)(F.ws + WS_Q); const bf16_t* K = (const bf16_t*)(F.ws + WS_K); const bf16_t* V = (const bf16_t*)(F.ws + WS_V);
    unsigned char* O = F.ws + WS_ATTN;
    const unsigned long long* MT = (const unsigned long long*)(F.ws + WS_MASK);
    LAS char* lds = (LAS char*)F.lds;
    const int wid = F.wave, lane = lane_id(), tid = wid * 64 + lane, r32 = lane & 31, hi = lane >> 5;
    const int hq = wid >> 1, th = wid & 1, h = 4 * g + hq, tok0 = b * SEQ + 64 * qb + 32 * th, NT = qb + 1;
    LAS char* V_lds = lds + LDS_V; LAS char* K_lds = lds + LDS_K; LAS float* wsf = (LAS float*)(lds + LDS_WS) + wid * 64; LAS float* li_l = wsf; LAS float* al_l = wsf + 32;
    const int sr = tid >> 4, sc = (tid & 15) * 8, vst0 = v_st(sr, sc), vst1 = v_st(32 + sr, sc), kws = KSWZ(sr, sc * 2);
    const int vb0 = (int)(uintptr_t)V_lds + v_rd_base(lane);
    bf16x8 qr[8];
    {
      u32x4 qw[8]; float ss = 0.f;
#pragma unroll
      for (int d0 = 0; d0 < 8; ++d0) { qw[d0] = *(const u32x4*)(Q + (size_t)(tok0 + r32) * AW + h * HD + d0 * 16 + hi * 8);
#pragma unroll
          for (int j = 0; j < 4; ++j) { const float lo = bflo(qw[d0][j]), hv = bfhi(qw[d0][j]); ss += lo * lo + hv * hv; } }
      { auto rr = __builtin_amdgcn_permlane32_swap(__float_as_uint(ss), __float_as_uint(ss), false, false); ss = __uint_as_float(rr[0]) + __uint_as_float(rr[1]); }
      const float rq = rsqrtf(ss * (1.0f / HD) + NORM_EPS) * 0.08838834764831845f;
#pragma unroll
      for (int d0 = 0; d0 < 8; ++d0) { const f32x4 g0 = *(const f32x4*)(qgain + d0 * 16 + hi * 8), g1 = *(const f32x4*)(qgain + d0 * 16 + hi * 8 + 4); u32x4 o;
          o[0] = cvt_pk_bf16(bflo(qw[d0][0]) * rq * g0[0], bfhi(qw[d0][0]) * rq * g0[1]); o[1] = cvt_pk_bf16(bflo(qw[d0][1]) * rq * g0[2], bfhi(qw[d0][1]) * rq * g0[3]);
          o[2] = cvt_pk_bf16(bflo(qw[d0][2]) * rq * g1[0], bfhi(qw[d0][2]) * rq * g1[1]); o[3] = cvt_pk_bf16(bflo(qw[d0][3]) * rq * g1[2], bfhi(qw[d0][3]) * rq * g1[3]);
          qr[d0] = __builtin_bit_cast(bf16x8, o); } }
    const unsigned sb = __float_as_uint(__builtin_ldexpf(1.0f, -(h + 1))) >> 16;
    const u32x4 qfw = {hi ? 0u : (sb | (sb << 16)), 0u, 0u, 0u}; const bf16x8 qf = __builtin_bit_cast(bf16x8, qfw);
    const bf16_t* Kg = K + (size_t)(b * SEQ) * KVW + g * HD + sc; const bf16_t* Vg = V + (size_t)(b * SEQ) * KVW + g * HD + sc;
    const unsigned long long* mrow = MT + (size_t)__builtin_amdgcn_readfirstlane(tok0 >> 5) * 64 * 32;
    float m_reg = -1e30f, l_reg = 0.f; f32x16 o[4] = {};
    bf16x8 st_k0, st_k1, st_v0, st_v1;
#define SLOAD(k0) do { st_k0 = *(const bf16x8*)(Kg + (size_t)((k0) + sr) * KVW); st_k1 = *(const bf16x8*)(Kg + (size_t)((k0) + 32 + sr) * KVW); \
                       st_v0 = *(const bf16x8*)(Vg + (size_t)((k0) + sr) * KVW); st_v1 = *(const bf16x8*)(Vg + (size_t)((k0) + 32 + sr) * KVW); } while (0)
#define SWRITE(bf) do { *(LAS bf16x8*)(K_lds + (bf) * SHM_K + kws) = st_k0; *(LAS bf16x8*)(K_lds + (bf) * SHM_K + kws + 32 * 256) = st_k1; \
                        *(LAS bf16x8*)(V_lds + (bf) * SHM_V + vst0) = st_v0; *(LAS bf16x8*)(V_lds + (bf) * SHM_V + vst1) = st_v1; } while (0)
#define TK(u_) (NT - 1 - (u_))
    SLOAD(TK(0) * KVBLK); SWRITE(0);
    __syncthreads();
    bool signaled = false;
    for (int t = 0; t < NT; t += 2) {
        if (done_ctr && !signaled && t + 8 >= NT) { signaled = true; if (wid == 0 && lane == 0) __hip_atomic_fetch_add(done_ctr, 1u, __ATOMIC_RELAXED, __HIP_MEMORY_SCOPE_AGENT); }
        if (t + 1 < NT) SLOAD(TK(t + 1) * KVBLK);
        tile_step<0>(o, m_reg, l_reg, K_lds, vb0, al_l, r32, hi, qr, TK(t) * KVBLK, qf, mrow + (size_t)TK(t) * 32);
        if (t + 1 < NT) SWRITE(1);
        __syncthreads();
        if (t + 1 < NT) {
            if (t + 2 < NT) SLOAD(TK(t + 2) * KVBLK);
            tile_step<1>(o, m_reg, l_reg, K_lds, vb0, al_l, r32, hi, qr, TK(t + 1) * KVBLK, qf, mrow + (size_t)TK(t + 1) * 32);
            if (t + 2 < NT) SWRITE(0);
            __syncthreads();
        }
    }
#undef TK
#undef SLOAD
#undef SWRITE
    if (hi == 0) li_l[r32] = l_reg; asm volatile("s_waitcnt lgkmcnt(0)" ::: "memory");
    unsigned char* Ow = O + (size_t)tok0 * AW + h * HD;
#pragma unroll
    for (int r = 0; r < 16; ++r) { const int orow = crow(r, hi); const float rl = __builtin_amdgcn_rcpf(li_l[orow]) * (FP8_MERGE ? A8_SCALE : 1.0f);
#pragma unroll
        for (int d0 = 0; d0 < 4; ++d0) { const float v = o[d0][r] * rl; const float v1 = __shfl_xor(v, 1);
            if constexpr (FP8_MERGE) { const float v2 = __shfl_xor(v, 2), v3 = __shfl_xor(v1, 2);
                if ((r32 & 3) == 0) *(unsigned*)(Ow + (size_t)orow * AW + d0 * 32 + r32) = pk4_fp8(v, v1, v2, v3); }
            else { if ((r32 & 1) == 0) *(unsigned*)((bf16_t*)O + (size_t)(tok0 + orow) * AW + h * HD + d0 * 32 + r32) = cvt_pk_bf16(v, v1); } } }
    __syncthreads();
}
#undef KSWZ
#undef SBAR
}
struct SchedPool {
    const char* A; const char* B; int c;
    __device__ __forceinline__ bool next(int i, pg8::Unit& u) const { if (i > 0 || c >= 128) return false; const int rt = c >> 2, g = c & 3; u.pm = rt; u.pn = g; u.aux = 0; u.tok = nullptr; u.nt8 = 0;
        u.A = A + ((size_t)rt * 256 * PW + g * 256) * 2; u.B = B + (size_t)g * 65536 * 2; return true; }
};
struct EpiPool {
    unsigned char* out; const float* pscale;
    __device__ __forceinline__ bool operator()(f32x4 (&acc)[2][2][4][2], const pg8::Unit& u, int wr, int wc, int fr, int fq) const {
        const int row0 = u.pm * 256 + wr * 64 + fr, col0 = u.pn * 256 + wc * 32 + 8 * fq;
#pragma unroll
        for (int bj = 0; bj < 2; ++bj) { const f32x4 s0 = *(const f32x4*)(pscale + col0 + bj * 128), s1 = *(const f32x4*)(pscale + col0 + bj * 128 + 4);
#pragma unroll
            for (int ai = 0; ai < 2; ++ai)
#pragma unroll
                for (int m = 0; m < 4; ++m) { const size_t o = (size_t)(row0 + ai * 128 + m * 16) * PW + col0 + bj * 128;
                    if constexpr (FP8_MERGE) { const f32x4 v0 = acc[ai][bj][m][0] * s0 * A8_SCALE, v1 = acc[ai][bj][m][1] * s1 * A8_SCALE; u32x2 w; w.x = pk4_fp8(v0[0], v0[1], v0[2], v0[3]); w.y = pk4_fp8(v1[0], v1[1], v1[2], v1[3]); *(u32x2*)(out + o) = w; }
                    else st_bf16x8((bf16_t*)out + o, acc[ai][bj][m][0] * s0, acc[ai][bj][m][1] * s1); } }
        return false;
    }
};
__device__ __forceinline__ void p4_pool_attn(Frame& F, const Args& a) {
    for (int c = blockIdx.x; c < 256; c += F.G) {
        const int bg = c >> 6, qb = c & 63;
        att::attn_unit(F, a.in[I_QNORM], bg >> 1, bg & 1, qb, (c + F.G >= 256) ? F.ctl + CW_DONE + 64 * 4 : nullptr);
        if (qb < 32) { const int pu = bg * 32 + qb, rt = pu >> 2, g = pu & 3;
            pooled_item(F, rt * 256 + 32 * F.wave, g, lane_id());
            asm volatile("s_waitcnt vmcnt(0)" ::: "memory"); __syncthreads();
            SchedPool S{(const char*)(F.ws + WS_POOLED), (const char*)(F.ws + WS_PLIN), pu}; EpiPool E{F.ws + WS_POOL, a.in[I_PSCALE]};
            pg8::gemm_phase<EpiPool, SchedPool, false>(F.lds, F.wave, 256 * 2, PW * 2, S, E); __syncthreads(); }
    }
}
struct SchedMerge {
    pg8::TileOrder T; const char* A0; const char* B0; const char* A1; const char* B1;
    __device__ __forceinline__ bool next(int i, pg8::Unit& u) const { int pm, pn; if (!T.tile(i >> 1, pm, pn)) return false; u.pm = pm; u.pn = pn; u.aux = i & 1; u.tok = nullptr; u.nt8 = 0;
        u.A = ((i & 1) ? A1 : A0) + (size_t)pm * 256 * 1024 * (FP8_MERGE ? 1 : 2); u.B = ((i & 1) ? B1 : B0) + (size_t)pn * 256 * 1024 * (FP8_MERGE ? 1 : 2); return true; }
};
struct EpiMerge {
    const bf16_t* G; unsigned char* out;
    __device__ __forceinline__ bool operator()(f32x4 (&acc)[2][2][4][2], const pg8::Unit& u, int wr, int wc, int fr, int fq) const {
        const int row0 = u.pm * 256 + wr * 64 + fr, col0 = u.pn * 256 + wc * 32 + 8 * fq;
#pragma unroll
        for (int ai = 0; ai < 2; ++ai)
#pragma unroll
            for (int m = 0; m < 4; ++m) { const size_t r = (size_t)(row0 + ai * 128 + m * 16);
#pragma unroll
                for (int bj = 0; bj < 2; ++bj) { const int c = col0 + bj * 128;
                    const u32x4 gp = *(const u32x4*)(G + r * (2 * DM) + DM + c);
                    const f32x4 p0 = {bflo(gp[0]), bfhi(gp[0]), bflo(gp[1]), bfhi(gp[1])}, p1 = {bflo(gp[2]), bfhi(gp[2]), bflo(gp[3]), bfhi(gp[3])};
                    if (u.aux == 0) { const u32x4 ga = *(const u32x4*)(G + r * (2 * DM) + c);
                        const f32x4 a0 = {bflo(ga[0]), bfhi(ga[0]), bflo(ga[1]), bfhi(ga[1])}, a1 = {bflo(ga[2]), bfhi(ga[2]), bflo(ga[3]), bfhi(ga[3])};
#pragma unroll
                        for (int j = 0; j < 4; ++j) { acc[ai][bj][m][0][j] *= a0[j] * __builtin_amdgcn_rcpf(fmaxf(p0[j], 1e-30f)); acc[ai][bj][m][1][j] *= a1[j] * __builtin_amdgcn_rcpf(fmaxf(p1[j], 1e-30f)); } }
                    else { if constexpr (FP8_OUT) { const f32x4 v0 = acc[ai][bj][m][0] * p0 * A8_SCALE, v1 = acc[ai][bj][m][1] * p1 * A8_SCALE; u32x2 w; w.x = pk4_fp8(v0[0], v0[1], v0[2], v0[3]); w.y = pk4_fp8(v1[0], v1[1], v1[2], v1[3]);
                        *(u32x2*)(out + r * DM + c) = w; } else st_bf16x8((bf16_t*)out + r * DM + c, acc[ai][bj][m][0] * p0, acc[ai][bj][m][1] * p1); } } }
        return u.aux == 0;
    }
};
__device__ __forceinline__ void p5_merge(Frame& F) {
    SchedMerge S; S.T.init(NTOK, DM, F.G, (int)blockIdx.x); S.A0 = (const char*)(F.ws + WS_ATTN); S.B0 = (const char*)(F.ws + WS_WAU); S.A1 = (const char*)(F.ws + WS_POOL); S.B1 = (const char*)(F.ws + WS_WPU);
    EpiMerge E{(const bf16_t*)(F.ws + WS_G), F.ws + WS_MERGED};
    constexpr int ES = FP8_MERGE ? 1 : 2;
    pg8::gemm_phase<EpiMerge, SchedMerge, false, ES, FP8_MERGE ? A8_E8 : 127, FP8_MERGE ? W8_E8 : 127>(F.lds, F.wave, 1024 * ES, 1024 * ES, S, E);
}
struct EpiOut {
    const float* x; const float* mod; float* out;
    __device__ __forceinline__ bool operator()(f32x4 (&acc)[2][2][4][2], const pg8::Unit& u, int wr, int wc, int fr, int fq) const {
        const int row0 = u.pm * 256 + wr * 64 + fr, col0 = u.pn * 256 + wc * 32 + 8 * fq; const int b = (u.pm * 256) / SEQ;
        const float* gm = mod + b * 6 * DM + 2 * DM;
#pragma unroll
        for (int bj = 0; bj < 2; ++bj) { const int c = col0 + bj * 128; const f32x4 g0 = *(const f32x4*)(gm + c), g1 = *(const f32x4*)(gm + c + 4);
#pragma unroll
            for (int ai = 0; ai < 2; ++ai)
#pragma unroll
                for (int m = 0; m < 4; ++m) { const size_t o = (size_t)(row0 + ai * 128 + m * 16) * DM + c;
                    const f32x4 x0 = __builtin_nontemporal_load((const f32x4*)(x + o)), x1 = __builtin_nontemporal_load((const f32x4*)(x + o + 4));
                    *(f32x4*)(out + o) = x0 + g0 * acc[ai][bj][m][0]; *(f32x4*)(out + o + 4) = x1 + g1 * acc[ai][bj][m][1]; } }
        return false;
    }
};
__device__ __forceinline__ void p6_out(Frame& F, const Args& a) {
    SchedDense S; S.T.init(NTOK, DM, F.G, (int)blockIdx.x); S.A = (const char*)(F.ws + WS_MERGED); S.B = (const char*)(F.ws + WS_WOUT);
    constexpr int ES = FP8_OUT ? 1 : 2; S.a_tile = (size_t)256 * DM * ES; S.b_tile = (size_t)256 * DM * ES;
    EpiOut E{a.in[I_X], (const float*)(F.ctl + CW_MOD), F.out};
    pg8::gemm_phase<EpiOut, SchedDense, false, ES, FP8_OUT ? A8_E8 : 127, FP8_OUT ? W8_E8 : 127>(F.lds, F.wave, DM * ES, DM * ES, S, E);
}
constexpr int P7_ROWB = 4096 + 16;
constexpr int P7_ROWS = 32, P7_RW = P7_ROWS / NWAVES;
constexpr int P7_LDS_P = P7_ROWS * P7_ROWB;
constexpr int P7_LDS_H = P7_LDS_P + 2 * P7_ROWS * 64 * 4;
__device__ __forceinline__ void p7_router(Frame& F, const Args& a) {
    const float* mod = (const float*)(F.ctl + CW_MOD);
    unsigned char* hb8 = F.ws + WS_HB; const bf16_t* Wr = (const bf16_t*)(F.ws + WS_WR);
    unsigned char* rt = F.ws + WS_ROUTE;
    int* eid = (int*)(rt + RT_EID); float* gate = (float*)(rt + RT_GATE); int* posn = (int*)(rt + RT_POS); int* list = (int*)(rt + RT_LIST); int* ident = (int*)(rt + RT_IDENT);
    unsigned* ecnt = F.ctl + CW_ECNT;
    LAS unsigned char* lds = F.lds; LAS float* P = (LAS float*)(lds + P7_LDS_P); LAS unsigned* hist = (LAS unsigned*)(lds + P7_LDS_H); LAS unsigned* baseL = hist + 64;
    const int lane = lane_id(), w = F.wave, tid = w * 64 + lane;
    if (tid < 64) hist[tid] = 0u;
    __syncthreads();
    for (int p = blockIdx.x; p < NTOK / P7_ROWS; p += F.G) {
        const int row0 = P7_ROWS * p;
        { const int b = row0 / SEQ; const float* sh = mod + b * 6 * DM + 3 * DM; const float* sl = mod + b * 6 * DM + 4 * DM;
          f32x4 v[P7_RW][8];
#pragma unroll
          for (int rr = 0; rr < P7_RW; ++rr) { const float* xrow = F.out + (size_t)(row0 + P7_RW * w + rr) * DM;
#pragma unroll
              for (int j = 0; j < 8; ++j) v[rr][j] = __builtin_nontemporal_load((const f32x4*)(xrow + 4 * lane + 256 * j)); }
          float rstd[P7_RW];
#pragma unroll
          for (int rr = 0; rr < P7_RW; ++rr) { float ss = 0.f;
#pragma unroll
              for (int j = 0; j < 8; ++j) ss += (v[rr][j].x * v[rr][j].x + v[rr][j].y * v[rr][j].y) + (v[rr][j].z * v[rr][j].z + v[rr][j].w * v[rr][j].w);
              rstd[rr] = rsqrtf(wave_sum(ss) * (1.0f / DM) + NORM_EPS); }
#pragma unroll
          for (int j = 0; j < 8; ++j) { const int c = 4 * lane + 256 * j;
              const f32x4 gg = *(const f32x4*)(a.in[I_GFFN] + c), shv = *(const f32x4*)(sh + c), slv = *(const f32x4*)(sl + c); const f32x4 mul = gg * (slv + 1.0f);
#pragma unroll
              for (int rr = 0; rr < P7_RW; ++rr) { const int lr = P7_RW * w + rr, m = row0 + lr;
                  const f32x4 o = v[rr][j] * rstd[rr] * mul + shv;
                  u32x2 wv; wv.x = cvt_pk_bf16(o.x, o.y); wv.y = cvt_pk_bf16(o.z, o.w);
                  *(unsigned*)(hb8 + (size_t)m * DM + c) = pk4_fp8(o.x * H8_SCALE, o.y * H8_SCALE, o.z * H8_SCALE, o.w * H8_SCALE); *(LAS u32x2*)(lds + lr * P7_ROWB + c * 2) = wv; } }
          if (lane < P7_RW) ident[row0 + P7_RW * w + lane] = row0 + P7_RW * w + lane;
        }
        __syncthreads();
        { const int nb = w & 3, kh = w >> 2, fr = lane & 15, kq = lane >> 4;
          f32x4 acc[2] = {{0.f, 0.f, 0.f, 0.f}, {0.f, 0.f, 0.f, 0.f}};
          const bf16_t* wp = Wr + (size_t)(16 * nb + fr) * DM + 1024 * kh + 8 * kq;
          const LAS unsigned char* ap = lds + fr * P7_ROWB + (1024 * kh + 8 * kq) * 2;
#pragma unroll 8
          for (int s = 0; s < 32; ++s) { const bf16x8 bv = *(const bf16x8*)(wp + 32 * s);
#pragma unroll
              for (int mb = 0; mb < 2; ++mb) { const bf16x8 av = *(const LAS bf16x8*)(ap + mb * 16 * P7_ROWB + 64 * s); acc[mb] = __builtin_amdgcn_mfma_f32_16x16x32_bf16(av, bv, acc[mb], 0, 0, 0); } }
#pragma unroll
          for (int mb = 0; mb < 2; ++mb)
#pragma unroll
              for (int j = 0; j < 4; ++j) P[(kh * P7_ROWS + 16 * mb + 4 * kq + j) * 64 + 16 * nb + fr] = acc[mb][j];
        }
        __syncthreads();
        int myrank[P7_RW]; unsigned mylocal[P7_RW]; bool chosen[P7_RW]; float mygate[P7_RW];
#pragma unroll
        for (int rr = 0; rr < P7_RW; ++rr) { const int lr = P7_RW * w + rr;
            const float logit = P[lr * 64 + lane] + P[(P7_ROWS + lr) * 64 + lane];
            const float score = 1.0f / (1.0f + __expf(-logit)); const float sel = score + a.in[I_RBIAS][lane];
            float m1 = sel; m1 = fmaxf(m1, __shfl_xor(m1, 1)); m1 = fmaxf(m1, __shfl_xor(m1, 2)); m1 = fmaxf(m1, __shfl_xor(m1, 4));
            const unsigned long long bm = __ballot(sel == m1); const unsigned grp = (unsigned)((bm >> (lane & ~7)) & 0xffull); const int first = __builtin_ctz(grp | 0x100u);
            float m2 = ((lane & 7) == first) ? -__builtin_inff() : sel; m2 = fmaxf(m2, __shfl_xor(m2, 1)); m2 = fmaxf(m2, __shfl_xor(m2, 2)); m2 = fmaxf(m2, __shfl_xor(m2, 4));
            const float gs = m1 + m2; const int g = lane >> 3; int grank = 0;
#pragma unroll
            for (int g2 = 0; g2 < 8; ++g2) { const float o = __uint_as_float(__builtin_amdgcn_readlane(__float_as_uint(gs), 8 * g2)); grank += (o > gs || (o == gs && g2 < g)) ? 1 : 0; }
            const float selm = grank < TOPG ? sel : -__builtin_inff(); int rank = 0;
#pragma unroll
            for (int e2 = 0; e2 < 64; ++e2) { const float o = __uint_as_float(__builtin_amdgcn_readlane(__float_as_uint(selm), e2)); rank += (o > selm || (o == selm && e2 < lane)) ? 1 : 0; }
            const bool ch = rank < ETOP && grank < TOPG; const float gsum = wave_sum(ch ? score : 0.f);
            chosen[rr] = ch; myrank[rr] = rank; mygate[rr] = score / gsum * ROUTED_SCALE;
            mylocal[rr] = ch ? __hip_atomic_fetch_add(hist + lane, 1u, __ATOMIC_RELAXED, __HIP_MEMORY_SCOPE_WORKGROUP) : 0u;
        }
        __syncthreads();
        if (w == 0) { const unsigned c = hist[lane]; baseL[lane] = c ? __hip_atomic_fetch_add(ecnt + lane, c, __ATOMIC_RELAXED, __HIP_MEMORY_SCOPE_AGENT) : 0u; hist[lane] = 0u; }
        __syncthreads();
#pragma unroll
        for (int rr = 0; rr < P7_RW; ++rr) if (chosen[rr]) { const int m = row0 + P7_RW * w + rr; const unsigned pos = baseL[lane] + mylocal[rr];
            eid[m * 8 + myrank[rr]] = lane; gate[m * 8 + myrank[rr]] = mygate[rr]; posn[m * 8 + myrank[rr]] = (int)pos; list[(size_t)lane * NTOK + pos] = m; }
        __syncthreads();
    }
}
constexpr int MOE_LDS = 131072;
__device__ __forceinline__ int moe_prefix(Frame& F) {
    LAS int* rtoff = (LAS int*)(F.lds + MOE_LDS);
    if (F.wave == 0) {
        const int e = lane_id(); unsigned n = F.ctl[CW_ECNT + e]; if (n > (unsigned)NTOK) n = NTOK;
        const int t = (int)((n + 255u) >> 8); int incl = t;
#pragma unroll
        for (int d = 1; d < 64; d <<= 1) { const int y = __shfl_up(incl, d); if (e >= d) incl += y; }
        rtoff[e] = incl - t; rtoff[66 + e] = (int)n;
        if (e == NE - 1) rtoff[NE] = incl; }
    __syncthreads();
    return __builtin_amdgcn_readfirstlane(rtoff[NE]);
}
__device__ __forceinline__ int moe_find(const LAS int* rtoff, int rtg) {
    int lo = 0, hi = NE;
#pragma unroll
    for (int it = 0; it < 6; ++it) { const int mid = (lo + hi) >> 1; const int v = __builtin_amdgcn_readfirstlane(rtoff[mid]); if (v <= rtg) lo = mid; else hi = mid; }
    return lo;
}
struct SchedMoe1 {
    const LAS int* rtoff; int RT, G, c; const char* hb; const char* w13; const char* ws13; const int* list; const int* ident;
    __device__ __forceinline__ bool next(int i, pg8::Unit& u) const {
        const int idx = i * G + (c & 7) * (G >> 3) + (c >> 3); if (idx >= (RT + NTOK / 256) * 4) return false;
        const int rtg = idx >> 2, ct = idx & 3; u.pn = ct; u.aux = 0; u.nt8 = 0; u.A = hb;
        if (rtg < RT) { const int e = moe_find(rtoff, rtg), rt = rtg - __builtin_amdgcn_readfirstlane(rtoff[e]); u.pm = rtg; u.tok = list + (size_t)e * NTOK + rt * 256;
            u.B = w13 + ((size_t)e * 1024 + ct * 256) * DM; }
        else { const int rt = rtg - RT; u.pm = HROWS_R / 256 + rt; u.tok = ident + rt * 256; u.B = ws13 + (size_t)(ct * 256) * DM; }
        return true; }
};
struct EpiMoe1 {
    unsigned char* H;
    __device__ __forceinline__ bool operator()(f32x4 (&acc)[2][2][4][2], const pg8::Unit& u, int wr, int wc, int fr, int fq) const {
        const int row0 = u.pm * 256 + wr * 64 + fr, col0 = u.pn * 128 + wc * 32 + 8 * fq;
#pragma unroll
        for (int ai = 0; ai < 2; ++ai)
#pragma unroll
            for (int m = 0; m < 4; ++m) { f32x4 h0, h1;
#pragma unroll
                for (int j = 0; j < 4; ++j) { const float g0 = acc[ai][0][m][0][j], g1 = acc[ai][0][m][1][j];
                    h0[j] = g0 * __builtin_amdgcn_rcpf(1.0f + __expf(-g0)) * acc[ai][1][m][0][j]; h1[j] = g1 * __builtin_amdgcn_rcpf(1.0f + __expf(-g1)) * acc[ai][1][m][1][j]; }
                u32x2 w; w.x = pk4_fp8(h0[0] * H8_SCALE, h0[1] * H8_SCALE, h0[2] * H8_SCALE, h0[3] * H8_SCALE); w.y = pk4_fp8(h1[0] * H8_SCALE, h1[1] * H8_SCALE, h1[2] * H8_SCALE, h1[3] * H8_SCALE);
                *(u32x2*)(H + (size_t)(row0 + ai * 128 + m * 16) * EH + col0) = w; }
        return false;
    }
};
__device__ __forceinline__ void p8_gemm1(Frame& F, const Args& a) {
    const int RT = moe_prefix(F);
    const int U = (RT + NTOK / 256) * 4, R0 = (U + F.G - 1) / F.G, R = (R0 * F.G - U < 24 * R0) ? R0 + 1 : R0, NG0 = ((U + R - 1) / R + 7) & ~7, NG = NG0 < F.G ? NG0 : (F.G & ~7);
    if ((int)blockIdx.x >= NG) { conv_drain<false, 1, 2>(F, a, 8); return; }
    SchedMoe1 S{(const LAS int*)(F.lds + MOE_LDS), RT, NG, (int)blockIdx.x, (const char*)(F.ws + WS_HB), (const char*)(F.ws + WS_W13), (const char*)(F.ws + WS_WS13),
                (const int*)(F.ws + WS_ROUTE + RT_LIST), (const int*)(F.ws + WS_ROUTE + RT_IDENT)};
    EpiMoe1 E{F.ws + WS_H};
    pg8::gemm_phase<EpiMoe1, SchedMoe1, true, 1, H8_E8, W8_E8>(F.lds, F.wave, DM, DM, S, E);
    conv_drain<false, 1, 2>(F, a, 8);
}
struct SchedMoe2 {
    const LAS int* rtoff; int RT, G, c; const char* H; const char* w2; const char* ws2;
    __device__ __forceinline__ bool next(int i, pg8::Unit& u) const {
        const int idx = (G & 7) ? i * G + c : i * G + (c & 7) * (G >> 3) + (c >> 3); if (idx >= (RT + NTOK / 256) * 8) return false;
        const int rtg = idx >> 3, ct = idx & 7; u.pn = ct; u.aux = 0; u.tok = nullptr; u.nt8 = 0;
        if (rtg < RT) { const int e = moe_find(rtoff, rtg); u.pm = rtg; u.B = w2 + ((size_t)e * DM + ct * 256) * EH;
            u.aux = __builtin_amdgcn_readfirstlane(rtoff[66 + e]) - 256 * (rtg - __builtin_amdgcn_readfirstlane(rtoff[e])); }
        else { u.pm = HROWS_R / 256 + (rtg - RT); u.B = ws2 + (size_t)(ct * 256) * EH; u.aux = 256; }
        u.A = H + (size_t)u.pm * 256 * EH; return true; }
};
constexpr float Y8_SCALE = 8.f;
#ifndef P9_STAGGER
#define P9_STAGGER 250
#endif
struct EpiY {
    unsigned char* Y; LAS unsigned char* lds;
    __device__ __forceinline__ bool operator()(f32x4 (&acc)[2][2][4][2], const pg8::Unit& u, int wr, int wc, int fr, int fq) const {
        const int tid = (wr * 4 + wc) * 64 + fq * 16 + fr, r0 = tid >> 4, g = tid & 15;
        const unsigned wa0 = (unsigned)(wr ? MOE_LDS + 1024 : 3 * 16384) + fr * 256 + (((2 * wc + (fq >> 1)) ^ fr) << 4) + (fq & 1) * 8, wa1 = wa0 ^ 128u;
        const unsigned ra = (unsigned)(r0 * 256 + ((g ^ (r0 & 15)) << 4));
        const unsigned yo = (unsigned)((u.pm * 256 + r0) * DM + u.pn * 256 + g * 16);
#pragma unroll
        for (int ai = 0; ai < 2; ++ai) {
#pragma unroll
            for (int m = 0; m < 4; ++m)
#pragma unroll
                for (int bj = 0; bj < 2; ++bj) { const f32x4 v0 = acc[ai][bj][m][0] * Y8_SCALE, v1 = acc[ai][bj][m][1] * Y8_SCALE; u32x2 w; w.x = pk4_fp8(v0[0], v0[1], v0[2], v0[3]); w.y = pk4_fp8(v1[0], v1[1], v1[2], v1[3]);
                    *(LAS u32x2*)(lds + (bj ? wa1 : wa0) + m * 4096) = w; }
            asm volatile("s_waitcnt lgkmcnt(0)\n\ts_barrier" ::: "memory");
#pragma unroll
            for (int it = 0; it < 4; ++it) {
                const u32x4 d = *(const LAS u32x4*)(lds + ra + ((it >> 1) ? MOE_LDS + 1024 : 3 * 16384) + (it & 1) * 8192);
                if (ai * 128 + it * 32 + r0 < u.aux) __builtin_nontemporal_store(d, (u32x4*)(Y + (yo + (unsigned)((ai * 128 + it * 32) * DM)))); }
            asm volatile("s_waitcnt lgkmcnt(0)\n\ts_barrier" ::: "memory");
        }
        return false;
    }
};
__device__ __forceinline__ void p9_gemm2(Frame& F) {
    const int RT = moe_prefix(F);
    SchedMoe2 S{(const LAS int*)(F.lds + MOE_LDS), RT, F.G, (int)blockIdx.x, (const char*)(F.ws + WS_H), (const char*)(F.ws + WS_W2), (const char*)(F.ws + WS_WS2)};
    EpiY E{F.ws + WS_Y, F.lds};
    pg8::gemm_phase<EpiY, SchedMoe2, false, 1, H8_E8, W8_E8>(F.lds, F.wave, EH, EH, S, E);
}
__device__ __forceinline__ void p10_combine(Frame& F) {
    (void)moe_prefix(F);
    const LAS int* rtoff = (const LAS int*)(F.lds + MOE_LDS);
    const unsigned char* Y = F.ws + WS_Y; unsigned char* rt = F.ws + WS_ROUTE;
    const int* eid = (const int*)(rt + RT_EID); const float* gate = (const float*)(rt + RT_GATE); const int* posn = (const int*)(rt + RT_POS); const float* mod = (const float*)(F.ctl + CW_MOD);
    const int lane = lane_id();
    size_t yr[9]; float g[9]; unsigned yv[9][8];
#define P10_ROUTE(t_) do { const u32x4 e0 = *(const u32x4*)(eid + (t_) * 8), e1 = *(const u32x4*)(eid + (t_) * 8 + 4), p0 = *(const u32x4*)(posn + (t_) * 8), p1 = *(const u32x4*)(posn + (t_) * 8 + 4); \
        const f32x4 g0 = *(const f32x4*)(gate + (t_) * 8), g1 = *(const f32x4*)(gate + (t_) * 8 + 4); \
        _Pragma("unroll") for (int k = 0; k < 8; ++k) { const int e = __builtin_amdgcn_readfirstlane((int)(k < 4 ? e0[k & 3] : e1[k & 3])) & 63, p = __builtin_amdgcn_readfirstlane((int)(k < 4 ? p0[k & 3] : p1[k & 3])); \
            yr[k] = (size_t)(256 * __builtin_amdgcn_readfirstlane(rtoff[e]) + p) * DM; g[k] = __uint_as_float(__builtin_amdgcn_readfirstlane(__float_as_uint(k < 4 ? g0[k & 3] : g1[k & 3]))); } \
        yr[8] = (size_t)(HROWS_R + (t_)) * DM; g[8] = 1.0f; } while (0)
#define P10_YLOAD() do { _Pragma("unroll") for (int k = 0; k < 9; ++k) { _Pragma("unroll") for (int j = 0; j < 8; ++j) yv[k][j] = __builtin_nontemporal_load((const unsigned*)(Y + yr[k] + 4 * lane + 256 * j)); } } while (0)
    int t = F.gw;
    if (t < NTOK) { P10_ROUTE(t); P10_YLOAD(); }
    for (; t < NTOK; t += F.NGW) {
        const int b = t / SEQ; const float* gf = mod + b * 6 * DM + 5 * DM + 4 * lane;
        float* orow = F.out + (size_t)t * DM + 4 * lane;
        f32x4 xv[8];
#pragma unroll
        for (int j = 0; j < 8; ++j) xv[j] = __builtin_nontemporal_load((const f32x4*)(orow + 256 * j));
        f32x4 s[8];
#pragma unroll
        for (int j = 0; j < 8; ++j) s[j] = (f32x4){0.f, 0.f, 0.f, 0.f};
#pragma unroll
        for (int k = 0; k < 9; ++k)
#pragma unroll
            for (int j = 0; j < 8; ++j) { const f32x2 lo = __builtin_amdgcn_cvt_pk_f32_fp8((int)yv[k][j], false), hi = __builtin_amdgcn_cvt_pk_f32_fp8((int)yv[k][j], true);
                s[j][0] += lo[0] * g[k]; s[j][1] += lo[1] * g[k]; s[j][2] += hi[0] * g[k]; s[j][3] += hi[1] * g[k]; }
        const int tn = t + F.NGW;
        if (tn < NTOK) { P10_ROUTE(tn); P10_YLOAD(); }
#pragma unroll
        for (int j = 0; j < 8; ++j) __builtin_nontemporal_store(xv[j] + *(const f32x4*)(gf + 256 * j) * s[j] * (1.0f / Y8_SCALE), (f32x4*)(orow + 256 * j));
    }
#undef P10_ROUTE
#undef P10_YLOAD
}
constexpr int LDS_BYTES = 155648;
constexpr int N_PHASES = 11;
#ifndef PROBE_REP
#define PROBE_REP -1
#endif
#define REP(k, stmt) do { stmt; if (PROBE_REP == (k)) { __syncthreads(); stmt; } } while (0)
__global__ void __launch_bounds__(NTHR, 2) fwd(Args args) {
    extern __shared__ __attribute__((aligned(16))) unsigned char lds_raw[];
    Frame F; F.lds = (LAS unsigned char*)lds_raw; F.wave = __builtin_amdgcn_readfirstlane((int)threadIdx.x >> 6);
    F.G = gridDim.x; F.gw = blockIdx.x * NWAVES + F.wave; F.NGW = F.G * NWAVES; F.ws = args.ws; F.ctl = (unsigned*)(args.ws + WS_CTL); F.out = args.out;
    volatile LAS unsigned* xbw = (volatile LAS unsigned*)(F.lds + LDS_BYTES - 16);
    if (threadIdx.x < 4) xbw[threadIdx.x] = 0u;
    __syncthreads();
    const bool one = (args.ph_hi - args.ph_lo) > 1;
    XcdBarrier bar; bar.bar = F.ctl + CW_BAR; bar.x = 0; bar.st = xbw;
    if (one) bar = xcd_barrier_post(F.ctl + CW_BAR, xbw, F.wave);
    const int lo = args.ph_lo, hi = args.ph_hi;
#ifndef PROBE_TIME
#define PROBE_TIME -1
#endif
    unsigned long long pt0 = 0ull, pt1 = 0ull;
#define TSTAMP(k, which) do { if (PROBE_TIME == (k) && blockIdx.x == 0) { if (which) pt1 = __builtin_amdgcn_s_memrealtime(); else pt0 = __builtin_amdgcn_s_memrealtime(); } } while (0)
#define IN(k) (lo <= (k) && (k) < hi)
#define SEAM(k) do { if (IN(k) && IN((k) + 1)) xcd_barrier(bar, F.wave); } while (0)
    TSTAMP(0, 0); if (IN(0)) { REP(0, p0_prologue(F, args)); } if (IN(0) && IN(1)) mod_wait(F); TSTAMP(0, 1);
    TSTAMP(1, 0); if (IN(1)) { REP(1, p1_h(F, args)); } SEAM(1); TSTAMP(1, 1);
    TSTAMP(2, 0); if (IN(2)) { REP(2, p2_inproj(F, args)); } SEAM(2); TSTAMP(2, 1);
    TSTAMP(3, 0); if (IN(3)) { p3_qknorm(F, args); __syncthreads(); REP(3, p3_indexer(F, args)); } SEAM(3); TSTAMP(3, 1);
    TSTAMP(4, 0); if (IN(4)) { REP(4, p4_pool_attn(F, args)); if (one) { conv_drain<true, 0, 2>(F, args, 4); } } SEAM(4); TSTAMP(4, 1);
    TSTAMP(5, 0); if (IN(5)) { REP(5, p5_merge(F)); } SEAM(5); TSTAMP(5, 1);
    TSTAMP(6, 0); if (IN(6)) { REP(6, p6_out(F, args)); } SEAM(6); TSTAMP(6, 1);
    TSTAMP(7, 0); if (IN(7)) { p7_router(F, args); conv_drain<false, 0, 1>(F, args, 7); }
    SEAM(7); TSTAMP(7, 1);
    TSTAMP(8, 0); if (IN(8)) { REP(8, p8_gemm1(F, args)); } SEAM(8); TSTAMP(8, 1);
    TSTAMP(9, 0); if (IN(9)) { REP(9, p9_gemm2(F)); } SEAM(9); TSTAMP(9, 1);
    TSTAMP(10, 0); if (IN(10)) { p10_combine(F); } TSTAMP(10, 1);
    if (PROBE_TIME >= 0 && blockIdx.x == 0) { const unsigned long long tend = __builtin_amdgcn_s_memrealtime() + 4ull * (pt1 - pt0); while (__builtin_amdgcn_s_memrealtime() < tend) __builtin_amdgcn_s_sleep(8); }
#undef IN
#undef SEAM
}
#ifndef N_LAUNCHES
#define N_LAUNCHES 1
#endif
extern "C" void kernel_launch(void* const* d_in, const int* in_sizes, int n_in, void* d_out, int out_size, void* d_ws, size_t ws_size, hipStream_t stream) {
    static int grid = 0;
    if (grid == 0) {
        if (n_in != 22 || out_size != NTOK * DM || ws_size < WS_END) { fprintf(stderr, "kernel_launch: unexpected shapes (n_in %d out %d ws %zu need %zu)\n", n_in, out_size, ws_size, (size_t)WS_END); grid = -1; return; }
        int dev = 0, cus = 0, per_cu = 0;
        if (hipGetDevice(&dev) != hipSuccess || hipDeviceGetAttribute(&cus, hipDeviceAttributeMultiprocessorCount, dev) != hipSuccess) { grid = -1; return; }
        if (hipFuncSetAttribute((const void*)fwd, hipFuncAttributeMaxDynamicSharedMemorySize, LDS_BYTES) != hipSuccess) { fprintf(stderr, "kernel_launch: hipFuncSetAttribute failed\n"); grid = -1; return; }
        if (hipOccupancyMaxActiveBlocksPerMultiprocessor(&per_cu, (const void*)fwd, NTHR, LDS_BYTES) != hipSuccess || per_cu < 1) fprintf(stderr, "kernel_launch: occupancy query says %d\n", per_cu);
        (void)hipGetLastError();
        grid = cus;
    }
    if (grid < 0) return;
    (void)hipMemsetAsync((char*)d_ws + WS_CTL, 0, (size_t)CW_MOD * 4, stream);
    Args a{};
    for (int i = 0; i < 22; ++i) a.in[i] = (const float*)d_in[i];
    a.out = (float*)d_out; a.ws = (unsigned char*)d_ws;
    if (N_LAUNCHES == 1) { a.ph_lo = 0; a.ph_hi = N_PHASES; hipLaunchKernelGGL(fwd, dim3(grid), dim3(NTHR), LDS_BYTES, stream, a); }
    else for (int p = 0; p < N_PHASES; ++p) { a.ph_lo = p; a.ph_hi = p + 1; hipLaunchKernelGGL(fwd, dim3(grid), dim3(NTHR), LDS_BYTES, stream, a); }
}
```
